# Optimizing an MI355X kernel written in HIP

```python
import math, functools
import jax, jax.numpy as jnp
from jax import lax
import numpy as np

D_MODEL = 1024
BATCH = 8
SEQ = 2048
DEPTH = 1
DEC_BATCH = 128
DEC_SEQ = 4
PAST_LEN = 2048
PAGE_SIZE = 128

D_INNER = 2 * D_MODEL
SSM_HEAD_DIM = 64
SSM_HEADS = D_INNER // SSM_HEAD_DIM
SSM_GROUPS = 4
SSM_STATE = 128
CONV_W = 4
CONV_DIM = D_INNER + 2 * SSM_GROUPS * SSM_STATE
SSD_CHUNK = 128
N_HEADS = 16
HEAD_DIM = 64
N_KV_HEADS = 4
Q_PER_KV = N_HEADS // N_KV_HEADS
IDX_HEADS = 8
IDX_DIM = 64
TOPK_MAX = 256
Q_BLOCK = 128
N_BUCKETS = 32
MAX_DISTANCE = 128
D_FF = 2816
ALPHA = (2 * DEPTH) ** 0.25
BETA = (8 * DEPTH) ** -0.25
LN_EPS = 1e-5
IN_SPLITS = (D_INNER, CONV_DIM, SSM_HEADS, N_HEADS * HEAD_DIM, N_KV_HEADS * HEAD_DIM,
             N_KV_HEADS * HEAD_DIM, IDX_HEADS * IDX_DIM, IDX_DIM, IDX_HEADS, 2 * D_MODEL)
N_IN = sum(IN_SPLITS)

kernel_name = 'hybrid_ssd_dsa_macaron_step'


def layer_norm(x, g, b):
    xf = x.astype(jnp.float32)
    mu = xf.mean(-1, keepdims=True)
    var = jnp.square(xf - mu).mean(-1, keepdims=True)
    return ((xf - mu) * lax.rsqrt(var + LN_EPS)).astype(x.dtype) * g + b


def swiglu(x, wi, wo):
    gate, up = jnp.split(x @ wi, 2, axis=-1)
    return (jax.nn.silu(gate) * up) @ wo


def causal_dwconv(u, prefix, w, b):
    up = jnp.concatenate([prefix.astype(u.dtype), u], axis=1)
    y = lax.conv_general_dilated(up, w[:, None, :].astype(up.dtype), (1,), 'VALID',
                                 dimension_numbers=('NWC', 'WIO', 'NWC'),
                                 feature_group_count=u.shape[-1])
    return jax.nn.silu(y + b), up[:, -(CONV_W - 1):]


def ssd_scan(x, dt, A, Bm, Cm, h0):
    b, l = x.shape[:2]
    q = math.gcd(l, SSD_CHUNK)
    nc = l // q
    r = SSM_HEADS // SSM_GROUPS
    x = x.reshape(b, nc, q, SSM_GROUPS, r, SSM_HEAD_DIM)
    dt = dt.reshape(b, nc, q, SSM_GROUPS, r)
    Bm = Bm.reshape(b, nc, q, SSM_GROUPS, SSM_STATE)
    Cm = Cm.reshape(b, nc, q, SSM_GROUPS, SSM_STATE)
    cum = jnp.cumsum(dt * A.reshape(SSM_GROUPS, r), axis=2)
    causal = jnp.tril(jnp.ones((q, q), dtype=bool))[:, :, None, None]
    seg = jnp.exp(jnp.where(causal, cum[:, :, :, None] - cum[:, :, None, :], -jnp.inf))
    cb = jnp.einsum('bctgn,bcsgn->bctsg', Cm, Bm)
    mix = cb[..., None] * seg * dt[:, :, None]
    y_diag = jnp.einsum('bctsgr,bcsgrp->bctgrp', mix, x)
    decay_end = jnp.exp(cum[:, :, -1:] - cum)
    states = jnp.einsum('bcsgrp,bcsgn->bcgrpn', x * (decay_end * dt)[..., None], Bm)
    chunk_decay = jnp.exp(cum[:, :, -1])

    def step(h, inp):
        dec, st = inp
        return dec[..., None, None] * h + st, h

    h_init = h0.astype(jnp.float32).reshape(b, SSM_GROUPS, r, SSM_HEAD_DIM, SSM_STATE)
    h_last, h_prev = lax.scan(step, h_init, (jnp.moveaxis(chunk_decay, 1, 0), jnp.moveaxis(states, 1, 0)))
    h_prev = jnp.moveaxis(h_prev, 0, 1)
    y_off = jnp.einsum('bctgn,bcgrpn->bctgrp', Cm, h_prev) * jnp.exp(cum)[..., None]
    y = (y_diag + y_off).reshape(b, l, SSM_HEADS, SSM_HEAD_DIM)
    return y, h_last.reshape(b, SSM_HEADS, SSM_HEAD_DIM, SSM_STATE)


def mamba2_branch(z, xbc, dt_raw, conv_prefix, h0, conv_w, conv_b, dt_bias, a_log, d_skip, norm_g):
    b, l = z.shape[:2]
    xbc, conv_state = causal_dwconv(xbc, conv_prefix, conv_w, conv_b)
    gn = SSM_GROUPS * SSM_STATE
    xs = xbc[..., :D_INNER].reshape(b, l, SSM_HEADS, SSM_HEAD_DIM)
    Bm = xbc[..., D_INNER:D_INNER + gn].reshape(b, l, SSM_GROUPS, SSM_STATE)
    Cm = xbc[..., D_INNER + gn:].reshape(b, l, SSM_GROUPS, SSM_STATE)
    dt = jax.nn.softplus((dt_raw + dt_bias).astype(jnp.float32))
    A = -jnp.exp(a_log.astype(jnp.float32))
    y, h = ssd_scan(xs, dt, A, Bm, Cm, h0)
    y = (y + d_skip[:, None] * xs).astype(z.dtype).reshape(b, l, D_INNER)
    u = (y * jax.nn.silu(z)).astype(jnp.float32).reshape(b, l, SSM_GROUPS, D_INNER // SSM_GROUPS)
    u = u * lax.rsqrt(jnp.mean(u * u, -1, keepdims=True) + LN_EPS)
    return u.reshape(b, l, D_INNER).astype(z.dtype) * norm_g, conv_state, h.astype(z.dtype)


def indexer_scores(qi, wi, ki):
    s = jnp.einsum('bthd,bsd->bths', qi, ki).astype(jnp.float32) * (IDX_DIM ** -0.5)
    return jnp.einsum('bths,bth->bts', jax.nn.relu(s), wi.astype(jnp.float32)) * (IDX_HEADS ** -0.5)


def t5_bucket(rel):
    n = jnp.maximum(rel, 0)
    max_exact = N_BUCKETS // 2
    nf = jnp.maximum(n, 1).astype(jnp.float32)
    large = max_exact + (jnp.log(nf / max_exact) / math.log(MAX_DISTANCE / max_exact)
                         * (N_BUCKETS - max_exact)).astype(jnp.int32)
    large = jnp.minimum(large, N_BUCKETS - 1)
    return jnp.where(n < max_exact, n, large)


def sparse_softmax(q, ksel, vsel, kpos, qpos, bias_table):
    b, t = q.shape[:2]
    kk = ksel.shape[2]
    qg = q.reshape(b, t, N_KV_HEADS, Q_PER_KV, HEAD_DIM)
    logits = jnp.einsum('btgqd,btkgd->btgqk', qg, ksel).astype(jnp.float32) * (HEAD_DIM ** -0.5)
    rel = qpos[..., None] - kpos
    bias = bias_table[t5_bucket(rel)].reshape(b, t, kk, N_KV_HEADS, Q_PER_KV).transpose(0, 1, 3, 4, 2)
    logits = jnp.where((rel >= 0)[:, :, None, None, :], logits + bias.astype(jnp.float32), -jnp.inf)
    p = jax.nn.softmax(logits, axis=-1).astype(vsel.dtype)
    out = jnp.einsum('btgqk,btkgd->btgqd', p, vsel)
    return out.reshape(b, t, N_HEADS * HEAD_DIM)


def gather_rows(a, idx):
    return jax.vmap(lambda ab, ib: ab[ib])(a, idx)


def prompt_attend(q, k, v, qi, ki, wi, bias_table):
    b, s = q.shape[:2]
    topk = min(TOPK_MAX, s // 4)
    qb = math.gcd(s, Q_BLOCK)
    nblk = s // qb
    pos = jnp.arange(s)

    def blocks(a):
        return jnp.moveaxis(a.reshape((b, nblk, qb) + a.shape[2:]), 1, 0)

    def one_block(args):
        q_b, qi_b, wi_b, qpos_b = args
        sc = indexer_scores(qi_b, wi_b, ki)
        sc = jnp.where(pos[None, None, :] <= qpos_b[None, :, None], sc, -jnp.inf)
        _, idx = lax.top_k(sc, topk)
        return sparse_softmax(q_b, gather_rows(k, idx), gather_rows(v, idx), idx,
                              jnp.broadcast_to(qpos_b, (b, qb)), bias_table)

    out = lax.map(one_block, (blocks(q), blocks(qi), blocks(wi), pos.reshape(nblk, qb)))
    return jnp.moveaxis(out, 0, 1).reshape(b, s, N_HEADS * HEAD_DIM)


def sample_attend(q, k, v, qi, ki, wi, bias_table, ck, cv, cki, page_table):
    db, t = q.shape[:2]
    page = ck.shape[1]
    past = page_table.shape[1] * page
    total = past + t
    topk = min(TOPK_MAX, total // 4)
    ki_all = jnp.concatenate([cki[page_table].reshape(db, past, IDX_DIM), ki.astype(cki.dtype)], axis=1)
    qpos = past + jnp.arange(t)
    sc = indexer_scores(qi, wi, ki_all)
    sc = jnp.where(jnp.arange(total)[None, None, :] <= qpos[None, :, None], sc, -jnp.inf)
    _, idx = lax.top_k(sc, topk)
    is_past = (idx < past)[..., None, None]
    pi = jnp.minimum(idx, past - 1)
    phys = jax.vmap(lambda pt, j: pt[j])(page_table, pi // page)
    slot = pi % page
    ni = jnp.clip(idx - past, 0, t - 1)
    ksel = jnp.where(is_past, ck[phys, slot], gather_rows(k, ni).astype(ck.dtype))
    vsel = jnp.where(is_past, cv[phys, slot], gather_rows(v, ni).astype(cv.dtype))
    return sparse_softmax(q, ksel, vsel, idx, jnp.broadcast_to(qpos, (db, t)), bias_table)


def trunk_layer(x, conv_prefix, h0, attend, w_in, conv_w, conv_b, dt_bias, a_log, d_skip, ssm_norm_g,
                w_branch_ssm, w_branch_attn, w_out, ffn1_wi, ffn1_wo, ffn2_wi, ffn2_wo,
                ln1_g, ln1_b, ln2_g, ln2_b, ln3_g, ln3_b):
    b, l = x.shape[:2]
    h = layer_norm(ALPHA * x + 0.5 * swiglu(x, ffn1_wi, ffn1_wo), ln1_g, ln1_b)
    offs = np.cumsum(IN_SPLITS)[:-1].tolist()
    z, xbc, dt_raw, q, k, v, qi, ki, wi, gates = jnp.split(h @ w_in, offs, axis=-1)
    y_ssm, conv_state, ssm_state = mamba2_branch(z, xbc, dt_raw, conv_prefix, h0, conv_w, conv_b,
                                                 dt_bias, a_log, d_skip, ssm_norm_g)
    q = q.reshape(b, l, N_HEADS, HEAD_DIM)
    k = k.reshape(b, l, N_KV_HEADS, HEAD_DIM)
    v = v.reshape(b, l, N_KV_HEADS, HEAD_DIM)
    qi = qi.reshape(b, l, IDX_HEADS, IDX_DIM)
    y_att = attend(q, k, v, qi, ki, wi)
    g_ssm, g_att = jnp.split(jax.nn.sigmoid(gates), 2, axis=-1)
    merged = g_ssm * (y_ssm @ w_branch_ssm) + g_att * (y_att @ w_branch_attn)
    h = layer_norm(ALPHA * h + merged @ w_out, ln2_g, ln2_b)
    h = layer_norm(ALPHA * h + 0.5 * swiglu(h, ffn2_wi, ffn2_wo), ln3_g, ln3_b)
    return h, k, v, ki, conv_state, ssm_state


def setup_inputs(seed: int = 0) -> dict:
    key = jax.random.key(seed)
    ks = jax.random.split(key, 32)
    n_pages = PAST_LEN // PAGE_SIZE
    n_used = DEC_BATCH * n_pages
    n_pool = n_used + max(1, n_used // 4)

    def nrm(k, shape, scale):
        return jax.random.normal(k, shape, jnp.float32) * scale

    x_prompt = nrm(ks[0], (BATCH, SEQ, D_MODEL), 1.0)
    x_sample = nrm(ks[1], (DEC_BATCH, DEC_SEQ, D_MODEL), 1.0)
    cache_k = nrm(ks[2], (DEPTH, n_pool, PAGE_SIZE, N_KV_HEADS, HEAD_DIM), 1.0)
    cache_v = nrm(ks[3], (DEPTH, n_pool, PAGE_SIZE, N_KV_HEADS, HEAD_DIM), BETA)
    cache_kidx = nrm(ks[4], (DEPTH, n_pool, PAGE_SIZE, IDX_DIM), 1.0)
    state_conv = nrm(ks[5], (DEPTH, DEC_BATCH, CONV_W - 1, CONV_DIM), 1.0)
    state_ssm = nrm(ks[6], (DEPTH, DEC_BATCH, SSM_HEADS, SSM_HEAD_DIM, SSM_STATE), 0.5)
    page_table = jax.random.permutation(ks[7], n_pool)[:n_used].reshape(DEC_BATCH, n_pages).astype(jnp.int32)
    bias_table = nrm(ks[8], (N_BUCKETS, N_HEADS), 0.3)
    w_in = nrm(ks[9], (DEPTH, D_MODEL, N_IN), D_MODEL ** -0.5)
    v_start = sum(IN_SPLITS[:5])
    w_in = w_in.at[:, :, v_start:v_start + N_KV_HEADS * HEAD_DIM].multiply(BETA)
    conv_w = nrm(ks[10], (DEPTH, CONV_W, CONV_DIM), CONV_W ** -0.5)
    conv_b = nrm(ks[11], (DEPTH, CONV_DIM), 0.01)
    dt0 = jnp.exp(jax.random.uniform(ks[12], (DEPTH, SSM_HEADS), jnp.float32, math.log(1e-3), math.log(1e-1)))
    dt_bias = dt0 + jnp.log(-jnp.expm1(-dt0))
    a_log = jnp.log(jax.random.uniform(ks[13], (DEPTH, SSM_HEADS), jnp.float32, 1.0, 16.0))
    d_skip = 1.0 + nrm(ks[14], (DEPTH, SSM_HEADS), 0.01)
    ssm_norm_g = 1.0 + nrm(ks[15], (DEPTH, D_INNER), 0.01)
    w_branch_ssm = nrm(ks[16], (DEPTH, D_INNER, D_MODEL), D_INNER ** -0.5)
    w_branch_attn = nrm(ks[17], (DEPTH, N_HEADS * HEAD_DIM, D_MODEL), (N_HEADS * HEAD_DIM) ** -0.5)
    w_out = nrm(ks[18], (DEPTH, D_MODEL, D_MODEL), BETA * D_MODEL ** -0.5)
    ffn1_wi = nrm(ks[19], (DEPTH, D_MODEL, 2 * D_FF), D_MODEL ** -0.5)
    ffn1_wo = nrm(ks[20], (DEPTH, D_FF, D_MODEL), BETA * D_FF ** -0.5)
    ffn2_wi = nrm(ks[21], (DEPTH, D_MODEL, 2 * D_FF), D_MODEL ** -0.5)
    ffn2_wo = nrm(ks[22], (DEPTH, D_FF, D_MODEL), BETA * D_FF ** -0.5)
    ln1_g = 1.0 + nrm(ks[23], (DEPTH, D_MODEL), 0.01)
    ln1_b = nrm(ks[24], (DEPTH, D_MODEL), 0.01)
    ln2_g = 1.0 + nrm(ks[25], (DEPTH, D_MODEL), 0.01)
    ln2_b = nrm(ks[26], (DEPTH, D_MODEL), 0.01)
    ln3_g = 1.0 + nrm(ks[27], (DEPTH, D_MODEL), 0.01)
    ln3_b = nrm(ks[28], (DEPTH, D_MODEL), 0.01)
    return {'x_prompt': x_prompt, 'x_sample': x_sample, 'cache_k': cache_k, 'cache_v': cache_v,
            'cache_kidx': cache_kidx, 'state_conv': state_conv, 'state_ssm': state_ssm,
            'page_table': page_table, 'bias_table': bias_table, 'w_in': w_in, 'conv_w': conv_w,
            'conv_b': conv_b, 'dt_bias': dt_bias, 'a_log': a_log, 'd_skip': d_skip,
            'ssm_norm_g': ssm_norm_g, 'w_branch_ssm': w_branch_ssm, 'w_branch_attn': w_branch_attn,
            'w_out': w_out, 'ffn1_wi': ffn1_wi, 'ffn1_wo': ffn1_wo, 'ffn2_wi': ffn2_wi, 'ffn2_wo': ffn2_wo,
            'ln1_g': ln1_g, 'ln1_b': ln1_b, 'ln2_g': ln2_g, 'ln2_b': ln2_b, 'ln3_g': ln3_g, 'ln3_b': ln3_b}


def reference(x_prompt, x_sample, cache_k, cache_v, cache_kidx, state_conv, state_ssm, page_table,
              bias_table, w_in, conv_w, conv_b, dt_bias, a_log, d_skip, ssm_norm_g, w_branch_ssm,
              w_branch_attn, w_out, ffn1_wi, ffn1_wo, ffn2_wi, ffn2_wo,
              ln1_g, ln1_b, ln2_g, ln2_b, ln3_g, ln3_b):
    yp, ys = x_prompt, x_sample
    outs_p, outs_s = [], []
    prompt_mix = functools.partial(prompt_attend, bias_table=bias_table)
    for i in range(DEPTH):
        lw = (w_in[i], conv_w[i], conv_b[i], dt_bias[i], a_log[i], d_skip[i], ssm_norm_g[i],
              w_branch_ssm[i], w_branch_attn[i], w_out[i], ffn1_wi[i], ffn1_wo[i], ffn2_wi[i], ffn2_wo[i],
              ln1_g[i], ln1_b[i], ln2_g[i], ln2_b[i], ln3_g[i], ln3_b[i])
        bp = yp.shape[0]
        conv0 = jnp.zeros((bp, CONV_W - 1, CONV_DIM), yp.dtype)
        h0 = jnp.zeros((bp, SSM_HEADS, SSM_HEAD_DIM, SSM_STATE), jnp.float32)
        yp, *sp = trunk_layer(yp, conv0, h0, prompt_mix, *lw)
        sample_mix = functools.partial(sample_attend, bias_table=bias_table, ck=cache_k[i], cv=cache_v[i],
                                       cki=cache_kidx[i], page_table=page_table)
        ys, *ss = trunk_layer(ys, state_conv[i], state_ssm[i], sample_mix, *lw)
        outs_p.append(sp)
        outs_s.append(ss)
    k_p, v_p, kidx_p, conv_p, ssm_p = [jnp.stack(a) for a in zip(*outs_p)]
    k_s, v_s, kidx_s, conv_s, ssm_s = [jnp.stack(a) for a in zip(*outs_s)]
    return (yp, ys, k_p, v_p, kidx_p, conv_p, ssm_p, k_s, v_s, kidx_s, conv_s, ssm_s)
```

```cpp
#include <hip/hip_runtime.h>
#include <cstdio>
#include <cstdint>
#define GAS __attribute__((address_space(1)))
#define LAS __attribute__((address_space(3)))
namespace pg8 {
#define PG8_LAS __attribute__((address_space(3)))
typedef unsigned short bf16_t;
typedef short bf16x8 __attribute__((ext_vector_type(8)));
typedef float f32x4 __attribute__((ext_vector_type(4)));
typedef unsigned u32x4 __attribute__((ext_vector_type(4)));
constexpr int BM = 256, BK = 64, HALF = 128, HTB = HALF * BK * 2  , STAGE_BYTES = 8 * HTB, NXCD = 8, WGM = 8;

__host__ __device__ __forceinline__ int lds_byte(int r, int c) { const int st = (r >> 4) * 2 + (c >> 5), rr = r & 15, cc = c & 31, ob = rr * 64 + cc * 2; return st * 1024 + (ob ^ (((ob >> 9) & 1) << 5)); }
__host__ __device__ __forceinline__ void stage_rc(int b, int& R, int& C) { const int st = b / 1024, sb = b % 1024, swz = sb ^ (((sb >> 9) & 1) << 5); R = (st >> 1) * 16 + swz / 64; C = (st & 1) * 32 + (swz % 64) / 2; }
__host__ __device__ __forceinline__ int perm32(int rho) { const int n = rho >> 4, i = rho & 15; return 8 * (i >> 2) + 4 * n + (i & 3); }

struct Unit { int pm, pn; };
struct Gemm { const bf16_t* A; const bf16_t* Bt; int M, N, K; };

struct StaticOrder {
    int nM, nN, nwg, G, c;
    __host__ __device__ void init(int M, int N, int G_, int c_) { nM = M / BM; nN = N / BM; nwg = nM * nN; G = G_; c = c_; }
    __host__ __device__ bool next(int i, Unit& u) const {
        const long L = (long)i * G + c; if (L >= nwg) return false;
        int wgid = (int)L; { const int q = nwg / NXCD, r = nwg % NXCD, xcd = wgid % NXCD, off = wgid / NXCD; wgid = (xcd < r ? xcd * (q + 1) : r * (q + 1) + (xcd - r) * q) + off; }
        const int nig = WGM * nN, gid = wgid / nig, fm = gid * WGM, gsz = (nM - fm) < WGM ? (nM - fm) : WGM;
        u.pm = fm + ((wgid % nig) % gsz); u.pn = (wgid % nig) / gsz; return true;
    }
    __device__ __forceinline__ void a_ready(const Unit&) const {}
    __device__ __forceinline__ void done(const Unit&) const {}
};

__device__ __forceinline__ unsigned cvt_pk_bf16(float lo, float hi) { unsigned r; asm volatile("v_cvt_pk_bf16_f32 %0, %1, %2" : "=v"(r) : "v"(lo), "v"(hi)); return r; }

template <class Epi, class Sched, bool ALIGN_EPI = false, bool SP2 = false>
__device__ __forceinline__ void gemm_phase(PG8_LAS unsigned char* lds, const Gemm g, const Sched& S, const Epi& E) {
    const int tid = threadIdx.x, wid = __builtin_amdgcn_readfirstlane(tid >> 6), lane = tid & 63, wr = wid >> 2, wc = wid & 3, fr = lane & 15, fq = lane >> 4;
    const int K = g.K, nt = K / BK;
    unsigned voffA[2], voffB[2];
#pragma unroll
    for (int i = 0; i < 2; ++i) { int R, C; stage_rc(tid * 16 + i * 8192, R, C); const int Rb = Epi::PERM ? ((R & ~31) + perm32(R & 31)) : R;
        voffA[i] = (unsigned)(R * K + C) * 2u; voffB[i] = (unsigned)(Rb * K + C) * 2u; }
    const size_t kstep = (size_t)(BK * 2);
    const size_t hstep = (size_t)HALF * K * 2;
    const size_t tstep = 2 * hstep;
    const unsigned ldsw = (unsigned)wid * 1024u;
    const int aoff = lds_byte(wr * 64 + fr, fq * 8), boff = lds_byte(wc * 32 + fr, fq * 8);
#define PG8_SA(b, h) (((b) * 2 + (h)) * HTB)
#define PG8_SB(b, h) ((4 + (b) * 2 + (h)) * HTB)
#define PG8_STAGE(bufoff, gbase, voff) do { _Pragma("unroll") for (int _i = 0; _i < 2; ++_i) \
        __builtin_amdgcn_global_load_lds((const unsigned*)((const char*)(gbase) + (voff)[_i]), (PG8_LAS unsigned*)(lds + (bufoff) + ldsw + _i * 8192), 16, 0, 0); } while (0)
#define PG8_LDA(dst, b, h) do { _Pragma("unroll") for (int m = 0; m < 4; ++m) _Pragma("unroll") for (int k = 0; k < 2; ++k) dst[m][k] = *(const PG8_LAS bf16x8*)(lds + PG8_SA(b, h) + aoff + m * 2048 + k * 1024); } while (0)
#define PG8_LDB(dst, b, h) do { _Pragma("unroll") for (int n = 0; n < 2; ++n) _Pragma("unroll") for (int k = 0; k < 2; ++k) dst[n][k] = *(const PG8_LAS bf16x8*)(lds + PG8_SB(b, h) + boff + n * 2048 + k * 1024); } while (0)
#define PG8_MMA(ai, bj, At, Bt) do { __builtin_amdgcn_s_setprio(1); _Pragma("unroll") for (int m = 0; m < 4; ++m) _Pragma("unroll") for (int n = 0; n < 2; ++n) _Pragma("unroll") for (int k = 0; k < 2; ++k) \
        acc[ai][bj][m][n] = __builtin_amdgcn_mfma_f32_16x16x32_bf16(Bt[n][k], At[m][k], acc[ai][bj][m][n], 0, 0, 0); __builtin_amdgcn_s_setprio(0); } while (0)
#define PG8_WAIT_V(n) asm volatile("s_waitcnt vmcnt(" #n ")" ::: "memory")
#define PG8_WAIT_L(n) asm volatile("s_waitcnt lgkmcnt(" #n ")" ::: "memory")
#define PG8_BAR __builtin_amdgcn_s_barrier()
#define PG8_SCHED __builtin_amdgcn_sched_barrier(0)
    Unit cur, nxt; int ui = 0;
    if (!S.next(0, cur)) return;
    f32x4 acc[2][2][4][2];
#pragma unroll
    for (int a = 0; a < 2; ++a)
#pragma unroll
        for (int b = 0; b < 2; ++b)
#pragma unroll
            for (int m = 0; m < 4; ++m)
#pragma unroll
                for (int n = 0; n < 2; ++n) acc[a][b][m][n] = (f32x4){0.f, 0.f, 0.f, 0.f};
    bf16x8 At[4][2], B0[2][2], B1[2][2];
    const char* cA = (const char*)g.A + (size_t)cur.pm * tstep; const char* cB = (const char*)g.Bt + (size_t)cur.pn * tstep;
    S.a_ready(cur);
    if constexpr (SP2) {
        PG8_STAGE(PG8_SB(0, 0), cB, voffB); PG8_STAGE(PG8_SB(0, 1), cB + hstep, voffB); PG8_STAGE(PG8_SA(0, 0), cA, voffA); PG8_STAGE(PG8_SA(0, 1), cA + hstep, voffA);
        if (wr == 1) PG8_BAR;
        PG8_WAIT_V(2); PG8_BAR;
        PG8_STAGE(PG8_SB(1, 0), cB + kstep, voffB); PG8_STAGE(PG8_SA(1, 0), cA + kstep, voffA); PG8_STAGE(PG8_SB(1, 1), cB + hstep + kstep, voffB);
        PG8_WAIT_V(6); PG8_BAR;
    } else {
        PG8_STAGE(PG8_SB(0, 0), cB, voffB); PG8_STAGE(PG8_SA(0, 0), cA, voffA); PG8_STAGE(PG8_SB(0, 1), cB + hstep, voffB); PG8_STAGE(PG8_SA(0, 1), cA + hstep, voffA);
        if (wr == 1) PG8_BAR;
        PG8_WAIT_V(4); PG8_BAR;
        PG8_STAGE(PG8_SB(1, 0), cB + kstep, voffB); PG8_STAGE(PG8_SA(1, 0), cA + kstep, voffA); PG8_STAGE(PG8_SB(1, 1), cB + hstep + kstep, voffB);
        PG8_WAIT_V(6); PG8_BAR;
    }
    for (;;) {
        const bool has_next = S.next(ui + 1, nxt);
        const char* nA = has_next ? (const char*)g.A + (size_t)nxt.pm * tstep : cA; const char* nB = has_next ? (const char*)g.Bt + (size_t)nxt.pn * tstep : cB;
        for (int t = 0; t < nt; t += 2) {
            const bool last = (t == nt - 2);
            const char* a1 = cA + (size_t)(t + 1) * kstep;
            const char* a2 = last ? nA : cA + (size_t)(t + 2) * kstep; const char* b2 = last ? nB : cB + (size_t)(t + 2) * kstep;
            const char* a3 = a2 + kstep; const char* b3 = b2 + kstep;
            if (last && has_next) S.a_ready(nxt);
            if constexpr (SP2) {
            PG8_LDB(B0, 0, 0); PG8_LDB(B1, 0, 1); PG8_SCHED; PG8_LDA(At, 0, 0); PG8_STAGE(PG8_SA(1, 1), a1 + hstep, voffA);
            PG8_WAIT_V(8); PG8_WAIT_L(0); PG8_BAR; PG8_MMA(0, 0, At, B0); PG8_MMA(0, 1, At, B1); PG8_BAR; PG8_SCHED;
            PG8_LDA(At, 0, 1); PG8_STAGE(PG8_SB(0, 0), b2, voffB); PG8_STAGE(PG8_SB(0, 1), b2 + hstep, voffB); PG8_STAGE(PG8_SA(0, 0), a2, voffA);
            PG8_WAIT_V(8); PG8_WAIT_L(0); PG8_BAR; PG8_MMA(1, 0, At, B0); PG8_MMA(1, 1, At, B1); PG8_BAR; PG8_SCHED;
            PG8_LDB(B0, 1, 0); PG8_LDB(B1, 1, 1); PG8_SCHED; PG8_LDA(At, 1, 0); PG8_STAGE(PG8_SA(0, 1), a2 + hstep, voffA);
            PG8_WAIT_V(8); PG8_WAIT_L(0); PG8_BAR; PG8_MMA(0, 0, At, B0); PG8_MMA(0, 1, At, B1); PG8_BAR; PG8_SCHED;
            PG8_LDA(At, 1, 1); PG8_STAGE(PG8_SB(1, 0), b3, voffB); PG8_STAGE(PG8_SB(1, 1), b3 + hstep, voffB); PG8_STAGE(PG8_SA(1, 0), a3, voffA);
            PG8_WAIT_V(8); PG8_WAIT_L(0); PG8_BAR; PG8_MMA(1, 0, At, B0); PG8_MMA(1, 1, At, B1); PG8_BAR; PG8_SCHED;
            } else {
            PG8_LDB(B0, 0, 0); PG8_SCHED; PG8_LDA(At, 0, 0); PG8_STAGE(PG8_SA(1, 1), a1 + hstep, voffA);
            PG8_WAIT_L(8); PG8_BAR; PG8_WAIT_L(0); PG8_MMA(0, 0, At, B0); PG8_BAR; PG8_SCHED;
            PG8_LDB(B1, 0, 1); PG8_STAGE(PG8_SB(0, 0), b2, voffB);
            PG8_BAR; PG8_WAIT_L(0); PG8_MMA(0, 1, At, B1); PG8_BAR;
            PG8_LDA(At, 0, 1); PG8_STAGE(PG8_SA(0, 0), a2, voffA);
            PG8_BAR; PG8_WAIT_L(0); PG8_MMA(1, 0, At, B0); PG8_BAR; PG8_SCHED;
            PG8_STAGE(PG8_SB(0, 1), b2 + hstep, voffB);
            PG8_WAIT_V(6); PG8_BAR; PG8_MMA(1, 1, At, B1); PG8_BAR;
            PG8_LDB(B0, 1, 0); PG8_SCHED; PG8_LDA(At, 1, 0); PG8_STAGE(PG8_SA(0, 1), a2 + hstep, voffA);
            PG8_WAIT_L(8); PG8_BAR; PG8_WAIT_L(0); PG8_MMA(0, 0, At, B0); PG8_BAR; PG8_SCHED;
            PG8_LDB(B1, 1, 1); PG8_STAGE(PG8_SB(1, 0), b3, voffB);
            PG8_BAR; PG8_WAIT_L(0); PG8_MMA(0, 1, At, B1); PG8_BAR;
            PG8_LDA(At, 1, 1); PG8_STAGE(PG8_SA(1, 0), a3, voffA);
            PG8_BAR; PG8_WAIT_L(0); PG8_MMA(1, 0, At, B0); PG8_BAR; PG8_SCHED;
            PG8_STAGE(PG8_SB(1, 1), b3 + hstep, voffB);
            PG8_WAIT_V(6); PG8_BAR; PG8_MMA(1, 1, At, B1); PG8_BAR;
            }
        }
        if constexpr (ALIGN_EPI) { if (wr == 0) PG8_BAR; }
        if constexpr (!Epi::AFTER_DRAIN) { E(acc, cur, wr, wc, fr, fq); S.done(cur); }
        if (!has_next) break;
#pragma unroll
        for (int a = 0; a < 2; ++a)
#pragma unroll
            for (int b = 0; b < 2; ++b)
#pragma unroll
                for (int m = 0; m < 4; ++m)
#pragma unroll
                    for (int n = 0; n < 2; ++n) acc[a][b][m][n] = (f32x4){0.f, 0.f, 0.f, 0.f};
        cur = nxt; cA = nA; cB = nB; ++ui;
        if constexpr (ALIGN_EPI) { if (wr == 1) PG8_BAR; }
    }
    PG8_WAIT_V(0);
    if constexpr (!ALIGN_EPI) { if (wr == 0) PG8_BAR; }
    PG8_BAR;
    if constexpr (Epi::AFTER_DRAIN) { E.fused(acc, cur, wr, wc, fr, fq, lds, wid, lane); S.done(cur); }
#undef PG8_SA
#undef PG8_SB
#undef PG8_STAGE
#undef PG8_LDA
#undef PG8_LDB
#undef PG8_MMA
#undef PG8_WAIT_V
#undef PG8_WAIT_L
#undef PG8_BAR
#undef PG8_SCHED
}
}
#define XB_TMO      128
#define XB_XCNT(j)  (256  + 64 * (j))
#define XB_XSUB(j)  (1280 + 64 * (j))
#define XB_XGEN(j)  (2304 + 64 * (j))
#define XB_TOP      3328
#define XB_TOPGEN   3392
#define XCD_BAR_WORDS 3456
#define XB_SPIN_CAP (1u << 18)

__device__ __forceinline__ unsigned xb_ld(unsigned* p)              { return __hip_atomic_load(p, __ATOMIC_RELAXED, __HIP_MEMORY_SCOPE_AGENT); }
__device__ __forceinline__ unsigned xb_add(unsigned* p, unsigned v) { return __hip_atomic_fetch_add(p, v, __ATOMIC_RELAXED, __HIP_MEMORY_SCOPE_AGENT); }
__device__ __forceinline__ unsigned xb_xcc_id() { return (unsigned)__builtin_amdgcn_s_getreg((3 << 11) | 20) & 0xFu; }
#define XB_SPIN(cond, bar) do { unsigned _sp = 0; while (cond) { __builtin_amdgcn_s_sleep(1); \
    if ((++_sp & 255u) == 0u) { if (xb_ld(&(bar)[XB_TMO])) break; if (_sp > XB_SPIN_CAP) { atomicAdd(&(bar)[XB_TMO], 1u); break; } } } } while (0)

struct XcdBarrier {
    unsigned* bar; unsigned x;
    volatile LAS unsigned* st;
};

__device__ __forceinline__ XcdBarrier xcd_barrier_post(unsigned* bar, volatile LAS unsigned* st) {
    XcdBarrier b; b.bar = bar; b.x = xb_xcc_id(); b.st = st;
    if (threadIdx.x == 0) (void)xb_add(&bar[XB_XCNT(b.x)], 1u);
    return b;
}
__device__ __forceinline__ void xcd_barrier_complete(unsigned* bar, unsigned x, unsigned& nloc, unsigned& nx) {
    const unsigned G = gridDim.x * gridDim.y * gridDim.z;
    unsigned sum, cnt, mine, sp = 0u;
    for (;;) {
        sum = 0u; cnt = 0u; mine = 0u;
#pragma unroll
        for (unsigned j = 0; j < 16; ++j) { const unsigned c = xb_ld(&bar[XB_XCNT(j)]); sum += c; cnt += (c > 0u) ? 1u : 0u; mine = (j == x) ? c : mine; }
        if (sum == G) break;
        __builtin_amdgcn_s_sleep(1);
        if ((++sp & 255u) == 0u) { if (xb_ld(&bar[XB_TMO])) break; if (sp > XB_SPIN_CAP) { atomicAdd(&bar[XB_TMO], 1u); break; } }
    }
    nloc = mine > 0u ? mine : 1u; nx = cnt > 0u ? cnt : 1u;
}

__device__ __forceinline__ void xcd_barrier(const XcdBarrier& b) {
    asm volatile("s_waitcnt vmcnt(0)" ::: "memory");
    __syncthreads();
    if (threadIdx.x == 0) {
        unsigned* bar = b.bar;
        __builtin_amdgcn_s_waitcnt(0);
        unsigned nloc = b.st[0], nx = b.st[1];
        if (nloc == 0u) { xcd_barrier_complete(bar, b.x, nloc, nx); b.st[0] = nloc; b.st[1] = nx; }
        const unsigned old = xb_add(&bar[XB_XSUB(b.x)], 1u);
        const unsigned gen = old / nloc;
        if (old + 1u == (gen + 1u) * nloc) {
            __builtin_amdgcn_fence(__ATOMIC_RELEASE, "agent");
            asm volatile("s_waitcnt vmcnt(0)" ::: "memory");
            const unsigned og = xb_add(&bar[XB_TOP], 1u);
            const unsigned tg = og / nx;
            if (og + 1u == (tg + 1u) * nx) xb_add(&bar[XB_TOPGEN], 1u);
            else XB_SPIN(xb_ld(&bar[XB_TOPGEN]) == tg, bar);
            __builtin_amdgcn_fence(__ATOMIC_ACQUIRE, "agent");
            xb_add(&bar[XB_XGEN(b.x)], 1u);
            asm volatile("s_waitcnt vmcnt(0)" ::: "memory");
        } else {
            XB_SPIN(xb_ld(&bar[XB_XGEN(b.x)]) == gen, bar);
            __builtin_amdgcn_fence(__ATOMIC_ACQUIRE, "agent");
            asm volatile("s_waitcnt vmcnt(0)" ::: "memory");
        }
    }
    __syncthreads();
}
namespace mk {
using pg8::bf16_t; using pg8::bf16x8; using pg8::f32x4; using pg8::u32x4;
typedef unsigned u32x2 __attribute__((ext_vector_type(2)));

#ifndef MK_SPLIT
#define MK_SPLIT 1
#endif

constexpr int NWAVES = 8, NTHR = 512;
constexpr int MP = 16384, MS = 512, M = MP + MS, D = 1024, DFF = 2816, DI = 2048, NP = 9472, XCW = 3072;
constexpr int PZ = 0, PXBC = 2048, PSM = 5120, PQ = 5376, PK = 6400, PV = 6656, PQI = 6912, PG = 7424;
constexpr int SCW = 2048, SCSW = 2112;
constexpr size_t O_Y = 0, O_KP = 17301504, O_VP = 21495808, O_KIP = 25690112, O_CVP = 26738688, O_SSP = 26812416,
                 O_KS = 28909568, O_VS = 29040640, O_KIS = 29171712, O_CVS = 29204480, O_SSS = 30384128, O_END = 63938560;
constexpr size_t MiB = 1u << 20;
constexpr size_t WS_CTL = 0, CTL_ZERO_BYTES = 1 * MiB;
constexpr size_t WS_W1A = 1 * MiB, WS_W1B = WS_W1A + 11 * MiB, WS_WIN = WS_W1B + 6 * MiB, WS_WBS = WS_WIN + 19 * MiB, WS_WBA = WS_WBS + 4 * MiB,
                 WS_WOUT = WS_WBA + 2 * MiB, WS_W2A = WS_WOUT + 2 * MiB, WS_W2B = WS_W2A + 11 * MiB;
constexpr size_t WS_XB = WS_W2B + 6 * MiB, WS_ACT = WS_XB + 33 * MiB, WS_T = WS_ACT + 91 * MiB, WS_HF = WS_T + 66 * MiB, WS_HB = WS_HF + 66 * MiB,
                 WS_P = WS_HB + 33 * MiB, WS_SMF = WS_P + 306 * MiB, WS_XC = WS_SMF + 9 * MiB, WS_Y = WS_XC + 99 * MiB, WS_SC = WS_Y + 66 * MiB,
                 WS_SCS = WS_SC + 128 * MiB, WS_YA = WS_SCS + 5 * MiB, WS_MG = WS_YA + 33 * MiB, WS_END = WS_MG + 33 * MiB;
constexpr int CW_BAR = 4096;
constexpr int LDS_BYTES = 163840, MISC_OFF = LDS_BYTES - 256;
constexpr int WAREA = 17920;
constexpr int BIASREL_OFF = NWAVES * WAREA;
static_assert(BIASREL_OFF + 129 * 16 * 4 <= MISC_OFF, "LDS map");

constexpr float ALPHA = 1.18920711500272f;
constexpr float LN_EPS = 1e-5f;

struct Args { const float* in[29]; float* out; unsigned char* ws; int ph_lo, ph_hi; };
enum { I_XP = 0, I_XS, I_CK, I_CV, I_CKI, I_SCONV, I_SSSM, I_PT, I_BIAS, I_WIN, I_CONVW, I_CONVB, I_DTB, I_ALOG, I_DSKIP, I_NORMG, I_WBS, I_WBA, I_WOUT,
       I_F1WI, I_F1WO, I_F2WI, I_F2WO, I_LN1G, I_LN1B, I_LN2G, I_LN2B, I_LN3G, I_LN3B };

__device__ __forceinline__ float bf2f(unsigned v) { return __uint_as_float(v << 16); }
__device__ __forceinline__ unsigned f2bf(float f) { unsigned u = __float_as_uint(f); return (u + 0x7fffu + ((u >> 16) & 1u)) >> 16; }
__device__ __forceinline__ unsigned pk2(float lo, float hi) { return pg8::cvt_pk_bf16(lo, hi); }
__device__ __forceinline__ void unpack8(const u32x4 w, float (&f)[8]) {
#pragma unroll
    for (int i = 0; i < 4; ++i) { f[2 * i] = __uint_as_float(w[i] << 16); f[2 * i + 1] = __uint_as_float(w[i] & 0xffff0000u); }
}
__device__ __forceinline__ u32x4 pack8(const float (&f)[8]) { u32x4 w; w.x = pk2(f[0], f[1]); w.y = pk2(f[2], f[3]); w.z = pk2(f[4], f[5]); w.w = pk2(f[6], f[7]); return w; }
__device__ __forceinline__ float sigmoidf_(float x) { return 1.0f / (1.0f + __expf(-x)); }
__device__ __forceinline__ float siluf_(float x) { return x / (1.0f + __expf(-x)); }
__device__ __forceinline__ float wave_sum(float v) {
#pragma unroll
    for (int o = 1; o < 64; o <<= 1) v += __shfl_xor(v, o);
    return v;
}
__device__ __forceinline__ float wave_max(float v) {
#pragma unroll
    for (int o = 1; o < 64; o <<= 1) v = fmaxf(v, __shfl_xor(v, o));
    return v;
}
__device__ __forceinline__ f32x4 mfma16(bf16x8 a, bf16x8 b, f32x4 c) { return __builtin_amdgcn_mfma_f32_16x16x32_bf16(a, b, c, 0, 0, 0); }
__device__ __forceinline__ int mbcnt64(unsigned long long m) { return (int)__builtin_amdgcn_mbcnt_hi((unsigned)(m >> 32), __builtin_amdgcn_mbcnt_lo((unsigned)m, 0u)); }

struct EpiSwiglu {
    static constexpr bool PERM = true, AFTER_DRAIN = false;
    bf16_t* O;
    __device__ __forceinline__ void operator()(const f32x4 (&acc)[2][2][4][2], const pg8::Unit& u, int wr, int wc, int fr, int fq) const {
        const int row0 = u.pm * 256 + wr * 64 + fr, col0 = u.pn * 128 + wc * 32 + 8 * fq;
#pragma unroll
        for (int ai = 0; ai < 2; ++ai)
#pragma unroll
            for (int m = 0; m < 4; ++m) {
                float o[8];
#pragma unroll
                for (int n = 0; n < 2; ++n)
#pragma unroll
                    for (int j = 0; j < 4; ++j) { const float g = acc[ai][0][m][n][j], up = acc[ai][1][m][n][j]; o[4 * n + j] = siluf_(g) * up; }
                *(u32x4*)(O + (size_t)(row0 + ai * 128 + m * 16) * DFF + col0) = pack8(o);
            }
    }
};
struct EpiResid {
    static constexpr bool PERM = false, AFTER_DRAIN = false;
    const float* base_p; const float* base_s; float* T; float alpha, s;
    __device__ __forceinline__ void operator()(const f32x4 (&acc)[2][2][4][2], const pg8::Unit& u, int wr, int wc, int fr, int fq) const {
        const int row0 = u.pm * 256 + wr * 64 + fr, col0 = u.pn * 256 + wc * 32 + 4 * fq;
#pragma unroll
        for (int ai = 0; ai < 2; ++ai)
#pragma unroll
            for (int m = 0; m < 4; ++m) {
                const int r = row0 + ai * 128 + m * 16;
                const float* b = (r < MP) ? base_p + (size_t)r * D : base_s + (size_t)(r - MP) * D;
#pragma unroll
                for (int bj = 0; bj < 2; ++bj)
#pragma unroll
                    for (int n = 0; n < 2; ++n) { const int c = col0 + bj * 128 + n * 16; const f32x4 bv = *(const f32x4*)(b + c);
                        *(f32x4*)(T + (size_t)r * D + c) = bv * alpha + acc[ai][bj][m][n] * s; }
            }
    }
};
struct EpiWin {
    static constexpr bool PERM = true, AFTER_DRAIN = false;
    bf16_t* P; float* smf; float* out;
    __device__ __forceinline__ void operator()(const f32x4 (&acc)[2][2][4][2], const pg8::Unit& u, int wr, int wc, int fr, int fq) const {
        const int row0 = u.pm * 256 + wr * 64 + fr, cl = wc * 32 + 8 * fq, col0 = u.pn * 256 + cl;
#pragma unroll
        for (int ai = 0; ai < 2; ++ai)
#pragma unroll
            for (int m = 0; m < 4; ++m) {
                const int r = row0 + ai * 128 + m * 16;
#pragma unroll
                for (int bj = 0; bj < 2; ++bj) {
                    const f32x4 v0 = acc[ai][bj][m][0], v1 = acc[ai][bj][m][1];
                    u32x4 w; w.x = pk2(v0[0], v0[1]); w.y = pk2(v0[2], v0[3]); w.z = pk2(v1[0], v1[1]); w.w = pk2(v1[2], v1[3]);
                    *(u32x4*)(P + (size_t)r * NP + col0 + bj * 128) = w;
                    if (u.pn == 20) {
                        if (bj == 0) {
                            float* d = smf + (size_t)r * 128 + cl; *(f32x4*)d = v0; *(f32x4*)(d + 4) = v1;
                            if (cl >= 64) { float* k = out + ((r < MP) ? O_KIP + (size_t)r * 64 : O_KIS + (size_t)(r - MP) * 64) + (cl - 64); *(f32x4*)k = v0; *(f32x4*)(k + 4) = v1; }
                        }
                    } else if (u.pn == 25) {
                        float* k = out + ((r < MP) ? O_KP + (size_t)r * 256 : O_KS + (size_t)(r - MP) * 256) + bj * 128 + cl; *(f32x4*)k = v0; *(f32x4*)(k + 4) = v1;
                    } else if (u.pn == 26) {
                        float* k = out + ((r < MP) ? O_VP + (size_t)r * 256 : O_VS + (size_t)(r - MP) * 256) + bj * 128 + cl; *(f32x4*)k = v0; *(f32x4*)(k + 4) = v1;
                    }
                }
            }
    }
};
struct EpiGateA {
    static constexpr bool PERM = false, AFTER_DRAIN = false;
    const bf16_t* P; int gcol; float* M1;
    __device__ __forceinline__ void operator()(const f32x4 (&acc)[2][2][4][2], const pg8::Unit& u, int wr, int wc, int fr, int fq) const {
        const int row0 = u.pm * 256 + wr * 64 + fr, col0 = u.pn * 256 + wc * 32 + 4 * fq;
#pragma unroll
        for (int ai = 0; ai < 2; ++ai)
#pragma unroll
            for (int m = 0; m < 4; ++m) {
                const int r = row0 + ai * 128 + m * 16;
#pragma unroll
                for (int bj = 0; bj < 2; ++bj)
#pragma unroll
                    for (int n = 0; n < 2; ++n) { const int c = col0 + bj * 128 + n * 16; const u32x2 gw = *(const u32x2*)(P + (size_t)r * NP + gcol + c);
                        f32x4 g; g[0] = sigmoidf_(__uint_as_float(gw.x << 16)); g[1] = sigmoidf_(__uint_as_float(gw.x & 0xffff0000u)); g[2] = sigmoidf_(__uint_as_float(gw.y << 16)); g[3] = sigmoidf_(__uint_as_float(gw.y & 0xffff0000u));
                        *(f32x4*)(M1 + (size_t)r * D + c) = g * acc[ai][bj][m][n]; }
            }
    }
};
struct EpiGateS {
    static constexpr bool PERM = true, AFTER_DRAIN = false;
    const bf16_t* P; int gcol; const float* M1; bf16_t* MG;
    __device__ __forceinline__ void operator()(const f32x4 (&acc)[2][2][4][2], const pg8::Unit& u, int wr, int wc, int fr, int fq) const {
        const int row0 = u.pm * 256 + wr * 64 + fr, col0 = u.pn * 256 + wc * 32 + 8 * fq;
#pragma unroll
        for (int ai = 0; ai < 2; ++ai)
#pragma unroll
            for (int m = 0; m < 4; ++m) {
                const int r = row0 + ai * 128 + m * 16;
#pragma unroll
                for (int bj = 0; bj < 2; ++bj) { const int c = col0 + bj * 128;
                    const u32x4 gw = *(const u32x4*)(P + (size_t)r * NP + gcol + c); float g[8]; unpack8(gw, g);
                    const f32x4 m0 = *(const f32x4*)(M1 + (size_t)r * D + c), m1 = *(const f32x4*)(M1 + (size_t)r * D + c + 4);
                    float o[8];
#pragma unroll
                    for (int j = 0; j < 4; ++j) { o[j] = m0[j] + sigmoidf_(g[j]) * acc[ai][bj][m][0][j]; o[4 + j] = m1[j] + sigmoidf_(g[4 + j]) * acc[ai][bj][m][1][j]; }
                    *(u32x4*)(MG + (size_t)r * D + c) = pack8(o); }
            }
    }
};

__device__ __forceinline__ void tr_item(const float* W, int K, int Nsrc, bf16_t* WT, int k0, int drow0, int scol0, int nvalid, LAS float* scr, int lane) {
    const int c = lane & 31;
#pragma unroll 8
    for (int i = 0; i < 32; ++i) { const int kk = 2 * i + (lane >> 5); float v = 0.f; if (c < nvalid) v = W[(size_t)(k0 + kk) * Nsrc + scol0 + c]; scr[kk * 33 + c] = v; }
    asm volatile("s_waitcnt lgkmcnt(0)" ::: "memory");
    const int cc = lane & 7;
#pragma unroll
    for (int j = 0; j < 4; ++j) { const int n = (lane >> 3) + 8 * j; const LAS float* s = scr + (8 * cc) * 33 + n;
        u32x4 o; o.x = pk2(s[0 * 33], s[1 * 33]); o.y = pk2(s[2 * 33], s[3 * 33]); o.z = pk2(s[4 * 33], s[5 * 33]); o.w = pk2(s[6 * 33], s[7 * 33]);
        *(u32x4*)(WT + (size_t)(drow0 + n) * K + k0 + 8 * cc) = o; }
    asm volatile("s_waitcnt lgkmcnt(0)" ::: "memory");
}
__device__ __forceinline__ void tr_map(int mode, int n0, int& scol0, int& nvalid) {
    nvalid = 32;
    if (mode == 0) { scol0 = n0; }
    else if (mode == 1) { const int j = n0 >> 8, i = n0 & 255; scol0 = (i < 128) ? j * 128 + i : DFF + j * 128 + (i - 128); }
    else {
        if (n0 < 5120) scol0 = n0;
        else if (n0 < 5376) { const int j = n0 - 5120;
            if (j == 0) scol0 = 5120;
            else if (j == 32) { scol0 = 7264; nvalid = 8; }
            else if (j == 64 || j == 96) scol0 = 7200 + (j - 64);
            else { scol0 = 0; nvalid = 0; } }
        else if (n0 < 6400) scol0 = 5152 + (n0 - 5376);
        else if (n0 < 6656) scol0 = 6176 + (n0 - 6400);
        else if (n0 < 6912) scol0 = 6432 + (n0 - 6656);
        else if (n0 < 7424) scol0 = 6688 + (n0 - 6912);
        else scol0 = 7272 + (n0 - 7424);
    }
}
__device__ __forceinline__ void p0_prologue(const Args& A, LAS unsigned char* lds, int gw, int NGW, int wave, int lane) {
    LAS float* scr = (LAS float*)(lds + wave * 16384);
    unsigned char* ws = A.ws;
    constexpr int NI0 = 16 * 176, NI1 = 44 * 32, NI2 = 16 * 296, NI3 = 32 * 32, NI4 = 16 * 32, NI5 = 16 * 32, NI6 = NI0, NI7 = NI1;
    constexpr int NIT = NI0 + NI1 + NI2 + NI3 + NI4 + NI5 + NI6 + NI7;
    for (int it = gw; it < NIT; it += NGW) {
        int r = it; const float* W; bf16_t* WT; int K, Nsrc, nblk, mode;
        if (r < NI0) { W = A.in[I_F1WI]; WT = (bf16_t*)(ws + WS_W1A); K = 1024; Nsrc = 2 * DFF; nblk = 176; mode = 1; }
        else if ((r -= NI0) < NI1) { W = A.in[I_F1WO]; WT = (bf16_t*)(ws + WS_W1B); K = DFF; Nsrc = 1024; nblk = 32; mode = 0; }
        else if ((r -= NI1) < NI2) { W = A.in[I_WIN]; WT = (bf16_t*)(ws + WS_WIN); K = 1024; Nsrc = 9320; nblk = 296; mode = 2; }
        else if ((r -= NI2) < NI3) { W = A.in[I_WBS]; WT = (bf16_t*)(ws + WS_WBS); K = 2048; Nsrc = 1024; nblk = 32; mode = 0; }
        else if ((r -= NI3) < NI4) { W = A.in[I_WBA]; WT = (bf16_t*)(ws + WS_WBA); K = 1024; Nsrc = 1024; nblk = 32; mode = 0; }
        else if ((r -= NI4) < NI5) { W = A.in[I_WOUT]; WT = (bf16_t*)(ws + WS_WOUT); K = 1024; Nsrc = 1024; nblk = 32; mode = 0; }
        else if ((r -= NI5) < NI6) { W = A.in[I_F2WI]; WT = (bf16_t*)(ws + WS_W2A); K = 1024; Nsrc = 2 * DFF; nblk = 176; mode = 1; }
        else { r -= NI6; W = A.in[I_F2WO]; WT = (bf16_t*)(ws + WS_W2B); K = DFF; Nsrc = 1024; nblk = 32; mode = 0; }
        const int kb = r / nblk, nb = r % nblk; int scol0, nvalid; tr_map(mode, nb * 32, scol0, nvalid);
        tr_item(W, K, Nsrc, WT, kb * 64, nb * 32, scol0, nvalid, scr, lane);
    }
    bf16_t* XB = (bf16_t*)(ws + WS_XB);
    const int nchunk = M * D / 8;
    for (int ch = gw * 64 + lane; ch < nchunk; ch += NGW * 64) {
        const int m = ch >> 7, c = (ch & 127) * 8;
        const float* src = (m < MP) ? A.in[I_XP] + (size_t)m * D + c : A.in[I_XS] + (size_t)(m - MP) * D + c;
        const f32x4 a = *(const f32x4*)src, b = *(const f32x4*)(src + 4);
        u32x4 w; w.x = pk2(a[0], a[1]); w.y = pk2(a[2], a[3]); w.z = pk2(b[0], b[1]); w.w = pk2(b[2], b[3]);
        *(u32x4*)(XB + (size_t)m * D + c) = w;
    }
}

__device__ __forceinline__ void ln_phase(const float* T, const float* g, const float* b, float* outf, bf16_t* outb, int gw, int NGW, int lane) {
    f32x4 gv[4], bv[4];
#pragma unroll
    for (int j = 0; j < 4; ++j) { gv[j] = *(const f32x4*)(g + 4 * lane + 256 * j); bv[j] = *(const f32x4*)(b + 4 * lane + 256 * j); }
    for (int m = gw; m < M; m += NGW) {
        const float* xr = T + (size_t)m * D + 4 * lane;
        f32x4 v[4]; float s = 0.f;
#pragma unroll
        for (int j = 0; j < 4; ++j) { v[j] = *(const f32x4*)(xr + 256 * j); s += (v[j][0] + v[j][1]) + (v[j][2] + v[j][3]); }
        const float mean = wave_sum(s) * (1.f / D); float s2 = 0.f;
#pragma unroll
        for (int j = 0; j < 4; ++j) { v[j] = v[j] - mean; s2 += (v[j][0] * v[j][0] + v[j][1] * v[j][1]) + (v[j][2] * v[j][2] + v[j][3] * v[j][3]); }
        const float rstd = 1.0f / sqrtf(wave_sum(s2) * (1.f / D) + LN_EPS);
#pragma unroll
        for (int j = 0; j < 4; ++j) {
            const f32x4 o = v[j] * rstd * gv[j] + bv[j];
            *(f32x4*)(outf + (size_t)m * D + 4 * lane + 256 * j) = o;
            if (outb) { u32x2 w; w.x = pk2(o[0], o[1]); w.y = pk2(o[2], o[3]); *(u32x2*)(outb + (size_t)m * D + 4 * lane + 256 * j) = w; }
        }
    }
}

__device__ __forceinline__ void conv_phase(const Args& A) {
    const bf16_t* P = (const bf16_t*)(A.ws + WS_P); bf16_t* XC = (bf16_t*)(A.ws + WS_XC);
    const float* cw = A.in[I_CONVW]; const float* cb = A.in[I_CONVB]; const float* sconv = A.in[I_SCONV];
    const long total = (long)M * 384, stride = (long)gridDim.x * NTHR;
    for (long it = (long)blockIdx.x * NTHR + threadIdx.x; it < total; it += stride) {
        const int m = (int)(it / 384), ch = (int)(it % 384) * 8;
        const bool samp = m >= MP; int b, t;
        if (!samp) { b = m >> 11; t = m & 2047; } else { const int ms = m - MP; b = ms >> 2; t = ms & 3; }
        float acc[8], cur[8];
        { const f32x4 b0 = *(const f32x4*)(cb + ch), b1 = *(const f32x4*)(cb + ch + 4);
#pragma unroll
          for (int i = 0; i < 4; ++i) { acc[i] = b0[i]; acc[4 + i] = b1[i]; } }
#pragma unroll
        for (int j = 0; j < 4; ++j) {
            const int tau = t - 3 + j; float uu[8];
            if (tau >= 0) { const u32x4 w = *(const u32x4*)(P + (size_t)(m - 3 + j) * NP + PXBC + ch); unpack8(w, uu); }
            else if (samp) { const float* s = sconv + ((size_t)b * 3 + (3 + tau)) * XCW + ch; const f32x4 s0 = *(const f32x4*)s, s1 = *(const f32x4*)(s + 4);
#pragma unroll
                for (int i = 0; i < 4; ++i) { uu[i] = s0[i]; uu[4 + i] = s1[i]; } }
            else {
#pragma unroll
                for (int i = 0; i < 8; ++i) uu[i] = 0.f; }
            const f32x4 w0 = *(const f32x4*)(cw + (size_t)j * XCW + ch), w1 = *(const f32x4*)(cw + (size_t)j * XCW + ch + 4);
#pragma unroll
            for (int i = 0; i < 4; ++i) { acc[i] += w0[i] * uu[i]; acc[4 + i] += w1[i] * uu[4 + i]; }
            if (j == 3) {
#pragma unroll
                for (int i = 0; i < 8; ++i) cur[i] = uu[i]; }
        }
        float o[8];
#pragma unroll
        for (int i = 0; i < 8; ++i) o[i] = siluf_(acc[i]);
        *(u32x4*)(XC + (size_t)m * XCW + ch) = pack8(o);
        float* cs = nullptr;
        if (!samp) { if (t >= 2045) cs = A.out + O_CVP + ((size_t)b * 3 + (t - 2045)) * XCW + ch; }
        else { if (t >= 1) cs = A.out + O_CVS + ((size_t)b * 3 + (t - 1)) * XCW + ch; }
        if (cs) { f32x4 c0, c1;
#pragma unroll
            for (int i = 0; i < 4; ++i) { c0[i] = cur[i]; c1[i] = cur[4 + i]; }
            *(f32x4*)cs = c0; *(f32x4*)(cs + 4) = c1; }
    }
}

constexpr float IDX_SCALE = 0.125f * 0.35355339059327373f;
__device__ __forceinline__ void scores_prompt_unit(const Args& A, int b, int qt, int wave, int lane) {
    const bf16_t* P = (const bf16_t*)(A.ws + WS_P); const float* SMF = (const float*)(A.ws + WS_SMF); float* SC = (float*)(A.ws + WS_SC);
    const int fr = lane & 15, fq = lane >> 4;
    const size_t rowq = (size_t)(b * 2048 + qt * 16 + fr);
    bf16x8 Af[8][2];
#pragma unroll
    for (int h = 0; h < 8; ++h)
#pragma unroll
        for (int ks = 0; ks < 2; ++ks) Af[h][ks] = *(const bf16x8*)(P + rowq * NP + PQI + h * 64 + ks * 32 + 8 * fq);
    float wq[4][8];
#pragma unroll
    for (int j = 0; j < 4; ++j) { const float* wp = SMF + (size_t)(b * 2048 + qt * 16 + 4 * fq + j) * 128 + 32; const f32x4 w0 = *(const f32x4*)wp, w1 = *(const f32x4*)(wp + 4);
#pragma unroll
        for (int h = 0; h < 4; ++h) { wq[j][h] = w0[h] * IDX_SCALE; wq[j][4 + h] = w1[h] * IDX_SCALE; } }
    for (int kt = wave; kt <= qt; kt += NWAVES) {
        const size_t rowk = (size_t)(b * 2048 + kt * 16 + fr);
        const bf16x8 B0 = *(const bf16x8*)(P + rowk * NP + PSM + 64 + 8 * fq), B1 = *(const bf16x8*)(P + rowk * NP + PSM + 96 + 8 * fq);
        f32x4 sc = {0.f, 0.f, 0.f, 0.f};
#pragma unroll
        for (int h = 0; h < 8; ++h) { f32x4 d = {0.f, 0.f, 0.f, 0.f}; d = mfma16(Af[h][0], B0, d); d = mfma16(Af[h][1], B1, d);
#pragma unroll
            for (int j = 0; j < 4; ++j) sc[j] += wq[j][h] * fmaxf(d[j], 0.f); }
#pragma unroll
        for (int j = 0; j < 4; ++j) SC[(size_t)(b * 2048 + qt * 16 + 4 * fq + j) * SCW + kt * 16 + fr] = sc[j];
    }
}
__device__ __forceinline__ void scores_sample_unit(const Args& A, int b, int half, int wave, int lane) {
    const bf16_t* P = (const bf16_t*)(A.ws + WS_P); const float* SMF = (const float*)(A.ws + WS_SMF); float* SCS = (float*)(A.ws + WS_SCS);
    const int* pt = (const int*)A.in[I_PT]; const float* cki = A.in[I_CKI];
    const int fr = lane & 15, fq = lane >> 4;
    bf16x8 Af[2][2]; float wq[2][4];
#pragma unroll
    for (int mt = 0; mt < 2; ++mt) {
#pragma unroll
        for (int ks = 0; ks < 2; ++ks) Af[mt][ks] = *(const bf16x8*)(P + (size_t)(MP + b * 4 + 2 * mt + (fr >> 3)) * NP + PQI + (fr & 7) * 64 + ks * 32 + 8 * fq);
        const f32x4 w = *(const f32x4*)(SMF + (size_t)(MP + b * 4 + 2 * mt + (fq >> 1)) * 128 + 32 + 4 * (fq & 1));
#pragma unroll
        for (int j = 0; j < 4; ++j) wq[mt][j] = w[j] * IDX_SCALE;
    }
    const int kt_end = (half == 0) ? 65 : 129;
    for (int kt = half * 65 + wave; kt < kt_end; kt += NWAVES) {
        const int key = kt * 16 + fr;
        bf16x8 B0, B1;
        if (key < 2048) {
            const int page = pt[b * 16 + (key >> 7)];
            const float* src = cki + ((size_t)page * 128 + (key & 127)) * 64 + 8 * fq;
            const f32x4 a0 = *(const f32x4*)src, a1 = *(const f32x4*)(src + 4), c0 = *(const f32x4*)(src + 32), c1 = *(const f32x4*)(src + 36);
            u32x4 w0, w1; w0.x = pk2(a0[0], a0[1]); w0.y = pk2(a0[2], a0[3]); w0.z = pk2(a1[0], a1[1]); w0.w = pk2(a1[2], a1[3]);
            w1.x = pk2(c0[0], c0[1]); w1.y = pk2(c0[2], c0[3]); w1.z = pk2(c1[0], c1[1]); w1.w = pk2(c1[2], c1[3]);
            B0 = __builtin_bit_cast(bf16x8, w0); B1 = __builtin_bit_cast(bf16x8, w1);
        } else if (key < 2052) {
            const bf16_t* src = P + (size_t)(MP + b * 4 + (key - 2048)) * NP + PSM + 64 + 8 * fq;
            B0 = *(const bf16x8*)src; B1 = *(const bf16x8*)(src + 32);
        } else { B0 = (bf16x8){0, 0, 0, 0, 0, 0, 0, 0}; B1 = B0; }
#pragma unroll
        for (int mt = 0; mt < 2; ++mt) {
            f32x4 d = {0.f, 0.f, 0.f, 0.f}; d = mfma16(Af[mt][0], B0, d); d = mfma16(Af[mt][1], B1, d);
            float s = 0.f;
#pragma unroll
            for (int j = 0; j < 4; ++j) s += wq[mt][j] * fmaxf(d[j], 0.f);
            s += __shfl_xor(s, 16);
            if ((fq & 1) == 0 && key < 2052) SCS[(size_t)(b * 4 + 2 * mt + (fq >> 1)) * SCSW + key] = s;
        }
    }
}

__device__ __forceinline__ float softplusf_(float x) { return fmaxf(x, 0.f) + log1pf(expf(-fabsf(x))); }
__device__ __forceinline__ void ssd_prompt_item(const Args& A, LAS unsigned char* lds, int b, int h) {
    const int tid = threadIdx.x, lane = tid & 63, wave = __builtin_amdgcn_readfirstlane(tid >> 6), fr = lane & 15, fq = lane >> 4;
    const int g = h >> 3;
    const bf16_t* XC = (const bf16_t*)(A.ws + WS_XC); const float* SMF = (const float*)(A.ws + WS_SMF); bf16_t* Y = (bf16_t*)(A.ws + WS_Y);
    LAS bf16_t* Cm = (LAS bf16_t*)lds;
    LAS bf16_t* Bm = Cm + 64 * 136;
    LAS bf16_t* Btw = Bm + 64 * 136;
    LAS bf16_t* Xt = Btw + 128 * 72;
    LAS bf16_t* Mt = Xt + 64 * 72;
    LAS bf16_t* Hp = Mt + 64 * 72;
    LAS float* cum = (LAS float*)(Hp + 64 * 136);
    LAS float* dtv = cum + 64; LAS float* wv = dtv + 64; LAS float* ecum = wv + 64;
    const float Ah = -expf(A.in[I_ALOG][h]), dtb = A.in[I_DTB][h], dsk = A.in[I_DSKIP][h];
    f32x4 hst[4];
#pragma unroll
    for (int i = 0; i < 4; ++i) hst[i] = (f32x4){0.f, 0.f, 0.f, 0.f};
    for (int i = tid; i < 64 * 136 / 8; i += NTHR) *(LAS u32x4*)(Hp + i * 8) = (u32x4){0u, 0u, 0u, 0u};
    const int s0 = tid >> 4, part0 = tid & 15;
    const int xs = tid >> 3, xpart = tid & 7;
    for (int c = 0; c < 32; ++c) {
        const int row0 = b * 2048 + c * 64;
        u32x4 cr[2], br[2];
#pragma unroll
        for (int i = 0; i < 2; ++i) { const bf16_t* rp = XC + (size_t)(row0 + s0 + 32 * i) * XCW + g * 128 + part0 * 8; cr[i] = *(const u32x4*)(rp + 2560); br[i] = *(const u32x4*)(rp + 2048); }
        const u32x4 xr = *(const u32x4*)(XC + (size_t)(row0 + xs) * XCW + h * 64 + xpart * 8);
        if (wave == 0) {
            const float dt = softplusf_(SMF[(size_t)(row0 + lane) * 128 + h] + dtb);
            float v = dt * Ah;
#pragma unroll
            for (int o = 1; o < 64; o <<= 1) { const float n = __shfl_up(v, o); if (lane >= o) v += n; }
            const float ce = __shfl(v, 63);
            cum[lane] = v; dtv[lane] = dt; wv[lane] = dt * expf(ce - v); ecum[lane] = expf(v);
        }
        __syncthreads();
#pragma unroll
        for (int i = 0; i < 2; ++i) {
            const int s = s0 + 32 * i;
            *(LAS u32x4*)(Cm + s * 136 + part0 * 8) = cr[i];
            *(LAS u32x4*)(Bm + s * 136 + part0 * 8) = br[i];
            float bf[8]; unpack8(br[i], bf); const float w = wv[s];
#pragma unroll
            for (int e = 0; e < 8; ++e) Btw[(part0 * 8 + e) * 72 + s] = (bf16_t)f2bf(bf[e] * w);
        }
        {
#pragma unroll
            for (int e = 0; e < 4; ++e) { Xt[(xpart * 8 + 2 * e) * 72 + xs] = (bf16_t)(xr[e] & 0xffffu); Xt[(xpart * 8 + 2 * e + 1) * 72 + xs] = (bf16_t)(xr[e] >> 16); }
        }
        __syncthreads();
        {
            const int st = wave >> 1, tt0 = 2 * (wave & 1);
            bf16x8 a[4];
#pragma unroll
            for (int ks = 0; ks < 4; ++ks) a[ks] = *(const LAS bf16x8*)(Bm + (16 * st + fr) * 136 + ks * 32 + 8 * fq);
#pragma unroll
            for (int u = 0; u < 2; ++u) {
                const int tt = tt0 + u; f32x4 d = {0.f, 0.f, 0.f, 0.f};
#pragma unroll
                for (int ks = 0; ks < 4; ++ks) { const bf16x8 bb = *(const LAS bf16x8*)(Cm + (16 * tt + fr) * 136 + ks * 32 + 8 * fq); d = mfma16(a[ks], bb, d); }
                const int t = 16 * tt + fr; const float ct = cum[t]; float mv[4];
#pragma unroll
                for (int j = 0; j < 4; ++j) { const int s = 16 * st + 4 * fq + j; mv[j] = (s <= t) ? d[j] * expf(ct - cum[s]) * dtv[s] : 0.f; }
                u32x2 w; w.x = pk2(mv[0], mv[1]); w.y = pk2(mv[2], mv[3]);
                *(LAS u32x2*)(Mt + t * 72 + 16 * st + 4 * fq) = w;
            }
        }
        __syncthreads();
        {
            const int pt = wave >> 1, tt0 = 2 * (wave & 1);
            bf16x8 a1[2], a2[4];
#pragma unroll
            for (int ks = 0; ks < 2; ++ks) a1[ks] = *(const LAS bf16x8*)(Xt + (16 * pt + fr) * 72 + ks * 32 + 8 * fq);
#pragma unroll
            for (int ks = 0; ks < 4; ++ks) a2[ks] = *(const LAS bf16x8*)(Hp + (16 * pt + fr) * 136 + ks * 32 + 8 * fq);
#pragma unroll
            for (int u = 0; u < 2; ++u) {
                const int tt = tt0 + u; f32x4 d1 = {0.f, 0.f, 0.f, 0.f}, d2 = {0.f, 0.f, 0.f, 0.f};
#pragma unroll
                for (int ks = 0; ks < 2; ++ks) { const bf16x8 bb = *(const LAS bf16x8*)(Mt + (16 * tt + fr) * 72 + ks * 32 + 8 * fq); d1 = mfma16(a1[ks], bb, d1); }
#pragma unroll
                for (int ks = 0; ks < 4; ++ks) { const bf16x8 bb = *(const LAS bf16x8*)(Cm + (16 * tt + fr) * 136 + ks * 32 + 8 * fq); d2 = mfma16(a2[ks], bb, d2); }
                const int t = 16 * tt + fr; const float et = ecum[t]; float yv[4];
#pragma unroll
                for (int j = 0; j < 4; ++j) { const int p = 16 * pt + 4 * fq + j; yv[j] = d1[j] + et * d2[j] + dsk * bf2f((unsigned)Xt[p * 72 + t]); }
                u32x2 w; w.x = pk2(yv[0], yv[1]); w.y = pk2(yv[2], yv[3]);
                *(u32x2*)(Y + (size_t)(row0 + t) * DI + h * 64 + 16 * pt + 4 * fq) = w;
            }
            bf16x8 a3[2];
#pragma unroll
            for (int ks = 0; ks < 2; ++ks) a3[ks] = *(const LAS bf16x8*)(Btw + (16 * wave + fr) * 72 + ks * 32 + 8 * fq);
            const float dec = ecum[63];
#pragma unroll
            for (int p4 = 0; p4 < 4; ++p4) { f32x4 d = {0.f, 0.f, 0.f, 0.f};
#pragma unroll
                for (int ks = 0; ks < 2; ++ks) { const bf16x8 bb = *(const LAS bf16x8*)(Xt + (16 * p4 + fr) * 72 + ks * 32 + 8 * fq); d = mfma16(a3[ks], bb, d); }
                hst[p4] = hst[p4] * dec + d; }
        }
        __syncthreads();
#pragma unroll
        for (int p4 = 0; p4 < 4; ++p4) { u32x2 w; w.x = pk2(hst[p4][0], hst[p4][1]); w.y = pk2(hst[p4][2], hst[p4][3]);
            *(LAS u32x2*)(Hp + (16 * p4 + fr) * 136 + 16 * wave + 4 * fq) = w; }
    }
    float* so = A.out + O_SSP + ((size_t)b * 32 + h) * 64 * 128;
#pragma unroll
    for (int p4 = 0; p4 < 4; ++p4) *(f32x4*)(so + (size_t)(16 * p4 + fr) * 128 + 16 * wave + 4 * fq) = hst[p4];
    __syncthreads();
}

__device__ __forceinline__ void ssd_sample_item(const Args& A, LAS unsigned char* wl, int b, int h, int lane) {
    const bf16_t* XC = (const bf16_t*)(A.ws + WS_XC); const float* SMF = (const float*)(A.ws + WS_SMF); bf16_t* Y = (bf16_t*)(A.ws + WS_Y);
    LAS float* red = (LAS float*)wl;
    const int g = h >> 3;
    const float Ah = -expf(A.in[I_ALOG][h]), dtb = A.in[I_DTB][h], dsk = A.in[I_DSKIP][h];
#pragma unroll 1
    for (int half = 0; half < 2; ++half) {
        const float* h0 = A.in[I_SSSM] + (((size_t)b * 32 + h) * 64 + 32 * half) * 128 + 2 * lane;
        float st[32][2];
#pragma unroll
        for (int p = 0; p < 32; ++p) { const float2 v = *(const float2*)(h0 + p * 128); st[p][0] = v.x; st[p][1] = v.y; }
#pragma unroll 1
        for (int t = 0; t < 4; ++t) {
            const size_t m = (size_t)(MP + b * 4 + t);
            const float dt = softplusf_(SMF[m * 128 + h] + dtb), dec = expf(dt * Ah);
            const unsigned bw = *(const unsigned*)(XC + m * XCW + 2048 + g * 128 + 2 * lane), cw = *(const unsigned*)(XC + m * XCW + 2560 + g * 128 + 2 * lane);
            const float b0 = bf2f(bw & 0xffffu) * dt, b1 = __uint_as_float(bw & 0xffff0000u) * dt, c0 = bf2f(cw & 0xffffu), c1 = __uint_as_float(cw & 0xffff0000u);
            const float xl = bf2f((unsigned)XC[m * XCW + h * 64 + 32 * half + (lane & 31)]);
#pragma unroll
            for (int p = 0; p < 32; ++p) {
                const float xp = __shfl(xl, p);
                st[p][0] = st[p][0] * dec + xp * b0; st[p][1] = st[p][1] * dec + xp * b1;
                red[p * 65 + lane] = st[p][0] * c0 + st[p][1] * c1;
            }
            asm volatile("s_waitcnt lgkmcnt(0)" ::: "memory");
            float y = 0.f;
#pragma unroll 16
            for (int i = 0; i < 64; ++i) y += red[(lane & 31) * 65 + i];
            y += dsk * xl;
            if (lane < 32) Y[m * DI + h * 64 + 32 * half + lane] = (bf16_t)f2bf(y);
            asm volatile("s_waitcnt lgkmcnt(0)" ::: "memory");
        }
        float* so = A.out + O_SSS + (((size_t)b * 32 + h) * 64 + 32 * half) * 128 + 2 * lane;
#pragma unroll
        for (int p = 0; p < 32; ++p) *(float2*)(so + p * 128) = make_float2(st[p][0], st[p][1]);
    }
}

__device__ __forceinline__ int t5_bucket(int n) {
    if (n < 16) return n;
    const float nf = (float)n;
    int large = 16 + (int)(logf(nf / 16.0f) / 2.0794415416798357f * 16.0f);
    return large < 31 ? large : 31;
}
__device__ __forceinline__ unsigned f2key(float v) { unsigned u = (v == 0.f) ? 0u : __float_as_uint(v); return (u & 0x80000000u) ? ~u : (u | 0x80000000u); }

template <bool SAMPLE> struct KVRow;
template <> struct KVRow<false> {
    typedef const bf16_t* ptr;
    const bf16_t* P;
    __device__ __forceinline__ ptr krow(unsigned rid) const { return P + (size_t)rid * NP + PK; }
    __device__ __forceinline__ ptr vrow(unsigned rid) const { return P + (size_t)rid * NP + PV; }
    static __device__ __forceinline__ void k8(ptr p, float (&f)[8]) { unpack8(*(const u32x4*)p, f); }
    static __device__ __forceinline__ f32x4 v4(ptr p) { const u32x2 w = *(const u32x2*)p;
        return (f32x4){__uint_as_float(w.x << 16), __uint_as_float(w.x & 0xffff0000u), __uint_as_float(w.y << 16), __uint_as_float(w.y & 0xffff0000u)}; }
};
template <> struct KVRow<true> {
    typedef const float* ptr;
    const float* ck; const float* cv; const float* kn; const float* vn;
    __device__ __forceinline__ ptr krow(unsigned rid) const { return (rid & 0x80000000u) ? kn + (size_t)(rid & 0x7fffffffu) * 256 : ck + (size_t)rid * 256; }
    __device__ __forceinline__ ptr vrow(unsigned rid) const { return (rid & 0x80000000u) ? vn + (size_t)(rid & 0x7fffffffu) * 256 : cv + (size_t)rid * 256; }
    static __device__ __forceinline__ void k8(ptr p, float (&f)[8]) { const f32x4 a = *(const f32x4*)p, b = *(const f32x4*)(p + 4);
#pragma unroll
        for (int i = 0; i < 4; ++i) { f[i] = a[i]; f[4 + i] = b[i]; } }
    static __device__ __forceinline__ f32x4 v4(ptr p) { return *(const f32x4*)p; }
};

template <bool SAMPLE>
__device__ __forceinline__ void attend_query(const Args& A, LAS unsigned char* wl, const LAS float* biasrel, int m, int lane_in) {
    constexpr int NJ = SAMPLE ? 33 : 32;
    int lane = lane_in; asm volatile("" : "+v"(lane));
    const bf16_t* P = (const bf16_t*)(A.ws + WS_P);
    int b, nvalid, qpos; const float* srow;
    if (!SAMPLE) { b = m >> 11; const int t = m & 2047; nvalid = t + 1; qpos = t; srow = (const float*)(A.ws + WS_SC) + (size_t)m * SCW; }
    else { const int ms = m - MP; b = ms >> 2; const int t = ms & 3; nvalid = 2049 + t; qpos = 2048 + t; srow = (const float*)(A.ws + WS_SCS) + (size_t)ms * SCSW; }
    LAS float* pq = (LAS float*)wl;
    LAS unsigned* rowid = (LAS unsigned*)(wl + 16384);
    LAS unsigned short* posl = (LAS unsigned short*)(wl + 16384 + 1024);
    unsigned key[NJ];
#pragma unroll
    for (int j = 0; j < NJ; ++j) { key[j] = (lane < nvalid - 64 * j) ? f2key(srow[lane + 64 * j]) : 0u; }
    unsigned T = 0u; int need_eq = 0;
    if (nvalid > 256) {
        for (int bit = 31; bit >= 0; --bit) {
            const unsigned cand = T | (1u << bit); int cnt = 0;
#pragma unroll
            for (int j = 0; j < NJ; ++j) cnt += __popcll(__ballot(key[j] >= cand));
            if (cnt >= 256) T = cand;
        }
        int cgt = 0;
#pragma unroll
        for (int j = 0; j < NJ; ++j) cgt += __popcll(__ballot(key[j] > T));
        need_eq = 256 - cgt;
    }
    int base = 0, eqused = 0;
    const int* pt = (const int*)A.in[I_PT];
#pragma unroll
    for (int j = 0; j < NJ; ++j) {
        const bool gt = key[j] > T, eq = (need_eq > 0) && (key[j] == T);
        const unsigned long long meq = __ballot(eq);
        const bool sel = gt || (eq && (eqused + mbcnt64(meq) < need_eq));
        eqused += __popcll(meq);
        const unsigned long long ms = __ballot(sel);
        if (sel) { const int pos = lane + 64 * j, k = base + mbcnt64(ms);
            posl[k] = (unsigned short)pos;
            unsigned rid;
            if (!SAMPLE) rid = (unsigned)(b * 2048 + pos);
            else rid = (pos < 2048) ? (unsigned)(pt[b * 16 + (pos >> 7)] * 128 + (pos & 127)) : (0x80000000u | (unsigned)(b * 4 + pos - 2048));
            rowid[k] = rid; }
        base += __popcll(ms);
    }
    const int nsel = base;
    asm volatile("s_waitcnt lgkmcnt(0)" ::: "memory");
    { const unsigned r0 = rowid[0]; const unsigned short p0 = posl[0];
#pragma unroll
      for (int i = 0; i < 4; ++i) { const int k = lane + 64 * i; if (k >= nsel) { rowid[k] = r0; posl[k] = p0; } } }
    { const u32x4 w0 = *(const u32x4*)(P + (size_t)m * NP + PQ + lane * 16), w1 = *(const u32x4*)(P + (size_t)m * NP + PQ + lane * 16 + 8);
      float f0[8], f1[8]; unpack8(w0, f0); unpack8(w1, f1);
#pragma unroll
      for (int e = 0; e < 8; ++e) { pq[lane * 16 + e] = f0[e]; pq[lane * 16 + 8 + e] = f1[e]; } }
    asm volatile("s_waitcnt lgkmcnt(0)" ::: "memory");
    KVRow<SAMPLE> R;
    if constexpr (!SAMPLE) { R.P = P; } else { R.ck = A.in[I_CK]; R.cv = A.in[I_CV]; R.kn = A.out + O_KS; R.vn = A.out + O_VS; }
    typename KVRow<SAMPLE>::ptr kp[4]; int rel[4];
#pragma unroll
    for (int i = 0; i < 4; ++i) { kp[i] = R.krow(rowid[lane + 64 * i]); rel[i] = qpos - (int)posl[lane + 64 * i]; }
    float acc[4][16];
#pragma unroll
    for (int i = 0; i < 4; ++i)
#pragma unroll
        for (int hh = 0; hh < 16; ++hh) acc[i][hh] = 0.f;
#pragma unroll
    for (int g = 0; g < 4; ++g) {
#pragma unroll 1
        for (int dc = 0; dc < 8; ++dc) {
            float kv[4][8];
#pragma unroll
            for (int i = 0; i < 4; ++i) KVRow<SAMPLE>::k8(kp[i] + g * 64 + dc * 8, kv[i]);
#pragma unroll
            for (int hh = 0; hh < 4; ++hh) {
                const f32x4 q0 = *(const LAS f32x4*)(pq + (4 * g + hh) * 64 + dc * 8), q1 = *(const LAS f32x4*)(pq + (4 * g + hh) * 64 + dc * 8 + 4);
#pragma unroll
                for (int i = 0; i < 4; ++i) {
                    float a = acc[i][4 * g + hh];
#pragma unroll
                    for (int e = 0; e < 4; ++e) { a += kv[i][e] * q0[e]; a += kv[i][4 + e] * q1[e]; }
                    acc[i][4 * g + hh] = a; }
            }
        }
    }
    asm volatile("s_waitcnt lgkmcnt(0)" ::: "memory");
#pragma unroll
    for (int i = 0; i < 4; ++i) {
        const bool valid = (lane + 64 * i) < nsel; const int rc = rel[i] < 128 ? (rel[i] < 0 ? 0 : rel[i]) : 128;
#pragma unroll
        for (int h4 = 0; h4 < 4; ++h4) { const f32x4 bv = *(const LAS f32x4*)(biasrel + rc * 16 + 4 * h4);
#pragma unroll
            for (int e = 0; e < 4; ++e) acc[i][4 * h4 + e] = valid ? acc[i][4 * h4 + e] * 0.125f + bv[e] : -INFINITY; }
    }
#pragma unroll
    for (int hh = 0; hh < 16; ++hh) {
        const float mx = wave_max(fmaxf(fmaxf(acc[0][hh], acc[1][hh]), fmaxf(acc[2][hh], acc[3][hh])));
        float s = 0.f;
#pragma unroll
        for (int i = 0; i < 4; ++i) { acc[i][hh] = __expf(acc[i][hh] - mx); s += acc[i][hh]; }
        const float inv = 1.0f / wave_sum(s);
#pragma unroll
        for (int i = 0; i < 4; ++i) acc[i][hh] *= inv;
    }
#pragma unroll
    for (int i = 0; i < 4; ++i)
#pragma unroll
        for (int h4 = 0; h4 < 4; ++h4) *(LAS f32x4*)(pq + (lane + 64 * i) * 16 + 4 * h4) = (f32x4){acc[i][4 * h4], acc[i][4 * h4 + 1], acc[i][4 * h4 + 2], acc[i][4 * h4 + 3]};
    asm volatile("s_waitcnt lgkmcnt(0)" ::: "memory");
    const int g = lane >> 4;
    f32x4 o[4];
#pragma unroll
    for (int hh = 0; hh < 4; ++hh) o[hh] = (f32x4){0.f, 0.f, 0.f, 0.f};
    const int nloop = (nsel + 3) & ~3;
    for (int k0 = 0; k0 < nloop; k0 += 4) {
        f32x4 vv[4], pp[4];
#pragma unroll
        for (int u = 0; u < 4; ++u) { const unsigned r = rowid[k0 + u]; vv[u] = KVRow<SAMPLE>::v4(R.vrow(r) + lane * 4); pp[u] = *(const LAS f32x4*)(pq + (k0 + u) * 16 + 4 * g); }
#pragma unroll
        for (int u = 0; u < 4; ++u)
#pragma unroll
            for (int hh = 0; hh < 4; ++hh) o[hh] += vv[u] * pp[u][hh];
    }
    bf16_t* YA = (bf16_t*)(A.ws + WS_YA);
#pragma unroll
    for (int hh = 0; hh < 4; ++hh) { u32x2 w; w.x = pk2(o[hh][0], o[hh][1]); w.y = pk2(o[hh][2], o[hh][3]);
        *(u32x2*)(YA + (size_t)m * D + (4 * g + hh) * 64 + (lane & 15) * 4) = w; }
    asm volatile("s_waitcnt lgkmcnt(0)" ::: "memory");
}

__device__ __forceinline__ void gate_norm_phase(const Args& A, int gw, int NGW, int lane) {
    const bf16_t* P = (const bf16_t*)(A.ws + WS_P); bf16_t* Y = (bf16_t*)(A.ws + WS_Y); const float* ng = A.in[I_NORMG];
    for (int it = gw; it < M * 4; it += NGW) {
        const int m = it >> 2, ch = (it & 3) * 512 + lane * 8;
        float y[8], z[8]; unpack8(*(const u32x4*)(Y + (size_t)m * DI + ch), y); unpack8(*(const u32x4*)(P + (size_t)m * NP + PZ + ch), z);
        float ss = 0.f;
#pragma unroll
        for (int i = 0; i < 8; ++i) { y[i] *= siluf_(z[i]); ss += y[i] * y[i]; }
        const float r = 1.0f / sqrtf(wave_sum(ss) * (1.f / 512.f) + LN_EPS);
        const f32x4 g0 = *(const f32x4*)(ng + ch), g1 = *(const f32x4*)(ng + ch + 4);
#pragma unroll
        for (int i = 0; i < 4; ++i) { y[i] = y[i] * r * g0[i]; y[4 + i] = y[4 + i] * r * g1[i]; }
        *(u32x4*)(Y + (size_t)m * DI + ch) = pack8(y);
    }
}

constexpr int NPHASE = 14;
__global__ void __launch_bounds__(NTHR, 2) fwd(Args args) {
    extern __shared__ __attribute__((aligned(16))) unsigned char lds_raw[];
    LAS unsigned char* lds = (LAS unsigned char*)lds_raw;
    const int tid = threadIdx.x, lane = tid & 63, wave = __builtin_amdgcn_readfirstlane(tid >> 6);
    const int G = gridDim.x, bx = blockIdx.x;
    const int vcu = (G % 8 == 0) ? (bx % 8) * (G / 8) + bx / 8 : bx;
    const int gw = vcu * NWAVES + wave, NGW = G * NWAVES;
    unsigned char* ws = args.ws;
    volatile LAS unsigned* MISC = (volatile LAS unsigned*)(lds + MISC_OFF);
    for (int u = tid; u < 64; u += NTHR) MISC[u] = 0u;
    __syncthreads();
    const int lo = args.ph_lo, hi = args.ph_hi;
    XcdBarrier bar; bar.bar = (unsigned*)(ws + WS_CTL) + CW_BAR; bar.x = 0; bar.st = nullptr;
    if (hi - lo > 1) bar = xcd_barrier_post((unsigned*)(ws + WS_CTL) + CW_BAR, MISC + 8);
#define IN(k) (lo <= (k) && (k) < hi)
#define SEAM(k) do { if (IN(k) && IN((k) + 1)) xcd_barrier(bar); } while (0)

    bf16_t* const XB = (bf16_t*)(ws + WS_XB); bf16_t* const ACT = (bf16_t*)(ws + WS_ACT); float* const T = (float*)(ws + WS_T);
    float* const HF = (float*)(ws + WS_HF); bf16_t* const HB = (bf16_t*)(ws + WS_HB); bf16_t* const P = (bf16_t*)(ws + WS_P);
    float* const SMF = (float*)(ws + WS_SMF); bf16_t* const Y = (bf16_t*)(ws + WS_Y); bf16_t* const YA = (bf16_t*)(ws + WS_YA); bf16_t* const MG = (bf16_t*)(ws + WS_MG);

    if (IN(0)) { p0_prologue(args, lds, gw, NGW, wave, lane); }
    SEAM(0);
    if (IN(1)) { pg8::Gemm g{XB, (const bf16_t*)(ws + WS_W1A), M, 2 * DFF, D}; pg8::StaticOrder S; S.init(M, 2 * DFF, G, bx);
        EpiSwiglu E{ACT}; pg8::gemm_phase<EpiSwiglu, pg8::StaticOrder, true, true>(lds, g, S, E); }
    SEAM(1);
    if (IN(2)) { pg8::Gemm g{ACT, (const bf16_t*)(ws + WS_W1B), M, D, DFF}; pg8::StaticOrder S; S.init(M, D, G, bx);
        EpiResid E{args.in[I_XP], args.in[I_XS], T, ALPHA, 0.5f}; pg8::gemm_phase<EpiResid, pg8::StaticOrder, true, true>(lds, g, S, E); }
    SEAM(2);
    if (IN(3)) { ln_phase(T, args.in[I_LN1G], args.in[I_LN1B], HF, HB, gw, NGW, lane); }
    SEAM(3);
    if (IN(4)) { pg8::Gemm g{HB, (const bf16_t*)(ws + WS_WIN), M, NP, D}; pg8::StaticOrder S; S.init(M, NP, G, bx);
        EpiWin E{P, SMF, args.out}; pg8::gemm_phase<EpiWin, pg8::StaticOrder, true, true>(lds, g, S, E); }
    SEAM(4);
    if (IN(5)) {
        conv_phase(args);
        for (int u = bx; u < 1024; u += G) { const int i = u >> 8, c = u & 255, b = c >> 5, s = c & 31; const int qt = (i == 0) ? s : (i == 1) ? 63 - s : (i == 2) ? 64 + s : 127 - s;
            scores_prompt_unit(args, b, qt, wave, lane); }
        for (int u = bx; u < 256; u += G) scores_sample_unit(args, u >> 1, u & 1, wave, lane);
    }
    SEAM(5);
    if (IN(6)) {
        for (int it = bx; it < 256; it += G) ssd_prompt_item(args, lds, it >> 5, it & 31);
        __syncthreads();
        LAS float* biasrel = (LAS float*)(lds + BIASREL_OFF);
        for (int i = tid; i < 129 * 16; i += NTHR) { const int rel = i >> 4, h = i & 15; biasrel[i] = args.in[I_BIAS][t5_bucket(rel) * 16 + h]; }
        __syncthreads();
        LAS unsigned char* wl = lds + wave * WAREA;
        for (int it = gw; it < 4096; it += NGW) ssd_sample_item(args, wl, it >> 5, it & 31, lane);
        for (int q = gw; q < MS; q += NGW) attend_query<true>(args, wl, biasrel, MP + q, lane);
        for (int q = gw; q < MP; q += NGW) attend_query<false>(args, wl, biasrel, q, lane);
        __syncthreads();
    }
    SEAM(6);
    if (IN(7)) {
        gate_norm_phase(args, gw, NGW, lane);
        pg8::Gemm g{YA, (const bf16_t*)(ws + WS_WBA), M, D, D}; pg8::StaticOrder S; S.init(M, D, G, bx);
        EpiGateA E{P, PG + D, T}; pg8::gemm_phase<EpiGateA, pg8::StaticOrder, true, true>(lds, g, S, E);
    }
    SEAM(7);
    if (IN(8)) { pg8::Gemm g{Y, (const bf16_t*)(ws + WS_WBS), M, D, DI}; pg8::StaticOrder S; S.init(M, D, G, bx);
        EpiGateS E{P, PG, T, MG}; pg8::gemm_phase<EpiGateS, pg8::StaticOrder, true, true>(lds, g, S, E); }
    SEAM(8);
    if (IN(9)) { pg8::Gemm g{MG, (const bf16_t*)(ws + WS_WOUT), M, D, D}; pg8::StaticOrder S; S.init(M, D, G, bx);
        EpiResid E{HF, HF + (size_t)MP * D, T, ALPHA, 1.0f}; pg8::gemm_phase<EpiResid, pg8::StaticOrder, true, true>(lds, g, S, E); }
    SEAM(9);
    if (IN(10)) { ln_phase(T, args.in[I_LN2G], args.in[I_LN2B], HF, HB, gw, NGW, lane); }
    SEAM(10);
    if (IN(11)) { pg8::Gemm g{HB, (const bf16_t*)(ws + WS_W2A), M, 2 * DFF, D}; pg8::StaticOrder S; S.init(M, 2 * DFF, G, bx);
        EpiSwiglu E{ACT}; pg8::gemm_phase<EpiSwiglu, pg8::StaticOrder, true, true>(lds, g, S, E); }
    SEAM(11);
    if (IN(12)) { pg8::Gemm g{ACT, (const bf16_t*)(ws + WS_W2B), M, D, DFF}; pg8::StaticOrder S; S.init(M, D, G, bx);
        EpiResid E{HF, HF + (size_t)MP * D, T, ALPHA, 0.5f}; pg8::gemm_phase<EpiResid, pg8::StaticOrder, true, true>(lds, g, S, E); }
    SEAM(12);
    if (IN(13)) { ln_phase(T, args.in[I_LN3G], args.in[I_LN3B], args.out + O_Y, nullptr, gw, NGW, lane); }
#undef IN
#undef SEAM
}
}

extern "C" void kernel_launch(void* const* d_in, const int* in_sizes, int n_in, void* d_out, int out_size, void* d_ws, size_t ws_size, hipStream_t stream) {
    using namespace mk;
    static int grid = 0;
    if (grid == 0) {
        if (n_in != 29 || (size_t)out_size != O_END || ws_size < WS_END) { fprintf(stderr, "kernel_launch: unexpected shapes (n_in %d, out %d, ws %zu)\n", n_in, out_size, ws_size); grid = -1; return; }
        int dev = 0, cus = 0, per_cu = 0;
        if (hipGetDevice(&dev) != hipSuccess || hipDeviceGetAttribute(&cus, hipDeviceAttributeMultiprocessorCount, dev) != hipSuccess) { grid = -1; return; }
        if (hipFuncSetAttribute((const void*)fwd, hipFuncAttributeMaxDynamicSharedMemorySize, LDS_BYTES) != hipSuccess) { fprintf(stderr, "kernel_launch: hipFuncSetAttribute failed\n"); grid = -1; return; }
        if (hipOccupancyMaxActiveBlocksPerMultiprocessor(&per_cu, (const void*)fwd, NTHR, LDS_BYTES) != hipSuccess || per_cu < 1) fprintf(stderr, "kernel_launch: occupancy query says %d\n", per_cu);
        (void)hipGetLastError();
        grid = cus;
    }
    if (grid < 0) return;
    (void)hipMemsetAsync((char*)d_ws + WS_CTL, 0, CTL_ZERO_BYTES, stream);
    Args a{};
    for (int i = 0; i < 29; ++i) a.in[i] = (const float*)d_in[i];
    a.out = (float*)d_out; a.ws = (unsigned char*)d_ws;
#if MK_SPLIT
    for (int p = 0; p < NPHASE; ++p) { a.ph_lo = p; a.ph_hi = p + 1; hipLaunchKernelGGL(fwd, dim3(grid), dim3(NTHR), LDS_BYTES, stream, a); }
#else
    a.ph_lo = 0; a.ph_hi = NPHASE; hipLaunchKernelGGL(fwd, dim3(grid), dim3(NTHR), LDS_BYTES, stream, a);
#endif
}
```

```cpp
#include <hip/hip_runtime.h>
#include <cstdio>
#include <cstdint>
#define GAS __attribute__((address_space(1)))
#define LAS __attribute__((address_space(3)))
namespace pg8 {
#define PG8_LAS __attribute__((address_space(3)))
typedef unsigned short bf16_t;
typedef short bf16x8 __attribute__((ext_vector_type(8)));
typedef float f32x4 __attribute__((ext_vector_type(4)));
typedef unsigned u32x4 __attribute__((ext_vector_type(4)));
constexpr int BM = 256, BK = 64, HALF = 128, HTB = HALF * BK * 2  , STAGE_BYTES = 8 * HTB, NXCD = 8, WGM = 8;

__host__ __device__ __forceinline__ int lds_byte(int r, int c) { const int st = (r >> 4) * 2 + (c >> 5), rr = r & 15, cc = c & 31, ob = rr * 64 + cc * 2; return st * 1024 + (ob ^ (((ob >> 9) & 1) << 5)); }
__host__ __device__ __forceinline__ void stage_rc(int b, int& R, int& C) { const int st = b / 1024, sb = b % 1024, swz = sb ^ (((sb >> 9) & 1) << 5); R = (st >> 1) * 16 + swz / 64; C = (st & 1) * 32 + (swz % 64) / 2; }
__host__ __device__ __forceinline__ int perm32(int rho) { const int n = rho >> 4, i = rho & 15; return 8 * (i >> 2) + 4 * n + (i & 3); }

struct Unit { int pm, pn; };
struct Gemm { const bf16_t* A; const bf16_t* Bt; int M, N, K; };

struct StaticOrder {
    int nM, nN, nwg, G, c;
    __host__ __device__ void init(int M, int N, int G_, int c_) { nM = M / BM; nN = N / BM; nwg = nM * nN; G = G_; c = c_; }
    __host__ __device__ bool next(int i, Unit& u) const {
        const long L = (long)i * G + c; if (L >= nwg) return false;
        int wgid = (int)L; { const int q = nwg / NXCD, r = nwg % NXCD, xcd = wgid % NXCD, off = wgid / NXCD; wgid = (xcd < r ? xcd * (q + 1) : r * (q + 1) + (xcd - r) * q) + off; }
        const int nig = WGM * nN, gid = wgid / nig, fm = gid * WGM, gsz = (nM - fm) < WGM ? (nM - fm) : WGM;
        u.pm = fm + ((wgid % nig) % gsz); u.pn = (wgid % nig) / gsz; return true;
    }
    __device__ __forceinline__ void a_ready(const Unit&) const {}
    __device__ __forceinline__ void done(const Unit&) const {}
};

__device__ __forceinline__ unsigned cvt_pk_bf16(float lo, float hi) { unsigned r; asm volatile("v_cvt_pk_bf16_f32 %0, %1, %2" : "=v"(r) : "v"(lo), "v"(hi)); return r; }

template <class Epi, class Sched, bool ALIGN_EPI = false, bool SP2 = false>
__device__ __forceinline__ void gemm_phase(PG8_LAS unsigned char* lds, const Gemm g, const Sched& S, const Epi& E) {
    const int tid = threadIdx.x, wid = __builtin_amdgcn_readfirstlane(tid >> 6), lane = tid & 63, wr = wid >> 2, wc = wid & 3, fr = lane & 15, fq = lane >> 4;
    const int K = g.K, nt = K / BK;
    unsigned voffA[2], voffB[2];
#pragma unroll
    for (int i = 0; i < 2; ++i) { int R, C; stage_rc(tid * 16 + i * 8192, R, C); const int Rb = Epi::PERM ? ((R & ~31) + perm32(R & 31)) : R;
        voffA[i] = (unsigned)(R * K + C) * 2u; voffB[i] = (unsigned)(Rb * K + C) * 2u; }
    const size_t kstep = (size_t)(BK * 2);
    const size_t hstep = (size_t)HALF * K * 2;
    const size_t tstep = 2 * hstep;
    const unsigned ldsw = (unsigned)wid * 1024u;
    const int aoff = lds_byte(wr * 64 + fr, fq * 8), boff = lds_byte(wc * 32 + fr, fq * 8);
#define PG8_SA(b, h) (((b) * 2 + (h)) * HTB)
#define PG8_SB(b, h) ((4 + (b) * 2 + (h)) * HTB)
#define PG8_STAGE(bufoff, gbase, voff) do { _Pragma("unroll") for (int _i = 0; _i < 2; ++_i) \
        __builtin_amdgcn_global_load_lds((const unsigned*)((const char*)(gbase) + (voff)[_i]), (PG8_LAS unsigned*)(lds + (bufoff) + ldsw + _i * 8192), 16, 0, 0); } while (0)
#define PG8_LDA(dst, b, h) do { _Pragma("unroll") for (int m = 0; m < 4; ++m) _Pragma("unroll") for (int k = 0; k < 2; ++k) dst[m][k] = *(const PG8_LAS bf16x8*)(lds + PG8_SA(b, h) + aoff + m * 2048 + k * 1024); } while (0)
#define PG8_LDB(dst, b, h) do { _Pragma("unroll") for (int n = 0; n < 2; ++n) _Pragma("unroll") for (int k = 0; k < 2; ++k) dst[n][k] = *(const PG8_LAS bf16x8*)(lds + PG8_SB(b, h) + boff + n * 2048 + k * 1024); } while (0)
#define PG8_MMA(ai, bj, At, Bt) do { __builtin_amdgcn_s_setprio(1); _Pragma("unroll") for (int m = 0; m < 4; ++m) _Pragma("unroll") for (int n = 0; n < 2; ++n) _Pragma("unroll") for (int k = 0; k < 2; ++k) \
        acc[ai][bj][m][n] = __builtin_amdgcn_mfma_f32_16x16x32_bf16(Bt[n][k], At[m][k], acc[ai][bj][m][n], 0, 0, 0); __builtin_amdgcn_s_setprio(0); } while (0)
#define PG8_WAIT_V(n) asm volatile("s_waitcnt vmcnt(" #n ")" ::: "memory")
#define PG8_WAIT_L(n) asm volatile("s_waitcnt lgkmcnt(" #n ")" ::: "memory")
#define PG8_BAR __builtin_amdgcn_s_barrier()
#define PG8_SCHED __builtin_amdgcn_sched_barrier(0)
    Unit cur, nxt; int ui = 0;
    if (!S.next(0, cur)) return;
    f32x4 acc[2][2][4][2];
#pragma unroll
    for (int a = 0; a < 2; ++a)
#pragma unroll
        for (int b = 0; b < 2; ++b)
#pragma unroll
            for (int m = 0; m < 4; ++m)
#pragma unroll
                for (int n = 0; n < 2; ++n) acc[a][b][m][n] = (f32x4){0.f, 0.f, 0.f, 0.f};
    bf16x8 At[4][2], B0[2][2], B1[2][2];
    const char* cA = (const char*)g.A + (size_t)cur.pm * tstep; const char* cB = (const char*)g.Bt + (size_t)cur.pn * tstep;
    S.a_ready(cur);
    if constexpr (SP2) {
        PG8_STAGE(PG8_SB(0, 0), cB, voffB); PG8_STAGE(PG8_SB(0, 1), cB + hstep, voffB); PG8_STAGE(PG8_SA(0, 0), cA, voffA); PG8_STAGE(PG8_SA(0, 1), cA + hstep, voffA);
        if (wr == 1) PG8_BAR;
        PG8_WAIT_V(2); PG8_BAR;
        PG8_STAGE(PG8_SB(1, 0), cB + kstep, voffB); PG8_STAGE(PG8_SA(1, 0), cA + kstep, voffA); PG8_STAGE(PG8_SB(1, 1), cB + hstep + kstep, voffB);
        PG8_WAIT_V(6); PG8_BAR;
    } else {
        PG8_STAGE(PG8_SB(0, 0), cB, voffB); PG8_STAGE(PG8_SA(0, 0), cA, voffA); PG8_STAGE(PG8_SB(0, 1), cB + hstep, voffB); PG8_STAGE(PG8_SA(0, 1), cA + hstep, voffA);
        if (wr == 1) PG8_BAR;
        PG8_WAIT_V(4); PG8_BAR;
        PG8_STAGE(PG8_SB(1, 0), cB + kstep, voffB); PG8_STAGE(PG8_SA(1, 0), cA + kstep, voffA); PG8_STAGE(PG8_SB(1, 1), cB + hstep + kstep, voffB);
        PG8_WAIT_V(6); PG8_BAR;
    }
    for (;;) {
        const bool has_next = S.next(ui + 1, nxt);
        const char* nA = has_next ? (const char*)g.A + (size_t)nxt.pm * tstep : cA; const char* nB = has_next ? (const char*)g.Bt + (size_t)nxt.pn * tstep : cB;
        for (int t = 0; t < nt; t += 2) {
            const bool last = (t == nt - 2);
            const char* a1 = cA + (size_t)(t + 1) * kstep;
            const char* a2 = last ? nA : cA + (size_t)(t + 2) * kstep; const char* b2 = last ? nB : cB + (size_t)(t + 2) * kstep;
            const char* a3 = a2 + kstep; const char* b3 = b2 + kstep;
            if (last && has_next) S.a_ready(nxt);
            if constexpr (SP2) {
            PG8_LDB(B0, 0, 0); PG8_LDB(B1, 0, 1); PG8_SCHED; PG8_LDA(At, 0, 0); PG8_STAGE(PG8_SA(1, 1), a1 + hstep, voffA);
            PG8_WAIT_V(8); PG8_WAIT_L(0); PG8_BAR; PG8_MMA(0, 0, At, B0); PG8_MMA(0, 1, At, B1); PG8_BAR; PG8_SCHED;
            PG8_LDA(At, 0, 1); PG8_STAGE(PG8_SB(0, 0), b2, voffB); PG8_STAGE(PG8_SB(0, 1), b2 + hstep, voffB); PG8_STAGE(PG8_SA(0, 0), a2, voffA);
            PG8_WAIT_V(8); PG8_WAIT_L(0); PG8_BAR; PG8_MMA(1, 0, At, B0); PG8_MMA(1, 1, At, B1); PG8_BAR; PG8_SCHED;
            PG8_LDB(B0, 1, 0); PG8_LDB(B1, 1, 1); PG8_SCHED; PG8_LDA(At, 1, 0); PG8_STAGE(PG8_SA(0, 1), a2 + hstep, voffA);
            PG8_WAIT_V(8); PG8_WAIT_L(0); PG8_BAR; PG8_MMA(0, 0, At, B0); PG8_MMA(0, 1, At, B1); PG8_BAR; PG8_SCHED;
            PG8_LDA(At, 1, 1); PG8_STAGE(PG8_SB(1, 0), b3, voffB); PG8_STAGE(PG8_SB(1, 1), b3 + hstep, voffB); PG8_STAGE(PG8_SA(1, 0), a3, voffA);
            PG8_WAIT_V(8); PG8_WAIT_L(0); PG8_BAR; PG8_MMA(1, 0, At, B0); PG8_MMA(1, 1, At, B1); PG8_BAR; PG8_SCHED;
            } else {
            PG8_LDB(B0, 0, 0); PG8_SCHED; PG8_LDA(At, 0, 0); PG8_STAGE(PG8_SA(1, 1), a1 + hstep, voffA);
            PG8_WAIT_L(8); PG8_BAR; PG8_WAIT_L(0); PG8_MMA(0, 0, At, B0); PG8_BAR; PG8_SCHED;
            PG8_LDB(B1, 0, 1); PG8_STAGE(PG8_SB(0, 0), b2, voffB);
            PG8_BAR; PG8_WAIT_L(0); PG8_MMA(0, 1, At, B1); PG8_BAR;
            PG8_LDA(At, 0, 1); PG8_STAGE(PG8_SA(0, 0), a2, voffA);
            PG8_BAR; PG8_WAIT_L(0); PG8_MMA(1, 0, At, B0); PG8_BAR; PG8_SCHED;
            PG8_STAGE(PG8_SB(0, 1), b2 + hstep, voffB);
            PG8_WAIT_V(6); PG8_BAR; PG8_MMA(1, 1, At, B1); PG8_BAR;
            PG8_LDB(B0, 1, 0); PG8_SCHED; PG8_LDA(At, 1, 0); PG8_STAGE(PG8_SA(0, 1), a2 + hstep, voffA);
            PG8_WAIT_L(8); PG8_BAR; PG8_WAIT_L(0); PG8_MMA(0, 0, At, B0); PG8_BAR; PG8_SCHED;
            PG8_LDB(B1, 1, 1); PG8_STAGE(PG8_SB(1, 0), b3, voffB);
            PG8_BAR; PG8_WAIT_L(0); PG8_MMA(0, 1, At, B1); PG8_BAR;
            PG8_LDA(At, 1, 1); PG8_STAGE(PG8_SA(1, 0), a3, voffA);
            PG8_BAR; PG8_WAIT_L(0); PG8_MMA(1, 0, At, B0); PG8_BAR; PG8_SCHED;
            PG8_STAGE(PG8_SB(1, 1), b3 + hstep, voffB);
            PG8_WAIT_V(6); PG8_BAR; PG8_MMA(1, 1, At, B1); PG8_BAR;
            }
        }
        if constexpr (ALIGN_EPI) { if (wr == 0) PG8_BAR; }
        if constexpr (!Epi::AFTER_DRAIN) { E(acc, cur, wr, wc, fr, fq); S.done(cur); }
        if (!has_next) break;
#pragma unroll
        for (int a = 0; a < 2; ++a)
#pragma unroll
            for (int b = 0; b < 2; ++b)
#pragma unroll
                for (int m = 0; m < 4; ++m)
#pragma unroll
                    for (int n = 0; n < 2; ++n) acc[a][b][m][n] = (f32x4){0.f, 0.f, 0.f, 0.f};
        cur = nxt; cA = nA; cB = nB; ++ui;
        if constexpr (ALIGN_EPI) { if (wr == 1) PG8_BAR; }
    }
    PG8_WAIT_V(0);
    if constexpr (!ALIGN_EPI) { if (wr == 0) PG8_BAR; }
    PG8_BAR;
    if constexpr (Epi::AFTER_DRAIN) { E.fused(acc, cur, wr, wc, fr, fq, lds, wid, lane); S.done(cur); }
#undef PG8_SA
#undef PG8_SB
#undef PG8_STAGE
#undef PG8_LDA
#undef PG8_LDB
#undef PG8_MMA
#undef PG8_WAIT_V
#undef PG8_WAIT_L
#undef PG8_BAR
#undef PG8_SCHED
}
}
#define XB_TMO      128
#define XB_XCNT(j)  (256  + 64 * (j))
#define XB_XSUB(j)  (1280 + 64 * (j))
#define XB_XGEN(j)  (2304 + 64 * (j))
#define XB_TOP      3328
#define XB_TOPGEN   3392
#define XCD_BAR_WORDS 3456
#define XB_SPIN_CAP (1u << 18)

__device__ __forceinline__ unsigned xb_ld(unsigned* p)              { return __hip_atomic_load(p, __ATOMIC_RELAXED, __HIP_MEMORY_SCOPE_AGENT); }
__device__ __forceinline__ unsigned xb_add(unsigned* p, unsigned v) { return __hip_atomic_fetch_add(p, v, __ATOMIC_RELAXED, __HIP_MEMORY_SCOPE_AGENT); }
__device__ __forceinline__ unsigned xb_xcc_id() { return (unsigned)__builtin_amdgcn_s_getreg((3 << 11) | 20) & 0xFu; }
#define XB_SPIN(cond, bar) do { unsigned _sp = 0; while (cond) { __builtin_amdgcn_s_sleep(1); \
    if ((++_sp & 255u) == 0u) { if (xb_ld(&(bar)[XB_TMO])) break; if (_sp > XB_SPIN_CAP) { atomicAdd(&(bar)[XB_TMO], 1u); break; } } } } while (0)

struct XcdBarrier {
    unsigned* bar; unsigned x;
    volatile LAS unsigned* st;
};

__device__ __forceinline__ XcdBarrier xcd_barrier_post(unsigned* bar, volatile LAS unsigned* st) {
    XcdBarrier b; b.bar = bar; b.x = xb_xcc_id(); b.st = st;
    if (threadIdx.x == 0) (void)xb_add(&bar[XB_XCNT(b.x)], 1u);
    return b;
}
__device__ __forceinline__ void xcd_barrier_complete(unsigned* bar, unsigned x, unsigned& nloc, unsigned& nx) {
    const unsigned G = gridDim.x * gridDim.y * gridDim.z;
    unsigned sum, cnt, mine, sp = 0u;
    for (;;) {
        sum = 0u; cnt = 0u; mine = 0u;
#pragma unroll
        for (unsigned j = 0; j < 16; ++j) { const unsigned c = xb_ld(&bar[XB_XCNT(j)]); sum += c; cnt += (c > 0u) ? 1u : 0u; mine = (j == x) ? c : mine; }
        if (sum == G) break;
        __builtin_amdgcn_s_sleep(1);
        if ((++sp & 255u) == 0u) { if (xb_ld(&bar[XB_TMO])) break; if (sp > XB_SPIN_CAP) { atomicAdd(&bar[XB_TMO], 1u); break; } }
    }
    nloc = mine > 0u ? mine : 1u; nx = cnt > 0u ? cnt : 1u;
}

__device__ __forceinline__ void xcd_barrier(const XcdBarrier& b) {
    asm volatile("s_waitcnt vmcnt(0)" ::: "memory");
    __syncthreads();
    if (threadIdx.x == 0) {
        unsigned* bar = b.bar;
        __builtin_amdgcn_s_waitcnt(0);
        unsigned nloc = b.st[0], nx = b.st[1];
        if (nloc == 0u) { xcd_barrier_complete(bar, b.x, nloc, nx); b.st[0] = nloc; b.st[1] = nx; }
        const unsigned old = xb_add(&bar[XB_XSUB(b.x)], 1u);
        const unsigned gen = old / nloc;
        if (old + 1u == (gen + 1u) * nloc) {
            __builtin_amdgcn_fence(__ATOMIC_RELEASE, "agent");
            asm volatile("s_waitcnt vmcnt(0)" ::: "memory");
            const unsigned og = xb_add(&bar[XB_TOP], 1u);
            const unsigned tg = og / nx;
            if (og + 1u == (tg + 1u) * nx) xb_add(&bar[XB_TOPGEN], 1u);
            else XB_SPIN(xb_ld(&bar[XB_TOPGEN]) == tg, bar);
            __builtin_amdgcn_fence(__ATOMIC_ACQUIRE, "agent");
            xb_add(&bar[XB_XGEN(b.x)], 1u);
            asm volatile("s_waitcnt vmcnt(0)" ::: "memory");
        } else {
            XB_SPIN(xb_ld(&bar[XB_XGEN(b.x)]) == gen, bar);
            __builtin_amdgcn_fence(__ATOMIC_ACQUIRE, "agent");
            asm volatile("s_waitcnt vmcnt(0)" ::: "memory");
        }
    }
    __syncthreads();
}
namespace mk {
using pg8::bf16_t; using pg8::bf16x8; using pg8::f32x4; using pg8::u32x4;
typedef unsigned u32x2 __attribute__((ext_vector_type(2)));

#ifndef MK_SPLIT
#define MK_SPLIT 0
#endif

constexpr int NWAVES = 8, NTHR = 512;
constexpr int MP = 16384, MS = 512, M = MP + MS, D = 1024, DFF = 2816, DI = 2048, NP = 9472, XCW = 3072;
constexpr int PZ = 0, PXBC = 2048, PSM = 5120, PQ = 5376, PK = 6400, PV = 6656, PQI = 6912, PG = 7424;
constexpr int SCW = 2048, SCSW = 2112;
constexpr size_t O_Y = 0, O_KP = 17301504, O_VP = 21495808, O_KIP = 25690112, O_CVP = 26738688, O_SSP = 26812416,
                 O_KS = 28909568, O_VS = 29040640, O_KIS = 29171712, O_CVS = 29204480, O_SSS = 30384128, O_END = 63938560;
constexpr size_t MiB = 1u << 20;
constexpr size_t WS_CTL = 0, CTL_ZERO_BYTES = 1 * MiB;
constexpr size_t WS_W1A = 1 * MiB, WS_W1B = WS_W1A + 11 * MiB, WS_WIN = WS_W1B + 6 * MiB, WS_WBS = WS_WIN + 19 * MiB, WS_WBA = WS_WBS + 4 * MiB,
                 WS_WOUT = WS_WBA + 2 * MiB, WS_W2A = WS_WOUT + 2 * MiB, WS_W2B = WS_W2A + 11 * MiB;
constexpr size_t WS_XB = WS_W2B + 6 * MiB, WS_ACT = WS_XB + 33 * MiB, WS_T = WS_ACT + 91 * MiB, WS_HF = WS_T + 66 * MiB, WS_HB = WS_HF + 66 * MiB,
                 WS_P = WS_HB + 33 * MiB, WS_SMF = WS_P + 306 * MiB, WS_XC = WS_SMF + 9 * MiB, WS_Y = WS_XC + 99 * MiB, WS_SC = WS_Y + 66 * MiB,
                 WS_SCS = WS_SC + 128 * MiB, WS_YA = WS_SCS + 5 * MiB, WS_MG = WS_YA + 33 * MiB, WS_END = WS_MG + 33 * MiB;
constexpr int CW_BAR = 4096;
constexpr int LDS_BYTES = 163840, MISC_OFF = LDS_BYTES - 256;
constexpr int WAREA = 17920;
constexpr int BIASREL_OFF = NWAVES * WAREA;
static_assert(BIASREL_OFF + 129 * 16 * 4 <= MISC_OFF, "LDS map");

constexpr float ALPHA = 1.18920711500272f;
constexpr float LN_EPS = 1e-5f;

struct Args { const float* in[29]; float* out; unsigned char* ws; int ph_lo, ph_hi; };
enum { I_XP = 0, I_XS, I_CK, I_CV, I_CKI, I_SCONV, I_SSSM, I_PT, I_BIAS, I_WIN, I_CONVW, I_CONVB, I_DTB, I_ALOG, I_DSKIP, I_NORMG, I_WBS, I_WBA, I_WOUT,
       I_F1WI, I_F1WO, I_F2WI, I_F2WO, I_LN1G, I_LN1B, I_LN2G, I_LN2B, I_LN3G, I_LN3B };

__device__ __forceinline__ float bf2f(unsigned v) { return __uint_as_float(v << 16); }
__device__ __forceinline__ unsigned f2bf(float f) { unsigned u = __float_as_uint(f); return (u + 0x7fffu + ((u >> 16) & 1u)) >> 16; }
__device__ __forceinline__ unsigned pk2(float lo, float hi) { return pg8::cvt_pk_bf16(lo, hi); }
__device__ __forceinline__ void unpack8(const u32x4 w, float (&f)[8]) {
#pragma unroll
    for (int i = 0; i < 4; ++i) { f[2 * i] = __uint_as_float(w[i] << 16); f[2 * i + 1] = __uint_as_float(w[i] & 0xffff0000u); }
}
__device__ __forceinline__ u32x4 pack8(const float (&f)[8]) { u32x4 w; w.x = pk2(f[0], f[1]); w.y = pk2(f[2], f[3]); w.z = pk2(f[4], f[5]); w.w = pk2(f[6], f[7]); return w; }
__device__ __forceinline__ float sigmoidf_(float x) { return 1.0f / (1.0f + __expf(-x)); }
__device__ __forceinline__ float siluf_(float x) { return x / (1.0f + __expf(-x)); }
__device__ __forceinline__ float wave_sum(float v) {
#pragma unroll
    for (int o = 1; o < 64; o <<= 1) v += __shfl_xor(v, o);
    return v;
}
__device__ __forceinline__ float wave_max(float v) {
#pragma unroll
    for (int o = 1; o < 64; o <<= 1) v = fmaxf(v, __shfl_xor(v, o));
    return v;
}
__device__ __forceinline__ f32x4 mfma16(bf16x8 a, bf16x8 b, f32x4 c) { return __builtin_amdgcn_mfma_f32_16x16x32_bf16(a, b, c, 0, 0, 0); }
__device__ __forceinline__ int mbcnt64(unsigned long long m) { return (int)__builtin_amdgcn_mbcnt_hi((unsigned)(m >> 32), __builtin_amdgcn_mbcnt_lo((unsigned)m, 0u)); }

struct EpiSwiglu {
    static constexpr bool PERM = true, AFTER_DRAIN = false;
    bf16_t* O;
    __device__ __forceinline__ void operator()(const f32x4 (&acc)[2][2][4][2], const pg8::Unit& u, int wr, int wc, int fr, int fq) const {
        const int row0 = u.pm * 256 + wr * 64 + fr, col0 = u.pn * 128 + wc * 32 + 8 * fq;
#pragma unroll
        for (int ai = 0; ai < 2; ++ai)
#pragma unroll
            for (int m = 0; m < 4; ++m) {
                float o[8];
#pragma unroll
                for (int n = 0; n < 2; ++n)
#pragma unroll
                    for (int j = 0; j < 4; ++j) { const float g = acc[ai][0][m][n][j], up = acc[ai][1][m][n][j]; o[4 * n + j] = siluf_(g) * up; }
                *(u32x4*)(O + (size_t)(row0 + ai * 128 + m * 16) * DFF + col0) = pack8(o);
            }
    }
};
struct EpiResid {
    static constexpr bool PERM = false, AFTER_DRAIN = false;
    const float* base_p; const float* base_s; float* T; float alpha, s;
    __device__ __forceinline__ void operator()(const f32x4 (&acc)[2][2][4][2], const pg8::Unit& u, int wr, int wc, int fr, int fq) const {
        const int row0 = u.pm * 256 + wr * 64 + fr, col0 = u.pn * 256 + wc * 32 + 4 * fq;
#pragma unroll
        for (int ai = 0; ai < 2; ++ai)
#pragma unroll
            for (int m = 0; m < 4; ++m) {
                const int r = row0 + ai * 128 + m * 16;
                const float* b = (r < MP) ? base_p + (size_t)r * D : base_s + (size_t)(r - MP) * D;
#pragma unroll
                for (int bj = 0; bj < 2; ++bj)
#pragma unroll
                    for (int n = 0; n < 2; ++n) { const int c = col0 + bj * 128 + n * 16; const f32x4 bv = *(const f32x4*)(b + c);
                        *(f32x4*)(T + (size_t)r * D + c) = bv * alpha + acc[ai][bj][m][n] * s; }
            }
    }
};
struct EpiWin {
    static constexpr bool PERM = true, AFTER_DRAIN = false;
    bf16_t* P; float* smf; float* out;
    __device__ __forceinline__ void operator()(const f32x4 (&acc)[2][2][4][2], const pg8::Unit& u, int wr, int wc, int fr, int fq) const {
        const int row0 = u.pm * 256 + wr * 64 + fr, cl = wc * 32 + 8 * fq, col0 = u.pn * 256 + cl;
#pragma unroll
        for (int ai = 0; ai < 2; ++ai)
#pragma unroll
            for (int m = 0; m < 4; ++m) {
                const int r = row0 + ai * 128 + m * 16;
#pragma unroll
                for (int bj = 0; bj < 2; ++bj) {
                    const f32x4 v0 = acc[ai][bj][m][0], v1 = acc[ai][bj][m][1];
                    u32x4 w; w.x = pk2(v0[0], v0[1]); w.y = pk2(v0[2], v0[3]); w.z = pk2(v1[0], v1[1]); w.w = pk2(v1[2], v1[3]);
                    *(u32x4*)(P + (size_t)r * NP + col0 + bj * 128) = w;
                    if (u.pn == 20) {
                        if (bj == 0) {
                            float* d = smf + (size_t)r * 128 + cl; *(f32x4*)d = v0; *(f32x4*)(d + 4) = v1;
                            if (cl >= 64) { float* k = out + ((r < MP) ? O_KIP + (size_t)r * 64 : O_KIS + (size_t)(r - MP) * 64) + (cl - 64); *(f32x4*)k = v0; *(f32x4*)(k + 4) = v1; }
                        }
                    } else if (u.pn == 25) {
                        float* k = out + ((r < MP) ? O_KP + (size_t)r * 256 : O_KS + (size_t)(r - MP) * 256) + bj * 128 + cl; *(f32x4*)k = v0; *(f32x4*)(k + 4) = v1;
                    } else if (u.pn == 26) {
                        float* k = out + ((r < MP) ? O_VP + (size_t)r * 256 : O_VS + (size_t)(r - MP) * 256) + bj * 128 + cl; *(f32x4*)k = v0; *(f32x4*)(k + 4) = v1;
                    }
                }
            }
    }
};
struct EpiGateA {
    static constexpr bool PERM = false, AFTER_DRAIN = false;
    const bf16_t* P; int gcol; float* M1;
    __device__ __forceinline__ void operator()(const f32x4 (&acc)[2][2][4][2], const pg8::Unit& u, int wr, int wc, int fr, int fq) const {
        const int row0 = u.pm * 256 + wr * 64 + fr, col0 = u.pn * 256 + wc * 32 + 4 * fq;
#pragma unroll
        for (int ai = 0; ai < 2; ++ai)
#pragma unroll
            for (int m = 0; m < 4; ++m) {
                const int r = row0 + ai * 128 + m * 16;
#pragma unroll
                for (int bj = 0; bj < 2; ++bj)
#pragma unroll
                    for (int n = 0; n < 2; ++n) { const int c = col0 + bj * 128 + n * 16; const u32x2 gw = *(const u32x2*)(P + (size_t)r * NP + gcol + c);
                        f32x4 g; g[0] = sigmoidf_(__uint_as_float(gw.x << 16)); g[1] = sigmoidf_(__uint_as_float(gw.x & 0xffff0000u)); g[2] = sigmoidf_(__uint_as_float(gw.y << 16)); g[3] = sigmoidf_(__uint_as_float(gw.y & 0xffff0000u));
                        *(f32x4*)(M1 + (size_t)r * D + c) = g * acc[ai][bj][m][n]; }
            }
    }
};
struct EpiGateS {
    static constexpr bool PERM = true, AFTER_DRAIN = false;
    const bf16_t* P; int gcol; const float* M1; bf16_t* MG;
    __device__ __forceinline__ void operator()(const f32x4 (&acc)[2][2][4][2], const pg8::Unit& u, int wr, int wc, int fr, int fq) const {
        const int row0 = u.pm * 256 + wr * 64 + fr, col0 = u.pn * 256 + wc * 32 + 8 * fq;
#pragma unroll
        for (int ai = 0; ai < 2; ++ai)
#pragma unroll
            for (int m = 0; m < 4; ++m) {
                const int r = row0 + ai * 128 + m * 16;
#pragma unroll
                for (int bj = 0; bj < 2; ++bj) { const int c = col0 + bj * 128;
                    const u32x4 gw = *(const u32x4*)(P + (size_t)r * NP + gcol + c); float g[8]; unpack8(gw, g);
                    const f32x4 m0 = *(const f32x4*)(M1 + (size_t)r * D + c), m1 = *(const f32x4*)(M1 + (size_t)r * D + c + 4);
                    float o[8];
#pragma unroll
                    for (int j = 0; j < 4; ++j) { o[j] = m0[j] + sigmoidf_(g[j]) * acc[ai][bj][m][0][j]; o[4 + j] = m1[j] + sigmoidf_(g[4 + j]) * acc[ai][bj][m][1][j]; }
                    *(u32x4*)(MG + (size_t)r * D + c) = pack8(o); }
            }
    }
};

__device__ __forceinline__ void tr_item(const float* W, int K, int Nsrc, bf16_t* WT, int k0, int drow0, int scol0, int nvalid, LAS float* scr, int lane) {
    const int c = lane & 31;
#pragma unroll 8
    for (int i = 0; i < 32; ++i) { const int kk = 2 * i + (lane >> 5); float v = 0.f; if (c < nvalid) v = W[(size_t)(k0 + kk) * Nsrc + scol0 + c]; scr[kk * 33 + c] = v; }
    asm volatile("s_waitcnt lgkmcnt(0)" ::: "memory");
    const int cc = lane & 7;
#pragma unroll
    for (int j = 0; j < 4; ++j) { const int n = (lane >> 3) + 8 * j; const LAS float* s = scr + (8 * cc) * 33 + n;
        u32x4 o; o.x = pk2(s[0 * 33], s[1 * 33]); o.y = pk2(s[2 * 33], s[3 * 33]); o.z = pk2(s[4 * 33], s[5 * 33]); o.w = pk2(s[6 * 33], s[7 * 33]);
        *(u32x4*)(WT + (size_t)(drow0 + n) * K + k0 + 8 * cc) = o; }
    asm volatile("s_waitcnt lgkmcnt(0)" ::: "memory");
}
__device__ __forceinline__ void tr_map(int mode, int n0, int& scol0, int& nvalid) {
    nvalid = 32;
    if (mode == 0) { scol0 = n0; }
    else if (mode == 1) { const int j = n0 >> 8, i = n0 & 255; scol0 = (i < 128) ? j * 128 + i : DFF + j * 128 + (i - 128); }
    else {
        if (n0 < 5120) scol0 = n0;
        else if (n0 < 5376) { const int j = n0 - 5120;
            if (j == 0) scol0 = 5120;
            else if (j == 32) { scol0 = 7264; nvalid = 8; }
            else if (j == 64 || j == 96) scol0 = 7200 + (j - 64);
            else { scol0 = 0; nvalid = 0; } }
        else if (n0 < 6400) scol0 = 5152 + (n0 - 5376);
        else if (n0 < 6656) scol0 = 6176 + (n0 - 6400);
        else if (n0 < 6912) scol0 = 6432 + (n0 - 6656);
        else if (n0 < 7424) scol0 = 6688 + (n0 - 6912);
        else scol0 = 7272 + (n0 - 7424);
    }
}
__device__ __forceinline__ void p0_prologue(const Args& A, LAS unsigned char* lds, int gw, int NGW, int wave, int lane) {
    LAS float* scr = (LAS float*)(lds + wave * 16384);
    unsigned char* ws = A.ws;
    constexpr int NI0 = 16 * 176, NI1 = 44 * 32, NI2 = 16 * 296, NI3 = 32 * 32, NI4 = 16 * 32, NI5 = 16 * 32, NI6 = NI0, NI7 = NI1;
    constexpr int NIT = NI0 + NI1 + NI2 + NI3 + NI4 + NI5 + NI6 + NI7;
    for (int it = gw; it < NIT; it += NGW) {
        int r = it; const float* W; bf16_t* WT; int K, Nsrc, nblk, mode;
        if (r < NI0) { W = A.in[I_F1WI]; WT = (bf16_t*)(ws + WS_W1A); K = 1024; Nsrc = 2 * DFF; nblk = 176; mode = 1; }
        else if ((r -= NI0) < NI1) { W = A.in[I_F1WO]; WT = (bf16_t*)(ws + WS_W1B); K = DFF; Nsrc = 1024; nblk = 32; mode = 0; }
        else if ((r -= NI1) < NI2) { W = A.in[I_WIN]; WT = (bf16_t*)(ws + WS_WIN); K = 1024; Nsrc = 9320; nblk = 296; mode = 2; }
        else if ((r -= NI2) < NI3) { W = A.in[I_WBS]; WT = (bf16_t*)(ws + WS_WBS); K = 2048; Nsrc = 1024; nblk = 32; mode = 0; }
        else if ((r -= NI3) < NI4) { W = A.in[I_WBA]; WT = (bf16_t*)(ws + WS_WBA); K = 1024; Nsrc = 1024; nblk = 32; mode = 0; }
        else if ((r -= NI4) < NI5) { W = A.in[I_WOUT]; WT = (bf16_t*)(ws + WS_WOUT); K = 1024; Nsrc = 1024; nblk = 32; mode = 0; }
        else if ((r -= NI5) < NI6) { W = A.in[I_F2WI]; WT = (bf16_t*)(ws + WS_W2A); K = 1024; Nsrc = 2 * DFF; nblk = 176; mode = 1; }
        else { r -= NI6; W = A.in[I_F2WO]; WT = (bf16_t*)(ws + WS_W2B); K = DFF; Nsrc = 1024; nblk = 32; mode = 0; }
        const int kb = r / nblk, nb = r % nblk; int scol0, nvalid; tr_map(mode, nb * 32, scol0, nvalid);
        tr_item(W, K, Nsrc, WT, kb * 64, nb * 32, scol0, nvalid, scr, lane);
    }
    bf16_t* XB = (bf16_t*)(ws + WS_XB);
    const int nchunk = M * D / 8;
    for (int ch = gw * 64 + lane; ch < nchunk; ch += NGW * 64) {
        const int m = ch >> 7, c = (ch & 127) * 8;
        const float* src = (m < MP) ? A.in[I_XP] + (size_t)m * D + c : A.in[I_XS] + (size_t)(m - MP) * D + c;
        const f32x4 a = *(const f32x4*)src, b = *(const f32x4*)(src + 4);
        u32x4 w; w.x = pk2(a[0], a[1]); w.y = pk2(a[2], a[3]); w.z = pk2(b[0], b[1]); w.w = pk2(b[2], b[3]);
        *(u32x4*)(XB + (size_t)m * D + c) = w;
    }
}

__device__ __forceinline__ void ln_phase(const float* T, const float* g, const float* b, float* outf, bf16_t* outb, int gw, int NGW, int lane) {
    f32x4 gv[4], bv[4];
#pragma unroll
    for (int j = 0; j < 4; ++j) { gv[j] = *(const f32x4*)(g + 4 * lane + 256 * j); bv[j] = *(const f32x4*)(b + 4 * lane + 256 * j); }
    for (int m = gw; m < M; m += NGW) {
        const float* xr = T + (size_t)m * D + 4 * lane;
        f32x4 v[4]; float s = 0.f;
#pragma unroll
        for (int j = 0; j < 4; ++j) { v[j] = *(const f32x4*)(xr + 256 * j); s += (v[j][0] + v[j][1]) + (v[j][2] + v[j][3]); }
        const float mean = wave_sum(s) * (1.f / D); float s2 = 0.f;
#pragma unroll
        for (int j = 0; j < 4; ++j) { v[j] = v[j] - mean; s2 += (v[j][0] * v[j][0] + v[j][1] * v[j][1]) + (v[j][2] * v[j][2] + v[j][3] * v[j][3]); }
        const float rstd = 1.0f / sqrtf(wave_sum(s2) * (1.f / D) + LN_EPS);
#pragma unroll
        for (int j = 0; j < 4; ++j) {
            const f32x4 o = v[j] * rstd * gv[j] + bv[j];
            *(f32x4*)(outf + (size_t)m * D + 4 * lane + 256 * j) = o;
            if (outb) { u32x2 w; w.x = pk2(o[0], o[1]); w.y = pk2(o[2], o[3]); *(u32x2*)(outb + (size_t)m * D + 4 * lane + 256 * j) = w; }
        }
    }
}

__device__ __forceinline__ void conv_phase(const Args& A) {
    const bf16_t* P = (const bf16_t*)(A.ws + WS_P); bf16_t* XC = (bf16_t*)(A.ws + WS_XC);
    const float* cw = A.in[I_CONVW]; const float* cb = A.in[I_CONVB]; const float* sconv = A.in[I_SCONV];
    const long total = (long)M * 384, stride = (long)gridDim.x * NTHR;
    for (long it = (long)blockIdx.x * NTHR + threadIdx.x; it < total; it += stride) {
        const int m = (int)(it / 384), ch = (int)(it % 384) * 8;
        const bool samp = m >= MP; int b, t;
        if (!samp) { b = m >> 11; t = m & 2047; } else { const int ms = m - MP; b = ms >> 2; t = ms & 3; }
        float acc[8], cur[8];
        { const f32x4 b0 = *(const f32x4*)(cb + ch), b1 = *(const f32x4*)(cb + ch + 4);
#pragma unroll
          for (int i = 0; i < 4; ++i) { acc[i] = b0[i]; acc[4 + i] = b1[i]; } }
#pragma unroll
        for (int j = 0; j < 4; ++j) {
            const int tau = t - 3 + j; float uu[8];
            if (tau >= 0) { const u32x4 w = *(const u32x4*)(P + (size_t)(m - 3 + j) * NP + PXBC + ch); unpack8(w, uu); }
            else if (samp) { const float* s = sconv + ((size_t)b * 3 + (3 + tau)) * XCW + ch; const f32x4 s0 = *(const f32x4*)s, s1 = *(const f32x4*)(s + 4);
#pragma unroll
                for (int i = 0; i < 4; ++i) { uu[i] = s0[i]; uu[4 + i] = s1[i]; } }
            else {
#pragma unroll
                for (int i = 0; i < 8; ++i) uu[i] = 0.f; }
            const f32x4 w0 = *(const f32x4*)(cw + (size_t)j * XCW + ch), w1 = *(const f32x4*)(cw + (size_t)j * XCW + ch + 4);
#pragma unroll
            for (int i = 0; i < 4; ++i) { acc[i] += w0[i] * uu[i]; acc[4 + i] += w1[i] * uu[4 + i]; }
            if (j == 3) {
#pragma unroll
                for (int i = 0; i < 8; ++i) cur[i] = uu[i]; }
        }
        float o[8];
#pragma unroll
        for (int i = 0; i < 8; ++i) o[i] = siluf_(acc[i]);
        *(u32x4*)(XC + (size_t)m * XCW + ch) = pack8(o);
        float* cs = nullptr;
        if (!samp) { if (t >= 2045) cs = A.out + O_CVP + ((size_t)b * 3 + (t - 2045)) * XCW + ch; }
        else { if (t >= 1) cs = A.out + O_CVS + ((size_t)b * 3 + (t - 1)) * XCW + ch; }
        if (cs) { f32x4 c0, c1;
#pragma unroll
            for (int i = 0; i < 4; ++i) { c0[i] = cur[i]; c1[i] = cur[4 + i]; }
            *(f32x4*)cs = c0; *(f32x4*)(cs + 4) = c1; }
    }
}

constexpr float IDX_SCALE = 0.125f * 0.35355339059327373f;
__device__ __forceinline__ void scores_prompt_unit(const Args& A, int b, int qt, int wave, int lane) {
    const bf16_t* P = (const bf16_t*)(A.ws + WS_P); const float* SMF = (const float*)(A.ws + WS_SMF); float* SC = (float*)(A.ws + WS_SC);
    const int fr = lane & 15, fq = lane >> 4;
    const size_t rowq = (size_t)(b * 2048 + qt * 16 + fr);
    bf16x8 Af[8][2];
#pragma unroll
    for (int h = 0; h < 8; ++h)
#pragma unroll
        for (int ks = 0; ks < 2; ++ks) Af[h][ks] = *(const bf16x8*)(P + rowq * NP + PQI + h * 64 + ks * 32 + 8 * fq);
    float wq[4][8];
#pragma unroll
    for (int j = 0; j < 4; ++j) { const float* wp = SMF + (size_t)(b * 2048 + qt * 16 + 4 * fq + j) * 128 + 32; const f32x4 w0 = *(const f32x4*)wp, w1 = *(const f32x4*)(wp + 4);
#pragma unroll
        for (int h = 0; h < 4; ++h) { wq[j][h] = w0[h] * IDX_SCALE; wq[j][4 + h] = w1[h] * IDX_SCALE; } }
    for (int kt = wave; kt <= qt; kt += NWAVES) {
        const size_t rowk = (size_t)(b * 2048 + kt * 16 + fr);
        const bf16x8 B0 = *(const bf16x8*)(P + rowk * NP + PSM + 64 + 8 * fq), B1 = *(const bf16x8*)(P + rowk * NP + PSM + 96 + 8 * fq);
        f32x4 sc = {0.f, 0.f, 0.f, 0.f};
#pragma unroll
        for (int h = 0; h < 8; ++h) { f32x4 d = {0.f, 0.f, 0.f, 0.f}; d = mfma16(Af[h][0], B0, d); d = mfma16(Af[h][1], B1, d);
#pragma unroll
            for (int j = 0; j < 4; ++j) sc[j] += wq[j][h] * fmaxf(d[j], 0.f); }
#pragma unroll
        for (int j = 0; j < 4; ++j) SC[(size_t)(b * 2048 + qt * 16 + 4 * fq + j) * SCW + kt * 16 + fr] = sc[j];
    }
}
__device__ __forceinline__ void scores_sample_unit(const Args& A, int b, int half, int wave, int lane) {
    const bf16_t* P = (const bf16_t*)(A.ws + WS_P); const float* SMF = (const float*)(A.ws + WS_SMF); float* SCS = (float*)(A.ws + WS_SCS);
    const int* pt = (const int*)A.in[I_PT]; const float* cki = A.in[I_CKI];
    const int fr = lane & 15, fq = lane >> 4;
    bf16x8 Af[2][2]; float wq[2][4];
#pragma unroll
    for (int mt = 0; mt < 2; ++mt) {
#pragma unroll
        for (int ks = 0; ks < 2; ++ks) Af[mt][ks] = *(const bf16x8*)(P + (size_t)(MP + b * 4 + 2 * mt + (fr >> 3)) * NP + PQI + (fr & 7) * 64 + ks * 32 + 8 * fq);
        const f32x4 w = *(const f32x4*)(SMF + (size_t)(MP + b * 4 + 2 * mt + (fq >> 1)) * 128 + 32 + 4 * (fq & 1));
#pragma unroll
        for (int j = 0; j < 4; ++j) wq[mt][j] = w[j] * IDX_SCALE;
    }
    const int kt_end = (half == 0) ? 65 : 129;
    for (int kt = half * 65 + wave; kt < kt_end; kt += NWAVES) {
        const int key = kt * 16 + fr;
        bf16x8 B0, B1;
        if (key < 2048) {
            const int page = pt[b * 16 + (key >> 7)];
            const float* src = cki + ((size_t)page * 128 + (key & 127)) * 64 + 8 * fq;
            const f32x4 a0 = *(const f32x4*)src, a1 = *(const f32x4*)(src + 4), c0 = *(const f32x4*)(src + 32), c1 = *(const f32x4*)(src + 36);
            u32x4 w0, w1; w0.x = pk2(a0[0], a0[1]); w0.y = pk2(a0[2], a0[3]); w0.z = pk2(a1[0], a1[1]); w0.w = pk2(a1[2], a1[3]);
            w1.x = pk2(c0[0], c0[1]); w1.y = pk2(c0[2], c0[3]); w1.z = pk2(c1[0], c1[1]); w1.w = pk2(c1[2], c1[3]);
            B0 = __builtin_bit_cast(bf16x8, w0); B1 = __builtin_bit_cast(bf16x8, w1);
        } else if (key < 2052) {
            const bf16_t* src = P + (size_t)(MP + b * 4 + (key - 2048)) * NP + PSM + 64 + 8 * fq;
            B0 = *(const bf16x8*)src; B1 = *(const bf16x8*)(src + 32);
        } else { B0 = (bf16x8){0, 0, 0, 0, 0, 0, 0, 0}; B1 = B0; }
#pragma unroll
        for (int mt = 0; mt < 2; ++mt) {
            f32x4 d = {0.f, 0.f, 0.f, 0.f}; d = mfma16(Af[mt][0], B0, d); d = mfma16(Af[mt][1], B1, d);
            float s = 0.f;
#pragma unroll
            for (int j = 0; j < 4; ++j) s += wq[mt][j] * fmaxf(d[j], 0.f);
            s += __shfl_xor(s, 16);
            if ((fq & 1) == 0 && key < 2052) SCS[(size_t)(b * 4 + 2 * mt + (fq >> 1)) * SCSW + key] = s;
        }
    }
}

__device__ __forceinline__ float softplusf_(float x) { return fmaxf(x, 0.f) + log1pf(expf(-fabsf(x))); }
__device__ __forceinline__ void ssd_prompt_item(const Args& A, LAS unsigned char* lds, int b, int h) {
    const int tid = threadIdx.x, lane = tid & 63, wave = __builtin_amdgcn_readfirstlane(tid >> 6), fr = lane & 15, fq = lane >> 4;
    const int g = h >> 3;
    const bf16_t* XC = (const bf16_t*)(A.ws + WS_XC); const float* SMF = (const float*)(A.ws + WS_SMF); bf16_t* Y = (bf16_t*)(A.ws + WS_Y);
    LAS bf16_t* Cm = (LAS bf16_t*)lds;
    LAS bf16_t* Bm = Cm + 64 * 136;
    LAS bf16_t* Btw = Bm + 64 * 136;
    LAS bf16_t* Xt = Btw + 128 * 72;
    LAS bf16_t* Mt = Xt + 64 * 72;
    LAS bf16_t* Hp = Mt + 64 * 72;
    LAS float* cum = (LAS float*)(Hp + 64 * 136);
    LAS float* dtv = cum + 64; LAS float* wv = dtv + 64; LAS float* ecum = wv + 64;
    const float Ah = -expf(A.in[I_ALOG][h]), dtb = A.in[I_DTB][h], dsk = A.in[I_DSKIP][h];
    f32x4 hst[4];
#pragma unroll
    for (int i = 0; i < 4; ++i) hst[i] = (f32x4){0.f, 0.f, 0.f, 0.f};
    for (int i = tid; i < 64 * 136 / 8; i += NTHR) *(LAS u32x4*)(Hp + i * 8) = (u32x4){0u, 0u, 0u, 0u};
    const int s0 = tid >> 4, part0 = tid & 15;
    const int xs = tid >> 3, xpart = tid & 7;
    for (int c = 0; c < 32; ++c) {
        const int row0 = b * 2048 + c * 64;
        u32x4 cr[2], br[2];
#pragma unroll
        for (int i = 0; i < 2; ++i) { const bf16_t* rp = XC + (size_t)(row0 + s0 + 32 * i) * XCW + g * 128 + part0 * 8; cr[i] = *(const u32x4*)(rp + 2560); br[i] = *(const u32x4*)(rp + 2048); }
        const u32x4 xr = *(const u32x4*)(XC + (size_t)(row0 + xs) * XCW + h * 64 + xpart * 8);
        if (wave == 0) {
            const float dt = softplusf_(SMF[(size_t)(row0 + lane) * 128 + h] + dtb);
            float v = dt * Ah;
#pragma unroll
            for (int o = 1; o < 64; o <<= 1) { const float n = __shfl_up(v, o); if (lane >= o) v += n; }
            const float ce = __shfl(v, 63);
            cum[lane] = v; dtv[lane] = dt; wv[lane] = dt * expf(ce - v); ecum[lane] = expf(v);
        }
        __syncthreads();
#pragma unroll
        for (int i = 0; i < 2; ++i) {
            const int s = s0 + 32 * i;
            *(LAS u32x4*)(Cm + s * 136 + part0 * 8) = cr[i];
            *(LAS u32x4*)(Bm + s * 136 + part0 * 8) = br[i];
            float bf[8]; unpack8(br[i], bf); const float w = wv[s];
#pragma unroll
            for (int e = 0; e < 8; ++e) Btw[(part0 * 8 + e) * 72 + s] = (bf16_t)f2bf(bf[e] * w);
        }
        {
#pragma unroll
            for (int e = 0; e < 4; ++e) { Xt[(xpart * 8 + 2 * e) * 72 + xs] = (bf16_t)(xr[e] & 0xffffu); Xt[(xpart * 8 + 2 * e + 1) * 72 + xs] = (bf16_t)(xr[e] >> 16); }
        }
        __syncthreads();
        {
            const int st = wave >> 1, tt0 = 2 * (wave & 1);
            bf16x8 a[4];
#pragma unroll
            for (int ks = 0; ks < 4; ++ks) a[ks] = *(const LAS bf16x8*)(Bm + (16 * st + fr) * 136 + ks * 32 + 8 * fq);
#pragma unroll
            for (int u = 0; u < 2; ++u) {
                const int tt = tt0 + u; f32x4 d = {0.f, 0.f, 0.f, 0.f};
#pragma unroll
                for (int ks = 0; ks < 4; ++ks) { const bf16x8 bb = *(const LAS bf16x8*)(Cm + (16 * tt + fr) * 136 + ks * 32 + 8 * fq); d = mfma16(a[ks], bb, d); }
                const int t = 16 * tt + fr; const float ct = cum[t]; float mv[4];
#pragma unroll
                for (int j = 0; j < 4; ++j) { const int s = 16 * st + 4 * fq + j; mv[j] = (s <= t) ? d[j] * expf(ct - cum[s]) * dtv[s] : 0.f; }
                u32x2 w; w.x = pk2(mv[0], mv[1]); w.y = pk2(mv[2], mv[3]);
                *(LAS u32x2*)(Mt + t * 72 + 16 * st + 4 * fq) = w;
            }
        }
        __syncthreads();
        {
            const int pt = wave >> 1, tt0 = 2 * (wave & 1);
            bf16x8 a1[2], a2[4];
#pragma unroll
            for (int ks = 0; ks < 2; ++ks) a1[ks] = *(const LAS bf16x8*)(Xt + (16 * pt + fr) * 72 + ks * 32 + 8 * fq);
#pragma unroll
            for (int ks = 0; ks < 4; ++ks) a2[ks] = *(const LAS bf16x8*)(Hp + (16 * pt + fr) * 136 + ks * 32 + 8 * fq);
#pragma unroll
            for (int u = 0; u < 2; ++u) {
                const int tt = tt0 + u; f32x4 d1 = {0.f, 0.f, 0.f, 0.f}, d2 = {0.f, 0.f, 0.f, 0.f};
#pragma unroll
                for (int ks = 0; ks < 2; ++ks) { const bf16x8 bb = *(const LAS bf16x8*)(Mt + (16 * tt + fr) * 72 + ks * 32 + 8 * fq); d1 = mfma16(a1[ks], bb, d1); }
#pragma unroll
                for (int ks = 0; ks < 4; ++ks) { const bf16x8 bb = *(const LAS bf16x8*)(Cm + (16 * tt + fr) * 136 + ks * 32 + 8 * fq); d2 = mfma16(a2[ks], bb, d2); }
                const int t = 16 * tt + fr; const float et = ecum[t]; float yv[4];
#pragma unroll
                for (int j = 0; j < 4; ++j) { const int p = 16 * pt + 4 * fq + j; yv[j] = d1[j] + et * d2[j] + dsk * bf2f((unsigned)Xt[p * 72 + t]); }
                u32x2 w; w.x = pk2(yv[0], yv[1]); w.y = pk2(yv[2], yv[3]);
                *(u32x2*)(Y + (size_t)(row0 + t) * DI + h * 64 + 16 * pt + 4 * fq) = w;
            }
            bf16x8 a3[2];
#pragma unroll
            for (int ks = 0; ks < 2; ++ks) a3[ks] = *(const LAS bf16x8*)(Btw + (16 * wave + fr) * 72 + ks * 32 + 8 * fq);
            const float dec = ecum[63];
#pragma unroll
            for (int p4 = 0; p4 < 4; ++p4) { f32x4 d = {0.f, 0.f, 0.f, 0.f};
#pragma unroll
                for (int ks = 0; ks < 2; ++ks) { const bf16x8 bb = *(const LAS bf16x8*)(Xt + (16 * p4 + fr) * 72 + ks * 32 + 8 * fq); d = mfma16(a3[ks], bb, d); }
                hst[p4] = hst[p4] * dec + d; }
        }
        __syncthreads();
#pragma unroll
        for (int p4 = 0; p4 < 4; ++p4) { u32x2 w; w.x = pk2(hst[p4][0], hst[p4][1]); w.y = pk2(hst[p4][2], hst[p4][3]);
            *(LAS u32x2*)(Hp + (16 * p4 + fr) * 136 + 16 * wave + 4 * fq) = w; }
    }
    float* so = A.out + O_SSP + ((size_t)b * 32 + h) * 64 * 128;
#pragma unroll
    for (int p4 = 0; p4 < 4; ++p4) *(f32x4*)(so + (size_t)(16 * p4 + fr) * 128 + 16 * wave + 4 * fq) = hst[p4];
    __syncthreads();
}

__device__ __forceinline__ void ssd_sample_item(const Args& A, LAS unsigned char* wl, int b, int h, int lane) {
    const bf16_t* XC = (const bf16_t*)(A.ws + WS_XC); const float* SMF = (const float*)(A.ws + WS_SMF); bf16_t* Y = (bf16_t*)(A.ws + WS_Y);
    LAS float* red = (LAS float*)wl;
    const int g = h >> 3;
    const float Ah = -expf(A.in[I_ALOG][h]), dtb = A.in[I_DTB][h], dsk = A.in[I_DSKIP][h];
#pragma unroll 1
    for (int half = 0; half < 2; ++half) {
        const float* h0 = A.in[I_SSSM] + (((size_t)b * 32 + h) * 64 + 32 * half) * 128 + 2 * lane;
        float st[32][2];
#pragma unroll
        for (int p = 0; p < 32; ++p) { const float2 v = *(const float2*)(h0 + p * 128); st[p][0] = v.x; st[p][1] = v.y; }
#pragma unroll 1
        for (int t = 0; t < 4; ++t) {
            const size_t m = (size_t)(MP + b * 4 + t);
            const float dt = softplusf_(SMF[m * 128 + h] + dtb), dec = expf(dt * Ah);
            const unsigned bw = *(const unsigned*)(XC + m * XCW + 2048 + g * 128 + 2 * lane), cw = *(const unsigned*)(XC + m * XCW + 2560 + g * 128 + 2 * lane);
            const float b0 = bf2f(bw & 0xffffu) * dt, b1 = __uint_as_float(bw & 0xffff0000u) * dt, c0 = bf2f(cw & 0xffffu), c1 = __uint_as_float(cw & 0xffff0000u);
            const float xl = bf2f((unsigned)XC[m * XCW + h * 64 + 32 * half + (lane & 31)]);
#pragma unroll
            for (int p = 0; p < 32; ++p) {
                const float xp = __shfl(xl, p);
                st[p][0] = st[p][0] * dec + xp * b0; st[p][1] = st[p][1] * dec + xp * b1;
                red[p * 65 + lane] = st[p][0] * c0 + st[p][1] * c1;
            }
            asm volatile("s_waitcnt lgkmcnt(0)" ::: "memory");
            float y = 0.f;
#pragma unroll 16
            for (int i = 0; i < 64; ++i) y += red[(lane & 31) * 65 + i];
            y += dsk * xl;
            if (lane < 32) Y[m * DI + h * 64 + 32 * half + lane] = (bf16_t)f2bf(y);
            asm volatile("s_waitcnt lgkmcnt(0)" ::: "memory");
        }
        float* so = A.out + O_SSS + (((size_t)b * 32 + h) * 64 + 32 * half) * 128 + 2 * lane;
#pragma unroll
        for (int p = 0; p < 32; ++p) *(float2*)(so + p * 128) = make_float2(st[p][0], st[p][1]);
    }
}

__device__ __forceinline__ int t5_bucket(int n) {
    if (n < 16) return n;
    const float nf = (float)n;
    int large = 16 + (int)(logf(nf / 16.0f) / 2.0794415416798357f * 16.0f);
    return large < 31 ? large : 31;
}
__device__ __forceinline__ unsigned f2key(float v) { unsigned u = (v == 0.f) ? 0u : __float_as_uint(v); return (u & 0x80000000u) ? ~u : (u | 0x80000000u); }

template <bool SAMPLE> struct KVRow;
template <> struct KVRow<false> {
    typedef const bf16_t* ptr;
    const bf16_t* P;
    __device__ __forceinline__ ptr krow(unsigned rid) const { return P + (size_t)rid * NP + PK; }
    __device__ __forceinline__ ptr vrow(unsigned rid) const { return P + (size_t)rid * NP + PV; }
    static __device__ __forceinline__ void k8(ptr p, float (&f)[8]) { unpack8(*(const u32x4*)p, f); }
    static __device__ __forceinline__ f32x4 v4(ptr p) { const u32x2 w = *(const u32x2*)p;
        return (f32x4){__uint_as_float(w.x << 16), __uint_as_float(w.x & 0xffff0000u), __uint_as_float(w.y << 16), __uint_as_float(w.y & 0xffff0000u)}; }
};
template <> struct KVRow<true> {
    typedef const float* ptr;
    const float* ck; const float* cv; const float* kn; const float* vn;
    __device__ __forceinline__ ptr krow(unsigned rid) const { return (rid & 0x80000000u) ? kn + (size_t)(rid & 0x7fffffffu) * 256 : ck + (size_t)rid * 256; }
    __device__ __forceinline__ ptr vrow(unsigned rid) const { return (rid & 0x80000000u) ? vn + (size_t)(rid & 0x7fffffffu) * 256 : cv + (size_t)rid * 256; }
    static __device__ __forceinline__ void k8(ptr p, float (&f)[8]) { const f32x4 a = *(const f32x4*)p, b = *(const f32x4*)(p + 4);
#pragma unroll
        for (int i = 0; i < 4; ++i) { f[i] = a[i]; f[4 + i] = b[i]; } }
    static __device__ __forceinline__ f32x4 v4(ptr p) { return *(const f32x4*)p; }
};

template <bool SAMPLE>
__device__ __forceinline__ void attend_query(const Args& A, LAS unsigned char* wl, const LAS float* biasrel, int m, int lane_in) {
    constexpr int NJ = SAMPLE ? 33 : 32;
    int lane = lane_in; asm volatile("" : "+v"(lane));
    const bf16_t* P = (const bf16_t*)(A.ws + WS_P);
    int b, nvalid, qpos; const float* srow;
    if (!SAMPLE) { b = m >> 11; const int t = m & 2047; nvalid = t + 1; qpos = t; srow = (const float*)(A.ws + WS_SC) + (size_t)m * SCW; }
    else { const int ms = m - MP; b = ms >> 2; const int t = ms & 3; nvalid = 2049 + t; qpos = 2048 + t; srow = (const float*)(A.ws + WS_SCS) + (size_t)ms * SCSW; }
    LAS float* pq = (LAS float*)wl;
    LAS unsigned* rowid = (LAS unsigned*)(wl + 16384);
    LAS unsigned short* posl = (LAS unsigned short*)(wl + 16384 + 1024);
    unsigned key[NJ];
#pragma unroll
    for (int j = 0; j < NJ; ++j) { key[j] = (lane < nvalid - 64 * j) ? f2key(srow[lane + 64 * j]) : 0u; }
    unsigned T = 0u; int need_eq = 0;
    if (nvalid > 256) {
        for (int bit = 31; bit >= 0; --bit) {
            const unsigned cand = T | (1u << bit); int cnt = 0;
#pragma unroll
            for (int j = 0; j < NJ; ++j) cnt += __popcll(__ballot(key[j] >= cand));
            if (cnt >= 256) T = cand;
        }
        int cgt = 0;
#pragma unroll
        for (int j = 0; j < NJ; ++j) cgt += __popcll(__ballot(key[j] > T));
        need_eq = 256 - cgt;
    }
    int base = 0, eqused = 0;
    const int* pt = (const int*)A.in[I_PT];
#pragma unroll
    for (int j = 0; j < NJ; ++j) {
        const bool gt = key[j] > T, eq = (need_eq > 0) && (key[j] == T);
        const unsigned long long meq = __ballot(eq);
        const bool sel = gt || (eq && (eqused + mbcnt64(meq) < need_eq));
        eqused += __popcll(meq);
        const unsigned long long ms = __ballot(sel);
        if (sel) { const int pos = lane + 64 * j, k = base + mbcnt64(ms);
            posl[k] = (unsigned short)pos;
            unsigned rid;
            if (!SAMPLE) rid = (unsigned)(b * 2048 + pos);
            else rid = (pos < 2048) ? (unsigned)(pt[b * 16 + (pos >> 7)] * 128 + (pos & 127)) : (0x80000000u | (unsigned)(b * 4 + pos - 2048));
            rowid[k] = rid; }
        base += __popcll(ms);
    }
    const int nsel = base;
    asm volatile("s_waitcnt lgkmcnt(0)" ::: "memory");
    { const unsigned r0 = rowid[0]; const unsigned short p0 = posl[0];
#pragma unroll
      for (int i = 0; i < 4; ++i) { const int k = lane + 64 * i; if (k >= nsel) { rowid[k] = r0; posl[k] = p0; } } }
    { const u32x4 w0 = *(const u32x4*)(P + (size_t)m * NP + PQ + lane * 16), w1 = *(const u32x4*)(P + (size_t)m * NP + PQ + lane * 16 + 8);
      float f0[8], f1[8]; unpack8(w0, f0); unpack8(w1, f1);
#pragma unroll
      for (int e = 0; e < 8; ++e) { pq[lane * 16 + e] = f0[e]; pq[lane * 16 + 8 + e] = f1[e]; } }
    asm volatile("s_waitcnt lgkmcnt(0)" ::: "memory");
    KVRow<SAMPLE> R;
    if constexpr (!SAMPLE) { R.P = P; } else { R.ck = A.in[I_CK]; R.cv = A.in[I_CV]; R.kn = A.out + O_KS; R.vn = A.out + O_VS; }
    typename KVRow<SAMPLE>::ptr kp[4]; int rel[4];
#pragma unroll
    for (int i = 0; i < 4; ++i) { kp[i] = R.krow(rowid[lane + 64 * i]); rel[i] = qpos - (int)posl[lane + 64 * i]; }
    float acc[4][16];
#pragma unroll
    for (int i = 0; i < 4; ++i)
#pragma unroll
        for (int hh = 0; hh < 16; ++hh) acc[i][hh] = 0.f;
#pragma unroll
    for (int g = 0; g < 4; ++g) {
#pragma unroll 1
        for (int dc = 0; dc < 8; ++dc) {
            float kv[4][8];
#pragma unroll
            for (int i = 0; i < 4; ++i) KVRow<SAMPLE>::k8(kp[i] + g * 64 + dc * 8, kv[i]);
#pragma unroll
            for (int hh = 0; hh < 4; ++hh) {
                const f32x4 q0 = *(const LAS f32x4*)(pq + (4 * g + hh) * 64 + dc * 8), q1 = *(const LAS f32x4*)(pq + (4 * g + hh) * 64 + dc * 8 + 4);
#pragma unroll
                for (int i = 0; i < 4; ++i) {
                    float a = acc[i][4 * g + hh];
#pragma unroll
                    for (int e = 0; e < 4; ++e) { a += kv[i][e] * q0[e]; a += kv[i][4 + e] * q1[e]; }
                    acc[i][4 * g + hh] = a; }
            }
        }
    }
    asm volatile("s_waitcnt lgkmcnt(0)" ::: "memory");
#pragma unroll
    for (int i = 0; i < 4; ++i) {
        const bool valid = (lane + 64 * i) < nsel; const int rc = rel[i] < 128 ? (rel[i] < 0 ? 0 : rel[i]) : 128;
#pragma unroll
        for (int h4 = 0; h4 < 4; ++h4) { const f32x4 bv = *(const LAS f32x4*)(biasrel + rc * 16 + 4 * h4);
#pragma unroll
            for (int e = 0; e < 4; ++e) acc[i][4 * h4 + e] = valid ? acc[i][4 * h4 + e] * 0.125f + bv[e] : -INFINITY; }
    }
#pragma unroll
    for (int hh = 0; hh < 16; ++hh) {
        const float mx = wave_max(fmaxf(fmaxf(acc[0][hh], acc[1][hh]), fmaxf(acc[2][hh], acc[3][hh])));
        float s = 0.f;
#pragma unroll
        for (int i = 0; i < 4; ++i) { acc[i][hh] = __expf(acc[i][hh] - mx); s += acc[i][hh]; }
        const float inv = 1.0f / wave_sum(s);
#pragma unroll
        for (int i = 0; i < 4; ++i) acc[i][hh] *= inv;
    }
#pragma unroll
    for (int i = 0; i < 4; ++i)
#pragma unroll
        for (int h4 = 0; h4 < 4; ++h4) *(LAS f32x4*)(pq + (lane + 64 * i) * 16 + 4 * h4) = (f32x4){acc[i][4 * h4], acc[i][4 * h4 + 1], acc[i][4 * h4 + 2], acc[i][4 * h4 + 3]};
    asm volatile("s_waitcnt lgkmcnt(0)" ::: "memory");
    const int g = lane >> 4;
    f32x4 o[4];
#pragma unroll
    for (int hh = 0; hh < 4; ++hh) o[hh] = (f32x4){0.f, 0.f, 0.f, 0.f};
    const int nloop = (nsel + 3) & ~3;
    for (int k0 = 0; k0 < nloop; k0 += 4) {
        f32x4 vv[4], pp[4];
#pragma unroll
        for (int u = 0; u < 4; ++u) { const unsigned r = rowid[k0 + u]; vv[u] = KVRow<SAMPLE>::v4(R.vrow(r) + lane * 4); pp[u] = *(const LAS f32x4*)(pq + (k0 + u) * 16 + 4 * g); }
#pragma unroll
        for (int u = 0; u < 4; ++u)
#pragma unroll
            for (int hh = 0; hh < 4; ++hh) o[hh] += vv[u] * pp[u][hh];
    }
    bf16_t* YA = (bf16_t*)(A.ws + WS_YA);
#pragma unroll
    for (int hh = 0; hh < 4; ++hh) { u32x2 w; w.x = pk2(o[hh][0], o[hh][1]); w.y = pk2(o[hh][2], o[hh][3]);
        *(u32x2*)(YA + (size_t)m * D + (4 * g + hh) * 64 + (lane & 15) * 4) = w; }
    asm volatile("s_waitcnt lgkmcnt(0)" ::: "memory");
}

__device__ __forceinline__ void gate_norm_phase(const Args& A, int gw, int NGW, int lane) {
    const bf16_t* P = (const bf16_t*)(A.ws + WS_P); bf16_t* Y = (bf16_t*)(A.ws + WS_Y); const float* ng = A.in[I_NORMG];
    for (int it = gw; it < M * 4; it += NGW) {
        const int m = it >> 2, ch = (it & 3) * 512 + lane * 8;
        float y[8], z[8]; unpack8(*(const u32x4*)(Y + (size_t)m * DI + ch), y); unpack8(*(const u32x4*)(P + (size_t)m * NP + PZ + ch), z);
        float ss = 0.f;
#pragma unroll
        for (int i = 0; i < 8; ++i) { y[i] *= siluf_(z[i]); ss += y[i] * y[i]; }
        const float r = 1.0f / sqrtf(wave_sum(ss) * (1.f / 512.f) + LN_EPS);
        const f32x4 g0 = *(const f32x4*)(ng + ch), g1 = *(const f32x4*)(ng + ch + 4);
#pragma unroll
        for (int i = 0; i < 4; ++i) { y[i] = y[i] * r * g0[i]; y[4 + i] = y[4 + i] * r * g1[i]; }
        *(u32x4*)(Y + (size_t)m * DI + ch) = pack8(y);
    }
}

constexpr int NPHASE = 14;
__global__ void __launch_bounds__(NTHR, 2) fwd(Args args) {
    extern __shared__ __attribute__((aligned(16))) unsigned char lds_raw[];
    LAS unsigned char* lds = (LAS unsigned char*)lds_raw;
    const int tid = threadIdx.x, lane = tid & 63, wave = __builtin_amdgcn_readfirstlane(tid >> 6);
    const int G = gridDim.x, bx = blockIdx.x;
    const int vcu = (G % 8 == 0) ? (bx % 8) * (G / 8) + bx / 8 : bx;
    const int gw = vcu * NWAVES + wave, NGW = G * NWAVES;
    unsigned char* ws = args.ws;
    volatile LAS unsigned* MISC = (volatile LAS unsigned*)(lds + MISC_OFF);
    for (int u = tid; u < 64; u += NTHR) MISC[u] = 0u;
    __syncthreads();
    const int lo = args.ph_lo, hi = args.ph_hi;
    XcdBarrier bar; bar.bar = (unsigned*)(ws + WS_CTL) + CW_BAR; bar.x = 0; bar.st = nullptr;
    if (hi - lo > 1) bar = xcd_barrier_post((unsigned*)(ws + WS_CTL) + CW_BAR, MISC + 8);
#define IN(k) (lo <= (k) && (k) < hi)
#define SEAM(k) do { if (IN(k) && IN((k) + 1)) xcd_barrier(bar); } while (0)

    bf16_t* const XB = (bf16_t*)(ws + WS_XB); bf16_t* const ACT = (bf16_t*)(ws + WS_ACT); float* const T = (float*)(ws + WS_T);
    float* const HF = (float*)(ws + WS_HF); bf16_t* const HB = (bf16_t*)(ws + WS_HB); bf16_t* const P = (bf16_t*)(ws + WS_P);
    float* const SMF = (float*)(ws + WS_SMF); bf16_t* const Y = (bf16_t*)(ws + WS_Y); bf16_t* const YA = (bf16_t*)(ws + WS_YA); bf16_t* const MG = (bf16_t*)(ws + WS_MG);

    if (IN(0)) { p0_prologue(args, lds, gw, NGW, wave, lane); }
    SEAM(0);
    if (IN(1)) { pg8::Gemm g{XB, (const bf16_t*)(ws + WS_W1A), M, 2 * DFF, D}; pg8::StaticOrder S; S.init(M, 2 * DFF, G, bx);
        EpiSwiglu E{ACT}; pg8::gemm_phase<EpiSwiglu, pg8::StaticOrder, true, true>(lds, g, S, E); }
    SEAM(1);
    if (IN(2)) { pg8::Gemm g{ACT, (const bf16_t*)(ws + WS_W1B), M, D, DFF}; pg8::StaticOrder S; S.init(M, D, G, bx);
        EpiResid E{args.in[I_XP], args.in[I_XS], T, ALPHA, 0.5f}; pg8::gemm_phase<EpiResid, pg8::StaticOrder, true, true>(lds, g, S, E); }
    SEAM(2);
    if (IN(3)) { ln_phase(T, args.in[I_LN1G], args.in[I_LN1B], HF, HB, gw, NGW, lane); }
    SEAM(3);
    if (IN(4)) { pg8::Gemm g{HB, (const bf16_t*)(ws + WS_WIN), M, NP, D}; pg8::StaticOrder S; S.init(M, NP, G, bx);
        EpiWin E{P, SMF, args.out}; pg8::gemm_phase<EpiWin, pg8::StaticOrder, true, true>(lds, g, S, E); }
    SEAM(4);
    if (IN(5)) {
        conv_phase(args);
        for (int u = bx; u < 1024; u += G) { const int i = u >> 8, c = u & 255, b = c >> 5, s = c & 31; const int qt = (i == 0) ? s : (i == 1) ? 63 - s : (i == 2) ? 64 + s : 127 - s;
            scores_prompt_unit(args, b, qt, wave, lane); }
        for (int u = bx; u < 256; u += G) scores_sample_unit(args, u >> 1, u & 1, wave, lane);
    }
    SEAM(5);
    if (IN(6)) {
        for (int it = bx; it < 256; it += G) ssd_prompt_item(args, lds, it >> 5, it & 31);
        __syncthreads();
        LAS float* biasrel = (LAS float*)(lds + BIASREL_OFF);
        for (int i = tid; i < 129 * 16; i += NTHR) { const int rel = i >> 4, h = i & 15; biasrel[i] = args.in[I_BIAS][t5_bucket(rel) * 16 + h]; }
        __syncthreads();
        LAS unsigned char* wl = lds + wave * WAREA;
        for (int it = gw; it < 4096; it += NGW) ssd_sample_item(args, wl, it >> 5, it & 31, lane);
        for (int q = gw; q < MS; q += NGW) attend_query<true>(args, wl, biasrel, MP + q, lane);
        for (int q = gw; q < MP; q += NGW) attend_query<false>(args, wl, biasrel, q, lane);
        __syncthreads();
    }
    SEAM(6);
    if (IN(7)) {
        gate_norm_phase(args, gw, NGW, lane);
        pg8::Gemm g{YA, (const bf16_t*)(ws + WS_WBA), M, D, D}; pg8::StaticOrder S; S.init(M, D, G, bx);
        EpiGateA E{P, PG + D, T}; pg8::gemm_phase<EpiGateA, pg8::StaticOrder, true, true>(lds, g, S, E);
    }
    SEAM(7);
    if (IN(8)) { pg8::Gemm g{Y, (const bf16_t*)(ws + WS_WBS), M, D, DI}; pg8::StaticOrder S; S.init(M, D, G, bx);
        EpiGateS E{P, PG, T, MG}; pg8::gemm_phase<EpiGateS, pg8::StaticOrder, true, true>(lds, g, S, E); }
    SEAM(8);
    if (IN(9)) { pg8::Gemm g{MG, (const bf16_t*)(ws + WS_WOUT), M, D, D}; pg8::StaticOrder S; S.init(M, D, G, bx);
        EpiResid E{HF, HF + (size_t)MP * D, T, ALPHA, 1.0f}; pg8::gemm_phase<EpiResid, pg8::StaticOrder, true, true>(lds, g, S, E); }
    SEAM(9);
    if (IN(10)) { ln_phase(T, args.in[I_LN2G], args.in[I_LN2B], HF, HB, gw, NGW, lane); }
    SEAM(10);
    if (IN(11)) { pg8::Gemm g{HB, (const bf16_t*)(ws + WS_W2A), M, 2 * DFF, D}; pg8::StaticOrder S; S.init(M, 2 * DFF, G, bx);
        EpiSwiglu E{ACT}; pg8::gemm_phase<EpiSwiglu, pg8::StaticOrder, true, true>(lds, g, S, E); }
    SEAM(11);
    if (IN(12)) { pg8::Gemm g{ACT, (const bf16_t*)(ws + WS_W2B), M, D, DFF}; pg8::StaticOrder S; S.init(M, D, G, bx);
        EpiResid E{HF, HF + (size_t)MP * D, T, ALPHA, 0.5f}; pg8::gemm_phase<EpiResid, pg8::StaticOrder, true, true>(lds, g, S, E); }
    SEAM(12);
    if (IN(13)) { ln_phase(T, args.in[I_LN3G], args.in[I_LN3B], args.out + O_Y, nullptr, gw, NGW, lane); }
#undef IN
#undef SEAM
}
}

extern "C" void kernel_launch(void* const* d_in, const int* in_sizes, int n_in, void* d_out, int out_size, void* d_ws, size_t ws_size, hipStream_t stream) {
    using namespace mk;
    static int grid = 0;
    if (grid == 0) {
        if (n_in != 29 || (size_t)out_size != O_END || ws_size < WS_END) { fprintf(stderr, "kernel_launch: unexpected shapes (n_in %d, out %d, ws %zu)\n", n_in, out_size, ws_size); grid = -1; return; }
        int dev = 0, cus = 0, per_cu = 0;
        if (hipGetDevice(&dev) != hipSuccess || hipDeviceGetAttribute(&cus, hipDeviceAttributeMultiprocessorCount, dev) != hipSuccess) { grid = -1; return; }
        if (hipFuncSetAttribute((const void*)fwd, hipFuncAttributeMaxDynamicSharedMemorySize, LDS_BYTES) != hipSuccess) { fprintf(stderr, "kernel_launch: hipFuncSetAttribute failed\n"); grid = -1; return; }
        if (hipOccupancyMaxActiveBlocksPerMultiprocessor(&per_cu, (const void*)fwd, NTHR, LDS_BYTES) != hipSuccess || per_cu < 1) fprintf(stderr, "kernel_launch: occupancy query says %d\n", per_cu);
        (void)hipGetLastError();
        grid = cus;
    }
    if (grid < 0) return;
    (void)hipMemsetAsync((char*)d_ws + WS_CTL, 0, CTL_ZERO_BYTES, stream);
    Args a{};
    for (int i = 0; i < 29; ++i) a.in[i] = (const float*)d_in[i];
    a.out = (float*)d_out; a.ws = (unsigned char*)d_ws;
#if MK_SPLIT
    for (int p = 0; p < NPHASE; ++p) { a.ph_lo = p; a.ph_hi = p + 1; hipLaunchKernelGGL(fwd, dim3(grid), dim3(NTHR), LDS_BYTES, stream, a); }
#else
    a.ph_lo = 0; a.ph_hi = NPHASE; hipLaunchKernelGGL(fwd, dim3(grid), dim3(NTHR), LDS_BYTES, stream, a);
#endif
}
```

```cpp
#include <hip/hip_runtime.h>
#include <cstdio>
#include <cstdint>
#define GAS __attribute__((address_space(1)))
#define LAS __attribute__((address_space(3)))
namespace pg8 {
#define PG8_LAS __attribute__((address_space(3)))
typedef unsigned short bf16_t;
typedef short bf16x8 __attribute__((ext_vector_type(8)));
typedef float f32x4 __attribute__((ext_vector_type(4)));
typedef unsigned u32x4 __attribute__((ext_vector_type(4)));
constexpr int BM = 256, BK = 64, HALF = 128, HTB = HALF * BK * 2  , STAGE_BYTES = 8 * HTB, NXCD = 8, WGM = 8;

__host__ __device__ __forceinline__ int lds_byte(int r, int c) { const int st = (r >> 4) * 2 + (c >> 5), rr = r & 15, cc = c & 31, ob = rr * 64 + cc * 2; return st * 1024 + (ob ^ (((ob >> 9) & 1) << 5)); }
__host__ __device__ __forceinline__ void stage_rc(int b, int& R, int& C) { const int st = b / 1024, sb = b % 1024, swz = sb ^ (((sb >> 9) & 1) << 5); R = (st >> 1) * 16 + swz / 64; C = (st & 1) * 32 + (swz % 64) / 2; }
__host__ __device__ __forceinline__ int perm32(int rho) { const int n = rho >> 4, i = rho & 15; return 8 * (i >> 2) + 4 * n + (i & 3); }

struct Unit { int pm, pn; };
struct Gemm { const bf16_t* A; const bf16_t* Bt; int M, N, K; };

struct StaticOrder {
    int nM, nN, nwg, G, c;
    __host__ __device__ void init(int M, int N, int G_, int c_) { nM = M / BM; nN = N / BM; nwg = nM * nN; G = G_; c = c_; }
    __host__ __device__ bool next(int i, Unit& u) const {
        const long L = (long)i * G + c; if (L >= nwg) return false;
        int wgid = (int)L; { const int q = nwg / NXCD, r = nwg % NXCD, xcd = wgid % NXCD, off = wgid / NXCD; wgid = (xcd < r ? xcd * (q + 1) : r * (q + 1) + (xcd - r) * q) + off; }
        const int nig = WGM * nN, gid = wgid / nig, fm = gid * WGM, gsz = (nM - fm) < WGM ? (nM - fm) : WGM;
        u.pm = fm + ((wgid % nig) % gsz); u.pn = (wgid % nig) / gsz; return true;
    }
    __device__ __forceinline__ void a_ready(const Unit&) const {}
    __device__ __forceinline__ void done(const Unit&) const {}
};

__device__ __forceinline__ unsigned cvt_pk_bf16(float lo, float hi) { unsigned r; asm volatile("v_cvt_pk_bf16_f32 %0, %1, %2" : "=v"(r) : "v"(lo), "v"(hi)); return r; }

template <class Epi, class Sched, bool ALIGN_EPI = false, bool SP2 = false>
__device__ __forceinline__ void gemm_phase(PG8_LAS unsigned char* lds, const Gemm g, const Sched& S, const Epi& E) {
    const int tid = threadIdx.x, wid = __builtin_amdgcn_readfirstlane(tid >> 6), lane = tid & 63, wr = wid >> 2, wc = wid & 3, fr = lane & 15, fq = lane >> 4;
    const int K = g.K, nt = K / BK;
    unsigned voffA[2], voffB[2];
#pragma unroll
    for (int i = 0; i < 2; ++i) { int R, C; stage_rc(tid * 16 + i * 8192, R, C); const int Rb = Epi::PERM ? ((R & ~31) + perm32(R & 31)) : R;
        voffA[i] = (unsigned)(R * K + C) * 2u; voffB[i] = (unsigned)(Rb * K + C) * 2u; }
    const size_t kstep = (size_t)(BK * 2);
    const size_t hstep = (size_t)HALF * K * 2;
    const size_t tstep = 2 * hstep;
    const unsigned ldsw = (unsigned)wid * 1024u;
    const int aoff = lds_byte(wr * 64 + fr, fq * 8), boff = lds_byte(wc * 32 + fr, fq * 8);
#define PG8_SA(b, h) (((b) * 2 + (h)) * HTB)
#define PG8_SB(b, h) ((4 + (b) * 2 + (h)) * HTB)
#define PG8_STAGE(bufoff, gbase, voff) do { _Pragma("unroll") for (int _i = 0; _i < 2; ++_i) \
        __builtin_amdgcn_global_load_lds((const unsigned*)((const char*)(gbase) + (voff)[_i]), (PG8_LAS unsigned*)(lds + (bufoff) + ldsw + _i * 8192), 16, 0, 0); } while (0)
#define PG8_LDA(dst, b, h) do { _Pragma("unroll") for (int m = 0; m < 4; ++m) _Pragma("unroll") for (int k = 0; k < 2; ++k) dst[m][k] = *(const PG8_LAS bf16x8*)(lds + PG8_SA(b, h) + aoff + m * 2048 + k * 1024); } while (0)
#define PG8_LDB(dst, b, h) do { _Pragma("unroll") for (int n = 0; n < 2; ++n) _Pragma("unroll") for (int k = 0; k < 2; ++k) dst[n][k] = *(const PG8_LAS bf16x8*)(lds + PG8_SB(b, h) + boff + n * 2048 + k * 1024); } while (0)
#define PG8_MMA(ai, bj, At, Bt) do { __builtin_amdgcn_s_setprio(1); _Pragma("unroll") for (int m = 0; m < 4; ++m) _Pragma("unroll") for (int n = 0; n < 2; ++n) _Pragma("unroll") for (int k = 0; k < 2; ++k) \
        acc[ai][bj][m][n] = __builtin_amdgcn_mfma_f32_16x16x32_bf16(Bt[n][k], At[m][k], acc[ai][bj][m][n], 0, 0, 0); __builtin_amdgcn_s_setprio(0); } while (0)
#define PG8_WAIT_V(n) asm volatile("s_waitcnt vmcnt(" #n ")" ::: "memory")
#define PG8_WAIT_L(n) asm volatile("s_waitcnt lgkmcnt(" #n ")" ::: "memory")
#define PG8_BAR __builtin_amdgcn_s_barrier()
#define PG8_SCHED __builtin_amdgcn_sched_barrier(0)
    Unit cur, nxt; int ui = 0;
    if (!S.next(0, cur)) return;
    f32x4 acc[2][2][4][2];
#pragma unroll
    for (int a = 0; a < 2; ++a)
#pragma unroll
        for (int b = 0; b < 2; ++b)
#pragma unroll
            for (int m = 0; m < 4; ++m)
#pragma unroll
                for (int n = 0; n < 2; ++n) acc[a][b][m][n] = (f32x4){0.f, 0.f, 0.f, 0.f};
    bf16x8 At[4][2], B0[2][2], B1[2][2];
    const char* cA = (const char*)g.A + (size_t)cur.pm * tstep; const char* cB = (const char*)g.Bt + (size_t)cur.pn * tstep;
    S.a_ready(cur);
    if constexpr (SP2) {
        PG8_STAGE(PG8_SB(0, 0), cB, voffB); PG8_STAGE(PG8_SB(0, 1), cB + hstep, voffB); PG8_STAGE(PG8_SA(0, 0), cA, voffA); PG8_STAGE(PG8_SA(0, 1), cA + hstep, voffA);
        if (wr == 1) PG8_BAR;
        PG8_WAIT_V(2); PG8_BAR;
        PG8_STAGE(PG8_SB(1, 0), cB + kstep, voffB); PG8_STAGE(PG8_SA(1, 0), cA + kstep, voffA); PG8_STAGE(PG8_SB(1, 1), cB + hstep + kstep, voffB);
        PG8_WAIT_V(6); PG8_BAR;
    } else {
        PG8_STAGE(PG8_SB(0, 0), cB, voffB); PG8_STAGE(PG8_SA(0, 0), cA, voffA); PG8_STAGE(PG8_SB(0, 1), cB + hstep, voffB); PG8_STAGE(PG8_SA(0, 1), cA + hstep, voffA);
        if (wr == 1) PG8_BAR;
        PG8_WAIT_V(4); PG8_BAR;
        PG8_STAGE(PG8_SB(1, 0), cB + kstep, voffB); PG8_STAGE(PG8_SA(1, 0), cA + kstep, voffA); PG8_STAGE(PG8_SB(1, 1), cB + hstep + kstep, voffB);
        PG8_WAIT_V(6); PG8_BAR;
    }
    for (;;) {
        const bool has_next = S.next(ui + 1, nxt);
        const char* nA = has_next ? (const char*)g.A + (size_t)nxt.pm * tstep : cA; const char* nB = has_next ? (const char*)g.Bt + (size_t)nxt.pn * tstep : cB;
        for (int t = 0; t < nt; t += 2) {
            const bool last = (t == nt - 2);
            const char* a1 = cA + (size_t)(t + 1) * kstep;
            const char* a2 = last ? nA : cA + (size_t)(t + 2) * kstep; const char* b2 = last ? nB : cB + (size_t)(t + 2) * kstep;
            const char* a3 = a2 + kstep; const char* b3 = b2 + kstep;
            if (last && has_next) S.a_ready(nxt);
            if constexpr (SP2) {
            PG8_LDB(B0, 0, 0); PG8_LDB(B1, 0, 1); PG8_SCHED; PG8_LDA(At, 0, 0); PG8_STAGE(PG8_SA(1, 1), a1 + hstep, voffA);
            PG8_WAIT_V(8); PG8_WAIT_L(0); PG8_BAR; PG8_MMA(0, 0, At, B0); PG8_MMA(0, 1, At, B1); PG8_BAR; PG8_SCHED;
            PG8_LDA(At, 0, 1); PG8_STAGE(PG8_SB(0, 0), b2, voffB); PG8_STAGE(PG8_SB(0, 1), b2 + hstep, voffB); PG8_STAGE(PG8_SA(0, 0), a2, voffA);
            PG8_WAIT_V(8); PG8_WAIT_L(0); PG8_BAR; PG8_MMA(1, 0, At, B0); PG8_MMA(1, 1, At, B1); PG8_BAR; PG8_SCHED;
            PG8_LDB(B0, 1, 0); PG8_LDB(B1, 1, 1); PG8_SCHED; PG8_LDA(At, 1, 0); PG8_STAGE(PG8_SA(0, 1), a2 + hstep, voffA);
            PG8_WAIT_V(8); PG8_WAIT_L(0); PG8_BAR; PG8_MMA(0, 0, At, B0); PG8_MMA(0, 1, At, B1); PG8_BAR; PG8_SCHED;
            PG8_LDA(At, 1, 1); PG8_STAGE(PG8_SB(1, 0), b3, voffB); PG8_STAGE(PG8_SB(1, 1), b3 + hstep, voffB); PG8_STAGE(PG8_SA(1, 0), a3, voffA);
            PG8_WAIT_V(8); PG8_WAIT_L(0); PG8_BAR; PG8_MMA(1, 0, At, B0); PG8_MMA(1, 1, At, B1); PG8_BAR; PG8_SCHED;
            } else {
            PG8_LDB(B0, 0, 0); PG8_SCHED; PG8_LDA(At, 0, 0); PG8_STAGE(PG8_SA(1, 1), a1 + hstep, voffA);
            PG8_WAIT_L(8); PG8_BAR; PG8_WAIT_L(0); PG8_MMA(0, 0, At, B0); PG8_BAR; PG8_SCHED;
            PG8_LDB(B1, 0, 1); PG8_STAGE(PG8_SB(0, 0), b2, voffB);
            PG8_BAR; PG8_WAIT_L(0); PG8_MMA(0, 1, At, B1); PG8_BAR;
            PG8_LDA(At, 0, 1); PG8_STAGE(PG8_SA(0, 0), a2, voffA);
            PG8_BAR; PG8_WAIT_L(0); PG8_MMA(1, 0, At, B0); PG8_BAR; PG8_SCHED;
            PG8_STAGE(PG8_SB(0, 1), b2 + hstep, voffB);
            PG8_WAIT_V(6); PG8_BAR; PG8_MMA(1, 1, At, B1); PG8_BAR;
            PG8_LDB(B0, 1, 0); PG8_SCHED; PG8_LDA(At, 1, 0); PG8_STAGE(PG8_SA(0, 1), a2 + hstep, voffA);
            PG8_WAIT_L(8); PG8_BAR; PG8_WAIT_L(0); PG8_MMA(0, 0, At, B0); PG8_BAR; PG8_SCHED;
            PG8_LDB(B1, 1, 1); PG8_STAGE(PG8_SB(1, 0), b3, voffB);
            PG8_BAR; PG8_WAIT_L(0); PG8_MMA(0, 1, At, B1); PG8_BAR;
            PG8_LDA(At, 1, 1); PG8_STAGE(PG8_SA(1, 0), a3, voffA);
            PG8_BAR; PG8_WAIT_L(0); PG8_MMA(1, 0, At, B0); PG8_BAR; PG8_SCHED;
            PG8_STAGE(PG8_SB(1, 1), b3 + hstep, voffB);
            PG8_WAIT_V(6); PG8_BAR; PG8_MMA(1, 1, At, B1); PG8_BAR;
            }
        }
        if constexpr (ALIGN_EPI) { if (wr == 0) PG8_BAR; }
        if constexpr (!Epi::AFTER_DRAIN) { E(acc, cur, wr, wc, fr, fq); S.done(cur); }
        if (!has_next) break;
#pragma unroll
        for (int a = 0; a < 2; ++a)
#pragma unroll
            for (int b = 0; b < 2; ++b)
#pragma unroll
                for (int m = 0; m < 4; ++m)
#pragma unroll
                    for (int n = 0; n < 2; ++n) acc[a][b][m][n] = (f32x4){0.f, 0.f, 0.f, 0.f};
        cur = nxt; cA = nA; cB = nB; ++ui;
        if constexpr (ALIGN_EPI) { if (wr == 1) PG8_BAR; }
    }
    PG8_WAIT_V(0);
    if constexpr (!ALIGN_EPI) { if (wr == 0) PG8_BAR; }
    PG8_BAR;
    if constexpr (Epi::AFTER_DRAIN) { E.fused(acc, cur, wr, wc, fr, fq, lds, wid, lane); S.done(cur); }
#undef PG8_SA
#undef PG8_SB
#undef PG8_STAGE
#undef PG8_LDA
#undef PG8_LDB
#undef PG8_MMA
#undef PG8_WAIT_V
#undef PG8_WAIT_L
#undef PG8_BAR
#undef PG8_SCHED
}
}
#define XB_TMO      128
#define XB_XCNT(j)  (256  + 64 * (j))
#define XB_XSUB(j)  (1280 + 64 * (j))
#define XB_XGEN(j)  (2304 + 64 * (j))
#define XB_TOP      3328
#define XB_TOPGEN   3392
#define XCD_BAR_WORDS 3456
#define XB_SPIN_CAP (1u << 18)

__device__ __forceinline__ unsigned xb_ld(unsigned* p)              { return __hip_atomic_load(p, __ATOMIC_RELAXED, __HIP_MEMORY_SCOPE_AGENT); }
__device__ __forceinline__ unsigned xb_add(unsigned* p, unsigned v) { return __hip_atomic_fetch_add(p, v, __ATOMIC_RELAXED, __HIP_MEMORY_SCOPE_AGENT); }
__device__ __forceinline__ unsigned xb_xcc_id() { return (unsigned)__builtin_amdgcn_s_getreg((3 << 11) | 20) & 0xFu; }
#define XB_SPIN(cond, bar) do { unsigned _sp = 0; while (cond) { __builtin_amdgcn_s_sleep(1); \
    if ((++_sp & 255u) == 0u) { if (xb_ld(&(bar)[XB_TMO])) break; if (_sp > XB_SPIN_CAP) { atomicAdd(&(bar)[XB_TMO], 1u); break; } } } } while (0)

struct XcdBarrier {
    unsigned* bar; unsigned x;
    volatile LAS unsigned* st;
};

__device__ __forceinline__ XcdBarrier xcd_barrier_post(unsigned* bar, volatile LAS unsigned* st) {
    XcdBarrier b; b.bar = bar; b.x = xb_xcc_id(); b.st = st;
    if (threadIdx.x == 0) (void)xb_add(&bar[XB_XCNT(b.x)], 1u);
    return b;
}
__device__ __forceinline__ void xcd_barrier_complete(unsigned* bar, unsigned x, unsigned& nloc, unsigned& nx) {
    const unsigned G = gridDim.x * gridDim.y * gridDim.z;
    unsigned sum, cnt, mine, sp = 0u;
    for (;;) {
        sum = 0u; cnt = 0u; mine = 0u;
#pragma unroll
        for (unsigned j = 0; j < 16; ++j) { const unsigned c = xb_ld(&bar[XB_XCNT(j)]); sum += c; cnt += (c > 0u) ? 1u : 0u; mine = (j == x) ? c : mine; }
        if (sum == G) break;
        __builtin_amdgcn_s_sleep(1);
        if ((++sp & 255u) == 0u) { if (xb_ld(&bar[XB_TMO])) break; if (sp > XB_SPIN_CAP) { atomicAdd(&bar[XB_TMO], 1u); break; } }
    }
    nloc = mine > 0u ? mine : 1u; nx = cnt > 0u ? cnt : 1u;
}

__device__ __forceinline__ void xcd_barrier(const XcdBarrier& b) {
    asm volatile("s_waitcnt vmcnt(0)" ::: "memory");
    __syncthreads();
    if (threadIdx.x == 0) {
        unsigned* bar = b.bar;
        __builtin_amdgcn_s_waitcnt(0);
        unsigned nloc = b.st[0], nx = b.st[1];
        if (nloc == 0u) { xcd_barrier_complete(bar, b.x, nloc, nx); b.st[0] = nloc; b.st[1] = nx; }
        const unsigned old = xb_add(&bar[XB_XSUB(b.x)], 1u);
        const unsigned gen = old / nloc;
        if (old + 1u == (gen + 1u) * nloc) {
            __builtin_amdgcn_fence(__ATOMIC_RELEASE, "agent");
            asm volatile("s_waitcnt vmcnt(0)" ::: "memory");
            const unsigned og = xb_add(&bar[XB_TOP], 1u);
            const unsigned tg = og / nx;
            if (og + 1u == (tg + 1u) * nx) xb_add(&bar[XB_TOPGEN], 1u);
            else XB_SPIN(xb_ld(&bar[XB_TOPGEN]) == tg, bar);
            __builtin_amdgcn_fence(__ATOMIC_ACQUIRE, "agent");
            xb_add(&bar[XB_XGEN(b.x)], 1u);
            asm volatile("s_waitcnt vmcnt(0)" ::: "memory");
        } else {
            XB_SPIN(xb_ld(&bar[XB_XGEN(b.x)]) == gen, bar);
            __builtin_amdgcn_fence(__ATOMIC_ACQUIRE, "agent");
            asm volatile("s_waitcnt vmcnt(0)" ::: "memory");
        }
    }
    __syncthreads();
}
namespace mk {
using pg8::bf16_t; using pg8::bf16x8; using pg8::f32x4; using pg8::u32x4;
typedef unsigned u32x2 __attribute__((ext_vector_type(2)));

#ifndef MK_CHECK_ATT
#define MK_CHECK_ATT 0
#endif
#define MK_REP_SSDP 1
#define MK_REP_SSDS 1
#define MK_REP_ATTS 1
#define MK_REP_ATTP 1
#define MK_CHECK_TOL 0.02f
#define MK_CHECK_CODE ((b0 ? 1.f : 0.f) + (b1 ? 2.f : 0.f) + (b2 ? 4.f : 0.f) + (b3 ? 8.f : 0.f) + (b4 ? 16.f : 0.f) + (b5 ? 32.f : 0.f))
#define MK_REP_MASK 0
#define DUPK(k) (((MK_REP_MASK >> (k)) & 1) != 0)
#define REPK(k) for (int rep_ = 0; rep_ < 1 + ((MK_REP_MASK >> (k)) & 1); ++rep_)
#ifndef MK_SPLIT
#define MK_SPLIT 0
#endif

constexpr int NWAVES = 8, NTHR = 512;
constexpr int MP = 16384, MS = 512, M = MP + MS, D = 1024, DFF = 2816, DI = 2048, NP = 9472, XCW = 3072;
constexpr int PZ = 0, PXBC = 2048, PSM = 5120, PQ = 5376, PK = 6400, PV = 6656, PQI = 6912, PG = 7424;
constexpr int SCW = 2048, SCSW = 2112;
constexpr size_t O_Y = 0, O_KP = 17301504, O_VP = 21495808, O_KIP = 25690112, O_CVP = 26738688, O_SSP = 26812416,
                 O_KS = 28909568, O_VS = 29040640, O_KIS = 29171712, O_CVS = 29204480, O_SSS = 30384128, O_END = 63938560;
constexpr size_t MiB = 1u << 20;
constexpr size_t WS_CTL = 0, CTL_ZERO_BYTES = 1 * MiB;
constexpr size_t WS_W1A = 1 * MiB, WS_W1B = WS_W1A + 11 * MiB, WS_WIN = WS_W1B + 6 * MiB, WS_WBS = WS_WIN + 19 * MiB, WS_WBA = WS_WBS + 4 * MiB,
                 WS_WOUT = WS_WBA + 2 * MiB, WS_W2A = WS_WOUT + 2 * MiB, WS_W2B = WS_W2A + 11 * MiB;
constexpr size_t WS_XB = WS_W2B + 6 * MiB, WS_ACT = WS_XB + 33 * MiB, WS_T = WS_ACT + 91 * MiB, WS_HF = WS_T + 66 * MiB, WS_HB = WS_HF + 66 * MiB,
                 WS_P = WS_HB + 33 * MiB, WS_SMF = WS_P + 306 * MiB, WS_XC = WS_SMF + 9 * MiB, WS_Y = WS_XC + 99 * MiB, WS_SC = WS_Y + 66 * MiB,
                 WS_SCS = WS_SC + 128 * MiB, WS_YA = WS_SCS + 5 * MiB, WS_MG = WS_YA + 33 * MiB, WS_END = WS_MG + 33 * MiB;
constexpr int CW_BAR = 4096;
constexpr int LDS_BYTES = 163840, MISC_OFF = LDS_BYTES - 256;
constexpr int WAREA = 17920;
constexpr int BIASREL_OFF = NWAVES * WAREA;
static_assert(BIASREL_OFF + 2 * 129 * 16 * 4 <= MISC_OFF, "LDS map");

constexpr float ALPHA = 1.18920711500272f;
constexpr float LN_EPS = 1e-5f;

struct Args { const float* in[29]; float* out; unsigned char* ws; int ph_lo, ph_hi; };
enum { I_XP = 0, I_XS, I_CK, I_CV, I_CKI, I_SCONV, I_SSSM, I_PT, I_BIAS, I_WIN, I_CONVW, I_CONVB, I_DTB, I_ALOG, I_DSKIP, I_NORMG, I_WBS, I_WBA, I_WOUT,
       I_F1WI, I_F1WO, I_F2WI, I_F2WO, I_LN1G, I_LN1B, I_LN2G, I_LN2B, I_LN3G, I_LN3B };

__device__ __forceinline__ float bf2f(unsigned v) { return __uint_as_float(v << 16); }
__device__ __forceinline__ unsigned f2bf(float f) { unsigned u = __float_as_uint(f); return (u + 0x7fffu + ((u >> 16) & 1u)) >> 16; }
__device__ __forceinline__ unsigned pk2(float lo, float hi) { return pg8::cvt_pk_bf16(lo, hi); }
__device__ __forceinline__ void unpack8(const u32x4 w, float (&f)[8]) {
#pragma unroll
    for (int i = 0; i < 4; ++i) { f[2 * i] = __uint_as_float(w[i] << 16); f[2 * i + 1] = __uint_as_float(w[i] & 0xffff0000u); }
}
__device__ __forceinline__ u32x4 pack8(const float (&f)[8]) { u32x4 w; w.x = pk2(f[0], f[1]); w.y = pk2(f[2], f[3]); w.z = pk2(f[4], f[5]); w.w = pk2(f[6], f[7]); return w; }
__device__ __forceinline__ float sigmoidf_(float x) { return 1.0f / (1.0f + __expf(-x)); }
__device__ __forceinline__ float siluf_(float x) { return x / (1.0f + __expf(-x)); }
__device__ __forceinline__ float wave_sum(float v) {
#pragma unroll
    for (int o = 1; o < 64; o <<= 1) v += __shfl_xor(v, o);
    return v;
}
__device__ __forceinline__ float wave_max(float v) {
#pragma unroll
    for (int o = 1; o < 64; o <<= 1) v = fmaxf(v, __shfl_xor(v, o));
    return v;
}
__device__ __forceinline__ f32x4 mfma16(bf16x8 a, bf16x8 b, f32x4 c) { return __builtin_amdgcn_mfma_f32_16x16x32_bf16(a, b, c, 0, 0, 0); }
__device__ __forceinline__ int mbcnt64(unsigned long long m) { return (int)__builtin_amdgcn_mbcnt_hi((unsigned)(m >> 32), __builtin_amdgcn_mbcnt_lo((unsigned)m, 0u)); }

struct EpiSwiglu {
    static constexpr bool PERM = true, AFTER_DRAIN = false;
    bf16_t* O;
    __device__ __forceinline__ void operator()(const f32x4 (&acc)[2][2][4][2], const pg8::Unit& u, int wr, int wc, int fr, int fq) const {
        const int row0 = u.pm * 256 + wr * 64 + fr, col0 = u.pn * 128 + wc * 32 + 8 * fq;
#pragma unroll
        for (int ai = 0; ai < 2; ++ai)
#pragma unroll
            for (int m = 0; m < 4; ++m) {
                float o[8];
#pragma unroll
                for (int n = 0; n < 2; ++n)
#pragma unroll
                    for (int j = 0; j < 4; ++j) { const float g = acc[ai][0][m][n][j], up = acc[ai][1][m][n][j]; o[4 * n + j] = siluf_(g) * up; }
                *(u32x4*)(O + (size_t)(row0 + ai * 128 + m * 16) * DFF + col0) = pack8(o);
            }
    }
};
struct EpiResid {
    static constexpr bool PERM = false, AFTER_DRAIN = false;
    const float* base_p; const float* base_s; float* T; float alpha, s;
    __device__ __forceinline__ void operator()(const f32x4 (&acc)[2][2][4][2], const pg8::Unit& u, int wr, int wc, int fr, int fq) const {
        const int row0 = u.pm * 256 + wr * 64 + fr, col0 = u.pn * 256 + wc * 32 + 4 * fq;
#pragma unroll
        for (int ai = 0; ai < 2; ++ai)
#pragma unroll
            for (int m = 0; m < 4; ++m) {
                const int r = row0 + ai * 128 + m * 16;
                const float* b = (r < MP) ? base_p + (size_t)r * D : base_s + (size_t)(r - MP) * D;
#pragma unroll
                for (int bj = 0; bj < 2; ++bj)
#pragma unroll
                    for (int n = 0; n < 2; ++n) { const int c = col0 + bj * 128 + n * 16; const f32x4 bv = *(const f32x4*)(b + c);
                        *(f32x4*)(T + (size_t)r * D + c) = bv * alpha + acc[ai][bj][m][n] * s; }
            }
    }
};
struct EpiWin {
    static constexpr bool PERM = true, AFTER_DRAIN = false;
    bf16_t* P; float* smf; float* out;
    __device__ __forceinline__ void operator()(const f32x4 (&acc)[2][2][4][2], const pg8::Unit& u, int wr, int wc, int fr, int fq) const {
        const int row0 = u.pm * 256 + wr * 64 + fr, cl = wc * 32 + 8 * fq, col0 = u.pn * 256 + cl;
#pragma unroll
        for (int ai = 0; ai < 2; ++ai)
#pragma unroll
            for (int m = 0; m < 4; ++m) {
                const int r = row0 + ai * 128 + m * 16;
#pragma unroll
                for (int bj = 0; bj < 2; ++bj) {
                    const f32x4 v0 = acc[ai][bj][m][0], v1 = acc[ai][bj][m][1];
                    u32x4 w; w.x = pk2(v0[0], v0[1]); w.y = pk2(v0[2], v0[3]); w.z = pk2(v1[0], v1[1]); w.w = pk2(v1[2], v1[3]);
                    *(u32x4*)(P + (size_t)r * NP + col0 + bj * 128) = w;
                    if (u.pn == 20) {
                        if (bj == 0) {
                            float* d = smf + (size_t)r * 128 + cl; *(f32x4*)d = v0; *(f32x4*)(d + 4) = v1;
                            if (cl >= 64) { float* k = out + ((r < MP) ? O_KIP + (size_t)r * 64 : O_KIS + (size_t)(r - MP) * 64) + (cl - 64); *(f32x4*)k = v0; *(f32x4*)(k + 4) = v1; }
                        }
                    } else if (u.pn == 25) {
                        float* k = out + ((r < MP) ? O_KP + (size_t)r * 256 : O_KS + (size_t)(r - MP) * 256) + bj * 128 + cl; *(f32x4*)k = v0; *(f32x4*)(k + 4) = v1;
                    } else if (u.pn == 26) {
                        float* k = out + ((r < MP) ? O_VP + (size_t)r * 256 : O_VS + (size_t)(r - MP) * 256) + bj * 128 + cl; *(f32x4*)k = v0; *(f32x4*)(k + 4) = v1;
                    }
                }
            }
    }
};
struct EpiGateA {
    static constexpr bool PERM = false, AFTER_DRAIN = false;
    const bf16_t* P; int gcol; float* M1;
    __device__ __forceinline__ void operator()(const f32x4 (&acc)[2][2][4][2], const pg8::Unit& u, int wr, int wc, int fr, int fq) const {
        const int row0 = u.pm * 256 + wr * 64 + fr, col0 = u.pn * 256 + wc * 32 + 4 * fq;
#pragma unroll
        for (int ai = 0; ai < 2; ++ai)
#pragma unroll
            for (int m = 0; m < 4; ++m) {
                const int r = row0 + ai * 128 + m * 16;
#pragma unroll
                for (int bj = 0; bj < 2; ++bj)
#pragma unroll
                    for (int n = 0; n < 2; ++n) { const int c = col0 + bj * 128 + n * 16; const u32x2 gw = *(const u32x2*)(P + (size_t)r * NP + gcol + c);
                        f32x4 g; g[0] = sigmoidf_(__uint_as_float(gw.x << 16)); g[1] = sigmoidf_(__uint_as_float(gw.x & 0xffff0000u)); g[2] = sigmoidf_(__uint_as_float(gw.y << 16)); g[3] = sigmoidf_(__uint_as_float(gw.y & 0xffff0000u));
                        *(f32x4*)(M1 + (size_t)r * D + c) = g * acc[ai][bj][m][n]; }
            }
    }
};
struct EpiGateS {
    static constexpr bool PERM = true, AFTER_DRAIN = false;
    const bf16_t* P; int gcol; const float* M1; bf16_t* MG;
    __device__ __forceinline__ void operator()(const f32x4 (&acc)[2][2][4][2], const pg8::Unit& u, int wr, int wc, int fr, int fq) const {
        const int row0 = u.pm * 256 + wr * 64 + fr, col0 = u.pn * 256 + wc * 32 + 8 * fq;
#pragma unroll
        for (int ai = 0; ai < 2; ++ai)
#pragma unroll
            for (int m = 0; m < 4; ++m) {
                const int r = row0 + ai * 128 + m * 16;
#pragma unroll
                for (int bj = 0; bj < 2; ++bj) { const int c = col0 + bj * 128;
                    const u32x4 gw = *(const u32x4*)(P + (size_t)r * NP + gcol + c); float g[8]; unpack8(gw, g);
                    const f32x4 m0 = *(const f32x4*)(M1 + (size_t)r * D + c), m1 = *(const f32x4*)(M1 + (size_t)r * D + c + 4);
                    float o[8];
#pragma unroll
                    for (int j = 0; j < 4; ++j) { o[j] = m0[j] + sigmoidf_(g[j]) * acc[ai][bj][m][0][j]; o[4 + j] = m1[j] + sigmoidf_(g[4 + j]) * acc[ai][bj][m][1][j]; }
                    *(u32x4*)(MG + (size_t)r * D + c) = pack8(o); }
            }
    }
};

__device__ __forceinline__ void tr_item(const float* W, int K, int Nsrc, bf16_t* WT, int k0, int drow0, int scol0, int nvalid, LAS float* scr, int lane) {
    const int c = lane & 31;
#pragma unroll 8
    for (int i = 0; i < 32; ++i) { const int kk = 2 * i + (lane >> 5); float v = 0.f; if (c < nvalid) v = W[(size_t)(k0 + kk) * Nsrc + scol0 + c]; scr[kk * 33 + c] = v; }
    asm volatile("s_waitcnt lgkmcnt(0)" ::: "memory");
    const int cc = lane & 7;
#pragma unroll
    for (int j = 0; j < 4; ++j) { const int n = (lane >> 3) + 8 * j; const LAS float* s = scr + (8 * cc) * 33 + n;
        u32x4 o; o.x = pk2(s[0 * 33], s[1 * 33]); o.y = pk2(s[2 * 33], s[3 * 33]); o.z = pk2(s[4 * 33], s[5 * 33]); o.w = pk2(s[6 * 33], s[7 * 33]);
        *(u32x4*)(WT + (size_t)(drow0 + n) * K + k0 + 8 * cc) = o; }
    asm volatile("s_waitcnt lgkmcnt(0)" ::: "memory");
}
__device__ __forceinline__ void tr_map(int mode, int n0, int& scol0, int& nvalid) {
    nvalid = 32;
    if (mode == 0) { scol0 = n0; }
    else if (mode == 1) { const int j = n0 >> 8, i = n0 & 255; scol0 = (i < 128) ? j * 128 + i : DFF + j * 128 + (i - 128); }
    else {
        if (n0 < 5120) scol0 = n0;
        else if (n0 < 5376) { const int j = n0 - 5120;
            if (j == 0) scol0 = 5120;
            else if (j == 32) { scol0 = 7264; nvalid = 8; }
            else if (j == 64 || j == 96) scol0 = 7200 + (j - 64);
            else { scol0 = 0; nvalid = 0; } }
        else if (n0 < 6400) scol0 = 5152 + (n0 - 5376);
        else if (n0 < 6656) scol0 = 6176 + (n0 - 6400);
        else if (n0 < 6912) scol0 = 6432 + (n0 - 6656);
        else if (n0 < 7424) scol0 = 6688 + (n0 - 6912);
        else scol0 = 7272 + (n0 - 7424);
    }
}
__device__ __forceinline__ void p0_prologue(const Args& A, LAS unsigned char* lds, int gw, int NGW, int wave, int lane) {
    LAS float* scr = (LAS float*)(lds + wave * 16384);
    unsigned char* ws = A.ws;
    constexpr int NI0 = 16 * 176, NI1 = 44 * 32, NI2 = 16 * 296, NI3 = 32 * 32, NI4 = 16 * 32, NI5 = 16 * 32, NI6 = NI0, NI7 = NI1;
    constexpr int NIT = NI0 + NI1 + NI2 + NI3 + NI4 + NI5 + NI6 + NI7;
    for (int it = gw; it < NIT; it += NGW) {
        int r = it; const float* W; bf16_t* WT; int K, Nsrc, nblk, mode;
        if (r < NI0) { W = A.in[I_F1WI]; WT = (bf16_t*)(ws + WS_W1A); K = 1024; Nsrc = 2 * DFF; nblk = 176; mode = 1; }
        else if ((r -= NI0) < NI1) { W = A.in[I_F1WO]; WT = (bf16_t*)(ws + WS_W1B); K = DFF; Nsrc = 1024; nblk = 32; mode = 0; }
        else if ((r -= NI1) < NI2) { W = A.in[I_WIN]; WT = (bf16_t*)(ws + WS_WIN); K = 1024; Nsrc = 9320; nblk = 296; mode = 2; }
        else if ((r -= NI2) < NI3) { W = A.in[I_WBS]; WT = (bf16_t*)(ws + WS_WBS); K = 2048; Nsrc = 1024; nblk = 32; mode = 0; }
        else if ((r -= NI3) < NI4) { W = A.in[I_WBA]; WT = (bf16_t*)(ws + WS_WBA); K = 1024; Nsrc = 1024; nblk = 32; mode = 0; }
        else if ((r -= NI4) < NI5) { W = A.in[I_WOUT]; WT = (bf16_t*)(ws + WS_WOUT); K = 1024; Nsrc = 1024; nblk = 32; mode = 0; }
        else if ((r -= NI5) < NI6) { W = A.in[I_F2WI]; WT = (bf16_t*)(ws + WS_W2A); K = 1024; Nsrc = 2 * DFF; nblk = 176; mode = 1; }
        else { r -= NI6; W = A.in[I_F2WO]; WT = (bf16_t*)(ws + WS_W2B); K = DFF; Nsrc = 1024; nblk = 32; mode = 0; }
        const int kb = r / nblk, nb = r % nblk; int scol0, nvalid; tr_map(mode, nb * 32, scol0, nvalid);
        tr_item(W, K, Nsrc, WT, kb * 64, nb * 32, scol0, nvalid, scr, lane);
    }
    bf16_t* XB = (bf16_t*)(ws + WS_XB);
    const int nchunk = M * D / 8;
    for (int ch = gw * 64 + lane; ch < nchunk; ch += NGW * 64) {
        const int m = ch >> 7, c = (ch & 127) * 8;
        const float* src = (m < MP) ? A.in[I_XP] + (size_t)m * D + c : A.in[I_XS] + (size_t)(m - MP) * D + c;
        const f32x4 a = *(const f32x4*)src, b = *(const f32x4*)(src + 4);
        u32x4 w; w.x = pk2(a[0], a[1]); w.y = pk2(a[2], a[3]); w.z = pk2(b[0], b[1]); w.w = pk2(b[2], b[3]);
        *(u32x4*)(XB + (size_t)m * D + c) = w;
    }
}

__device__ __forceinline__ void ln_phase(const float* T, const float* g, const float* b, float* outf, bf16_t* outb, int gw, int NGW, int lane) {
    f32x4 gv[4], bv[4];
#pragma unroll
    for (int j = 0; j < 4; ++j) { gv[j] = *(const f32x4*)(g + 4 * lane + 256 * j); bv[j] = *(const f32x4*)(b + 4 * lane + 256 * j); }
    for (int m = gw; m < M; m += NGW) {
        const float* xr = T + (size_t)m * D + 4 * lane;
        f32x4 v[4]; float s = 0.f;
#pragma unroll
        for (int j = 0; j < 4; ++j) { v[j] = *(const f32x4*)(xr + 256 * j); s += (v[j][0] + v[j][1]) + (v[j][2] + v[j][3]); }
        const float mean = wave_sum(s) * (1.f / D); float s2 = 0.f;
#pragma unroll
        for (int j = 0; j < 4; ++j) { v[j] = v[j] - mean; s2 += (v[j][0] * v[j][0] + v[j][1] * v[j][1]) + (v[j][2] * v[j][2] + v[j][3] * v[j][3]); }
        const float rstd = 1.0f / sqrtf(wave_sum(s2) * (1.f / D) + LN_EPS);
#pragma unroll
        for (int j = 0; j < 4; ++j) {
            const f32x4 o = v[j] * rstd * gv[j] + bv[j];
            *(f32x4*)(outf + (size_t)m * D + 4 * lane + 256 * j) = o;
            if (outb) { u32x2 w; w.x = pk2(o[0], o[1]); w.y = pk2(o[2], o[3]); *(u32x2*)(outb + (size_t)m * D + 4 * lane + 256 * j) = w; }
        }
    }
}

__device__ __forceinline__ void conv_phase(const Args& A) {
    const bf16_t* P = (const bf16_t*)(A.ws + WS_P); bf16_t* XC = (bf16_t*)(A.ws + WS_XC);
    const float* cw = A.in[I_CONVW]; const float* cb = A.in[I_CONVB]; const float* sconv = A.in[I_SCONV];
    const long total = (long)M * 384, stride = (long)gridDim.x * NTHR;
    for (long it = (long)blockIdx.x * NTHR + threadIdx.x; it < total; it += stride) {
        const int m = (int)(it / 384), ch = (int)(it % 384) * 8;
        const bool samp = m >= MP; int b, t;
        if (!samp) { b = m >> 11; t = m & 2047; } else { const int ms = m - MP; b = ms >> 2; t = ms & 3; }
        float acc[8], cur[8];
        { const f32x4 b0 = *(const f32x4*)(cb + ch), b1 = *(const f32x4*)(cb + ch + 4);
#pragma unroll
          for (int i = 0; i < 4; ++i) { acc[i] = b0[i]; acc[4 + i] = b1[i]; } }
#pragma unroll
        for (int j = 0; j < 4; ++j) {
            const int tau = t - 3 + j; float uu[8];
            if (tau >= 0) { const u32x4 w = *(const u32x4*)(P + (size_t)(m - 3 + j) * NP + PXBC + ch); unpack8(w, uu); }
            else if (samp) { const float* s = sconv + ((size_t)b * 3 + (3 + tau)) * XCW + ch; const f32x4 s0 = *(const f32x4*)s, s1 = *(const f32x4*)(s + 4);
#pragma unroll
                for (int i = 0; i < 4; ++i) { uu[i] = s0[i]; uu[4 + i] = s1[i]; } }
            else {
#pragma unroll
                for (int i = 0; i < 8; ++i) uu[i] = 0.f; }
            const f32x4 w0 = *(const f32x4*)(cw + (size_t)j * XCW + ch), w1 = *(const f32x4*)(cw + (size_t)j * XCW + ch + 4);
#pragma unroll
            for (int i = 0; i < 4; ++i) { acc[i] += w0[i] * uu[i]; acc[4 + i] += w1[i] * uu[4 + i]; }
            if (j == 3) {
#pragma unroll
                for (int i = 0; i < 8; ++i) cur[i] = uu[i]; }
        }
        float o[8];
#pragma unroll
        for (int i = 0; i < 8; ++i) o[i] = siluf_(acc[i]);
        *(u32x4*)(XC + (size_t)m * XCW + ch) = pack8(o);
        float* cs = nullptr;
        if (!samp) { if (t >= 2045) cs = A.out + O_CVP + ((size_t)b * 3 + (t - 2045)) * XCW + ch; }
        else { if (t >= 1) cs = A.out + O_CVS + ((size_t)b * 3 + (t - 1)) * XCW + ch; }
        if (cs) { f32x4 c0, c1;
#pragma unroll
            for (int i = 0; i < 4; ++i) { c0[i] = cur[i]; c1[i] = cur[4 + i]; }
            *(f32x4*)cs = c0; *(f32x4*)(cs + 4) = c1; }
    }
}

constexpr float IDX_SCALE = 0.125f * 0.35355339059327373f;
constexpr int SCL = 2052;
__device__ __forceinline__ unsigned f2key(float v) { unsigned u = (v == 0.f) ? 0u : __float_as_uint(v); return (u & 0x80000000u) ? ~u : (u | 0x80000000u); }
__device__ __forceinline__ void scores_select_prompt_unit(const Args& A, LAS unsigned char* lds, int b, int qt, int wave, int lane_in) {
    const bf16_t* P = (const bf16_t*)(A.ws + WS_P); const float* SMF = (const float*)(A.ws + WS_SMF);
    unsigned long long* MASKW = (unsigned long long*)(A.ws + WS_SC);
    LAS float* sc = (LAS float*)lds;
    int lane = lane_in; asm volatile("" : "+v"(lane));
    const int fr = lane & 15, fq = lane >> 4;
    {
        const size_t rowq = (size_t)(b * 2048 + qt * 16 + fr);
        bf16x8 Af[8][2];
#pragma unroll
        for (int h = 0; h < 8; ++h)
#pragma unroll
            for (int ks = 0; ks < 2; ++ks) Af[h][ks] = *(const bf16x8*)(P + rowq * NP + PQI + h * 64 + ks * 32 + 8 * fq);
        float wq[4][8];
#pragma unroll
        for (int j = 0; j < 4; ++j) { const float* wp = SMF + (size_t)(b * 2048 + qt * 16 + 4 * fq + j) * 128 + 32; const f32x4 w0 = *(const f32x4*)wp, w1 = *(const f32x4*)(wp + 4);
#pragma unroll
            for (int h = 0; h < 4; ++h) { wq[j][h] = w0[h] * IDX_SCALE; wq[j][4 + h] = w1[h] * IDX_SCALE; } }
        for (int kt = wave; kt <= qt; kt += NWAVES) {
            const size_t rowk = (size_t)(b * 2048 + kt * 16 + fr);
            const bf16x8 B0 = *(const bf16x8*)(P + rowk * NP + PSM + 64 + 8 * fq), B1 = *(const bf16x8*)(P + rowk * NP + PSM + 96 + 8 * fq);
            f32x4 scv = {0.f, 0.f, 0.f, 0.f};
#pragma unroll
            for (int h = 0; h < 8; ++h) { f32x4 d = {0.f, 0.f, 0.f, 0.f}; d = mfma16(Af[h][0], B0, d); d = mfma16(Af[h][1], B1, d);
#pragma unroll
                for (int j = 0; j < 4; ++j) scv[j] += wq[j][h] * fmaxf(d[j], 0.f); }
#pragma unroll
            for (int j = 0; j < 4; ++j) sc[(4 * fq + j) * SCL + kt * 16 + fr] = scv[j];
#if MK_CHECK_ATT
#pragma unroll
            for (int j = 0; j < 4; ++j) ((float*)(A.ws + WS_END))[(size_t)(b * 2048 + qt * 16 + 4 * fq + j) * SCW + kt * 16 + fr] = scv[j];
#endif
        }
    }
    __syncthreads();
#pragma unroll 1
    for (int u = 0; u < 2; ++u) {
        const int ql = 2 * wave + u, t = qt * 16 + ql, nvalid = t + 1;
        const LAS float* srow = sc + ql * SCL + lane;
        unsigned key[32];
#pragma unroll
        for (int j = 0; j < 32; ++j) key[j] = (lane < nvalid - 64 * j) ? f2key(srow[64 * j]) : 0u;
        unsigned T = 0u; int need_eq = 0;
        if (nvalid > 256) {
            bool exact = false;
            for (int bit = 31; bit >= 0; --bit) {
                const unsigned cand = T | (1u << bit); int cnt = 0;
#pragma unroll
                for (int j = 0; j < 32; ++j) if (64 * j < nvalid) cnt += __popcll(__ballot(key[j] >= cand));
                if (cnt >= 256) { T = cand; if (cnt == 256) { exact = true; break; } }
            }
            if (exact) { T -= 1u; }
            else { int cgt = 0;
#pragma unroll
                for (int j = 0; j < 32; ++j) if (64 * j < nvalid) cgt += __popcll(__ballot(key[j] > T));
                need_eq = 256 - cgt; }
        }
        int eqused = 0; unsigned long long mine = 0ull;
#pragma unroll
        for (int j = 0; j < 32; ++j) {
            unsigned long long ms = 0ull;
            if (64 * j < nvalid) {
                const bool gt = key[j] > T, eq = (need_eq > 0) && (key[j] == T);
                const unsigned long long meq = __ballot(eq);
                const bool sel = gt || (eq && (eqused + mbcnt64(meq) < need_eq));
                eqused += __popcll(meq);
                ms = __ballot(sel);
            }
            if (lane == j) mine = ms;
        }
        if (lane < 32) MASKW[(size_t)(b * 2048 + t) * 32 + lane] = mine;
    }
    __syncthreads();
}
__device__ __forceinline__ void scores_sample_unit(const Args& A, int b, int half, int wave, int lane) {
    const bf16_t* P = (const bf16_t*)(A.ws + WS_P); const float* SMF = (const float*)(A.ws + WS_SMF); float* SCS = (float*)(A.ws + WS_SCS);
    const int* pt = (const int*)A.in[I_PT]; const float* cki = A.in[I_CKI];
    const int fr = lane & 15, fq = lane >> 4;
    bf16x8 Af[2][2]; float wq[2][4];
#pragma unroll
    for (int mt = 0; mt < 2; ++mt) {
#pragma unroll
        for (int ks = 0; ks < 2; ++ks) Af[mt][ks] = *(const bf16x8*)(P + (size_t)(MP + b * 4 + 2 * mt + (fr >> 3)) * NP + PQI + (fr & 7) * 64 + ks * 32 + 8 * fq);
        const f32x4 w = *(const f32x4*)(SMF + (size_t)(MP + b * 4 + 2 * mt + (fq >> 1)) * 128 + 32 + 4 * (fq & 1));
#pragma unroll
        for (int j = 0; j < 4; ++j) wq[mt][j] = w[j] * IDX_SCALE;
    }
    const int kt_end = (half == 0) ? 65 : 129;
    for (int kt = half * 65 + wave; kt < kt_end; kt += NWAVES) {
        const int key = kt * 16 + fr;
        bf16x8 B0, B1;
        if (key < 2048) {
            const int page = pt[b * 16 + (key >> 7)];
            const float* src = cki + ((size_t)page * 128 + (key & 127)) * 64 + 8 * fq;
            const f32x4 a0 = *(const f32x4*)src, a1 = *(const f32x4*)(src + 4), c0 = *(const f32x4*)(src + 32), c1 = *(const f32x4*)(src + 36);
            u32x4 w0, w1; w0.x = pk2(a0[0], a0[1]); w0.y = pk2(a0[2], a0[3]); w0.z = pk2(a1[0], a1[1]); w0.w = pk2(a1[2], a1[3]);
            w1.x = pk2(c0[0], c0[1]); w1.y = pk2(c0[2], c0[3]); w1.z = pk2(c1[0], c1[1]); w1.w = pk2(c1[2], c1[3]);
            B0 = __builtin_bit_cast(bf16x8, w0); B1 = __builtin_bit_cast(bf16x8, w1);
        } else if (key < 2052) {
            const bf16_t* src = P + (size_t)(MP + b * 4 + (key - 2048)) * NP + PSM + 64 + 8 * fq;
            B0 = *(const bf16x8*)src; B1 = *(const bf16x8*)(src + 32);
        } else { B0 = (bf16x8){0, 0, 0, 0, 0, 0, 0, 0}; B1 = B0; }
#pragma unroll
        for (int mt = 0; mt < 2; ++mt) {
            f32x4 d = {0.f, 0.f, 0.f, 0.f}; d = mfma16(Af[mt][0], B0, d); d = mfma16(Af[mt][1], B1, d);
            float s = 0.f;
#pragma unroll
            for (int j = 0; j < 4; ++j) s += wq[mt][j] * fmaxf(d[j], 0.f);
            s += __shfl_xor(s, 16);
            if ((fq & 1) == 0 && key < 2052) SCS[(size_t)(b * 4 + 2 * mt + (fq >> 1)) * SCSW + key] = s;
        }
    }
}

__device__ __forceinline__ float softplusf_(float x) { return fmaxf(x, 0.f) + log1pf(expf(-fabsf(x))); }
__device__ __forceinline__ void ssd_prompt_item(const Args& A, LAS unsigned char* lds, int b, int h) {
    const int tid = threadIdx.x, lane = tid & 63, wave = __builtin_amdgcn_readfirstlane(tid >> 6), fr = lane & 15, fq = lane >> 4;
    const int g = h >> 3;
    const bf16_t* XC = (const bf16_t*)(A.ws + WS_XC); const float* SMF = (const float*)(A.ws + WS_SMF); bf16_t* Y = (bf16_t*)(A.ws + WS_Y);
    LAS bf16_t* Cm = (LAS bf16_t*)lds;
    LAS bf16_t* Bm = Cm + 64 * 136;
    LAS bf16_t* Btw = Bm + 64 * 136;
    LAS bf16_t* Xt = Btw + 128 * 72;
    LAS bf16_t* Mt = Xt + 64 * 72;
    LAS bf16_t* Hp = Mt + 64 * 72;
    LAS float* cum = (LAS float*)(Hp + 64 * 136);
    LAS float* dtv = cum + 64; LAS float* wv = dtv + 64; LAS float* ecum = wv + 64;
    const float Ah = -expf(A.in[I_ALOG][h]), dtb = A.in[I_DTB][h], dsk = A.in[I_DSKIP][h];
    f32x4 hst[4];
#pragma unroll
    for (int i = 0; i < 4; ++i) hst[i] = (f32x4){0.f, 0.f, 0.f, 0.f};
    for (int i = tid; i < 64 * 136 / 8; i += NTHR) *(LAS u32x4*)(Hp + i * 8) = (u32x4){0u, 0u, 0u, 0u};
    const int s0 = tid >> 4, part0 = tid & 15;
    const int xs = tid >> 3, xpart = tid & 7;
    for (int c = 0; c < 32; ++c) {
        const int row0 = b * 2048 + c * 64;
        u32x4 cr[2], br[2];
#pragma unroll
        for (int i = 0; i < 2; ++i) { const bf16_t* rp = XC + (size_t)(row0 + s0 + 32 * i) * XCW + g * 128 + part0 * 8; cr[i] = *(const u32x4*)(rp + 2560); br[i] = *(const u32x4*)(rp + 2048); }
        const u32x4 xr = *(const u32x4*)(XC + (size_t)(row0 + xs) * XCW + h * 64 + xpart * 8);
        if (wave == 0) {
            const float dt = softplusf_(SMF[(size_t)(row0 + lane) * 128 + h] + dtb);
            float v = dt * Ah;
#pragma unroll
            for (int o = 1; o < 64; o <<= 1) { const float n = __shfl_up(v, o); if (lane >= o) v += n; }
            const float ce = __shfl(v, 63);
            cum[lane] = v; dtv[lane] = dt; wv[lane] = dt * expf(ce - v); ecum[lane] = expf(v);
        }
        __syncthreads();
#pragma unroll
        for (int i = 0; i < 2; ++i) {
            const int s = s0 + 32 * i;
            *(LAS u32x4*)(Cm + s * 136 + part0 * 8) = cr[i];
            *(LAS u32x4*)(Bm + s * 136 + part0 * 8) = br[i];
            float bf[8]; unpack8(br[i], bf); const float w = wv[s];
#pragma unroll
            for (int e = 0; e < 8; ++e) Btw[(part0 * 8 + e) * 72 + s] = (bf16_t)f2bf(bf[e] * w);
        }
        {
#pragma unroll
            for (int e = 0; e < 4; ++e) { Xt[(xpart * 8 + 2 * e) * 72 + xs] = (bf16_t)(xr[e] & 0xffffu); Xt[(xpart * 8 + 2 * e + 1) * 72 + xs] = (bf16_t)(xr[e] >> 16); }
        }
        __syncthreads();
        {
            const int st = wave >> 1, tt0 = 2 * (wave & 1);
            bf16x8 a[4];
#pragma unroll
            for (int ks = 0; ks < 4; ++ks) a[ks] = *(const LAS bf16x8*)(Bm + (16 * st + fr) * 136 + ks * 32 + 8 * fq);
#pragma unroll
            for (int u = 0; u < 2; ++u) {
                const int tt = tt0 + u; f32x4 d = {0.f, 0.f, 0.f, 0.f};
#pragma unroll
                for (int ks = 0; ks < 4; ++ks) { const bf16x8 bb = *(const LAS bf16x8*)(Cm + (16 * tt + fr) * 136 + ks * 32 + 8 * fq); d = mfma16(a[ks], bb, d); }
                const int t = 16 * tt + fr; const float ct = cum[t]; float mv[4];
#pragma unroll
                for (int j = 0; j < 4; ++j) { const int s = 16 * st + 4 * fq + j; mv[j] = (s <= t) ? d[j] * expf(ct - cum[s]) * dtv[s] : 0.f; }
                u32x2 w; w.x = pk2(mv[0], mv[1]); w.y = pk2(mv[2], mv[3]);
                *(LAS u32x2*)(Mt + t * 72 + 16 * st + 4 * fq) = w;
            }
        }
        __syncthreads();
        {
            const int pt = wave >> 1, tt0 = 2 * (wave & 1);
            bf16x8 a1[2], a2[4];
#pragma unroll
            for (int ks = 0; ks < 2; ++ks) a1[ks] = *(const LAS bf16x8*)(Xt + (16 * pt + fr) * 72 + ks * 32 + 8 * fq);
#pragma unroll
            for (int ks = 0; ks < 4; ++ks) a2[ks] = *(const LAS bf16x8*)(Hp + (16 * pt + fr) * 136 + ks * 32 + 8 * fq);
#pragma unroll
            for (int u = 0; u < 2; ++u) {
                const int tt = tt0 + u; f32x4 d1 = {0.f, 0.f, 0.f, 0.f}, d2 = {0.f, 0.f, 0.f, 0.f};
#pragma unroll
                for (int ks = 0; ks < 2; ++ks) { const bf16x8 bb = *(const LAS bf16x8*)(Mt + (16 * tt + fr) * 72 + ks * 32 + 8 * fq); d1 = mfma16(a1[ks], bb, d1); }
#pragma unroll
                for (int ks = 0; ks < 4; ++ks) { const bf16x8 bb = *(const LAS bf16x8*)(Cm + (16 * tt + fr) * 136 + ks * 32 + 8 * fq); d2 = mfma16(a2[ks], bb, d2); }
                const int t = 16 * tt + fr; const float et = ecum[t]; float yv[4];
#pragma unroll
                for (int j = 0; j < 4; ++j) { const int p = 16 * pt + 4 * fq + j; yv[j] = d1[j] + et * d2[j] + dsk * bf2f((unsigned)Xt[p * 72 + t]); }
                u32x2 w; w.x = pk2(yv[0], yv[1]); w.y = pk2(yv[2], yv[3]);
                *(u32x2*)(Y + (size_t)(row0 + t) * DI + h * 64 + 16 * pt + 4 * fq) = w;
            }
            bf16x8 a3[2];
#pragma unroll
            for (int ks = 0; ks < 2; ++ks) a3[ks] = *(const LAS bf16x8*)(Btw + (16 * wave + fr) * 72 + ks * 32 + 8 * fq);
            const float dec = ecum[63];
#pragma unroll
            for (int p4 = 0; p4 < 4; ++p4) { f32x4 d = {0.f, 0.f, 0.f, 0.f};
#pragma unroll
                for (int ks = 0; ks < 2; ++ks) { const bf16x8 bb = *(const LAS bf16x8*)(Xt + (16 * p4 + fr) * 72 + ks * 32 + 8 * fq); d = mfma16(a3[ks], bb, d); }
                hst[p4] = hst[p4] * dec + d; }
        }
        __syncthreads();
#pragma unroll
        for (int p4 = 0; p4 < 4; ++p4) { u32x2 w; w.x = pk2(hst[p4][0], hst[p4][1]); w.y = pk2(hst[p4][2], hst[p4][3]);
            *(LAS u32x2*)(Hp + (16 * p4 + fr) * 136 + 16 * wave + 4 * fq) = w; }
    }
    float* so = A.out + O_SSP + ((size_t)b * 32 + h) * 64 * 128;
#pragma unroll
    for (int p4 = 0; p4 < 4; ++p4) *(f32x4*)(so + (size_t)(16 * p4 + fr) * 128 + 16 * wave + 4 * fq) = hst[p4];
    __syncthreads();
}

__device__ __forceinline__ void ssd_sample_item(const Args& A, LAS unsigned char* wl, int b, int h, int lane) {
    const bf16_t* XC = (const bf16_t*)(A.ws + WS_XC); const float* SMF = (const float*)(A.ws + WS_SMF); bf16_t* Y = (bf16_t*)(A.ws + WS_Y);
    LAS float* red = (LAS float*)wl;
    const int g = h >> 3;
    const float Ah = -expf(A.in[I_ALOG][h]), dtb = A.in[I_DTB][h], dsk = A.in[I_DSKIP][h];
#pragma unroll 1
    for (int half = 0; half < 2; ++half) {
        const float* h0 = A.in[I_SSSM] + (((size_t)b * 32 + h) * 64 + 32 * half) * 128 + 2 * lane;
        float st[32][2];
#pragma unroll
        for (int p = 0; p < 32; ++p) { const float2 v = *(const float2*)(h0 + p * 128); st[p][0] = v.x; st[p][1] = v.y; }
#pragma unroll 1
        for (int t = 0; t < 4; ++t) {
            const size_t m = (size_t)(MP + b * 4 + t);
            const float dt = softplusf_(SMF[m * 128 + h] + dtb), dec = expf(dt * Ah);
            const unsigned bw = *(const unsigned*)(XC + m * XCW + 2048 + g * 128 + 2 * lane), cw = *(const unsigned*)(XC + m * XCW + 2560 + g * 128 + 2 * lane);
            const float b0 = bf2f(bw & 0xffffu) * dt, b1 = __uint_as_float(bw & 0xffff0000u) * dt, c0 = bf2f(cw & 0xffffu), c1 = __uint_as_float(cw & 0xffff0000u);
            const float xl = bf2f((unsigned)XC[m * XCW + h * 64 + 32 * half + (lane & 31)]);
#pragma unroll
            for (int p = 0; p < 32; ++p) {
                const float xp = __shfl(xl, p);
                st[p][0] = st[p][0] * dec + xp * b0; st[p][1] = st[p][1] * dec + xp * b1;
                red[p * 65 + lane] = st[p][0] * c0 + st[p][1] * c1;
            }
            asm volatile("s_waitcnt lgkmcnt(0)" ::: "memory");
            float y = 0.f;
#pragma unroll 16
            for (int i = 0; i < 64; ++i) y += red[(lane & 31) * 65 + i];
            y += dsk * xl;
            if (lane < 32) Y[m * DI + h * 64 + 32 * half + lane] = (bf16_t)f2bf(y);
            asm volatile("s_waitcnt lgkmcnt(0)" ::: "memory");
        }
        float* so = A.out + O_SSS + (((size_t)b * 32 + h) * 64 + 32 * half) * 128 + 2 * lane;
#pragma unroll
        for (int p = 0; p < 32; ++p) *(float2*)(so + p * 128) = make_float2(st[p][0], st[p][1]);
    }
}

__device__ __forceinline__ int t5_bucket(int n) {
    if (n < 16) return n;
    const float nf = (float)n;
    int large = 16 + (int)(logf(nf / 16.0f) / 2.0794415416798357f * 16.0f);
    return large < 31 ? large : 31;
}
typedef float f32x16 __attribute__((ext_vector_type(16)));
__device__ __forceinline__ f32x16 mfma32(bf16x8 a, bf16x8 b, f32x16 c) { return __builtin_amdgcn_mfma_f32_32x32x16_bf16(a, b, c, 0, 0, 0); }
constexpr float LOG2E = 1.4426950408889634f;
constexpr int AK_STR = 72, AV_STR = 68, AT_K0 = 0, AT_V0 = 2 * 64 * AK_STR * 2, AT_WS = AT_V0 + 2 * 64 * AV_STR * 2;
__device__ __forceinline__ void attn_prompt_unit(const Args& A, LAS unsigned char* lds, const LAS float* biasL, int b, int g, int qt, int wave, int lane_in) {
    const bf16_t* P = (const bf16_t*)(A.ws + WS_P); const unsigned* MASK32 = (const unsigned*)(A.ws + WS_SC); bf16_t* YA = (bf16_t*)(A.ws + WS_YA);
    int lane = lane_in; asm volatile("" : "+v"(lane));
    const int tid = wave * 64 + lane, r32 = lane & 31, hi = lane >> 5;
    LAS float* wsc = (LAS float*)(lds + AT_WS) + wave * 64;
    const int query = qt * 64 + 8 * wave + (r32 >> 2), head = 4 * g + (r32 & 3);
    const size_t qrow = (size_t)(b * 2048 + query);
    bf16x8 qf[4];
#pragma unroll
    for (int ds = 0; ds < 4; ++ds) qf[ds] = *(const bf16x8*)(P + qrow * NP + PQ + head * 64 + 16 * ds + 8 * hi);
    const unsigned* mrow = MASK32 + qrow * 64;
    const float bfar = biasL[128 * 16 + head];
    const int skey = tid >> 3, sdch = tid & 7;
    const bf16_t* ksrc = P + (size_t)(b * 2048 + skey) * NP + PK + g * 64 + sdch * 8;
    f32x16 O0, O1;
#pragma unroll
    for (int i = 0; i < 16; ++i) { O0[i] = 0.f; O1[i] = 0.f; }
    float m_run = -1e30f, l_run = 0.f;
    u32x4 kreg = *(const u32x4*)ksrc, vreg = *(const u32x4*)(ksrc + 256);
    unsigned mw0 = mrow[0], mw1 = mrow[1];
    {
        LAS bf16_t* Kb = (LAS bf16_t*)(lds + AT_K0); LAS bf16_t* Vb = (LAS bf16_t*)(lds + AT_V0);
        *(LAS u32x4*)(Kb + skey * AK_STR + sdch * 8) = kreg;
#pragma unroll
        for (int e = 0; e < 4; ++e) { Vb[(sdch * 8 + 2 * e) * AV_STR + skey] = (bf16_t)(vreg[e] & 0xffffu); Vb[(sdch * 8 + 2 * e + 1) * AV_STR + skey] = (bf16_t)(vreg[e] >> 16); }
    }
    for (int kt = 0; kt <= qt; ++kt) {
        const int buf = kt & 1;
        __syncthreads();
        const unsigned w0 = mw0 >> (4 * hi), w1 = mw1 >> (4 * hi);
        if (kt < qt) { const bf16_t* src = ksrc + (size_t)(kt + 1) * 64 * NP; kreg = *(const u32x4*)src; vreg = *(const u32x4*)(src + 256); mw0 = mrow[2 * kt + 2]; mw1 = mrow[2 * kt + 3]; }
        const LAS bf16_t* Kb = (const LAS bf16_t*)(lds + AT_K0 + buf * (64 * AK_STR * 2)); const LAS bf16_t* Vb = (const LAS bf16_t*)(lds + AT_V0 + buf * (64 * AV_STR * 2));
        f32x16 S0, S1;
#pragma unroll
        for (int i = 0; i < 16; ++i) { S0[i] = 0.f; S1[i] = 0.f; }
#pragma unroll
        for (int ds = 0; ds < 4; ++ds) {
            const bf16x8 k0 = *(const LAS bf16x8*)(Kb + r32 * AK_STR + 16 * ds + 8 * hi), k1 = *(const LAS bf16x8*)(Kb + (32 + r32) * AK_STR + 16 * ds + 8 * hi);
            S0 = mfma32(k0, qf[ds], S0); S1 = mfma32(k1, qf[ds], S1);
        }
        const float c1 = 0.125f * LOG2E;
        if (qt - kt >= 3) {
#pragma unroll
            for (int i = 0; i < 16; ++i) { const unsigned bit = 1u << ((i & 3) + 8 * (i >> 2));
                S0[i] = (w0 & bit) ? S0[i] * c1 + bfar : -INFINITY; S1[i] = (w1 & bit) ? S1[i] * c1 + bfar : -INFINITY; }
        } else {
            const int kbase = kt * 64 + 4 * hi;
#pragma unroll
            for (int i = 0; i < 16; ++i) { const int pos = (i & 3) + 8 * (i >> 2); const unsigned bit = 1u << pos;
                int r0 = query - (kbase + pos), r1 = r0 - 32; r0 = r0 < 0 ? 0 : (r0 > 128 ? 128 : r0); r1 = r1 < 0 ? 0 : (r1 > 128 ? 128 : r1);
                S0[i] = (w0 & bit) ? S0[i] * c1 + biasL[r0 * 16 + head] : -INFINITY; S1[i] = (w1 & bit) ? S1[i] * c1 + biasL[r1 * 16 + head] : -INFINITY; }
        }
        float tm = fmaxf(S0[0], S1[0]);
#pragma unroll
        for (int i = 1; i < 16; ++i) tm = fmaxf(tm, fmaxf(S0[i], S1[i]));
        tm = fmaxf(tm, __shfl_xor(tm, 32));
        if (__any(tm > m_run + 8.0f)) {
            const float mn = fmaxf(m_run, tm), f = __builtin_amdgcn_exp2f(m_run - mn);
            m_run = mn; l_run *= f;
            if (hi == 0) wsc[r32] = f;
            asm volatile("s_waitcnt lgkmcnt(0)" ::: "memory");
#pragma unroll
            for (int i = 0; i < 16; ++i) { const float fi = wsc[(i & 3) + 8 * (i >> 2) + 4 * hi]; O0[i] *= fi; O1[i] *= fi; }
            asm volatile("s_waitcnt lgkmcnt(0)" ::: "memory");
        }
        float ls = 0.f;
#pragma unroll
        for (int i = 0; i < 16; ++i) { S0[i] = __builtin_amdgcn_exp2f(S0[i] - m_run); S1[i] = __builtin_amdgcn_exp2f(S1[i] - m_run); ls += S0[i] + S1[i]; }
        l_run += ls;
        bf16x8 pa[2][2];
#pragma unroll
        for (int sk = 0; sk < 2; ++sk) {
            u32x4 a0, a1;
            a0.x = pk2(S0[8 * sk + 0], S0[8 * sk + 1]); a0.y = pk2(S0[8 * sk + 2], S0[8 * sk + 3]); a0.z = pk2(S0[8 * sk + 4], S0[8 * sk + 5]); a0.w = pk2(S0[8 * sk + 6], S0[8 * sk + 7]);
            a1.x = pk2(S1[8 * sk + 0], S1[8 * sk + 1]); a1.y = pk2(S1[8 * sk + 2], S1[8 * sk + 3]); a1.z = pk2(S1[8 * sk + 4], S1[8 * sk + 5]); a1.w = pk2(S1[8 * sk + 6], S1[8 * sk + 7]);
            pa[0][sk] = __builtin_bit_cast(bf16x8, a0); pa[1][sk] = __builtin_bit_cast(bf16x8, a1);
        }
#pragma unroll
        for (int blk = 0; blk < 2; ++blk)
#pragma unroll
            for (int sk = 0; sk < 2; ++sk) {
                const int kb = 32 * blk + 16 * sk + 4 * hi;
                const u32x2 a = *(const LAS u32x2*)(Vb + r32 * AV_STR + kb), c = *(const LAS u32x2*)(Vb + r32 * AV_STR + kb + 8);
                const u32x2 a2 = *(const LAS u32x2*)(Vb + (32 + r32) * AV_STR + kb), c2 = *(const LAS u32x2*)(Vb + (32 + r32) * AV_STR + kb + 8);
                const u32x4 v0 = {a.x, a.y, c.x, c.y}, v1 = {a2.x, a2.y, c2.x, c2.y};
                O0 = mfma32(pa[blk][sk], __builtin_bit_cast(bf16x8, v0), O0);
                O1 = mfma32(pa[blk][sk], __builtin_bit_cast(bf16x8, v1), O1);
            }
        if (kt < qt) {
            LAS bf16_t* Kn = (LAS bf16_t*)(lds + AT_K0 + (buf ^ 1) * (64 * AK_STR * 2)); LAS bf16_t* Vn = (LAS bf16_t*)(lds + AT_V0 + (buf ^ 1) * (64 * AV_STR * 2));
            *(LAS u32x4*)(Kn + skey * AK_STR + sdch * 8) = kreg;
#pragma unroll
            for (int e = 0; e < 4; ++e) { Vn[(sdch * 8 + 2 * e) * AV_STR + skey] = (bf16_t)(vreg[e] & 0xffffu); Vn[(sdch * 8 + 2 * e + 1) * AV_STR + skey] = (bf16_t)(vreg[e] >> 16); }
        }
    }
    l_run += __shfl_xor(l_run, 32);
    if (hi == 0) wsc[r32] = 1.0f / l_run;
    asm volatile("s_waitcnt lgkmcnt(0)" ::: "memory");
#pragma unroll
    for (int i = 0; i < 16; ++i) {
        const int rq = (i & 3) + 8 * (i >> 2) + 4 * hi; const float inv = wsc[rq];
        bf16_t* dst = YA + (size_t)(b * 2048 + qt * 64 + 8 * wave + (rq >> 2)) * D + (4 * g + (rq & 3)) * 64 + r32;
        dst[0] = (bf16_t)f2bf(O0[i] * inv); dst[32] = (bf16_t)f2bf(O1[i] * inv);
    }
    __syncthreads();
}

__device__ __forceinline__ void attend_sample_task(const Args& A, LAS unsigned char* wl, const LAS float* biasrel, int ms, int g, int lane_in) {
    constexpr int NJ = 33;
    int lane = lane_in; asm volatile("" : "+v"(lane));
    const bf16_t* P = (const bf16_t*)(A.ws + WS_P);
    const int b = ms >> 2, t = ms & 3, nvalid = 2049 + t, qpos = 2048 + t, m = MP + ms;
    const float* srow = (const float*)(A.ws + WS_SCS) + (size_t)ms * SCSW;
    LAS float* pq = (LAS float*)wl;
    LAS unsigned* rowid = (LAS unsigned*)(wl + 4096);
    LAS unsigned short* posl = (LAS unsigned short*)(wl + 4096 + 1024);
    unsigned key[NJ];
#pragma unroll
    for (int j = 0; j < NJ; ++j) key[j] = (lane < nvalid - 64 * j) ? f2key(srow[lane + 64 * j]) : 0u;
    unsigned T = 0u; int need_eq = 0;
    {
        bool exact = false;
        for (int bit = 31; bit >= 0; --bit) {
            const unsigned cand = T | (1u << bit); int cnt = 0;
#pragma unroll
            for (int j = 0; j < NJ; ++j) cnt += __popcll(__ballot(key[j] >= cand));
            if (cnt >= 256) { T = cand; if (cnt == 256) { exact = true; break; } }
        }
        if (exact) { T -= 1u; }
        else { int cgt = 0;
#pragma unroll
            for (int j = 0; j < NJ; ++j) cgt += __popcll(__ballot(key[j] > T));
            need_eq = 256 - cgt; }
    }
    int base = 0, eqused = 0;
    const int* pt = (const int*)A.in[I_PT];
#pragma unroll
    for (int j = 0; j < NJ; ++j) {
        const bool gt = key[j] > T, eq = (need_eq > 0) && (key[j] == T);
        const unsigned long long meq = __ballot(eq);
        const bool sel = gt || (eq && (eqused + mbcnt64(meq) < need_eq));
        eqused += __popcll(meq);
        const unsigned long long msk = __ballot(sel);
        if (sel) { const int pos = lane + 64 * j, k = base + mbcnt64(msk);
            posl[k] = (unsigned short)pos;
            rowid[k] = (pos < 2048) ? (unsigned)(pt[b * 16 + (pos >> 7)] * 128 + (pos & 127)) : (0x80000000u | (unsigned)(b * 4 + pos - 2048)); }
        base += __popcll(msk);
    }
    { const u32x2 w = *(const u32x2*)(P + (size_t)m * NP + PQ + g * 256 + lane * 4);
      *(LAS f32x4*)(pq + lane * 4) = (f32x4){__uint_as_float(w.x << 16), __uint_as_float(w.x & 0xffff0000u), __uint_as_float(w.y << 16), __uint_as_float(w.y & 0xffff0000u)}; }
    asm volatile("s_waitcnt lgkmcnt(0)" ::: "memory");
    const float* ck = A.in[I_CK]; const float* cv = A.in[I_CV]; const float* kn = A.out + O_KS; const float* vn = A.out + O_VS;
    const float* kp[4]; int rel[4];
#pragma unroll
    for (int i = 0; i < 4; ++i) { const unsigned rid = rowid[lane + 64 * i]; rel[i] = qpos - (int)posl[lane + 64 * i];
        kp[i] = ((rid & 0x80000000u) ? kn + (size_t)(rid & 0x7fffffffu) * 256 : ck + (size_t)rid * 256) + g * 64; }
    float acc[4][4];
#pragma unroll
    for (int i = 0; i < 4; ++i)
#pragma unroll
        for (int hh = 0; hh < 4; ++hh) acc[i][hh] = 0.f;
#pragma unroll 2
    for (int dc = 0; dc < 16; ++dc) {
        f32x4 kv[4];
#pragma unroll
        for (int i = 0; i < 4; ++i) kv[i] = *(const f32x4*)(kp[i] + dc * 4);
#pragma unroll
        for (int hh = 0; hh < 4; ++hh) { const f32x4 q4 = *(const LAS f32x4*)(pq + hh * 64 + dc * 4);
#pragma unroll
            for (int i = 0; i < 4; ++i) acc[i][hh] += kv[i][0] * q4[0] + kv[i][1] * q4[1] + kv[i][2] * q4[2] + kv[i][3] * q4[3]; }
    }
    asm volatile("s_waitcnt lgkmcnt(0)" ::: "memory");
#pragma unroll
    for (int i = 0; i < 4; ++i) { const int rc = rel[i] < 128 ? (rel[i] < 0 ? 0 : rel[i]) : 128; const f32x4 bv = *(const LAS f32x4*)(biasrel + rc * 16 + 4 * g);
#pragma unroll
        for (int hh = 0; hh < 4; ++hh) acc[i][hh] = acc[i][hh] * 0.125f + bv[hh]; }
#pragma unroll
    for (int hh = 0; hh < 4; ++hh) {
        const float mx = wave_max(fmaxf(fmaxf(acc[0][hh], acc[1][hh]), fmaxf(acc[2][hh], acc[3][hh])));
        float sm = 0.f;
#pragma unroll
        for (int i = 0; i < 4; ++i) { acc[i][hh] = __expf(acc[i][hh] - mx); sm += acc[i][hh]; }
        const float inv = 1.0f / wave_sum(sm);
#pragma unroll
        for (int i = 0; i < 4; ++i) acc[i][hh] *= inv;
    }
#pragma unroll
    for (int i = 0; i < 4; ++i) *(LAS f32x4*)(pq + (lane + 64 * i) * 4) = (f32x4){acc[i][0], acc[i][1], acc[i][2], acc[i][3]};
    asm volatile("s_waitcnt lgkmcnt(0)" ::: "memory");
    float o[4] = {0.f, 0.f, 0.f, 0.f};
    for (int k0 = 0; k0 < 256; k0 += 8) {
        float vv[8]; f32x4 pp[8];
#pragma unroll
        for (int u = 0; u < 8; ++u) { const unsigned rid = rowid[k0 + u];
            const float* vp = ((rid & 0x80000000u) ? vn + (size_t)(rid & 0x7fffffffu) * 256 : cv + (size_t)rid * 256) + g * 64 + lane;
            vv[u] = *vp; pp[u] = *(const LAS f32x4*)(pq + (k0 + u) * 4); }
#pragma unroll
        for (int u = 0; u < 8; ++u)
#pragma unroll
            for (int hh = 0; hh < 4; ++hh) o[hh] += pp[u][hh] * vv[u];
    }
    bf16_t* YA = (bf16_t*)(A.ws + WS_YA);
#pragma unroll
    for (int hh = 0; hh < 4; ++hh) YA[(size_t)m * D + (4 * g + hh) * 64 + lane] = (bf16_t)f2bf(o[hh]);
    asm volatile("s_waitcnt lgkmcnt(0)" ::: "memory");
}

#if MK_CHECK_ATT
constexpr size_t WS_CHK_SC = WS_END, WS_CHK_YA = WS_CHK_SC + 128 * MiB, WS_CHK_MASK = WS_CHK_YA + 33 * MiB, WS_CHK_END = WS_CHK_MASK + 4 * MiB;
constexpr int CW_CHK = 512;
template <bool SAMPLE> struct KVRow;
template <> struct KVRow<false> {
    typedef const bf16_t* ptr;
    const bf16_t* P;
    __device__ __forceinline__ ptr krow(unsigned rid) const { return P + (size_t)rid * NP + PK; }
    __device__ __forceinline__ ptr vrow(unsigned rid) const { return P + (size_t)rid * NP + PV; }
    static __device__ __forceinline__ void k8(ptr p, float (&f)[8]) { unpack8(*(const u32x4*)p, f); }
    static __device__ __forceinline__ f32x4 v4(ptr p) { const u32x2 w = *(const u32x2*)p;
        return (f32x4){__uint_as_float(w.x << 16), __uint_as_float(w.x & 0xffff0000u), __uint_as_float(w.y << 16), __uint_as_float(w.y & 0xffff0000u)}; }
};
template <> struct KVRow<true> {
    typedef const float* ptr;
    const float* ck; const float* cv; const float* kn; const float* vn;
    __device__ __forceinline__ ptr krow(unsigned rid) const { return (rid & 0x80000000u) ? kn + (size_t)(rid & 0x7fffffffu) * 256 : ck + (size_t)rid * 256; }
    __device__ __forceinline__ ptr vrow(unsigned rid) const { return (rid & 0x80000000u) ? vn + (size_t)(rid & 0x7fffffffu) * 256 : cv + (size_t)rid * 256; }
    static __device__ __forceinline__ void k8(ptr p, float (&f)[8]) { const f32x4 a = *(const f32x4*)p, b = *(const f32x4*)(p + 4);
#pragma unroll
        for (int i = 0; i < 4; ++i) { f[i] = a[i]; f[4 + i] = b[i]; } }
    static __device__ __forceinline__ f32x4 v4(ptr p) { return *(const f32x4*)p; }
};

template <bool SAMPLE>
__device__ __forceinline__ void attend_query(const Args& A, LAS unsigned char* wl, const LAS float* biasrel, int m, int lane_in) {
    constexpr int NJ = SAMPLE ? 33 : 32;
    int lane = lane_in; asm volatile("" : "+v"(lane));
    const bf16_t* P = (const bf16_t*)(A.ws + WS_P);
    int b, nvalid, qpos; const float* srow;
    if (!SAMPLE) { b = m >> 11; const int t = m & 2047; nvalid = t + 1; qpos = t; srow = (const float*)(A.ws + WS_CHK_SC) + (size_t)m * SCW; }
    else { const int ms = m - MP; b = ms >> 2; const int t = ms & 3; nvalid = 2049 + t; qpos = 2048 + t; srow = (const float*)(A.ws + WS_SCS) + (size_t)ms * SCSW; }
    LAS float* pq = (LAS float*)wl;
    LAS unsigned* rowid = (LAS unsigned*)(wl + 16384);
    LAS unsigned short* posl = (LAS unsigned short*)(wl + 16384 + 1024);
    unsigned key[NJ];
#pragma unroll
    for (int j = 0; j < NJ; ++j) { key[j] = (lane < nvalid - 64 * j) ? f2key(srow[lane + 64 * j]) : 0u; }
    unsigned T = 0u; int need_eq = 0;
    if (nvalid > 256) {
        for (int bit = 31; bit >= 0; --bit) {
            const unsigned cand = T | (1u << bit); int cnt = 0;
#pragma unroll
            for (int j = 0; j < NJ; ++j) cnt += __popcll(__ballot(key[j] >= cand));
            if (cnt >= 256) T = cand;
        }
        int cgt = 0;
#pragma unroll
        for (int j = 0; j < NJ; ++j) cgt += __popcll(__ballot(key[j] > T));
        need_eq = 256 - cgt;
    }
    int base = 0, eqused = 0; unsigned long long mine_chk = 0ull;
    const int* pt = (const int*)A.in[I_PT];
#pragma unroll
    for (int j = 0; j < NJ; ++j) {
        const bool gt = key[j] > T, eq = (need_eq > 0) && (key[j] == T);
        const unsigned long long meq = __ballot(eq);
        const bool sel = gt || (eq && (eqused + mbcnt64(meq) < need_eq));
        eqused += __popcll(meq);
        const unsigned long long ms = __ballot(sel);
        if (sel) { const int pos = lane + 64 * j, k = base + mbcnt64(ms);
            posl[k] = (unsigned short)pos;
            unsigned rid;
            if (!SAMPLE) rid = (unsigned)(b * 2048 + pos);
            else rid = (pos < 2048) ? (unsigned)(pt[b * 16 + (pos >> 7)] * 128 + (pos & 127)) : (0x80000000u | (unsigned)(b * 4 + pos - 2048));
            rowid[k] = rid; }
        base += __popcll(ms);
        if (!SAMPLE) { if (lane == j) mine_chk = ms; }
    }
    if (!SAMPLE) { if (lane < 32) ((unsigned long long*)(A.ws + WS_CHK_MASK))[(size_t)m * 32 + lane] = mine_chk; }
    const int nsel = base;
    asm volatile("s_waitcnt lgkmcnt(0)" ::: "memory");
    { const unsigned r0 = rowid[0]; const unsigned short p0 = posl[0];
#pragma unroll
      for (int i = 0; i < 4; ++i) { const int k = lane + 64 * i; if (k >= nsel) { rowid[k] = r0; posl[k] = p0; } } }
    { const u32x4 w0 = *(const u32x4*)(P + (size_t)m * NP + PQ + lane * 16), w1 = *(const u32x4*)(P + (size_t)m * NP + PQ + lane * 16 + 8);
      float f0[8], f1[8]; unpack8(w0, f0); unpack8(w1, f1);
#pragma unroll
      for (int e = 0; e < 8; ++e) { pq[lane * 16 + e] = f0[e]; pq[lane * 16 + 8 + e] = f1[e]; } }
    asm volatile("s_waitcnt lgkmcnt(0)" ::: "memory");
    KVRow<SAMPLE> R;
    if constexpr (!SAMPLE) { R.P = P; } else { R.ck = A.in[I_CK]; R.cv = A.in[I_CV]; R.kn = A.out + O_KS; R.vn = A.out + O_VS; }
    typename KVRow<SAMPLE>::ptr kp[4]; int rel[4];
#pragma unroll
    for (int i = 0; i < 4; ++i) { kp[i] = R.krow(rowid[lane + 64 * i]); rel[i] = qpos - (int)posl[lane + 64 * i]; }
    float acc[4][16];
#pragma unroll
    for (int i = 0; i < 4; ++i)
#pragma unroll
        for (int hh = 0; hh < 16; ++hh) acc[i][hh] = 0.f;
#pragma unroll
    for (int g = 0; g < 4; ++g) {
#pragma unroll 1
        for (int dc = 0; dc < 8; ++dc) {
            float kv[4][8];
#pragma unroll
            for (int i = 0; i < 4; ++i) KVRow<SAMPLE>::k8(kp[i] + g * 64 + dc * 8, kv[i]);
#pragma unroll
            for (int hh = 0; hh < 4; ++hh) {
                const f32x4 q0 = *(const LAS f32x4*)(pq + (4 * g + hh) * 64 + dc * 8), q1 = *(const LAS f32x4*)(pq + (4 * g + hh) * 64 + dc * 8 + 4);
#pragma unroll
                for (int i = 0; i < 4; ++i) {
                    float a = acc[i][4 * g + hh];
#pragma unroll
                    for (int e = 0; e < 4; ++e) { a += kv[i][e] * q0[e]; a += kv[i][4 + e] * q1[e]; }
                    acc[i][4 * g + hh] = a; }
            }
        }
    }
    asm volatile("s_waitcnt lgkmcnt(0)" ::: "memory");
#pragma unroll
    for (int i = 0; i < 4; ++i) {
        const bool valid = (lane + 64 * i) < nsel; const int rc = rel[i] < 128 ? (rel[i] < 0 ? 0 : rel[i]) : 128;
#pragma unroll
        for (int h4 = 0; h4 < 4; ++h4) { const f32x4 bv = *(const LAS f32x4*)(biasrel + rc * 16 + 4 * h4);
#pragma unroll
            for (int e = 0; e < 4; ++e) acc[i][4 * h4 + e] = valid ? acc[i][4 * h4 + e] * 0.125f + bv[e] : -INFINITY; }
    }
#pragma unroll
    for (int hh = 0; hh < 16; ++hh) {
        const float mx = wave_max(fmaxf(fmaxf(acc[0][hh], acc[1][hh]), fmaxf(acc[2][hh], acc[3][hh])));
        float s = 0.f;
#pragma unroll
        for (int i = 0; i < 4; ++i) { acc[i][hh] = __expf(acc[i][hh] - mx); s += acc[i][hh]; }
        const float inv = 1.0f / wave_sum(s);
#pragma unroll
        for (int i = 0; i < 4; ++i) acc[i][hh] *= inv;
    }
#pragma unroll
    for (int i = 0; i < 4; ++i)
#pragma unroll
        for (int h4 = 0; h4 < 4; ++h4) *(LAS f32x4*)(pq + (lane + 64 * i) * 16 + 4 * h4) = (f32x4){acc[i][4 * h4], acc[i][4 * h4 + 1], acc[i][4 * h4 + 2], acc[i][4 * h4 + 3]};
    asm volatile("s_waitcnt lgkmcnt(0)" ::: "memory");
    const int g = lane >> 4;
    f32x4 o[4];
#pragma unroll
    for (int hh = 0; hh < 4; ++hh) o[hh] = (f32x4){0.f, 0.f, 0.f, 0.f};
    const int nloop = (nsel + 3) & ~3;
    for (int k0 = 0; k0 < nloop; k0 += 4) {
        f32x4 vv[4], pp[4];
#pragma unroll
        for (int u = 0; u < 4; ++u) { const unsigned r = rowid[k0 + u]; vv[u] = KVRow<SAMPLE>::v4(R.vrow(r) + lane * 4); pp[u] = *(const LAS f32x4*)(pq + (k0 + u) * 16 + 4 * g); }
#pragma unroll
        for (int u = 0; u < 4; ++u)
#pragma unroll
            for (int hh = 0; hh < 4; ++hh) o[hh] += vv[u] * pp[u][hh];
    }
    bf16_t* YA = (bf16_t*)(A.ws + WS_CHK_YA);
#pragma unroll
    for (int hh = 0; hh < 4; ++hh) { u32x2 w; w.x = pk2(o[hh][0], o[hh][1]); w.y = pk2(o[hh][2], o[hh][3]);
        *(u32x2*)(YA + (size_t)m * D + (4 * g + hh) * 64 + (lane & 15) * 4) = w; }
    asm volatile("s_waitcnt lgkmcnt(0)" ::: "memory");
}


__device__ __forceinline__ void check_compare(const Args& A, int gw, int NGW, int lane) {
    const bf16_t* Y1 = (const bf16_t*)(A.ws + WS_YA); const bf16_t* Y2 = (const bf16_t*)(A.ws + WS_CHK_YA); unsigned* ctl = (unsigned*)(A.ws + WS_CTL);
    for (int m = gw; m < MP; m += NGW) {
        float e = 0.f, n = 0.f;
#pragma unroll
        for (int j = 0; j < 2; ++j) { float a[8], b[8]; unpack8(*(const u32x4*)(Y1 + (size_t)m * D + j * 512 + lane * 8), a); unpack8(*(const u32x4*)(Y2 + (size_t)m * D + j * 512 + lane * 8), b);
#pragma unroll
            for (int i = 0; i < 8; ++i) { const float d = a[i] - b[i]; e += d * d; n += b[i] * b[i]; } }
        e = wave_sum(e); n = wave_sum(n);
        { const unsigned long long w1 = (lane < 32) ? ((const unsigned long long*)(A.ws + WS_SC))[(size_t)m * 32 + lane] : 0ull, w2 = (lane < 32) ? ((const unsigned long long*)(A.ws + WS_CHK_MASK))[(size_t)m * 32 + lane] : 0ull;
          if (__any(w1 != w2) && lane == 0) atomicAdd(ctl + CW_CHK + 3, 1u);
          const int t = m & 2047;
          if (t >= 256) {
              const float* srow = (const float*)(A.ws + WS_CHK_SC) + (size_t)m * SCW;
              int c1 = 0, c2 = 0; float mins1 = INFINITY, maxu1 = -INFINITY, mins2 = INFINITY, maxu2 = -INFINITY;
              for (int j = 0; j < 32; ++j) { const int sp = lane + 64 * j; if (64 * j > t) break;
                  const unsigned long long a1 = __shfl((unsigned long long)w1, j), a2 = __shfl((unsigned long long)w2, j);
                  if (sp <= t) { const float v = srow[sp]; const bool s1 = (a1 >> lane) & 1ull, s2 = (a2 >> lane) & 1ull;
                      if (s1) { ++c1; mins1 = fminf(mins1, v); } else maxu1 = fmaxf(maxu1, v);
                      if (s2) { ++c2; mins2 = fminf(mins2, v); } else maxu2 = fmaxf(maxu2, v); } }
              c1 = (int)wave_sum((float)c1); c2 = (int)wave_sum((float)c2);
              mins1 = -wave_max(-mins1); mins2 = -wave_max(-mins2); maxu1 = wave_max(maxu1); maxu2 = wave_max(maxu2);
              if (lane == 0) { if (c1 != 256 || mins1 < maxu1) atomicAdd(ctl + CW_CHK + 4, 1u); if (c2 != 256 || mins2 < maxu2) atomicAdd(ctl + CW_CHK + 5, 1u); }
          } }
        if (lane == 0 && !(e <= MK_CHECK_TOL * MK_CHECK_TOL * n + 1e-12f)) { const int t = m & 2047; atomicAdd(ctl + CW_CHK + (t < 64 ? 0 : t < 256 ? 1 : 2), 1u); }
    }
}
#endif
__device__ __forceinline__ void gate_norm_phase(const Args& A, int gw, int NGW, int lane) {
    const bf16_t* P = (const bf16_t*)(A.ws + WS_P); bf16_t* Y = (bf16_t*)(A.ws + WS_Y); const float* ng = A.in[I_NORMG];
    for (int it = gw; it < M * 4; it += NGW) {
        const int m = it >> 2, ch = (it & 3) * 512 + lane * 8;
        float y[8], z[8]; unpack8(*(const u32x4*)(Y + (size_t)m * DI + ch), y); unpack8(*(const u32x4*)(P + (size_t)m * NP + PZ + ch), z);
        float ss = 0.f;
#pragma unroll
        for (int i = 0; i < 8; ++i) { y[i] *= siluf_(z[i]); ss += y[i] * y[i]; }
        const float r = 1.0f / sqrtf(wave_sum(ss) * (1.f / 512.f) + LN_EPS);
        const f32x4 g0 = *(const f32x4*)(ng + ch), g1 = *(const f32x4*)(ng + ch + 4);
#pragma unroll
        for (int i = 0; i < 4; ++i) { y[i] = y[i] * r * g0[i]; y[4 + i] = y[4 + i] * r * g1[i]; }
        *(u32x4*)(Y + (size_t)m * DI + ch) = pack8(y);
    }
}

constexpr int NPHASE = 14;
__global__ void __launch_bounds__(NTHR, 2) fwd(Args args) {
    extern __shared__ __attribute__((aligned(16))) unsigned char lds_raw[];
    LAS unsigned char* lds = (LAS unsigned char*)lds_raw;
    const int tid = threadIdx.x, lane = tid & 63, wave = __builtin_amdgcn_readfirstlane(tid >> 6);
    const int G = gridDim.x, bx = blockIdx.x;
    const int vcu = (G % 8 == 0) ? (bx % 8) * (G / 8) + bx / 8 : bx;
    const int gw = vcu * NWAVES + wave, NGW = G * NWAVES;
    unsigned char* ws = args.ws;
    volatile LAS unsigned* MISC = (volatile LAS unsigned*)(lds + MISC_OFF);
    for (int u = tid; u < 64; u += NTHR) MISC[u] = 0u;
    __syncthreads();
    const int lo = args.ph_lo, hi = args.ph_hi;
    XcdBarrier bar; bar.bar = (unsigned*)(ws + WS_CTL) + CW_BAR; bar.x = 0; bar.st = nullptr;
    if (hi - lo > 1) bar = xcd_barrier_post((unsigned*)(ws + WS_CTL) + CW_BAR, MISC + 8);
#define IN(k) (lo <= (k) && (k) < hi)
#define SEAM(k) do { if (IN(k) && IN((k) + 1)) xcd_barrier(bar); } while (0)

    bf16_t* const XB = (bf16_t*)(ws + WS_XB); bf16_t* const ACT = (bf16_t*)(ws + WS_ACT); float* const T = (float*)(ws + WS_T);
    float* const HF = (float*)(ws + WS_HF); bf16_t* const HB = (bf16_t*)(ws + WS_HB); bf16_t* const P = (bf16_t*)(ws + WS_P);
    float* const SMF = (float*)(ws + WS_SMF); bf16_t* const Y = (bf16_t*)(ws + WS_Y); bf16_t* const YA = (bf16_t*)(ws + WS_YA); bf16_t* const MG = (bf16_t*)(ws + WS_MG);

    if (IN(0)) REPK(0) { p0_prologue(args, lds, gw, NGW, wave, lane); }
    SEAM(0);
    if (IN(1)) {
        { pg8::Gemm g{XB, (const bf16_t*)(ws + WS_W1A), M, 2 * DFF, D}; pg8::StaticOrder S; S.init(M, 2 * DFF, G, bx);
        EpiSwiglu E{ACT}; pg8::gemm_phase<EpiSwiglu, pg8::StaticOrder, true, true>(lds, g, S, E); }
        if constexpr (DUPK(1)) { pg8::Gemm g{XB, (const bf16_t*)(ws + WS_W1A), M, 2 * DFF, D}; pg8::StaticOrder S; S.init(M, 2 * DFF, G, bx);
        EpiSwiglu E{ACT}; pg8::gemm_phase<EpiSwiglu, pg8::StaticOrder, true, true>(lds, g, S, E); }
    }
    SEAM(1);
    if (IN(2)) {
        { pg8::Gemm g{ACT, (const bf16_t*)(ws + WS_W1B), M, D, DFF}; pg8::StaticOrder S; S.init(M, D, G, bx);
        EpiResid E{args.in[I_XP], args.in[I_XS], T, ALPHA, 0.5f}; pg8::gemm_phase<EpiResid, pg8::StaticOrder, true, true>(lds, g, S, E); }
        if constexpr (DUPK(2)) { pg8::Gemm g{ACT, (const bf16_t*)(ws + WS_W1B), M, D, DFF}; pg8::StaticOrder S; S.init(M, D, G, bx);
        EpiResid E{args.in[I_XP], args.in[I_XS], T, ALPHA, 0.5f}; pg8::gemm_phase<EpiResid, pg8::StaticOrder, true, true>(lds, g, S, E); }
    }
    SEAM(2);
    if (IN(3)) REPK(3) { ln_phase(T, args.in[I_LN1G], args.in[I_LN1B], HF, HB, gw, NGW, lane); }
    SEAM(3);
    if (IN(4)) {
        { pg8::Gemm g{HB, (const bf16_t*)(ws + WS_WIN), M, NP, D}; pg8::StaticOrder S; S.init(M, NP, G, bx);
        EpiWin E{P, SMF, args.out}; pg8::gemm_phase<EpiWin, pg8::StaticOrder, true, true>(lds, g, S, E); }
        if constexpr (DUPK(4)) { pg8::Gemm g{HB, (const bf16_t*)(ws + WS_WIN), M, NP, D}; pg8::StaticOrder S; S.init(M, NP, G, bx);
        EpiWin E{P, SMF, args.out}; pg8::gemm_phase<EpiWin, pg8::StaticOrder, true, true>(lds, g, S, E); }
    }
    SEAM(4);
    if (IN(5)) REPK(5) {
        conv_phase(args);
        for (int u = bx; u < 1024; u += G) { const int i = u >> 8, c = u & 255, b = c >> 5, s = c & 31; const int qt = (i == 0) ? s : (i == 1) ? 63 - s : (i == 2) ? 64 + s : 127 - s;
            scores_select_prompt_unit(args, lds, b, qt, wave, lane); }
        for (int u = bx; u < 256; u += G) scores_sample_unit(args, u >> 1, u & 1, wave, lane);
    }
    SEAM(5);
    if (IN(6)) {
        for (int rep = 0; rep < MK_REP_SSDP; ++rep)
        for (int it = bx; it < 256; it += G) ssd_prompt_item(args, lds, it >> 5, it & 31);
        __syncthreads();
        LAS float* biasrel = (LAS float*)(lds + BIASREL_OFF); LAS float* biasL = biasrel + 129 * 16;
        for (int i = tid; i < 129 * 16; i += NTHR) { const int rel = i >> 4, h = i & 15; const float bv = args.in[I_BIAS][t5_bucket(rel) * 16 + h]; biasrel[i] = bv; biasL[i] = bv * LOG2E; }
        __syncthreads();
        for (int rep = 0; rep < MK_REP_ATTP; ++rep)
        for (int u = bx; u < 1024; u += G) { const int i = u >> 8, c = u & 255, bg = c >> 3, s8 = c & 7; const int qt = (i == 0) ? s8 : (i == 1) ? 15 - s8 : (i == 2) ? 16 + s8 : 31 - s8;
            attn_prompt_unit(args, lds, biasL, bg >> 2, bg & 3, qt, wave, lane); }
        __syncthreads();
        LAS unsigned char* wl = lds + wave * WAREA;
        for (int rep = 0; rep < MK_REP_SSDS; ++rep)
        for (int it = gw; it < 4096; it += NGW) ssd_sample_item(args, wl, it >> 5, it & 31, lane);
        for (int rep = 0; rep < MK_REP_ATTS; ++rep)
        for (int q = gw; q < MS * 4; q += NGW) attend_sample_task(args, wl, biasrel, q >> 2, q & 3, lane);
#if MK_CHECK_ATT
        for (int q = gw; q < MP; q += NGW) attend_query<false>(args, wl, biasrel, q, lane);
#endif
        __syncthreads();
    }
    SEAM(6);
    if (IN(7)) {
        gate_norm_phase(args, gw, NGW, lane);
#if MK_CHECK_ATT
        check_compare(args, gw, NGW, lane);
#endif
        { pg8::Gemm g{YA, (const bf16_t*)(ws + WS_WBA), M, D, D}; pg8::StaticOrder S; S.init(M, D, G, bx);
        EpiGateA E{P, PG + D, T}; pg8::gemm_phase<EpiGateA, pg8::StaticOrder, true, true>(lds, g, S, E); }
        if constexpr (DUPK(7)) { pg8::Gemm g{YA, (const bf16_t*)(ws + WS_WBA), M, D, D}; pg8::StaticOrder S; S.init(M, D, G, bx);
        EpiGateA E{P, PG + D, T}; pg8::gemm_phase<EpiGateA, pg8::StaticOrder, true, true>(lds, g, S, E); }
    }
    SEAM(7);
    if (IN(8)) {
        { pg8::Gemm g{Y, (const bf16_t*)(ws + WS_WBS), M, D, DI}; pg8::StaticOrder S; S.init(M, D, G, bx);
        EpiGateS E{P, PG, T, MG}; pg8::gemm_phase<EpiGateS, pg8::StaticOrder, true, true>(lds, g, S, E); }
        if constexpr (DUPK(8)) { pg8::Gemm g{Y, (const bf16_t*)(ws + WS_WBS), M, D, DI}; pg8::StaticOrder S; S.init(M, D, G, bx);
        EpiGateS E{P, PG, T, MG}; pg8::gemm_phase<EpiGateS, pg8::StaticOrder, true, true>(lds, g, S, E); }
    }
    SEAM(8);
    if (IN(9)) {
        { pg8::Gemm g{MG, (const bf16_t*)(ws + WS_WOUT), M, D, D}; pg8::StaticOrder S; S.init(M, D, G, bx);
        EpiResid E{HF, HF + (size_t)MP * D, T, ALPHA, 1.0f}; pg8::gemm_phase<EpiResid, pg8::StaticOrder, true, true>(lds, g, S, E); }
        if constexpr (DUPK(9)) { pg8::Gemm g{MG, (const bf16_t*)(ws + WS_WOUT), M, D, D}; pg8::StaticOrder S; S.init(M, D, G, bx);
        EpiResid E{HF, HF + (size_t)MP * D, T, ALPHA, 1.0f}; pg8::gemm_phase<EpiResid, pg8::StaticOrder, true, true>(lds, g, S, E); }
    }
    SEAM(9);
    if (IN(10)) REPK(10) { ln_phase(T, args.in[I_LN2G], args.in[I_LN2B], HF, HB, gw, NGW, lane); }
    SEAM(10);
    if (IN(11)) {
        { pg8::Gemm g{HB, (const bf16_t*)(ws + WS_W2A), M, 2 * DFF, D}; pg8::StaticOrder S; S.init(M, 2 * DFF, G, bx);
        EpiSwiglu E{ACT}; pg8::gemm_phase<EpiSwiglu, pg8::StaticOrder, true, true>(lds, g, S, E); }
        if constexpr (DUPK(11)) { pg8::Gemm g{HB, (const bf16_t*)(ws + WS_W2A), M, 2 * DFF, D}; pg8::StaticOrder S; S.init(M, 2 * DFF, G, bx);
        EpiSwiglu E{ACT}; pg8::gemm_phase<EpiSwiglu, pg8::StaticOrder, true, true>(lds, g, S, E); }
    }
    SEAM(11);
    if (IN(12)) {
        { pg8::Gemm g{ACT, (const bf16_t*)(ws + WS_W2B), M, D, DFF}; pg8::StaticOrder S; S.init(M, D, G, bx);
        EpiResid E{HF, HF + (size_t)MP * D, T, ALPHA, 0.5f}; pg8::gemm_phase<EpiResid, pg8::StaticOrder, true, true>(lds, g, S, E); }
        if constexpr (DUPK(12)) { pg8::Gemm g{ACT, (const bf16_t*)(ws + WS_W2B), M, D, DFF}; pg8::StaticOrder S; S.init(M, D, G, bx);
        EpiResid E{HF, HF + (size_t)MP * D, T, ALPHA, 0.5f}; pg8::gemm_phase<EpiResid, pg8::StaticOrder, true, true>(lds, g, S, E); }
    }
    SEAM(12);
    if (IN(13)) REPK(13) { ln_phase(T, args.in[I_LN3G], args.in[I_LN3B], args.out + O_Y, nullptr, gw, NGW, lane); }
#if MK_CHECK_ATT
    if (IN(13)) { __syncthreads(); unsigned* cw = (unsigned*)(ws + WS_CTL) + CW_CHK;
        const unsigned b0 = __hip_atomic_load(cw, __ATOMIC_RELAXED, __HIP_MEMORY_SCOPE_AGENT), b1 = __hip_atomic_load(cw + 1, __ATOMIC_RELAXED, __HIP_MEMORY_SCOPE_AGENT), b2 = __hip_atomic_load(cw + 2, __ATOMIC_RELAXED, __HIP_MEMORY_SCOPE_AGENT), b3 = __hip_atomic_load(cw + 3, __ATOMIC_RELAXED, __HIP_MEMORY_SCOPE_AGENT), b4 = __hip_atomic_load(cw + 4, __ATOMIC_RELAXED, __HIP_MEMORY_SCOPE_AGENT), b5 = __hip_atomic_load(cw + 5, __ATOMIC_RELAXED, __HIP_MEMORY_SCOPE_AGENT);
        const float code = MK_CHECK_CODE;
        if (code > 0.f && bx == 0 && tid == 0) args.out[O_Y] = 4096.0f * sqrtf(code); }
#endif
#undef IN
#undef SEAM
}
}

extern "C" void kernel_launch(void* const* d_in, const int* in_sizes, int n_in, void* d_out, int out_size, void* d_ws, size_t ws_size, hipStream_t stream) {
    using namespace mk;
    static int grid = 0;
    if (grid == 0) {
        if (n_in != 29 || (size_t)out_size != O_END || ws_size < WS_END) { fprintf(stderr, "kernel_launch: unexpected shapes (n_in %d, out %d, ws %zu)\n", n_in, out_size, ws_size); grid = -1; return; }
        int dev = 0, cus = 0, per_cu = 0;
        if (hipGetDevice(&dev) != hipSuccess || hipDeviceGetAttribute(&cus, hipDeviceAttributeMultiprocessorCount, dev) != hipSuccess) { grid = -1; return; }
        if (hipFuncSetAttribute((const void*)fwd, hipFuncAttributeMaxDynamicSharedMemorySize, LDS_BYTES) != hipSuccess) { fprintf(stderr, "kernel_launch: hipFuncSetAttribute failed\n"); grid = -1; return; }
        if (hipOccupancyMaxActiveBlocksPerMultiprocessor(&per_cu, (const void*)fwd, NTHR, LDS_BYTES) != hipSuccess || per_cu < 1) fprintf(stderr, "kernel_launch: occupancy query says %d\n", per_cu);
        (void)hipGetLastError();
        grid = cus;
    }
    if (grid < 0) return;
    (void)hipMemsetAsync((char*)d_ws + WS_CTL, 0, CTL_ZERO_BYTES, stream);
    Args a{};
    for (int i = 0; i < 29; ++i) a.in[i] = (const float*)d_in[i];
    a.out = (float*)d_out; a.ws = (unsigned char*)d_ws;
#if MK_SPLIT
    for (int p = 0; p < NPHASE; ++p) { a.ph_lo = p; a.ph_hi = p + 1; hipLaunchKernelGGL(fwd, dim3(grid), dim3(NTHR), LDS_BYTES, stream, a); }
#else
    a.ph_lo = 0; a.ph_hi = NPHASE; hipLaunchKernelGGL(fwd, dim3(grid), dim3(NTHR), LDS_BYTES, stream, a);
#endif
}
```

```cpp
#include <hip/hip_runtime.h>
#include <cstdio>
#include <cstdint>
#define GAS __attribute__((address_space(1)))
#define LAS __attribute__((address_space(3)))
namespace pg8 {
#define PG8_LAS __attribute__((address_space(3)))
typedef unsigned short bf16_t;
typedef short bf16x8 __attribute__((ext_vector_type(8)));
typedef float f32x4 __attribute__((ext_vector_type(4)));
typedef unsigned u32x4 __attribute__((ext_vector_type(4)));
constexpr int BM = 256, BK = 64, HALF = 128, HTB = HALF * BK * 2  , STAGE_BYTES = 8 * HTB, NXCD = 8, WGM = 8;

__host__ __device__ __forceinline__ int lds_byte(int r, int c) { const int st = (r >> 4) * 2 + (c >> 5), rr = r & 15, cc = c & 31, ob = rr * 64 + cc * 2; return st * 1024 + (ob ^ (((ob >> 9) & 1) << 5)); }
__host__ __device__ __forceinline__ void stage_rc(int b, int& R, int& C) { const int st = b / 1024, sb = b % 1024, swz = sb ^ (((sb >> 9) & 1) << 5); R = (st >> 1) * 16 + swz / 64; C = (st & 1) * 32 + (swz % 64) / 2; }
__host__ __device__ __forceinline__ int perm32(int rho) { const int n = rho >> 4, i = rho & 15; return 8 * (i >> 2) + 4 * n + (i & 3); }

struct Unit { int pm, pn; };
struct Gemm { const bf16_t* A; const bf16_t* Bt; int M, N, K; };

struct StaticOrder {
    int nM, nN, nwg, G, c;
    __host__ __device__ void init(int M, int N, int G_, int c_) { nM = M / BM; nN = N / BM; nwg = nM * nN; G = G_; c = c_; }
    __host__ __device__ bool next(int i, Unit& u) const {
        const long L = (long)i * G + c; if (L >= nwg) return false;
        int wgid = (int)L; { const int q = nwg / NXCD, r = nwg % NXCD, xcd = wgid % NXCD, off = wgid / NXCD; wgid = (xcd < r ? xcd * (q + 1) : r * (q + 1) + (xcd - r) * q) + off; }
        const int nig = WGM * nN, gid = wgid / nig, fm = gid * WGM, gsz = (nM - fm) < WGM ? (nM - fm) : WGM;
        u.pm = fm + ((wgid % nig) % gsz); u.pn = (wgid % nig) / gsz; return true;
    }
    __device__ __forceinline__ void a_ready(const Unit&) const {}
    __device__ __forceinline__ void done(const Unit&) const {}
};

__device__ __forceinline__ unsigned cvt_pk_bf16(float lo, float hi) { unsigned r; asm volatile("v_cvt_pk_bf16_f32 %0, %1, %2" : "=v"(r) : "v"(lo), "v"(hi)); return r; }

template <class Epi, class Sched, bool ALIGN_EPI = false, bool SP2 = false>
__device__ __forceinline__ void gemm_phase(PG8_LAS unsigned char* lds, const Gemm g, const Sched& S, const Epi& E) {
    const int tid = threadIdx.x, wid = __builtin_amdgcn_readfirstlane(tid >> 6), lane = tid & 63, wr = wid >> 2, wc = wid & 3, fr = lane & 15, fq = lane >> 4;
    const int K = g.K, nt = K / BK;
    unsigned voffA[2], voffB[2];
#pragma unroll
    for (int i = 0; i < 2; ++i) { int R, C; stage_rc(tid * 16 + i * 8192, R, C); const int Rb = Epi::PERM ? ((R & ~31) + perm32(R & 31)) : R;
        voffA[i] = (unsigned)(R * K + C) * 2u; voffB[i] = (unsigned)(Rb * K + C) * 2u; }
    const size_t kstep = (size_t)(BK * 2);
    const size_t hstep = (size_t)HALF * K * 2;
    const size_t tstep = 2 * hstep;
    const unsigned ldsw = (unsigned)wid * 1024u;
    const int aoff = lds_byte(wr * 64 + fr, fq * 8), boff = lds_byte(wc * 32 + fr, fq * 8);
#define PG8_SA(b, h) (((b) * 2 + (h)) * HTB)
#define PG8_SB(b, h) ((4 + (b) * 2 + (h)) * HTB)
#define PG8_STAGE(bufoff, gbase, voff) do { _Pragma("unroll") for (int _i = 0; _i < 2; ++_i) \
        __builtin_amdgcn_global_load_lds((const unsigned*)((const char*)(gbase) + (voff)[_i]), (PG8_LAS unsigned*)(lds + (bufoff) + ldsw + _i * 8192), 16, 0, 0); } while (0)
#define PG8_LDA(dst, b, h) do { _Pragma("unroll") for (int m = 0; m < 4; ++m) _Pragma("unroll") for (int k = 0; k < 2; ++k) dst[m][k] = *(const PG8_LAS bf16x8*)(lds + PG8_SA(b, h) + aoff + m * 2048 + k * 1024); } while (0)
#define PG8_LDB(dst, b, h) do { _Pragma("unroll") for (int n = 0; n < 2; ++n) _Pragma("unroll") for (int k = 0; k < 2; ++k) dst[n][k] = *(const PG8_LAS bf16x8*)(lds + PG8_SB(b, h) + boff + n * 2048 + k * 1024); } while (0)
#define PG8_MMA(ai, bj, At, Bt) do { __builtin_amdgcn_s_setprio(1); _Pragma("unroll") for (int m = 0; m < 4; ++m) _Pragma("unroll") for (int n = 0; n < 2; ++n) _Pragma("unroll") for (int k = 0; k < 2; ++k) \
        acc[ai][bj][m][n] = __builtin_amdgcn_mfma_f32_16x16x32_bf16(Bt[n][k], At[m][k], acc[ai][bj][m][n], 0, 0, 0); __builtin_amdgcn_s_setprio(0); } while (0)
#define PG8_WAIT_V(n) asm volatile("s_waitcnt vmcnt(" #n ")" ::: "memory")
#define PG8_WAIT_L(n) asm volatile("s_waitcnt lgkmcnt(" #n ")" ::: "memory")
#define PG8_BAR __builtin_amdgcn_s_barrier()
#define PG8_SCHED __builtin_amdgcn_sched_barrier(0)
    Unit cur, nxt; int ui = 0;
    if (!S.next(0, cur)) return;
    f32x4 acc[2][2][4][2];
#pragma unroll
    for (int a = 0; a < 2; ++a)
#pragma unroll
        for (int b = 0; b < 2; ++b)
#pragma unroll
            for (int m = 0; m < 4; ++m)
#pragma unroll
                for (int n = 0; n < 2; ++n) acc[a][b][m][n] = (f32x4){0.f, 0.f, 0.f, 0.f};
    bf16x8 At[4][2], B0[2][2], B1[2][2];
    const char* cA = (const char*)g.A + (size_t)cur.pm * tstep; const char* cB = (const char*)g.Bt + (size_t)cur.pn * tstep;
    S.a_ready(cur);
    if constexpr (SP2) {
        PG8_STAGE(PG8_SB(0, 0), cB, voffB); PG8_STAGE(PG8_SB(0, 1), cB + hstep, voffB); PG8_STAGE(PG8_SA(0, 0), cA, voffA); PG8_STAGE(PG8_SA(0, 1), cA + hstep, voffA);
        if (wr == 1) PG8_BAR;
        PG8_WAIT_V(2); PG8_BAR;
        PG8_STAGE(PG8_SB(1, 0), cB + kstep, voffB); PG8_STAGE(PG8_SA(1, 0), cA + kstep, voffA); PG8_STAGE(PG8_SB(1, 1), cB + hstep + kstep, voffB);
        PG8_WAIT_V(6); PG8_BAR;
    } else {
        PG8_STAGE(PG8_SB(0, 0), cB, voffB); PG8_STAGE(PG8_SA(0, 0), cA, voffA); PG8_STAGE(PG8_SB(0, 1), cB + hstep, voffB); PG8_STAGE(PG8_SA(0, 1), cA + hstep, voffA);
        if (wr == 1) PG8_BAR;
        PG8_WAIT_V(4); PG8_BAR;
        PG8_STAGE(PG8_SB(1, 0), cB + kstep, voffB); PG8_STAGE(PG8_SA(1, 0), cA + kstep, voffA); PG8_STAGE(PG8_SB(1, 1), cB + hstep + kstep, voffB);
        PG8_WAIT_V(6); PG8_BAR;
    }
    for (;;) {
        const bool has_next = S.next(ui + 1, nxt);
        const char* nA = has_next ? (const char*)g.A + (size_t)nxt.pm * tstep : cA; const char* nB = has_next ? (const char*)g.Bt + (size_t)nxt.pn * tstep : cB;
        for (int t = 0; t < nt; t += 2) {
            const bool last = (t == nt - 2);
            const char* a1 = cA + (size_t)(t + 1) * kstep;
            const char* a2 = last ? nA : cA + (size_t)(t + 2) * kstep; const char* b2 = last ? nB : cB + (size_t)(t + 2) * kstep;
            const char* a3 = a2 + kstep; const char* b3 = b2 + kstep;
            if (last && has_next) S.a_ready(nxt);
            if constexpr (SP2) {
            PG8_LDB(B0, 0, 0); PG8_LDB(B1, 0, 1); PG8_SCHED; PG8_LDA(At, 0, 0); PG8_STAGE(PG8_SA(1, 1), a1 + hstep, voffA);
            PG8_WAIT_V(8); PG8_WAIT_L(0); PG8_BAR; PG8_MMA(0, 0, At, B0); PG8_MMA(0, 1, At, B1); PG8_BAR; PG8_SCHED;
            PG8_LDA(At, 0, 1); PG8_STAGE(PG8_SB(0, 0), b2, voffB); PG8_STAGE(PG8_SB(0, 1), b2 + hstep, voffB); PG8_STAGE(PG8_SA(0, 0), a2, voffA);
            PG8_WAIT_V(8); PG8_WAIT_L(0); PG8_BAR; PG8_MMA(1, 0, At, B0); PG8_MMA(1, 1, At, B1); PG8_BAR; PG8_SCHED;
            PG8_LDB(B0, 1, 0); PG8_LDB(B1, 1, 1); PG8_SCHED; PG8_LDA(At, 1, 0); PG8_STAGE(PG8_SA(0, 1), a2 + hstep, voffA);
            PG8_WAIT_V(8); PG8_WAIT_L(0); PG8_BAR; PG8_MMA(0, 0, At, B0); PG8_MMA(0, 1, At, B1); PG8_BAR; PG8_SCHED;
            PG8_LDA(At, 1, 1); PG8_STAGE(PG8_SB(1, 0), b3, voffB); PG8_STAGE(PG8_SB(1, 1), b3 + hstep, voffB); PG8_STAGE(PG8_SA(1, 0), a3, voffA);
            PG8_WAIT_V(8); PG8_WAIT_L(0); PG8_BAR; PG8_MMA(1, 0, At, B0); PG8_MMA(1, 1, At, B1); PG8_BAR; PG8_SCHED;
            } else {
            PG8_LDB(B0, 0, 0); PG8_SCHED; PG8_LDA(At, 0, 0); PG8_STAGE(PG8_SA(1, 1), a1 + hstep, voffA);
            PG8_WAIT_L(8); PG8_BAR; PG8_WAIT_L(0); PG8_MMA(0, 0, At, B0); PG8_BAR; PG8_SCHED;
            PG8_LDB(B1, 0, 1); PG8_STAGE(PG8_SB(0, 0), b2, voffB);
            PG8_BAR; PG8_WAIT_L(0); PG8_MMA(0, 1, At, B1); PG8_BAR;
            PG8_LDA(At, 0, 1); PG8_STAGE(PG8_SA(0, 0), a2, voffA);
            PG8_BAR; PG8_WAIT_L(0); PG8_MMA(1, 0, At, B0); PG8_BAR; PG8_SCHED;
            PG8_STAGE(PG8_SB(0, 1), b2 + hstep, voffB);
            PG8_WAIT_V(6); PG8_BAR; PG8_MMA(1, 1, At, B1); PG8_BAR;
            PG8_LDB(B0, 1, 0); PG8_SCHED; PG8_LDA(At, 1, 0); PG8_STAGE(PG8_SA(0, 1), a2 + hstep, voffA);
            PG8_WAIT_L(8); PG8_BAR; PG8_WAIT_L(0); PG8_MMA(0, 0, At, B0); PG8_BAR; PG8_SCHED;
            PG8_LDB(B1, 1, 1); PG8_STAGE(PG8_SB(1, 0), b3, voffB);
            PG8_BAR; PG8_WAIT_L(0); PG8_MMA(0, 1, At, B1); PG8_BAR;
            PG8_LDA(At, 1, 1); PG8_STAGE(PG8_SA(1, 0), a3, voffA);
            PG8_BAR; PG8_WAIT_L(0); PG8_MMA(1, 0, At, B0); PG8_BAR; PG8_SCHED;
            PG8_STAGE(PG8_SB(1, 1), b3 + hstep, voffB);
            PG8_WAIT_V(6); PG8_BAR; PG8_MMA(1, 1, At, B1); PG8_BAR;
            }
        }
        if constexpr (ALIGN_EPI) { if (wr == 0) PG8_BAR; }
        if constexpr (!Epi::AFTER_DRAIN) { E(acc, cur, wr, wc, fr, fq); S.done(cur); }
        if (!has_next) break;
#pragma unroll
        for (int a = 0; a < 2; ++a)
#pragma unroll
            for (int b = 0; b < 2; ++b)
#pragma unroll
                for (int m = 0; m < 4; ++m)
#pragma unroll
                    for (int n = 0; n < 2; ++n) acc[a][b][m][n] = (f32x4){0.f, 0.f, 0.f, 0.f};
        cur = nxt; cA = nA; cB = nB; ++ui;
        if constexpr (ALIGN_EPI) { if (wr == 1) PG8_BAR; }
    }
    PG8_WAIT_V(0);
    if constexpr (!ALIGN_EPI) { if (wr == 0) PG8_BAR; }
    PG8_BAR;
    if constexpr (Epi::AFTER_DRAIN) { E.fused(acc, cur, wr, wc, fr, fq, lds, wid, lane); S.done(cur); }
#undef PG8_SA
#undef PG8_SB
#undef PG8_STAGE
#undef PG8_LDA
#undef PG8_LDB
#undef PG8_MMA
#undef PG8_WAIT_V
#undef PG8_WAIT_L
#undef PG8_BAR
#undef PG8_SCHED
}
}
#define XB_TMO      128
#define XB_XCNT(j)  (256  + 64 * (j))
#define XB_XSUB(j)  (1280 + 64 * (j))
#define XB_XGEN(j)  (2304 + 64 * (j))
#define XB_TOP      3328
#define XB_TOPGEN   3392
#define XCD_BAR_WORDS 3456
#define XB_SPIN_CAP (1u << 18)

__device__ __forceinline__ unsigned xb_ld(unsigned* p)              { return __hip_atomic_load(p, __ATOMIC_RELAXED, __HIP_MEMORY_SCOPE_AGENT); }
__device__ __forceinline__ unsigned xb_add(unsigned* p, unsigned v) { return __hip_atomic_fetch_add(p, v, __ATOMIC_RELAXED, __HIP_MEMORY_SCOPE_AGENT); }
__device__ __forceinline__ unsigned xb_xcc_id() { return (unsigned)__builtin_amdgcn_s_getreg((3 << 11) | 20) & 0xFu; }
#define XB_SPIN(cond, bar) do { unsigned _sp = 0; while (cond) { __builtin_amdgcn_s_sleep(1); \
    if ((++_sp & 255u) == 0u) { if (xb_ld(&(bar)[XB_TMO])) break; if (_sp > XB_SPIN_CAP) { atomicAdd(&(bar)[XB_TMO], 1u); break; } } } } while (0)

struct XcdBarrier {
    unsigned* bar; unsigned x;
    volatile LAS unsigned* st;
};

__device__ __forceinline__ XcdBarrier xcd_barrier_post(unsigned* bar, volatile LAS unsigned* st) {
    XcdBarrier b; b.bar = bar; b.x = xb_xcc_id(); b.st = st;
    if (threadIdx.x == 0) (void)xb_add(&bar[XB_XCNT(b.x)], 1u);
    return b;
}
__device__ __forceinline__ void xcd_barrier_complete(unsigned* bar, unsigned x, unsigned& nloc, unsigned& nx) {
    const unsigned G = gridDim.x * gridDim.y * gridDim.z;
    unsigned sum, cnt, mine, sp = 0u;
    for (;;) {
        sum = 0u; cnt = 0u; mine = 0u;
#pragma unroll
        for (unsigned j = 0; j < 16; ++j) { const unsigned c = xb_ld(&bar[XB_XCNT(j)]); sum += c; cnt += (c > 0u) ? 1u : 0u; mine = (j == x) ? c : mine; }
        if (sum == G) break;
        __builtin_amdgcn_s_sleep(1);
        if ((++sp & 255u) == 0u) { if (xb_ld(&bar[XB_TMO])) break; if (sp > XB_SPIN_CAP) { atomicAdd(&bar[XB_TMO], 1u); break; } }
    }
    nloc = mine > 0u ? mine : 1u; nx = cnt > 0u ? cnt : 1u;
}

__device__ __forceinline__ void xcd_barrier(const XcdBarrier& b) {
    asm volatile("s_waitcnt vmcnt(0)" ::: "memory");
    __syncthreads();
    if (threadIdx.x == 0) {
        unsigned* bar = b.bar;
        __builtin_amdgcn_s_waitcnt(0);
        unsigned nloc = b.st[0], nx = b.st[1];
        if (nloc == 0u) { xcd_barrier_complete(bar, b.x, nloc, nx); b.st[0] = nloc; b.st[1] = nx; }
        const unsigned old = xb_add(&bar[XB_XSUB(b.x)], 1u);
        const unsigned gen = old / nloc;
        if (old + 1u == (gen + 1u) * nloc) {
            __builtin_amdgcn_fence(__ATOMIC_RELEASE, "agent");
            asm volatile("s_waitcnt vmcnt(0)" ::: "memory");
            const unsigned og = xb_add(&bar[XB_TOP], 1u);
            const unsigned tg = og / nx;
            if (og + 1u == (tg + 1u) * nx) xb_add(&bar[XB_TOPGEN], 1u);
            else XB_SPIN(xb_ld(&bar[XB_TOPGEN]) == tg, bar);
            __builtin_amdgcn_fence(__ATOMIC_ACQUIRE, "agent");
            xb_add(&bar[XB_XGEN(b.x)], 1u);
            asm volatile("s_waitcnt vmcnt(0)" ::: "memory");
        } else {
            XB_SPIN(xb_ld(&bar[XB_XGEN(b.x)]) == gen, bar);
            __builtin_amdgcn_fence(__ATOMIC_ACQUIRE, "agent");
            asm volatile("s_waitcnt vmcnt(0)" ::: "memory");
        }
    }
    __syncthreads();
}
namespace mk {
using pg8::bf16_t; using pg8::bf16x8; using pg8::f32x4; using pg8::u32x4;
typedef unsigned u32x2 __attribute__((ext_vector_type(2)));

#ifndef MK_CHECK_ATT
#define MK_CHECK_ATT 0
#endif
#define MK_REP_SSDP 1
#define MK_REP_SSDS 1
#define MK_REP_ATTS 1
#define MK_REP_ATTP 1
#define MK_CHECK_TOL 0.02f
#define MK_CHECK_CODE ((b0 ? 1.f : 0.f) + (b1 ? 2.f : 0.f) + (b2 ? 4.f : 0.f) + (b3 ? 8.f : 0.f) + (b4 ? 16.f : 0.f) + (b5 ? 32.f : 0.f))
#define MK_REP_MASK 0
#define DUPK(k) (((MK_REP_MASK >> (k)) & 1) != 0)
#define REPK(k) for (int rep_ = 0; rep_ < 1 + ((MK_REP_MASK >> (k)) & 1); ++rep_)
#ifndef MK_SPLIT
#define MK_SPLIT 0
#endif

constexpr int NWAVES = 8, NTHR = 512;
constexpr int MP = 16384, MS = 512, M = MP + MS, D = 1024, DFF = 2816, DI = 2048, NP = 9472, XCW = 3072;
constexpr int PZ = 0, PXBC = 2048, PSM = 5120, PQ = 5376, PK = 6400, PV = 6656, PQI = 6912, PG = 7424;
constexpr int SCW = 2048, SCSW = 2112;
constexpr size_t O_Y = 0, O_KP = 17301504, O_VP = 21495808, O_KIP = 25690112, O_CVP = 26738688, O_SSP = 26812416,
                 O_KS = 28909568, O_VS = 29040640, O_KIS = 29171712, O_CVS = 29204480, O_SSS = 30384128, O_END = 63938560;
constexpr size_t MiB = 1u << 20;
constexpr size_t WS_CTL = 0, CTL_ZERO_BYTES = 1 * MiB;
constexpr size_t WS_W1A = 1 * MiB, WS_W1B = WS_W1A + 11 * MiB, WS_WIN = WS_W1B + 6 * MiB, WS_WBS = WS_WIN + 19 * MiB, WS_WBA = WS_WBS + 4 * MiB,
                 WS_WOUT = WS_WBA + 2 * MiB, WS_W2A = WS_WOUT + 2 * MiB, WS_W2B = WS_W2A + 11 * MiB;
constexpr size_t WS_XB = WS_W2B + 6 * MiB, WS_ACT = WS_XB + 33 * MiB, WS_T = WS_ACT + 91 * MiB, WS_HF = WS_T + 66 * MiB, WS_HB = WS_HF + 66 * MiB,
                 WS_P = WS_HB + 33 * MiB, WS_SMF = WS_P + 306 * MiB, WS_XC = WS_SMF + 9 * MiB, WS_Y = WS_XC + 99 * MiB, WS_SC = WS_Y + 66 * MiB,
                 WS_SCS = WS_SC + 128 * MiB, WS_YA = WS_SCS + 5 * MiB, WS_MG = WS_YA + 33 * MiB, WS_END = WS_MG + 33 * MiB;
constexpr int CW_BAR = 4096;
constexpr int LDS_BYTES = 163840, MISC_OFF = LDS_BYTES - 256;
constexpr int WAREA = 17920;
constexpr int BIASREL_OFF = NWAVES * WAREA;
static_assert(BIASREL_OFF + 2 * 129 * 16 * 4 <= MISC_OFF, "LDS map");

constexpr float ALPHA = 1.18920711500272f;
constexpr float LN_EPS = 1e-5f;

struct Args { const float* in[29]; float* out; unsigned char* ws; int ph_lo, ph_hi; };
enum { I_XP = 0, I_XS, I_CK, I_CV, I_CKI, I_SCONV, I_SSSM, I_PT, I_BIAS, I_WIN, I_CONVW, I_CONVB, I_DTB, I_ALOG, I_DSKIP, I_NORMG, I_WBS, I_WBA, I_WOUT,
       I_F1WI, I_F1WO, I_F2WI, I_F2WO, I_LN1G, I_LN1B, I_LN2G, I_LN2B, I_LN3G, I_LN3B };

__device__ __forceinline__ float bf2f(unsigned v) { return __uint_as_float(v << 16); }
__device__ __forceinline__ unsigned f2bf(float f) { unsigned u = __float_as_uint(f); return (u + 0x7fffu + ((u >> 16) & 1u)) >> 16; }
__device__ __forceinline__ unsigned pk2(float lo, float hi) { return pg8::cvt_pk_bf16(lo, hi); }
__device__ __forceinline__ void unpack8(const u32x4 w, float (&f)[8]) {
#pragma unroll
    for (int i = 0; i < 4; ++i) { f[2 * i] = __uint_as_float(w[i] << 16); f[2 * i + 1] = __uint_as_float(w[i] & 0xffff0000u); }
}
__device__ __forceinline__ u32x4 pack8(const float (&f)[8]) { u32x4 w; w.x = pk2(f[0], f[1]); w.y = pk2(f[2], f[3]); w.z = pk2(f[4], f[5]); w.w = pk2(f[6], f[7]); return w; }
__device__ __forceinline__ float sigmoidf_(float x) { return 1.0f / (1.0f + __expf(-x)); }
__device__ __forceinline__ float siluf_(float x) { return x / (1.0f + __expf(-x)); }
__device__ __forceinline__ float wave_sum(float v) {
#pragma unroll
    for (int o = 1; o < 64; o <<= 1) v += __shfl_xor(v, o);
    return v;
}
__device__ __forceinline__ float wave_max(float v) {
#pragma unroll
    for (int o = 1; o < 64; o <<= 1) v = fmaxf(v, __shfl_xor(v, o));
    return v;
}
__device__ __forceinline__ f32x4 mfma16(bf16x8 a, bf16x8 b, f32x4 c) { return __builtin_amdgcn_mfma_f32_16x16x32_bf16(a, b, c, 0, 0, 0); }
__device__ __forceinline__ int mbcnt64(unsigned long long m) { return (int)__builtin_amdgcn_mbcnt_hi((unsigned)(m >> 32), __builtin_amdgcn_mbcnt_lo((unsigned)m, 0u)); }

struct EpiSwiglu {
    static constexpr bool PERM = true, AFTER_DRAIN = false;
    bf16_t* O;
    __device__ __forceinline__ void operator()(const f32x4 (&acc)[2][2][4][2], const pg8::Unit& u, int wr, int wc, int fr, int fq) const {
        const int row0 = u.pm * 256 + wr * 64 + fr, col0 = u.pn * 128 + wc * 32 + 8 * fq;
#pragma unroll
        for (int ai = 0; ai < 2; ++ai)
#pragma unroll
            for (int m = 0; m < 4; ++m) {
                float o[8];
#pragma unroll
                for (int n = 0; n < 2; ++n)
#pragma unroll
                    for (int j = 0; j < 4; ++j) { const float g = acc[ai][0][m][n][j], up = acc[ai][1][m][n][j]; o[4 * n + j] = siluf_(g) * up; }
                *(u32x4*)(O + (size_t)(row0 + ai * 128 + m * 16) * DFF + col0) = pack8(o);
            }
    }
};
struct EpiResid {
    static constexpr bool PERM = false, AFTER_DRAIN = false;
    const float* base_p; const float* base_s; float* T; float alpha, s;
    __device__ __forceinline__ void operator()(const f32x4 (&acc)[2][2][4][2], const pg8::Unit& u, int wr, int wc, int fr, int fq) const {
        const int row0 = u.pm * 256 + wr * 64 + fr, col0 = u.pn * 256 + wc * 32 + 4 * fq;
#pragma unroll
        for (int ai = 0; ai < 2; ++ai)
#pragma unroll
            for (int m = 0; m < 4; ++m) {
                const int r = row0 + ai * 128 + m * 16;
                const float* b = (r < MP) ? base_p + (size_t)r * D : base_s + (size_t)(r - MP) * D;
#pragma unroll
                for (int bj = 0; bj < 2; ++bj)
#pragma unroll
                    for (int n = 0; n < 2; ++n) { const int c = col0 + bj * 128 + n * 16; const f32x4 bv = *(const f32x4*)(b + c);
                        *(f32x4*)(T + (size_t)r * D + c) = bv * alpha + acc[ai][bj][m][n] * s; }
            }
    }
};
struct EpiWin {
    static constexpr bool PERM = true, AFTER_DRAIN = false;
    bf16_t* P; float* smf; float* out;
    __device__ __forceinline__ void operator()(const f32x4 (&acc)[2][2][4][2], const pg8::Unit& u, int wr, int wc, int fr, int fq) const {
        const int row0 = u.pm * 256 + wr * 64 + fr, cl = wc * 32 + 8 * fq, col0 = u.pn * 256 + cl;
#pragma unroll
        for (int ai = 0; ai < 2; ++ai)
#pragma unroll
            for (int m = 0; m < 4; ++m) {
                const int r = row0 + ai * 128 + m * 16;
#pragma unroll
                for (int bj = 0; bj < 2; ++bj) {
                    const f32x4 v0 = acc[ai][bj][m][0], v1 = acc[ai][bj][m][1];
                    u32x4 w; w.x = pk2(v0[0], v0[1]); w.y = pk2(v0[2], v0[3]); w.z = pk2(v1[0], v1[1]); w.w = pk2(v1[2], v1[3]);
                    *(u32x4*)(P + (size_t)r * NP + col0 + bj * 128) = w;
                    if (u.pn == 20) {
                        if (bj == 0) {
                            float* d = smf + (size_t)r * 128 + cl; *(f32x4*)d = v0; *(f32x4*)(d + 4) = v1;
                            if (cl >= 64) { float* k = out + ((r < MP) ? O_KIP + (size_t)r * 64 : O_KIS + (size_t)(r - MP) * 64) + (cl - 64); *(f32x4*)k = v0; *(f32x4*)(k + 4) = v1; }
                        }
                    } else if (u.pn == 25) {
                        float* k = out + ((r < MP) ? O_KP + (size_t)r * 256 : O_KS + (size_t)(r - MP) * 256) + bj * 128 + cl; *(f32x4*)k = v0; *(f32x4*)(k + 4) = v1;
                    } else if (u.pn == 26) {
                        float* k = out + ((r < MP) ? O_VP + (size_t)r * 256 : O_VS + (size_t)(r - MP) * 256) + bj * 128 + cl; *(f32x4*)k = v0; *(f32x4*)(k + 4) = v1;
                    }
                }
            }
    }
};
struct EpiGateA {
    static constexpr bool PERM = false, AFTER_DRAIN = false;
    const bf16_t* P; int gcol; float* M1;
    __device__ __forceinline__ void operator()(const f32x4 (&acc)[2][2][4][2], const pg8::Unit& u, int wr, int wc, int fr, int fq) const {
        const int row0 = u.pm * 256 + wr * 64 + fr, col0 = u.pn * 256 + wc * 32 + 4 * fq;
#pragma unroll
        for (int ai = 0; ai < 2; ++ai)
#pragma unroll
            for (int m = 0; m < 4; ++m) {
                const int r = row0 + ai * 128 + m * 16;
#pragma unroll
                for (int bj = 0; bj < 2; ++bj)
#pragma unroll
                    for (int n = 0; n < 2; ++n) { const int c = col0 + bj * 128 + n * 16; const u32x2 gw = *(const u32x2*)(P + (size_t)r * NP + gcol + c);
                        f32x4 g; g[0] = sigmoidf_(__uint_as_float(gw.x << 16)); g[1] = sigmoidf_(__uint_as_float(gw.x & 0xffff0000u)); g[2] = sigmoidf_(__uint_as_float(gw.y << 16)); g[3] = sigmoidf_(__uint_as_float(gw.y & 0xffff0000u));
                        *(f32x4*)(M1 + (size_t)r * D + c) = g * acc[ai][bj][m][n]; }
            }
    }
};
struct EpiGateS {
    static constexpr bool PERM = true, AFTER_DRAIN = false;
    const bf16_t* P; int gcol; const float* M1; bf16_t* MG;
    __device__ __forceinline__ void operator()(const f32x4 (&acc)[2][2][4][2], const pg8::Unit& u, int wr, int wc, int fr, int fq) const {
        const int row0 = u.pm * 256 + wr * 64 + fr, col0 = u.pn * 256 + wc * 32 + 8 * fq;
#pragma unroll
        for (int ai = 0; ai < 2; ++ai)
#pragma unroll
            for (int m = 0; m < 4; ++m) {
                const int r = row0 + ai * 128 + m * 16;
#pragma unroll
                for (int bj = 0; bj < 2; ++bj) { const int c = col0 + bj * 128;
                    const u32x4 gw = *(const u32x4*)(P + (size_t)r * NP + gcol + c); float g[8]; unpack8(gw, g);
                    const f32x4 m0 = *(const f32x4*)(M1 + (size_t)r * D + c), m1 = *(const f32x4*)(M1 + (size_t)r * D + c + 4);
                    float o[8];
#pragma unroll
                    for (int j = 0; j < 4; ++j) { o[j] = m0[j] + sigmoidf_(g[j]) * acc[ai][bj][m][0][j]; o[4 + j] = m1[j] + sigmoidf_(g[4 + j]) * acc[ai][bj][m][1][j]; }
                    *(u32x4*)(MG + (size_t)r * D + c) = pack8(o); }
            }
    }
};

__device__ __forceinline__ void tr_item(const float* W, int K, int Nsrc, bf16_t* WT, int k0, int drow0, int scol0, int nvalid, LAS float* scr, int lane) {
    const int c = lane & 31;
#pragma unroll 8
    for (int i = 0; i < 32; ++i) { const int kk = 2 * i + (lane >> 5); float v = 0.f; if (c < nvalid) v = W[(size_t)(k0 + kk) * Nsrc + scol0 + c]; scr[kk * 33 + c] = v; }
    asm volatile("s_waitcnt lgkmcnt(0)" ::: "memory");
    const int cc = lane & 7;
#pragma unroll
    for (int j = 0; j < 4; ++j) { const int n = (lane >> 3) + 8 * j; const LAS float* s = scr + (8 * cc) * 33 + n;
        u32x4 o; o.x = pk2(s[0 * 33], s[1 * 33]); o.y = pk2(s[2 * 33], s[3 * 33]); o.z = pk2(s[4 * 33], s[5 * 33]); o.w = pk2(s[6 * 33], s[7 * 33]);
        *(u32x4*)(WT + (size_t)(drow0 + n) * K + k0 + 8 * cc) = o; }
    asm volatile("s_waitcnt lgkmcnt(0)" ::: "memory");
}
__device__ __forceinline__ void tr_map(int mode, int n0, int& scol0, int& nvalid) {
    nvalid = 32;
    if (mode == 0) { scol0 = n0; }
    else if (mode == 1) { const int j = n0 >> 8, i = n0 & 255; scol0 = (i < 128) ? j * 128 + i : DFF + j * 128 + (i - 128); }
    else {
        if (n0 < 5120) scol0 = n0;
        else if (n0 < 5376) { const int j = n0 - 5120;
            if (j == 0) scol0 = 5120;
            else if (j == 32) { scol0 = 7264; nvalid = 8; }
            else if (j == 64 || j == 96) scol0 = 7200 + (j - 64);
            else { scol0 = 0; nvalid = 0; } }
        else if (n0 < 6400) scol0 = 5152 + (n0 - 5376);
        else if (n0 < 6656) scol0 = 6176 + (n0 - 6400);
        else if (n0 < 6912) scol0 = 6432 + (n0 - 6656);
        else if (n0 < 7424) scol0 = 6688 + (n0 - 6912);
        else scol0 = 7272 + (n0 - 7424);
    }
}
__device__ __forceinline__ void p0_prologue(const Args& A, LAS unsigned char* lds, int gw, int NGW, int wave, int lane) {
    LAS float* scr = (LAS float*)(lds + wave * 16384);
    unsigned char* ws = A.ws;
    constexpr int NI0 = 16 * 176, NI1 = 44 * 32, NI2 = 16 * 296, NI3 = 32 * 32, NI4 = 16 * 32, NI5 = 16 * 32, NI6 = NI0, NI7 = NI1;
    constexpr int NIT = NI0 + NI1 + NI2 + NI3 + NI4 + NI5 + NI6 + NI7;
    for (int it = gw; it < NIT; it += NGW) {
        int r = it; const float* W; bf16_t* WT; int K, Nsrc, nblk, mode;
        if (r < NI0) { W = A.in[I_F1WI]; WT = (bf16_t*)(ws + WS_W1A); K = 1024; Nsrc = 2 * DFF; nblk = 176; mode = 1; }
        else if ((r -= NI0) < NI1) { W = A.in[I_F1WO]; WT = (bf16_t*)(ws + WS_W1B); K = DFF; Nsrc = 1024; nblk = 32; mode = 0; }
        else if ((r -= NI1) < NI2) { W = A.in[I_WIN]; WT = (bf16_t*)(ws + WS_WIN); K = 1024; Nsrc = 9320; nblk = 296; mode = 2; }
        else if ((r -= NI2) < NI3) { W = A.in[I_WBS]; WT = (bf16_t*)(ws + WS_WBS); K = 2048; Nsrc = 1024; nblk = 32; mode = 0; }
        else if ((r -= NI3) < NI4) { W = A.in[I_WBA]; WT = (bf16_t*)(ws + WS_WBA); K = 1024; Nsrc = 1024; nblk = 32; mode = 0; }
        else if ((r -= NI4) < NI5) { W = A.in[I_WOUT]; WT = (bf16_t*)(ws + WS_WOUT); K = 1024; Nsrc = 1024; nblk = 32; mode = 0; }
        else if ((r -= NI5) < NI6) { W = A.in[I_F2WI]; WT = (bf16_t*)(ws + WS_W2A); K = 1024; Nsrc = 2 * DFF; nblk = 176; mode = 1; }
        else { r -= NI6; W = A.in[I_F2WO]; WT = (bf16_t*)(ws + WS_W2B); K = DFF; Nsrc = 1024; nblk = 32; mode = 0; }
        const int kb = r / nblk, nb = r % nblk; int scol0, nvalid; tr_map(mode, nb * 32, scol0, nvalid);
        tr_item(W, K, Nsrc, WT, kb * 64, nb * 32, scol0, nvalid, scr, lane);
    }
    bf16_t* XB = (bf16_t*)(ws + WS_XB);
    const int nchunk = M * D / 8;
    for (int ch = gw * 64 + lane; ch < nchunk; ch += NGW * 64) {
        const int m = ch >> 7, c = (ch & 127) * 8;
        const float* src = (m < MP) ? A.in[I_XP] + (size_t)m * D + c : A.in[I_XS] + (size_t)(m - MP) * D + c;
        const f32x4 a = *(const f32x4*)src, b = *(const f32x4*)(src + 4);
        u32x4 w; w.x = pk2(a[0], a[1]); w.y = pk2(a[2], a[3]); w.z = pk2(b[0], b[1]); w.w = pk2(b[2], b[3]);
        *(u32x4*)(XB + (size_t)m * D + c) = w;
    }
}

__device__ __forceinline__ void ln_phase(const float* T, const float* g, const float* b, float* outf, bf16_t* outb, int gw, int NGW, int lane) {
    f32x4 gv[4], bv[4];
#pragma unroll
    for (int j = 0; j < 4; ++j) { gv[j] = *(const f32x4*)(g + 4 * lane + 256 * j); bv[j] = *(const f32x4*)(b + 4 * lane + 256 * j); }
    for (int m = gw; m < M; m += NGW) {
        const float* xr = T + (size_t)m * D + 4 * lane;
        f32x4 v[4]; float s = 0.f;
#pragma unroll
        for (int j = 0; j < 4; ++j) { v[j] = *(const f32x4*)(xr + 256 * j); s += (v[j][0] + v[j][1]) + (v[j][2] + v[j][3]); }
        const float mean = wave_sum(s) * (1.f / D); float s2 = 0.f;
#pragma unroll
        for (int j = 0; j < 4; ++j) { v[j] = v[j] - mean; s2 += (v[j][0] * v[j][0] + v[j][1] * v[j][1]) + (v[j][2] * v[j][2] + v[j][3] * v[j][3]); }
        const float rstd = 1.0f / sqrtf(wave_sum(s2) * (1.f / D) + LN_EPS);
#pragma unroll
        for (int j = 0; j < 4; ++j) {
            const f32x4 o = v[j] * rstd * gv[j] + bv[j];
            *(f32x4*)(outf + (size_t)m * D + 4 * lane + 256 * j) = o;
            if (outb) { u32x2 w; w.x = pk2(o[0], o[1]); w.y = pk2(o[2], o[3]); *(u32x2*)(outb + (size_t)m * D + 4 * lane + 256 * j) = w; }
        }
    }
}

template <int NT  , bool SAMP>
__device__ __forceinline__ void conv_item(const Args& A, int b, int t0, int cg, int lane) {
    const bf16_t* P = (const bf16_t*)(A.ws + WS_P); bf16_t* XC = (bf16_t*)(A.ws + WS_XC);
    const float* cw = A.in[I_CONVW]; const float* cb = A.in[I_CONVB];
    const int ch = (cg * 64 + lane) * 8;
    const size_t row0 = SAMP ? (size_t)(MP + b * 4) : (size_t)(b * 2048 + t0);
    u32x4 raw[NT + 3];
#pragma unroll
    for (int i = 0; i < NT + 3; ++i) {
        const int t = t0 - 3 + i;
        if (t >= 0) raw[i] = *(const u32x4*)(P + (row0 + (size_t)(i - 3)) * NP + PXBC + ch);
        else raw[i] = (u32x4){0u, 0u, 0u, 0u};
    }
    float w[4][8], bias[8];
#pragma unroll
    for (int j = 0; j < 4; ++j) { const f32x4 w0 = *(const f32x4*)(cw + (size_t)j * XCW + ch), w1 = *(const f32x4*)(cw + (size_t)j * XCW + ch + 4);
#pragma unroll
        for (int i = 0; i < 4; ++i) { w[j][i] = w0[i]; w[j][4 + i] = w1[i]; } }
    { const f32x4 b0 = *(const f32x4*)(cb + ch), b1 = *(const f32x4*)(cb + ch + 4);
#pragma unroll
      for (int i = 0; i < 4; ++i) { bias[i] = b0[i]; bias[4 + i] = b1[i]; } }
    float u0[8], u1[8], u2[8];
    if (SAMP) {
        const float* sc = A.in[I_SCONV] + (size_t)b * 3 * XCW + ch;
#pragma unroll
        for (int i = 0; i < 4; ++i) { const f32x4 a0 = *(const f32x4*)(sc), a1 = *(const f32x4*)(sc + 4), c0 = *(const f32x4*)(sc + XCW), c1 = *(const f32x4*)(sc + XCW + 4), e0 = *(const f32x4*)(sc + 2 * XCW), e1 = *(const f32x4*)(sc + 2 * XCW + 4);
            u0[i] = a0[i]; u0[4 + i] = a1[i]; u1[i] = c0[i]; u1[4 + i] = c1[i]; u2[i] = e0[i]; u2[4 + i] = e1[i]; }
    } else { unpack8(raw[0], u0); unpack8(raw[1], u1); unpack8(raw[2], u2); }
#pragma unroll
    for (int i = 0; i < NT; ++i) {
        float u3[8], o[8]; unpack8(raw[i + 3], u3);
#pragma unroll
        for (int e = 0; e < 8; ++e) o[e] = siluf_(bias[e] + w[0][e] * u0[e] + w[1][e] * u1[e] + w[2][e] * u2[e] + w[3][e] * u3[e]);
        *(u32x4*)(XC + (row0 + (size_t)i) * XCW + ch) = pack8(o);
        const int t = t0 + i; float* cs = nullptr;
        if (!SAMP) { if (t >= 2045) cs = A.out + O_CVP + ((size_t)b * 3 + (t - 2045)) * XCW + ch; }
        else { if (t >= 1) cs = A.out + O_CVS + ((size_t)b * 3 + (t - 1)) * XCW + ch; }
        if (cs) { *(f32x4*)cs = (f32x4){u3[0], u3[1], u3[2], u3[3]}; *(f32x4*)(cs + 4) = (f32x4){u3[4], u3[5], u3[6], u3[7]}; }
#pragma unroll
        for (int e = 0; e < 8; ++e) { u0[e] = u1[e]; u1[e] = u2[e]; u2[e] = u3[e]; }
    }
}
__device__ __forceinline__ void conv_phase(const Args& A, int gw, int NGW, int lane) {
    constexpr int NPI = 8 * 128 * 6, NSI = 128 * 6;
    for (int it = gw; it < NPI + NSI; it += NGW) {
        if (it < NPI) { const int cg = it % 6, r = it / 6; conv_item<16, false>(A, r >> 7, (r & 127) * 16, cg, lane); }
        else { const int r = it - NPI; conv_item<4, true>(A, r / 6, 0, r % 6, lane); }
    }
}

constexpr float IDX_SCALE = 0.125f * 0.35355339059327373f;
constexpr int SCL = 2052;
__device__ __forceinline__ unsigned f2key(float v) { unsigned u = (v == 0.f) ? 0u : __float_as_uint(v); return (u & 0x80000000u) ? ~u : (u | 0x80000000u); }
__device__ __forceinline__ void scores_select_prompt_unit(const Args& A, LAS unsigned char* lds, int b, int qt, int wave, int lane_in) {
    const bf16_t* P = (const bf16_t*)(A.ws + WS_P); const float* SMF = (const float*)(A.ws + WS_SMF);
    unsigned long long* MASKW = (unsigned long long*)(A.ws + WS_SC);
    LAS float* sc = (LAS float*)lds;
    int lane = lane_in; asm volatile("" : "+v"(lane));
    const int fr = lane & 15, fq = lane >> 4;
    {
        const size_t rowq = (size_t)(b * 2048 + qt * 16 + fr);
        bf16x8 Af[8][2];
#pragma unroll
        for (int h = 0; h < 8; ++h)
#pragma unroll
            for (int ks = 0; ks < 2; ++ks) Af[h][ks] = *(const bf16x8*)(P + rowq * NP + PQI + h * 64 + ks * 32 + 8 * fq);
        float wq[4][8];
#pragma unroll
        for (int j = 0; j < 4; ++j) { const float* wp = SMF + (size_t)(b * 2048 + qt * 16 + 4 * fq + j) * 128 + 32; const f32x4 w0 = *(const f32x4*)wp, w1 = *(const f32x4*)(wp + 4);
#pragma unroll
            for (int h = 0; h < 4; ++h) { wq[j][h] = w0[h] * IDX_SCALE; wq[j][4 + h] = w1[h] * IDX_SCALE; } }
        const bf16_t* kbase = P + (size_t)(b * 2048 + fr) * NP + PSM + 64 + 8 * fq;
        bf16x8 nB0 = {0, 0, 0, 0, 0, 0, 0, 0}, nB1 = nB0;
        if (wave <= qt) { const bf16_t* kp = kbase + (size_t)wave * 16 * NP; nB0 = *(const bf16x8*)kp; nB1 = *(const bf16x8*)(kp + 32); }
        for (int kt = wave; kt <= qt; kt += NWAVES) {
            const bf16x8 B0 = nB0, B1 = nB1;
            if (kt + NWAVES <= qt) { const bf16_t* kp = kbase + (size_t)(kt + NWAVES) * 16 * NP; nB0 = *(const bf16x8*)kp; nB1 = *(const bf16x8*)(kp + 32); }
            f32x4 scv = {0.f, 0.f, 0.f, 0.f};
#pragma unroll
            for (int h = 0; h < 8; ++h) { f32x4 d = {0.f, 0.f, 0.f, 0.f}; d = mfma16(Af[h][0], B0, d); d = mfma16(Af[h][1], B1, d);
#pragma unroll
                for (int j = 0; j < 4; ++j) scv[j] += wq[j][h] * fmaxf(d[j], 0.f); }
#pragma unroll
            for (int j = 0; j < 4; ++j) sc[(4 * fq + j) * SCL + kt * 16 + fr] = scv[j];
#if MK_CHECK_ATT
#pragma unroll
            for (int j = 0; j < 4; ++j) ((float*)(A.ws + WS_END))[(size_t)(b * 2048 + qt * 16 + 4 * fq + j) * SCW + kt * 16 + fr] = scv[j];
#endif
        }
    }
    __syncthreads();
#pragma unroll 1
    for (int u = 0; u < 2; ++u) {
        const int ql = 2 * wave + u, t = qt * 16 + ql, nvalid = t + 1;
        const LAS float* srow = sc + ql * SCL + lane;
        unsigned key[32];
#pragma unroll
        for (int j = 0; j < 32; ++j) key[j] = (lane < nvalid - 64 * j) ? f2key(srow[64 * j]) : 0u;
        unsigned T = 0u; int need_eq = 0;
        if (nvalid > 256) {
            bool exact = false;
            for (int bit = 31; bit >= 0; --bit) {
                const unsigned cand = T | (1u << bit); int cnt = 0;
#pragma unroll
                for (int j = 0; j < 32; ++j) if (64 * j < nvalid) cnt += __popcll(__ballot(key[j] >= cand));
                if (cnt >= 256) { T = cand; if (cnt == 256) { exact = true; break; } }
            }
            if (exact) { T -= 1u; }
            else { int cgt = 0;
#pragma unroll
                for (int j = 0; j < 32; ++j) if (64 * j < nvalid) cgt += __popcll(__ballot(key[j] > T));
                need_eq = 256 - cgt; }
        }
        int eqused = 0; unsigned long long mine = 0ull;
#pragma unroll
        for (int j = 0; j < 32; ++j) {
            unsigned long long ms = 0ull;
            if (64 * j < nvalid) {
                const bool gt = key[j] > T, eq = (need_eq > 0) && (key[j] == T);
                const unsigned long long meq = __ballot(eq);
                const bool sel = gt || (eq && (eqused + mbcnt64(meq) < need_eq));
                eqused += __popcll(meq);
                ms = __ballot(sel);
            }
            if (lane == j) mine = ms;
        }
        if (lane < 32) MASKW[(size_t)(b * 2048 + t) * 32 + lane] = mine;
    }
    __syncthreads();
}
__device__ __forceinline__ void scores_sample_unit(const Args& A, int b, int half, int wave, int lane) {
    const bf16_t* P = (const bf16_t*)(A.ws + WS_P); const float* SMF = (const float*)(A.ws + WS_SMF); float* SCS = (float*)(A.ws + WS_SCS);
    const int* pt = (const int*)A.in[I_PT]; const float* cki = A.in[I_CKI];
    const int fr = lane & 15, fq = lane >> 4;
    bf16x8 Af[2][2]; float wq[2][4];
#pragma unroll
    for (int mt = 0; mt < 2; ++mt) {
#pragma unroll
        for (int ks = 0; ks < 2; ++ks) Af[mt][ks] = *(const bf16x8*)(P + (size_t)(MP + b * 4 + 2 * mt + (fr >> 3)) * NP + PQI + (fr & 7) * 64 + ks * 32 + 8 * fq);
        const f32x4 w = *(const f32x4*)(SMF + (size_t)(MP + b * 4 + 2 * mt + (fq >> 1)) * 128 + 32 + 4 * (fq & 1));
#pragma unroll
        for (int j = 0; j < 4; ++j) wq[mt][j] = w[j] * IDX_SCALE;
    }
    const int kt_end = (half == 0) ? 65 : 129;
    for (int kt = half * 65 + wave; kt < kt_end; kt += NWAVES) {
        const int key = kt * 16 + fr;
        bf16x8 B0, B1;
        if (key < 2048) {
            const int page = pt[b * 16 + (key >> 7)];
            const float* src = cki + ((size_t)page * 128 + (key & 127)) * 64 + 8 * fq;
            const f32x4 a0 = *(const f32x4*)src, a1 = *(const f32x4*)(src + 4), c0 = *(const f32x4*)(src + 32), c1 = *(const f32x4*)(src + 36);
            u32x4 w0, w1; w0.x = pk2(a0[0], a0[1]); w0.y = pk2(a0[2], a0[3]); w0.z = pk2(a1[0], a1[1]); w0.w = pk2(a1[2], a1[3]);
            w1.x = pk2(c0[0], c0[1]); w1.y = pk2(c0[2], c0[3]); w1.z = pk2(c1[0], c1[1]); w1.w = pk2(c1[2], c1[3]);
            B0 = __builtin_bit_cast(bf16x8, w0); B1 = __builtin_bit_cast(bf16x8, w1);
        } else if (key < 2052) {
            const bf16_t* src = P + (size_t)(MP + b * 4 + (key - 2048)) * NP + PSM + 64 + 8 * fq;
            B0 = *(const bf16x8*)src; B1 = *(const bf16x8*)(src + 32);
        } else { B0 = (bf16x8){0, 0, 0, 0, 0, 0, 0, 0}; B1 = B0; }
#pragma unroll
        for (int mt = 0; mt < 2; ++mt) {
            f32x4 d = {0.f, 0.f, 0.f, 0.f}; d = mfma16(Af[mt][0], B0, d); d = mfma16(Af[mt][1], B1, d);
            float s = 0.f;
#pragma unroll
            for (int j = 0; j < 4; ++j) s += wq[mt][j] * fmaxf(d[j], 0.f);
            s += __shfl_xor(s, 16);
            if ((fq & 1) == 0 && key < 2052) SCS[(size_t)(b * 4 + 2 * mt + (fq >> 1)) * SCSW + key] = s;
        }
    }
}

__device__ __forceinline__ float softplusf_(float x) { return fmaxf(x, 0.f) + log1pf(expf(-fabsf(x))); }
__device__ __forceinline__ void ssd_prompt_item(const Args& A, LAS unsigned char* lds, int b, int h) {
    const int tid = threadIdx.x, lane = tid & 63, wave = __builtin_amdgcn_readfirstlane(tid >> 6), fr = lane & 15, fq = lane >> 4;
    const int g = h >> 3;
    const bf16_t* XC = (const bf16_t*)(A.ws + WS_XC); const float* SMF = (const float*)(A.ws + WS_SMF); bf16_t* Y = (bf16_t*)(A.ws + WS_Y);
    LAS bf16_t* Cm = (LAS bf16_t*)lds;
    LAS bf16_t* Bm = Cm + 64 * 136;
    LAS bf16_t* Btw = Bm + 64 * 136;
    LAS bf16_t* Xt = Btw + 128 * 72;
    LAS bf16_t* Mt = Xt + 64 * 72;
    LAS bf16_t* Hp = Mt + 64 * 72;
    LAS float* cum = (LAS float*)(Hp + 64 * 136);
    LAS float* dtv = cum + 64; LAS float* wv = dtv + 64; LAS float* ecum = wv + 64;
    const float Ah = -expf(A.in[I_ALOG][h]), dtb = A.in[I_DTB][h], dsk = A.in[I_DSKIP][h];
    f32x4 hst[4];
#pragma unroll
    for (int i = 0; i < 4; ++i) hst[i] = (f32x4){0.f, 0.f, 0.f, 0.f};
    for (int i = tid; i < 64 * 136 / 8; i += NTHR) *(LAS u32x4*)(Hp + i * 8) = (u32x4){0u, 0u, 0u, 0u};
    const int s0 = tid >> 4, part0 = tid & 15;
    const int xs = tid >> 3, xpart = tid & 7;
    for (int c = 0; c < 32; ++c) {
        const int row0 = b * 2048 + c * 64;
        u32x4 cr[2], br[2];
#pragma unroll
        for (int i = 0; i < 2; ++i) { const bf16_t* rp = XC + (size_t)(row0 + s0 + 32 * i) * XCW + g * 128 + part0 * 8; cr[i] = *(const u32x4*)(rp + 2560); br[i] = *(const u32x4*)(rp + 2048); }
        const u32x4 xr = *(const u32x4*)(XC + (size_t)(row0 + xs) * XCW + h * 64 + xpart * 8);
        if (wave == 0) {
            const float dt = softplusf_(SMF[(size_t)(row0 + lane) * 128 + h] + dtb);
            float v = dt * Ah;
#pragma unroll
            for (int o = 1; o < 64; o <<= 1) { const float n = __shfl_up(v, o); if (lane >= o) v += n; }
            const float ce = __shfl(v, 63);
            cum[lane] = v; dtv[lane] = dt; wv[lane] = dt * expf(ce - v); ecum[lane] = expf(v);
        }
        __syncthreads();
#pragma unroll
        for (int i = 0; i < 2; ++i) {
            const int s = s0 + 32 * i;
            *(LAS u32x4*)(Cm + s * 136 + part0 * 8) = cr[i];
            *(LAS u32x4*)(Bm + s * 136 + part0 * 8) = br[i];
            float bf[8]; unpack8(br[i], bf); const float w = wv[s];
#pragma unroll
            for (int e = 0; e < 8; ++e) Btw[(part0 * 8 + e) * 72 + s] = (bf16_t)f2bf(bf[e] * w);
        }
        {
#pragma unroll
            for (int e = 0; e < 4; ++e) { Xt[(xpart * 8 + 2 * e) * 72 + xs] = (bf16_t)(xr[e] & 0xffffu); Xt[(xpart * 8 + 2 * e + 1) * 72 + xs] = (bf16_t)(xr[e] >> 16); }
        }
        __syncthreads();
        {
            const int st = wave >> 1, tt0 = 2 * (wave & 1);
            bf16x8 a[4];
#pragma unroll
            for (int ks = 0; ks < 4; ++ks) a[ks] = *(const LAS bf16x8*)(Bm + (16 * st + fr) * 136 + ks * 32 + 8 * fq);
#pragma unroll
            for (int u = 0; u < 2; ++u) {
                const int tt = tt0 + u; f32x4 d = {0.f, 0.f, 0.f, 0.f};
#pragma unroll
                for (int ks = 0; ks < 4; ++ks) { const bf16x8 bb = *(const LAS bf16x8*)(Cm + (16 * tt + fr) * 136 + ks * 32 + 8 * fq); d = mfma16(a[ks], bb, d); }
                const int t = 16 * tt + fr; const float ct = cum[t]; float mv[4];
#pragma unroll
                for (int j = 0; j < 4; ++j) { const int s = 16 * st + 4 * fq + j; mv[j] = (s <= t) ? d[j] * expf(ct - cum[s]) * dtv[s] : 0.f; }
                u32x2 w; w.x = pk2(mv[0], mv[1]); w.y = pk2(mv[2], mv[3]);
                *(LAS u32x2*)(Mt + t * 72 + 16 * st + 4 * fq) = w;
            }
        }
        __syncthreads();
        {
            const int pt = wave >> 1, tt0 = 2 * (wave & 1);
            bf16x8 a1[2], a2[4];
#pragma unroll
            for (int ks = 0; ks < 2; ++ks) a1[ks] = *(const LAS bf16x8*)(Xt + (16 * pt + fr) * 72 + ks * 32 + 8 * fq);
#pragma unroll
            for (int ks = 0; ks < 4; ++ks) a2[ks] = *(const LAS bf16x8*)(Hp + (16 * pt + fr) * 136 + ks * 32 + 8 * fq);
#pragma unroll
            for (int u = 0; u < 2; ++u) {
                const int tt = tt0 + u; f32x4 d1 = {0.f, 0.f, 0.f, 0.f}, d2 = {0.f, 0.f, 0.f, 0.f};
#pragma unroll
                for (int ks = 0; ks < 2; ++ks) { const bf16x8 bb = *(const LAS bf16x8*)(Mt + (16 * tt + fr) * 72 + ks * 32 + 8 * fq); d1 = mfma16(a1[ks], bb, d1); }
#pragma unroll
                for (int ks = 0; ks < 4; ++ks) { const bf16x8 bb = *(const LAS bf16x8*)(Cm + (16 * tt + fr) * 136 + ks * 32 + 8 * fq); d2 = mfma16(a2[ks], bb, d2); }
                const int t = 16 * tt + fr; const float et = ecum[t]; float yv[4];
#pragma unroll
                for (int j = 0; j < 4; ++j) { const int p = 16 * pt + 4 * fq + j; yv[j] = d1[j] + et * d2[j] + dsk * bf2f((unsigned)Xt[p * 72 + t]); }
                u32x2 w; w.x = pk2(yv[0], yv[1]); w.y = pk2(yv[2], yv[3]);
                *(u32x2*)(Y + (size_t)(row0 + t) * DI + h * 64 + 16 * pt + 4 * fq) = w;
            }
            bf16x8 a3[2];
#pragma unroll
            for (int ks = 0; ks < 2; ++ks) a3[ks] = *(const LAS bf16x8*)(Btw + (16 * wave + fr) * 72 + ks * 32 + 8 * fq);
            const float dec = ecum[63];
#pragma unroll
            for (int p4 = 0; p4 < 4; ++p4) { f32x4 d = {0.f, 0.f, 0.f, 0.f};
#pragma unroll
                for (int ks = 0; ks < 2; ++ks) { const bf16x8 bb = *(const LAS bf16x8*)(Xt + (16 * p4 + fr) * 72 + ks * 32 + 8 * fq); d = mfma16(a3[ks], bb, d); }
                hst[p4] = hst[p4] * dec + d; }
        }
        __syncthreads();
#pragma unroll
        for (int p4 = 0; p4 < 4; ++p4) { u32x2 w; w.x = pk2(hst[p4][0], hst[p4][1]); w.y = pk2(hst[p4][2], hst[p4][3]);
            *(LAS u32x2*)(Hp + (16 * p4 + fr) * 136 + 16 * wave + 4 * fq) = w; }
    }
    float* so = A.out + O_SSP + ((size_t)b * 32 + h) * 64 * 128;
#pragma unroll
    for (int p4 = 0; p4 < 4; ++p4) *(f32x4*)(so + (size_t)(16 * p4 + fr) * 128 + 16 * wave + 4 * fq) = hst[p4];
    __syncthreads();
}

__device__ __forceinline__ void ssd_sample_item(const Args& A, LAS unsigned char* wl, int b, int h, int lane) {
    const bf16_t* XC = (const bf16_t*)(A.ws + WS_XC); const float* SMF = (const float*)(A.ws + WS_SMF); bf16_t* Y = (bf16_t*)(A.ws + WS_Y);
    LAS float* red = (LAS float*)wl;
    const int g = h >> 3;
    const float Ah = -expf(A.in[I_ALOG][h]), dtb = A.in[I_DTB][h], dsk = A.in[I_DSKIP][h];
#pragma unroll 1
    for (int half = 0; half < 2; ++half) {
        const float* h0 = A.in[I_SSSM] + (((size_t)b * 32 + h) * 64 + 32 * half) * 128 + 2 * lane;
        float st[32][2];
#pragma unroll
        for (int p = 0; p < 32; ++p) { const float2 v = *(const float2*)(h0 + p * 128); st[p][0] = v.x; st[p][1] = v.y; }
#pragma unroll 1
        for (int t = 0; t < 4; ++t) {
            const size_t m = (size_t)(MP + b * 4 + t);
            const float dt = softplusf_(SMF[m * 128 + h] + dtb), dec = expf(dt * Ah);
            const unsigned bw = *(const unsigned*)(XC + m * XCW + 2048 + g * 128 + 2 * lane), cw = *(const unsigned*)(XC + m * XCW + 2560 + g * 128 + 2 * lane);
            const float b0 = bf2f(bw & 0xffffu) * dt, b1 = __uint_as_float(bw & 0xffff0000u) * dt, c0 = bf2f(cw & 0xffffu), c1 = __uint_as_float(cw & 0xffff0000u);
            const float xl = bf2f((unsigned)XC[m * XCW + h * 64 + 32 * half + (lane & 31)]);
#pragma unroll
            for (int p = 0; p < 32; ++p) {
                const float xp = __shfl(xl, p);
                st[p][0] = st[p][0] * dec + xp * b0; st[p][1] = st[p][1] * dec + xp * b1;
                red[p * 65 + lane] = st[p][0] * c0 + st[p][1] * c1;
            }
            asm volatile("s_waitcnt lgkmcnt(0)" ::: "memory");
            float y = 0.f;
#pragma unroll 16
            for (int i = 0; i < 64; ++i) y += red[(lane & 31) * 65 + i];
            y += dsk * xl;
            if (lane < 32) Y[m * DI + h * 64 + 32 * half + lane] = (bf16_t)f2bf(y);
            asm volatile("s_waitcnt lgkmcnt(0)" ::: "memory");
        }
        float* so = A.out + O_SSS + (((size_t)b * 32 + h) * 64 + 32 * half) * 128 + 2 * lane;
#pragma unroll
        for (int p = 0; p < 32; ++p) *(float2*)(so + p * 128) = make_float2(st[p][0], st[p][1]);
    }
}

__device__ __forceinline__ int t5_bucket(int n) {
    if (n < 16) return n;
    const float nf = (float)n;
    int large = 16 + (int)(logf(nf / 16.0f) / 2.0794415416798357f * 16.0f);
    return large < 31 ? large : 31;
}
typedef float f32x16 __attribute__((ext_vector_type(16)));
__device__ __forceinline__ f32x16 mfma32(bf16x8 a, bf16x8 b, f32x16 c) { return __builtin_amdgcn_mfma_f32_32x32x16_bf16(a, b, c, 0, 0, 0); }
constexpr float LOG2E = 1.4426950408889634f;
constexpr int AK_STR = 72, AV_STR = 68, AT_K0 = 0, AT_V0 = 2 * 64 * AK_STR * 2, AT_WS = AT_V0 + 2 * 64 * AV_STR * 2;
__device__ __forceinline__ void attn_prompt_unit(const Args& A, LAS unsigned char* lds, const LAS float* biasL, int b, int g, int qt, int wave, int lane_in) {
    const bf16_t* P = (const bf16_t*)(A.ws + WS_P); const unsigned* MASK32 = (const unsigned*)(A.ws + WS_SC); bf16_t* YA = (bf16_t*)(A.ws + WS_YA);
    int lane = lane_in; asm volatile("" : "+v"(lane));
    const int tid = wave * 64 + lane, r32 = lane & 31, hi = lane >> 5;
    LAS float* wsc = (LAS float*)(lds + AT_WS) + wave * 64;
    const int query = qt * 64 + 8 * wave + (r32 >> 2), head = 4 * g + (r32 & 3);
    const size_t qrow = (size_t)(b * 2048 + query);
    bf16x8 qf[4];
#pragma unroll
    for (int ds = 0; ds < 4; ++ds) qf[ds] = *(const bf16x8*)(P + qrow * NP + PQ + head * 64 + 16 * ds + 8 * hi);
    const unsigned* mrow = MASK32 + qrow * 64;
    const float bfar = biasL[128 * 16 + head];
    const int skey = tid >> 3, sdch = tid & 7;
    const bf16_t* ksrc = P + (size_t)(b * 2048 + skey) * NP + PK + g * 64 + sdch * 8;
    f32x16 O0, O1;
#pragma unroll
    for (int i = 0; i < 16; ++i) { O0[i] = 0.f; O1[i] = 0.f; }
    float m_run = -1e30f, l_run = 0.f;
    u32x4 kreg = *(const u32x4*)ksrc, vreg = *(const u32x4*)(ksrc + 256);
    unsigned mw0 = mrow[0], mw1 = mrow[1];
    {
        LAS bf16_t* Kb = (LAS bf16_t*)(lds + AT_K0); LAS bf16_t* Vb = (LAS bf16_t*)(lds + AT_V0);
        *(LAS u32x4*)(Kb + skey * AK_STR + sdch * 8) = kreg;
#pragma unroll
        for (int e = 0; e < 4; ++e) { Vb[(sdch * 8 + 2 * e) * AV_STR + skey] = (bf16_t)(vreg[e] & 0xffffu); Vb[(sdch * 8 + 2 * e + 1) * AV_STR + skey] = (bf16_t)(vreg[e] >> 16); }
    }
    for (int kt = 0; kt <= qt; ++kt) {
        const int buf = kt & 1;
        __syncthreads();
        const unsigned w0 = mw0 >> (4 * hi), w1 = mw1 >> (4 * hi);
        if (kt < qt) { const bf16_t* src = ksrc + (size_t)(kt + 1) * 64 * NP; kreg = *(const u32x4*)src; vreg = *(const u32x4*)(src + 256); mw0 = mrow[2 * kt + 2]; mw1 = mrow[2 * kt + 3]; }
        const LAS bf16_t* Kb = (const LAS bf16_t*)(lds + AT_K0 + buf * (64 * AK_STR * 2)); const LAS bf16_t* Vb = (const LAS bf16_t*)(lds + AT_V0 + buf * (64 * AV_STR * 2));
        f32x16 S0, S1;
#pragma unroll
        for (int i = 0; i < 16; ++i) { S0[i] = 0.f; S1[i] = 0.f; }
#pragma unroll
        for (int ds = 0; ds < 4; ++ds) {
            const bf16x8 k0 = *(const LAS bf16x8*)(Kb + r32 * AK_STR + 16 * ds + 8 * hi), k1 = *(const LAS bf16x8*)(Kb + (32 + r32) * AK_STR + 16 * ds + 8 * hi);
            S0 = mfma32(k0, qf[ds], S0); S1 = mfma32(k1, qf[ds], S1);
        }
        const float c1 = 0.125f * LOG2E;
        if (qt - kt >= 3) {
#pragma unroll
            for (int i = 0; i < 16; ++i) { const unsigned bit = 1u << ((i & 3) + 8 * (i >> 2));
                S0[i] = (w0 & bit) ? S0[i] * c1 + bfar : -INFINITY; S1[i] = (w1 & bit) ? S1[i] * c1 + bfar : -INFINITY; }
        } else {
            const int kbase = kt * 64 + 4 * hi;
#pragma unroll
            for (int i = 0; i < 16; ++i) { const int pos = (i & 3) + 8 * (i >> 2); const unsigned bit = 1u << pos;
                int r0 = query - (kbase + pos), r1 = r0 - 32; r0 = r0 < 0 ? 0 : (r0 > 128 ? 128 : r0); r1 = r1 < 0 ? 0 : (r1 > 128 ? 128 : r1);
                S0[i] = (w0 & bit) ? S0[i] * c1 + biasL[r0 * 16 + head] : -INFINITY; S1[i] = (w1 & bit) ? S1[i] * c1 + biasL[r1 * 16 + head] : -INFINITY; }
        }
        float tm = fmaxf(S0[0], S1[0]);
#pragma unroll
        for (int i = 1; i < 16; ++i) tm = fmaxf(tm, fmaxf(S0[i], S1[i]));
        tm = fmaxf(tm, __shfl_xor(tm, 32));
        if (__any(tm > m_run + 8.0f)) {
            const float mn = fmaxf(m_run, tm), f = __builtin_amdgcn_exp2f(m_run - mn);
            m_run = mn; l_run *= f;
            if (hi == 0) wsc[r32] = f;
            asm volatile("s_waitcnt lgkmcnt(0)" ::: "memory");
#pragma unroll
            for (int i = 0; i < 16; ++i) { const float fi = wsc[(i & 3) + 8 * (i >> 2) + 4 * hi]; O0[i] *= fi; O1[i] *= fi; }
            asm volatile("s_waitcnt lgkmcnt(0)" ::: "memory");
        }
        float ls = 0.f;
#pragma unroll
        for (int i = 0; i < 16; ++i) { S0[i] = __builtin_amdgcn_exp2f(S0[i] - m_run); S1[i] = __builtin_amdgcn_exp2f(S1[i] - m_run); ls += S0[i] + S1[i]; }
        l_run += ls;
        bf16x8 pa[2][2];
#pragma unroll
        for (int sk = 0; sk < 2; ++sk) {
            u32x4 a0, a1;
            a0.x = pk2(S0[8 * sk + 0], S0[8 * sk + 1]); a0.y = pk2(S0[8 * sk + 2], S0[8 * sk + 3]); a0.z = pk2(S0[8 * sk + 4], S0[8 * sk + 5]); a0.w = pk2(S0[8 * sk + 6], S0[8 * sk + 7]);
            a1.x = pk2(S1[8 * sk + 0], S1[8 * sk + 1]); a1.y = pk2(S1[8 * sk + 2], S1[8 * sk + 3]); a1.z = pk2(S1[8 * sk + 4], S1[8 * sk + 5]); a1.w = pk2(S1[8 * sk + 6], S1[8 * sk + 7]);
            pa[0][sk] = __builtin_bit_cast(bf16x8, a0); pa[1][sk] = __builtin_bit_cast(bf16x8, a1);
        }
#pragma unroll
        for (int blk = 0; blk < 2; ++blk)
#pragma unroll
            for (int sk = 0; sk < 2; ++sk) {
                const int kb = 32 * blk + 16 * sk + 4 * hi;
                const u32x2 a = *(const LAS u32x2*)(Vb + r32 * AV_STR + kb), c = *(const LAS u32x2*)(Vb + r32 * AV_STR + kb + 8);
                const u32x2 a2 = *(const LAS u32x2*)(Vb + (32 + r32) * AV_STR + kb), c2 = *(const LAS u32x2*)(Vb + (32 + r32) * AV_STR + kb + 8);
                const u32x4 v0 = {a.x, a.y, c.x, c.y}, v1 = {a2.x, a2.y, c2.x, c2.y};
                O0 = mfma32(pa[blk][sk], __builtin_bit_cast(bf16x8, v0), O0);
                O1 = mfma32(pa[blk][sk], __builtin_bit_cast(bf16x8, v1), O1);
            }
        if (kt < qt) {
            LAS bf16_t* Kn = (LAS bf16_t*)(lds + AT_K0 + (buf ^ 1) * (64 * AK_STR * 2)); LAS bf16_t* Vn = (LAS bf16_t*)(lds + AT_V0 + (buf ^ 1) * (64 * AV_STR * 2));
            *(LAS u32x4*)(Kn + skey * AK_STR + sdch * 8) = kreg;
#pragma unroll
            for (int e = 0; e < 4; ++e) { Vn[(sdch * 8 + 2 * e) * AV_STR + skey] = (bf16_t)(vreg[e] & 0xffffu); Vn[(sdch * 8 + 2 * e + 1) * AV_STR + skey] = (bf16_t)(vreg[e] >> 16); }
        }
    }
    l_run += __shfl_xor(l_run, 32);
    if (hi == 0) wsc[r32] = 1.0f / l_run;
    asm volatile("s_waitcnt lgkmcnt(0)" ::: "memory");
#pragma unroll
    for (int i = 0; i < 16; ++i) {
        const int rq = (i & 3) + 8 * (i >> 2) + 4 * hi; const float inv = wsc[rq];
        bf16_t* dst = YA + (size_t)(b * 2048 + qt * 64 + 8 * wave + (rq >> 2)) * D + (4 * g + (rq & 3)) * 64 + r32;
        dst[0] = (bf16_t)f2bf(O0[i] * inv); dst[32] = (bf16_t)f2bf(O1[i] * inv);
    }
    __syncthreads();
}

__device__ __forceinline__ void attend_sample_task(const Args& A, LAS unsigned char* wl, const LAS float* biasrel, int ms, int g, int lane_in) {
    constexpr int NJ = 33;
    int lane = lane_in; asm volatile("" : "+v"(lane));
    const bf16_t* P = (const bf16_t*)(A.ws + WS_P);
    const int b = ms >> 2, t = ms & 3, nvalid = 2049 + t, qpos = 2048 + t, m = MP + ms;
    const float* srow = (const float*)(A.ws + WS_SCS) + (size_t)ms * SCSW;
    LAS float* pq = (LAS float*)wl;
    LAS unsigned* rowid = (LAS unsigned*)(wl + 4096);
    LAS unsigned short* posl = (LAS unsigned short*)(wl + 4096 + 1024);
    unsigned key[NJ];
#pragma unroll
    for (int j = 0; j < NJ; ++j) key[j] = (lane < nvalid - 64 * j) ? f2key(srow[lane + 64 * j]) : 0u;
    unsigned T = 0u; int need_eq = 0;
    {
        bool exact = false;
        for (int bit = 31; bit >= 0; --bit) {
            const unsigned cand = T | (1u << bit); int cnt = 0;
#pragma unroll
            for (int j = 0; j < NJ; ++j) cnt += __popcll(__ballot(key[j] >= cand));
            if (cnt >= 256) { T = cand; if (cnt == 256) { exact = true; break; } }
        }
        if (exact) { T -= 1u; }
        else { int cgt = 0;
#pragma unroll
            for (int j = 0; j < NJ; ++j) cgt += __popcll(__ballot(key[j] > T));
            need_eq = 256 - cgt; }
    }
    int base = 0, eqused = 0;
    const int* pt = (const int*)A.in[I_PT];
#pragma unroll
    for (int j = 0; j < NJ; ++j) {
        const bool gt = key[j] > T, eq = (need_eq > 0) && (key[j] == T);
        const unsigned long long meq = __ballot(eq);
        const bool sel = gt || (eq && (eqused + mbcnt64(meq) < need_eq));
        eqused += __popcll(meq);
        const unsigned long long msk = __ballot(sel);
        if (sel) { const int pos = lane + 64 * j, k = base + mbcnt64(msk);
            posl[k] = (unsigned short)pos;
            rowid[k] = (pos < 2048) ? (unsigned)(pt[b * 16 + (pos >> 7)] * 128 + (pos & 127)) : (0x80000000u | (unsigned)(b * 4 + pos - 2048)); }
        base += __popcll(msk);
    }
    { const u32x2 w = *(const u32x2*)(P + (size_t)m * NP + PQ + g * 256 + lane * 4);
      *(LAS f32x4*)(pq + lane * 4) = (f32x4){__uint_as_float(w.x << 16), __uint_as_float(w.x & 0xffff0000u), __uint_as_float(w.y << 16), __uint_as_float(w.y & 0xffff0000u)}; }
    asm volatile("s_waitcnt lgkmcnt(0)" ::: "memory");
    const float* ck = A.in[I_CK]; const float* cv = A.in[I_CV]; const float* kn = A.out + O_KS; const float* vn = A.out + O_VS;
    const float* kp[4]; int rel[4];
#pragma unroll
    for (int i = 0; i < 4; ++i) { const unsigned rid = rowid[lane + 64 * i]; rel[i] = qpos - (int)posl[lane + 64 * i];
        kp[i] = ((rid & 0x80000000u) ? kn + (size_t)(rid & 0x7fffffffu) * 256 : ck + (size_t)rid * 256) + g * 64; }
    float acc[4][4];
#pragma unroll
    for (int i = 0; i < 4; ++i)
#pragma unroll
        for (int hh = 0; hh < 4; ++hh) acc[i][hh] = 0.f;
#pragma unroll 2
    for (int dc = 0; dc < 16; ++dc) {
        f32x4 kv[4];
#pragma unroll
        for (int i = 0; i < 4; ++i) kv[i] = *(const f32x4*)(kp[i] + dc * 4);
#pragma unroll
        for (int hh = 0; hh < 4; ++hh) { const f32x4 q4 = *(const LAS f32x4*)(pq + hh * 64 + dc * 4);
#pragma unroll
            for (int i = 0; i < 4; ++i) acc[i][hh] += kv[i][0] * q4[0] + kv[i][1] * q4[1] + kv[i][2] * q4[2] + kv[i][3] * q4[3]; }
    }
    asm volatile("s_waitcnt lgkmcnt(0)" ::: "memory");
#pragma unroll
    for (int i = 0; i < 4; ++i) { const int rc = rel[i] < 128 ? (rel[i] < 0 ? 0 : rel[i]) : 128; const f32x4 bv = *(const LAS f32x4*)(biasrel + rc * 16 + 4 * g);
#pragma unroll
        for (int hh = 0; hh < 4; ++hh) acc[i][hh] = acc[i][hh] * 0.125f + bv[hh]; }
#pragma unroll
    for (int hh = 0; hh < 4; ++hh) {
        const float mx = wave_max(fmaxf(fmaxf(acc[0][hh], acc[1][hh]), fmaxf(acc[2][hh], acc[3][hh])));
        float sm = 0.f;
#pragma unroll
        for (int i = 0; i < 4; ++i) { acc[i][hh] = __expf(acc[i][hh] - mx); sm += acc[i][hh]; }
        const float inv = 1.0f / wave_sum(sm);
#pragma unroll
        for (int i = 0; i < 4; ++i) acc[i][hh] *= inv;
    }
#pragma unroll
    for (int i = 0; i < 4; ++i) *(LAS f32x4*)(pq + (lane + 64 * i) * 4) = (f32x4){acc[i][0], acc[i][1], acc[i][2], acc[i][3]};
    asm volatile("s_waitcnt lgkmcnt(0)" ::: "memory");
    float o[4] = {0.f, 0.f, 0.f, 0.f};
    for (int k0 = 0; k0 < 256; k0 += 8) {
        float vv[8]; f32x4 pp[8];
#pragma unroll
        for (int u = 0; u < 8; ++u) { const unsigned rid = rowid[k0 + u];
            const float* vp = ((rid & 0x80000000u) ? vn + (size_t)(rid & 0x7fffffffu) * 256 : cv + (size_t)rid * 256) + g * 64 + lane;
            vv[u] = *vp; pp[u] = *(const LAS f32x4*)(pq + (k0 + u) * 4); }
#pragma unroll
        for (int u = 0; u < 8; ++u)
#pragma unroll
            for (int hh = 0; hh < 4; ++hh) o[hh] += pp[u][hh] * vv[u];
    }
    bf16_t* YA = (bf16_t*)(A.ws + WS_YA);
#pragma unroll
    for (int hh = 0; hh < 4; ++hh) YA[(size_t)m * D + (4 * g + hh) * 64 + lane] = (bf16_t)f2bf(o[hh]);
    asm volatile("s_waitcnt lgkmcnt(0)" ::: "memory");
}

#if MK_CHECK_ATT
constexpr size_t WS_CHK_SC = WS_END, WS_CHK_YA = WS_CHK_SC + 128 * MiB, WS_CHK_MASK = WS_CHK_YA + 33 * MiB, WS_CHK_END = WS_CHK_MASK + 4 * MiB;
constexpr int CW_CHK = 512;
template <bool SAMPLE> struct KVRow;
template <> struct KVRow<false> {
    typedef const bf16_t* ptr;
    const bf16_t* P;
    __device__ __forceinline__ ptr krow(unsigned rid) const { return P + (size_t)rid * NP + PK; }
    __device__ __forceinline__ ptr vrow(unsigned rid) const { return P + (size_t)rid * NP + PV; }
    static __device__ __forceinline__ void k8(ptr p, float (&f)[8]) { unpack8(*(const u32x4*)p, f); }
    static __device__ __forceinline__ f32x4 v4(ptr p) { const u32x2 w = *(const u32x2*)p;
        return (f32x4){__uint_as_float(w.x << 16), __uint_as_float(w.x & 0xffff0000u), __uint_as_float(w.y << 16), __uint_as_float(w.y & 0xffff0000u)}; }
};
template <> struct KVRow<true> {
    typedef const float* ptr;
    const float* ck; const float* cv; const float* kn; const float* vn;
    __device__ __forceinline__ ptr krow(unsigned rid) const { return (rid & 0x80000000u) ? kn + (size_t)(rid & 0x7fffffffu) * 256 : ck + (size_t)rid * 256; }
    __device__ __forceinline__ ptr vrow(unsigned rid) const { return (rid & 0x80000000u) ? vn + (size_t)(rid & 0x7fffffffu) * 256 : cv + (size_t)rid * 256; }
    static __device__ __forceinline__ void k8(ptr p, float (&f)[8]) { const f32x4 a = *(const f32x4*)p, b = *(const f32x4*)(p + 4);
#pragma unroll
        for (int i = 0; i < 4; ++i) { f[i] = a[i]; f[4 + i] = b[i]; } }
    static __device__ __forceinline__ f32x4 v4(ptr p) { return *(const f32x4*)p; }
};

template <bool SAMPLE>
__device__ __forceinline__ void attend_query(const Args& A, LAS unsigned char* wl, const LAS float* biasrel, int m, int lane_in) {
    constexpr int NJ = SAMPLE ? 33 : 32;
    int lane = lane_in; asm volatile("" : "+v"(lane));
    const bf16_t* P = (const bf16_t*)(A.ws + WS_P);
    int b, nvalid, qpos; const float* srow;
    if (!SAMPLE) { b = m >> 11; const int t = m & 2047; nvalid = t + 1; qpos = t; srow = (const float*)(A.ws + WS_CHK_SC) + (size_t)m * SCW; }
    else { const int ms = m - MP; b = ms >> 2; const int t = ms & 3; nvalid = 2049 + t; qpos = 2048 + t; srow = (const float*)(A.ws + WS_SCS) + (size_t)ms * SCSW; }
    LAS float* pq = (LAS float*)wl;
    LAS unsigned* rowid = (LAS unsigned*)(wl + 16384);
    LAS unsigned short* posl = (LAS unsigned short*)(wl + 16384 + 1024);
    unsigned key[NJ];
#pragma unroll
    for (int j = 0; j < NJ; ++j) { key[j] = (lane < nvalid - 64 * j) ? f2key(srow[lane + 64 * j]) : 0u; }
    unsigned T = 0u; int need_eq = 0;
    if (nvalid > 256) {
        for (int bit = 31; bit >= 0; --bit) {
            const unsigned cand = T | (1u << bit); int cnt = 0;
#pragma unroll
            for (int j = 0; j < NJ; ++j) cnt += __popcll(__ballot(key[j] >= cand));
            if (cnt >= 256) T = cand;
        }
        int cgt = 0;
#pragma unroll
        for (int j = 0; j < NJ; ++j) cgt += __popcll(__ballot(key[j] > T));
        need_eq = 256 - cgt;
    }
    int base = 0, eqused = 0; unsigned long long mine_chk = 0ull;
    const int* pt = (const int*)A.in[I_PT];
#pragma unroll
    for (int j = 0; j < NJ; ++j) {
        const bool gt = key[j] > T, eq = (need_eq > 0) && (key[j] == T);
        const unsigned long long meq = __ballot(eq);
        const bool sel = gt || (eq && (eqused + mbcnt64(meq) < need_eq));
        eqused += __popcll(meq);
        const unsigned long long ms = __ballot(sel);
        if (sel) { const int pos = lane + 64 * j, k = base + mbcnt64(ms);
            posl[k] = (unsigned short)pos;
            unsigned rid;
            if (!SAMPLE) rid = (unsigned)(b * 2048 + pos);
            else rid = (pos < 2048) ? (unsigned)(pt[b * 16 + (pos >> 7)] * 128 + (pos & 127)) : (0x80000000u | (unsigned)(b * 4 + pos - 2048));
            rowid[k] = rid; }
        base += __popcll(ms);
        if (!SAMPLE) { if (lane == j) mine_chk = ms; }
    }
    if (!SAMPLE) { if (lane < 32) ((unsigned long long*)(A.ws + WS_CHK_MASK))[(size_t)m * 32 + lane] = mine_chk; }
    const int nsel = base;
    asm volatile("s_waitcnt lgkmcnt(0)" ::: "memory");
    { const unsigned r0 = rowid[0]; const unsigned short p0 = posl[0];
#pragma unroll
      for (int i = 0; i < 4; ++i) { const int k = lane + 64 * i; if (k >= nsel) { rowid[k] = r0; posl[k] = p0; } } }
    { const u32x4 w0 = *(const u32x4*)(P + (size_t)m * NP + PQ + lane * 16), w1 = *(const u32x4*)(P + (size_t)m * NP + PQ + lane * 16 + 8);
      float f0[8], f1[8]; unpack8(w0, f0); unpack8(w1, f1);
#pragma unroll
      for (int e = 0; e < 8; ++e) { pq[lane * 16 + e] = f0[e]; pq[lane * 16 + 8 + e] = f1[e]; } }
    asm volatile("s_waitcnt lgkmcnt(0)" ::: "memory");
    KVRow<SAMPLE> R;
    if constexpr (!SAMPLE) { R.P = P; } else { R.ck = A.in[I_CK]; R.cv = A.in[I_CV]; R.kn = A.out + O_KS; R.vn = A.out + O_VS; }
    typename KVRow<SAMPLE>::ptr kp[4]; int rel[4];
#pragma unroll
    for (int i = 0; i < 4; ++i) { kp[i] = R.krow(rowid[lane + 64 * i]); rel[i] = qpos - (int)posl[lane + 64 * i]; }
    float acc[4][16];
#pragma unroll
    for (int i = 0; i < 4; ++i)
#pragma unroll
        for (int hh = 0; hh < 16; ++hh) acc[i][hh] = 0.f;
#pragma unroll
    for (int g = 0; g < 4; ++g) {
#pragma unroll 1
        for (int dc = 0; dc < 8; ++dc) {
            float kv[4][8];
#pragma unroll
            for (int i = 0; i < 4; ++i) KVRow<SAMPLE>::k8(kp[i] + g * 64 + dc * 8, kv[i]);
#pragma unroll
            for (int hh = 0; hh < 4; ++hh) {
                const f32x4 q0 = *(const LAS f32x4*)(pq + (4 * g + hh) * 64 + dc * 8), q1 = *(const LAS f32x4*)(pq + (4 * g + hh) * 64 + dc * 8 + 4);
#pragma unroll
                for (int i = 0; i < 4; ++i) {
                    float a = acc[i][4 * g + hh];
#pragma unroll
                    for (int e = 0; e < 4; ++e) { a += kv[i][e] * q0[e]; a += kv[i][4 + e] * q1[e]; }
                    acc[i][4 * g + hh] = a; }
            }
        }
    }
    asm volatile("s_waitcnt lgkmcnt(0)" ::: "memory");
#pragma unroll
    for (int i = 0; i < 4; ++i) {
        const bool valid = (lane + 64 * i) < nsel; const int rc = rel[i] < 128 ? (rel[i] < 0 ? 0 : rel[i]) : 128;
#pragma unroll
        for (int h4 = 0; h4 < 4; ++h4) { const f32x4 bv = *(const LAS f32x4*)(biasrel + rc * 16 + 4 * h4);
#pragma unroll
            for (int e = 0; e < 4; ++e) acc[i][4 * h4 + e] = valid ? acc[i][4 * h4 + e] * 0.125f + bv[e] : -INFINITY; }
    }
#pragma unroll
    for (int hh = 0; hh < 16; ++hh) {
        const float mx = wave_max(fmaxf(fmaxf(acc[0][hh], acc[1][hh]), fmaxf(acc[2][hh], acc[3][hh])));
        float s = 0.f;
#pragma unroll
        for (int i = 0; i < 4; ++i) { acc[i][hh] = __expf(acc[i][hh] - mx); s += acc[i][hh]; }
        const float inv = 1.0f / wave_sum(s);
#pragma unroll
        for (int i = 0; i < 4; ++i) acc[i][hh] *= inv;
    }
#pragma unroll
    for (int i = 0; i < 4; ++i)
#pragma unroll
        for (int h4 = 0; h4 < 4; ++h4) *(LAS f32x4*)(pq + (lane + 64 * i) * 16 + 4 * h4) = (f32x4){acc[i][4 * h4], acc[i][4 * h4 + 1], acc[i][4 * h4 + 2], acc[i][4 * h4 + 3]};
    asm volatile("s_waitcnt lgkmcnt(0)" ::: "memory");
    const int g = lane >> 4;
    f32x4 o[4];
#pragma unroll
    for (int hh = 0; hh < 4; ++hh) o[hh] = (f32x4){0.f, 0.f, 0.f, 0.f};
    const int nloop = (nsel + 3) & ~3;
    for (int k0 = 0; k0 < nloop; k0 += 4) {
        f32x4 vv[4], pp[4];
#pragma unroll
        for (int u = 0; u < 4; ++u) { const unsigned r = rowid[k0 + u]; vv[u] = KVRow<SAMPLE>::v4(R.vrow(r) + lane * 4); pp[u] = *(const LAS f32x4*)(pq + (k0 + u) * 16 + 4 * g); }
#pragma unroll
        for (int u = 0; u < 4; ++u)
#pragma unroll
            for (int hh = 0; hh < 4; ++hh) o[hh] += vv[u] * pp[u][hh];
    }
    bf16_t* YA = (bf16_t*)(A.ws + WS_CHK_YA);
#pragma unroll
    for (int hh = 0; hh < 4; ++hh) { u32x2 w; w.x = pk2(o[hh][0], o[hh][1]); w.y = pk2(o[hh][2], o[hh][3]);
        *(u32x2*)(YA + (size_t)m * D + (4 * g + hh) * 64 + (lane & 15) * 4) = w; }
    asm volatile("s_waitcnt lgkmcnt(0)" ::: "memory");
}


__device__ __forceinline__ void check_compare(const Args& A, int gw, int NGW, int lane) {
    const bf16_t* Y1 = (const bf16_t*)(A.ws + WS_YA); const bf16_t* Y2 = (const bf16_t*)(A.ws + WS_CHK_YA); unsigned* ctl = (unsigned*)(A.ws + WS_CTL);
    for (int m = gw; m < MP; m += NGW) {
        float e = 0.f, n = 0.f;
#pragma unroll
        for (int j = 0; j < 2; ++j) { float a[8], b[8]; unpack8(*(const u32x4*)(Y1 + (size_t)m * D + j * 512 + lane * 8), a); unpack8(*(const u32x4*)(Y2 + (size_t)m * D + j * 512 + lane * 8), b);
#pragma unroll
            for (int i = 0; i < 8; ++i) { const float d = a[i] - b[i]; e += d * d; n += b[i] * b[i]; } }
        e = wave_sum(e); n = wave_sum(n);
        { const unsigned long long w1 = (lane < 32) ? ((const unsigned long long*)(A.ws + WS_SC))[(size_t)m * 32 + lane] : 0ull, w2 = (lane < 32) ? ((const unsigned long long*)(A.ws + WS_CHK_MASK))[(size_t)m * 32 + lane] : 0ull;
          if (__any(w1 != w2) && lane == 0) atomicAdd(ctl + CW_CHK + 3, 1u);
          const int t = m & 2047;
          if (t >= 256) {
              const float* srow = (const float*)(A.ws + WS_CHK_SC) + (size_t)m * SCW;
              int c1 = 0, c2 = 0; float mins1 = INFINITY, maxu1 = -INFINITY, mins2 = INFINITY, maxu2 = -INFINITY;
              for (int j = 0; j < 32; ++j) { const int sp = lane + 64 * j; if (64 * j > t) break;
                  const unsigned long long a1 = __shfl((unsigned long long)w1, j), a2 = __shfl((unsigned long long)w2, j);
                  if (sp <= t) { const float v = srow[sp]; const bool s1 = (a1 >> lane) & 1ull, s2 = (a2 >> lane) & 1ull;
                      if (s1) { ++c1; mins1 = fminf(mins1, v); } else maxu1 = fmaxf(maxu1, v);
                      if (s2) { ++c2; mins2 = fminf(mins2, v); } else maxu2 = fmaxf(maxu2, v); } }
              c1 = (int)wave_sum((float)c1); c2 = (int)wave_sum((float)c2);
              mins1 = -wave_max(-mins1); mins2 = -wave_max(-mins2); maxu1 = wave_max(maxu1); maxu2 = wave_max(maxu2);
              if (lane == 0) { if (c1 != 256 || mins1 < maxu1) atomicAdd(ctl + CW_CHK + 4, 1u); if (c2 != 256 || mins2 < maxu2) atomicAdd(ctl + CW_CHK + 5, 1u); }
          } }
        if (lane == 0 && !(e <= MK_CHECK_TOL * MK_CHECK_TOL * n + 1e-12f)) { const int t = m & 2047; atomicAdd(ctl + CW_CHK + (t < 64 ? 0 : t < 256 ? 1 : 2), 1u); }
    }
}
#endif
__device__ __forceinline__ void gate_norm_phase(const Args& A, int gw, int NGW, int lane) {
    const bf16_t* P = (const bf16_t*)(A.ws + WS_P); bf16_t* Y = (bf16_t*)(A.ws + WS_Y); const float* ng = A.in[I_NORMG];
    for (int it = gw; it < M * 4; it += NGW) {
        const int m = it >> 2, ch = (it & 3) * 512 + lane * 8;
        float y[8], z[8]; unpack8(*(const u32x4*)(Y + (size_t)m * DI + ch), y); unpack8(*(const u32x4*)(P + (size_t)m * NP + PZ + ch), z);
        float ss = 0.f;
#pragma unroll
        for (int i = 0; i < 8; ++i) { y[i] *= siluf_(z[i]); ss += y[i] * y[i]; }
        const float r = 1.0f / sqrtf(wave_sum(ss) * (1.f / 512.f) + LN_EPS);
        const f32x4 g0 = *(const f32x4*)(ng + ch), g1 = *(const f32x4*)(ng + ch + 4);
#pragma unroll
        for (int i = 0; i < 4; ++i) { y[i] = y[i] * r * g0[i]; y[4 + i] = y[4 + i] * r * g1[i]; }
        *(u32x4*)(Y + (size_t)m * DI + ch) = pack8(y);
    }
}

constexpr int NPHASE = 14;
__global__ void __launch_bounds__(NTHR, 2) fwd(Args args) {
    extern __shared__ __attribute__((aligned(16))) unsigned char lds_raw[];
    LAS unsigned char* lds = (LAS unsigned char*)lds_raw;
    const int tid = threadIdx.x, lane = tid & 63, wave = __builtin_amdgcn_readfirstlane(tid >> 6);
    const int G = gridDim.x, bx = blockIdx.x;
    const int vcu = (G % 8 == 0) ? (bx % 8) * (G / 8) + bx / 8 : bx;
    const int gw = vcu * NWAVES + wave, NGW = G * NWAVES;
    unsigned char* ws = args.ws;
    volatile LAS unsigned* MISC = (volatile LAS unsigned*)(lds + MISC_OFF);
    for (int u = tid; u < 64; u += NTHR) MISC[u] = 0u;
    __syncthreads();
    const int lo = args.ph_lo, hi = args.ph_hi;
    XcdBarrier bar; bar.bar = (unsigned*)(ws + WS_CTL) + CW_BAR; bar.x = 0; bar.st = nullptr;
    if (hi - lo > 1) bar = xcd_barrier_post((unsigned*)(ws + WS_CTL) + CW_BAR, MISC + 8);
#define IN(k) (lo <= (k) && (k) < hi)
#define SEAM(k) do { if (IN(k) && IN((k) + 1)) xcd_barrier(bar); } while (0)

    bf16_t* const XB = (bf16_t*)(ws + WS_XB); bf16_t* const ACT = (bf16_t*)(ws + WS_ACT); float* const T = (float*)(ws + WS_T);
    float* const HF = (float*)(ws + WS_HF); bf16_t* const HB = (bf16_t*)(ws + WS_HB); bf16_t* const P = (bf16_t*)(ws + WS_P);
    float* const SMF = (float*)(ws + WS_SMF); bf16_t* const Y = (bf16_t*)(ws + WS_Y); bf16_t* const YA = (bf16_t*)(ws + WS_YA); bf16_t* const MG = (bf16_t*)(ws + WS_MG);

    if (IN(0)) REPK(0) { p0_prologue(args, lds, gw, NGW, wave, lane); }
    SEAM(0);
    if (IN(1)) {
        { pg8::Gemm g{XB, (const bf16_t*)(ws + WS_W1A), M, 2 * DFF, D}; pg8::StaticOrder S; S.init(M, 2 * DFF, G, bx);
        EpiSwiglu E{ACT}; pg8::gemm_phase<EpiSwiglu, pg8::StaticOrder, true, true>(lds, g, S, E); }
        if constexpr (DUPK(1)) { pg8::Gemm g{XB, (const bf16_t*)(ws + WS_W1A), M, 2 * DFF, D}; pg8::StaticOrder S; S.init(M, 2 * DFF, G, bx);
        EpiSwiglu E{ACT}; pg8::gemm_phase<EpiSwiglu, pg8::StaticOrder, true, true>(lds, g, S, E); }
    }
    SEAM(1);
    if (IN(2)) {
        { pg8::Gemm g{ACT, (const bf16_t*)(ws + WS_W1B), M, D, DFF}; pg8::StaticOrder S; S.init(M, D, G, bx);
        EpiResid E{args.in[I_XP], args.in[I_XS], T, ALPHA, 0.5f}; pg8::gemm_phase<EpiResid, pg8::StaticOrder, true, true>(lds, g, S, E); }
        if constexpr (DUPK(2)) { pg8::Gemm g{ACT, (const bf16_t*)(ws + WS_W1B), M, D, DFF}; pg8::StaticOrder S; S.init(M, D, G, bx);
        EpiResid E{args.in[I_XP], args.in[I_XS], T, ALPHA, 0.5f}; pg8::gemm_phase<EpiResid, pg8::StaticOrder, true, true>(lds, g, S, E); }
    }
    SEAM(2);
    if (IN(3)) REPK(3) { ln_phase(T, args.in[I_LN1G], args.in[I_LN1B], HF, HB, gw, NGW, lane); }
    SEAM(3);
    if (IN(4)) {
        { pg8::Gemm g{HB, (const bf16_t*)(ws + WS_WIN), M, NP, D}; pg8::StaticOrder S; S.init(M, NP, G, bx);
        EpiWin E{P, SMF, args.out}; pg8::gemm_phase<EpiWin, pg8::StaticOrder, true, true>(lds, g, S, E); }
        if constexpr (DUPK(4)) { pg8::Gemm g{HB, (const bf16_t*)(ws + WS_WIN), M, NP, D}; pg8::StaticOrder S; S.init(M, NP, G, bx);
        EpiWin E{P, SMF, args.out}; pg8::gemm_phase<EpiWin, pg8::StaticOrder, true, true>(lds, g, S, E); }
    }
    SEAM(4);
    if (IN(5)) REPK(5) {
        conv_phase(args, gw, NGW, lane);
        for (int u = bx; u < 1024; u += G) { const int i = u >> 8, c = u & 255, b = c >> 5, s = c & 31; const int qt = (i == 0) ? s : (i == 1) ? 63 - s : (i == 2) ? 64 + s : 127 - s;
            scores_select_prompt_unit(args, lds, b, qt, wave, lane); }
        for (int u = bx; u < 256; u += G) scores_sample_unit(args, u >> 1, u & 1, wave, lane);
    }
    SEAM(5);
    if (IN(6)) {
        for (int rep = 0; rep < MK_REP_SSDP; ++rep)
        for (int it = bx; it < 256; it += G) ssd_prompt_item(args, lds, it >> 5, it & 31);
        __syncthreads();
        LAS float* biasrel = (LAS float*)(lds + BIASREL_OFF); LAS float* biasL = biasrel + 129 * 16;
        for (int i = tid; i < 129 * 16; i += NTHR) { const int rel = i >> 4, h = i & 15; const float bv = args.in[I_BIAS][t5_bucket(rel) * 16 + h]; biasrel[i] = bv; biasL[i] = bv * LOG2E; }
        __syncthreads();
        for (int rep = 0; rep < MK_REP_ATTP; ++rep)
        for (int u = bx; u < 1024; u += G) { const int i = u >> 8, c = u & 255, bg = c >> 3, s8 = c & 7; const int qt = (i == 0) ? s8 : (i == 1) ? 15 - s8 : (i == 2) ? 16 + s8 : 31 - s8;
            attn_prompt_unit(args, lds, biasL, bg >> 2, bg & 3, qt, wave, lane); }
        __syncthreads();
        LAS unsigned char* wl = lds + wave * WAREA;
        for (int rep = 0; rep < MK_REP_SSDS; ++rep)
        for (int it = gw; it < 4096; it += NGW) ssd_sample_item(args, wl, it >> 5, it & 31, lane);
        for (int rep = 0; rep < MK_REP_ATTS; ++rep)
        for (int q = gw; q < MS * 4; q += NGW) attend_sample_task(args, wl, biasrel, q >> 2, q & 3, lane);
#if MK_CHECK_ATT
        for (int q = gw; q < MP; q += NGW) attend_query<false>(args, wl, biasrel, q, lane);
#endif
        __syncthreads();
    }
    SEAM(6);
    if (IN(7)) {
        gate_norm_phase(args, gw, NGW, lane);
#if MK_CHECK_ATT
        check_compare(args, gw, NGW, lane);
#endif
        { pg8::Gemm g{YA, (const bf16_t*)(ws + WS_WBA), M, D, D}; pg8::StaticOrder S; S.init(M, D, G, bx);
        EpiGateA E{P, PG + D, T}; pg8::gemm_phase<EpiGateA, pg8::StaticOrder, true, true>(lds, g, S, E); }
        if constexpr (DUPK(7)) { pg8::Gemm g{YA, (const bf16_t*)(ws + WS_WBA), M, D, D}; pg8::StaticOrder S; S.init(M, D, G, bx);
        EpiGateA E{P, PG + D, T}; pg8::gemm_phase<EpiGateA, pg8::StaticOrder, true, true>(lds, g, S, E); }
    }
    SEAM(7);
    if (IN(8)) {
        { pg8::Gemm g{Y, (const bf16_t*)(ws + WS_WBS), M, D, DI}; pg8::StaticOrder S; S.init(M, D, G, bx);
        EpiGateS E{P, PG, T, MG}; pg8::gemm_phase<EpiGateS, pg8::StaticOrder, true, true>(lds, g, S, E); }
        if constexpr (DUPK(8)) { pg8::Gemm g{Y, (const bf16_t*)(ws + WS_WBS), M, D, DI}; pg8::StaticOrder S; S.init(M, D, G, bx);
        EpiGateS E{P, PG, T, MG}; pg8::gemm_phase<EpiGateS, pg8::StaticOrder, true, true>(lds, g, S, E); }
    }
    SEAM(8);
    if (IN(9)) {
        { pg8::Gemm g{MG, (const bf16_t*)(ws + WS_WOUT), M, D, D}; pg8::StaticOrder S; S.init(M, D, G, bx);
        EpiResid E{HF, HF + (size_t)MP * D, T, ALPHA, 1.0f}; pg8::gemm_phase<EpiResid, pg8::StaticOrder, true, true>(lds, g, S, E); }
        if constexpr (DUPK(9)) { pg8::Gemm g{MG, (const bf16_t*)(ws + WS_WOUT), M, D, D}; pg8::StaticOrder S; S.init(M, D, G, bx);
        EpiResid E{HF, HF + (size_t)MP * D, T, ALPHA, 1.0f}; pg8::gemm_phase<EpiResid, pg8::StaticOrder, true, true>(lds, g, S, E); }
    }
    SEAM(9);
    if (IN(10)) REPK(10) { ln_phase(T, args.in[I_LN2G], args.in[I_LN2B], HF, HB, gw, NGW, lane); }
    SEAM(10);
    if (IN(11)) {
        { pg8::Gemm g{HB, (const bf16_t*)(ws + WS_W2A), M, 2 * DFF, D}; pg8::StaticOrder S; S.init(M, 2 * DFF, G, bx);
        EpiSwiglu E{ACT}; pg8::gemm_phase<EpiSwiglu, pg8::StaticOrder, true, true>(lds, g, S, E); }
        if constexpr (DUPK(11)) { pg8::Gemm g{HB, (const bf16_t*)(ws + WS_W2A), M, 2 * DFF, D}; pg8::StaticOrder S; S.init(M, 2 * DFF, G, bx);
        EpiSwiglu E{ACT}; pg8::gemm_phase<EpiSwiglu, pg8::StaticOrder, true, true>(lds, g, S, E); }
    }
    SEAM(11);
    if (IN(12)) {
        { pg8::Gemm g{ACT, (const bf16_t*)(ws + WS_W2B), M, D, DFF}; pg8::StaticOrder S; S.init(M, D, G, bx);
        EpiResid E{HF, HF + (size_t)MP * D, T, ALPHA, 0.5f}; pg8::gemm_phase<EpiResid, pg8::StaticOrder, true, true>(lds, g, S, E); }
        if constexpr (DUPK(12)) { pg8::Gemm g{ACT, (const bf16_t*)(ws + WS_W2B), M, D, DFF}; pg8::StaticOrder S; S.init(M, D, G, bx);
        EpiResid E{HF, HF + (size_t)MP * D, T, ALPHA, 0.5f}; pg8::gemm_phase<EpiResid, pg8::StaticOrder, true, true>(lds, g, S, E); }
    }
    SEAM(12);
    if (IN(13)) REPK(13) { ln_phase(T, args.in[I_LN3G], args.in[I_LN3B], args.out + O_Y, nullptr, gw, NGW, lane); }
#if MK_CHECK_ATT
    if (IN(13)) { __syncthreads(); unsigned* cw = (unsigned*)(ws + WS_CTL) + CW_CHK;
        const unsigned b0 = __hip_atomic_load(cw, __ATOMIC_RELAXED, __HIP_MEMORY_SCOPE_AGENT), b1 = __hip_atomic_load(cw + 1, __ATOMIC_RELAXED, __HIP_MEMORY_SCOPE_AGENT), b2 = __hip_atomic_load(cw + 2, __ATOMIC_RELAXED, __HIP_MEMORY_SCOPE_AGENT), b3 = __hip_atomic_load(cw + 3, __ATOMIC_RELAXED, __HIP_MEMORY_SCOPE_AGENT), b4 = __hip_atomic_load(cw + 4, __ATOMIC_RELAXED, __HIP_MEMORY_SCOPE_AGENT), b5 = __hip_atomic_load(cw + 5, __ATOMIC_RELAXED, __HIP_MEMORY_SCOPE_AGENT);
        const float code = MK_CHECK_CODE;
        if (code > 0.f && bx == 0 && tid == 0) args.out[O_Y] = 4096.0f * sqrtf(code); }
#endif
#undef IN
#undef SEAM
}
}

extern "C" void kernel_launch(void* const* d_in, const int* in_sizes, int n_in, void* d_out, int out_size, void* d_ws, size_t ws_size, hipStream_t stream) {
    using namespace mk;
    static int grid = 0;
    if (grid == 0) {
        if (n_in != 29 || (size_t)out_size != O_END || ws_size < WS_END) { fprintf(stderr, "kernel_launch: unexpected shapes (n_in %d, out %d, ws %zu)\n", n_in, out_size, ws_size); grid = -1; return; }
        int dev = 0, cus = 0, per_cu = 0;
        if (hipGetDevice(&dev) != hipSuccess || hipDeviceGetAttribute(&cus, hipDeviceAttributeMultiprocessorCount, dev) != hipSuccess) { grid = -1; return; }
        if (hipFuncSetAttribute((const void*)fwd, hipFuncAttributeMaxDynamicSharedMemorySize, LDS_BYTES) != hipSuccess) { fprintf(stderr, "kernel_launch: hipFuncSetAttribute failed\n"); grid = -1; return; }
        if (hipOccupancyMaxActiveBlocksPerMultiprocessor(&per_cu, (const void*)fwd, NTHR, LDS_BYTES) != hipSuccess || per_cu < 1) fprintf(stderr, "kernel_launch: occupancy query says %d\n", per_cu);
        (void)hipGetLastError();
        grid = cus;
    }
    if (grid < 0) return;
    (void)hipMemsetAsync((char*)d_ws + WS_CTL, 0, CTL_ZERO_BYTES, stream);
    Args a{};
    for (int i = 0; i < 29; ++i) a.in[i] = (const float*)d_in[i];
    a.out = (float*)d_out; a.ws = (unsigned char*)d_ws;
#if MK_SPLIT
    for (int p = 0; p < NPHASE; ++p) { a.ph_lo = p; a.ph_hi = p + 1; hipLaunchKernelGGL(fwd, dim3(grid), dim3(NTHR), LDS_BYTES, stream, a); }
#else
    a.ph_lo = 0; a.ph_hi = NPHASE; hipLaunchKernelGGL(fwd, dim3(grid), dim3(NTHR), LDS_BYTES, stream, a);
#endif
}
```

```cpp
#include <hip/hip_runtime.h>
#include <cstdio>
#include <cstdint>
#define GAS __attribute__((address_space(1)))
#define LAS __attribute__((address_space(3)))
namespace pg8 {
#define PG8_LAS __attribute__((address_space(3)))
typedef unsigned short bf16_t;
typedef short bf16x8 __attribute__((ext_vector_type(8)));
typedef float f32x4 __attribute__((ext_vector_type(4)));
typedef unsigned u32x4 __attribute__((ext_vector_type(4)));
constexpr int BM = 256, BK = 64, HALF = 128, HTB = HALF * BK * 2  , STAGE_BYTES = 8 * HTB, NXCD = 8, WGM = 8;

__host__ __device__ __forceinline__ int lds_byte(int r, int c) { const int st = (r >> 4) * 2 + (c >> 5), rr = r & 15, cc = c & 31, ob = rr * 64 + cc * 2; return st * 1024 + (ob ^ (((ob >> 9) & 1) << 5)); }
__host__ __device__ __forceinline__ void stage_rc(int b, int& R, int& C) { const int st = b / 1024, sb = b % 1024, swz = sb ^ (((sb >> 9) & 1) << 5); R = (st >> 1) * 16 + swz / 64; C = (st & 1) * 32 + (swz % 64) / 2; }
__host__ __device__ __forceinline__ int perm32(int rho) { const int n = rho >> 4, i = rho & 15; return 8 * (i >> 2) + 4 * n + (i & 3); }

struct Unit { int pm, pn; };
struct Gemm { const bf16_t* A; const bf16_t* Bt; int M, N, K; };

struct StaticOrder {
    int nM, nN, nwg, G, c;
    __host__ __device__ void init(int M, int N, int G_, int c_) { nM = M / BM; nN = N / BM; nwg = nM * nN; G = G_; c = c_; }
    __host__ __device__ bool next(int i, Unit& u) const {
        const long L = (long)i * G + c; if (L >= nwg) return false;
        int wgid = (int)L; { const int q = nwg / NXCD, r = nwg % NXCD, xcd = wgid % NXCD, off = wgid / NXCD; wgid = (xcd < r ? xcd * (q + 1) : r * (q + 1) + (xcd - r) * q) + off; }
        const int nig = WGM * nN, gid = wgid / nig, fm = gid * WGM, gsz = (nM - fm) < WGM ? (nM - fm) : WGM;
        u.pm = fm + ((wgid % nig) % gsz); u.pn = (wgid % nig) / gsz; return true;
    }
    __device__ __forceinline__ void a_ready(const Unit&) const {}
    __device__ __forceinline__ void done(const Unit&) const {}
};

__device__ __forceinline__ unsigned cvt_pk_bf16(float lo, float hi) { unsigned r; asm volatile("v_cvt_pk_bf16_f32 %0, %1, %2" : "=v"(r) : "v"(lo), "v"(hi)); return r; }

template <class Epi, class Sched, bool ALIGN_EPI = false, bool SP2 = false>
__device__ __forceinline__ void gemm_phase(PG8_LAS unsigned char* lds, const Gemm g, const Sched& S, const Epi& E) {
    const int tid = threadIdx.x, wid = __builtin_amdgcn_readfirstlane(tid >> 6), lane = tid & 63, wr = wid >> 2, wc = wid & 3, fr = lane & 15, fq = lane >> 4;
    const int K = g.K, nt = K / BK;
    unsigned voffA[2], voffB[2];
#pragma unroll
    for (int i = 0; i < 2; ++i) { int R, C; stage_rc(tid * 16 + i * 8192, R, C); const int Rb = Epi::PERM ? ((R & ~31) + perm32(R & 31)) : R;
        voffA[i] = (unsigned)(R * K + C) * 2u; voffB[i] = (unsigned)(Rb * K + C) * 2u; }
    const size_t kstep = (size_t)(BK * 2);
    const size_t hstep = (size_t)HALF * K * 2;
    const size_t tstep = 2 * hstep;
    const unsigned ldsw = (unsigned)wid * 1024u;
    const int aoff = lds_byte(wr * 64 + fr, fq * 8), boff = lds_byte(wc * 32 + fr, fq * 8);
#define PG8_SA(b, h) (((b) * 2 + (h)) * HTB)
#define PG8_SB(b, h) ((4 + (b) * 2 + (h)) * HTB)
#define PG8_STAGE(bufoff, gbase, voff) do { _Pragma("unroll") for (int _i = 0; _i < 2; ++_i) \
        __builtin_amdgcn_global_load_lds((const unsigned*)((const char*)(gbase) + (voff)[_i]), (PG8_LAS unsigned*)(lds + (bufoff) + ldsw + _i * 8192), 16, 0, 0); } while (0)
#define PG8_LDA(dst, b, h) do { _Pragma("unroll") for (int m = 0; m < 4; ++m) _Pragma("unroll") for (int k = 0; k < 2; ++k) dst[m][k] = *(const PG8_LAS bf16x8*)(lds + PG8_SA(b, h) + aoff + m * 2048 + k * 1024); } while (0)
#define PG8_LDB(dst, b, h) do { _Pragma("unroll") for (int n = 0; n < 2; ++n) _Pragma("unroll") for (int k = 0; k < 2; ++k) dst[n][k] = *(const PG8_LAS bf16x8*)(lds + PG8_SB(b, h) + boff + n * 2048 + k * 1024); } while (0)
#define PG8_MMA(ai, bj, At, Bt) do { __builtin_amdgcn_s_setprio(1); _Pragma("unroll") for (int m = 0; m < 4; ++m) _Pragma("unroll") for (int n = 0; n < 2; ++n) _Pragma("unroll") for (int k = 0; k < 2; ++k) \
        acc[ai][bj][m][n] = __builtin_amdgcn_mfma_f32_16x16x32_bf16(Bt[n][k], At[m][k], acc[ai][bj][m][n], 0, 0, 0); __builtin_amdgcn_s_setprio(0); } while (0)
#define PG8_WAIT_V(n) asm volatile("s_waitcnt vmcnt(" #n ")" ::: "memory")
#define PG8_WAIT_L(n) asm volatile("s_waitcnt lgkmcnt(" #n ")" ::: "memory")
#define PG8_BAR __builtin_amdgcn_s_barrier()
#define PG8_SCHED __builtin_amdgcn_sched_barrier(0)
    Unit cur, nxt; int ui = 0;
    if (!S.next(0, cur)) return;
    f32x4 acc[2][2][4][2];
#pragma unroll
    for (int a = 0; a < 2; ++a)
#pragma unroll
        for (int b = 0; b < 2; ++b)
#pragma unroll
            for (int m = 0; m < 4; ++m)
#pragma unroll
                for (int n = 0; n < 2; ++n) acc[a][b][m][n] = (f32x4){0.f, 0.f, 0.f, 0.f};
    bf16x8 At[4][2], B0[2][2], B1[2][2];
    const char* cA = (const char*)g.A + (size_t)cur.pm * tstep; const char* cB = (const char*)g.Bt + (size_t)cur.pn * tstep;
    S.a_ready(cur);
    if constexpr (SP2) {
        PG8_STAGE(PG8_SB(0, 0), cB, voffB); PG8_STAGE(PG8_SB(0, 1), cB + hstep, voffB); PG8_STAGE(PG8_SA(0, 0), cA, voffA); PG8_STAGE(PG8_SA(0, 1), cA + hstep, voffA);
        if (wr == 1) PG8_BAR;
        PG8_WAIT_V(2); PG8_BAR;
        PG8_STAGE(PG8_SB(1, 0), cB + kstep, voffB); PG8_STAGE(PG8_SA(1, 0), cA + kstep, voffA); PG8_STAGE(PG8_SB(1, 1), cB + hstep + kstep, voffB);
        PG8_WAIT_V(6); PG8_BAR;
    } else {
        PG8_STAGE(PG8_SB(0, 0), cB, voffB); PG8_STAGE(PG8_SA(0, 0), cA, voffA); PG8_STAGE(PG8_SB(0, 1), cB + hstep, voffB); PG8_STAGE(PG8_SA(0, 1), cA + hstep, voffA);
        if (wr == 1) PG8_BAR;
        PG8_WAIT_V(4); PG8_BAR;
        PG8_STAGE(PG8_SB(1, 0), cB + kstep, voffB); PG8_STAGE(PG8_SA(1, 0), cA + kstep, voffA); PG8_STAGE(PG8_SB(1, 1), cB + hstep + kstep, voffB);
        PG8_WAIT_V(6); PG8_BAR;
    }
    for (;;) {
        const bool has_next = S.next(ui + 1, nxt);
        const char* nA = has_next ? (const char*)g.A + (size_t)nxt.pm * tstep : cA; const char* nB = has_next ? (const char*)g.Bt + (size_t)nxt.pn * tstep : cB;
        for (int t = 0; t < nt; t += 2) {
            const bool last = (t == nt - 2);
            const char* a1 = cA + (size_t)(t + 1) * kstep;
            const char* a2 = last ? nA : cA + (size_t)(t + 2) * kstep; const char* b2 = last ? nB : cB + (size_t)(t + 2) * kstep;
            const char* a3 = a2 + kstep; const char* b3 = b2 + kstep;
            if (last && has_next) S.a_ready(nxt);
            if constexpr (SP2) {
            PG8_LDB(B0, 0, 0); PG8_LDB(B1, 0, 1); PG8_SCHED; PG8_LDA(At, 0, 0); PG8_STAGE(PG8_SA(1, 1), a1 + hstep, voffA);
            PG8_WAIT_V(8); PG8_WAIT_L(0); PG8_BAR; PG8_MMA(0, 0, At, B0); PG8_MMA(0, 1, At, B1); PG8_BAR; PG8_SCHED;
            PG8_LDA(At, 0, 1); PG8_STAGE(PG8_SB(0, 0), b2, voffB); PG8_STAGE(PG8_SB(0, 1), b2 + hstep, voffB); PG8_STAGE(PG8_SA(0, 0), a2, voffA);
            PG8_WAIT_V(8); PG8_WAIT_L(0); PG8_BAR; PG8_MMA(1, 0, At, B0); PG8_MMA(1, 1, At, B1); PG8_BAR; PG8_SCHED;
            PG8_LDB(B0, 1, 0); PG8_LDB(B1, 1, 1); PG8_SCHED; PG8_LDA(At, 1, 0); PG8_STAGE(PG8_SA(0, 1), a2 + hstep, voffA);
            PG8_WAIT_V(8); PG8_WAIT_L(0); PG8_BAR; PG8_MMA(0, 0, At, B0); PG8_MMA(0, 1, At, B1); PG8_BAR; PG8_SCHED;
            PG8_LDA(At, 1, 1); PG8_STAGE(PG8_SB(1, 0), b3, voffB); PG8_STAGE(PG8_SB(1, 1), b3 + hstep, voffB); PG8_STAGE(PG8_SA(1, 0), a3, voffA);
            PG8_WAIT_V(8); PG8_WAIT_L(0); PG8_BAR; PG8_MMA(1, 0, At, B0); PG8_MMA(1, 1, At, B1); PG8_BAR; PG8_SCHED;
            } else {
            PG8_LDB(B0, 0, 0); PG8_SCHED; PG8_LDA(At, 0, 0); PG8_STAGE(PG8_SA(1, 1), a1 + hstep, voffA);
            PG8_WAIT_L(8); PG8_BAR; PG8_WAIT_L(0); PG8_MMA(0, 0, At, B0); PG8_BAR; PG8_SCHED;
            PG8_LDB(B1, 0, 1); PG8_STAGE(PG8_SB(0, 0), b2, voffB);
            PG8_BAR; PG8_WAIT_L(0); PG8_MMA(0, 1, At, B1); PG8_BAR;
            PG8_LDA(At, 0, 1); PG8_STAGE(PG8_SA(0, 0), a2, voffA);
            PG8_BAR; PG8_WAIT_L(0); PG8_MMA(1, 0, At, B0); PG8_BAR; PG8_SCHED;
            PG8_STAGE(PG8_SB(0, 1), b2 + hstep, voffB);
            PG8_WAIT_V(6); PG8_BAR; PG8_MMA(1, 1, At, B1); PG8_BAR;
            PG8_LDB(B0, 1, 0); PG8_SCHED; PG8_LDA(At, 1, 0); PG8_STAGE(PG8_SA(0, 1), a2 + hstep, voffA);
            PG8_WAIT_L(8); PG8_BAR; PG8_WAIT_L(0); PG8_MMA(0, 0, At, B0); PG8_BAR; PG8_SCHED;
            PG8_LDB(B1, 1, 1); PG8_STAGE(PG8_SB(1, 0), b3, voffB);
            PG8_BAR; PG8_WAIT_L(0); PG8_MMA(0, 1, At, B1); PG8_BAR;
            PG8_LDA(At, 1, 1); PG8_STAGE(PG8_SA(1, 0), a3, voffA);
            PG8_BAR; PG8_WAIT_L(0); PG8_MMA(1, 0, At, B0); PG8_BAR; PG8_SCHED;
            PG8_STAGE(PG8_SB(1, 1), b3 + hstep, voffB);
            PG8_WAIT_V(6); PG8_BAR; PG8_MMA(1, 1, At, B1); PG8_BAR;
            }
        }
        if constexpr (ALIGN_EPI) { if (wr == 0) PG8_BAR; }
        if constexpr (!Epi::AFTER_DRAIN) { E(acc, cur, wr, wc, fr, fq); S.done(cur); }
        if (!has_next) break;
#pragma unroll
        for (int a = 0; a < 2; ++a)
#pragma unroll
            for (int b = 0; b < 2; ++b)
#pragma unroll
                for (int m = 0; m < 4; ++m)
#pragma unroll
                    for (int n = 0; n < 2; ++n) acc[a][b][m][n] = (f32x4){0.f, 0.f, 0.f, 0.f};
        cur = nxt; cA = nA; cB = nB; ++ui;
        if constexpr (ALIGN_EPI) { if (wr == 1) PG8_BAR; }
    }
    PG8_WAIT_V(0);
    if constexpr (!ALIGN_EPI) { if (wr == 0) PG8_BAR; }
    PG8_BAR;
    if constexpr (Epi::AFTER_DRAIN) { E.fused(acc, cur, wr, wc, fr, fq, lds, wid, lane); S.done(cur); }
#undef PG8_SA
#undef PG8_SB
#undef PG8_STAGE
#undef PG8_LDA
#undef PG8_LDB
#undef PG8_MMA
#undef PG8_WAIT_V
#undef PG8_WAIT_L
#undef PG8_BAR
#undef PG8_SCHED
}
}
#define XB_TMO      128
#define XB_XCNT(j)  (256  + 64 * (j))
#define XB_XSUB(j)  (1280 + 64 * (j))
#define XB_XGEN(j)  (2304 + 64 * (j))
#define XB_TOP      3328
#define XB_TOPGEN   3392
#define XCD_BAR_WORDS 3456
#define XB_SPIN_CAP (1u << 18)

__device__ __forceinline__ unsigned xb_ld(unsigned* p)              { return __hip_atomic_load(p, __ATOMIC_RELAXED, __HIP_MEMORY_SCOPE_AGENT); }
__device__ __forceinline__ unsigned xb_add(unsigned* p, unsigned v) { return __hip_atomic_fetch_add(p, v, __ATOMIC_RELAXED, __HIP_MEMORY_SCOPE_AGENT); }
__device__ __forceinline__ unsigned xb_xcc_id() { return (unsigned)__builtin_amdgcn_s_getreg((3 << 11) | 20) & 0xFu; }
#define XB_SPIN(cond, bar) do { unsigned _sp = 0; while (cond) { __builtin_amdgcn_s_sleep(1); \
    if ((++_sp & 255u) == 0u) { if (xb_ld(&(bar)[XB_TMO])) break; if (_sp > XB_SPIN_CAP) { atomicAdd(&(bar)[XB_TMO], 1u); break; } } } } while (0)

struct XcdBarrier {
    unsigned* bar; unsigned x;
    volatile LAS unsigned* st;
};

__device__ __forceinline__ XcdBarrier xcd_barrier_post(unsigned* bar, volatile LAS unsigned* st) {
    XcdBarrier b; b.bar = bar; b.x = xb_xcc_id(); b.st = st;
    if (threadIdx.x == 0) (void)xb_add(&bar[XB_XCNT(b.x)], 1u);
    return b;
}
__device__ __forceinline__ void xcd_barrier_complete(unsigned* bar, unsigned x, unsigned& nloc, unsigned& nx) {
    const unsigned G = gridDim.x * gridDim.y * gridDim.z;
    unsigned sum, cnt, mine, sp = 0u;
    for (;;) {
        sum = 0u; cnt = 0u; mine = 0u;
#pragma unroll
        for (unsigned j = 0; j < 16; ++j) { const unsigned c = xb_ld(&bar[XB_XCNT(j)]); sum += c; cnt += (c > 0u) ? 1u : 0u; mine = (j == x) ? c : mine; }
        if (sum == G) break;
        __builtin_amdgcn_s_sleep(1);
        if ((++sp & 255u) == 0u) { if (xb_ld(&bar[XB_TMO])) break; if (sp > XB_SPIN_CAP) { atomicAdd(&bar[XB_TMO], 1u); break; } }
    }
    nloc = mine > 0u ? mine : 1u; nx = cnt > 0u ? cnt : 1u;
}

__device__ __forceinline__ void xcd_barrier(const XcdBarrier& b) {
    asm volatile("s_waitcnt vmcnt(0)" ::: "memory");
    __syncthreads();
    if (threadIdx.x == 0) {
        unsigned* bar = b.bar;
        __builtin_amdgcn_s_waitcnt(0);
        unsigned nloc = b.st[0], nx = b.st[1];
        if (nloc == 0u) { xcd_barrier_complete(bar, b.x, nloc, nx); b.st[0] = nloc; b.st[1] = nx; }
        const unsigned old = xb_add(&bar[XB_XSUB(b.x)], 1u);
        const unsigned gen = old / nloc;
        if (old + 1u == (gen + 1u) * nloc) {
            __builtin_amdgcn_fence(__ATOMIC_RELEASE, "agent");
            asm volatile("s_waitcnt vmcnt(0)" ::: "memory");
            const unsigned og = xb_add(&bar[XB_TOP], 1u);
            const unsigned tg = og / nx;
            if (og + 1u == (tg + 1u) * nx) xb_add(&bar[XB_TOPGEN], 1u);
            else XB_SPIN(xb_ld(&bar[XB_TOPGEN]) == tg, bar);
            __builtin_amdgcn_fence(__ATOMIC_ACQUIRE, "agent");
            xb_add(&bar[XB_XGEN(b.x)], 1u);
            asm volatile("s_waitcnt vmcnt(0)" ::: "memory");
        } else {
            XB_SPIN(xb_ld(&bar[XB_XGEN(b.x)]) == gen, bar);
            __builtin_amdgcn_fence(__ATOMIC_ACQUIRE, "agent");
            asm volatile("s_waitcnt vmcnt(0)" ::: "memory");
        }
    }
    __syncthreads();
}
namespace mk {
using pg8::bf16_t; using pg8::bf16x8; using pg8::f32x4; using pg8::u32x4;
typedef unsigned u32x2 __attribute__((ext_vector_type(2)));

#ifndef MK_CHECK_ATT
#define MK_CHECK_ATT 0
#endif
#define MK_REP_SSDP 1
#define MK_REP_CONV 1
#define MK_REP_SCP 1
#define MK_REP_SCS 1
#define MK_REP_SSDS 1
#define MK_REP_ATTS 1
#define MK_REP_ATTP 1
#define MK_CHECK_TOL 0.02f
#define MK_CHECK_CODE ((b0 ? 1.f : 0.f) + (b1 ? 2.f : 0.f) + (b2 ? 4.f : 0.f) + (b3 ? 8.f : 0.f) + (b4 ? 16.f : 0.f) + (b5 ? 32.f : 0.f))
#define MK_REP_MASK 0
#define DUPK(k) (((MK_REP_MASK >> (k)) & 1) != 0)
#define REPK(k) for (int rep_ = 0; rep_ < 1 + ((MK_REP_MASK >> (k)) & 1); ++rep_)
#ifndef MK_SPLIT
#define MK_SPLIT 0
#endif

constexpr int NWAVES = 8, NTHR = 512;
constexpr int MP = 16384, MS = 512, M = MP + MS, D = 1024, DFF = 2816, DI = 2048, NP = 9472, XCW = 3072;
constexpr int PZ = 0, PXBC = 2048, PSM = 5120, PQ = 5376, PK = 6400, PV = 6656, PQI = 6912, PG = 7424;
constexpr int SCW = 2048, SCSW = 2112;
constexpr size_t O_Y = 0, O_KP = 17301504, O_VP = 21495808, O_KIP = 25690112, O_CVP = 26738688, O_SSP = 26812416,
                 O_KS = 28909568, O_VS = 29040640, O_KIS = 29171712, O_CVS = 29204480, O_SSS = 30384128, O_END = 63938560;
constexpr size_t MiB = 1u << 20;
constexpr size_t WS_CTL = 0, CTL_ZERO_BYTES = 1 * MiB;
constexpr size_t WS_W1A = 1 * MiB, WS_W1B = WS_W1A + 11 * MiB, WS_WIN = WS_W1B + 6 * MiB, WS_WBS = WS_WIN + 19 * MiB, WS_WBA = WS_WBS + 4 * MiB,
                 WS_WOUT = WS_WBA + 2 * MiB, WS_W2A = WS_WOUT + 2 * MiB, WS_W2B = WS_W2A + 11 * MiB;
constexpr size_t WS_XB = WS_W2B + 6 * MiB, WS_ACT = WS_XB + 33 * MiB, WS_T = WS_ACT + 91 * MiB, WS_HF = WS_T + 66 * MiB, WS_HB = WS_HF + 66 * MiB,
                 WS_P = WS_HB + 33 * MiB, WS_SMF = WS_P + 306 * MiB, WS_XC = WS_SMF + 9 * MiB, WS_Y = WS_XC + 99 * MiB, WS_SC = WS_Y + 66 * MiB,
                 WS_SCS = WS_SC + 128 * MiB, WS_YA = WS_SCS + 5 * MiB, WS_MG = WS_YA + 33 * MiB, WS_END = WS_MG + 33 * MiB;
constexpr int CW_BAR = 4096;
constexpr int LDS_BYTES = 163840, MISC_OFF = LDS_BYTES - 256;
constexpr int WAREA = 17920;
constexpr int BIASREL_OFF = NWAVES * WAREA;
static_assert(BIASREL_OFF + 2 * 129 * 16 * 4 <= MISC_OFF, "LDS map");

constexpr float ALPHA = 1.18920711500272f;
constexpr float LN_EPS = 1e-5f;

struct Args { const float* in[29]; float* out; unsigned char* ws; int ph_lo, ph_hi; };
enum { I_XP = 0, I_XS, I_CK, I_CV, I_CKI, I_SCONV, I_SSSM, I_PT, I_BIAS, I_WIN, I_CONVW, I_CONVB, I_DTB, I_ALOG, I_DSKIP, I_NORMG, I_WBS, I_WBA, I_WOUT,
       I_F1WI, I_F1WO, I_F2WI, I_F2WO, I_LN1G, I_LN1B, I_LN2G, I_LN2B, I_LN3G, I_LN3B };

__device__ __forceinline__ float bf2f(unsigned v) { return __uint_as_float(v << 16); }
__device__ __forceinline__ unsigned f2bf(float f) { unsigned u = __float_as_uint(f); return (u + 0x7fffu + ((u >> 16) & 1u)) >> 16; }
__device__ __forceinline__ unsigned pk2(float lo, float hi) { return pg8::cvt_pk_bf16(lo, hi); }
__device__ __forceinline__ void unpack8(const u32x4 w, float (&f)[8]) {
#pragma unroll
    for (int i = 0; i < 4; ++i) { f[2 * i] = __uint_as_float(w[i] << 16); f[2 * i + 1] = __uint_as_float(w[i] & 0xffff0000u); }
}
__device__ __forceinline__ u32x4 pack8(const float (&f)[8]) { u32x4 w; w.x = pk2(f[0], f[1]); w.y = pk2(f[2], f[3]); w.z = pk2(f[4], f[5]); w.w = pk2(f[6], f[7]); return w; }
__device__ __forceinline__ float sigmoidf_(float x) { return 1.0f / (1.0f + __expf(-x)); }
__device__ __forceinline__ float siluf_(float x) { return x / (1.0f + __expf(-x)); }
__device__ __forceinline__ float wave_sum(float v) {
#pragma unroll
    for (int o = 1; o < 64; o <<= 1) v += __shfl_xor(v, o);
    return v;
}
__device__ __forceinline__ float wave_max(float v) {
#pragma unroll
    for (int o = 1; o < 64; o <<= 1) v = fmaxf(v, __shfl_xor(v, o));
    return v;
}
__device__ __forceinline__ f32x4 mfma16(bf16x8 a, bf16x8 b, f32x4 c) { return __builtin_amdgcn_mfma_f32_16x16x32_bf16(a, b, c, 0, 0, 0); }
__device__ __forceinline__ int mbcnt64(unsigned long long m) { return (int)__builtin_amdgcn_mbcnt_hi((unsigned)(m >> 32), __builtin_amdgcn_mbcnt_lo((unsigned)m, 0u)); }

struct EpiSwiglu {
    static constexpr bool PERM = true, AFTER_DRAIN = false;
    bf16_t* O;
    __device__ __forceinline__ void operator()(const f32x4 (&acc)[2][2][4][2], const pg8::Unit& u, int wr, int wc, int fr, int fq) const {
        const int row0 = u.pm * 256 + wr * 64 + fr, col0 = u.pn * 128 + wc * 32 + 8 * fq;
#pragma unroll
        for (int ai = 0; ai < 2; ++ai)
#pragma unroll
            for (int m = 0; m < 4; ++m) {
                float o[8];
#pragma unroll
                for (int n = 0; n < 2; ++n)
#pragma unroll
                    for (int j = 0; j < 4; ++j) { const float g = acc[ai][0][m][n][j], up = acc[ai][1][m][n][j]; o[4 * n + j] = siluf_(g) * up; }
                *(u32x4*)(O + (size_t)(row0 + ai * 128 + m * 16) * DFF + col0) = pack8(o);
            }
    }
};
struct EpiResid {
    static constexpr bool PERM = false, AFTER_DRAIN = false;
    const float* base_p; const float* base_s; float* T; float alpha, s;
    __device__ __forceinline__ void operator()(const f32x4 (&acc)[2][2][4][2], const pg8::Unit& u, int wr, int wc, int fr, int fq) const {
        const int row0 = u.pm * 256 + wr * 64 + fr, col0 = u.pn * 256 + wc * 32 + 4 * fq;
#pragma unroll
        for (int ai = 0; ai < 2; ++ai)
#pragma unroll
            for (int m = 0; m < 4; ++m) {
                const int r = row0 + ai * 128 + m * 16;
                const float* b = (r < MP) ? base_p + (size_t)r * D : base_s + (size_t)(r - MP) * D;
#pragma unroll
                for (int bj = 0; bj < 2; ++bj)
#pragma unroll
                    for (int n = 0; n < 2; ++n) { const int c = col0 + bj * 128 + n * 16; const f32x4 bv = *(const f32x4*)(b + c);
                        *(f32x4*)(T + (size_t)r * D + c) = bv * alpha + acc[ai][bj][m][n] * s; }
            }
    }
};
struct EpiWin {
    static constexpr bool PERM = true, AFTER_DRAIN = false;
    bf16_t* P; float* smf; float* out;
    __device__ __forceinline__ void operator()(const f32x4 (&acc)[2][2][4][2], const pg8::Unit& u, int wr, int wc, int fr, int fq) const {
        const int row0 = u.pm * 256 + wr * 64 + fr, cl = wc * 32 + 8 * fq, col0 = u.pn * 256 + cl;
#pragma unroll
        for (int ai = 0; ai < 2; ++ai)
#pragma unroll
            for (int m = 0; m < 4; ++m) {
                const int r = row0 + ai * 128 + m * 16;
#pragma unroll
                for (int bj = 0; bj < 2; ++bj) {
                    const f32x4 v0 = acc[ai][bj][m][0], v1 = acc[ai][bj][m][1];
                    u32x4 w; w.x = pk2(v0[0], v0[1]); w.y = pk2(v0[2], v0[3]); w.z = pk2(v1[0], v1[1]); w.w = pk2(v1[2], v1[3]);
                    *(u32x4*)(P + (size_t)r * NP + col0 + bj * 128) = w;
                    if (u.pn == 20) {
                        if (bj == 0) {
                            float* d = smf + (size_t)r * 128 + cl; *(f32x4*)d = v0; *(f32x4*)(d + 4) = v1;
                            if (cl >= 64) { float* k = out + ((r < MP) ? O_KIP + (size_t)r * 64 : O_KIS + (size_t)(r - MP) * 64) + (cl - 64); *(f32x4*)k = v0; *(f32x4*)(k + 4) = v1; }
                        }
                    } else if (u.pn == 25) {
                        float* k = out + ((r < MP) ? O_KP + (size_t)r * 256 : O_KS + (size_t)(r - MP) * 256) + bj * 128 + cl; *(f32x4*)k = v0; *(f32x4*)(k + 4) = v1;
                    } else if (u.pn == 26) {
                        float* k = out + ((r < MP) ? O_VP + (size_t)r * 256 : O_VS + (size_t)(r - MP) * 256) + bj * 128 + cl; *(f32x4*)k = v0; *(f32x4*)(k + 4) = v1;
                    }
                }
            }
    }
};
struct EpiGateA {
    static constexpr bool PERM = false, AFTER_DRAIN = false;
    const bf16_t* P; int gcol; float* M1;
    __device__ __forceinline__ void operator()(const f32x4 (&acc)[2][2][4][2], const pg8::Unit& u, int wr, int wc, int fr, int fq) const {
        const int row0 = u.pm * 256 + wr * 64 + fr, col0 = u.pn * 256 + wc * 32 + 4 * fq;
#pragma unroll
        for (int ai = 0; ai < 2; ++ai)
#pragma unroll
            for (int m = 0; m < 4; ++m) {
                const int r = row0 + ai * 128 + m * 16;
#pragma unroll
                for (int bj = 0; bj < 2; ++bj)
#pragma unroll
                    for (int n = 0; n < 2; ++n) { const int c = col0 + bj * 128 + n * 16; const u32x2 gw = *(const u32x2*)(P + (size_t)r * NP + gcol + c);
                        f32x4 g; g[0] = sigmoidf_(__uint_as_float(gw.x << 16)); g[1] = sigmoidf_(__uint_as_float(gw.x & 0xffff0000u)); g[2] = sigmoidf_(__uint_as_float(gw.y << 16)); g[3] = sigmoidf_(__uint_as_float(gw.y & 0xffff0000u));
                        *(f32x4*)(M1 + (size_t)r * D + c) = g * acc[ai][bj][m][n]; }
            }
    }
};
struct EpiGateS {
    static constexpr bool PERM = true, AFTER_DRAIN = false;
    const bf16_t* P; int gcol; const float* M1; bf16_t* MG;
    __device__ __forceinline__ void operator()(const f32x4 (&acc)[2][2][4][2], const pg8::Unit& u, int wr, int wc, int fr, int fq) const {
        const int row0 = u.pm * 256 + wr * 64 + fr, col0 = u.pn * 256 + wc * 32 + 8 * fq;
#pragma unroll
        for (int ai = 0; ai < 2; ++ai)
#pragma unroll
            for (int m = 0; m < 4; ++m) {
                const int r = row0 + ai * 128 + m * 16;
#pragma unroll
                for (int bj = 0; bj < 2; ++bj) { const int c = col0 + bj * 128;
                    const u32x4 gw = *(const u32x4*)(P + (size_t)r * NP + gcol + c); float g[8]; unpack8(gw, g);
                    const f32x4 m0 = *(const f32x4*)(M1 + (size_t)r * D + c), m1 = *(const f32x4*)(M1 + (size_t)r * D + c + 4);
                    float o[8];
#pragma unroll
                    for (int j = 0; j < 4; ++j) { o[j] = m0[j] + sigmoidf_(g[j]) * acc[ai][bj][m][0][j]; o[4 + j] = m1[j] + sigmoidf_(g[4 + j]) * acc[ai][bj][m][1][j]; }
                    *(u32x4*)(MG + (size_t)r * D + c) = pack8(o); }
            }
    }
};

__device__ __forceinline__ void tr_item(const float* W, int K, int Nsrc, bf16_t* WT, int k0, int drow0, int scol0, int nvalid, LAS float* scr, int lane) {
    const int c = lane & 31;
#pragma unroll 8
    for (int i = 0; i < 32; ++i) { const int kk = 2 * i + (lane >> 5); float v = 0.f; if (c < nvalid) v = W[(size_t)(k0 + kk) * Nsrc + scol0 + c]; scr[kk * 33 + c] = v; }
    asm volatile("s_waitcnt lgkmcnt(0)" ::: "memory");
    const int cc = lane & 7;
#pragma unroll
    for (int j = 0; j < 4; ++j) { const int n = (lane >> 3) + 8 * j; const LAS float* s = scr + (8 * cc) * 33 + n;
        u32x4 o; o.x = pk2(s[0 * 33], s[1 * 33]); o.y = pk2(s[2 * 33], s[3 * 33]); o.z = pk2(s[4 * 33], s[5 * 33]); o.w = pk2(s[6 * 33], s[7 * 33]);
        *(u32x4*)(WT + (size_t)(drow0 + n) * K + k0 + 8 * cc) = o; }
    asm volatile("s_waitcnt lgkmcnt(0)" ::: "memory");
}
__device__ __forceinline__ void tr_map(int mode, int n0, int& scol0, int& nvalid) {
    nvalid = 32;
    if (mode == 0) { scol0 = n0; }
    else if (mode == 1) { const int j = n0 >> 8, i = n0 & 255; scol0 = (i < 128) ? j * 128 + i : DFF + j * 128 + (i - 128); }
    else {
        if (n0 < 5120) scol0 = n0;
        else if (n0 < 5376) { const int j = n0 - 5120;
            if (j == 0) scol0 = 5120;
            else if (j == 32) { scol0 = 7264; nvalid = 8; }
            else if (j == 64 || j == 96) scol0 = 7200 + (j - 64);
            else { scol0 = 0; nvalid = 0; } }
        else if (n0 < 6400) scol0 = 5152 + (n0 - 5376);
        else if (n0 < 6656) scol0 = 6176 + (n0 - 6400);
        else if (n0 < 6912) scol0 = 6432 + (n0 - 6656);
        else if (n0 < 7424) scol0 = 6688 + (n0 - 6912);
        else scol0 = 7272 + (n0 - 7424);
    }
}
__device__ __forceinline__ void p0_prologue(const Args& A, LAS unsigned char* lds, int gw, int NGW, int wave, int lane) {
    LAS float* scr = (LAS float*)(lds + wave * 16384);
    unsigned char* ws = A.ws;
    constexpr int NI0 = 16 * 176, NI1 = 44 * 32, NI2 = 16 * 296, NI3 = 32 * 32, NI4 = 16 * 32, NI5 = 16 * 32, NI6 = NI0, NI7 = NI1;
    constexpr int NIT = NI0 + NI1 + NI2 + NI3 + NI4 + NI5 + NI6 + NI7;
    for (int it = gw; it < NIT; it += NGW) {
        int r = it; const float* W; bf16_t* WT; int K, Nsrc, nblk, mode;
        if (r < NI0) { W = A.in[I_F1WI]; WT = (bf16_t*)(ws + WS_W1A); K = 1024; Nsrc = 2 * DFF; nblk = 176; mode = 1; }
        else if ((r -= NI0) < NI1) { W = A.in[I_F1WO]; WT = (bf16_t*)(ws + WS_W1B); K = DFF; Nsrc = 1024; nblk = 32; mode = 0; }
        else if ((r -= NI1) < NI2) { W = A.in[I_WIN]; WT = (bf16_t*)(ws + WS_WIN); K = 1024; Nsrc = 9320; nblk = 296; mode = 2; }
        else if ((r -= NI2) < NI3) { W = A.in[I_WBS]; WT = (bf16_t*)(ws + WS_WBS); K = 2048; Nsrc = 1024; nblk = 32; mode = 0; }
        else if ((r -= NI3) < NI4) { W = A.in[I_WBA]; WT = (bf16_t*)(ws + WS_WBA); K = 1024; Nsrc = 1024; nblk = 32; mode = 0; }
        else if ((r -= NI4) < NI5) { W = A.in[I_WOUT]; WT = (bf16_t*)(ws + WS_WOUT); K = 1024; Nsrc = 1024; nblk = 32; mode = 0; }
        else if ((r -= NI5) < NI6) { W = A.in[I_F2WI]; WT = (bf16_t*)(ws + WS_W2A); K = 1024; Nsrc = 2 * DFF; nblk = 176; mode = 1; }
        else { r -= NI6; W = A.in[I_F2WO]; WT = (bf16_t*)(ws + WS_W2B); K = DFF; Nsrc = 1024; nblk = 32; mode = 0; }
        const int kb = r / nblk, nb = r % nblk; int scol0, nvalid; tr_map(mode, nb * 32, scol0, nvalid);
        tr_item(W, K, Nsrc, WT, kb * 64, nb * 32, scol0, nvalid, scr, lane);
    }
    bf16_t* XB = (bf16_t*)(ws + WS_XB);
    const int nchunk = M * D / 8;
    for (int ch = gw * 64 + lane; ch < nchunk; ch += NGW * 64) {
        const int m = ch >> 7, c = (ch & 127) * 8;
        const float* src = (m < MP) ? A.in[I_XP] + (size_t)m * D + c : A.in[I_XS] + (size_t)(m - MP) * D + c;
        const f32x4 a = *(const f32x4*)src, b = *(const f32x4*)(src + 4);
        u32x4 w; w.x = pk2(a[0], a[1]); w.y = pk2(a[2], a[3]); w.z = pk2(b[0], b[1]); w.w = pk2(b[2], b[3]);
        *(u32x4*)(XB + (size_t)m * D + c) = w;
    }
}

__device__ __forceinline__ void ln_phase(const float* T, const float* g, const float* b, float* outf, bf16_t* outb, int gw, int NGW, int lane) {
    f32x4 gv[4], bv[4];
#pragma unroll
    for (int j = 0; j < 4; ++j) { gv[j] = *(const f32x4*)(g + 4 * lane + 256 * j); bv[j] = *(const f32x4*)(b + 4 * lane + 256 * j); }
    for (int m = gw; m < M; m += NGW) {
        const float* xr = T + (size_t)m * D + 4 * lane;
        f32x4 v[4]; float s = 0.f;
#pragma unroll
        for (int j = 0; j < 4; ++j) { v[j] = *(const f32x4*)(xr + 256 * j); s += (v[j][0] + v[j][1]) + (v[j][2] + v[j][3]); }
        const float mean = wave_sum(s) * (1.f / D); float s2 = 0.f;
#pragma unroll
        for (int j = 0; j < 4; ++j) { v[j] = v[j] - mean; s2 += (v[j][0] * v[j][0] + v[j][1] * v[j][1]) + (v[j][2] * v[j][2] + v[j][3] * v[j][3]); }
        const float rstd = 1.0f / sqrtf(wave_sum(s2) * (1.f / D) + LN_EPS);
#pragma unroll
        for (int j = 0; j < 4; ++j) {
            const f32x4 o = v[j] * rstd * gv[j] + bv[j];
            *(f32x4*)(outf + (size_t)m * D + 4 * lane + 256 * j) = o;
            if (outb) { u32x2 w; w.x = pk2(o[0], o[1]); w.y = pk2(o[2], o[3]); *(u32x2*)(outb + (size_t)m * D + 4 * lane + 256 * j) = w; }
        }
    }
}

template <int NT  , bool SAMP>
__device__ __forceinline__ void conv_item(const Args& A, int b, int t0, int cg, int lane) {
    const bf16_t* P = (const bf16_t*)(A.ws + WS_P); bf16_t* XC = (bf16_t*)(A.ws + WS_XC);
    const float* cw = A.in[I_CONVW]; const float* cb = A.in[I_CONVB];
    const int ch = (cg * 64 + lane) * 8;
    const size_t row0 = SAMP ? (size_t)(MP + b * 4) : (size_t)(b * 2048 + t0);
    u32x4 raw[NT + 3];
#pragma unroll
    for (int i = 0; i < NT + 3; ++i) {
        const int t = t0 - 3 + i;
        if (t >= 0) raw[i] = *(const u32x4*)(P + (row0 + (size_t)(i - 3)) * NP + PXBC + ch);
        else raw[i] = (u32x4){0u, 0u, 0u, 0u};
    }
    float w[4][8], bias[8];
#pragma unroll
    for (int j = 0; j < 4; ++j) { const f32x4 w0 = *(const f32x4*)(cw + (size_t)j * XCW + ch), w1 = *(const f32x4*)(cw + (size_t)j * XCW + ch + 4);
#pragma unroll
        for (int i = 0; i < 4; ++i) { w[j][i] = w0[i]; w[j][4 + i] = w1[i]; } }
    { const f32x4 b0 = *(const f32x4*)(cb + ch), b1 = *(const f32x4*)(cb + ch + 4);
#pragma unroll
      for (int i = 0; i < 4; ++i) { bias[i] = b0[i]; bias[4 + i] = b1[i]; } }
    float u0[8], u1[8], u2[8];
    if (SAMP) {
        const float* sc = A.in[I_SCONV] + (size_t)b * 3 * XCW + ch;
#pragma unroll
        for (int i = 0; i < 4; ++i) { const f32x4 a0 = *(const f32x4*)(sc), a1 = *(const f32x4*)(sc + 4), c0 = *(const f32x4*)(sc + XCW), c1 = *(const f32x4*)(sc + XCW + 4), e0 = *(const f32x4*)(sc + 2 * XCW), e1 = *(const f32x4*)(sc + 2 * XCW + 4);
            u0[i] = a0[i]; u0[4 + i] = a1[i]; u1[i] = c0[i]; u1[4 + i] = c1[i]; u2[i] = e0[i]; u2[4 + i] = e1[i]; }
    } else { unpack8(raw[0], u0); unpack8(raw[1], u1); unpack8(raw[2], u2); }
#pragma unroll
    for (int i = 0; i < NT; ++i) {
        float u3[8], o[8]; unpack8(raw[i + 3], u3);
#pragma unroll
        for (int e = 0; e < 8; ++e) o[e] = siluf_(bias[e] + w[0][e] * u0[e] + w[1][e] * u1[e] + w[2][e] * u2[e] + w[3][e] * u3[e]);
        *(u32x4*)(XC + (row0 + (size_t)i) * XCW + ch) = pack8(o);
        const int t = t0 + i; float* cs = nullptr;
        if (!SAMP) { if (t >= 2045) cs = A.out + O_CVP + ((size_t)b * 3 + (t - 2045)) * XCW + ch; }
        else { if (t >= 1) cs = A.out + O_CVS + ((size_t)b * 3 + (t - 1)) * XCW + ch; }
        if (cs) { *(f32x4*)cs = (f32x4){u3[0], u3[1], u3[2], u3[3]}; *(f32x4*)(cs + 4) = (f32x4){u3[4], u3[5], u3[6], u3[7]}; }
#pragma unroll
        for (int e = 0; e < 8; ++e) { u0[e] = u1[e]; u1[e] = u2[e]; u2[e] = u3[e]; }
    }
}
__device__ __forceinline__ void conv_phase(const Args& A, int gw, int NGW, int lane) {
    constexpr int NPI = 8 * 128 * 6, NSI = 128 * 6;
    for (int it = gw; it < NPI + NSI; it += NGW) {
        if (it < NPI) { const int cg = it % 6, r = it / 6; conv_item<16, false>(A, r >> 7, (r & 127) * 16, cg, lane); }
        else { const int r = it - NPI; conv_item<4, true>(A, r / 6, 0, r % 6, lane); }
    }
}

constexpr float IDX_SCALE = 0.125f * 0.35355339059327373f;
constexpr int SCL = 2052;
__device__ __forceinline__ unsigned f2key(float v) { unsigned u = (v == 0.f) ? 0u : __float_as_uint(v); return (u & 0x80000000u) ? ~u : (u | 0x80000000u); }
__device__ __forceinline__ void scores_select_prompt_unit(const Args& A, LAS unsigned char* lds, int b, int qt, int wave, int lane_in) {
    const bf16_t* P = (const bf16_t*)(A.ws + WS_P); const float* SMF = (const float*)(A.ws + WS_SMF);
    unsigned long long* MASKW = (unsigned long long*)(A.ws + WS_SC);
    LAS float* sc = (LAS float*)lds;
    int lane = lane_in; asm volatile("" : "+v"(lane));
    const int fr = lane & 15, fq = lane >> 4;
    {
        const size_t rowq = (size_t)(b * 2048 + qt * 16 + fr);
        bf16x8 Af[8][2];
#pragma unroll
        for (int h = 0; h < 8; ++h)
#pragma unroll
            for (int ks = 0; ks < 2; ++ks) Af[h][ks] = *(const bf16x8*)(P + rowq * NP + PQI + h * 64 + ks * 32 + 8 * fq);
        float wq[4][8];
#pragma unroll
        for (int j = 0; j < 4; ++j) { const float* wp = SMF + (size_t)(b * 2048 + qt * 16 + 4 * fq + j) * 128 + 32; const f32x4 w0 = *(const f32x4*)wp, w1 = *(const f32x4*)(wp + 4);
#pragma unroll
            for (int h = 0; h < 4; ++h) { wq[j][h] = w0[h] * IDX_SCALE; wq[j][4 + h] = w1[h] * IDX_SCALE; } }
        const bf16_t* kbase = P + (size_t)(b * 2048 + fr) * NP + PSM + 64 + 8 * fq;
        bf16x8 nB0 = {0, 0, 0, 0, 0, 0, 0, 0}, nB1 = nB0;
        if (wave <= qt) { const bf16_t* kp = kbase + (size_t)wave * 16 * NP; nB0 = *(const bf16x8*)kp; nB1 = *(const bf16x8*)(kp + 32); }
        for (int kt = wave; kt <= qt; kt += NWAVES) {
            const bf16x8 B0 = nB0, B1 = nB1;
            if (kt + NWAVES <= qt) { const bf16_t* kp = kbase + (size_t)(kt + NWAVES) * 16 * NP; nB0 = *(const bf16x8*)kp; nB1 = *(const bf16x8*)(kp + 32); }
            f32x4 scv = {0.f, 0.f, 0.f, 0.f};
#pragma unroll
            for (int h = 0; h < 8; ++h) { f32x4 d = {0.f, 0.f, 0.f, 0.f}; d = mfma16(Af[h][0], B0, d); d = mfma16(Af[h][1], B1, d);
#pragma unroll
                for (int j = 0; j < 4; ++j) scv[j] += wq[j][h] * fmaxf(d[j], 0.f); }
#pragma unroll
            for (int j = 0; j < 4; ++j) sc[(4 * fq + j) * SCL + kt * 16 + fr] = scv[j];
#if MK_CHECK_ATT
#pragma unroll
            for (int j = 0; j < 4; ++j) ((float*)(A.ws + WS_END))[(size_t)(b * 2048 + qt * 16 + 4 * fq + j) * SCW + kt * 16 + fr] = scv[j];
#endif
        }
    }
    __syncthreads();
#pragma unroll 1
    for (int u = 0; u < 2; ++u) {
        const int ql = 2 * wave + u, t = qt * 16 + ql, nvalid = t + 1;
        const LAS float* srow = sc + ql * SCL + lane;
        unsigned key[32];
#pragma unroll
        for (int j = 0; j < 32; ++j) key[j] = (lane < nvalid - 64 * j) ? f2key(srow[64 * j]) : 0u;
        unsigned T = 0u; int need_eq = 0;
        if (nvalid > 256) {
            bool exact = false;
            for (int bit = 31; bit >= 0; --bit) {
                const unsigned cand = T | (1u << bit); int cnt = 0;
#pragma unroll
                for (int j = 0; j < 32; ++j) cnt += __popcll(__ballot(key[j] >= cand));
                if (cnt >= 256) { T = cand; if (cnt == 256) { exact = true; break; } }
            }
            if (exact) { T -= 1u; }
            else { int cgt = 0;
#pragma unroll
                for (int j = 0; j < 32; ++j) cgt += __popcll(__ballot(key[j] > T));
                need_eq = 256 - cgt; }
        }
        int eqused = 0; unsigned long long mine = 0ull;
#pragma unroll
        for (int j = 0; j < 32; ++j) {
            unsigned long long ms;
            if (need_eq > 0) {
                const bool gt = key[j] > T, eq = key[j] == T;
                const unsigned long long meq = __ballot(eq);
                const bool sel = gt || (eq && (eqused + mbcnt64(meq) < need_eq));
                eqused += __popcll(meq);
                ms = __ballot(sel);
            } else ms = __ballot(key[j] > T);
            if (lane == j) mine = ms;
        }
        if (lane < 32) MASKW[(size_t)(b * 2048 + t) * 32 + lane] = mine;
    }
    __syncthreads();
}
__device__ __forceinline__ void scores_sample_unit(const Args& A, int b, int half, int wave, int lane) {
    const bf16_t* P = (const bf16_t*)(A.ws + WS_P); const float* SMF = (const float*)(A.ws + WS_SMF); float* SCS = (float*)(A.ws + WS_SCS);
    const int* pt = (const int*)A.in[I_PT]; const float* cki = A.in[I_CKI];
    const int fr = lane & 15, fq = lane >> 4;
    bf16x8 Af[2][2]; float wq[2][4];
#pragma unroll
    for (int mt = 0; mt < 2; ++mt) {
#pragma unroll
        for (int ks = 0; ks < 2; ++ks) Af[mt][ks] = *(const bf16x8*)(P + (size_t)(MP + b * 4 + 2 * mt + (fr >> 3)) * NP + PQI + (fr & 7) * 64 + ks * 32 + 8 * fq);
        const f32x4 w = *(const f32x4*)(SMF + (size_t)(MP + b * 4 + 2 * mt + (fq >> 1)) * 128 + 32 + 4 * (fq & 1));
#pragma unroll
        for (int j = 0; j < 4; ++j) wq[mt][j] = w[j] * IDX_SCALE;
    }
    const int kt_end = (half == 0) ? 65 : 129;
    for (int kt = half * 65 + wave; kt < kt_end; kt += NWAVES) {
        const int key = kt * 16 + fr;
        bf16x8 B0, B1;
        if (key < 2048) {
            const int page = pt[b * 16 + (key >> 7)];
            const float* src = cki + ((size_t)page * 128 + (key & 127)) * 64 + 8 * fq;
            const f32x4 a0 = *(const f32x4*)src, a1 = *(const f32x4*)(src + 4), c0 = *(const f32x4*)(src + 32), c1 = *(const f32x4*)(src + 36);
            u32x4 w0, w1; w0.x = pk2(a0[0], a0[1]); w0.y = pk2(a0[2], a0[3]); w0.z = pk2(a1[0], a1[1]); w0.w = pk2(a1[2], a1[3]);
            w1.x = pk2(c0[0], c0[1]); w1.y = pk2(c0[2], c0[3]); w1.z = pk2(c1[0], c1[1]); w1.w = pk2(c1[2], c1[3]);
            B0 = __builtin_bit_cast(bf16x8, w0); B1 = __builtin_bit_cast(bf16x8, w1);
        } else if (key < 2052) {
            const bf16_t* src = P + (size_t)(MP + b * 4 + (key - 2048)) * NP + PSM + 64 + 8 * fq;
            B0 = *(const bf16x8*)src; B1 = *(const bf16x8*)(src + 32);
        } else { B0 = (bf16x8){0, 0, 0, 0, 0, 0, 0, 0}; B1 = B0; }
#pragma unroll
        for (int mt = 0; mt < 2; ++mt) {
            f32x4 d = {0.f, 0.f, 0.f, 0.f}; d = mfma16(Af[mt][0], B0, d); d = mfma16(Af[mt][1], B1, d);
            float s = 0.f;
#pragma unroll
            for (int j = 0; j < 4; ++j) s += wq[mt][j] * fmaxf(d[j], 0.f);
            s += __shfl_xor(s, 16);
            if ((fq & 1) == 0 && key < 2052) SCS[(size_t)(b * 4 + 2 * mt + (fq >> 1)) * SCSW + key] = s;
        }
    }
}

__device__ __forceinline__ float softplusf_(float x) { return fmaxf(x, 0.f) + log1pf(expf(-fabsf(x))); }
__device__ __forceinline__ void ssd_prompt_item(const Args& A, LAS unsigned char* lds, int b, int h) {
    const int tid = threadIdx.x, lane = tid & 63, wave = __builtin_amdgcn_readfirstlane(tid >> 6), fr = lane & 15, fq = lane >> 4;
    const int g = h >> 3;
    const bf16_t* XC = (const bf16_t*)(A.ws + WS_XC); const float* SMF = (const float*)(A.ws + WS_SMF); bf16_t* Y = (bf16_t*)(A.ws + WS_Y);
    LAS bf16_t* Cm = (LAS bf16_t*)lds;
    LAS bf16_t* Bm = Cm + 64 * 136;
    LAS bf16_t* Btw = Bm + 64 * 136;
    LAS bf16_t* Xt = Btw + 128 * 72;
    LAS bf16_t* Mt = Xt + 64 * 72;
    LAS bf16_t* Hp = Mt + 64 * 72;
    LAS float* cum = (LAS float*)(Hp + 64 * 136);
    LAS float* dtv = cum + 64; LAS float* wv = dtv + 64; LAS float* ecum = wv + 64;
    const float Ah = -expf(A.in[I_ALOG][h]), dtb = A.in[I_DTB][h], dsk = A.in[I_DSKIP][h];
    f32x4 hst[4];
#pragma unroll
    for (int i = 0; i < 4; ++i) hst[i] = (f32x4){0.f, 0.f, 0.f, 0.f};
    for (int i = tid; i < 64 * 136 / 8; i += NTHR) *(LAS u32x4*)(Hp + i * 8) = (u32x4){0u, 0u, 0u, 0u};
    const int s0 = tid >> 4, part0 = tid & 15;
    const int xs = tid >> 3, xpart = tid & 7;
    for (int c = 0; c < 32; ++c) {
        const int row0 = b * 2048 + c * 64;
        u32x4 cr[2], br[2];
#pragma unroll
        for (int i = 0; i < 2; ++i) { const bf16_t* rp = XC + (size_t)(row0 + s0 + 32 * i) * XCW + g * 128 + part0 * 8; cr[i] = *(const u32x4*)(rp + 2560); br[i] = *(const u32x4*)(rp + 2048); }
        const u32x4 xr = *(const u32x4*)(XC + (size_t)(row0 + xs) * XCW + h * 64 + xpart * 8);
        if (wave == 0) {
            const float dt = softplusf_(SMF[(size_t)(row0 + lane) * 128 + h] + dtb);
            float v = dt * Ah;
#pragma unroll
            for (int o = 1; o < 64; o <<= 1) { const float n = __shfl_up(v, o); if (lane >= o) v += n; }
            const float ce = __shfl(v, 63);
            cum[lane] = v; dtv[lane] = dt; wv[lane] = dt * expf(ce - v); ecum[lane] = expf(v);
        }
        __syncthreads();
#pragma unroll
        for (int i = 0; i < 2; ++i) {
            const int s = s0 + 32 * i;
            *(LAS u32x4*)(Cm + s * 136 + part0 * 8) = cr[i];
            *(LAS u32x4*)(Bm + s * 136 + part0 * 8) = br[i];
            float bf[8]; unpack8(br[i], bf); const float w = wv[s];
#pragma unroll
            for (int e = 0; e < 8; ++e) Btw[(part0 * 8 + e) * 72 + s] = (bf16_t)f2bf(bf[e] * w);
        }
        {
#pragma unroll
            for (int e = 0; e < 4; ++e) { Xt[(xpart * 8 + 2 * e) * 72 + xs] = (bf16_t)(xr[e] & 0xffffu); Xt[(xpart * 8 + 2 * e + 1) * 72 + xs] = (bf16_t)(xr[e] >> 16); }
        }
        __syncthreads();
        {
            const int st = wave >> 1, tt0 = 2 * (wave & 1);
            bf16x8 a[4];
#pragma unroll
            for (int ks = 0; ks < 4; ++ks) a[ks] = *(const LAS bf16x8*)(Bm + (16 * st + fr) * 136 + ks * 32 + 8 * fq);
#pragma unroll
            for (int u = 0; u < 2; ++u) {
                const int tt = tt0 + u; f32x4 d = {0.f, 0.f, 0.f, 0.f};
#pragma unroll
                for (int ks = 0; ks < 4; ++ks) { const bf16x8 bb = *(const LAS bf16x8*)(Cm + (16 * tt + fr) * 136 + ks * 32 + 8 * fq); d = mfma16(a[ks], bb, d); }
                const int t = 16 * tt + fr; const float ct = cum[t]; float mv[4];
#pragma unroll
                for (int j = 0; j < 4; ++j) { const int s = 16 * st + 4 * fq + j; mv[j] = (s <= t) ? d[j] * expf(ct - cum[s]) * dtv[s] : 0.f; }
                u32x2 w; w.x = pk2(mv[0], mv[1]); w.y = pk2(mv[2], mv[3]);
                *(LAS u32x2*)(Mt + t * 72 + 16 * st + 4 * fq) = w;
            }
        }
        __syncthreads();
        {
            const int pt = wave >> 1, tt0 = 2 * (wave & 1);
            bf16x8 a1[2], a2[4];
#pragma unroll
            for (int ks = 0; ks < 2; ++ks) a1[ks] = *(const LAS bf16x8*)(Xt + (16 * pt + fr) * 72 + ks * 32 + 8 * fq);
#pragma unroll
            for (int ks = 0; ks < 4; ++ks) a2[ks] = *(const LAS bf16x8*)(Hp + (16 * pt + fr) * 136 + ks * 32 + 8 * fq);
#pragma unroll
            for (int u = 0; u < 2; ++u) {
                const int tt = tt0 + u; f32x4 d1 = {0.f, 0.f, 0.f, 0.f}, d2 = {0.f, 0.f, 0.f, 0.f};
#pragma unroll
                for (int ks = 0; ks < 2; ++ks) { const bf16x8 bb = *(const LAS bf16x8*)(Mt + (16 * tt + fr) * 72 + ks * 32 + 8 * fq); d1 = mfma16(a1[ks], bb, d1); }
#pragma unroll
                for (int ks = 0; ks < 4; ++ks) { const bf16x8 bb = *(const LAS bf16x8*)(Cm + (16 * tt + fr) * 136 + ks * 32 + 8 * fq); d2 = mfma16(a2[ks], bb, d2); }
                const int t = 16 * tt + fr; const float et = ecum[t]; float yv[4];
#pragma unroll
                for (int j = 0; j < 4; ++j) { const int p = 16 * pt + 4 * fq + j; yv[j] = d1[j] + et * d2[j] + dsk * bf2f((unsigned)Xt[p * 72 + t]); }
                u32x2 w; w.x = pk2(yv[0], yv[1]); w.y = pk2(yv[2], yv[3]);
                *(u32x2*)(Y + (size_t)(row0 + t) * DI + h * 64 + 16 * pt + 4 * fq) = w;
            }
            bf16x8 a3[2];
#pragma unroll
            for (int ks = 0; ks < 2; ++ks) a3[ks] = *(const LAS bf16x8*)(Btw + (16 * wave + fr) * 72 + ks * 32 + 8 * fq);
            const float dec = ecum[63];
#pragma unroll
            for (int p4 = 0; p4 < 4; ++p4) { f32x4 d = {0.f, 0.f, 0.f, 0.f};
#pragma unroll
                for (int ks = 0; ks < 2; ++ks) { const bf16x8 bb = *(const LAS bf16x8*)(Xt + (16 * p4 + fr) * 72 + ks * 32 + 8 * fq); d = mfma16(a3[ks], bb, d); }
                hst[p4] = hst[p4] * dec + d; }
        }
        __syncthreads();
#pragma unroll
        for (int p4 = 0; p4 < 4; ++p4) { u32x2 w; w.x = pk2(hst[p4][0], hst[p4][1]); w.y = pk2(hst[p4][2], hst[p4][3]);
            *(LAS u32x2*)(Hp + (16 * p4 + fr) * 136 + 16 * wave + 4 * fq) = w; }
    }
    float* so = A.out + O_SSP + ((size_t)b * 32 + h) * 64 * 128;
#pragma unroll
    for (int p4 = 0; p4 < 4; ++p4) *(f32x4*)(so + (size_t)(16 * p4 + fr) * 128 + 16 * wave + 4 * fq) = hst[p4];
    __syncthreads();
}

__device__ __forceinline__ void ssd_sample_item(const Args& A, LAS unsigned char* wl, int b, int h, int lane) {
    const bf16_t* XC = (const bf16_t*)(A.ws + WS_XC); const float* SMF = (const float*)(A.ws + WS_SMF); bf16_t* Y = (bf16_t*)(A.ws + WS_Y);
    LAS float* red = (LAS float*)wl;
    const int g = h >> 3;
    const float Ah = -expf(A.in[I_ALOG][h]), dtb = A.in[I_DTB][h], dsk = A.in[I_DSKIP][h];
#pragma unroll 1
    for (int half = 0; half < 2; ++half) {
        const float* h0 = A.in[I_SSSM] + (((size_t)b * 32 + h) * 64 + 32 * half) * 128 + 2 * lane;
        float st[32][2];
#pragma unroll
        for (int p = 0; p < 32; ++p) { const float2 v = *(const float2*)(h0 + p * 128); st[p][0] = v.x; st[p][1] = v.y; }
#pragma unroll 1
        for (int t = 0; t < 4; ++t) {
            const size_t m = (size_t)(MP + b * 4 + t);
            const float dt = softplusf_(SMF[m * 128 + h] + dtb), dec = expf(dt * Ah);
            const unsigned bw = *(const unsigned*)(XC + m * XCW + 2048 + g * 128 + 2 * lane), cw = *(const unsigned*)(XC + m * XCW + 2560 + g * 128 + 2 * lane);
            const float b0 = bf2f(bw & 0xffffu) * dt, b1 = __uint_as_float(bw & 0xffff0000u) * dt, c0 = bf2f(cw & 0xffffu), c1 = __uint_as_float(cw & 0xffff0000u);
            const float xl = bf2f((unsigned)XC[m * XCW + h * 64 + 32 * half + (lane & 31)]);
#pragma unroll
            for (int p = 0; p < 32; ++p) {
                const float xp = __shfl(xl, p);
                st[p][0] = st[p][0] * dec + xp * b0; st[p][1] = st[p][1] * dec + xp * b1;
                red[p * 65 + lane] = st[p][0] * c0 + st[p][1] * c1;
            }
            asm volatile("s_waitcnt lgkmcnt(0)" ::: "memory");
            float y = 0.f;
#pragma unroll 16
            for (int i = 0; i < 64; ++i) y += red[(lane & 31) * 65 + i];
            y += dsk * xl;
            if (lane < 32) Y[m * DI + h * 64 + 32 * half + lane] = (bf16_t)f2bf(y);
            asm volatile("s_waitcnt lgkmcnt(0)" ::: "memory");
        }
        float* so = A.out + O_SSS + (((size_t)b * 32 + h) * 64 + 32 * half) * 128 + 2 * lane;
#pragma unroll
        for (int p = 0; p < 32; ++p) *(float2*)(so + p * 128) = make_float2(st[p][0], st[p][1]);
    }
}

__device__ __forceinline__ int t5_bucket(int n) {
    if (n < 16) return n;
    const float nf = (float)n;
    int large = 16 + (int)(logf(nf / 16.0f) / 2.0794415416798357f * 16.0f);
    return large < 31 ? large : 31;
}
typedef float f32x16 __attribute__((ext_vector_type(16)));
__device__ __forceinline__ f32x16 mfma32(bf16x8 a, bf16x8 b, f32x16 c) { return __builtin_amdgcn_mfma_f32_32x32x16_bf16(a, b, c, 0, 0, 0); }
constexpr float LOG2E = 1.4426950408889634f;
constexpr int AK_STR = 72, AV_STR = 68, AT_K0 = 0, AT_V0 = 2 * 64 * AK_STR * 2, AT_WS = AT_V0 + 2 * 64 * AV_STR * 2;
__device__ __forceinline__ void attn_prompt_unit(const Args& A, LAS unsigned char* lds, const LAS float* biasL, int b, int g, int qt, int wave, int lane_in) {
    const bf16_t* P = (const bf16_t*)(A.ws + WS_P); const unsigned* MASK32 = (const unsigned*)(A.ws + WS_SC); bf16_t* YA = (bf16_t*)(A.ws + WS_YA);
    int lane = lane_in; asm volatile("" : "+v"(lane));
    const int tid = wave * 64 + lane, r32 = lane & 31, hi = lane >> 5;
    LAS float* wsc = (LAS float*)(lds + AT_WS) + wave * 64;
    const int query = qt * 64 + 8 * wave + (r32 >> 2), head = 4 * g + (r32 & 3);
    const size_t qrow = (size_t)(b * 2048 + query);
    bf16x8 qf[4];
#pragma unroll
    for (int ds = 0; ds < 4; ++ds) qf[ds] = *(const bf16x8*)(P + qrow * NP + PQ + head * 64 + 16 * ds + 8 * hi);
    const unsigned* mrow = MASK32 + qrow * 64;
    const float bfar = biasL[128 * 16 + head];
    const int skey = tid >> 3, sdch = tid & 7;
    const bf16_t* ksrc = P + (size_t)(b * 2048 + skey) * NP + PK + g * 64 + sdch * 8;
    f32x16 O0, O1;
#pragma unroll
    for (int i = 0; i < 16; ++i) { O0[i] = 0.f; O1[i] = 0.f; }
    float m_run = -1e30f, l_run = 0.f;
    u32x4 kreg = *(const u32x4*)ksrc, vreg = *(const u32x4*)(ksrc + 256);
    unsigned mw0 = mrow[0], mw1 = mrow[1];
    {
        LAS bf16_t* Kb = (LAS bf16_t*)(lds + AT_K0); LAS bf16_t* Vb = (LAS bf16_t*)(lds + AT_V0);
        *(LAS u32x4*)(Kb + skey * AK_STR + sdch * 8) = kreg;
#pragma unroll
        for (int e = 0; e < 4; ++e) { Vb[(sdch * 8 + 2 * e) * AV_STR + skey] = (bf16_t)(vreg[e] & 0xffffu); Vb[(sdch * 8 + 2 * e + 1) * AV_STR + skey] = (bf16_t)(vreg[e] >> 16); }
    }
    for (int kt = 0; kt <= qt; ++kt) {
        const int buf = kt & 1;
        __syncthreads();
        const unsigned w0 = mw0 >> (4 * hi), w1 = mw1 >> (4 * hi);
        if (kt < qt) { const bf16_t* src = ksrc + (size_t)(kt + 1) * 64 * NP; kreg = *(const u32x4*)src; vreg = *(const u32x4*)(src + 256); mw0 = mrow[2 * kt + 2]; mw1 = mrow[2 * kt + 3]; }
        const LAS bf16_t* Kb = (const LAS bf16_t*)(lds + AT_K0 + buf * (64 * AK_STR * 2)); const LAS bf16_t* Vb = (const LAS bf16_t*)(lds + AT_V0 + buf * (64 * AV_STR * 2));
        f32x16 S0, S1;
#pragma unroll
        for (int i = 0; i < 16; ++i) { S0[i] = 0.f; S1[i] = 0.f; }
#pragma unroll
        for (int ds = 0; ds < 4; ++ds) {
            const bf16x8 k0 = *(const LAS bf16x8*)(Kb + r32 * AK_STR + 16 * ds + 8 * hi), k1 = *(const LAS bf16x8*)(Kb + (32 + r32) * AK_STR + 16 * ds + 8 * hi);
            S0 = mfma32(k0, qf[ds], S0); S1 = mfma32(k1, qf[ds], S1);
        }
        const float c1 = 0.125f * LOG2E;
        if (qt - kt >= 3) {
#pragma unroll
            for (int i = 0; i < 16; ++i) { const unsigned bit = 1u << ((i & 3) + 8 * (i >> 2));
                S0[i] = (w0 & bit) ? S0[i] * c1 + bfar : -INFINITY; S1[i] = (w1 & bit) ? S1[i] * c1 + bfar : -INFINITY; }
        } else {
            const int kbase = kt * 64 + 4 * hi;
#pragma unroll
            for (int i = 0; i < 16; ++i) { const int pos = (i & 3) + 8 * (i >> 2); const unsigned bit = 1u << pos;
                int r0 = query - (kbase + pos), r1 = r0 - 32; r0 = r0 < 0 ? 0 : (r0 > 128 ? 128 : r0); r1 = r1 < 0 ? 0 : (r1 > 128 ? 128 : r1);
                S0[i] = (w0 & bit) ? S0[i] * c1 + biasL[r0 * 16 + head] : -INFINITY; S1[i] = (w1 & bit) ? S1[i] * c1 + biasL[r1 * 16 + head] : -INFINITY; }
        }
        float tm = fmaxf(S0[0], S1[0]);
#pragma unroll
        for (int i = 1; i < 16; ++i) tm = fmaxf(tm, fmaxf(S0[i], S1[i]));
        tm = fmaxf(tm, __shfl_xor(tm, 32));
        if (__any(tm > m_run + 8.0f)) {
            const float mn = fmaxf(m_run, tm), f = __builtin_amdgcn_exp2f(m_run - mn);
            m_run = mn; l_run *= f;
            if (hi == 0) wsc[r32] = f;
            asm volatile("s_waitcnt lgkmcnt(0)" ::: "memory");
#pragma unroll
            for (int i = 0; i < 16; ++i) { const float fi = wsc[(i & 3) + 8 * (i >> 2) + 4 * hi]; O0[i] *= fi; O1[i] *= fi; }
            asm volatile("s_waitcnt lgkmcnt(0)" ::: "memory");
        }
        float ls = 0.f;
#pragma unroll
        for (int i = 0; i < 16; ++i) { S0[i] = __builtin_amdgcn_exp2f(S0[i] - m_run); S1[i] = __builtin_amdgcn_exp2f(S1[i] - m_run); ls += S0[i] + S1[i]; }
        l_run += ls;
        bf16x8 pa[2][2];
#pragma unroll
        for (int sk = 0; sk < 2; ++sk) {
            u32x4 a0, a1;
            a0.x = pk2(S0[8 * sk + 0], S0[8 * sk + 1]); a0.y = pk2(S0[8 * sk + 2], S0[8 * sk + 3]); a0.z = pk2(S0[8 * sk + 4], S0[8 * sk + 5]); a0.w = pk2(S0[8 * sk + 6], S0[8 * sk + 7]);
            a1.x = pk2(S1[8 * sk + 0], S1[8 * sk + 1]); a1.y = pk2(S1[8 * sk + 2], S1[8 * sk + 3]); a1.z = pk2(S1[8 * sk + 4], S1[8 * sk + 5]); a1.w = pk2(S1[8 * sk + 6], S1[8 * sk + 7]);
            pa[0][sk] = __builtin_bit_cast(bf16x8, a0); pa[1][sk] = __builtin_bit_cast(bf16x8, a1);
        }
#pragma unroll
        for (int blk = 0; blk < 2; ++blk)
#pragma unroll
            for (int sk = 0; sk < 2; ++sk) {
                const int kb = 32 * blk + 16 * sk + 4 * hi;
                const u32x2 a = *(const LAS u32x2*)(Vb + r32 * AV_STR + kb), c = *(const LAS u32x2*)(Vb + r32 * AV_STR + kb + 8);
                const u32x2 a2 = *(const LAS u32x2*)(Vb + (32 + r32) * AV_STR + kb), c2 = *(const LAS u32x2*)(Vb + (32 + r32) * AV_STR + kb + 8);
                const u32x4 v0 = {a.x, a.y, c.x, c.y}, v1 = {a2.x, a2.y, c2.x, c2.y};
                O0 = mfma32(pa[blk][sk], __builtin_bit_cast(bf16x8, v0), O0);
                O1 = mfma32(pa[blk][sk], __builtin_bit_cast(bf16x8, v1), O1);
            }
        if (kt < qt) {
            LAS bf16_t* Kn = (LAS bf16_t*)(lds + AT_K0 + (buf ^ 1) * (64 * AK_STR * 2)); LAS bf16_t* Vn = (LAS bf16_t*)(lds + AT_V0 + (buf ^ 1) * (64 * AV_STR * 2));
            *(LAS u32x4*)(Kn + skey * AK_STR + sdch * 8) = kreg;
#pragma unroll
            for (int e = 0; e < 4; ++e) { Vn[(sdch * 8 + 2 * e) * AV_STR + skey] = (bf16_t)(vreg[e] & 0xffffu); Vn[(sdch * 8 + 2 * e + 1) * AV_STR + skey] = (bf16_t)(vreg[e] >> 16); }
        }
    }
    l_run += __shfl_xor(l_run, 32);
    if (hi == 0) wsc[r32] = 1.0f / l_run;
    asm volatile("s_waitcnt lgkmcnt(0)" ::: "memory");
#pragma unroll
    for (int i = 0; i < 16; ++i) {
        const int rq = (i & 3) + 8 * (i >> 2) + 4 * hi; const float inv = wsc[rq];
        bf16_t* dst = YA + (size_t)(b * 2048 + qt * 64 + 8 * wave + (rq >> 2)) * D + (4 * g + (rq & 3)) * 64 + r32;
        dst[0] = (bf16_t)f2bf(O0[i] * inv); dst[32] = (bf16_t)f2bf(O1[i] * inv);
    }
    __syncthreads();
}

__device__ __forceinline__ void attend_sample_task(const Args& A, LAS unsigned char* wl, const LAS float* biasrel, int ms, int g, int lane_in) {
    constexpr int NJ = 33;
    int lane = lane_in; asm volatile("" : "+v"(lane));
    const bf16_t* P = (const bf16_t*)(A.ws + WS_P);
    const int b = ms >> 2, t = ms & 3, nvalid = 2049 + t, qpos = 2048 + t, m = MP + ms;
    const float* srow = (const float*)(A.ws + WS_SCS) + (size_t)ms * SCSW;
    LAS float* pq = (LAS float*)wl;
    LAS unsigned* rowid = (LAS unsigned*)(wl + 4096);
    LAS unsigned short* posl = (LAS unsigned short*)(wl + 4096 + 1024);
    unsigned key[NJ];
#pragma unroll
    for (int j = 0; j < NJ; ++j) key[j] = (lane < nvalid - 64 * j) ? f2key(srow[lane + 64 * j]) : 0u;
    unsigned T = 0u; int need_eq = 0;
    {
        bool exact = false;
        for (int bit = 31; bit >= 0; --bit) {
            const unsigned cand = T | (1u << bit); int cnt = 0;
#pragma unroll
            for (int j = 0; j < NJ; ++j) cnt += __popcll(__ballot(key[j] >= cand));
            if (cnt >= 256) { T = cand; if (cnt == 256) { exact = true; break; } }
        }
        if (exact) { T -= 1u; }
        else { int cgt = 0;
#pragma unroll
            for (int j = 0; j < NJ; ++j) cgt += __popcll(__ballot(key[j] > T));
            need_eq = 256 - cgt; }
    }
    int base = 0, eqused = 0;
    const int* pt = (const int*)A.in[I_PT];
#pragma unroll
    for (int j = 0; j < NJ; ++j) {
        const bool gt = key[j] > T, eq = (need_eq > 0) && (key[j] == T);
        const unsigned long long meq = __ballot(eq);
        const bool sel = gt || (eq && (eqused + mbcnt64(meq) < need_eq));
        eqused += __popcll(meq);
        const unsigned long long msk = __ballot(sel);
        if (sel) { const int pos = lane + 64 * j, k = base + mbcnt64(msk);
            posl[k] = (unsigned short)pos;
            rowid[k] = (pos < 2048) ? (unsigned)(pt[b * 16 + (pos >> 7)] * 128 + (pos & 127)) : (0x80000000u | (unsigned)(b * 4 + pos - 2048)); }
        base += __popcll(msk);
    }
    { const u32x2 w = *(const u32x2*)(P + (size_t)m * NP + PQ + g * 256 + lane * 4);
      *(LAS f32x4*)(pq + lane * 4) = (f32x4){__uint_as_float(w.x << 16), __uint_as_float(w.x & 0xffff0000u), __uint_as_float(w.y << 16), __uint_as_float(w.y & 0xffff0000u)}; }
    asm volatile("s_waitcnt lgkmcnt(0)" ::: "memory");
    const float* ck = A.in[I_CK]; const float* cv = A.in[I_CV]; const float* kn = A.out + O_KS; const float* vn = A.out + O_VS;
    const float* kp[4]; int rel[4];
#pragma unroll
    for (int i = 0; i < 4; ++i) { const unsigned rid = rowid[lane + 64 * i]; rel[i] = qpos - (int)posl[lane + 64 * i];
        kp[i] = ((rid & 0x80000000u) ? kn + (size_t)(rid & 0x7fffffffu) * 256 : ck + (size_t)rid * 256) + g * 64; }
    float acc[4][4];
#pragma unroll
    for (int i = 0; i < 4; ++i)
#pragma unroll
        for (int hh = 0; hh < 4; ++hh) acc[i][hh] = 0.f;
#pragma unroll 2
    for (int dc = 0; dc < 16; ++dc) {
        f32x4 kv[4];
#pragma unroll
        for (int i = 0; i < 4; ++i) kv[i] = *(const f32x4*)(kp[i] + dc * 4);
#pragma unroll
        for (int hh = 0; hh < 4; ++hh) { const f32x4 q4 = *(const LAS f32x4*)(pq + hh * 64 + dc * 4);
#pragma unroll
            for (int i = 0; i < 4; ++i) acc[i][hh] += kv[i][0] * q4[0] + kv[i][1] * q4[1] + kv[i][2] * q4[2] + kv[i][3] * q4[3]; }
    }
    asm volatile("s_waitcnt lgkmcnt(0)" ::: "memory");
#pragma unroll
    for (int i = 0; i < 4; ++i) { const int rc = rel[i] < 128 ? (rel[i] < 0 ? 0 : rel[i]) : 128; const f32x4 bv = *(const LAS f32x4*)(biasrel + rc * 16 + 4 * g);
#pragma unroll
        for (int hh = 0; hh < 4; ++hh) acc[i][hh] = acc[i][hh] * 0.125f + bv[hh]; }
#pragma unroll
    for (int hh = 0; hh < 4; ++hh) {
        const float mx = wave_max(fmaxf(fmaxf(acc[0][hh], acc[1][hh]), fmaxf(acc[2][hh], acc[3][hh])));
        float sm = 0.f;
#pragma unroll
        for (int i = 0; i < 4; ++i) { acc[i][hh] = __expf(acc[i][hh] - mx); sm += acc[i][hh]; }
        const float inv = 1.0f / wave_sum(sm);
#pragma unroll
        for (int i = 0; i < 4; ++i) acc[i][hh] *= inv;
    }
#pragma unroll
    for (int i = 0; i < 4; ++i) *(LAS f32x4*)(pq + (lane + 64 * i) * 4) = (f32x4){acc[i][0], acc[i][1], acc[i][2], acc[i][3]};
    asm volatile("s_waitcnt lgkmcnt(0)" ::: "memory");
    float o[4] = {0.f, 0.f, 0.f, 0.f};
    for (int k0 = 0; k0 < 256; k0 += 8) {
        float vv[8]; f32x4 pp[8];
#pragma unroll
        for (int u = 0; u < 8; ++u) { const unsigned rid = rowid[k0 + u];
            const float* vp = ((rid & 0x80000000u) ? vn + (size_t)(rid & 0x7fffffffu) * 256 : cv + (size_t)rid * 256) + g * 64 + lane;
            vv[u] = *vp; pp[u] = *(const LAS f32x4*)(pq + (k0 + u) * 4); }
#pragma unroll
        for (int u = 0; u < 8; ++u)
#pragma unroll
            for (int hh = 0; hh < 4; ++hh) o[hh] += pp[u][hh] * vv[u];
    }
    bf16_t* YA = (bf16_t*)(A.ws + WS_YA);
#pragma unroll
    for (int hh = 0; hh < 4; ++hh) YA[(size_t)m * D + (4 * g + hh) * 64 + lane] = (bf16_t)f2bf(o[hh]);
    asm volatile("s_waitcnt lgkmcnt(0)" ::: "memory");
}

#if MK_CHECK_ATT
constexpr size_t WS_CHK_SC = WS_END, WS_CHK_YA = WS_CHK_SC + 128 * MiB, WS_CHK_MASK = WS_CHK_YA + 33 * MiB, WS_CHK_END = WS_CHK_MASK + 4 * MiB;
constexpr int CW_CHK = 512;
template <bool SAMPLE> struct KVRow;
template <> struct KVRow<false> {
    typedef const bf16_t* ptr;
    const bf16_t* P;
    __device__ __forceinline__ ptr krow(unsigned rid) const { return P + (size_t)rid * NP + PK; }
    __device__ __forceinline__ ptr vrow(unsigned rid) const { return P + (size_t)rid * NP + PV; }
    static __device__ __forceinline__ void k8(ptr p, float (&f)[8]) { unpack8(*(const u32x4*)p, f); }
    static __device__ __forceinline__ f32x4 v4(ptr p) { const u32x2 w = *(const u32x2*)p;
        return (f32x4){__uint_as_float(w.x << 16), __uint_as_float(w.x & 0xffff0000u), __uint_as_float(w.y << 16), __uint_as_float(w.y & 0xffff0000u)}; }
};
template <> struct KVRow<true> {
    typedef const float* ptr;
    const float* ck; const float* cv; const float* kn; const float* vn;
    __device__ __forceinline__ ptr krow(unsigned rid) const { return (rid & 0x80000000u) ? kn + (size_t)(rid & 0x7fffffffu) * 256 : ck + (size_t)rid * 256; }
    __device__ __forceinline__ ptr vrow(unsigned rid) const { return (rid & 0x80000000u) ? vn + (size_t)(rid & 0x7fffffffu) * 256 : cv + (size_t)rid * 256; }
    static __device__ __forceinline__ void k8(ptr p, float (&f)[8]) { const f32x4 a = *(const f32x4*)p, b = *(const f32x4*)(p + 4);
#pragma unroll
        for (int i = 0; i < 4; ++i) { f[i] = a[i]; f[4 + i] = b[i]; } }
    static __device__ __forceinline__ f32x4 v4(ptr p) { return *(const f32x4*)p; }
};

template <bool SAMPLE>
__device__ __forceinline__ void attend_query(const Args& A, LAS unsigned char* wl, const LAS float* biasrel, int m, int lane_in) {
    constexpr int NJ = SAMPLE ? 33 : 32;
    int lane = lane_in; asm volatile("" : "+v"(lane));
    const bf16_t* P = (const bf16_t*)(A.ws + WS_P);
    int b, nvalid, qpos; const float* srow;
    if (!SAMPLE) { b = m >> 11; const int t = m & 2047; nvalid = t + 1; qpos = t; srow = (const float*)(A.ws + WS_CHK_SC) + (size_t)m * SCW; }
    else { const int ms = m - MP; b = ms >> 2; const int t = ms & 3; nvalid = 2049 + t; qpos = 2048 + t; srow = (const float*)(A.ws + WS_SCS) + (size_t)ms * SCSW; }
    LAS float* pq = (LAS float*)wl;
    LAS unsigned* rowid = (LAS unsigned*)(wl + 16384);
    LAS unsigned short* posl = (LAS unsigned short*)(wl + 16384 + 1024);
    unsigned key[NJ];
#pragma unroll
    for (int j = 0; j < NJ; ++j) { key[j] = (lane < nvalid - 64 * j) ? f2key(srow[lane + 64 * j]) : 0u; }
    unsigned T = 0u; int need_eq = 0;
    if (nvalid > 256) {
        for (int bit = 31; bit >= 0; --bit) {
            const unsigned cand = T | (1u << bit); int cnt = 0;
#pragma unroll
            for (int j = 0; j < NJ; ++j) cnt += __popcll(__ballot(key[j] >= cand));
            if (cnt >= 256) T = cand;
        }
        int cgt = 0;
#pragma unroll
        for (int j = 0; j < NJ; ++j) cgt += __popcll(__ballot(key[j] > T));
        need_eq = 256 - cgt;
    }
    int base = 0, eqused = 0; unsigned long long mine_chk = 0ull;
    const int* pt = (const int*)A.in[I_PT];
#pragma unroll
    for (int j = 0; j < NJ; ++j) {
        const bool gt = key[j] > T, eq = (need_eq > 0) && (key[j] == T);
        const unsigned long long meq = __ballot(eq);
        const bool sel = gt || (eq && (eqused + mbcnt64(meq) < need_eq));
        eqused += __popcll(meq);
        const unsigned long long ms = __ballot(sel);
        if (sel) { const int pos = lane + 64 * j, k = base + mbcnt64(ms);
            posl[k] = (unsigned short)pos;
            unsigned rid;
            if (!SAMPLE) rid = (unsigned)(b * 2048 + pos);
            else rid = (pos < 2048) ? (unsigned)(pt[b * 16 + (pos >> 7)] * 128 + (pos & 127)) : (0x80000000u | (unsigned)(b * 4 + pos - 2048));
            rowid[k] = rid; }
        base += __popcll(ms);
        if (!SAMPLE) { if (lane == j) mine_chk = ms; }
    }
    if (!SAMPLE) { if (lane < 32) ((unsigned long long*)(A.ws + WS_CHK_MASK))[(size_t)m * 32 + lane] = mine_chk; }
    const int nsel = base;
    asm volatile("s_waitcnt lgkmcnt(0)" ::: "memory");
    { const unsigned r0 = rowid[0]; const unsigned short p0 = posl[0];
#pragma unroll
      for (int i = 0; i < 4; ++i) { const int k = lane + 64 * i; if (k >= nsel) { rowid[k] = r0; posl[k] = p0; } } }
    { const u32x4 w0 = *(const u32x4*)(P + (size_t)m * NP + PQ + lane * 16), w1 = *(const u32x4*)(P + (size_t)m * NP + PQ + lane * 16 + 8);
      float f0[8], f1[8]; unpack8(w0, f0); unpack8(w1, f1);
#pragma unroll
      for (int e = 0; e < 8; ++e) { pq[lane * 16 + e] = f0[e]; pq[lane * 16 + 8 + e] = f1[e]; } }
    asm volatile("s_waitcnt lgkmcnt(0)" ::: "memory");
    KVRow<SAMPLE> R;
    if constexpr (!SAMPLE) { R.P = P; } else { R.ck = A.in[I_CK]; R.cv = A.in[I_CV]; R.kn = A.out + O_KS; R.vn = A.out + O_VS; }
    typename KVRow<SAMPLE>::ptr kp[4]; int rel[4];
#pragma unroll
    for (int i = 0; i < 4; ++i) { kp[i] = R.krow(rowid[lane + 64 * i]); rel[i] = qpos - (int)posl[lane + 64 * i]; }
    float acc[4][16];
#pragma unroll
    for (int i = 0; i < 4; ++i)
#pragma unroll
        for (int hh = 0; hh < 16; ++hh) acc[i][hh] = 0.f;
#pragma unroll
    for (int g = 0; g < 4; ++g) {
#pragma unroll 1
        for (int dc = 0; dc < 8; ++dc) {
            float kv[4][8];
#pragma unroll
            for (int i = 0; i < 4; ++i) KVRow<SAMPLE>::k8(kp[i] + g * 64 + dc * 8, kv[i]);
#pragma unroll
            for (int hh = 0; hh < 4; ++hh) {
                const f32x4 q0 = *(const LAS f32x4*)(pq + (4 * g + hh) * 64 + dc * 8), q1 = *(const LAS f32x4*)(pq + (4 * g + hh) * 64 + dc * 8 + 4);
#pragma unroll
                for (int i = 0; i < 4; ++i) {
                    float a = acc[i][4 * g + hh];
#pragma unroll
                    for (int e = 0; e < 4; ++e) { a += kv[i][e] * q0[e]; a += kv[i][4 + e] * q1[e]; }
                    acc[i][4 * g + hh] = a; }
            }
        }
    }
    asm volatile("s_waitcnt lgkmcnt(0)" ::: "memory");
#pragma unroll
    for (int i = 0; i < 4; ++i) {
        const bool valid = (lane + 64 * i) < nsel; const int rc = rel[i] < 128 ? (rel[i] < 0 ? 0 : rel[i]) : 128;
#pragma unroll
        for (int h4 = 0; h4 < 4; ++h4) { const f32x4 bv = *(const LAS f32x4*)(biasrel + rc * 16 + 4 * h4);
#pragma unroll
            for (int e = 0; e < 4; ++e) acc[i][4 * h4 + e] = valid ? acc[i][4 * h4 + e] * 0.125f + bv[e] : -INFINITY; }
    }
#pragma unroll
    for (int hh = 0; hh < 16; ++hh) {
        const float mx = wave_max(fmaxf(fmaxf(acc[0][hh], acc[1][hh]), fmaxf(acc[2][hh], acc[3][hh])));
        float s = 0.f;
#pragma unroll
        for (int i = 0; i < 4; ++i) { acc[i][hh] = __expf(acc[i][hh] - mx); s += acc[i][hh]; }
        const float inv = 1.0f / wave_sum(s);
#pragma unroll
        for (int i = 0; i < 4; ++i) acc[i][hh] *= inv;
    }
#pragma unroll
    for (int i = 0; i < 4; ++i)
#pragma unroll
        for (int h4 = 0; h4 < 4; ++h4) *(LAS f32x4*)(pq + (lane + 64 * i) * 16 + 4 * h4) = (f32x4){acc[i][4 * h4], acc[i][4 * h4 + 1], acc[i][4 * h4 + 2], acc[i][4 * h4 + 3]};
    asm volatile("s_waitcnt lgkmcnt(0)" ::: "memory");
    const int g = lane >> 4;
    f32x4 o[4];
#pragma unroll
    for (int hh = 0; hh < 4; ++hh) o[hh] = (f32x4){0.f, 0.f, 0.f, 0.f};
    const int nloop = (nsel + 3) & ~3;
    for (int k0 = 0; k0 < nloop; k0 += 4) {
        f32x4 vv[4], pp[4];
#pragma unroll
        for (int u = 0; u < 4; ++u) { const unsigned r = rowid[k0 + u]; vv[u] = KVRow<SAMPLE>::v4(R.vrow(r) + lane * 4); pp[u] = *(const LAS f32x4*)(pq + (k0 + u) * 16 + 4 * g); }
#pragma unroll
        for (int u = 0; u < 4; ++u)
#pragma unroll
            for (int hh = 0; hh < 4; ++hh) o[hh] += vv[u] * pp[u][hh];
    }
    bf16_t* YA = (bf16_t*)(A.ws + WS_CHK_YA);
#pragma unroll
    for (int hh = 0; hh < 4; ++hh) { u32x2 w; w.x = pk2(o[hh][0], o[hh][1]); w.y = pk2(o[hh][2], o[hh][3]);
        *(u32x2*)(YA + (size_t)m * D + (4 * g + hh) * 64 + (lane & 15) * 4) = w; }
    asm volatile("s_waitcnt lgkmcnt(0)" ::: "memory");
}


__device__ __forceinline__ void check_compare(const Args& A, int gw, int NGW, int lane) {
    const bf16_t* Y1 = (const bf16_t*)(A.ws + WS_YA); const bf16_t* Y2 = (const bf16_t*)(A.ws + WS_CHK_YA); unsigned* ctl = (unsigned*)(A.ws + WS_CTL);
    for (int m = gw; m < MP; m += NGW) {
        float e = 0.f, n = 0.f;
#pragma unroll
        for (int j = 0; j < 2; ++j) { float a[8], b[8]; unpack8(*(const u32x4*)(Y1 + (size_t)m * D + j * 512 + lane * 8), a); unpack8(*(const u32x4*)(Y2 + (size_t)m * D + j * 512 + lane * 8), b);
#pragma unroll
            for (int i = 0; i < 8; ++i) { const float d = a[i] - b[i]; e += d * d; n += b[i] * b[i]; } }
        e = wave_sum(e); n = wave_sum(n);
        { const unsigned long long w1 = (lane < 32) ? ((const unsigned long long*)(A.ws + WS_SC))[(size_t)m * 32 + lane] : 0ull, w2 = (lane < 32) ? ((const unsigned long long*)(A.ws + WS_CHK_MASK))[(size_t)m * 32 + lane] : 0ull;
          if (__any(w1 != w2) && lane == 0) atomicAdd(ctl + CW_CHK + 3, 1u);
          const int t = m & 2047;
          if (t >= 256) {
              const float* srow = (const float*)(A.ws + WS_CHK_SC) + (size_t)m * SCW;
              int c1 = 0, c2 = 0; float mins1 = INFINITY, maxu1 = -INFINITY, mins2 = INFINITY, maxu2 = -INFINITY;
              for (int j = 0; j < 32; ++j) { const int sp = lane + 64 * j; if (64 * j > t) break;
                  const unsigned long long a1 = __shfl((unsigned long long)w1, j), a2 = __shfl((unsigned long long)w2, j);
                  if (sp <= t) { const float v = srow[sp]; const bool s1 = (a1 >> lane) & 1ull, s2 = (a2 >> lane) & 1ull;
                      if (s1) { ++c1; mins1 = fminf(mins1, v); } else maxu1 = fmaxf(maxu1, v);
                      if (s2) { ++c2; mins2 = fminf(mins2, v); } else maxu2 = fmaxf(maxu2, v); } }
              c1 = (int)wave_sum((float)c1); c2 = (int)wave_sum((float)c2);
              mins1 = -wave_max(-mins1); mins2 = -wave_max(-mins2); maxu1 = wave_max(maxu1); maxu2 = wave_max(maxu2);
              if (lane == 0) { if (c1 != 256 || mins1 < maxu1) atomicAdd(ctl + CW_CHK + 4, 1u); if (c2 != 256 || mins2 < maxu2) atomicAdd(ctl + CW_CHK + 5, 1u); }
          } }
        if (lane == 0 && !(e <= MK_CHECK_TOL * MK_CHECK_TOL * n + 1e-12f)) { const int t = m & 2047; atomicAdd(ctl + CW_CHK + (t < 64 ? 0 : t < 256 ? 1 : 2), 1u); }
    }
}
#endif
__device__ __forceinline__ void gate_norm_phase(const Args& A, int gw, int NGW, int lane) {
    const bf16_t* P = (const bf16_t*)(A.ws + WS_P); bf16_t* Y = (bf16_t*)(A.ws + WS_Y); const float* ng = A.in[I_NORMG];
    for (int it = gw; it < M * 4; it += NGW) {
        const int m = it >> 2, ch = (it & 3) * 512 + lane * 8;
        float y[8], z[8]; unpack8(*(const u32x4*)(Y + (size_t)m * DI + ch), y); unpack8(*(const u32x4*)(P + (size_t)m * NP + PZ + ch), z);
        float ss = 0.f;
#pragma unroll
        for (int i = 0; i < 8; ++i) { y[i] *= siluf_(z[i]); ss += y[i] * y[i]; }
        const float r = 1.0f / sqrtf(wave_sum(ss) * (1.f / 512.f) + LN_EPS);
        const f32x4 g0 = *(const f32x4*)(ng + ch), g1 = *(const f32x4*)(ng + ch + 4);
#pragma unroll
        for (int i = 0; i < 4; ++i) { y[i] = y[i] * r * g0[i]; y[4 + i] = y[4 + i] * r * g1[i]; }
        *(u32x4*)(Y + (size_t)m * DI + ch) = pack8(y);
    }
}

constexpr int NPHASE = 14;
__global__ void __launch_bounds__(NTHR, 2) fwd(Args args) {
    extern __shared__ __attribute__((aligned(16))) unsigned char lds_raw[];
    LAS unsigned char* lds = (LAS unsigned char*)lds_raw;
    const int tid = threadIdx.x, lane = tid & 63, wave = __builtin_amdgcn_readfirstlane(tid >> 6);
    const int G = gridDim.x, bx = blockIdx.x;
    const int vcu = (G % 8 == 0) ? (bx % 8) * (G / 8) + bx / 8 : bx;
    const int gw = vcu * NWAVES + wave, NGW = G * NWAVES;
    unsigned char* ws = args.ws;
    volatile LAS unsigned* MISC = (volatile LAS unsigned*)(lds + MISC_OFF);
    for (int u = tid; u < 64; u += NTHR) MISC[u] = 0u;
    __syncthreads();
    const int lo = args.ph_lo, hi = args.ph_hi;
    XcdBarrier bar; bar.bar = (unsigned*)(ws + WS_CTL) + CW_BAR; bar.x = 0; bar.st = nullptr;
    if (hi - lo > 1) bar = xcd_barrier_post((unsigned*)(ws + WS_CTL) + CW_BAR, MISC + 8);
#define IN(k) (lo <= (k) && (k) < hi)
#define SEAM(k) do { if (IN(k) && IN((k) + 1)) xcd_barrier(bar); } while (0)

    bf16_t* const XB = (bf16_t*)(ws + WS_XB); bf16_t* const ACT = (bf16_t*)(ws + WS_ACT); float* const T = (float*)(ws + WS_T);
    float* const HF = (float*)(ws + WS_HF); bf16_t* const HB = (bf16_t*)(ws + WS_HB); bf16_t* const P = (bf16_t*)(ws + WS_P);
    float* const SMF = (float*)(ws + WS_SMF); bf16_t* const Y = (bf16_t*)(ws + WS_Y); bf16_t* const YA = (bf16_t*)(ws + WS_YA); bf16_t* const MG = (bf16_t*)(ws + WS_MG);

    if (IN(0)) REPK(0) { p0_prologue(args, lds, gw, NGW, wave, lane); }
    SEAM(0);
    if (IN(1)) {
        { pg8::Gemm g{XB, (const bf16_t*)(ws + WS_W1A), M, 2 * DFF, D}; pg8::StaticOrder S; S.init(M, 2 * DFF, G, bx);
        EpiSwiglu E{ACT}; pg8::gemm_phase<EpiSwiglu, pg8::StaticOrder, true, true>(lds, g, S, E); }
        if constexpr (DUPK(1)) { pg8::Gemm g{XB, (const bf16_t*)(ws + WS_W1A), M, 2 * DFF, D}; pg8::StaticOrder S; S.init(M, 2 * DFF, G, bx);
        EpiSwiglu E{ACT}; pg8::gemm_phase<EpiSwiglu, pg8::StaticOrder, true, true>(lds, g, S, E); }
    }
    SEAM(1);
    if (IN(2)) {
        { pg8::Gemm g{ACT, (const bf16_t*)(ws + WS_W1B), M, D, DFF}; pg8::StaticOrder S; S.init(M, D, G, bx);
        EpiResid E{args.in[I_XP], args.in[I_XS], T, ALPHA, 0.5f}; pg8::gemm_phase<EpiResid, pg8::StaticOrder, true, true>(lds, g, S, E); }
        if constexpr (DUPK(2)) { pg8::Gemm g{ACT, (const bf16_t*)(ws + WS_W1B), M, D, DFF}; pg8::StaticOrder S; S.init(M, D, G, bx);
        EpiResid E{args.in[I_XP], args.in[I_XS], T, ALPHA, 0.5f}; pg8::gemm_phase<EpiResid, pg8::StaticOrder, true, true>(lds, g, S, E); }
    }
    SEAM(2);
    if (IN(3)) REPK(3) { ln_phase(T, args.in[I_LN1G], args.in[I_LN1B], HF, HB, gw, NGW, lane); }
    SEAM(3);
    if (IN(4)) {
        { pg8::Gemm g{HB, (const bf16_t*)(ws + WS_WIN), M, NP, D}; pg8::StaticOrder S; S.init(M, NP, G, bx);
        EpiWin E{P, SMF, args.out}; pg8::gemm_phase<EpiWin, pg8::StaticOrder, true, true>(lds, g, S, E); }
        if constexpr (DUPK(4)) { pg8::Gemm g{HB, (const bf16_t*)(ws + WS_WIN), M, NP, D}; pg8::StaticOrder S; S.init(M, NP, G, bx);
        EpiWin E{P, SMF, args.out}; pg8::gemm_phase<EpiWin, pg8::StaticOrder, true, true>(lds, g, S, E); }
    }
    SEAM(4);
    if (IN(5)) REPK(5) {
        for (int rep = 0; rep < MK_REP_CONV; ++rep)
        conv_phase(args, gw, NGW, lane);
        for (int rep = 0; rep < MK_REP_SCP; ++rep)
        for (int u = bx; u < 1024; u += G) { const int i = u >> 8, c = u & 255, b = c >> 5, s = c & 31; const int qt = (i == 0) ? s : (i == 1) ? 63 - s : (i == 2) ? 64 + s : 127 - s;
            scores_select_prompt_unit(args, lds, b, qt, wave, lane); }
        for (int rep = 0; rep < MK_REP_SCS; ++rep)
        for (int u = bx; u < 256; u += G) scores_sample_unit(args, u >> 1, u & 1, wave, lane);
    }
    SEAM(5);
    if (IN(6)) {
        for (int rep = 0; rep < MK_REP_SSDP; ++rep)
        for (int it = bx; it < 256; it += G) ssd_prompt_item(args, lds, it >> 5, it & 31);
        __syncthreads();
        LAS float* biasrel = (LAS float*)(lds + BIASREL_OFF); LAS float* biasL = biasrel + 129 * 16;
        for (int i = tid; i < 129 * 16; i += NTHR) { const int rel = i >> 4, h = i & 15; const float bv = args.in[I_BIAS][t5_bucket(rel) * 16 + h]; biasrel[i] = bv; biasL[i] = bv * LOG2E; }
        __syncthreads();
        for (int rep = 0; rep < MK_REP_ATTP; ++rep)
        for (int u = bx; u < 1024; u += G) { const int i = u >> 8, c = u & 255, bg = c >> 3, s8 = c & 7; const int qt = (i == 0) ? s8 : (i == 1) ? 15 - s8 : (i == 2) ? 16 + s8 : 31 - s8;
            attn_prompt_unit(args, lds, biasL, bg >> 2, bg & 3, qt, wave, lane); }
        __syncthreads();
        LAS unsigned char* wl = lds + wave * WAREA;
        for (int rep = 0; rep < MK_REP_SSDS; ++rep)
        for (int it = gw; it < 4096; it += NGW) ssd_sample_item(args, wl, it >> 5, it & 31, lane);
        for (int rep = 0; rep < MK_REP_ATTS; ++rep)
        for (int q = gw; q < MS * 4; q += NGW) attend_sample_task(args, wl, biasrel, q >> 2, q & 3, lane);
#if MK_CHECK_ATT
        for (int q = gw; q < MP; q += NGW) attend_query<false>(args, wl, biasrel, q, lane);
#endif
        __syncthreads();
    }
    SEAM(6);
    if (IN(7)) {
        gate_norm_phase(args, gw, NGW, lane);
#if MK_CHECK_ATT
        check_compare(args, gw, NGW, lane);
#endif
        { pg8::Gemm g{YA, (const bf16_t*)(ws + WS_WBA), M, D, D}; pg8::StaticOrder S; S.init(M, D, G, bx);
        EpiGateA E{P, PG + D, T}; pg8::gemm_phase<EpiGateA, pg8::StaticOrder, true, true>(lds, g, S, E); }
        if constexpr (DUPK(7)) { pg8::Gemm g{YA, (const bf16_t*)(ws + WS_WBA), M, D, D}; pg8::StaticOrder S; S.init(M, D, G, bx);
        EpiGateA E{P, PG + D, T}; pg8::gemm_phase<EpiGateA, pg8::StaticOrder, true, true>(lds, g, S, E); }
    }
    SEAM(7);
    if (IN(8)) {
        { pg8::Gemm g{Y, (const bf16_t*)(ws + WS_WBS), M, D, DI}; pg8::StaticOrder S; S.init(M, D, G, bx);
        EpiGateS E{P, PG, T, MG}; pg8::gemm_phase<EpiGateS, pg8::StaticOrder, true, true>(lds, g, S, E); }
        if constexpr (DUPK(8)) { pg8::Gemm g{Y, (const bf16_t*)(ws + WS_WBS), M, D, DI}; pg8::StaticOrder S; S.init(M, D, G, bx);
        EpiGateS E{P, PG, T, MG}; pg8::gemm_phase<EpiGateS, pg8::StaticOrder, true, true>(lds, g, S, E); }
    }
    SEAM(8);
    if (IN(9)) {
        { pg8::Gemm g{MG, (const bf16_t*)(ws + WS_WOUT), M, D, D}; pg8::StaticOrder S; S.init(M, D, G, bx);
        EpiResid E{HF, HF + (size_t)MP * D, T, ALPHA, 1.0f}; pg8::gemm_phase<EpiResid, pg8::StaticOrder, true, true>(lds, g, S, E); }
        if constexpr (DUPK(9)) { pg8::Gemm g{MG, (const bf16_t*)(ws + WS_WOUT), M, D, D}; pg8::StaticOrder S; S.init(M, D, G, bx);
        EpiResid E{HF, HF + (size_t)MP * D, T, ALPHA, 1.0f}; pg8::gemm_phase<EpiResid, pg8::StaticOrder, true, true>(lds, g, S, E); }
    }
    SEAM(9);
    if (IN(10)) REPK(10) { ln_phase(T, args.in[I_LN2G], args.in[I_LN2B], HF, HB, gw, NGW, lane); }
    SEAM(10);
    if (IN(11)) {
        { pg8::Gemm g{HB, (const bf16_t*)(ws + WS_W2A), M, 2 * DFF, D}; pg8::StaticOrder S; S.init(M, 2 * DFF, G, bx);
        EpiSwiglu E{ACT}; pg8::gemm_phase<EpiSwiglu, pg8::StaticOrder, true, true>(lds, g, S, E); }
        if constexpr (DUPK(11)) { pg8::Gemm g{HB, (const bf16_t*)(ws + WS_W2A), M, 2 * DFF, D}; pg8::StaticOrder S; S.init(M, 2 * DFF, G, bx);
        EpiSwiglu E{ACT}; pg8::gemm_phase<EpiSwiglu, pg8::StaticOrder, true, true>(lds, g, S, E); }
    }
    SEAM(11);
    if (IN(12)) {
        { pg8::Gemm g{ACT, (const bf16_t*)(ws + WS_W2B), M, D, DFF}; pg8::StaticOrder S; S.init(M, D, G, bx);
        EpiResid E{HF, HF + (size_t)MP * D, T, ALPHA, 0.5f}; pg8::gemm_phase<EpiResid, pg8::StaticOrder, true, true>(lds, g, S, E); }
        if constexpr (DUPK(12)) { pg8::Gemm g{ACT, (const bf16_t*)(ws + WS_W2B), M, D, DFF}; pg8::StaticOrder S; S.init(M, D, G, bx);
        EpiResid E{HF, HF + (size_t)MP * D, T, ALPHA, 0.5f}; pg8::gemm_phase<EpiResid, pg8::StaticOrder, true, true>(lds, g, S, E); }
    }
    SEAM(12);
    if (IN(13)) REPK(13) { ln_phase(T, args.in[I_LN3G], args.in[I_LN3B], args.out + O_Y, nullptr, gw, NGW, lane); }
#if MK_CHECK_ATT
    if (IN(13)) { __syncthreads(); unsigned* cw = (unsigned*)(ws + WS_CTL) + CW_CHK;
        const unsigned b0 = __hip_atomic_load(cw, __ATOMIC_RELAXED, __HIP_MEMORY_SCOPE_AGENT), b1 = __hip_atomic_load(cw + 1, __ATOMIC_RELAXED, __HIP_MEMORY_SCOPE_AGENT), b2 = __hip_atomic_load(cw + 2, __ATOMIC_RELAXED, __HIP_MEMORY_SCOPE_AGENT), b3 = __hip_atomic_load(cw + 3, __ATOMIC_RELAXED, __HIP_MEMORY_SCOPE_AGENT), b4 = __hip_atomic_load(cw + 4, __ATOMIC_RELAXED, __HIP_MEMORY_SCOPE_AGENT), b5 = __hip_atomic_load(cw + 5, __ATOMIC_RELAXED, __HIP_MEMORY_SCOPE_AGENT);
        const float code = MK_CHECK_CODE;
        if (code > 0.f && bx == 0 && tid == 0) args.out[O_Y] = 4096.0f * sqrtf(code); }
#endif
#undef IN
#undef SEAM
}
}

extern "C" void kernel_launch(void* const* d_in, const int* in_sizes, int n_in, void* d_out, int out_size, void* d_ws, size_t ws_size, hipStream_t stream) {
    using namespace mk;
    static int grid = 0;
    if (grid == 0) {
        if (n_in != 29 || (size_t)out_size != O_END || ws_size < WS_END) { fprintf(stderr, "kernel_launch: unexpected shapes (n_in %d, out %d, ws %zu)\n", n_in, out_size, ws_size); grid = -1; return; }
        int dev = 0, cus = 0, per_cu = 0;
        if (hipGetDevice(&dev) != hipSuccess || hipDeviceGetAttribute(&cus, hipDeviceAttributeMultiprocessorCount, dev) != hipSuccess) { grid = -1; return; }
        if (hipFuncSetAttribute((const void*)fwd, hipFuncAttributeMaxDynamicSharedMemorySize, LDS_BYTES) != hipSuccess) { fprintf(stderr, "kernel_launch: hipFuncSetAttribute failed\n"); grid = -1; return; }
        if (hipOccupancyMaxActiveBlocksPerMultiprocessor(&per_cu, (const void*)fwd, NTHR, LDS_BYTES) != hipSuccess || per_cu < 1) fprintf(stderr, "kernel_launch: occupancy query says %d\n", per_cu);
        (void)hipGetLastError();
        grid = cus;
    }
    if (grid < 0) return;
    (void)hipMemsetAsync((char*)d_ws + WS_CTL, 0, CTL_ZERO_BYTES, stream);
    Args a{};
    for (int i = 0; i < 29; ++i) a.in[i] = (const float*)d_in[i];
    a.out = (float*)d_out; a.ws = (unsigned char*)d_ws;
#if MK_SPLIT
    for (int p = 0; p < NPHASE; ++p) { a.ph_lo = p; a.ph_hi = p + 1; hipLaunchKernelGGL(fwd, dim3(grid), dim3(NTHR), LDS_BYTES, stream, a); }
#else
    a.ph_lo = 0; a.ph_hi = NPHASE; hipLaunchKernelGGL(fwd, dim3(grid), dim3(NTHR), LDS_BYTES, stream, a);
#endif
}
```

```cpp
#include <hip/hip_runtime.h>
#include <cstdio>
#include <cstdint>
#define GAS __attribute__((address_space(1)))
#define LAS __attribute__((address_space(3)))
namespace pg8 {
#define PG8_LAS __attribute__((address_space(3)))
typedef unsigned short bf16_t;
typedef short bf16x8 __attribute__((ext_vector_type(8)));
typedef float f32x4 __attribute__((ext_vector_type(4)));
typedef unsigned u32x4 __attribute__((ext_vector_type(4)));
constexpr int BM = 256, BK = 64, HALF = 128, HTB = HALF * BK * 2  , STAGE_BYTES = 8 * HTB, NXCD = 8, WGM = 8;

__host__ __device__ __forceinline__ int lds_byte(int r, int c) { const int st = (r >> 4) * 2 + (c >> 5), rr = r & 15, cc = c & 31, ob = rr * 64 + cc * 2; return st * 1024 + (ob ^ (((ob >> 9) & 1) << 5)); }
__host__ __device__ __forceinline__ void stage_rc(int b, int& R, int& C) { const int st = b / 1024, sb = b % 1024, swz = sb ^ (((sb >> 9) & 1) << 5); R = (st >> 1) * 16 + swz / 64; C = (st & 1) * 32 + (swz % 64) / 2; }
__host__ __device__ __forceinline__ int perm32(int rho) { const int n = rho >> 4, i = rho & 15; return 8 * (i >> 2) + 4 * n + (i & 3); }

struct Unit { int pm, pn; };
struct Gemm { const bf16_t* A; const bf16_t* Bt; int M, N, K; };

struct StaticOrder {
    int nM, nN, nwg, G, c;
    __host__ __device__ void init(int M, int N, int G_, int c_) { nM = M / BM; nN = N / BM; nwg = nM * nN; G = G_; c = c_; }
    __host__ __device__ bool next(int i, Unit& u) const {
        const long L = (long)i * G + c; if (L >= nwg) return false;
        int wgid = (int)L; { const int q = nwg / NXCD, r = nwg % NXCD, xcd = wgid % NXCD, off = wgid / NXCD; wgid = (xcd < r ? xcd * (q + 1) : r * (q + 1) + (xcd - r) * q) + off; }
        const int nig = WGM * nN, gid = wgid / nig, fm = gid * WGM, gsz = (nM - fm) < WGM ? (nM - fm) : WGM;
        u.pm = fm + ((wgid % nig) % gsz); u.pn = (wgid % nig) / gsz; return true;
    }
    __device__ __forceinline__ void a_ready(const Unit&) const {}
    __device__ __forceinline__ void done(const Unit&) const {}
};

__device__ __forceinline__ unsigned cvt_pk_bf16(float lo, float hi) { unsigned r; asm volatile("v_cvt_pk_bf16_f32 %0, %1, %2" : "=v"(r) : "v"(lo), "v"(hi)); return r; }

template <class Epi, class Sched, bool ALIGN_EPI = false, bool SP2 = false>
__device__ __forceinline__ void gemm_phase(PG8_LAS unsigned char* lds, const Gemm g, const Sched& S, const Epi& E) {
    const int tid = threadIdx.x, wid = __builtin_amdgcn_readfirstlane(tid >> 6), lane = tid & 63, wr = wid >> 2, wc = wid & 3, fr = lane & 15, fq = lane >> 4;
    const int K = g.K, nt = K / BK;
    unsigned voffA[2], voffB[2];
#pragma unroll
    for (int i = 0; i < 2; ++i) { int R, C; stage_rc(tid * 16 + i * 8192, R, C); const int Rb = Epi::PERM ? ((R & ~31) + perm32(R & 31)) : R;
        voffA[i] = (unsigned)(R * K + C) * 2u; voffB[i] = (unsigned)(Rb * K + C) * 2u; }
    const size_t kstep = (size_t)(BK * 2);
    const size_t hstep = (size_t)HALF * K * 2;
    const size_t tstep = 2 * hstep;
    const unsigned ldsw = (unsigned)wid * 1024u;
    const int aoff = lds_byte(wr * 64 + fr, fq * 8), boff = lds_byte(wc * 32 + fr, fq * 8);
#define PG8_SA(b, h) (((b) * 2 + (h)) * HTB)
#define PG8_SB(b, h) ((4 + (b) * 2 + (h)) * HTB)
#define PG8_STAGE(bufoff, gbase, voff) do { _Pragma("unroll") for (int _i = 0; _i < 2; ++_i) \
        __builtin_amdgcn_global_load_lds((const unsigned*)((const char*)(gbase) + (voff)[_i]), (PG8_LAS unsigned*)(lds + (bufoff) + ldsw + _i * 8192), 16, 0, 0); } while (0)
#define PG8_LDA(dst, b, h) do { _Pragma("unroll") for (int m = 0; m < 4; ++m) _Pragma("unroll") for (int k = 0; k < 2; ++k) dst[m][k] = *(const PG8_LAS bf16x8*)(lds + PG8_SA(b, h) + aoff + m * 2048 + k * 1024); } while (0)
#define PG8_LDB(dst, b, h) do { _Pragma("unroll") for (int n = 0; n < 2; ++n) _Pragma("unroll") for (int k = 0; k < 2; ++k) dst[n][k] = *(const PG8_LAS bf16x8*)(lds + PG8_SB(b, h) + boff + n * 2048 + k * 1024); } while (0)
#define PG8_MMA(ai, bj, At, Bt) do { __builtin_amdgcn_s_setprio(1); _Pragma("unroll") for (int m = 0; m < 4; ++m) _Pragma("unroll") for (int n = 0; n < 2; ++n) _Pragma("unroll") for (int k = 0; k < 2; ++k) \
        acc[ai][bj][m][n] = __builtin_amdgcn_mfma_f32_16x16x32_bf16(Bt[n][k], At[m][k], acc[ai][bj][m][n], 0, 0, 0); __builtin_amdgcn_s_setprio(0); } while (0)
#define PG8_WAIT_V(n) asm volatile("s_waitcnt vmcnt(" #n ")" ::: "memory")
#define PG8_WAIT_L(n) asm volatile("s_waitcnt lgkmcnt(" #n ")" ::: "memory")
#define PG8_BAR __builtin_amdgcn_s_barrier()
#define PG8_SCHED __builtin_amdgcn_sched_barrier(0)
    Unit cur, nxt; int ui = 0;
    if (!S.next(0, cur)) return;
    f32x4 acc[2][2][4][2];
#pragma unroll
    for (int a = 0; a < 2; ++a)
#pragma unroll
        for (int b = 0; b < 2; ++b)
#pragma unroll
            for (int m = 0; m < 4; ++m)
#pragma unroll
                for (int n = 0; n < 2; ++n) acc[a][b][m][n] = (f32x4){0.f, 0.f, 0.f, 0.f};
    bf16x8 At[4][2], B0[2][2], B1[2][2];
    const char* cA = (const char*)g.A + (size_t)cur.pm * tstep; const char* cB = (const char*)g.Bt + (size_t)cur.pn * tstep;
    S.a_ready(cur);
    if constexpr (SP2) {
        PG8_STAGE(PG8_SB(0, 0), cB, voffB); PG8_STAGE(PG8_SB(0, 1), cB + hstep, voffB); PG8_STAGE(PG8_SA(0, 0), cA, voffA); PG8_STAGE(PG8_SA(0, 1), cA + hstep, voffA);
        if (wr == 1) PG8_BAR;
        PG8_WAIT_V(2); PG8_BAR;
        PG8_STAGE(PG8_SB(1, 0), cB + kstep, voffB); PG8_STAGE(PG8_SA(1, 0), cA + kstep, voffA); PG8_STAGE(PG8_SB(1, 1), cB + hstep + kstep, voffB);
        PG8_WAIT_V(6); PG8_BAR;
    } else {
        PG8_STAGE(PG8_SB(0, 0), cB, voffB); PG8_STAGE(PG8_SA(0, 0), cA, voffA); PG8_STAGE(PG8_SB(0, 1), cB + hstep, voffB); PG8_STAGE(PG8_SA(0, 1), cA + hstep, voffA);
        if (wr == 1) PG8_BAR;
        PG8_WAIT_V(4); PG8_BAR;
        PG8_STAGE(PG8_SB(1, 0), cB + kstep, voffB); PG8_STAGE(PG8_SA(1, 0), cA + kstep, voffA); PG8_STAGE(PG8_SB(1, 1), cB + hstep + kstep, voffB);
        PG8_WAIT_V(6); PG8_BAR;
    }
    for (;;) {
        const bool has_next = S.next(ui + 1, nxt);
        const char* nA = has_next ? (const char*)g.A + (size_t)nxt.pm * tstep : cA; const char* nB = has_next ? (const char*)g.Bt + (size_t)nxt.pn * tstep : cB;
        for (int t = 0; t < nt; t += 2) {
            const bool last = (t == nt - 2);
            const char* a1 = cA + (size_t)(t + 1) * kstep;
            const char* a2 = last ? nA : cA + (size_t)(t + 2) * kstep; const char* b2 = last ? nB : cB + (size_t)(t + 2) * kstep;
            const char* a3 = a2 + kstep; const char* b3 = b2 + kstep;
            if (last && has_next) S.a_ready(nxt);
            if constexpr (SP2) {
            PG8_LDB(B0, 0, 0); PG8_LDB(B1, 0, 1); PG8_SCHED; PG8_LDA(At, 0, 0); PG8_STAGE(PG8_SA(1, 1), a1 + hstep, voffA);
            PG8_WAIT_V(8); PG8_WAIT_L(0); PG8_BAR; PG8_MMA(0, 0, At, B0); PG8_MMA(0, 1, At, B1); PG8_BAR; PG8_SCHED;
            PG8_LDA(At, 0, 1); PG8_STAGE(PG8_SB(0, 0), b2, voffB); PG8_STAGE(PG8_SB(0, 1), b2 + hstep, voffB); PG8_STAGE(PG8_SA(0, 0), a2, voffA);
            PG8_WAIT_V(8); PG8_WAIT_L(0); PG8_BAR; PG8_MMA(1, 0, At, B0); PG8_MMA(1, 1, At, B1); PG8_BAR; PG8_SCHED;
            PG8_LDB(B0, 1, 0); PG8_LDB(B1, 1, 1); PG8_SCHED; PG8_LDA(At, 1, 0); PG8_STAGE(PG8_SA(0, 1), a2 + hstep, voffA);
            PG8_WAIT_V(8); PG8_WAIT_L(0); PG8_BAR; PG8_MMA(0, 0, At, B0); PG8_MMA(0, 1, At, B1); PG8_BAR; PG8_SCHED;
            PG8_LDA(At, 1, 1); PG8_STAGE(PG8_SB(1, 0), b3, voffB); PG8_STAGE(PG8_SB(1, 1), b3 + hstep, voffB); PG8_STAGE(PG8_SA(1, 0), a3, voffA);
            PG8_WAIT_V(8); PG8_WAIT_L(0); PG8_BAR; PG8_MMA(1, 0, At, B0); PG8_MMA(1, 1, At, B1); PG8_BAR; PG8_SCHED;
            } else {
            PG8_LDB(B0, 0, 0); PG8_SCHED; PG8_LDA(At, 0, 0); PG8_STAGE(PG8_SA(1, 1), a1 + hstep, voffA);
            PG8_WAIT_L(8); PG8_BAR; PG8_WAIT_L(0); PG8_MMA(0, 0, At, B0); PG8_BAR; PG8_SCHED;
            PG8_LDB(B1, 0, 1); PG8_STAGE(PG8_SB(0, 0), b2, voffB);
            PG8_BAR; PG8_WAIT_L(0); PG8_MMA(0, 1, At, B1); PG8_BAR;
            PG8_LDA(At, 0, 1); PG8_STAGE(PG8_SA(0, 0), a2, voffA);
            PG8_BAR; PG8_WAIT_L(0); PG8_MMA(1, 0, At, B0); PG8_BAR; PG8_SCHED;
            PG8_STAGE(PG8_SB(0, 1), b2 + hstep, voffB);
            PG8_WAIT_V(6); PG8_BAR; PG8_MMA(1, 1, At, B1); PG8_BAR;
            PG8_LDB(B0, 1, 0); PG8_SCHED; PG8_LDA(At, 1, 0); PG8_STAGE(PG8_SA(0, 1), a2 + hstep, voffA);
            PG8_WAIT_L(8); PG8_BAR; PG8_WAIT_L(0); PG8_MMA(0, 0, At, B0); PG8_BAR; PG8_SCHED;
            PG8_LDB(B1, 1, 1); PG8_STAGE(PG8_SB(1, 0), b3, voffB);
            PG8_BAR; PG8_WAIT_L(0); PG8_MMA(0, 1, At, B1); PG8_BAR;
            PG8_LDA(At, 1, 1); PG8_STAGE(PG8_SA(1, 0), a3, voffA);
            PG8_BAR; PG8_WAIT_L(0); PG8_MMA(1, 0, At, B0); PG8_BAR; PG8_SCHED;
            PG8_STAGE(PG8_SB(1, 1), b3 + hstep, voffB);
            PG8_WAIT_V(6); PG8_BAR; PG8_MMA(1, 1, At, B1); PG8_BAR;
            }
        }
        if constexpr (ALIGN_EPI) { if (wr == 0) PG8_BAR; }
        if constexpr (!Epi::AFTER_DRAIN) { E(acc, cur, wr, wc, fr, fq); S.done(cur); }
        if (!has_next) break;
#pragma unroll
        for (int a = 0; a < 2; ++a)
#pragma unroll
            for (int b = 0; b < 2; ++b)
#pragma unroll
                for (int m = 0; m < 4; ++m)
#pragma unroll
                    for (int n = 0; n < 2; ++n) acc[a][b][m][n] = (f32x4){0.f, 0.f, 0.f, 0.f};
        cur = nxt; cA = nA; cB = nB; ++ui;
        if constexpr (ALIGN_EPI) { if (wr == 1) PG8_BAR; }
    }
    PG8_WAIT_V(0);
    if constexpr (!ALIGN_EPI) { if (wr == 0) PG8_BAR; }
    PG8_BAR;
    if constexpr (Epi::AFTER_DRAIN) { E.fused(acc, cur, wr, wc, fr, fq, lds, wid, lane); S.done(cur); }
#undef PG8_SA
#undef PG8_SB
#undef PG8_STAGE
#undef PG8_LDA
#undef PG8_LDB
#undef PG8_MMA
#undef PG8_WAIT_V
#undef PG8_WAIT_L
#undef PG8_BAR
#undef PG8_SCHED
}
}
#define XB_TMO      128
#define XB_XCNT(j)  (256  + 64 * (j))
#define XB_XSUB(j)  (1280 + 64 * (j))
#define XB_XGEN(j)  (2304 + 64 * (j))
#define XB_TOP      3328
#define XB_TOPGEN   3392
#define XCD_BAR_WORDS 3456
#define XB_SPIN_CAP (1u << 18)

__device__ __forceinline__ unsigned xb_ld(unsigned* p)              { return __hip_atomic_load(p, __ATOMIC_RELAXED, __HIP_MEMORY_SCOPE_AGENT); }
__device__ __forceinline__ unsigned xb_add(unsigned* p, unsigned v) { return __hip_atomic_fetch_add(p, v, __ATOMIC_RELAXED, __HIP_MEMORY_SCOPE_AGENT); }
__device__ __forceinline__ unsigned xb_xcc_id() { return (unsigned)__builtin_amdgcn_s_getreg((3 << 11) | 20) & 0xFu; }
#define XB_SPIN(cond, bar) do { unsigned _sp = 0; while (cond) { __builtin_amdgcn_s_sleep(1); \
    if ((++_sp & 255u) == 0u) { if (xb_ld(&(bar)[XB_TMO])) break; if (_sp > XB_SPIN_CAP) { atomicAdd(&(bar)[XB_TMO], 1u); break; } } } } while (0)

struct XcdBarrier {
    unsigned* bar; unsigned x;
    volatile LAS unsigned* st;
};

__device__ __forceinline__ XcdBarrier xcd_barrier_post(unsigned* bar, volatile LAS unsigned* st) {
    XcdBarrier b; b.bar = bar; b.x = xb_xcc_id(); b.st = st;
    if (threadIdx.x == 0) (void)xb_add(&bar[XB_XCNT(b.x)], 1u);
    return b;
}
__device__ __forceinline__ void xcd_barrier_complete(unsigned* bar, unsigned x, unsigned& nloc, unsigned& nx) {
    const unsigned G = gridDim.x * gridDim.y * gridDim.z;
    unsigned sum, cnt, mine, sp = 0u;
    for (;;) {
        sum = 0u; cnt = 0u; mine = 0u;
#pragma unroll
        for (unsigned j = 0; j < 16; ++j) { const unsigned c = xb_ld(&bar[XB_XCNT(j)]); sum += c; cnt += (c > 0u) ? 1u : 0u; mine = (j == x) ? c : mine; }
        if (sum == G) break;
        __builtin_amdgcn_s_sleep(1);
        if ((++sp & 255u) == 0u) { if (xb_ld(&bar[XB_TMO])) break; if (sp > XB_SPIN_CAP) { atomicAdd(&bar[XB_TMO], 1u); break; } }
    }
    nloc = mine > 0u ? mine : 1u; nx = cnt > 0u ? cnt : 1u;
}

__device__ __forceinline__ void xcd_barrier(const XcdBarrier& b) {
    asm volatile("s_waitcnt vmcnt(0)" ::: "memory");
    __syncthreads();
    if (threadIdx.x == 0) {
        unsigned* bar = b.bar;
        __builtin_amdgcn_s_waitcnt(0);
        unsigned nloc = b.st[0], nx = b.st[1];
        if (nloc == 0u) { xcd_barrier_complete(bar, b.x, nloc, nx); b.st[0] = nloc; b.st[1] = nx; }
        const unsigned old = xb_add(&bar[XB_XSUB(b.x)], 1u);
        const unsigned gen = old / nloc;
        if (old + 1u == (gen + 1u) * nloc) {
            __builtin_amdgcn_fence(__ATOMIC_RELEASE, "agent");
            asm volatile("s_waitcnt vmcnt(0)" ::: "memory");
            const unsigned og = xb_add(&bar[XB_TOP], 1u);
            const unsigned tg = og / nx;
            if (og + 1u == (tg + 1u) * nx) xb_add(&bar[XB_TOPGEN], 1u);
            else XB_SPIN(xb_ld(&bar[XB_TOPGEN]) == tg, bar);
            __builtin_amdgcn_fence(__ATOMIC_ACQUIRE, "agent");
            xb_add(&bar[XB_XGEN(b.x)], 1u);
            asm volatile("s_waitcnt vmcnt(0)" ::: "memory");
        } else {
            XB_SPIN(xb_ld(&bar[XB_XGEN(b.x)]) == gen, bar);
            __builtin_amdgcn_fence(__ATOMIC_ACQUIRE, "agent");
            asm volatile("s_waitcnt vmcnt(0)" ::: "memory");
        }
    }
    __syncthreads();
}
namespace mk {
using pg8::bf16_t; using pg8::bf16x8; using pg8::f32x4; using pg8::u32x4;
typedef unsigned u32x2 __attribute__((ext_vector_type(2)));

#ifndef MK_CHECK_ATT
#define MK_CHECK_ATT 0
#endif
#define MK_REP_SSDP 1
#define MK_REP_CONV 1
#define MK_REP_SCP 1
#define MK_REP_SCS 1
#define MK_REP_SSDS 1
#define MK_REP_ATTS 1
#define MK_REP_ATTP 1
#define MK_CHECK_TOL 0.02f
#define MK_CHECK_CODE ((b0 ? 1.f : 0.f) + (b1 ? 2.f : 0.f) + (b2 ? 4.f : 0.f) + (b3 ? 8.f : 0.f) + (b4 ? 16.f : 0.f) + (b5 ? 32.f : 0.f))
#define MK_REP_MASK 0
#define DUPK(k) (((MK_REP_MASK >> (k)) & 1) != 0)
#define REPK(k) for (int rep_ = 0; rep_ < 1 + ((MK_REP_MASK >> (k)) & 1); ++rep_)
#ifndef MK_SPLIT
#define MK_SPLIT 0
#endif

constexpr int NWAVES = 8, NTHR = 512;
constexpr int MP = 16384, MS = 512, M = MP + MS, D = 1024, DFF = 2816, DI = 2048, NP = 9472, XCW = 3072;
constexpr int PZ = 0, PXBC = 2048, PSM = 5120, PQ = 5376, PK = 6400, PV = 6656, PQI = 6912, PG = 7424;
constexpr int SCW = 2048, SCSW = 2112;
constexpr size_t O_Y = 0, O_KP = 17301504, O_VP = 21495808, O_KIP = 25690112, O_CVP = 26738688, O_SSP = 26812416,
                 O_KS = 28909568, O_VS = 29040640, O_KIS = 29171712, O_CVS = 29204480, O_SSS = 30384128, O_END = 63938560;
constexpr size_t MiB = 1u << 20;
constexpr size_t WS_CTL = 0, CTL_ZERO_BYTES = 1 * MiB;
constexpr size_t WS_W1A = 1 * MiB, WS_W1B = WS_W1A + 11 * MiB, WS_WIN = WS_W1B + 6 * MiB, WS_WBS = WS_WIN + 19 * MiB, WS_WBA = WS_WBS + 4 * MiB,
                 WS_WOUT = WS_WBA + 2 * MiB, WS_W2A = WS_WOUT + 2 * MiB, WS_W2B = WS_W2A + 11 * MiB;
constexpr size_t WS_XB = WS_W2B + 6 * MiB, WS_ACT = WS_XB + 33 * MiB, WS_T = WS_ACT + 91 * MiB, WS_HF = WS_T + 66 * MiB, WS_HB = WS_HF + 66 * MiB,
                 WS_P = WS_HB + 33 * MiB, WS_SMF = WS_P + 306 * MiB, WS_XC = WS_SMF + 9 * MiB, WS_Y = WS_XC + 99 * MiB, WS_SC = WS_Y + 66 * MiB,
                 WS_SCS = WS_SC + 128 * MiB, WS_YA = WS_SCS + 5 * MiB, WS_MG = WS_YA + 33 * MiB, WS_END = WS_MG + 33 * MiB;
constexpr int CW_BAR = 4096;
constexpr int LDS_BYTES = 163840, MISC_OFF = LDS_BYTES - 256;
constexpr int WAREA = 17920;
constexpr int BIASREL_OFF = NWAVES * WAREA;
static_assert(BIASREL_OFF + 2 * 129 * 16 * 4 <= MISC_OFF, "LDS map");

constexpr float ALPHA = 1.18920711500272f;
constexpr float LN_EPS = 1e-5f;

struct Args { const float* in[29]; float* out; unsigned char* ws; int ph_lo, ph_hi; };
enum { I_XP = 0, I_XS, I_CK, I_CV, I_CKI, I_SCONV, I_SSSM, I_PT, I_BIAS, I_WIN, I_CONVW, I_CONVB, I_DTB, I_ALOG, I_DSKIP, I_NORMG, I_WBS, I_WBA, I_WOUT,
       I_F1WI, I_F1WO, I_F2WI, I_F2WO, I_LN1G, I_LN1B, I_LN2G, I_LN2B, I_LN3G, I_LN3B };

__device__ __forceinline__ float bf2f(unsigned v) { return __uint_as_float(v << 16); }
__device__ __forceinline__ unsigned f2bf(float f) { unsigned u = __float_as_uint(f); return (u + 0x7fffu + ((u >> 16) & 1u)) >> 16; }
__device__ __forceinline__ unsigned pk2(float lo, float hi) { return pg8::cvt_pk_bf16(lo, hi); }
__device__ __forceinline__ void unpack8(const u32x4 w, float (&f)[8]) {
#pragma unroll
    for (int i = 0; i < 4; ++i) { f[2 * i] = __uint_as_float(w[i] << 16); f[2 * i + 1] = __uint_as_float(w[i] & 0xffff0000u); }
}
__device__ __forceinline__ u32x4 pack8(const float (&f)[8]) { u32x4 w; w.x = pk2(f[0], f[1]); w.y = pk2(f[2], f[3]); w.z = pk2(f[4], f[5]); w.w = pk2(f[6], f[7]); return w; }
__device__ __forceinline__ float sigmoidf_(float x) { return 1.0f / (1.0f + __expf(-x)); }
__device__ __forceinline__ float siluf_(float x) { return x / (1.0f + __expf(-x)); }
__device__ __forceinline__ float wave_sum(float v) {
#pragma unroll
    for (int o = 1; o < 64; o <<= 1) v += __shfl_xor(v, o);
    return v;
}
__device__ __forceinline__ float wave_max(float v) {
#pragma unroll
    for (int o = 1; o < 64; o <<= 1) v = fmaxf(v, __shfl_xor(v, o));
    return v;
}
__device__ __forceinline__ f32x4 mfma16(bf16x8 a, bf16x8 b, f32x4 c) { return __builtin_amdgcn_mfma_f32_16x16x32_bf16(a, b, c, 0, 0, 0); }
__device__ __forceinline__ int mbcnt64(unsigned long long m) { return (int)__builtin_amdgcn_mbcnt_hi((unsigned)(m >> 32), __builtin_amdgcn_mbcnt_lo((unsigned)m, 0u)); }

struct EpiSwiglu {
    static constexpr bool PERM = true, AFTER_DRAIN = false;
    bf16_t* O;
    __device__ __forceinline__ void operator()(const f32x4 (&acc)[2][2][4][2], const pg8::Unit& u, int wr, int wc, int fr, int fq) const {
        const int row0 = u.pm * 256 + wr * 64 + fr, col0 = u.pn * 128 + wc * 32 + 8 * fq;
#pragma unroll
        for (int ai = 0; ai < 2; ++ai)
#pragma unroll
            for (int m = 0; m < 4; ++m) {
                float o[8];
#pragma unroll
                for (int n = 0; n < 2; ++n)
#pragma unroll
                    for (int j = 0; j < 4; ++j) { const float g = acc[ai][0][m][n][j], up = acc[ai][1][m][n][j]; o[4 * n + j] = siluf_(g) * up; }
                *(u32x4*)(O + (size_t)(row0 + ai * 128 + m * 16) * DFF + col0) = pack8(o);
            }
    }
};
struct EpiResid {
    static constexpr bool PERM = false, AFTER_DRAIN = false;
    const float* base_p; const float* base_s; float* T; float alpha, s;
    __device__ __forceinline__ void operator()(const f32x4 (&acc)[2][2][4][2], const pg8::Unit& u, int wr, int wc, int fr, int fq) const {
        const int row0 = u.pm * 256 + wr * 64 + fr, col0 = u.pn * 256 + wc * 32 + 4 * fq;
#pragma unroll
        for (int ai = 0; ai < 2; ++ai)
#pragma unroll
            for (int m = 0; m < 4; ++m) {
                const int r = row0 + ai * 128 + m * 16;
                const float* b = (r < MP) ? base_p + (size_t)r * D : base_s + (size_t)(r - MP) * D;
#pragma unroll
                for (int bj = 0; bj < 2; ++bj)
#pragma unroll
                    for (int n = 0; n < 2; ++n) { const int c = col0 + bj * 128 + n * 16; const f32x4 bv = *(const f32x4*)(b + c);
                        *(f32x4*)(T + (size_t)r * D + c) = bv * alpha + acc[ai][bj][m][n] * s; }
            }
    }
};
struct EpiWin {
    static constexpr bool PERM = true, AFTER_DRAIN = false;
    bf16_t* P; float* smf; float* out;
    __device__ __forceinline__ void operator()(const f32x4 (&acc)[2][2][4][2], const pg8::Unit& u, int wr, int wc, int fr, int fq) const {
        const int row0 = u.pm * 256 + wr * 64 + fr, cl = wc * 32 + 8 * fq, col0 = u.pn * 256 + cl;
#pragma unroll
        for (int ai = 0; ai < 2; ++ai)
#pragma unroll
            for (int m = 0; m < 4; ++m) {
                const int r = row0 + ai * 128 + m * 16;
#pragma unroll
                for (int bj = 0; bj < 2; ++bj) {
                    const f32x4 v0 = acc[ai][bj][m][0], v1 = acc[ai][bj][m][1];
                    u32x4 w; w.x = pk2(v0[0], v0[1]); w.y = pk2(v0[2], v0[3]); w.z = pk2(v1[0], v1[1]); w.w = pk2(v1[2], v1[3]);
                    *(u32x4*)(P + (size_t)r * NP + col0 + bj * 128) = w;
                    if (u.pn == 20) {
                        if (bj == 0) {
                            float* d = smf + (size_t)r * 128 + cl; *(f32x4*)d = v0; *(f32x4*)(d + 4) = v1;
                            if (cl >= 64) { float* k = out + ((r < MP) ? O_KIP + (size_t)r * 64 : O_KIS + (size_t)(r - MP) * 64) + (cl - 64); *(f32x4*)k = v0; *(f32x4*)(k + 4) = v1; }
                        }
                    } else if (u.pn == 25) {
                        float* k = out + ((r < MP) ? O_KP + (size_t)r * 256 : O_KS + (size_t)(r - MP) * 256) + bj * 128 + cl; *(f32x4*)k = v0; *(f32x4*)(k + 4) = v1;
                    } else if (u.pn == 26) {
                        float* k = out + ((r < MP) ? O_VP + (size_t)r * 256 : O_VS + (size_t)(r - MP) * 256) + bj * 128 + cl; *(f32x4*)k = v0; *(f32x4*)(k + 4) = v1;
                    }
                }
            }
    }
};
struct EpiGateA {
    static constexpr bool PERM = false, AFTER_DRAIN = false;
    const bf16_t* P; int gcol; float* M1;
    __device__ __forceinline__ void operator()(const f32x4 (&acc)[2][2][4][2], const pg8::Unit& u, int wr, int wc, int fr, int fq) const {
        const int row0 = u.pm * 256 + wr * 64 + fr, col0 = u.pn * 256 + wc * 32 + 4 * fq;
#pragma unroll
        for (int ai = 0; ai < 2; ++ai)
#pragma unroll
            for (int m = 0; m < 4; ++m) {
                const int r = row0 + ai * 128 + m * 16;
#pragma unroll
                for (int bj = 0; bj < 2; ++bj)
#pragma unroll
                    for (int n = 0; n < 2; ++n) { const int c = col0 + bj * 128 + n * 16; const u32x2 gw = *(const u32x2*)(P + (size_t)r * NP + gcol + c);
                        f32x4 g; g[0] = sigmoidf_(__uint_as_float(gw.x << 16)); g[1] = sigmoidf_(__uint_as_float(gw.x & 0xffff0000u)); g[2] = sigmoidf_(__uint_as_float(gw.y << 16)); g[3] = sigmoidf_(__uint_as_float(gw.y & 0xffff0000u));
                        *(f32x4*)(M1 + (size_t)r * D + c) = g * acc[ai][bj][m][n]; }
            }
    }
};
struct EpiGateS {
    static constexpr bool PERM = true, AFTER_DRAIN = false;
    const bf16_t* P; int gcol; const float* M1; bf16_t* MG;
    __device__ __forceinline__ void operator()(const f32x4 (&acc)[2][2][4][2], const pg8::Unit& u, int wr, int wc, int fr, int fq) const {
        const int row0 = u.pm * 256 + wr * 64 + fr, col0 = u.pn * 256 + wc * 32 + 8 * fq;
#pragma unroll
        for (int ai = 0; ai < 2; ++ai)
#pragma unroll
            for (int m = 0; m < 4; ++m) {
                const int r = row0 + ai * 128 + m * 16;
#pragma unroll
                for (int bj = 0; bj < 2; ++bj) { const int c = col0 + bj * 128;
                    const u32x4 gw = *(const u32x4*)(P + (size_t)r * NP + gcol + c); float g[8]; unpack8(gw, g);
                    const f32x4 m0 = *(const f32x4*)(M1 + (size_t)r * D + c), m1 = *(const f32x4*)(M1 + (size_t)r * D + c + 4);
                    float o[8];
#pragma unroll
                    for (int j = 0; j < 4; ++j) { o[j] = m0[j] + sigmoidf_(g[j]) * acc[ai][bj][m][0][j]; o[4 + j] = m1[j] + sigmoidf_(g[4 + j]) * acc[ai][bj][m][1][j]; }
                    *(u32x4*)(MG + (size_t)r * D + c) = pack8(o); }
            }
    }
};

struct SkResid { const float* base; float* T; float alpha, s;
    __device__ __forceinline__ void operator()(int r, int c, f32x4 v) const { const f32x4 bv = *(const f32x4*)(base + (size_t)(r - MP) * D + c); *(f32x4*)(T + (size_t)r * D + c) = bv * alpha + v * s; } };
struct SkGateA { const bf16_t* P; int gcol; float* M1;
    __device__ __forceinline__ void operator()(int r, int c, f32x4 v) const { const u32x2 gw = *(const u32x2*)(P + (size_t)r * NP + gcol + c);
        f32x4 g; g[0] = sigmoidf_(__uint_as_float(gw.x << 16)); g[1] = sigmoidf_(__uint_as_float(gw.x & 0xffff0000u)); g[2] = sigmoidf_(__uint_as_float(gw.y << 16)); g[3] = sigmoidf_(__uint_as_float(gw.y & 0xffff0000u));
        *(f32x4*)(M1 + (size_t)r * D + c) = g * v; } };
struct SkGateS { const bf16_t* P; int gcol; const float* M1; bf16_t* MG;
    __device__ __forceinline__ void operator()(int r, int c, f32x4 v) const { const u32x2 gw = *(const u32x2*)(P + (size_t)r * NP + gcol + c); const f32x4 m = *(const f32x4*)(M1 + (size_t)r * D + c);
        const float o0 = m[0] + sigmoidf_(__uint_as_float(gw.x << 16)) * v[0], o1 = m[1] + sigmoidf_(__uint_as_float(gw.x & 0xffff0000u)) * v[1], o2 = m[2] + sigmoidf_(__uint_as_float(gw.y << 16)) * v[2], o3 = m[3] + sigmoidf_(__uint_as_float(gw.y & 0xffff0000u)) * v[3];
        u32x2 w; w.x = pk2(o0, o1); w.y = pk2(o2, o3); *(u32x2*)(MG + (size_t)r * D + c) = w; } };
template <int K, class Epi>
__device__ __forceinline__ void skinny_gemm(LAS unsigned char* lds, const bf16_t* A  , const bf16_t* Bt, const Epi& E, int bx, int G, int wave, int lane) {
    constexpr int KW = K / 8, NS = KW / 32;
    const int fr = lane & 15, fq = lane >> 4, tid = wave * 64 + lane;
    LAS float* part = (LAS float*)lds;
    for (int tile = bx; tile < 256; tile += G) {
        const int tm = tile >> 4, tn = tile & 15;
        const bf16_t* ap = A + (size_t)(tm * 32 + fr) * K + wave * KW + 8 * fq;
        const bf16_t* bp = Bt + (size_t)(tn * 64 + fr) * K + wave * KW + 8 * fq;
        f32x4 acc[2][4];
#pragma unroll
        for (int m = 0; m < 2; ++m)
#pragma unroll
            for (int n = 0; n < 4; ++n) acc[m][n] = (f32x4){0.f, 0.f, 0.f, 0.f};
#pragma unroll 4
        for (int ks = 0; ks < NS; ++ks) {
            bf16x8 a[2], bb[4];
#pragma unroll
            for (int m = 0; m < 2; ++m) a[m] = *(const bf16x8*)(ap + (size_t)m * 16 * K + ks * 32);
#pragma unroll
            for (int n = 0; n < 4; ++n) bb[n] = *(const bf16x8*)(bp + (size_t)n * 16 * K + ks * 32);
#pragma unroll
            for (int m = 0; m < 2; ++m)
#pragma unroll
                for (int n = 0; n < 4; ++n) acc[m][n] = mfma16(a[m], bb[n], acc[m][n]);
        }
#pragma unroll
        for (int m = 0; m < 2; ++m)
#pragma unroll
            for (int n = 0; n < 4; ++n)
#pragma unroll
                for (int j = 0; j < 4; ++j) part[(wave * 32 + m * 16 + 4 * fq + j) * 64 + n * 16 + fr] = acc[m][n][j];
        __syncthreads();
        { const int row = tid >> 4, c4 = (tid & 15) * 4; f32x4 v = {0.f, 0.f, 0.f, 0.f};
#pragma unroll
          for (int w = 0; w < 8; ++w) v += *(const LAS f32x4*)(part + (w * 32 + row) * 64 + c4);
          E(MP + tm * 32 + row, tn * 64 + c4, v); }
        __syncthreads();
    }
}

__device__ __forceinline__ void tr_item(const float* W, int K, int Nsrc, bf16_t* WT, int k0, int drow0, int scol0, int nvalid, LAS float* scr, int lane) {
    const int c = lane & 31;
#pragma unroll 8
    for (int i = 0; i < 32; ++i) { const int kk = 2 * i + (lane >> 5); float v = 0.f; if (c < nvalid) v = W[(size_t)(k0 + kk) * Nsrc + scol0 + c]; scr[kk * 33 + c] = v; }
    asm volatile("s_waitcnt lgkmcnt(0)" ::: "memory");
    const int cc = lane & 7;
#pragma unroll
    for (int j = 0; j < 4; ++j) { const int n = (lane >> 3) + 8 * j; const LAS float* s = scr + (8 * cc) * 33 + n;
        u32x4 o; o.x = pk2(s[0 * 33], s[1 * 33]); o.y = pk2(s[2 * 33], s[3 * 33]); o.z = pk2(s[4 * 33], s[5 * 33]); o.w = pk2(s[6 * 33], s[7 * 33]);
        *(u32x4*)(WT + (size_t)(drow0 + n) * K + k0 + 8 * cc) = o; }
    asm volatile("s_waitcnt lgkmcnt(0)" ::: "memory");
}
__device__ __forceinline__ void tr_map(int mode, int n0, int& scol0, int& nvalid) {
    nvalid = 32;
    if (mode == 0) { scol0 = n0; }
    else if (mode == 1) { const int j = n0 >> 8, i = n0 & 255; scol0 = (i < 128) ? j * 128 + i : DFF + j * 128 + (i - 128); }
    else {
        if (n0 < 5120) scol0 = n0;
        else if (n0 < 5376) { const int j = n0 - 5120;
            if (j == 0) scol0 = 5120;
            else if (j == 32) { scol0 = 7264; nvalid = 8; }
            else if (j == 64 || j == 96) scol0 = 7200 + (j - 64);
            else { scol0 = 0; nvalid = 0; } }
        else if (n0 < 6400) scol0 = 5152 + (n0 - 5376);
        else if (n0 < 6656) scol0 = 6176 + (n0 - 6400);
        else if (n0 < 6912) scol0 = 6432 + (n0 - 6656);
        else if (n0 < 7424) scol0 = 6688 + (n0 - 6912);
        else scol0 = 7272 + (n0 - 7424);
    }
}
__device__ __forceinline__ void p0_prologue(const Args& A, LAS unsigned char* lds, int gw, int NGW, int wave, int lane) {
    LAS float* scr = (LAS float*)(lds + wave * 16384);
    unsigned char* ws = A.ws;
    constexpr int NI0 = 16 * 176, NI1 = 44 * 32, NI2 = 16 * 296, NI3 = 32 * 32, NI4 = 16 * 32, NI5 = 16 * 32, NI6 = NI0, NI7 = NI1;
    constexpr int NIT = NI0 + NI1 + NI2 + NI3 + NI4 + NI5 + NI6 + NI7;
    for (int it = gw; it < NIT; it += NGW) {
        int r = it; const float* W; bf16_t* WT; int K, Nsrc, nblk, mode;
        if (r < NI0) { W = A.in[I_F1WI]; WT = (bf16_t*)(ws + WS_W1A); K = 1024; Nsrc = 2 * DFF; nblk = 176; mode = 1; }
        else if ((r -= NI0) < NI1) { W = A.in[I_F1WO]; WT = (bf16_t*)(ws + WS_W1B); K = DFF; Nsrc = 1024; nblk = 32; mode = 0; }
        else if ((r -= NI1) < NI2) { W = A.in[I_WIN]; WT = (bf16_t*)(ws + WS_WIN); K = 1024; Nsrc = 9320; nblk = 296; mode = 2; }
        else if ((r -= NI2) < NI3) { W = A.in[I_WBS]; WT = (bf16_t*)(ws + WS_WBS); K = 2048; Nsrc = 1024; nblk = 32; mode = 0; }
        else if ((r -= NI3) < NI4) { W = A.in[I_WBA]; WT = (bf16_t*)(ws + WS_WBA); K = 1024; Nsrc = 1024; nblk = 32; mode = 0; }
        else if ((r -= NI4) < NI5) { W = A.in[I_WOUT]; WT = (bf16_t*)(ws + WS_WOUT); K = 1024; Nsrc = 1024; nblk = 32; mode = 0; }
        else if ((r -= NI5) < NI6) { W = A.in[I_F2WI]; WT = (bf16_t*)(ws + WS_W2A); K = 1024; Nsrc = 2 * DFF; nblk = 176; mode = 1; }
        else { r -= NI6; W = A.in[I_F2WO]; WT = (bf16_t*)(ws + WS_W2B); K = DFF; Nsrc = 1024; nblk = 32; mode = 0; }
        const int kb = r / nblk, nb = r % nblk; int scol0, nvalid; tr_map(mode, nb * 32, scol0, nvalid);
        tr_item(W, K, Nsrc, WT, kb * 64, nb * 32, scol0, nvalid, scr, lane);
    }
    bf16_t* XB = (bf16_t*)(ws + WS_XB);
    const int nchunk = M * D / 8;
    for (int ch = gw * 64 + lane; ch < nchunk; ch += NGW * 64) {
        const int m = ch >> 7, c = (ch & 127) * 8;
        const float* src = (m < MP) ? A.in[I_XP] + (size_t)m * D + c : A.in[I_XS] + (size_t)(m - MP) * D + c;
        const f32x4 a = *(const f32x4*)src, b = *(const f32x4*)(src + 4);
        u32x4 w; w.x = pk2(a[0], a[1]); w.y = pk2(a[2], a[3]); w.z = pk2(b[0], b[1]); w.w = pk2(b[2], b[3]);
        *(u32x4*)(XB + (size_t)m * D + c) = w;
    }
}

__device__ __forceinline__ void ln_phase(const float* T, const float* g, const float* b, float* outf, bf16_t* outb, int gw, int NGW, int lane) {
    f32x4 gv[4], bv[4];
#pragma unroll
    for (int j = 0; j < 4; ++j) { gv[j] = *(const f32x4*)(g + 4 * lane + 256 * j); bv[j] = *(const f32x4*)(b + 4 * lane + 256 * j); }
    for (int m = gw; m < M; m += NGW) {
        const float* xr = T + (size_t)m * D + 4 * lane;
        f32x4 v[4]; float s = 0.f;
#pragma unroll
        for (int j = 0; j < 4; ++j) { v[j] = *(const f32x4*)(xr + 256 * j); s += (v[j][0] + v[j][1]) + (v[j][2] + v[j][3]); }
        const float mean = wave_sum(s) * (1.f / D); float s2 = 0.f;
#pragma unroll
        for (int j = 0; j < 4; ++j) { v[j] = v[j] - mean; s2 += (v[j][0] * v[j][0] + v[j][1] * v[j][1]) + (v[j][2] * v[j][2] + v[j][3] * v[j][3]); }
        const float rstd = 1.0f / sqrtf(wave_sum(s2) * (1.f / D) + LN_EPS);
#pragma unroll
        for (int j = 0; j < 4; ++j) {
            const f32x4 o = v[j] * rstd * gv[j] + bv[j];
            *(f32x4*)(outf + (size_t)m * D + 4 * lane + 256 * j) = o;
            if (outb) { u32x2 w; w.x = pk2(o[0], o[1]); w.y = pk2(o[2], o[3]); *(u32x2*)(outb + (size_t)m * D + 4 * lane + 256 * j) = w; }
        }
    }
}

template <int NT  , bool SAMP>
__device__ __forceinline__ void conv_item(const Args& A, int b, int t0, int cg, int lane) {
    const bf16_t* P = (const bf16_t*)(A.ws + WS_P); bf16_t* XC = (bf16_t*)(A.ws + WS_XC);
    const float* cw = A.in[I_CONVW]; const float* cb = A.in[I_CONVB];
    const int ch = (cg * 64 + lane) * 8;
    const size_t row0 = SAMP ? (size_t)(MP + b * 4) : (size_t)(b * 2048 + t0);
    u32x4 raw[NT + 3];
#pragma unroll
    for (int i = 0; i < NT + 3; ++i) {
        const int t = t0 - 3 + i;
        if (t >= 0) raw[i] = *(const u32x4*)(P + (row0 + (size_t)(i - 3)) * NP + PXBC + ch);
        else raw[i] = (u32x4){0u, 0u, 0u, 0u};
    }
    float w[4][8], bias[8];
#pragma unroll
    for (int j = 0; j < 4; ++j) { const f32x4 w0 = *(const f32x4*)(cw + (size_t)j * XCW + ch), w1 = *(const f32x4*)(cw + (size_t)j * XCW + ch + 4);
#pragma unroll
        for (int i = 0; i < 4; ++i) { w[j][i] = w0[i]; w[j][4 + i] = w1[i]; } }
    { const f32x4 b0 = *(const f32x4*)(cb + ch), b1 = *(const f32x4*)(cb + ch + 4);
#pragma unroll
      for (int i = 0; i < 4; ++i) { bias[i] = b0[i]; bias[4 + i] = b1[i]; } }
    float u0[8], u1[8], u2[8];
    if (SAMP) {
        const float* sc = A.in[I_SCONV] + (size_t)b * 3 * XCW + ch;
#pragma unroll
        for (int i = 0; i < 4; ++i) { const f32x4 a0 = *(const f32x4*)(sc), a1 = *(const f32x4*)(sc + 4), c0 = *(const f32x4*)(sc + XCW), c1 = *(const f32x4*)(sc + XCW + 4), e0 = *(const f32x4*)(sc + 2 * XCW), e1 = *(const f32x4*)(sc + 2 * XCW + 4);
            u0[i] = a0[i]; u0[4 + i] = a1[i]; u1[i] = c0[i]; u1[4 + i] = c1[i]; u2[i] = e0[i]; u2[4 + i] = e1[i]; }
    } else { unpack8(raw[0], u0); unpack8(raw[1], u1); unpack8(raw[2], u2); }
#pragma unroll
    for (int i = 0; i < NT; ++i) {
        float u3[8], o[8]; unpack8(raw[i + 3], u3);
#pragma unroll
        for (int e = 0; e < 8; ++e) o[e] = siluf_(bias[e] + w[0][e] * u0[e] + w[1][e] * u1[e] + w[2][e] * u2[e] + w[3][e] * u3[e]);
        *(u32x4*)(XC + (row0 + (size_t)i) * XCW + ch) = pack8(o);
        const int t = t0 + i; float* cs = nullptr;
        if (!SAMP) { if (t >= 2045) cs = A.out + O_CVP + ((size_t)b * 3 + (t - 2045)) * XCW + ch; }
        else { if (t >= 1) cs = A.out + O_CVS + ((size_t)b * 3 + (t - 1)) * XCW + ch; }
        if (cs) { *(f32x4*)cs = (f32x4){u3[0], u3[1], u3[2], u3[3]}; *(f32x4*)(cs + 4) = (f32x4){u3[4], u3[5], u3[6], u3[7]}; }
#pragma unroll
        for (int e = 0; e < 8; ++e) { u0[e] = u1[e]; u1[e] = u2[e]; u2[e] = u3[e]; }
    }
}
__device__ __forceinline__ void conv_phase(const Args& A, int gw, int NGW, int lane) {
    constexpr int NPI = 8 * 128 * 6, NSI = 128 * 6;
    for (int it = gw; it < NPI + NSI; it += NGW) {
        if (it < NPI) { const int cg = it % 6, r = it / 6; conv_item<16, false>(A, r >> 7, (r & 127) * 16, cg, lane); }
        else { const int r = it - NPI; conv_item<4, true>(A, r / 6, 0, r % 6, lane); }
    }
}

constexpr float IDX_SCALE = 0.125f * 0.35355339059327373f;
constexpr int SCL = 2052;
__device__ __forceinline__ unsigned f2key(float v) { unsigned u = (v == 0.f) ? 0u : __float_as_uint(v); return (u & 0x80000000u) ? ~u : (u | 0x80000000u); }
__device__ __forceinline__ void scores_select_prompt_unit(const Args& A, LAS unsigned char* lds, int b, int qt, int wave, int lane_in) {
    const bf16_t* P = (const bf16_t*)(A.ws + WS_P); const float* SMF = (const float*)(A.ws + WS_SMF);
    unsigned long long* MASKW = (unsigned long long*)(A.ws + WS_SC);
    LAS float* sc = (LAS float*)lds;
    int lane = lane_in; asm volatile("" : "+v"(lane));
    const int fr = lane & 15, fq = lane >> 4;
    {
        const size_t rowq = (size_t)(b * 2048 + qt * 16 + fr);
        bf16x8 Af[8][2];
#pragma unroll
        for (int h = 0; h < 8; ++h)
#pragma unroll
            for (int ks = 0; ks < 2; ++ks) Af[h][ks] = *(const bf16x8*)(P + rowq * NP + PQI + h * 64 + ks * 32 + 8 * fq);
        float wq[4][8];
#pragma unroll
        for (int j = 0; j < 4; ++j) { const float* wp = SMF + (size_t)(b * 2048 + qt * 16 + 4 * fq + j) * 128 + 32; const f32x4 w0 = *(const f32x4*)wp, w1 = *(const f32x4*)(wp + 4);
#pragma unroll
            for (int h = 0; h < 4; ++h) { wq[j][h] = w0[h] * IDX_SCALE; wq[j][4 + h] = w1[h] * IDX_SCALE; } }
        const bf16_t* kbase = P + (size_t)(b * 2048 + fr) * NP + PSM + 64 + 8 * fq;
        bf16x8 nB0 = {0, 0, 0, 0, 0, 0, 0, 0}, nB1 = nB0;
        if (wave <= qt) { const bf16_t* kp = kbase + (size_t)wave * 16 * NP; nB0 = *(const bf16x8*)kp; nB1 = *(const bf16x8*)(kp + 32); }
        for (int kt = wave; kt <= qt; kt += NWAVES) {
            const bf16x8 B0 = nB0, B1 = nB1;
            if (kt + NWAVES <= qt) { const bf16_t* kp = kbase + (size_t)(kt + NWAVES) * 16 * NP; nB0 = *(const bf16x8*)kp; nB1 = *(const bf16x8*)(kp + 32); }
            f32x4 scv = {0.f, 0.f, 0.f, 0.f};
#pragma unroll
            for (int h = 0; h < 8; ++h) { f32x4 d = {0.f, 0.f, 0.f, 0.f}; d = mfma16(Af[h][0], B0, d); d = mfma16(Af[h][1], B1, d);
#pragma unroll
                for (int j = 0; j < 4; ++j) scv[j] += wq[j][h] * fmaxf(d[j], 0.f); }
#pragma unroll
            for (int j = 0; j < 4; ++j) sc[(4 * fq + j) * SCL + kt * 16 + fr] = scv[j];
#if MK_CHECK_ATT
#pragma unroll
            for (int j = 0; j < 4; ++j) ((float*)(A.ws + WS_END))[(size_t)(b * 2048 + qt * 16 + 4 * fq + j) * SCW + kt * 16 + fr] = scv[j];
#endif
        }
    }
    __syncthreads();
#pragma unroll 1
    for (int u = 0; u < 2; ++u) {
        const int ql = 2 * wave + u, t = qt * 16 + ql, nvalid = t + 1;
        const LAS float* srow = sc + ql * SCL + lane;
        unsigned key[32];
#pragma unroll
        for (int j = 0; j < 32; ++j) key[j] = (lane < nvalid - 64 * j) ? f2key(srow[64 * j]) : 0u;
        unsigned T = 0u; int need_eq = 0;
        if (nvalid > 256) {
            bool exact = false;
            for (int bit = 31; bit >= 0; --bit) {
                const unsigned cand = T | (1u << bit); int cnt = 0;
#pragma unroll
                for (int j = 0; j < 32; ++j) cnt += __popcll(__ballot(key[j] >= cand));
                if (cnt >= 256) { T = cand; if (cnt == 256) { exact = true; break; } }
            }
            if (exact) { T -= 1u; }
            else { int cgt = 0;
#pragma unroll
                for (int j = 0; j < 32; ++j) cgt += __popcll(__ballot(key[j] > T));
                need_eq = 256 - cgt; }
        }
        int eqused = 0; unsigned long long mine = 0ull;
#pragma unroll
        for (int j = 0; j < 32; ++j) {
            unsigned long long ms;
            if (need_eq > 0) {
                const bool gt = key[j] > T, eq = key[j] == T;
                const unsigned long long meq = __ballot(eq);
                const bool sel = gt || (eq && (eqused + mbcnt64(meq) < need_eq));
                eqused += __popcll(meq);
                ms = __ballot(sel);
            } else ms = __ballot(key[j] > T);
            if (lane == j) mine = ms;
        }
        if (lane < 32) MASKW[(size_t)(b * 2048 + t) * 32 + lane] = mine;
    }
    __syncthreads();
}
__device__ __forceinline__ void scores_sample_unit(const Args& A, int b, int half, int wave, int lane) {
    const bf16_t* P = (const bf16_t*)(A.ws + WS_P); const float* SMF = (const float*)(A.ws + WS_SMF); float* SCS = (float*)(A.ws + WS_SCS);
    const int* pt = (const int*)A.in[I_PT]; const float* cki = A.in[I_CKI];
    const int fr = lane & 15, fq = lane >> 4;
    bf16x8 Af[2][2]; float wq[2][4];
#pragma unroll
    for (int mt = 0; mt < 2; ++mt) {
#pragma unroll
        for (int ks = 0; ks < 2; ++ks) Af[mt][ks] = *(const bf16x8*)(P + (size_t)(MP + b * 4 + 2 * mt + (fr >> 3)) * NP + PQI + (fr & 7) * 64 + ks * 32 + 8 * fq);
        const f32x4 w = *(const f32x4*)(SMF + (size_t)(MP + b * 4 + 2 * mt + (fq >> 1)) * 128 + 32 + 4 * (fq & 1));
#pragma unroll
        for (int j = 0; j < 4; ++j) wq[mt][j] = w[j] * IDX_SCALE;
    }
    const int kt_end = (half == 0) ? 65 : 129;
    for (int kt = half * 65 + wave; kt < kt_end; kt += NWAVES) {
        const int key = kt * 16 + fr;
        bf16x8 B0, B1;
        if (key < 2048) {
            const int page = pt[b * 16 + (key >> 7)];
            const float* src = cki + ((size_t)page * 128 + (key & 127)) * 64 + 8 * fq;
            const f32x4 a0 = *(const f32x4*)src, a1 = *(const f32x4*)(src + 4), c0 = *(const f32x4*)(src + 32), c1 = *(const f32x4*)(src + 36);
            u32x4 w0, w1; w0.x = pk2(a0[0], a0[1]); w0.y = pk2(a0[2], a0[3]); w0.z = pk2(a1[0], a1[1]); w0.w = pk2(a1[2], a1[3]);
            w1.x = pk2(c0[0], c0[1]); w1.y = pk2(c0[2], c0[3]); w1.z = pk2(c1[0], c1[1]); w1.w = pk2(c1[2], c1[3]);
            B0 = __builtin_bit_cast(bf16x8, w0); B1 = __builtin_bit_cast(bf16x8, w1);
        } else if (key < 2052) {
            const bf16_t* src = P + (size_t)(MP + b * 4 + (key - 2048)) * NP + PSM + 64 + 8 * fq;
            B0 = *(const bf16x8*)src; B1 = *(const bf16x8*)(src + 32);
        } else { B0 = (bf16x8){0, 0, 0, 0, 0, 0, 0, 0}; B1 = B0; }
#pragma unroll
        for (int mt = 0; mt < 2; ++mt) {
            f32x4 d = {0.f, 0.f, 0.f, 0.f}; d = mfma16(Af[mt][0], B0, d); d = mfma16(Af[mt][1], B1, d);
            float s = 0.f;
#pragma unroll
            for (int j = 0; j < 4; ++j) s += wq[mt][j] * fmaxf(d[j], 0.f);
            s += __shfl_xor(s, 16);
            if ((fq & 1) == 0 && key < 2052) SCS[(size_t)(b * 4 + 2 * mt + (fq >> 1)) * SCSW + key] = s;
        }
    }
}

__device__ __forceinline__ float softplusf_(float x) { return fmaxf(x, 0.f) + log1pf(expf(-fabsf(x))); }
__device__ __forceinline__ void ssd_prompt_item(const Args& A, LAS unsigned char* lds, int b, int h) {
    const int tid = threadIdx.x, lane = tid & 63, wave = __builtin_amdgcn_readfirstlane(tid >> 6), fr = lane & 15, fq = lane >> 4;
    const int g = h >> 3;
    const bf16_t* XC = (const bf16_t*)(A.ws + WS_XC); const float* SMF = (const float*)(A.ws + WS_SMF); bf16_t* Y = (bf16_t*)(A.ws + WS_Y);
    LAS bf16_t* Cm = (LAS bf16_t*)lds;
    LAS bf16_t* Bm = Cm + 64 * 136;
    LAS bf16_t* Btw = Bm + 64 * 136;
    LAS bf16_t* Xt = Btw + 128 * 72;
    LAS bf16_t* Mt = Xt + 64 * 72;
    LAS bf16_t* Hp = Mt + 64 * 72;
    LAS float* cum = (LAS float*)(Hp + 64 * 136);
    LAS float* dtv = cum + 64; LAS float* wv = dtv + 64; LAS float* ecum = wv + 64;
    const float Ah = -expf(A.in[I_ALOG][h]), dtb = A.in[I_DTB][h], dsk = A.in[I_DSKIP][h];
    f32x4 hst[4];
#pragma unroll
    for (int i = 0; i < 4; ++i) hst[i] = (f32x4){0.f, 0.f, 0.f, 0.f};
    for (int i = tid; i < 64 * 136 / 8; i += NTHR) *(LAS u32x4*)(Hp + i * 8) = (u32x4){0u, 0u, 0u, 0u};
    const int s0 = tid >> 4, part0 = tid & 15;
    const int xs = tid >> 3, xpart = tid & 7;
    for (int c = 0; c < 32; ++c) {
        const int row0 = b * 2048 + c * 64;
        u32x4 cr[2], br[2];
#pragma unroll
        for (int i = 0; i < 2; ++i) { const bf16_t* rp = XC + (size_t)(row0 + s0 + 32 * i) * XCW + g * 128 + part0 * 8; cr[i] = *(const u32x4*)(rp + 2560); br[i] = *(const u32x4*)(rp + 2048); }
        const u32x4 xr = *(const u32x4*)(XC + (size_t)(row0 + xs) * XCW + h * 64 + xpart * 8);
        if (wave == 0) {
            const float dt = softplusf_(SMF[(size_t)(row0 + lane) * 128 + h] + dtb);
            float v = dt * Ah;
#pragma unroll
            for (int o = 1; o < 64; o <<= 1) { const float n = __shfl_up(v, o); if (lane >= o) v += n; }
            const float ce = __shfl(v, 63);
            cum[lane] = v; dtv[lane] = dt; wv[lane] = dt * expf(ce - v); ecum[lane] = expf(v);
        }
        __syncthreads();
#pragma unroll
        for (int i = 0; i < 2; ++i) {
            const int s = s0 + 32 * i;
            *(LAS u32x4*)(Cm + s * 136 + part0 * 8) = cr[i];
            *(LAS u32x4*)(Bm + s * 136 + part0 * 8) = br[i];
            float bf[8]; unpack8(br[i], bf); const float w = wv[s];
#pragma unroll
            for (int e = 0; e < 8; ++e) Btw[(part0 * 8 + e) * 72 + s] = (bf16_t)f2bf(bf[e] * w);
        }
        {
#pragma unroll
            for (int e = 0; e < 4; ++e) { Xt[(xpart * 8 + 2 * e) * 72 + xs] = (bf16_t)(xr[e] & 0xffffu); Xt[(xpart * 8 + 2 * e + 1) * 72 + xs] = (bf16_t)(xr[e] >> 16); }
        }
        __syncthreads();
        {
            const int st = wave >> 1, tt0 = 2 * (wave & 1);
            bf16x8 a[4];
#pragma unroll
            for (int ks = 0; ks < 4; ++ks) a[ks] = *(const LAS bf16x8*)(Bm + (16 * st + fr) * 136 + ks * 32 + 8 * fq);
#pragma unroll
            for (int u = 0; u < 2; ++u) {
                const int tt = tt0 + u; f32x4 d = {0.f, 0.f, 0.f, 0.f};
#pragma unroll
                for (int ks = 0; ks < 4; ++ks) { const bf16x8 bb = *(const LAS bf16x8*)(Cm + (16 * tt + fr) * 136 + ks * 32 + 8 * fq); d = mfma16(a[ks], bb, d); }
                const int t = 16 * tt + fr; const float ct = cum[t]; float mv[4];
#pragma unroll
                for (int j = 0; j < 4; ++j) { const int s = 16 * st + 4 * fq + j; mv[j] = (s <= t) ? d[j] * expf(ct - cum[s]) * dtv[s] : 0.f; }
                u32x2 w; w.x = pk2(mv[0], mv[1]); w.y = pk2(mv[2], mv[3]);
                *(LAS u32x2*)(Mt + t * 72 + 16 * st + 4 * fq) = w;
            }
        }
        __syncthreads();
        {
            const int pt = wave >> 1, tt0 = 2 * (wave & 1);
            bf16x8 a1[2], a2[4];
#pragma unroll
            for (int ks = 0; ks < 2; ++ks) a1[ks] = *(const LAS bf16x8*)(Xt + (16 * pt + fr) * 72 + ks * 32 + 8 * fq);
#pragma unroll
            for (int ks = 0; ks < 4; ++ks) a2[ks] = *(const LAS bf16x8*)(Hp + (16 * pt + fr) * 136 + ks * 32 + 8 * fq);
#pragma unroll
            for (int u = 0; u < 2; ++u) {
                const int tt = tt0 + u; f32x4 d1 = {0.f, 0.f, 0.f, 0.f}, d2 = {0.f, 0.f, 0.f, 0.f};
#pragma unroll
                for (int ks = 0; ks < 2; ++ks) { const bf16x8 bb = *(const LAS bf16x8*)(Mt + (16 * tt + fr) * 72 + ks * 32 + 8 * fq); d1 = mfma16(a1[ks], bb, d1); }
#pragma unroll
                for (int ks = 0; ks < 4; ++ks) { const bf16x8 bb = *(const LAS bf16x8*)(Cm + (16 * tt + fr) * 136 + ks * 32 + 8 * fq); d2 = mfma16(a2[ks], bb, d2); }
                const int t = 16 * tt + fr; const float et = ecum[t]; float yv[4];
#pragma unroll
                for (int j = 0; j < 4; ++j) { const int p = 16 * pt + 4 * fq + j; yv[j] = d1[j] + et * d2[j] + dsk * bf2f((unsigned)Xt[p * 72 + t]); }
                u32x2 w; w.x = pk2(yv[0], yv[1]); w.y = pk2(yv[2], yv[3]);
                *(u32x2*)(Y + (size_t)(row0 + t) * DI + h * 64 + 16 * pt + 4 * fq) = w;
            }
            bf16x8 a3[2];
#pragma unroll
            for (int ks = 0; ks < 2; ++ks) a3[ks] = *(const LAS bf16x8*)(Btw + (16 * wave + fr) * 72 + ks * 32 + 8 * fq);
            const float dec = ecum[63];
#pragma unroll
            for (int p4 = 0; p4 < 4; ++p4) { f32x4 d = {0.f, 0.f, 0.f, 0.f};
#pragma unroll
                for (int ks = 0; ks < 2; ++ks) { const bf16x8 bb = *(const LAS bf16x8*)(Xt + (16 * p4 + fr) * 72 + ks * 32 + 8 * fq); d = mfma16(a3[ks], bb, d); }
                hst[p4] = hst[p4] * dec + d; }
        }
        __syncthreads();
#pragma unroll
        for (int p4 = 0; p4 < 4; ++p4) { u32x2 w; w.x = pk2(hst[p4][0], hst[p4][1]); w.y = pk2(hst[p4][2], hst[p4][3]);
            *(LAS u32x2*)(Hp + (16 * p4 + fr) * 136 + 16 * wave + 4 * fq) = w; }
    }
    float* so = A.out + O_SSP + ((size_t)b * 32 + h) * 64 * 128;
#pragma unroll
    for (int p4 = 0; p4 < 4; ++p4) *(f32x4*)(so + (size_t)(16 * p4 + fr) * 128 + 16 * wave + 4 * fq) = hst[p4];
    __syncthreads();
}

__device__ __forceinline__ void ssd_sample_item(const Args& A, LAS unsigned char* wl, int b, int h, int lane) {
    const bf16_t* XC = (const bf16_t*)(A.ws + WS_XC); const float* SMF = (const float*)(A.ws + WS_SMF); bf16_t* Y = (bf16_t*)(A.ws + WS_Y);
    LAS float* red = (LAS float*)wl;
    const int g = h >> 3;
    const float Ah = -expf(A.in[I_ALOG][h]), dtb = A.in[I_DTB][h], dsk = A.in[I_DSKIP][h];
#pragma unroll 1
    for (int half = 0; half < 2; ++half) {
        const float* h0 = A.in[I_SSSM] + (((size_t)b * 32 + h) * 64 + 32 * half) * 128 + 2 * lane;
        float st[32][2];
#pragma unroll
        for (int p = 0; p < 32; ++p) { const float2 v = *(const float2*)(h0 + p * 128); st[p][0] = v.x; st[p][1] = v.y; }
#pragma unroll 1
        for (int t = 0; t < 4; ++t) {
            const size_t m = (size_t)(MP + b * 4 + t);
            const float dt = softplusf_(SMF[m * 128 + h] + dtb), dec = expf(dt * Ah);
            const unsigned bw = *(const unsigned*)(XC + m * XCW + 2048 + g * 128 + 2 * lane), cw = *(const unsigned*)(XC + m * XCW + 2560 + g * 128 + 2 * lane);
            const float b0 = bf2f(bw & 0xffffu) * dt, b1 = __uint_as_float(bw & 0xffff0000u) * dt, c0 = bf2f(cw & 0xffffu), c1 = __uint_as_float(cw & 0xffff0000u);
            const float xl = bf2f((unsigned)XC[m * XCW + h * 64 + 32 * half + (lane & 31)]);
#pragma unroll
            for (int p = 0; p < 32; ++p) {
                const float xp = __shfl(xl, p);
                st[p][0] = st[p][0] * dec + xp * b0; st[p][1] = st[p][1] * dec + xp * b1;
                red[p * 65 + lane] = st[p][0] * c0 + st[p][1] * c1;
            }
            asm volatile("s_waitcnt lgkmcnt(0)" ::: "memory");
            float y = 0.f;
#pragma unroll 16
            for (int i = 0; i < 64; ++i) y += red[(lane & 31) * 65 + i];
            y += dsk * xl;
            if (lane < 32) Y[m * DI + h * 64 + 32 * half + lane] = (bf16_t)f2bf(y);
            asm volatile("s_waitcnt lgkmcnt(0)" ::: "memory");
        }
        float* so = A.out + O_SSS + (((size_t)b * 32 + h) * 64 + 32 * half) * 128 + 2 * lane;
#pragma unroll
        for (int p = 0; p < 32; ++p) *(float2*)(so + p * 128) = make_float2(st[p][0], st[p][1]);
    }
}

__device__ __forceinline__ int t5_bucket(int n) {
    if (n < 16) return n;
    const float nf = (float)n;
    int large = 16 + (int)(logf(nf / 16.0f) / 2.0794415416798357f * 16.0f);
    return large < 31 ? large : 31;
}
typedef float f32x16 __attribute__((ext_vector_type(16)));
__device__ __forceinline__ f32x16 mfma32(bf16x8 a, bf16x8 b, f32x16 c) { return __builtin_amdgcn_mfma_f32_32x32x16_bf16(a, b, c, 0, 0, 0); }
constexpr float LOG2E = 1.4426950408889634f;
constexpr int AK_STR = 72, AV_STR = 68, AT_K0 = 0, AT_V0 = 2 * 64 * AK_STR * 2, AT_WS = AT_V0 + 2 * 64 * AV_STR * 2;
__device__ __forceinline__ void attn_prompt_unit(const Args& A, LAS unsigned char* lds, const LAS float* biasL, int b, int g, int qt, int wave, int lane_in) {
    const bf16_t* P = (const bf16_t*)(A.ws + WS_P); const unsigned* MASK32 = (const unsigned*)(A.ws + WS_SC); bf16_t* YA = (bf16_t*)(A.ws + WS_YA);
    int lane = lane_in; asm volatile("" : "+v"(lane));
    const int tid = wave * 64 + lane, r32 = lane & 31, hi = lane >> 5;
    LAS float* wsc = (LAS float*)(lds + AT_WS) + wave * 64;
    const int query = qt * 64 + 8 * wave + (r32 >> 2), head = 4 * g + (r32 & 3);
    const size_t qrow = (size_t)(b * 2048 + query);
    bf16x8 qf[4];
#pragma unroll
    for (int ds = 0; ds < 4; ++ds) qf[ds] = *(const bf16x8*)(P + qrow * NP + PQ + head * 64 + 16 * ds + 8 * hi);
    const unsigned* mrow = MASK32 + qrow * 64;
    const float bfar = biasL[128 * 16 + head];
    const int skey = tid >> 3, sdch = tid & 7;
    const bf16_t* ksrc = P + (size_t)(b * 2048 + skey) * NP + PK + g * 64 + sdch * 8;
    f32x16 O0, O1;
#pragma unroll
    for (int i = 0; i < 16; ++i) { O0[i] = 0.f; O1[i] = 0.f; }
    float m_run = -1e30f, l_run = 0.f;
    u32x4 kreg = *(const u32x4*)ksrc, vreg = *(const u32x4*)(ksrc + 256);
    unsigned mw0 = mrow[0], mw1 = mrow[1];
    {
        LAS bf16_t* Kb = (LAS bf16_t*)(lds + AT_K0); LAS bf16_t* Vb = (LAS bf16_t*)(lds + AT_V0);
        *(LAS u32x4*)(Kb + skey * AK_STR + sdch * 8) = kreg;
#pragma unroll
        for (int e = 0; e < 4; ++e) { Vb[(sdch * 8 + 2 * e) * AV_STR + skey] = (bf16_t)(vreg[e] & 0xffffu); Vb[(sdch * 8 + 2 * e + 1) * AV_STR + skey] = (bf16_t)(vreg[e] >> 16); }
    }
    for (int kt = 0; kt <= qt; ++kt) {
        const int buf = kt & 1;
        __syncthreads();
        const unsigned w0 = mw0 >> (4 * hi), w1 = mw1 >> (4 * hi);
        if (kt < qt) { const bf16_t* src = ksrc + (size_t)(kt + 1) * 64 * NP; kreg = *(const u32x4*)src; vreg = *(const u32x4*)(src + 256); mw0 = mrow[2 * kt + 2]; mw1 = mrow[2 * kt + 3]; }
        const LAS bf16_t* Kb = (const LAS bf16_t*)(lds + AT_K0 + buf * (64 * AK_STR * 2)); const LAS bf16_t* Vb = (const LAS bf16_t*)(lds + AT_V0 + buf * (64 * AV_STR * 2));
        f32x16 S0, S1;
#pragma unroll
        for (int i = 0; i < 16; ++i) { S0[i] = 0.f; S1[i] = 0.f; }
#pragma unroll
        for (int ds = 0; ds < 4; ++ds) {
            const bf16x8 k0 = *(const LAS bf16x8*)(Kb + r32 * AK_STR + 16 * ds + 8 * hi), k1 = *(const LAS bf16x8*)(Kb + (32 + r32) * AK_STR + 16 * ds + 8 * hi);
            S0 = mfma32(k0, qf[ds], S0); S1 = mfma32(k1, qf[ds], S1);
        }
        const float c1 = 0.125f * LOG2E;
        if (qt - kt >= 3) {
#pragma unroll
            for (int i = 0; i < 16; ++i) { const unsigned bit = 1u << ((i & 3) + 8 * (i >> 2));
                S0[i] = (w0 & bit) ? S0[i] * c1 + bfar : -INFINITY; S1[i] = (w1 & bit) ? S1[i] * c1 + bfar : -INFINITY; }
        } else {
            const int kbase = kt * 64 + 4 * hi;
#pragma unroll
            for (int i = 0; i < 16; ++i) { const int pos = (i & 3) + 8 * (i >> 2); const unsigned bit = 1u << pos;
                int r0 = query - (kbase + pos), r1 = r0 - 32; r0 = r0 < 0 ? 0 : (r0 > 128 ? 128 : r0); r1 = r1 < 0 ? 0 : (r1 > 128 ? 128 : r1);
                S0[i] = (w0 & bit) ? S0[i] * c1 + biasL[r0 * 16 + head] : -INFINITY; S1[i] = (w1 & bit) ? S1[i] * c1 + biasL[r1 * 16 + head] : -INFINITY; }
        }
        float tm = fmaxf(S0[0], S1[0]);
#pragma unroll
        for (int i = 1; i < 16; ++i) tm = fmaxf(tm, fmaxf(S0[i], S1[i]));
        tm = fmaxf(tm, __shfl_xor(tm, 32));
        if (__any(tm > m_run + 8.0f)) {
            const float mn = fmaxf(m_run, tm), f = __builtin_amdgcn_exp2f(m_run - mn);
            m_run = mn; l_run *= f;
            if (hi == 0) wsc[r32] = f;
            asm volatile("s_waitcnt lgkmcnt(0)" ::: "memory");
#pragma unroll
            for (int i = 0; i < 16; ++i) { const float fi = wsc[(i & 3) + 8 * (i >> 2) + 4 * hi]; O0[i] *= fi; O1[i] *= fi; }
            asm volatile("s_waitcnt lgkmcnt(0)" ::: "memory");
        }
        float ls = 0.f;
#pragma unroll
        for (int i = 0; i < 16; ++i) { S0[i] = __builtin_amdgcn_exp2f(S0[i] - m_run); S1[i] = __builtin_amdgcn_exp2f(S1[i] - m_run); ls += S0[i] + S1[i]; }
        l_run += ls;
        bf16x8 pa[2][2];
#pragma unroll
        for (int sk = 0; sk < 2; ++sk) {
            u32x4 a0, a1;
            a0.x = pk2(S0[8 * sk + 0], S0[8 * sk + 1]); a0.y = pk2(S0[8 * sk + 2], S0[8 * sk + 3]); a0.z = pk2(S0[8 * sk + 4], S0[8 * sk + 5]); a0.w = pk2(S0[8 * sk + 6], S0[8 * sk + 7]);
            a1.x = pk2(S1[8 * sk + 0], S1[8 * sk + 1]); a1.y = pk2(S1[8 * sk + 2], S1[8 * sk + 3]); a1.z = pk2(S1[8 * sk + 4], S1[8 * sk + 5]); a1.w = pk2(S1[8 * sk + 6], S1[8 * sk + 7]);
            pa[0][sk] = __builtin_bit_cast(bf16x8, a0); pa[1][sk] = __builtin_bit_cast(bf16x8, a1);
        }
#pragma unroll
        for (int blk = 0; blk < 2; ++blk)
#pragma unroll
            for (int sk = 0; sk < 2; ++sk) {
                const int kb = 32 * blk + 16 * sk + 4 * hi;
                const u32x2 a = *(const LAS u32x2*)(Vb + r32 * AV_STR + kb), c = *(const LAS u32x2*)(Vb + r32 * AV_STR + kb + 8);
                const u32x2 a2 = *(const LAS u32x2*)(Vb + (32 + r32) * AV_STR + kb), c2 = *(const LAS u32x2*)(Vb + (32 + r32) * AV_STR + kb + 8);
                const u32x4 v0 = {a.x, a.y, c.x, c.y}, v1 = {a2.x, a2.y, c2.x, c2.y};
                O0 = mfma32(pa[blk][sk], __builtin_bit_cast(bf16x8, v0), O0);
                O1 = mfma32(pa[blk][sk], __builtin_bit_cast(bf16x8, v1), O1);
            }
        if (kt < qt) {
            LAS bf16_t* Kn = (LAS bf16_t*)(lds + AT_K0 + (buf ^ 1) * (64 * AK_STR * 2)); LAS bf16_t* Vn = (LAS bf16_t*)(lds + AT_V0 + (buf ^ 1) * (64 * AV_STR * 2));
            *(LAS u32x4*)(Kn + skey * AK_STR + sdch * 8) = kreg;
#pragma unroll
            for (int e = 0; e < 4; ++e) { Vn[(sdch * 8 + 2 * e) * AV_STR + skey] = (bf16_t)(vreg[e] & 0xffffu); Vn[(sdch * 8 + 2 * e + 1) * AV_STR + skey] = (bf16_t)(vreg[e] >> 16); }
        }
    }
    l_run += __shfl_xor(l_run, 32);
    if (hi == 0) wsc[r32] = 1.0f / l_run;
    asm volatile("s_waitcnt lgkmcnt(0)" ::: "memory");
#pragma unroll
    for (int i = 0; i < 16; ++i) {
        const int rq = (i & 3) + 8 * (i >> 2) + 4 * hi; const float inv = wsc[rq];
        bf16_t* dst = YA + (size_t)(b * 2048 + qt * 64 + 8 * wave + (rq >> 2)) * D + (4 * g + (rq & 3)) * 64 + r32;
        dst[0] = (bf16_t)f2bf(O0[i] * inv); dst[32] = (bf16_t)f2bf(O1[i] * inv);
    }
    __syncthreads();
}

__device__ __forceinline__ void attend_sample_task(const Args& A, LAS unsigned char* wl, const LAS float* biasrel, int ms, int g, int lane_in) {
    constexpr int NJ = 33;
    int lane = lane_in; asm volatile("" : "+v"(lane));
    const bf16_t* P = (const bf16_t*)(A.ws + WS_P);
    const int b = ms >> 2, t = ms & 3, nvalid = 2049 + t, qpos = 2048 + t, m = MP + ms;
    const float* srow = (const float*)(A.ws + WS_SCS) + (size_t)ms * SCSW;
    LAS float* pq = (LAS float*)wl;
    LAS unsigned* rowid = (LAS unsigned*)(wl + 4096);
    LAS unsigned short* posl = (LAS unsigned short*)(wl + 4096 + 1024);
    unsigned key[NJ];
#pragma unroll
    for (int j = 0; j < NJ; ++j) key[j] = (lane < nvalid - 64 * j) ? f2key(srow[lane + 64 * j]) : 0u;
    unsigned T = 0u; int need_eq = 0;
    {
        bool exact = false;
        for (int bit = 31; bit >= 0; --bit) {
            const unsigned cand = T | (1u << bit); int cnt = 0;
#pragma unroll
            for (int j = 0; j < NJ; ++j) cnt += __popcll(__ballot(key[j] >= cand));
            if (cnt >= 256) { T = cand; if (cnt == 256) { exact = true; break; } }
        }
        if (exact) { T -= 1u; }
        else { int cgt = 0;
#pragma unroll
            for (int j = 0; j < NJ; ++j) cgt += __popcll(__ballot(key[j] > T));
            need_eq = 256 - cgt; }
    }
    int base = 0, eqused = 0;
    const int* pt = (const int*)A.in[I_PT];
#pragma unroll
    for (int j = 0; j < NJ; ++j) {
        const bool gt = key[j] > T, eq = (need_eq > 0) && (key[j] == T);
        const unsigned long long meq = __ballot(eq);
        const bool sel = gt || (eq && (eqused + mbcnt64(meq) < need_eq));
        eqused += __popcll(meq);
        const unsigned long long msk = __ballot(sel);
        if (sel) { const int pos = lane + 64 * j, k = base + mbcnt64(msk);
            posl[k] = (unsigned short)pos;
            rowid[k] = (pos < 2048) ? (unsigned)(pt[b * 16 + (pos >> 7)] * 128 + (pos & 127)) : (0x80000000u | (unsigned)(b * 4 + pos - 2048)); }
        base += __popcll(msk);
    }
    { const u32x2 w = *(const u32x2*)(P + (size_t)m * NP + PQ + g * 256 + lane * 4);
      *(LAS f32x4*)(pq + lane * 4) = (f32x4){__uint_as_float(w.x << 16), __uint_as_float(w.x & 0xffff0000u), __uint_as_float(w.y << 16), __uint_as_float(w.y & 0xffff0000u)}; }
    asm volatile("s_waitcnt lgkmcnt(0)" ::: "memory");
    const float* ck = A.in[I_CK]; const float* cv = A.in[I_CV]; const float* kn = A.out + O_KS; const float* vn = A.out + O_VS;
    const float* kp[4]; int rel[4];
#pragma unroll
    for (int i = 0; i < 4; ++i) { const unsigned rid = rowid[lane + 64 * i]; rel[i] = qpos - (int)posl[lane + 64 * i];
        kp[i] = ((rid & 0x80000000u) ? kn + (size_t)(rid & 0x7fffffffu) * 256 : ck + (size_t)rid * 256) + g * 64; }
    float acc[4][4];
#pragma unroll
    for (int i = 0; i < 4; ++i)
#pragma unroll
        for (int hh = 0; hh < 4; ++hh) acc[i][hh] = 0.f;
#pragma unroll 2
    for (int dc = 0; dc < 16; ++dc) {
        f32x4 kv[4];
#pragma unroll
        for (int i = 0; i < 4; ++i) kv[i] = *(const f32x4*)(kp[i] + dc * 4);
#pragma unroll
        for (int hh = 0; hh < 4; ++hh) { const f32x4 q4 = *(const LAS f32x4*)(pq + hh * 64 + dc * 4);
#pragma unroll
            for (int i = 0; i < 4; ++i) acc[i][hh] += kv[i][0] * q4[0] + kv[i][1] * q4[1] + kv[i][2] * q4[2] + kv[i][3] * q4[3]; }
    }
    asm volatile("s_waitcnt lgkmcnt(0)" ::: "memory");
#pragma unroll
    for (int i = 0; i < 4; ++i) { const int rc = rel[i] < 128 ? (rel[i] < 0 ? 0 : rel[i]) : 128; const f32x4 bv = *(const LAS f32x4*)(biasrel + rc * 16 + 4 * g);
#pragma unroll
        for (int hh = 0; hh < 4; ++hh) acc[i][hh] = acc[i][hh] * 0.125f + bv[hh]; }
#pragma unroll
    for (int hh = 0; hh < 4; ++hh) {
        const float mx = wave_max(fmaxf(fmaxf(acc[0][hh], acc[1][hh]), fmaxf(acc[2][hh], acc[3][hh])));
        float sm = 0.f;
#pragma unroll
        for (int i = 0; i < 4; ++i) { acc[i][hh] = __expf(acc[i][hh] - mx); sm += acc[i][hh]; }
        const float inv = 1.0f / wave_sum(sm);
#pragma unroll
        for (int i = 0; i < 4; ++i) acc[i][hh] *= inv;
    }
#pragma unroll
    for (int i = 0; i < 4; ++i) *(LAS f32x4*)(pq + (lane + 64 * i) * 4) = (f32x4){acc[i][0], acc[i][1], acc[i][2], acc[i][3]};
    asm volatile("s_waitcnt lgkmcnt(0)" ::: "memory");
    float o[4] = {0.f, 0.f, 0.f, 0.f};
    for (int k0 = 0; k0 < 256; k0 += 8) {
        float vv[8]; f32x4 pp[8];
#pragma unroll
        for (int u = 0; u < 8; ++u) { const unsigned rid = rowid[k0 + u];
            const float* vp = ((rid & 0x80000000u) ? vn + (size_t)(rid & 0x7fffffffu) * 256 : cv + (size_t)rid * 256) + g * 64 + lane;
            vv[u] = *vp; pp[u] = *(const LAS f32x4*)(pq + (k0 + u) * 4); }
#pragma unroll
        for (int u = 0; u < 8; ++u)
#pragma unroll
            for (int hh = 0; hh < 4; ++hh) o[hh] += pp[u][hh] * vv[u];
    }
    bf16_t* YA = (bf16_t*)(A.ws + WS_YA);
#pragma unroll
    for (int hh = 0; hh < 4; ++hh) YA[(size_t)m * D + (4 * g + hh) * 64 + lane] = (bf16_t)f2bf(o[hh]);
    asm volatile("s_waitcnt lgkmcnt(0)" ::: "memory");
}

#if MK_CHECK_ATT
constexpr size_t WS_CHK_SC = WS_END, WS_CHK_YA = WS_CHK_SC + 128 * MiB, WS_CHK_MASK = WS_CHK_YA + 33 * MiB, WS_CHK_END = WS_CHK_MASK + 4 * MiB;
constexpr int CW_CHK = 512;
template <bool SAMPLE> struct KVRow;
template <> struct KVRow<false> {
    typedef const bf16_t* ptr;
    const bf16_t* P;
    __device__ __forceinline__ ptr krow(unsigned rid) const { return P + (size_t)rid * NP + PK; }
    __device__ __forceinline__ ptr vrow(unsigned rid) const { return P + (size_t)rid * NP + PV; }
    static __device__ __forceinline__ void k8(ptr p, float (&f)[8]) { unpack8(*(const u32x4*)p, f); }
    static __device__ __forceinline__ f32x4 v4(ptr p) { const u32x2 w = *(const u32x2*)p;
        return (f32x4){__uint_as_float(w.x << 16), __uint_as_float(w.x & 0xffff0000u), __uint_as_float(w.y << 16), __uint_as_float(w.y & 0xffff0000u)}; }
};
template <> struct KVRow<true> {
    typedef const float* ptr;
    const float* ck; const float* cv; const float* kn; const float* vn;
    __device__ __forceinline__ ptr krow(unsigned rid) const { return (rid & 0x80000000u) ? kn + (size_t)(rid & 0x7fffffffu) * 256 : ck + (size_t)rid * 256; }
    __device__ __forceinline__ ptr vrow(unsigned rid) const { return (rid & 0x80000000u) ? vn + (size_t)(rid & 0x7fffffffu) * 256 : cv + (size_t)rid * 256; }
    static __device__ __forceinline__ void k8(ptr p, float (&f)[8]) { const f32x4 a = *(const f32x4*)p, b = *(const f32x4*)(p + 4);
#pragma unroll
        for (int i = 0; i < 4; ++i) { f[i] = a[i]; f[4 + i] = b[i]; } }
    static __device__ __forceinline__ f32x4 v4(ptr p) { return *(const f32x4*)p; }
};

template <bool SAMPLE>
__device__ __forceinline__ void attend_query(const Args& A, LAS unsigned char* wl, const LAS float* biasrel, int m, int lane_in) {
    constexpr int NJ = SAMPLE ? 33 : 32;
    int lane = lane_in; asm volatile("" : "+v"(lane));
    const bf16_t* P = (const bf16_t*)(A.ws + WS_P);
    int b, nvalid, qpos; const float* srow;
    if (!SAMPLE) { b = m >> 11; const int t = m & 2047; nvalid = t + 1; qpos = t; srow = (const float*)(A.ws + WS_CHK_SC) + (size_t)m * SCW; }
    else { const int ms = m - MP; b = ms >> 2; const int t = ms & 3; nvalid = 2049 + t; qpos = 2048 + t; srow = (const float*)(A.ws + WS_SCS) + (size_t)ms * SCSW; }
    LAS float* pq = (LAS float*)wl;
    LAS unsigned* rowid = (LAS unsigned*)(wl + 16384);
    LAS unsigned short* posl = (LAS unsigned short*)(wl + 16384 + 1024);
    unsigned key[NJ];
#pragma unroll
    for (int j = 0; j < NJ; ++j) { key[j] = (lane < nvalid - 64 * j) ? f2key(srow[lane + 64 * j]) : 0u; }
    unsigned T = 0u; int need_eq = 0;
    if (nvalid > 256) {
        for (int bit = 31; bit >= 0; --bit) {
            const unsigned cand = T | (1u << bit); int cnt = 0;
#pragma unroll
            for (int j = 0; j < NJ; ++j) cnt += __popcll(__ballot(key[j] >= cand));
            if (cnt >= 256) T = cand;
        }
        int cgt = 0;
#pragma unroll
        for (int j = 0; j < NJ; ++j) cgt += __popcll(__ballot(key[j] > T));
        need_eq = 256 - cgt;
    }
    int base = 0, eqused = 0; unsigned long long mine_chk = 0ull;
    const int* pt = (const int*)A.in[I_PT];
#pragma unroll
    for (int j = 0; j < NJ; ++j) {
        const bool gt = key[j] > T, eq = (need_eq > 0) && (key[j] == T);
        const unsigned long long meq = __ballot(eq);
        const bool sel = gt || (eq && (eqused + mbcnt64(meq) < need_eq));
        eqused += __popcll(meq);
        const unsigned long long ms = __ballot(sel);
        if (sel) { const int pos = lane + 64 * j, k = base + mbcnt64(ms);
            posl[k] = (unsigned short)pos;
            unsigned rid;
            if (!SAMPLE) rid = (unsigned)(b * 2048 + pos);
            else rid = (pos < 2048) ? (unsigned)(pt[b * 16 + (pos >> 7)] * 128 + (pos & 127)) : (0x80000000u | (unsigned)(b * 4 + pos - 2048));
            rowid[k] = rid; }
        base += __popcll(ms);
        if (!SAMPLE) { if (lane == j) mine_chk = ms; }
    }
    if (!SAMPLE) { if (lane < 32) ((unsigned long long*)(A.ws + WS_CHK_MASK))[(size_t)m * 32 + lane] = mine_chk; }
    const int nsel = base;
    asm volatile("s_waitcnt lgkmcnt(0)" ::: "memory");
    { const unsigned r0 = rowid[0]; const unsigned short p0 = posl[0];
#pragma unroll
      for (int i = 0; i < 4; ++i) { const int k = lane + 64 * i; if (k >= nsel) { rowid[k] = r0; posl[k] = p0; } } }
    { const u32x4 w0 = *(const u32x4*)(P + (size_t)m * NP + PQ + lane * 16), w1 = *(const u32x4*)(P + (size_t)m * NP + PQ + lane * 16 + 8);
      float f0[8], f1[8]; unpack8(w0, f0); unpack8(w1, f1);
#pragma unroll
      for (int e = 0; e < 8; ++e) { pq[lane * 16 + e] = f0[e]; pq[lane * 16 + 8 + e] = f1[e]; } }
    asm volatile("s_waitcnt lgkmcnt(0)" ::: "memory");
    KVRow<SAMPLE> R;
    if constexpr (!SAMPLE) { R.P = P; } else { R.ck = A.in[I_CK]; R.cv = A.in[I_CV]; R.kn = A.out + O_KS; R.vn = A.out + O_VS; }
    typename KVRow<SAMPLE>::ptr kp[4]; int rel[4];
#pragma unroll
    for (int i = 0; i < 4; ++i) { kp[i] = R.krow(rowid[lane + 64 * i]); rel[i] = qpos - (int)posl[lane + 64 * i]; }
    float acc[4][16];
#pragma unroll
    for (int i = 0; i < 4; ++i)
#pragma unroll
        for (int hh = 0; hh < 16; ++hh) acc[i][hh] = 0.f;
#pragma unroll
    for (int g = 0; g < 4; ++g) {
#pragma unroll 1
        for (int dc = 0; dc < 8; ++dc) {
            float kv[4][8];
#pragma unroll
            for (int i = 0; i < 4; ++i) KVRow<SAMPLE>::k8(kp[i] + g * 64 + dc * 8, kv[i]);
#pragma unroll
            for (int hh = 0; hh < 4; ++hh) {
                const f32x4 q0 = *(const LAS f32x4*)(pq + (4 * g + hh) * 64 + dc * 8), q1 = *(const LAS f32x4*)(pq + (4 * g + hh) * 64 + dc * 8 + 4);
#pragma unroll
                for (int i = 0; i < 4; ++i) {
                    float a = acc[i][4 * g + hh];
#pragma unroll
                    for (int e = 0; e < 4; ++e) { a += kv[i][e] * q0[e]; a += kv[i][4 + e] * q1[e]; }
                    acc[i][4 * g + hh] = a; }
            }
        }
    }
    asm volatile("s_waitcnt lgkmcnt(0)" ::: "memory");
#pragma unroll
    for (int i = 0; i < 4; ++i) {
        const bool valid = (lane + 64 * i) < nsel; const int rc = rel[i] < 128 ? (rel[i] < 0 ? 0 : rel[i]) : 128;
#pragma unroll
        for (int h4 = 0; h4 < 4; ++h4) { const f32x4 bv = *(const LAS f32x4*)(biasrel + rc * 16 + 4 * h4);
#pragma unroll
            for (int e = 0; e < 4; ++e) acc[i][4 * h4 + e] = valid ? acc[i][4 * h4 + e] * 0.125f + bv[e] : -INFINITY; }
    }
#pragma unroll
    for (int hh = 0; hh < 16; ++hh) {
        const float mx = wave_max(fmaxf(fmaxf(acc[0][hh], acc[1][hh]), fmaxf(acc[2][hh], acc[3][hh])));
        float s = 0.f;
#pragma unroll
        for (int i = 0; i < 4; ++i) { acc[i][hh] = __expf(acc[i][hh] - mx); s += acc[i][hh]; }
        const float inv = 1.0f / wave_sum(s);
#pragma unroll
        for (int i = 0; i < 4; ++i) acc[i][hh] *= inv;
    }
#pragma unroll
    for (int i = 0; i < 4; ++i)
#pragma unroll
        for (int h4 = 0; h4 < 4; ++h4) *(LAS f32x4*)(pq + (lane + 64 * i) * 16 + 4 * h4) = (f32x4){acc[i][4 * h4], acc[i][4 * h4 + 1], acc[i][4 * h4 + 2], acc[i][4 * h4 + 3]};
    asm volatile("s_waitcnt lgkmcnt(0)" ::: "memory");
    const int g = lane >> 4;
    f32x4 o[4];
#pragma unroll
    for (int hh = 0; hh < 4; ++hh) o[hh] = (f32x4){0.f, 0.f, 0.f, 0.f};
    const int nloop = (nsel + 3) & ~3;
    for (int k0 = 0; k0 < nloop; k0 += 4) {
        f32x4 vv[4], pp[4];
#pragma unroll
        for (int u = 0; u < 4; ++u) { const unsigned r = rowid[k0 + u]; vv[u] = KVRow<SAMPLE>::v4(R.vrow(r) + lane * 4); pp[u] = *(const LAS f32x4*)(pq + (k0 + u) * 16 + 4 * g); }
#pragma unroll
        for (int u = 0; u < 4; ++u)
#pragma unroll
            for (int hh = 0; hh < 4; ++hh) o[hh] += vv[u] * pp[u][hh];
    }
    bf16_t* YA = (bf16_t*)(A.ws + WS_CHK_YA);
#pragma unroll
    for (int hh = 0; hh < 4; ++hh) { u32x2 w; w.x = pk2(o[hh][0], o[hh][1]); w.y = pk2(o[hh][2], o[hh][3]);
        *(u32x2*)(YA + (size_t)m * D + (4 * g + hh) * 64 + (lane & 15) * 4) = w; }
    asm volatile("s_waitcnt lgkmcnt(0)" ::: "memory");
}


__device__ __forceinline__ void check_compare(const Args& A, int gw, int NGW, int lane) {
    const bf16_t* Y1 = (const bf16_t*)(A.ws + WS_YA); const bf16_t* Y2 = (const bf16_t*)(A.ws + WS_CHK_YA); unsigned* ctl = (unsigned*)(A.ws + WS_CTL);
    for (int m = gw; m < MP; m += NGW) {
        float e = 0.f, n = 0.f;
#pragma unroll
        for (int j = 0; j < 2; ++j) { float a[8], b[8]; unpack8(*(const u32x4*)(Y1 + (size_t)m * D + j * 512 + lane * 8), a); unpack8(*(const u32x4*)(Y2 + (size_t)m * D + j * 512 + lane * 8), b);
#pragma unroll
            for (int i = 0; i < 8; ++i) { const float d = a[i] - b[i]; e += d * d; n += b[i] * b[i]; } }
        e = wave_sum(e); n = wave_sum(n);
        { const unsigned long long w1 = (lane < 32) ? ((const unsigned long long*)(A.ws + WS_SC))[(size_t)m * 32 + lane] : 0ull, w2 = (lane < 32) ? ((const unsigned long long*)(A.ws + WS_CHK_MASK))[(size_t)m * 32 + lane] : 0ull;
          if (__any(w1 != w2) && lane == 0) atomicAdd(ctl + CW_CHK + 3, 1u);
          const int t = m & 2047;
          if (t >= 256) {
              const float* srow = (const float*)(A.ws + WS_CHK_SC) + (size_t)m * SCW;
              int c1 = 0, c2 = 0; float mins1 = INFINITY, maxu1 = -INFINITY, mins2 = INFINITY, maxu2 = -INFINITY;
              for (int j = 0; j < 32; ++j) { const int sp = lane + 64 * j; if (64 * j > t) break;
                  const unsigned long long a1 = __shfl((unsigned long long)w1, j), a2 = __shfl((unsigned long long)w2, j);
                  if (sp <= t) { const float v = srow[sp]; const bool s1 = (a1 >> lane) & 1ull, s2 = (a2 >> lane) & 1ull;
                      if (s1) { ++c1; mins1 = fminf(mins1, v); } else maxu1 = fmaxf(maxu1, v);
                      if (s2) { ++c2; mins2 = fminf(mins2, v); } else maxu2 = fmaxf(maxu2, v); } }
              c1 = (int)wave_sum((float)c1); c2 = (int)wave_sum((float)c2);
              mins1 = -wave_max(-mins1); mins2 = -wave_max(-mins2); maxu1 = wave_max(maxu1); maxu2 = wave_max(maxu2);
              if (lane == 0) { if (c1 != 256 || mins1 < maxu1) atomicAdd(ctl + CW_CHK + 4, 1u); if (c2 != 256 || mins2 < maxu2) atomicAdd(ctl + CW_CHK + 5, 1u); }
          } }
        if (lane == 0 && !(e <= MK_CHECK_TOL * MK_CHECK_TOL * n + 1e-12f)) { const int t = m & 2047; atomicAdd(ctl + CW_CHK + (t < 64 ? 0 : t < 256 ? 1 : 2), 1u); }
    }
}
#endif
__device__ __forceinline__ void gate_norm_phase(const Args& A, int gw, int NGW, int lane) {
    const bf16_t* P = (const bf16_t*)(A.ws + WS_P); bf16_t* Y = (bf16_t*)(A.ws + WS_Y); const float* ng = A.in[I_NORMG];
    for (int it = gw; it < M * 4; it += NGW) {
        const int m = it >> 2, ch = (it & 3) * 512 + lane * 8;
        float y[8], z[8]; unpack8(*(const u32x4*)(Y + (size_t)m * DI + ch), y); unpack8(*(const u32x4*)(P + (size_t)m * NP + PZ + ch), z);
        float ss = 0.f;
#pragma unroll
        for (int i = 0; i < 8; ++i) { y[i] *= siluf_(z[i]); ss += y[i] * y[i]; }
        const float r = 1.0f / sqrtf(wave_sum(ss) * (1.f / 512.f) + LN_EPS);
        const f32x4 g0 = *(const f32x4*)(ng + ch), g1 = *(const f32x4*)(ng + ch + 4);
#pragma unroll
        for (int i = 0; i < 4; ++i) { y[i] = y[i] * r * g0[i]; y[4 + i] = y[4 + i] * r * g1[i]; }
        *(u32x4*)(Y + (size_t)m * DI + ch) = pack8(y);
    }
}

constexpr int NPHASE = 14;
__global__ void __launch_bounds__(NTHR, 2) fwd(Args args) {
    extern __shared__ __attribute__((aligned(16))) unsigned char lds_raw[];
    LAS unsigned char* lds = (LAS unsigned char*)lds_raw;
    const int tid = threadIdx.x, lane = tid & 63, wave = __builtin_amdgcn_readfirstlane(tid >> 6);
    const int G = gridDim.x, bx = blockIdx.x;
    const int vcu = (G % 8 == 0) ? (bx % 8) * (G / 8) + bx / 8 : bx;
    const int gw = vcu * NWAVES + wave, NGW = G * NWAVES;
    unsigned char* ws = args.ws;
    volatile LAS unsigned* MISC = (volatile LAS unsigned*)(lds + MISC_OFF);
    for (int u = tid; u < 64; u += NTHR) MISC[u] = 0u;
    __syncthreads();
    const int lo = args.ph_lo, hi = args.ph_hi;
    XcdBarrier bar; bar.bar = (unsigned*)(ws + WS_CTL) + CW_BAR; bar.x = 0; bar.st = nullptr;
    if (hi - lo > 1) bar = xcd_barrier_post((unsigned*)(ws + WS_CTL) + CW_BAR, MISC + 8);
#define IN(k) (lo <= (k) && (k) < hi)
#define SEAM(k) do { if (IN(k) && IN((k) + 1)) xcd_barrier(bar); } while (0)

    bf16_t* const XB = (bf16_t*)(ws + WS_XB); bf16_t* const ACT = (bf16_t*)(ws + WS_ACT); float* const T = (float*)(ws + WS_T);
    float* const HF = (float*)(ws + WS_HF); bf16_t* const HB = (bf16_t*)(ws + WS_HB); bf16_t* const P = (bf16_t*)(ws + WS_P);
    float* const SMF = (float*)(ws + WS_SMF); bf16_t* const Y = (bf16_t*)(ws + WS_Y); bf16_t* const YA = (bf16_t*)(ws + WS_YA); bf16_t* const MG = (bf16_t*)(ws + WS_MG);

    if (IN(0)) REPK(0) { p0_prologue(args, lds, gw, NGW, wave, lane); }
    SEAM(0);
    if (IN(1)) {
        { pg8::Gemm g{XB, (const bf16_t*)(ws + WS_W1A), M, 2 * DFF, D}; pg8::StaticOrder S; S.init(M, 2 * DFF, G, bx);
        EpiSwiglu E{ACT}; pg8::gemm_phase<EpiSwiglu, pg8::StaticOrder, true, true>(lds, g, S, E); }
        if constexpr (DUPK(1)) { pg8::Gemm g{XB, (const bf16_t*)(ws + WS_W1A), M, 2 * DFF, D}; pg8::StaticOrder S; S.init(M, 2 * DFF, G, bx);
        EpiSwiglu E{ACT}; pg8::gemm_phase<EpiSwiglu, pg8::StaticOrder, true, true>(lds, g, S, E); }
    }
    SEAM(1);
    if (IN(2)) {
        { pg8::Gemm g{ACT, (const bf16_t*)(ws + WS_W1B), MP, D, DFF}; pg8::StaticOrder S; S.init(MP, D, G, bx);
        EpiResid E{args.in[I_XP], args.in[I_XS], T, ALPHA, 0.5f}; pg8::gemm_phase<EpiResid, pg8::StaticOrder, true, true>(lds, g, S, E); }
        { SkResid E{args.in[I_XS], T, ALPHA, 0.5f}; skinny_gemm<DFF>(lds, ACT + (size_t)MP * DFF, (const bf16_t*)(ws + WS_W1B), E, bx, G, wave, lane); }
        if constexpr (DUPK(2)) { pg8::Gemm g{ACT, (const bf16_t*)(ws + WS_W1B), MP, D, DFF}; pg8::StaticOrder S; S.init(MP, D, G, bx);
        EpiResid E{args.in[I_XP], args.in[I_XS], T, ALPHA, 0.5f}; pg8::gemm_phase<EpiResid, pg8::StaticOrder, true, true>(lds, g, S, E); }
    }
    SEAM(2);
    if (IN(3)) REPK(3) { ln_phase(T, args.in[I_LN1G], args.in[I_LN1B], HF, HB, gw, NGW, lane); }
    SEAM(3);
    if (IN(4)) {
        { pg8::Gemm g{HB, (const bf16_t*)(ws + WS_WIN), M, NP, D}; pg8::StaticOrder S; S.init(M, NP, G, bx);
        EpiWin E{P, SMF, args.out}; pg8::gemm_phase<EpiWin, pg8::StaticOrder, true, true>(lds, g, S, E); }
        if constexpr (DUPK(4)) { pg8::Gemm g{HB, (const bf16_t*)(ws + WS_WIN), M, NP, D}; pg8::StaticOrder S; S.init(M, NP, G, bx);
        EpiWin E{P, SMF, args.out}; pg8::gemm_phase<EpiWin, pg8::StaticOrder, true, true>(lds, g, S, E); }
    }
    SEAM(4);
    if (IN(5)) REPK(5) {
        for (int rep = 0; rep < MK_REP_CONV; ++rep)
        conv_phase(args, gw, NGW, lane);
        for (int rep = 0; rep < MK_REP_SCP; ++rep)
        for (int u = bx; u < 1024; u += G) { const int i = u >> 8, c = u & 255, b = c >> 5, s = c & 31; const int qt = (i == 0) ? s : (i == 1) ? 63 - s : (i == 2) ? 64 + s : 127 - s;
            scores_select_prompt_unit(args, lds, b, qt, wave, lane); }
        for (int rep = 0; rep < MK_REP_SCS; ++rep)
        for (int u = bx; u < 256; u += G) scores_sample_unit(args, u >> 1, u & 1, wave, lane);
    }
    SEAM(5);
    if (IN(6)) {
        for (int rep = 0; rep < MK_REP_SSDP; ++rep)
        for (int it = bx; it < 256; it += G) ssd_prompt_item(args, lds, it >> 5, it & 31);
        __syncthreads();
        LAS float* biasrel = (LAS float*)(lds + BIASREL_OFF); LAS float* biasL = biasrel + 129 * 16;
        for (int i = tid; i < 129 * 16; i += NTHR) { const int rel = i >> 4, h = i & 15; const float bv = args.in[I_BIAS][t5_bucket(rel) * 16 + h]; biasrel[i] = bv; biasL[i] = bv * LOG2E; }
        __syncthreads();
        for (int rep = 0; rep < MK_REP_ATTP; ++rep)
        for (int u = bx; u < 1024; u += G) { const int i = u >> 8, c = u & 255, bg = c >> 3, s8 = c & 7; const int qt = (i == 0) ? s8 : (i == 1) ? 15 - s8 : (i == 2) ? 16 + s8 : 31 - s8;
            attn_prompt_unit(args, lds, biasL, bg >> 2, bg & 3, qt, wave, lane); }
        __syncthreads();
        LAS unsigned char* wl = lds + wave * WAREA;
        for (int rep = 0; rep < MK_REP_SSDS; ++rep)
        for (int it = gw; it < 4096; it += NGW) ssd_sample_item(args, wl, it >> 5, it & 31, lane);
        for (int rep = 0; rep < MK_REP_ATTS; ++rep)
        for (int q = gw; q < MS * 4; q += NGW) attend_sample_task(args, wl, biasrel, q >> 2, q & 3, lane);
#if MK_CHECK_ATT
        for (int q = gw; q < MP; q += NGW) attend_query<false>(args, wl, biasrel, q, lane);
#endif
        __syncthreads();
    }
    SEAM(6);
    if (IN(7)) {
        gate_norm_phase(args, gw, NGW, lane);
#if MK_CHECK_ATT
        check_compare(args, gw, NGW, lane);
#endif
        { pg8::Gemm g{YA, (const bf16_t*)(ws + WS_WBA), MP, D, D}; pg8::StaticOrder S; S.init(MP, D, G, bx);
        EpiGateA E{P, PG + D, T}; pg8::gemm_phase<EpiGateA, pg8::StaticOrder, true, true>(lds, g, S, E); }
        { SkGateA E{P, PG + D, T}; skinny_gemm<D>(lds, YA + (size_t)MP * D, (const bf16_t*)(ws + WS_WBA), E, bx, G, wave, lane); }
        if constexpr (DUPK(7)) { pg8::Gemm g{YA, (const bf16_t*)(ws + WS_WBA), MP, D, D}; pg8::StaticOrder S; S.init(MP, D, G, bx);
        EpiGateA E{P, PG + D, T}; pg8::gemm_phase<EpiGateA, pg8::StaticOrder, true, true>(lds, g, S, E); }
    }
    SEAM(7);
    if (IN(8)) {
        { pg8::Gemm g{Y, (const bf16_t*)(ws + WS_WBS), MP, D, DI}; pg8::StaticOrder S; S.init(MP, D, G, bx);
        EpiGateS E{P, PG, T, MG}; pg8::gemm_phase<EpiGateS, pg8::StaticOrder, true, true>(lds, g, S, E); }
        { SkGateS E{P, PG, T, MG}; skinny_gemm<DI>(lds, Y + (size_t)MP * DI, (const bf16_t*)(ws + WS_WBS), E, bx, G, wave, lane); }
        if constexpr (DUPK(8)) { pg8::Gemm g{Y, (const bf16_t*)(ws + WS_WBS), MP, D, DI}; pg8::StaticOrder S; S.init(MP, D, G, bx);
        EpiGateS E{P, PG, T, MG}; pg8::gemm_phase<EpiGateS, pg8::StaticOrder, true, true>(lds, g, S, E); }
    }
    SEAM(8);
    if (IN(9)) {
        { pg8::Gemm g{MG, (const bf16_t*)(ws + WS_WOUT), MP, D, D}; pg8::StaticOrder S; S.init(MP, D, G, bx);
        EpiResid E{HF, HF + (size_t)MP * D, T, ALPHA, 1.0f}; pg8::gemm_phase<EpiResid, pg8::StaticOrder, true, true>(lds, g, S, E); }
        { SkResid E{HF + (size_t)MP * D, T, ALPHA, 1.0f}; skinny_gemm<D>(lds, MG + (size_t)MP * D, (const bf16_t*)(ws + WS_WOUT), E, bx, G, wave, lane); }
        if constexpr (DUPK(9)) { pg8::Gemm g{MG, (const bf16_t*)(ws + WS_WOUT), MP, D, D}; pg8::StaticOrder S; S.init(MP, D, G, bx);
        EpiResid E{HF, HF + (size_t)MP * D, T, ALPHA, 1.0f}; pg8::gemm_phase<EpiResid, pg8::StaticOrder, true, true>(lds, g, S, E); }
    }
    SEAM(9);
    if (IN(10)) REPK(10) { ln_phase(T, args.in[I_LN2G], args.in[I_LN2B], HF, HB, gw, NGW, lane); }
    SEAM(10);
    if (IN(11)) {
        { pg8::Gemm g{HB, (const bf16_t*)(ws + WS_W2A), M, 2 * DFF, D}; pg8::StaticOrder S; S.init(M, 2 * DFF, G, bx);
        EpiSwiglu E{ACT}; pg8::gemm_phase<EpiSwiglu, pg8::StaticOrder, true, true>(lds, g, S, E); }
        if constexpr (DUPK(11)) { pg8::Gemm g{HB, (const bf16_t*)(ws + WS_W2A), M, 2 * DFF, D}; pg8::StaticOrder S; S.init(M, 2 * DFF, G, bx);
        EpiSwiglu E{ACT}; pg8::gemm_phase<EpiSwiglu, pg8::StaticOrder, true, true>(lds, g, S, E); }
    }
    SEAM(11);
    if (IN(12)) {
        { pg8::Gemm g{ACT, (const bf16_t*)(ws + WS_W2B), MP, D, DFF}; pg8::StaticOrder S; S.init(MP, D, G, bx);
        EpiResid E{HF, HF + (size_t)MP * D, T, ALPHA, 0.5f}; pg8::gemm_phase<EpiResid, pg8::StaticOrder, true, true>(lds, g, S, E); }
        { SkResid E{HF + (size_t)MP * D, T, ALPHA, 0.5f}; skinny_gemm<DFF>(lds, ACT + (size_t)MP * DFF, (const bf16_t*)(ws + WS_W2B), E, bx, G, wave, lane); }
        if constexpr (DUPK(12)) { pg8::Gemm g{ACT, (const bf16_t*)(ws + WS_W2B), MP, D, DFF}; pg8::StaticOrder S; S.init(MP, D, G, bx);
        EpiResid E{HF, HF + (size_t)MP * D, T, ALPHA, 0.5f}; pg8::gemm_phase<EpiResid, pg8::StaticOrder, true, true>(lds, g, S, E); }
    }
    SEAM(12);
    if (IN(13)) REPK(13) { ln_phase(T, args.in[I_LN3G], args.in[I_LN3B], args.out + O_Y, nullptr, gw, NGW, lane); }
#if MK_CHECK_ATT
    if (IN(13)) { __syncthreads(); unsigned* cw = (unsigned*)(ws + WS_CTL) + CW_CHK;
        const unsigned b0 = __hip_atomic_load(cw, __ATOMIC_RELAXED, __HIP_MEMORY_SCOPE_AGENT), b1 = __hip_atomic_load(cw + 1, __ATOMIC_RELAXED, __HIP_MEMORY_SCOPE_AGENT), b2 = __hip_atomic_load(cw + 2, __ATOMIC_RELAXED, __HIP_MEMORY_SCOPE_AGENT), b3 = __hip_atomic_load(cw + 3, __ATOMIC_RELAXED, __HIP_MEMORY_SCOPE_AGENT), b4 = __hip_atomic_load(cw + 4, __ATOMIC_RELAXED, __HIP_MEMORY_SCOPE_AGENT), b5 = __hip_atomic_load(cw + 5, __ATOMIC_RELAXED, __HIP_MEMORY_SCOPE_AGENT);
        const float code = MK_CHECK_CODE;
        if (code > 0.f && bx == 0 && tid == 0) args.out[O_Y] = 4096.0f * sqrtf(code); }
#endif
#undef IN
#undef SEAM
}
}

extern "C" void kernel_launch(void* const* d_in, const int* in_sizes, int n_in, void* d_out, int out_size, void* d_ws, size_t ws_size, hipStream_t stream) {
    using namespace mk;
    static int grid = 0;
    if (grid == 0) {
        if (n_in != 29 || (size_t)out_size != O_END || ws_size < WS_END) { fprintf(stderr, "kernel_launch: unexpected shapes (n_in %d, out %d, ws %zu)\n", n_in, out_size, ws_size); grid = -1; return; }
        int dev = 0, cus = 0, per_cu = 0;
        if (hipGetDevice(&dev) != hipSuccess || hipDeviceGetAttribute(&cus, hipDeviceAttributeMultiprocessorCount, dev) != hipSuccess) { grid = -1; return; }
        if (hipFuncSetAttribute((const void*)fwd, hipFuncAttributeMaxDynamicSharedMemorySize, LDS_BYTES) != hipSuccess) { fprintf(stderr, "kernel_launch: hipFuncSetAttribute failed\n"); grid = -1; return; }
        if (hipOccupancyMaxActiveBlocksPerMultiprocessor(&per_cu, (const void*)fwd, NTHR, LDS_BYTES) != hipSuccess || per_cu < 1) fprintf(stderr, "kernel_launch: occupancy query says %d\n", per_cu);
        (void)hipGetLastError();
        grid = cus;
    }
    if (grid < 0) return;
    (void)hipMemsetAsync((char*)d_ws + WS_CTL, 0, CTL_ZERO_BYTES, stream);
    Args a{};
    for (int i = 0; i < 29; ++i) a.in[i] = (const float*)d_in[i];
    a.out = (float*)d_out; a.ws = (unsigned char*)d_ws;
#if MK_SPLIT
    for (int p = 0; p < NPHASE; ++p) { a.ph_lo = p; a.ph_hi = p + 1; hipLaunchKernelGGL(fwd, dim3(grid), dim3(NTHR), LDS_BYTES, stream, a); }
#else
    a.ph_lo = 0; a.ph_hi = NPHASE; hipLaunchKernelGGL(fwd, dim3(grid), dim3(NTHR), LDS_BYTES, stream, a);
#endif
}
```

```cpp
#include <hip/hip_runtime.h>
#include <cstdio>
#include <cstdint>
#define GAS __attribute__((address_space(1)))
#define LAS __attribute__((address_space(3)))
namespace pg8 {
#define PG8_LAS __attribute__((address_space(3)))
typedef unsigned short bf16_t;
typedef short bf16x8 __attribute__((ext_vector_type(8)));
typedef float f32x4 __attribute__((ext_vector_type(4)));
typedef unsigned u32x4 __attribute__((ext_vector_type(4)));
constexpr int BM = 256, BK = 64, HALF = 128, HTB = HALF * BK * 2  , STAGE_BYTES = 8 * HTB, NXCD = 8, WGM = 8;

__host__ __device__ __forceinline__ int lds_byte(int r, int c) { const int st = (r >> 4) * 2 + (c >> 5), rr = r & 15, cc = c & 31, ob = rr * 64 + cc * 2; return st * 1024 + (ob ^ (((ob >> 9) & 1) << 5)); }
__host__ __device__ __forceinline__ void stage_rc(int b, int& R, int& C) { const int st = b / 1024, sb = b % 1024, swz = sb ^ (((sb >> 9) & 1) << 5); R = (st >> 1) * 16 + swz / 64; C = (st & 1) * 32 + (swz % 64) / 2; }
__host__ __device__ __forceinline__ int perm32(int rho) { const int n = rho >> 4, i = rho & 15; return 8 * (i >> 2) + 4 * n + (i & 3); }

struct Unit { int pm, pn; };
struct Gemm { const bf16_t* A; const bf16_t* Bt; int M, N, K; };

struct StaticOrder {
    int nM, nN, nwg, G, c;
    __host__ __device__ void init(int M, int N, int G_, int c_) { nM = M / BM; nN = N / BM; nwg = nM * nN; G = G_; c = c_; }
    __host__ __device__ bool next(int i, Unit& u) const {
        const long L = (long)i * G + c; if (L >= nwg) return false;
        int wgid = (int)L; { const int q = nwg / NXCD, r = nwg % NXCD, xcd = wgid % NXCD, off = wgid / NXCD; wgid = (xcd < r ? xcd * (q + 1) : r * (q + 1) + (xcd - r) * q) + off; }
        const int nig = WGM * nN, gid = wgid / nig, fm = gid * WGM, gsz = (nM - fm) < WGM ? (nM - fm) : WGM;
        u.pm = fm + ((wgid % nig) % gsz); u.pn = (wgid % nig) / gsz; return true;
    }
    __device__ __forceinline__ void a_ready(const Unit&) const {}
    __device__ __forceinline__ void done(const Unit&) const {}
};

__device__ __forceinline__ unsigned cvt_pk_bf16(float lo, float hi) { unsigned r; asm volatile("v_cvt_pk_bf16_f32 %0, %1, %2" : "=v"(r) : "v"(lo), "v"(hi)); return r; }

template <class Epi, class Sched, bool ALIGN_EPI = false, bool SP2 = false>
__device__ __forceinline__ void gemm_phase(PG8_LAS unsigned char* lds, const Gemm g, const Sched& S, const Epi& E) {
    const int tid = threadIdx.x, wid = __builtin_amdgcn_readfirstlane(tid >> 6), lane = tid & 63, wr = wid >> 2, wc = wid & 3, fr = lane & 15, fq = lane >> 4;
    const int K = g.K, nt = K / BK;
    unsigned voffA[2], voffB[2];
#pragma unroll
    for (int i = 0; i < 2; ++i) { int R, C; stage_rc(tid * 16 + i * 8192, R, C); const int Rb = Epi::PERM ? ((R & ~31) + perm32(R & 31)) : R;
        voffA[i] = (unsigned)(R * K + C) * 2u; voffB[i] = (unsigned)(Rb * K + C) * 2u; }
    const size_t kstep = (size_t)(BK * 2);
    const size_t hstep = (size_t)HALF * K * 2;
    const size_t tstep = 2 * hstep;
    const unsigned ldsw = (unsigned)wid * 1024u;
    const int aoff = lds_byte(wr * 64 + fr, fq * 8), boff = lds_byte(wc * 32 + fr, fq * 8);
#define PG8_SA(b, h) (((b) * 2 + (h)) * HTB)
#define PG8_SB(b, h) ((4 + (b) * 2 + (h)) * HTB)
#define PG8_STAGE(bufoff, gbase, voff) do { _Pragma("unroll") for (int _i = 0; _i < 2; ++_i) \
        __builtin_amdgcn_global_load_lds((const unsigned*)((const char*)(gbase) + (voff)[_i]), (PG8_LAS unsigned*)(lds + (bufoff) + ldsw + _i * 8192), 16, 0, 0); } while (0)
#define PG8_LDA(dst, b, h) do { _Pragma("unroll") for (int m = 0; m < 4; ++m) _Pragma("unroll") for (int k = 0; k < 2; ++k) dst[m][k] = *(const PG8_LAS bf16x8*)(lds + PG8_SA(b, h) + aoff + m * 2048 + k * 1024); } while (0)
#define PG8_LDB(dst, b, h) do { _Pragma("unroll") for (int n = 0; n < 2; ++n) _Pragma("unroll") for (int k = 0; k < 2; ++k) dst[n][k] = *(const PG8_LAS bf16x8*)(lds + PG8_SB(b, h) + boff + n * 2048 + k * 1024); } while (0)
#define PG8_MMA(ai, bj, At, Bt) do { __builtin_amdgcn_s_setprio(1); _Pragma("unroll") for (int m = 0; m < 4; ++m) _Pragma("unroll") for (int n = 0; n < 2; ++n) _Pragma("unroll") for (int k = 0; k < 2; ++k) \
        acc[ai][bj][m][n] = __builtin_amdgcn_mfma_f32_16x16x32_bf16(Bt[n][k], At[m][k], acc[ai][bj][m][n], 0, 0, 0); __builtin_amdgcn_s_setprio(0); } while (0)
#define PG8_WAIT_V(n) asm volatile("s_waitcnt vmcnt(" #n ")" ::: "memory")
#define PG8_WAIT_L(n) asm volatile("s_waitcnt lgkmcnt(" #n ")" ::: "memory")
#define PG8_BAR __builtin_amdgcn_s_barrier()
#define PG8_SCHED __builtin_amdgcn_sched_barrier(0)
    Unit cur, nxt; int ui = 0;
    if (!S.next(0, cur)) return;
    f32x4 acc[2][2][4][2];
#pragma unroll
    for (int a = 0; a < 2; ++a)
#pragma unroll
        for (int b = 0; b < 2; ++b)
#pragma unroll
            for (int m = 0; m < 4; ++m)
#pragma unroll
                for (int n = 0; n < 2; ++n) acc[a][b][m][n] = (f32x4){0.f, 0.f, 0.f, 0.f};
    bf16x8 At[4][2], B0[2][2], B1[2][2];
    const char* cA = (const char*)g.A + (size_t)cur.pm * tstep; const char* cB = (const char*)g.Bt + (size_t)cur.pn * tstep;
    S.a_ready(cur);
    if constexpr (SP2) {
        PG8_STAGE(PG8_SB(0, 0), cB, voffB); PG8_STAGE(PG8_SB(0, 1), cB + hstep, voffB); PG8_STAGE(PG8_SA(0, 0), cA, voffA); PG8_STAGE(PG8_SA(0, 1), cA + hstep, voffA);
        if (wr == 1) PG8_BAR;
        PG8_WAIT_V(2); PG8_BAR;
        PG8_STAGE(PG8_SB(1, 0), cB + kstep, voffB); PG8_STAGE(PG8_SA(1, 0), cA + kstep, voffA); PG8_STAGE(PG8_SB(1, 1), cB + hstep + kstep, voffB);
        PG8_WAIT_V(6); PG8_BAR;
    } else {
        PG8_STAGE(PG8_SB(0, 0), cB, voffB); PG8_STAGE(PG8_SA(0, 0), cA, voffA); PG8_STAGE(PG8_SB(0, 1), cB + hstep, voffB); PG8_STAGE(PG8_SA(0, 1), cA + hstep, voffA);
        if (wr == 1) PG8_BAR;
        PG8_WAIT_V(4); PG8_BAR;
        PG8_STAGE(PG8_SB(1, 0), cB + kstep, voffB); PG8_STAGE(PG8_SA(1, 0), cA + kstep, voffA); PG8_STAGE(PG8_SB(1, 1), cB + hstep + kstep, voffB);
        PG8_WAIT_V(6); PG8_BAR;
    }
    for (;;) {
        const bool has_next = S.next(ui + 1, nxt);
        const char* nA = has_next ? (const char*)g.A + (size_t)nxt.pm * tstep : cA; const char* nB = has_next ? (const char*)g.Bt + (size_t)nxt.pn * tstep : cB;
        for (int t = 0; t < nt; t += 2) {
            const bool last = (t == nt - 2);
            const char* a1 = cA + (size_t)(t + 1) * kstep;
            const char* a2 = last ? nA : cA + (size_t)(t + 2) * kstep; const char* b2 = last ? nB : cB + (size_t)(t + 2) * kstep;
            const char* a3 = a2 + kstep; const char* b3 = b2 + kstep;
            if (last && has_next) S.a_ready(nxt);
            if constexpr (SP2) {
            PG8_LDB(B0, 0, 0); PG8_LDB(B1, 0, 1); PG8_SCHED; PG8_LDA(At, 0, 0); PG8_STAGE(PG8_SA(1, 1), a1 + hstep, voffA);
            PG8_WAIT_V(8); PG8_WAIT_L(0); PG8_BAR; PG8_MMA(0, 0, At, B0); PG8_MMA(0, 1, At, B1); PG8_BAR; PG8_SCHED;
            PG8_LDA(At, 0, 1); PG8_STAGE(PG8_SB(0, 0), b2, voffB); PG8_STAGE(PG8_SB(0, 1), b2 + hstep, voffB); PG8_STAGE(PG8_SA(0, 0), a2, voffA);
            PG8_WAIT_V(8); PG8_WAIT_L(0); PG8_BAR; PG8_MMA(1, 0, At, B0); PG8_MMA(1, 1, At, B1); PG8_BAR; PG8_SCHED;
            PG8_LDB(B0, 1, 0); PG8_LDB(B1, 1, 1); PG8_SCHED; PG8_LDA(At, 1, 0); PG8_STAGE(PG8_SA(0, 1), a2 + hstep, voffA);
            PG8_WAIT_V(8); PG8_WAIT_L(0); PG8_BAR; PG8_MMA(0, 0, At, B0); PG8_MMA(0, 1, At, B1); PG8_BAR; PG8_SCHED;
            PG8_LDA(At, 1, 1); PG8_STAGE(PG8_SB(1, 0), b3, voffB); PG8_STAGE(PG8_SB(1, 1), b3 + hstep, voffB); PG8_STAGE(PG8_SA(1, 0), a3, voffA);
            PG8_WAIT_V(8); PG8_WAIT_L(0); PG8_BAR; PG8_MMA(1, 0, At, B0); PG8_MMA(1, 1, At, B1); PG8_BAR; PG8_SCHED;
            } else {
            PG8_LDB(B0, 0, 0); PG8_SCHED; PG8_LDA(At, 0, 0); PG8_STAGE(PG8_SA(1, 1), a1 + hstep, voffA);
            PG8_WAIT_L(8); PG8_BAR; PG8_WAIT_L(0); PG8_MMA(0, 0, At, B0); PG8_BAR; PG8_SCHED;
            PG8_LDB(B1, 0, 1); PG8_STAGE(PG8_SB(0, 0), b2, voffB);
            PG8_BAR; PG8_WAIT_L(0); PG8_MMA(0, 1, At, B1); PG8_BAR;
            PG8_LDA(At, 0, 1); PG8_STAGE(PG8_SA(0, 0), a2, voffA);
            PG8_BAR; PG8_WAIT_L(0); PG8_MMA(1, 0, At, B0); PG8_BAR; PG8_SCHED;
            PG8_STAGE(PG8_SB(0, 1), b2 + hstep, voffB);
            PG8_WAIT_V(6); PG8_BAR; PG8_MMA(1, 1, At, B1); PG8_BAR;
            PG8_LDB(B0, 1, 0); PG8_SCHED; PG8_LDA(At, 1, 0); PG8_STAGE(PG8_SA(0, 1), a2 + hstep, voffA);
            PG8_WAIT_L(8); PG8_BAR; PG8_WAIT_L(0); PG8_MMA(0, 0, At, B0); PG8_BAR; PG8_SCHED;
            PG8_LDB(B1, 1, 1); PG8_STAGE(PG8_SB(1, 0), b3, voffB);
            PG8_BAR; PG8_WAIT_L(0); PG8_MMA(0, 1, At, B1); PG8_BAR;
            PG8_LDA(At, 1, 1); PG8_STAGE(PG8_SA(1, 0), a3, voffA);
            PG8_BAR; PG8_WAIT_L(0); PG8_MMA(1, 0, At, B0); PG8_BAR; PG8_SCHED;
            PG8_STAGE(PG8_SB(1, 1), b3 + hstep, voffB);
            PG8_WAIT_V(6); PG8_BAR; PG8_MMA(1, 1, At, B1); PG8_BAR;
            }
        }
        if constexpr (ALIGN_EPI) { if (wr == 0) PG8_BAR; }
        if constexpr (!Epi::AFTER_DRAIN) { E(acc, cur, wr, wc, fr, fq); S.done(cur); }
        if (!has_next) break;
#pragma unroll
        for (int a = 0; a < 2; ++a)
#pragma unroll
            for (int b = 0; b < 2; ++b)
#pragma unroll
                for (int m = 0; m < 4; ++m)
#pragma unroll
                    for (int n = 0; n < 2; ++n) acc[a][b][m][n] = (f32x4){0.f, 0.f, 0.f, 0.f};
        cur = nxt; cA = nA; cB = nB; ++ui;
        if constexpr (ALIGN_EPI) { if (wr == 1) PG8_BAR; }
    }
    PG8_WAIT_V(0);
    if constexpr (!ALIGN_EPI) { if (wr == 0) PG8_BAR; }
    PG8_BAR;
    if constexpr (Epi::AFTER_DRAIN) { E.fused(acc, cur, wr, wc, fr, fq, lds, wid, lane); S.done(cur); }
#undef PG8_SA
#undef PG8_SB
#undef PG8_STAGE
#undef PG8_LDA
#undef PG8_LDB
#undef PG8_MMA
#undef PG8_WAIT_V
#undef PG8_WAIT_L
#undef PG8_BAR
#undef PG8_SCHED
}
}
#define XB_TMO      128
#define XB_XCNT(j)  (256  + 64 * (j))
#define XB_XSUB(j)  (1280 + 64 * (j))
#define XB_XGEN(j)  (2304 + 64 * (j))
#define XB_TOP      3328
#define XB_TOPGEN   3392
#define XCD_BAR_WORDS 3456
#define XB_SPIN_CAP (1u << 18)

__device__ __forceinline__ unsigned xb_ld(unsigned* p)              { return __hip_atomic_load(p, __ATOMIC_RELAXED, __HIP_MEMORY_SCOPE_AGENT); }
__device__ __forceinline__ unsigned xb_add(unsigned* p, unsigned v) { return __hip_atomic_fetch_add(p, v, __ATOMIC_RELAXED, __HIP_MEMORY_SCOPE_AGENT); }
__device__ __forceinline__ unsigned xb_xcc_id() { return (unsigned)__builtin_amdgcn_s_getreg((3 << 11) | 20) & 0xFu; }
#define XB_SPIN(cond, bar) do { unsigned _sp = 0; while (cond) { __builtin_amdgcn_s_sleep(1); \
    if ((++_sp & 255u) == 0u) { if (xb_ld(&(bar)[XB_TMO])) break; if (_sp > XB_SPIN_CAP) { atomicAdd(&(bar)[XB_TMO], 1u); break; } } } } while (0)

struct XcdBarrier {
    unsigned* bar; unsigned x;
    volatile LAS unsigned* st;
};

__device__ __forceinline__ XcdBarrier xcd_barrier_post(unsigned* bar, volatile LAS unsigned* st) {
    XcdBarrier b; b.bar = bar; b.x = xb_xcc_id(); b.st = st;
    if (threadIdx.x == 0) (void)xb_add(&bar[XB_XCNT(b.x)], 1u);
    return b;
}
__device__ __forceinline__ void xcd_barrier_complete(unsigned* bar, unsigned x, unsigned& nloc, unsigned& nx) {
    const unsigned G = gridDim.x * gridDim.y * gridDim.z;
    unsigned sum, cnt, mine, sp = 0u;
    for (;;) {
        sum = 0u; cnt = 0u; mine = 0u;
#pragma unroll
        for (unsigned j = 0; j < 16; ++j) { const unsigned c = xb_ld(&bar[XB_XCNT(j)]); sum += c; cnt += (c > 0u) ? 1u : 0u; mine = (j == x) ? c : mine; }
        if (sum == G) break;
        __builtin_amdgcn_s_sleep(1);
        if ((++sp & 255u) == 0u) { if (xb_ld(&bar[XB_TMO])) break; if (sp > XB_SPIN_CAP) { atomicAdd(&bar[XB_TMO], 1u); break; } }
    }
    nloc = mine > 0u ? mine : 1u; nx = cnt > 0u ? cnt : 1u;
}

__device__ __forceinline__ void xcd_barrier(const XcdBarrier& b) {
    asm volatile("s_waitcnt vmcnt(0)" ::: "memory");
    __syncthreads();
    if (threadIdx.x == 0) {
        unsigned* bar = b.bar;
        __builtin_amdgcn_s_waitcnt(0);
        unsigned nloc = b.st[0], nx = b.st[1];
        if (nloc == 0u) { xcd_barrier_complete(bar, b.x, nloc, nx); b.st[0] = nloc; b.st[1] = nx; }
        const unsigned old = xb_add(&bar[XB_XSUB(b.x)], 1u);
        const unsigned gen = old / nloc;
        if (old + 1u == (gen + 1u) * nloc) {
            __builtin_amdgcn_fence(__ATOMIC_RELEASE, "agent");
            asm volatile("s_waitcnt vmcnt(0)" ::: "memory");
            const unsigned og = xb_add(&bar[XB_TOP], 1u);
            const unsigned tg = og / nx;
            if (og + 1u == (tg + 1u) * nx) xb_add(&bar[XB_TOPGEN], 1u);
            else XB_SPIN(xb_ld(&bar[XB_TOPGEN]) == tg, bar);
            __builtin_amdgcn_fence(__ATOMIC_ACQUIRE, "agent");
            xb_add(&bar[XB_XGEN(b.x)], 1u);
            asm volatile("s_waitcnt vmcnt(0)" ::: "memory");
        } else {
            XB_SPIN(xb_ld(&bar[XB_XGEN(b.x)]) == gen, bar);
            __builtin_amdgcn_fence(__ATOMIC_ACQUIRE, "agent");
            asm volatile("s_waitcnt vmcnt(0)" ::: "memory");
        }
    }
    __syncthreads();
}
namespace mk {
using pg8::bf16_t; using pg8::bf16x8; using pg8::f32x4; using pg8::u32x4;
typedef unsigned u32x2 __attribute__((ext_vector_type(2)));

#ifndef MK_CHECK_ATT
#define MK_CHECK_ATT 0
#endif
#define MK_REP_SSDP 1
#define MK_REP_CONV 1
#define MK_REP_SCP 1
#define MK_REP_SCS 1
#define MK_REP_SSDS 1
#define MK_REP_ATTS 1
#define MK_REP_ATTP 1
#define MK_CHECK_TOL 0.02f
#define MK_CHECK_CODE ((b0 ? 1.f : 0.f) + (b1 ? 2.f : 0.f) + (b2 ? 4.f : 0.f) + (b3 ? 8.f : 0.f) + (b4 ? 16.f : 0.f) + (b5 ? 32.f : 0.f))
#define MK_REP_MASK 0
#define DUPK(k) (((MK_REP_MASK >> (k)) & 1) != 0)
#define REPK(k) for (int rep_ = 0; rep_ < 1 + ((MK_REP_MASK >> (k)) & 1); ++rep_)
#ifndef MK_SPLIT
#define MK_SPLIT 0
#endif

constexpr int NWAVES = 8, NTHR = 512;
constexpr int MP = 16384, MS = 512, M = MP + MS, D = 1024, DFF = 2816, DI = 2048, NP = 9472, XCW = 3072;
constexpr int PZ = 0, PXBC = 2048, PSM = 5120, PQ = 5376, PK = 6400, PV = 6656, PQI = 6912, PG = 7424;
constexpr int SCW = 2048, SCSW = 2112;
constexpr size_t O_Y = 0, O_KP = 17301504, O_VP = 21495808, O_KIP = 25690112, O_CVP = 26738688, O_SSP = 26812416,
                 O_KS = 28909568, O_VS = 29040640, O_KIS = 29171712, O_CVS = 29204480, O_SSS = 30384128, O_END = 63938560;
constexpr size_t MiB = 1u << 20;
constexpr size_t WS_CTL = 0, CTL_ZERO_BYTES = 1 * MiB;
constexpr size_t WS_W1A = 1 * MiB, WS_W1B = WS_W1A + 11 * MiB, WS_WIN = WS_W1B + 6 * MiB, WS_WBS = WS_WIN + 19 * MiB, WS_WBA = WS_WBS + 4 * MiB,
                 WS_WOUT = WS_WBA + 2 * MiB, WS_W2A = WS_WOUT + 2 * MiB, WS_W2B = WS_W2A + 11 * MiB;
constexpr size_t WS_XB = WS_W2B + 6 * MiB, WS_ACT = WS_XB + 33 * MiB, WS_T = WS_ACT + 91 * MiB, WS_HF = WS_T + 66 * MiB, WS_HB = WS_HF + 66 * MiB,
                 WS_P = WS_HB + 33 * MiB, WS_SMF = WS_P + 306 * MiB, WS_XC = WS_SMF + 9 * MiB, WS_Y = WS_XC + 99 * MiB, WS_SC = WS_Y + 66 * MiB,
                 WS_SCS = WS_SC + 128 * MiB, WS_YA = WS_SCS + 5 * MiB, WS_MG = WS_YA + 33 * MiB, WS_END = WS_MG + 33 * MiB;
constexpr int CW_BAR = 4096;
constexpr int LDS_BYTES = 163840, MISC_OFF = LDS_BYTES - 256;
constexpr int WAREA = 17920;
constexpr int BIASREL_OFF = NWAVES * WAREA;
static_assert(BIASREL_OFF + 2 * 129 * 16 * 4 <= MISC_OFF, "LDS map");

constexpr float ALPHA = 1.18920711500272f;
constexpr float LN_EPS = 1e-5f;

struct Args { const float* in[29]; float* out; unsigned char* ws; int ph_lo, ph_hi; };
enum { I_XP = 0, I_XS, I_CK, I_CV, I_CKI, I_SCONV, I_SSSM, I_PT, I_BIAS, I_WIN, I_CONVW, I_CONVB, I_DTB, I_ALOG, I_DSKIP, I_NORMG, I_WBS, I_WBA, I_WOUT,
       I_F1WI, I_F1WO, I_F2WI, I_F2WO, I_LN1G, I_LN1B, I_LN2G, I_LN2B, I_LN3G, I_LN3B };

__device__ __forceinline__ float bf2f(unsigned v) { return __uint_as_float(v << 16); }
__device__ __forceinline__ unsigned f2bf(float f) { unsigned u = __float_as_uint(f); return (u + 0x7fffu + ((u >> 16) & 1u)) >> 16; }
__device__ __forceinline__ unsigned pk2(float lo, float hi) { return pg8::cvt_pk_bf16(lo, hi); }
__device__ __forceinline__ void unpack8(const u32x4 w, float (&f)[8]) {
#pragma unroll
    for (int i = 0; i < 4; ++i) { f[2 * i] = __uint_as_float(w[i] << 16); f[2 * i + 1] = __uint_as_float(w[i] & 0xffff0000u); }
}
__device__ __forceinline__ u32x4 pack8(const float (&f)[8]) { u32x4 w; w.x = pk2(f[0], f[1]); w.y = pk2(f[2], f[3]); w.z = pk2(f[4], f[5]); w.w = pk2(f[6], f[7]); return w; }
__device__ __forceinline__ float sigmoidf_(float x) { return 1.0f / (1.0f + __expf(-x)); }
__device__ __forceinline__ float siluf_(float x) { return x / (1.0f + __expf(-x)); }
__device__ __forceinline__ float wave_sum(float v) {
#pragma unroll
    for (int o = 1; o < 64; o <<= 1) v += __shfl_xor(v, o);
    return v;
}
__device__ __forceinline__ float wave_max(float v) {
#pragma unroll
    for (int o = 1; o < 64; o <<= 1) v = fmaxf(v, __shfl_xor(v, o));
    return v;
}
__device__ __forceinline__ f32x4 mfma16(bf16x8 a, bf16x8 b, f32x4 c) { return __builtin_amdgcn_mfma_f32_16x16x32_bf16(a, b, c, 0, 0, 0); }
__device__ __forceinline__ int mbcnt64(unsigned long long m) { return (int)__builtin_amdgcn_mbcnt_hi((unsigned)(m >> 32), __builtin_amdgcn_mbcnt_lo((unsigned)m, 0u)); }

struct EpiSwiglu {
    static constexpr bool PERM = true, AFTER_DRAIN = false;
    bf16_t* O;
    __device__ __forceinline__ void operator()(const f32x4 (&acc)[2][2][4][2], const pg8::Unit& u, int wr, int wc, int fr, int fq) const {
        const int row0 = u.pm * 256 + wr * 64 + fr, col0 = u.pn * 128 + wc * 32 + 8 * fq;
#pragma unroll
        for (int ai = 0; ai < 2; ++ai)
#pragma unroll
            for (int m = 0; m < 4; ++m) {
                float o[8];
#pragma unroll
                for (int n = 0; n < 2; ++n)
#pragma unroll
                    for (int j = 0; j < 4; ++j) { const float g = acc[ai][0][m][n][j], up = acc[ai][1][m][n][j]; o[4 * n + j] = siluf_(g) * up; }
                *(u32x4*)(O + (size_t)(row0 + ai * 128 + m * 16) * DFF + col0) = pack8(o);
            }
    }
};
struct EpiResid {
    static constexpr bool PERM = false, AFTER_DRAIN = false;
    const float* base_p; const float* base_s; float* T; float alpha, s;
    __device__ __forceinline__ void operator()(const f32x4 (&acc)[2][2][4][2], const pg8::Unit& u, int wr, int wc, int fr, int fq) const {
        const int row0 = u.pm * 256 + wr * 64 + fr, col0 = u.pn * 256 + wc * 32 + 4 * fq;
#pragma unroll
        for (int ai = 0; ai < 2; ++ai)
#pragma unroll
            for (int m = 0; m < 4; ++m) {
                const int r = row0 + ai * 128 + m * 16;
                const float* b = (r < MP) ? base_p + (size_t)r * D : base_s + (size_t)(r - MP) * D;
#pragma unroll
                for (int bj = 0; bj < 2; ++bj)
#pragma unroll
                    for (int n = 0; n < 2; ++n) { const int c = col0 + bj * 128 + n * 16; const f32x4 bv = *(const f32x4*)(b + c);
                        *(f32x4*)(T + (size_t)r * D + c) = bv * alpha + acc[ai][bj][m][n] * s; }
            }
    }
};
struct EpiWin {
    static constexpr bool PERM = true, AFTER_DRAIN = false;
    bf16_t* P; float* smf; float* out;
    __device__ __forceinline__ void operator()(const f32x4 (&acc)[2][2][4][2], const pg8::Unit& u, int wr, int wc, int fr, int fq) const {
        const int row0 = u.pm * 256 + wr * 64 + fr, cl = wc * 32 + 8 * fq, col0 = u.pn * 256 + cl;
#pragma unroll
        for (int ai = 0; ai < 2; ++ai)
#pragma unroll
            for (int m = 0; m < 4; ++m) {
                const int r = row0 + ai * 128 + m * 16;
#pragma unroll
                for (int bj = 0; bj < 2; ++bj) {
                    const f32x4 v0 = acc[ai][bj][m][0], v1 = acc[ai][bj][m][1];
                    u32x4 w; w.x = pk2(v0[0], v0[1]); w.y = pk2(v0[2], v0[3]); w.z = pk2(v1[0], v1[1]); w.w = pk2(v1[2], v1[3]);
                    *(u32x4*)(P + (size_t)r * NP + col0 + bj * 128) = w;
                    if (u.pn == 20) {
                        if (bj == 0) {
                            float* d = smf + (size_t)r * 128 + cl; *(f32x4*)d = v0; *(f32x4*)(d + 4) = v1;
                            if (cl >= 64) { float* k = out + ((r < MP) ? O_KIP + (size_t)r * 64 : O_KIS + (size_t)(r - MP) * 64) + (cl - 64); *(f32x4*)k = v0; *(f32x4*)(k + 4) = v1; }
                        }
                    } else if (u.pn == 25) {
                        float* k = out + ((r < MP) ? O_KP + (size_t)r * 256 : O_KS + (size_t)(r - MP) * 256) + bj * 128 + cl; *(f32x4*)k = v0; *(f32x4*)(k + 4) = v1;
                    } else if (u.pn == 26) {
                        float* k = out + ((r < MP) ? O_VP + (size_t)r * 256 : O_VS + (size_t)(r - MP) * 256) + bj * 128 + cl; *(f32x4*)k = v0; *(f32x4*)(k + 4) = v1;
                    }
                }
            }
    }
};
struct EpiGateA {
    static constexpr bool PERM = false, AFTER_DRAIN = false;
    const bf16_t* P; int gcol; float* M1;
    __device__ __forceinline__ void operator()(const f32x4 (&acc)[2][2][4][2], const pg8::Unit& u, int wr, int wc, int fr, int fq) const {
        const int row0 = u.pm * 256 + wr * 64 + fr, col0 = u.pn * 256 + wc * 32 + 4 * fq;
#pragma unroll
        for (int ai = 0; ai < 2; ++ai)
#pragma unroll
            for (int m = 0; m < 4; ++m) {
                const int r = row0 + ai * 128 + m * 16;
#pragma unroll
                for (int bj = 0; bj < 2; ++bj)
#pragma unroll
                    for (int n = 0; n < 2; ++n) { const int c = col0 + bj * 128 + n * 16; const u32x2 gw = *(const u32x2*)(P + (size_t)r * NP + gcol + c);
                        f32x4 g; g[0] = sigmoidf_(__uint_as_float(gw.x << 16)); g[1] = sigmoidf_(__uint_as_float(gw.x & 0xffff0000u)); g[2] = sigmoidf_(__uint_as_float(gw.y << 16)); g[3] = sigmoidf_(__uint_as_float(gw.y & 0xffff0000u));
                        *(f32x4*)(M1 + (size_t)r * D + c) = g * acc[ai][bj][m][n]; }
            }
    }
};
struct EpiGateS {
    static constexpr bool PERM = true, AFTER_DRAIN = false;
    const bf16_t* P; int gcol; const float* M1; bf16_t* MG;
    __device__ __forceinline__ void operator()(const f32x4 (&acc)[2][2][4][2], const pg8::Unit& u, int wr, int wc, int fr, int fq) const {
        const int row0 = u.pm * 256 + wr * 64 + fr, col0 = u.pn * 256 + wc * 32 + 8 * fq;
#pragma unroll
        for (int ai = 0; ai < 2; ++ai)
#pragma unroll
            for (int m = 0; m < 4; ++m) {
                const int r = row0 + ai * 128 + m * 16;
#pragma unroll
                for (int bj = 0; bj < 2; ++bj) { const int c = col0 + bj * 128;
                    const u32x4 gw = *(const u32x4*)(P + (size_t)r * NP + gcol + c); float g[8]; unpack8(gw, g);
                    const f32x4 m0 = *(const f32x4*)(M1 + (size_t)r * D + c), m1 = *(const f32x4*)(M1 + (size_t)r * D + c + 4);
                    float o[8];
#pragma unroll
                    for (int j = 0; j < 4; ++j) { o[j] = m0[j] + sigmoidf_(g[j]) * acc[ai][bj][m][0][j]; o[4 + j] = m1[j] + sigmoidf_(g[4 + j]) * acc[ai][bj][m][1][j]; }
                    *(u32x4*)(MG + (size_t)r * D + c) = pack8(o); }
            }
    }
};

struct SkResid { const float* base; float* T; float alpha, s;
    __device__ __forceinline__ void operator()(int r, int c, f32x4 v) const { const f32x4 bv = *(const f32x4*)(base + (size_t)(r - MP) * D + c); *(f32x4*)(T + (size_t)r * D + c) = bv * alpha + v * s; } };
struct SkGateA { const bf16_t* P; int gcol; float* M1;
    __device__ __forceinline__ void operator()(int r, int c, f32x4 v) const { const u32x2 gw = *(const u32x2*)(P + (size_t)r * NP + gcol + c);
        f32x4 g; g[0] = sigmoidf_(__uint_as_float(gw.x << 16)); g[1] = sigmoidf_(__uint_as_float(gw.x & 0xffff0000u)); g[2] = sigmoidf_(__uint_as_float(gw.y << 16)); g[3] = sigmoidf_(__uint_as_float(gw.y & 0xffff0000u));
        *(f32x4*)(M1 + (size_t)r * D + c) = g * v; } };
struct SkGateS { const bf16_t* P; int gcol; const float* M1; bf16_t* MG;
    __device__ __forceinline__ void operator()(int r, int c, f32x4 v) const { const u32x2 gw = *(const u32x2*)(P + (size_t)r * NP + gcol + c); const f32x4 m = *(const f32x4*)(M1 + (size_t)r * D + c);
        const float o0 = m[0] + sigmoidf_(__uint_as_float(gw.x << 16)) * v[0], o1 = m[1] + sigmoidf_(__uint_as_float(gw.x & 0xffff0000u)) * v[1], o2 = m[2] + sigmoidf_(__uint_as_float(gw.y << 16)) * v[2], o3 = m[3] + sigmoidf_(__uint_as_float(gw.y & 0xffff0000u)) * v[3];
        u32x2 w; w.x = pk2(o0, o1); w.y = pk2(o2, o3); *(u32x2*)(MG + (size_t)r * D + c) = w; } };
template <int K, class Epi>
__device__ __forceinline__ void skinny_gemm(LAS unsigned char* lds, const bf16_t* A  , const bf16_t* Bt, const Epi& E, int bx, int G, int wave, int lane) {
    constexpr int KW = K / 8, NS = KW / 32;
    const int fr = lane & 15, fq = lane >> 4, tid = wave * 64 + lane;
    LAS float* part = (LAS float*)lds;
    for (int tile = bx; tile < 256; tile += G) {
        const int tm = tile >> 4, tn = tile & 15;
        const bf16_t* ap = A + (size_t)(tm * 32 + fr) * K + wave * KW + 8 * fq;
        const bf16_t* bp = Bt + (size_t)(tn * 64 + fr) * K + wave * KW + 8 * fq;
        f32x4 acc[2][4];
#pragma unroll
        for (int m = 0; m < 2; ++m)
#pragma unroll
            for (int n = 0; n < 4; ++n) acc[m][n] = (f32x4){0.f, 0.f, 0.f, 0.f};
#pragma unroll 4
        for (int ks = 0; ks < NS; ++ks) {
            bf16x8 a[2], bb[4];
#pragma unroll
            for (int m = 0; m < 2; ++m) a[m] = *(const bf16x8*)(ap + (size_t)m * 16 * K + ks * 32);
#pragma unroll
            for (int n = 0; n < 4; ++n) bb[n] = *(const bf16x8*)(bp + (size_t)n * 16 * K + ks * 32);
#pragma unroll
            for (int m = 0; m < 2; ++m)
#pragma unroll
                for (int n = 0; n < 4; ++n) acc[m][n] = mfma16(a[m], bb[n], acc[m][n]);
        }
#pragma unroll
        for (int m = 0; m < 2; ++m)
#pragma unroll
            for (int n = 0; n < 4; ++n)
#pragma unroll
                for (int j = 0; j < 4; ++j) part[(wave * 32 + m * 16 + 4 * fq + j) * 64 + n * 16 + fr] = acc[m][n][j];
        __syncthreads();
        { const int row = tid >> 4, c4 = (tid & 15) * 4; f32x4 v = {0.f, 0.f, 0.f, 0.f};
#pragma unroll
          for (int w = 0; w < 8; ++w) v += *(const LAS f32x4*)(part + (w * 32 + row) * 64 + c4);
          E(MP + tm * 32 + row, tn * 64 + c4, v); }
        __syncthreads();
    }
}

__device__ __forceinline__ void tr_item(const float* W, int K, int Nsrc, bf16_t* WT, int k0, int drow0, int scol0, int nvalid, LAS float* scr, int lane) {
    const int c = lane & 31;
#pragma unroll 8
    for (int i = 0; i < 32; ++i) { const int kk = 2 * i + (lane >> 5); float v = 0.f; if (c < nvalid) v = W[(size_t)(k0 + kk) * Nsrc + scol0 + c]; scr[kk * 33 + c] = v; }
    asm volatile("s_waitcnt lgkmcnt(0)" ::: "memory");
    const int cc = lane & 7;
#pragma unroll
    for (int j = 0; j < 4; ++j) { const int n = (lane >> 3) + 8 * j; const LAS float* s = scr + (8 * cc) * 33 + n;
        u32x4 o; o.x = pk2(s[0 * 33], s[1 * 33]); o.y = pk2(s[2 * 33], s[3 * 33]); o.z = pk2(s[4 * 33], s[5 * 33]); o.w = pk2(s[6 * 33], s[7 * 33]);
        *(u32x4*)(WT + (size_t)(drow0 + n) * K + k0 + 8 * cc) = o; }
    asm volatile("s_waitcnt lgkmcnt(0)" ::: "memory");
}
__device__ __forceinline__ void tr_map(int mode, int n0, int& scol0, int& nvalid) {
    nvalid = 32;
    if (mode == 0) { scol0 = n0; }
    else if (mode == 1) { const int j = n0 >> 8, i = n0 & 255; scol0 = (i < 128) ? j * 128 + i : DFF + j * 128 + (i - 128); }
    else {
        if (n0 < 5120) scol0 = n0;
        else if (n0 < 5376) { const int j = n0 - 5120;
            if (j == 0) scol0 = 5120;
            else if (j == 32) { scol0 = 7264; nvalid = 8; }
            else if (j == 64 || j == 96) scol0 = 7200 + (j - 64);
            else { scol0 = 0; nvalid = 0; } }
        else if (n0 < 6400) scol0 = 5152 + (n0 - 5376);
        else if (n0 < 6656) scol0 = 6176 + (n0 - 6400);
        else if (n0 < 6912) scol0 = 6432 + (n0 - 6656);
        else if (n0 < 7424) scol0 = 6688 + (n0 - 6912);
        else scol0 = 7272 + (n0 - 7424);
    }
}
__device__ __forceinline__ void p0_prologue(const Args& A, LAS unsigned char* lds, int gw, int NGW, int wave, int lane) {
    LAS float* scr = (LAS float*)(lds + wave * 16384);
    unsigned char* ws = A.ws;
    constexpr int NI0 = 16 * 176, NI1 = 44 * 32, NI2 = 16 * 296, NI3 = 32 * 32, NI4 = 16 * 32, NI5 = 16 * 32, NI6 = NI0, NI7 = NI1;
    constexpr int NIT = NI0 + NI1 + NI2 + NI3 + NI4 + NI5 + NI6 + NI7;
    for (int it = gw; it < NIT; it += NGW) {
        int r = it; const float* W; bf16_t* WT; int K, Nsrc, nblk, mode;
        if (r < NI0) { W = A.in[I_F1WI]; WT = (bf16_t*)(ws + WS_W1A); K = 1024; Nsrc = 2 * DFF; nblk = 176; mode = 1; }
        else if ((r -= NI0) < NI1) { W = A.in[I_F1WO]; WT = (bf16_t*)(ws + WS_W1B); K = DFF; Nsrc = 1024; nblk = 32; mode = 0; }
        else if ((r -= NI1) < NI2) { W = A.in[I_WIN]; WT = (bf16_t*)(ws + WS_WIN); K = 1024; Nsrc = 9320; nblk = 296; mode = 2; }
        else if ((r -= NI2) < NI3) { W = A.in[I_WBS]; WT = (bf16_t*)(ws + WS_WBS); K = 2048; Nsrc = 1024; nblk = 32; mode = 0; }
        else if ((r -= NI3) < NI4) { W = A.in[I_WBA]; WT = (bf16_t*)(ws + WS_WBA); K = 1024; Nsrc = 1024; nblk = 32; mode = 0; }
        else if ((r -= NI4) < NI5) { W = A.in[I_WOUT]; WT = (bf16_t*)(ws + WS_WOUT); K = 1024; Nsrc = 1024; nblk = 32; mode = 0; }
        else if ((r -= NI5) < NI6) { W = A.in[I_F2WI]; WT = (bf16_t*)(ws + WS_W2A); K = 1024; Nsrc = 2 * DFF; nblk = 176; mode = 1; }
        else { r -= NI6; W = A.in[I_F2WO]; WT = (bf16_t*)(ws + WS_W2B); K = DFF; Nsrc = 1024; nblk = 32; mode = 0; }
        const int kb = r / nblk, nb = r % nblk; int scol0, nvalid; tr_map(mode, nb * 32, scol0, nvalid);
        tr_item(W, K, Nsrc, WT, kb * 64, nb * 32, scol0, nvalid, scr, lane);
    }
    bf16_t* XB = (bf16_t*)(ws + WS_XB);
    const int nchunk = M * D / 8;
    for (int ch = gw * 64 + lane; ch < nchunk; ch += NGW * 64) {
        const int m = ch >> 7, c = (ch & 127) * 8;
        const float* src = (m < MP) ? A.in[I_XP] + (size_t)m * D + c : A.in[I_XS] + (size_t)(m - MP) * D + c;
        const f32x4 a = *(const f32x4*)src, b = *(const f32x4*)(src + 4);
        u32x4 w; w.x = pk2(a[0], a[1]); w.y = pk2(a[2], a[3]); w.z = pk2(b[0], b[1]); w.w = pk2(b[2], b[3]);
        *(u32x4*)(XB + (size_t)m * D + c) = w;
    }
}

__device__ __forceinline__ void ln_phase(const float* T, const float* g, const float* b, float* outf, bf16_t* outb, int gw, int NGW, int lane) {
    f32x4 gv[4], bv[4];
#pragma unroll
    for (int j = 0; j < 4; ++j) { gv[j] = *(const f32x4*)(g + 4 * lane + 256 * j); bv[j] = *(const f32x4*)(b + 4 * lane + 256 * j); }
    for (int m = gw; m < M; m += NGW) {
        const float* xr = T + (size_t)m * D + 4 * lane;
        f32x4 v[4]; float s = 0.f;
#pragma unroll
        for (int j = 0; j < 4; ++j) { v[j] = *(const f32x4*)(xr + 256 * j); s += (v[j][0] + v[j][1]) + (v[j][2] + v[j][3]); }
        const float mean = wave_sum(s) * (1.f / D); float s2 = 0.f;
#pragma unroll
        for (int j = 0; j < 4; ++j) { v[j] = v[j] - mean; s2 += (v[j][0] * v[j][0] + v[j][1] * v[j][1]) + (v[j][2] * v[j][2] + v[j][3] * v[j][3]); }
        const float rstd = 1.0f / sqrtf(wave_sum(s2) * (1.f / D) + LN_EPS);
#pragma unroll
        for (int j = 0; j < 4; ++j) {
            const f32x4 o = v[j] * rstd * gv[j] + bv[j];
            *(f32x4*)(outf + (size_t)m * D + 4 * lane + 256 * j) = o;
            if (outb) { u32x2 w; w.x = pk2(o[0], o[1]); w.y = pk2(o[2], o[3]); *(u32x2*)(outb + (size_t)m * D + 4 * lane + 256 * j) = w; }
        }
    }
}

template <int NT  , bool SAMP>
__device__ __forceinline__ void conv_item(const Args& A, int b, int t0, int cg, int lane) {
    const bf16_t* P = (const bf16_t*)(A.ws + WS_P); bf16_t* XC = (bf16_t*)(A.ws + WS_XC);
    const float* cw = A.in[I_CONVW]; const float* cb = A.in[I_CONVB];
    const int ch = (cg * 64 + lane) * 8;
    const size_t row0 = SAMP ? (size_t)(MP + b * 4) : (size_t)(b * 2048 + t0);
    u32x4 raw[NT + 3];
#pragma unroll
    for (int i = 0; i < NT + 3; ++i) {
        const int t = t0 - 3 + i;
        if (t >= 0) raw[i] = *(const u32x4*)(P + (row0 + (size_t)(i - 3)) * NP + PXBC + ch);
        else raw[i] = (u32x4){0u, 0u, 0u, 0u};
    }
    float w[4][8], bias[8];
#pragma unroll
    for (int j = 0; j < 4; ++j) { const f32x4 w0 = *(const f32x4*)(cw + (size_t)j * XCW + ch), w1 = *(const f32x4*)(cw + (size_t)j * XCW + ch + 4);
#pragma unroll
        for (int i = 0; i < 4; ++i) { w[j][i] = w0[i]; w[j][4 + i] = w1[i]; } }
    { const f32x4 b0 = *(const f32x4*)(cb + ch), b1 = *(const f32x4*)(cb + ch + 4);
#pragma unroll
      for (int i = 0; i < 4; ++i) { bias[i] = b0[i]; bias[4 + i] = b1[i]; } }
    float u0[8], u1[8], u2[8];
    if (SAMP) {
        const float* sc = A.in[I_SCONV] + (size_t)b * 3 * XCW + ch;
#pragma unroll
        for (int i = 0; i < 4; ++i) { const f32x4 a0 = *(const f32x4*)(sc), a1 = *(const f32x4*)(sc + 4), c0 = *(const f32x4*)(sc + XCW), c1 = *(const f32x4*)(sc + XCW + 4), e0 = *(const f32x4*)(sc + 2 * XCW), e1 = *(const f32x4*)(sc + 2 * XCW + 4);
            u0[i] = a0[i]; u0[4 + i] = a1[i]; u1[i] = c0[i]; u1[4 + i] = c1[i]; u2[i] = e0[i]; u2[4 + i] = e1[i]; }
    } else { unpack8(raw[0], u0); unpack8(raw[1], u1); unpack8(raw[2], u2); }
#pragma unroll
    for (int i = 0; i < NT; ++i) {
        float u3[8], o[8]; unpack8(raw[i + 3], u3);
#pragma unroll
        for (int e = 0; e < 8; ++e) o[e] = siluf_(bias[e] + w[0][e] * u0[e] + w[1][e] * u1[e] + w[2][e] * u2[e] + w[3][e] * u3[e]);
        *(u32x4*)(XC + (row0 + (size_t)i) * XCW + ch) = pack8(o);
        const int t = t0 + i; float* cs = nullptr;
        if (!SAMP) { if (t >= 2045) cs = A.out + O_CVP + ((size_t)b * 3 + (t - 2045)) * XCW + ch; }
        else { if (t >= 1) cs = A.out + O_CVS + ((size_t)b * 3 + (t - 1)) * XCW + ch; }
        if (cs) { *(f32x4*)cs = (f32x4){u3[0], u3[1], u3[2], u3[3]}; *(f32x4*)(cs + 4) = (f32x4){u3[4], u3[5], u3[6], u3[7]}; }
#pragma unroll
        for (int e = 0; e < 8; ++e) { u0[e] = u1[e]; u1[e] = u2[e]; u2[e] = u3[e]; }
    }
}
__device__ __forceinline__ void conv_phase(const Args& A, int gw, int NGW, int lane) {
    constexpr int NPI = 8 * 128 * 6, NSI = 128 * 6;
    for (int it = gw; it < NPI + NSI; it += NGW) {
        if (it < NPI) { const int cg = it % 6, r = it / 6; conv_item<16, false>(A, r >> 7, (r & 127) * 16, cg, lane); }
        else { const int r = it - NPI; conv_item<4, true>(A, r / 6, 0, r % 6, lane); }
    }
}

constexpr float IDX_SCALE = 0.125f * 0.35355339059327373f;
constexpr int SCL = 2052;
__device__ __forceinline__ unsigned f2key(float v) { unsigned u = (v == 0.f) ? 0u : __float_as_uint(v); return (u & 0x80000000u) ? ~u : (u | 0x80000000u); }
__device__ __forceinline__ void scores_select_prompt_unit(const Args& A, LAS unsigned char* lds, int b, int qt, int wave, int lane_in) {
    const bf16_t* P = (const bf16_t*)(A.ws + WS_P); const float* SMF = (const float*)(A.ws + WS_SMF);
    unsigned long long* MASKW = (unsigned long long*)(A.ws + WS_SC);
    LAS float* sc = (LAS float*)lds;
    int lane = lane_in; asm volatile("" : "+v"(lane));
    const int fr = lane & 15, fq = lane >> 4;
    {
        const size_t rowq = (size_t)(b * 2048 + qt * 16 + fr);
        bf16x8 Af[8][2];
#pragma unroll
        for (int h = 0; h < 8; ++h)
#pragma unroll
            for (int ks = 0; ks < 2; ++ks) Af[h][ks] = *(const bf16x8*)(P + rowq * NP + PQI + h * 64 + ks * 32 + 8 * fq);
        float wq[4][8];
#pragma unroll
        for (int j = 0; j < 4; ++j) { const float* wp = SMF + (size_t)(b * 2048 + qt * 16 + 4 * fq + j) * 128 + 32; const f32x4 w0 = *(const f32x4*)wp, w1 = *(const f32x4*)(wp + 4);
#pragma unroll
            for (int h = 0; h < 4; ++h) { wq[j][h] = w0[h] * IDX_SCALE; wq[j][4 + h] = w1[h] * IDX_SCALE; } }
        const bf16_t* kbase = P + (size_t)(b * 2048 + fr) * NP + PSM + 64 + 8 * fq;
        bf16x8 nB0 = {0, 0, 0, 0, 0, 0, 0, 0}, nB1 = nB0;
        if (wave <= qt) { const bf16_t* kp = kbase + (size_t)wave * 16 * NP; nB0 = *(const bf16x8*)kp; nB1 = *(const bf16x8*)(kp + 32); }
        for (int kt = wave; kt <= qt; kt += NWAVES) {
            const bf16x8 B0 = nB0, B1 = nB1;
            if (kt + NWAVES <= qt) { const bf16_t* kp = kbase + (size_t)(kt + NWAVES) * 16 * NP; nB0 = *(const bf16x8*)kp; nB1 = *(const bf16x8*)(kp + 32); }
            f32x4 scv = {0.f, 0.f, 0.f, 0.f};
#pragma unroll
            for (int h = 0; h < 8; ++h) { f32x4 d = {0.f, 0.f, 0.f, 0.f}; d = mfma16(Af[h][0], B0, d); d = mfma16(Af[h][1], B1, d);
#pragma unroll
                for (int j = 0; j < 4; ++j) scv[j] += wq[j][h] * fmaxf(d[j], 0.f); }
#pragma unroll
            for (int j = 0; j < 4; ++j) sc[(4 * fq + j) * SCL + kt * 16 + fr] = scv[j];
#if MK_CHECK_ATT
#pragma unroll
            for (int j = 0; j < 4; ++j) ((float*)(A.ws + WS_END))[(size_t)(b * 2048 + qt * 16 + 4 * fq + j) * SCW + kt * 16 + fr] = scv[j];
#endif
        }
    }
    __syncthreads();
#pragma unroll 1
    for (int u = 0; u < 2; ++u) {
        const int ql = 2 * wave + u, t = qt * 16 + ql, nvalid = t + 1;
        const LAS float* srow = sc + ql * SCL + lane;
        unsigned key[32];
#pragma unroll
        for (int j = 0; j < 32; ++j) key[j] = (lane < nvalid - 64 * j) ? f2key(srow[64 * j]) : 0u;
        unsigned T = 0u; int need_eq = 0;
        if (nvalid > 256) {
            bool exact = false;
            for (int bit = 31; bit >= 0; --bit) {
                const unsigned cand = T | (1u << bit); int cnt = 0;
#pragma unroll
                for (int j = 0; j < 32; ++j) cnt += __popcll(__ballot(key[j] >= cand));
                if (cnt >= 256) { T = cand; if (cnt == 256) { exact = true; break; } }
            }
            if (exact) { T -= 1u; }
            else { int cgt = 0;
#pragma unroll
                for (int j = 0; j < 32; ++j) cgt += __popcll(__ballot(key[j] > T));
                need_eq = 256 - cgt; }
        }
        int eqused = 0; unsigned long long mine = 0ull;
#pragma unroll
        for (int j = 0; j < 32; ++j) {
            unsigned long long ms;
            if (need_eq > 0) {
                const bool gt = key[j] > T, eq = key[j] == T;
                const unsigned long long meq = __ballot(eq);
                const bool sel = gt || (eq && (eqused + mbcnt64(meq) < need_eq));
                eqused += __popcll(meq);
                ms = __ballot(sel);
            } else ms = __ballot(key[j] > T);
            if (lane == j) mine = ms;
        }
        if (lane < 32) MASKW[(size_t)(b * 2048 + t) * 32 + lane] = mine;
    }
    __syncthreads();
}
__device__ __forceinline__ void scores_sample_unit(const Args& A, int b, int half, int wave, int lane) {
    const bf16_t* P = (const bf16_t*)(A.ws + WS_P); const float* SMF = (const float*)(A.ws + WS_SMF); float* SCS = (float*)(A.ws + WS_SCS);
    const int* pt = (const int*)A.in[I_PT]; const float* cki = A.in[I_CKI];
    const int fr = lane & 15, fq = lane >> 4;
    bf16x8 Af[2][2]; float wq[2][4];
#pragma unroll
    for (int mt = 0; mt < 2; ++mt) {
#pragma unroll
        for (int ks = 0; ks < 2; ++ks) Af[mt][ks] = *(const bf16x8*)(P + (size_t)(MP + b * 4 + 2 * mt + (fr >> 3)) * NP + PQI + (fr & 7) * 64 + ks * 32 + 8 * fq);
        const f32x4 w = *(const f32x4*)(SMF + (size_t)(MP + b * 4 + 2 * mt + (fq >> 1)) * 128 + 32 + 4 * (fq & 1));
#pragma unroll
        for (int j = 0; j < 4; ++j) wq[mt][j] = w[j] * IDX_SCALE;
    }
    const int kt_end = (half == 0) ? 65 : 129;
    for (int kt = half * 65 + wave; kt < kt_end; kt += NWAVES) {
        const int key = kt * 16 + fr;
        bf16x8 B0, B1;
        if (key < 2048) {
            const int page = pt[b * 16 + (key >> 7)];
            const float* src = cki + ((size_t)page * 128 + (key & 127)) * 64 + 8 * fq;
            const f32x4 a0 = *(const f32x4*)src, a1 = *(const f32x4*)(src + 4), c0 = *(const f32x4*)(src + 32), c1 = *(const f32x4*)(src + 36);
            u32x4 w0, w1; w0.x = pk2(a0[0], a0[1]); w0.y = pk2(a0[2], a0[3]); w0.z = pk2(a1[0], a1[1]); w0.w = pk2(a1[2], a1[3]);
            w1.x = pk2(c0[0], c0[1]); w1.y = pk2(c0[2], c0[3]); w1.z = pk2(c1[0], c1[1]); w1.w = pk2(c1[2], c1[3]);
            B0 = __builtin_bit_cast(bf16x8, w0); B1 = __builtin_bit_cast(bf16x8, w1);
        } else if (key < 2052) {
            const bf16_t* src = P + (size_t)(MP + b * 4 + (key - 2048)) * NP + PSM + 64 + 8 * fq;
            B0 = *(const bf16x8*)src; B1 = *(const bf16x8*)(src + 32);
        } else { B0 = (bf16x8){0, 0, 0, 0, 0, 0, 0, 0}; B1 = B0; }
#pragma unroll
        for (int mt = 0; mt < 2; ++mt) {
            f32x4 d = {0.f, 0.f, 0.f, 0.f}; d = mfma16(Af[mt][0], B0, d); d = mfma16(Af[mt][1], B1, d);
            float s = 0.f;
#pragma unroll
            for (int j = 0; j < 4; ++j) s += wq[mt][j] * fmaxf(d[j], 0.f);
            s += __shfl_xor(s, 16);
            if ((fq & 1) == 0 && key < 2052) SCS[(size_t)(b * 4 + 2 * mt + (fq >> 1)) * SCSW + key] = s;
        }
    }
}

__device__ __forceinline__ float softplusf_(float x) { return fmaxf(x, 0.f) + log1pf(expf(-fabsf(x))); }
__device__ __forceinline__ void ssd_prompt_item(const Args& A, LAS unsigned char* lds, int b, int h) {
    const int tid = threadIdx.x, lane = tid & 63, wave = __builtin_amdgcn_readfirstlane(tid >> 6), fr = lane & 15, fq = lane >> 4;
    const int g = h >> 3;
    const bf16_t* XC = (const bf16_t*)(A.ws + WS_XC); const float* SMF = (const float*)(A.ws + WS_SMF); bf16_t* Y = (bf16_t*)(A.ws + WS_Y);
    LAS bf16_t* Cm = (LAS bf16_t*)lds;
    LAS bf16_t* Bm = Cm + 64 * 136;
    LAS bf16_t* Btw = Bm + 64 * 136;
    LAS bf16_t* Xt = Btw + 128 * 72;
    LAS bf16_t* Mt = Xt + 64 * 72;
    LAS bf16_t* Hp = Mt + 64 * 72;
    LAS float* cumA = (LAS float*)(Hp + 64 * 136);
    LAS float* dtvA = cumA + 2048; LAS float* wvA = dtvA + 2048; LAS float* ecumA = wvA + 2048;
    const float Ah = -expf(A.in[I_ALOG][h]), dtb = A.in[I_DTB][h], dsk = A.in[I_DSKIP][h];
    f32x4 hst[4];
#pragma unroll
    for (int i = 0; i < 4; ++i) hst[i] = (f32x4){0.f, 0.f, 0.f, 0.f};
    for (int i = tid; i < 64 * 136 / 8; i += NTHR) *(LAS u32x4*)(Hp + i * 8) = (u32x4){0u, 0u, 0u, 0u};
#pragma unroll 1
    for (int c = wave; c < 32; c += NWAVES) {
        const int tk = c * 64 + lane;
        const float dt = softplusf_(SMF[(size_t)(b * 2048 + tk) * 128 + h] + dtb);
        float v = dt * Ah;
#pragma unroll
        for (int o = 1; o < 64; o <<= 1) { const float n = __shfl_up(v, o); if (lane >= o) v += n; }
        const float ce = __shfl(v, 63);
        cumA[tk] = v; dtvA[tk] = dt; wvA[tk] = dt * expf(ce - v); ecumA[tk] = expf(v);
    }
    const int s0 = tid >> 4, part0 = tid & 15;
    const int xs = tid >> 3, xpart = tid & 7;
    u32x4 cr[2], br[2], xr;
    {
#pragma unroll
        for (int i = 0; i < 2; ++i) { const bf16_t* rp = XC + (size_t)(b * 2048 + s0 + 32 * i) * XCW + g * 128 + part0 * 8; cr[i] = *(const u32x4*)(rp + 2560); br[i] = *(const u32x4*)(rp + 2048); }
        xr = *(const u32x4*)(XC + (size_t)(b * 2048 + xs) * XCW + h * 64 + xpart * 8);
    }
    for (int c = 0; c < 32; ++c) {
        const int row0 = b * 2048 + c * 64;
        const LAS float* cum = cumA + c * 64; const LAS float* dtv = dtvA + c * 64; const LAS float* wv = wvA + c * 64; const LAS float* ecum = ecumA + c * 64;
        __syncthreads();
#pragma unroll
        for (int i = 0; i < 2; ++i) {
            const int s = s0 + 32 * i;
            *(LAS u32x4*)(Cm + s * 136 + part0 * 8) = cr[i];
            *(LAS u32x4*)(Bm + s * 136 + part0 * 8) = br[i];
            float bf[8]; unpack8(br[i], bf); const float w = wv[s];
#pragma unroll
            for (int e = 0; e < 8; ++e) Btw[(part0 * 8 + e) * 72 + s] = (bf16_t)f2bf(bf[e] * w);
        }
        {
#pragma unroll
            for (int e = 0; e < 4; ++e) { Xt[(xpart * 8 + 2 * e) * 72 + xs] = (bf16_t)(xr[e] & 0xffffu); Xt[(xpart * 8 + 2 * e + 1) * 72 + xs] = (bf16_t)(xr[e] >> 16); }
        }
#pragma unroll
        for (int p4 = 0; p4 < 4; ++p4) { u32x2 w; w.x = pk2(hst[p4][0], hst[p4][1]); w.y = pk2(hst[p4][2], hst[p4][3]);
            *(LAS u32x2*)(Hp + (16 * p4 + fr) * 136 + 16 * wave + 4 * fq) = w; }
        if (c + 1 < 32) {
#pragma unroll
            for (int i = 0; i < 2; ++i) { const bf16_t* rp = XC + (size_t)(row0 + 64 + s0 + 32 * i) * XCW + g * 128 + part0 * 8; cr[i] = *(const u32x4*)(rp + 2560); br[i] = *(const u32x4*)(rp + 2048); }
            xr = *(const u32x4*)(XC + (size_t)(row0 + 64 + xs) * XCW + h * 64 + xpart * 8);
        }
        __syncthreads();
        {
            const int st = wave >> 1, tt0 = 2 * (wave & 1);
            bf16x8 a[4];
#pragma unroll
            for (int ks = 0; ks < 4; ++ks) a[ks] = *(const LAS bf16x8*)(Bm + (16 * st + fr) * 136 + ks * 32 + 8 * fq);
#pragma unroll
            for (int u = 0; u < 2; ++u) {
                const int tt = tt0 + u; f32x4 d = {0.f, 0.f, 0.f, 0.f};
#pragma unroll
                for (int ks = 0; ks < 4; ++ks) { const bf16x8 bb = *(const LAS bf16x8*)(Cm + (16 * tt + fr) * 136 + ks * 32 + 8 * fq); d = mfma16(a[ks], bb, d); }
                const int t = 16 * tt + fr; const float ct = cum[t]; float mv[4];
#pragma unroll
                for (int j = 0; j < 4; ++j) { const int s = 16 * st + 4 * fq + j; mv[j] = (s <= t) ? d[j] * __expf(ct - cum[s]) * dtv[s] : 0.f; }
                u32x2 w; w.x = pk2(mv[0], mv[1]); w.y = pk2(mv[2], mv[3]);
                *(LAS u32x2*)(Mt + t * 72 + 16 * st + 4 * fq) = w;
            }
        }
        __syncthreads();
        {
            const int pt = wave >> 1, tt0 = 2 * (wave & 1);
            bf16x8 a1[2], a2[4];
#pragma unroll
            for (int ks = 0; ks < 2; ++ks) a1[ks] = *(const LAS bf16x8*)(Xt + (16 * pt + fr) * 72 + ks * 32 + 8 * fq);
#pragma unroll
            for (int ks = 0; ks < 4; ++ks) a2[ks] = *(const LAS bf16x8*)(Hp + (16 * pt + fr) * 136 + ks * 32 + 8 * fq);
#pragma unroll
            for (int u = 0; u < 2; ++u) {
                const int tt = tt0 + u; f32x4 d1 = {0.f, 0.f, 0.f, 0.f}, d2 = {0.f, 0.f, 0.f, 0.f};
#pragma unroll
                for (int ks = 0; ks < 2; ++ks) { const bf16x8 bb = *(const LAS bf16x8*)(Mt + (16 * tt + fr) * 72 + ks * 32 + 8 * fq); d1 = mfma16(a1[ks], bb, d1); }
#pragma unroll
                for (int ks = 0; ks < 4; ++ks) { const bf16x8 bb = *(const LAS bf16x8*)(Cm + (16 * tt + fr) * 136 + ks * 32 + 8 * fq); d2 = mfma16(a2[ks], bb, d2); }
                const int t = 16 * tt + fr; const float et = ecum[t]; float yv[4];
#pragma unroll
                for (int j = 0; j < 4; ++j) { const int p = 16 * pt + 4 * fq + j; yv[j] = d1[j] + et * d2[j] + dsk * bf2f((unsigned)Xt[p * 72 + t]); }
                u32x2 w; w.x = pk2(yv[0], yv[1]); w.y = pk2(yv[2], yv[3]);
                *(u32x2*)(Y + (size_t)(row0 + t) * DI + h * 64 + 16 * pt + 4 * fq) = w;
            }
            bf16x8 a3[2];
#pragma unroll
            for (int ks = 0; ks < 2; ++ks) a3[ks] = *(const LAS bf16x8*)(Btw + (16 * wave + fr) * 72 + ks * 32 + 8 * fq);
            const float dec = ecum[63];
#pragma unroll
            for (int p4 = 0; p4 < 4; ++p4) { f32x4 d = {0.f, 0.f, 0.f, 0.f};
#pragma unroll
                for (int ks = 0; ks < 2; ++ks) { const bf16x8 bb = *(const LAS bf16x8*)(Xt + (16 * p4 + fr) * 72 + ks * 32 + 8 * fq); d = mfma16(a3[ks], bb, d); }
                hst[p4] = hst[p4] * dec + d; }
        }
    }
    float* so = A.out + O_SSP + ((size_t)b * 32 + h) * 64 * 128;
#pragma unroll
    for (int p4 = 0; p4 < 4; ++p4) *(f32x4*)(so + (size_t)(16 * p4 + fr) * 128 + 16 * wave + 4 * fq) = hst[p4];
    __syncthreads();
}

__device__ __forceinline__ void ssd_sample_item(const Args& A, LAS unsigned char* wl, int b, int h, int lane) {
    const bf16_t* XC = (const bf16_t*)(A.ws + WS_XC); const float* SMF = (const float*)(A.ws + WS_SMF); bf16_t* Y = (bf16_t*)(A.ws + WS_Y);
    LAS float* red = (LAS float*)wl;
    const int g = h >> 3;
    const float Ah = -expf(A.in[I_ALOG][h]), dtb = A.in[I_DTB][h], dsk = A.in[I_DSKIP][h];
#pragma unroll 1
    for (int half = 0; half < 2; ++half) {
        const float* h0 = A.in[I_SSSM] + (((size_t)b * 32 + h) * 64 + 32 * half) * 128 + 2 * lane;
        float st[32][2];
#pragma unroll
        for (int p = 0; p < 32; ++p) { const float2 v = *(const float2*)(h0 + p * 128); st[p][0] = v.x; st[p][1] = v.y; }
#pragma unroll 1
        for (int t = 0; t < 4; ++t) {
            const size_t m = (size_t)(MP + b * 4 + t);
            const float dt = softplusf_(SMF[m * 128 + h] + dtb), dec = expf(dt * Ah);
            const unsigned bw = *(const unsigned*)(XC + m * XCW + 2048 + g * 128 + 2 * lane), cw = *(const unsigned*)(XC + m * XCW + 2560 + g * 128 + 2 * lane);
            const float b0 = bf2f(bw & 0xffffu) * dt, b1 = __uint_as_float(bw & 0xffff0000u) * dt, c0 = bf2f(cw & 0xffffu), c1 = __uint_as_float(cw & 0xffff0000u);
            const float xl = bf2f((unsigned)XC[m * XCW + h * 64 + 32 * half + (lane & 31)]);
#pragma unroll
            for (int p = 0; p < 32; ++p) {
                const float xp = __shfl(xl, p);
                st[p][0] = st[p][0] * dec + xp * b0; st[p][1] = st[p][1] * dec + xp * b1;
                red[p * 65 + lane] = st[p][0] * c0 + st[p][1] * c1;
            }
            asm volatile("s_waitcnt lgkmcnt(0)" ::: "memory");
            float y = 0.f;
#pragma unroll 16
            for (int i = 0; i < 64; ++i) y += red[(lane & 31) * 65 + i];
            y += dsk * xl;
            if (lane < 32) Y[m * DI + h * 64 + 32 * half + lane] = (bf16_t)f2bf(y);
            asm volatile("s_waitcnt lgkmcnt(0)" ::: "memory");
        }
        float* so = A.out + O_SSS + (((size_t)b * 32 + h) * 64 + 32 * half) * 128 + 2 * lane;
#pragma unroll
        for (int p = 0; p < 32; ++p) *(float2*)(so + p * 128) = make_float2(st[p][0], st[p][1]);
    }
}

__device__ __forceinline__ int t5_bucket(int n) {
    if (n < 16) return n;
    const float nf = (float)n;
    int large = 16 + (int)(logf(nf / 16.0f) / 2.0794415416798357f * 16.0f);
    return large < 31 ? large : 31;
}
typedef float f32x16 __attribute__((ext_vector_type(16)));
__device__ __forceinline__ f32x16 mfma32(bf16x8 a, bf16x8 b, f32x16 c) { return __builtin_amdgcn_mfma_f32_32x32x16_bf16(a, b, c, 0, 0, 0); }
constexpr float LOG2E = 1.4426950408889634f;
constexpr int AK_STR = 72, AV_STR = 68, AT_K0 = 0, AT_V0 = 2 * 64 * AK_STR * 2, AT_WS = AT_V0 + 2 * 64 * AV_STR * 2;
__device__ __forceinline__ void attn_prompt_unit(const Args& A, LAS unsigned char* lds, const LAS float* biasL, int b, int g, int qt, int wave, int lane_in) {
    const bf16_t* P = (const bf16_t*)(A.ws + WS_P); const unsigned* MASK32 = (const unsigned*)(A.ws + WS_SC); bf16_t* YA = (bf16_t*)(A.ws + WS_YA);
    int lane = lane_in; asm volatile("" : "+v"(lane));
    const int tid = wave * 64 + lane, r32 = lane & 31, hi = lane >> 5;
    LAS float* wsc = (LAS float*)(lds + AT_WS) + wave * 64;
    const int query = qt * 64 + 8 * wave + (r32 >> 2), head = 4 * g + (r32 & 3);
    const size_t qrow = (size_t)(b * 2048 + query);
    bf16x8 qf[4];
#pragma unroll
    for (int ds = 0; ds < 4; ++ds) qf[ds] = *(const bf16x8*)(P + qrow * NP + PQ + head * 64 + 16 * ds + 8 * hi);
    const unsigned* mrow = MASK32 + qrow * 64;
    const float bfar = biasL[128 * 16 + head];
    const int skey = tid >> 3, sdch = tid & 7;
    const bf16_t* ksrc = P + (size_t)(b * 2048 + skey) * NP + PK + g * 64 + sdch * 8;
    f32x16 O0, O1;
#pragma unroll
    for (int i = 0; i < 16; ++i) { O0[i] = 0.f; O1[i] = 0.f; }
    float m_run = -1e30f, l_run = 0.f;
    u32x4 kreg = *(const u32x4*)ksrc, vreg = *(const u32x4*)(ksrc + 256);
    unsigned mw0 = mrow[0], mw1 = mrow[1];
    {
        LAS bf16_t* Kb = (LAS bf16_t*)(lds + AT_K0); LAS bf16_t* Vb = (LAS bf16_t*)(lds + AT_V0);
        *(LAS u32x4*)(Kb + skey * AK_STR + sdch * 8) = kreg;
#pragma unroll
        for (int e = 0; e < 4; ++e) { Vb[(sdch * 8 + 2 * e) * AV_STR + skey] = (bf16_t)(vreg[e] & 0xffffu); Vb[(sdch * 8 + 2 * e + 1) * AV_STR + skey] = (bf16_t)(vreg[e] >> 16); }
    }
    for (int kt = 0; kt <= qt; ++kt) {
        const int buf = kt & 1;
        __syncthreads();
        const unsigned w0 = mw0 >> (4 * hi), w1 = mw1 >> (4 * hi);
        if (kt < qt) { const bf16_t* src = ksrc + (size_t)(kt + 1) * 64 * NP; kreg = *(const u32x4*)src; vreg = *(const u32x4*)(src + 256); mw0 = mrow[2 * kt + 2]; mw1 = mrow[2 * kt + 3]; }
        const LAS bf16_t* Kb = (const LAS bf16_t*)(lds + AT_K0 + buf * (64 * AK_STR * 2)); const LAS bf16_t* Vb = (const LAS bf16_t*)(lds + AT_V0 + buf * (64 * AV_STR * 2));
        f32x16 S0, S1;
#pragma unroll
        for (int i = 0; i < 16; ++i) { S0[i] = 0.f; S1[i] = 0.f; }
#pragma unroll
        for (int ds = 0; ds < 4; ++ds) {
            const bf16x8 k0 = *(const LAS bf16x8*)(Kb + r32 * AK_STR + 16 * ds + 8 * hi), k1 = *(const LAS bf16x8*)(Kb + (32 + r32) * AK_STR + 16 * ds + 8 * hi);
            S0 = mfma32(k0, qf[ds], S0); S1 = mfma32(k1, qf[ds], S1);
        }
        const float c1 = 0.125f * LOG2E;
        if (qt - kt >= 3) {
#pragma unroll
            for (int i = 0; i < 16; ++i) { const unsigned bit = 1u << ((i & 3) + 8 * (i >> 2));
                S0[i] = (w0 & bit) ? S0[i] * c1 + bfar : -INFINITY; S1[i] = (w1 & bit) ? S1[i] * c1 + bfar : -INFINITY; }
        } else {
            const int kbase = kt * 64 + 4 * hi;
#pragma unroll
            for (int i = 0; i < 16; ++i) { const int pos = (i & 3) + 8 * (i >> 2); const unsigned bit = 1u << pos;
                int r0 = query - (kbase + pos), r1 = r0 - 32; r0 = r0 < 0 ? 0 : (r0 > 128 ? 128 : r0); r1 = r1 < 0 ? 0 : (r1 > 128 ? 128 : r1);
                S0[i] = (w0 & bit) ? S0[i] * c1 + biasL[r0 * 16 + head] : -INFINITY; S1[i] = (w1 & bit) ? S1[i] * c1 + biasL[r1 * 16 + head] : -INFINITY; }
        }
        float tm = fmaxf(S0[0], S1[0]);
#pragma unroll
        for (int i = 1; i < 16; ++i) tm = fmaxf(tm, fmaxf(S0[i], S1[i]));
        tm = fmaxf(tm, __shfl_xor(tm, 32));
        if (__any(tm > m_run + 8.0f)) {
            const float mn = fmaxf(m_run, tm), f = __builtin_amdgcn_exp2f(m_run - mn);
            m_run = mn; l_run *= f;
            if (hi == 0) wsc[r32] = f;
            asm volatile("s_waitcnt lgkmcnt(0)" ::: "memory");
#pragma unroll
            for (int i = 0; i < 16; ++i) { const float fi = wsc[(i & 3) + 8 * (i >> 2) + 4 * hi]; O0[i] *= fi; O1[i] *= fi; }
            asm volatile("s_waitcnt lgkmcnt(0)" ::: "memory");
        }
        float ls = 0.f;
#pragma unroll
        for (int i = 0; i < 16; ++i) { S0[i] = __builtin_amdgcn_exp2f(S0[i] - m_run); S1[i] = __builtin_amdgcn_exp2f(S1[i] - m_run); ls += S0[i] + S1[i]; }
        l_run += ls;
        bf16x8 pa[2][2];
#pragma unroll
        for (int sk = 0; sk < 2; ++sk) {
            u32x4 a0, a1;
            a0.x = pk2(S0[8 * sk + 0], S0[8 * sk + 1]); a0.y = pk2(S0[8 * sk + 2], S0[8 * sk + 3]); a0.z = pk2(S0[8 * sk + 4], S0[8 * sk + 5]); a0.w = pk2(S0[8 * sk + 6], S0[8 * sk + 7]);
            a1.x = pk2(S1[8 * sk + 0], S1[8 * sk + 1]); a1.y = pk2(S1[8 * sk + 2], S1[8 * sk + 3]); a1.z = pk2(S1[8 * sk + 4], S1[8 * sk + 5]); a1.w = pk2(S1[8 * sk + 6], S1[8 * sk + 7]);
            pa[0][sk] = __builtin_bit_cast(bf16x8, a0); pa[1][sk] = __builtin_bit_cast(bf16x8, a1);
        }
#pragma unroll
        for (int blk = 0; blk < 2; ++blk)
#pragma unroll
            for (int sk = 0; sk < 2; ++sk) {
                const int kb = 32 * blk + 16 * sk + 4 * hi;
                const u32x2 a = *(const LAS u32x2*)(Vb + r32 * AV_STR + kb), c = *(const LAS u32x2*)(Vb + r32 * AV_STR + kb + 8);
                const u32x2 a2 = *(const LAS u32x2*)(Vb + (32 + r32) * AV_STR + kb), c2 = *(const LAS u32x2*)(Vb + (32 + r32) * AV_STR + kb + 8);
                const u32x4 v0 = {a.x, a.y, c.x, c.y}, v1 = {a2.x, a2.y, c2.x, c2.y};
                O0 = mfma32(pa[blk][sk], __builtin_bit_cast(bf16x8, v0), O0);
                O1 = mfma32(pa[blk][sk], __builtin_bit_cast(bf16x8, v1), O1);
            }
        if (kt < qt) {
            LAS bf16_t* Kn = (LAS bf16_t*)(lds + AT_K0 + (buf ^ 1) * (64 * AK_STR * 2)); LAS bf16_t* Vn = (LAS bf16_t*)(lds + AT_V0 + (buf ^ 1) * (64 * AV_STR * 2));
            *(LAS u32x4*)(Kn + skey * AK_STR + sdch * 8) = kreg;
#pragma unroll
            for (int e = 0; e < 4; ++e) { Vn[(sdch * 8 + 2 * e) * AV_STR + skey] = (bf16_t)(vreg[e] & 0xffffu); Vn[(sdch * 8 + 2 * e + 1) * AV_STR + skey] = (bf16_t)(vreg[e] >> 16); }
        }
    }
    l_run += __shfl_xor(l_run, 32);
    if (hi == 0) wsc[r32] = 1.0f / l_run;
    asm volatile("s_waitcnt lgkmcnt(0)" ::: "memory");
#pragma unroll
    for (int i = 0; i < 16; ++i) {
        const int rq = (i & 3) + 8 * (i >> 2) + 4 * hi; const float inv = wsc[rq];
        bf16_t* dst = YA + (size_t)(b * 2048 + qt * 64 + 8 * wave + (rq >> 2)) * D + (4 * g + (rq & 3)) * 64 + r32;
        dst[0] = (bf16_t)f2bf(O0[i] * inv); dst[32] = (bf16_t)f2bf(O1[i] * inv);
    }
    __syncthreads();
}

__device__ __forceinline__ void attend_sample_task(const Args& A, LAS unsigned char* wl, const LAS float* biasrel, int ms, int g, int lane_in) {
    constexpr int NJ = 33;
    int lane = lane_in; asm volatile("" : "+v"(lane));
    const bf16_t* P = (const bf16_t*)(A.ws + WS_P);
    const int b = ms >> 2, t = ms & 3, nvalid = 2049 + t, qpos = 2048 + t, m = MP + ms;
    const float* srow = (const float*)(A.ws + WS_SCS) + (size_t)ms * SCSW;
    LAS float* pq = (LAS float*)wl;
    LAS unsigned* rowid = (LAS unsigned*)(wl + 4096);
    LAS unsigned short* posl = (LAS unsigned short*)(wl + 4096 + 1024);
    unsigned key[NJ];
#pragma unroll
    for (int j = 0; j < NJ; ++j) key[j] = (lane < nvalid - 64 * j) ? f2key(srow[lane + 64 * j]) : 0u;
    unsigned T = 0u; int need_eq = 0;
    {
        bool exact = false;
        for (int bit = 31; bit >= 0; --bit) {
            const unsigned cand = T | (1u << bit); int cnt = 0;
#pragma unroll
            for (int j = 0; j < NJ; ++j) cnt += __popcll(__ballot(key[j] >= cand));
            if (cnt >= 256) { T = cand; if (cnt == 256) { exact = true; break; } }
        }
        if (exact) { T -= 1u; }
        else { int cgt = 0;
#pragma unroll
            for (int j = 0; j < NJ; ++j) cgt += __popcll(__ballot(key[j] > T));
            need_eq = 256 - cgt; }
    }
    int base = 0, eqused = 0;
    const int* pt = (const int*)A.in[I_PT];
#pragma unroll
    for (int j = 0; j < NJ; ++j) {
        const bool gt = key[j] > T, eq = (need_eq > 0) && (key[j] == T);
        const unsigned long long meq = __ballot(eq);
        const bool sel = gt || (eq && (eqused + mbcnt64(meq) < need_eq));
        eqused += __popcll(meq);
        const unsigned long long msk = __ballot(sel);
        if (sel) { const int pos = lane + 64 * j, k = base + mbcnt64(msk);
            posl[k] = (unsigned short)pos;
            rowid[k] = (pos < 2048) ? (unsigned)(pt[b * 16 + (pos >> 7)] * 128 + (pos & 127)) : (0x80000000u | (unsigned)(b * 4 + pos - 2048)); }
        base += __popcll(msk);
    }
    { const u32x2 w = *(const u32x2*)(P + (size_t)m * NP + PQ + g * 256 + lane * 4);
      *(LAS f32x4*)(pq + lane * 4) = (f32x4){__uint_as_float(w.x << 16), __uint_as_float(w.x & 0xffff0000u), __uint_as_float(w.y << 16), __uint_as_float(w.y & 0xffff0000u)}; }
    asm volatile("s_waitcnt lgkmcnt(0)" ::: "memory");
    const float* ck = A.in[I_CK]; const float* cv = A.in[I_CV]; const float* kn = A.out + O_KS; const float* vn = A.out + O_VS;
    const float* kp[4]; int rel[4];
#pragma unroll
    for (int i = 0; i < 4; ++i) { const unsigned rid = rowid[lane + 64 * i]; rel[i] = qpos - (int)posl[lane + 64 * i];
        kp[i] = ((rid & 0x80000000u) ? kn + (size_t)(rid & 0x7fffffffu) * 256 : ck + (size_t)rid * 256) + g * 64; }
    float acc[4][4];
#pragma unroll
    for (int i = 0; i < 4; ++i)
#pragma unroll
        for (int hh = 0; hh < 4; ++hh) acc[i][hh] = 0.f;
#pragma unroll 2
    for (int dc = 0; dc < 16; ++dc) {
        f32x4 kv[4];
#pragma unroll
        for (int i = 0; i < 4; ++i) kv[i] = *(const f32x4*)(kp[i] + dc * 4);
#pragma unroll
        for (int hh = 0; hh < 4; ++hh) { const f32x4 q4 = *(const LAS f32x4*)(pq + hh * 64 + dc * 4);
#pragma unroll
            for (int i = 0; i < 4; ++i) acc[i][hh] += kv[i][0] * q4[0] + kv[i][1] * q4[1] + kv[i][2] * q4[2] + kv[i][3] * q4[3]; }
    }
    asm volatile("s_waitcnt lgkmcnt(0)" ::: "memory");
#pragma unroll
    for (int i = 0; i < 4; ++i) { const int rc = rel[i] < 128 ? (rel[i] < 0 ? 0 : rel[i]) : 128; const f32x4 bv = *(const LAS f32x4*)(biasrel + rc * 16 + 4 * g);
#pragma unroll
        for (int hh = 0; hh < 4; ++hh) acc[i][hh] = acc[i][hh] * 0.125f + bv[hh]; }
#pragma unroll
    for (int hh = 0; hh < 4; ++hh) {
        const float mx = wave_max(fmaxf(fmaxf(acc[0][hh], acc[1][hh]), fmaxf(acc[2][hh], acc[3][hh])));
        float sm = 0.f;
#pragma unroll
        for (int i = 0; i < 4; ++i) { acc[i][hh] = __expf(acc[i][hh] - mx); sm += acc[i][hh]; }
        const float inv = 1.0f / wave_sum(sm);
#pragma unroll
        for (int i = 0; i < 4; ++i) acc[i][hh] *= inv;
    }
#pragma unroll
    for (int i = 0; i < 4; ++i) *(LAS f32x4*)(pq + (lane + 64 * i) * 4) = (f32x4){acc[i][0], acc[i][1], acc[i][2], acc[i][3]};
    asm volatile("s_waitcnt lgkmcnt(0)" ::: "memory");
    float o[4] = {0.f, 0.f, 0.f, 0.f};
    for (int k0 = 0; k0 < 256; k0 += 8) {
        float vv[8]; f32x4 pp[8];
#pragma unroll
        for (int u = 0; u < 8; ++u) { const unsigned rid = rowid[k0 + u];
            const float* vp = ((rid & 0x80000000u) ? vn + (size_t)(rid & 0x7fffffffu) * 256 : cv + (size_t)rid * 256) + g * 64 + lane;
            vv[u] = *vp; pp[u] = *(const LAS f32x4*)(pq + (k0 + u) * 4); }
#pragma unroll
        for (int u = 0; u < 8; ++u)
#pragma unroll
            for (int hh = 0; hh < 4; ++hh) o[hh] += pp[u][hh] * vv[u];
    }
    bf16_t* YA = (bf16_t*)(A.ws + WS_YA);
#pragma unroll
    for (int hh = 0; hh < 4; ++hh) YA[(size_t)m * D + (4 * g + hh) * 64 + lane] = (bf16_t)f2bf(o[hh]);
    asm volatile("s_waitcnt lgkmcnt(0)" ::: "memory");
}

#if MK_CHECK_ATT
constexpr size_t WS_CHK_SC = WS_END, WS_CHK_YA = WS_CHK_SC + 128 * MiB, WS_CHK_MASK = WS_CHK_YA + 33 * MiB, WS_CHK_END = WS_CHK_MASK + 4 * MiB;
constexpr int CW_CHK = 512;
template <bool SAMPLE> struct KVRow;
template <> struct KVRow<false> {
    typedef const bf16_t* ptr;
    const bf16_t* P;
    __device__ __forceinline__ ptr krow(unsigned rid) const { return P + (size_t)rid * NP + PK; }
    __device__ __forceinline__ ptr vrow(unsigned rid) const { return P + (size_t)rid * NP + PV; }
    static __device__ __forceinline__ void k8(ptr p, float (&f)[8]) { unpack8(*(const u32x4*)p, f); }
    static __device__ __forceinline__ f32x4 v4(ptr p) { const u32x2 w = *(const u32x2*)p;
        return (f32x4){__uint_as_float(w.x << 16), __uint_as_float(w.x & 0xffff0000u), __uint_as_float(w.y << 16), __uint_as_float(w.y & 0xffff0000u)}; }
};
template <> struct KVRow<true> {
    typedef const float* ptr;
    const float* ck; const float* cv; const float* kn; const float* vn;
    __device__ __forceinline__ ptr krow(unsigned rid) const { return (rid & 0x80000000u) ? kn + (size_t)(rid & 0x7fffffffu) * 256 : ck + (size_t)rid * 256; }
    __device__ __forceinline__ ptr vrow(unsigned rid) const { return (rid & 0x80000000u) ? vn + (size_t)(rid & 0x7fffffffu) * 256 : cv + (size_t)rid * 256; }
    static __device__ __forceinline__ void k8(ptr p, float (&f)[8]) { const f32x4 a = *(const f32x4*)p, b = *(const f32x4*)(p + 4);
#pragma unroll
        for (int i = 0; i < 4; ++i) { f[i] = a[i]; f[4 + i] = b[i]; } }
    static __device__ __forceinline__ f32x4 v4(ptr p) { return *(const f32x4*)p; }
};

template <bool SAMPLE>
__device__ __forceinline__ void attend_query(const Args& A, LAS unsigned char* wl, const LAS float* biasrel, int m, int lane_in) {
    constexpr int NJ = SAMPLE ? 33 : 32;
    int lane = lane_in; asm volatile("" : "+v"(lane));
    const bf16_t* P = (const bf16_t*)(A.ws + WS_P);
    int b, nvalid, qpos; const float* srow;
    if (!SAMPLE) { b = m >> 11; const int t = m & 2047; nvalid = t + 1; qpos = t; srow = (const float*)(A.ws + WS_CHK_SC) + (size_t)m * SCW; }
    else { const int ms = m - MP; b = ms >> 2; const int t = ms & 3; nvalid = 2049 + t; qpos = 2048 + t; srow = (const float*)(A.ws + WS_SCS) + (size_t)ms * SCSW; }
    LAS float* pq = (LAS float*)wl;
    LAS unsigned* rowid = (LAS unsigned*)(wl + 16384);
    LAS unsigned short* posl = (LAS unsigned short*)(wl + 16384 + 1024);
    unsigned key[NJ];
#pragma unroll
    for (int j = 0; j < NJ; ++j) { key[j] = (lane < nvalid - 64 * j) ? f2key(srow[lane + 64 * j]) : 0u; }
    unsigned T = 0u; int need_eq = 0;
    if (nvalid > 256) {
        for (int bit = 31; bit >= 0; --bit) {
            const unsigned cand = T | (1u << bit); int cnt = 0;
#pragma unroll
            for (int j = 0; j < NJ; ++j) cnt += __popcll(__ballot(key[j] >= cand));
            if (cnt >= 256) T = cand;
        }
        int cgt = 0;
#pragma unroll
        for (int j = 0; j < NJ; ++j) cgt += __popcll(__ballot(key[j] > T));
        need_eq = 256 - cgt;
    }
    int base = 0, eqused = 0; unsigned long long mine_chk = 0ull;
    const int* pt = (const int*)A.in[I_PT];
#pragma unroll
    for (int j = 0; j < NJ; ++j) {
        const bool gt = key[j] > T, eq = (need_eq > 0) && (key[j] == T);
        const unsigned long long meq = __ballot(eq);
        const bool sel = gt || (eq && (eqused + mbcnt64(meq) < need_eq));
        eqused += __popcll(meq);
        const unsigned long long ms = __ballot(sel);
        if (sel) { const int pos = lane + 64 * j, k = base + mbcnt64(ms);
            posl[k] = (unsigned short)pos;
            unsigned rid;
            if (!SAMPLE) rid = (unsigned)(b * 2048 + pos);
            else rid = (pos < 2048) ? (unsigned)(pt[b * 16 + (pos >> 7)] * 128 + (pos & 127)) : (0x80000000u | (unsigned)(b * 4 + pos - 2048));
            rowid[k] = rid; }
        base += __popcll(ms);
        if (!SAMPLE) { if (lane == j) mine_chk = ms; }
    }
    if (!SAMPLE) { if (lane < 32) ((unsigned long long*)(A.ws + WS_CHK_MASK))[(size_t)m * 32 + lane] = mine_chk; }
    const int nsel = base;
    asm volatile("s_waitcnt lgkmcnt(0)" ::: "memory");
    { const unsigned r0 = rowid[0]; const unsigned short p0 = posl[0];
#pragma unroll
      for (int i = 0; i < 4; ++i) { const int k = lane + 64 * i; if (k >= nsel) { rowid[k] = r0; posl[k] = p0; } } }
    { const u32x4 w0 = *(const u32x4*)(P + (size_t)m * NP + PQ + lane * 16), w1 = *(const u32x4*)(P + (size_t)m * NP + PQ + lane * 16 + 8);
      float f0[8], f1[8]; unpack8(w0, f0); unpack8(w1, f1);
#pragma unroll
      for (int e = 0; e < 8; ++e) { pq[lane * 16 + e] = f0[e]; pq[lane * 16 + 8 + e] = f1[e]; } }
    asm volatile("s_waitcnt lgkmcnt(0)" ::: "memory");
    KVRow<SAMPLE> R;
    if constexpr (!SAMPLE) { R.P = P; } else { R.ck = A.in[I_CK]; R.cv = A.in[I_CV]; R.kn = A.out + O_KS; R.vn = A.out + O_VS; }
    typename KVRow<SAMPLE>::ptr kp[4]; int rel[4];
#pragma unroll
    for (int i = 0; i < 4; ++i) { kp[i] = R.krow(rowid[lane + 64 * i]); rel[i] = qpos - (int)posl[lane + 64 * i]; }
    float acc[4][16];
#pragma unroll
    for (int i = 0; i < 4; ++i)
#pragma unroll
        for (int hh = 0; hh < 16; ++hh) acc[i][hh] = 0.f;
#pragma unroll
    for (int g = 0; g < 4; ++g) {
#pragma unroll 1
        for (int dc = 0; dc < 8; ++dc) {
            float kv[4][8];
#pragma unroll
            for (int i = 0; i < 4; ++i) KVRow<SAMPLE>::k8(kp[i] + g * 64 + dc * 8, kv[i]);
#pragma unroll
            for (int hh = 0; hh < 4; ++hh) {
                const f32x4 q0 = *(const LAS f32x4*)(pq + (4 * g + hh) * 64 + dc * 8), q1 = *(const LAS f32x4*)(pq + (4 * g + hh) * 64 + dc * 8 + 4);
#pragma unroll
                for (int i = 0; i < 4; ++i) {
                    float a = acc[i][4 * g + hh];
#pragma unroll
                    for (int e = 0; e < 4; ++e) { a += kv[i][e] * q0[e]; a += kv[i][4 + e] * q1[e]; }
                    acc[i][4 * g + hh] = a; }
            }
        }
    }
    asm volatile("s_waitcnt lgkmcnt(0)" ::: "memory");
#pragma unroll
    for (int i = 0; i < 4; ++i) {
        const bool valid = (lane + 64 * i) < nsel; const int rc = rel[i] < 128 ? (rel[i] < 0 ? 0 : rel[i]) : 128;
#pragma unroll
        for (int h4 = 0; h4 < 4; ++h4) { const f32x4 bv = *(const LAS f32x4*)(biasrel + rc * 16 + 4 * h4);
#pragma unroll
            for (int e = 0; e < 4; ++e) acc[i][4 * h4 + e] = valid ? acc[i][4 * h4 + e] * 0.125f + bv[e] : -INFINITY; }
    }
#pragma unroll
    for (int hh = 0; hh < 16; ++hh) {
        const float mx = wave_max(fmaxf(fmaxf(acc[0][hh], acc[1][hh]), fmaxf(acc[2][hh], acc[3][hh])));
        float s = 0.f;
#pragma unroll
        for (int i = 0; i < 4; ++i) { acc[i][hh] = __expf(acc[i][hh] - mx); s += acc[i][hh]; }
        const float inv = 1.0f / wave_sum(s);
#pragma unroll
        for (int i = 0; i < 4; ++i) acc[i][hh] *= inv;
    }
#pragma unroll
    for (int i = 0; i < 4; ++i)
#pragma unroll
        for (int h4 = 0; h4 < 4; ++h4) *(LAS f32x4*)(pq + (lane + 64 * i) * 16 + 4 * h4) = (f32x4){acc[i][4 * h4], acc[i][4 * h4 + 1], acc[i][4 * h4 + 2], acc[i][4 * h4 + 3]};
    asm volatile("s_waitcnt lgkmcnt(0)" ::: "memory");
    const int g = lane >> 4;
    f32x4 o[4];
#pragma unroll
    for (int hh = 0; hh < 4; ++hh) o[hh] = (f32x4){0.f, 0.f, 0.f, 0.f};
    const int nloop = (nsel + 3) & ~3;
    for (int k0 = 0; k0 < nloop; k0 += 4) {
        f32x4 vv[4], pp[4];
#pragma unroll
        for (int u = 0; u < 4; ++u) { const unsigned r = rowid[k0 + u]; vv[u] = KVRow<SAMPLE>::v4(R.vrow(r) + lane * 4); pp[u] = *(const LAS f32x4*)(pq + (k0 + u) * 16 + 4 * g); }
#pragma unroll
        for (int u = 0; u < 4; ++u)
#pragma unroll
            for (int hh = 0; hh < 4; ++hh) o[hh] += vv[u] * pp[u][hh];
    }
    bf16_t* YA = (bf16_t*)(A.ws + WS_CHK_YA);
#pragma unroll
    for (int hh = 0; hh < 4; ++hh) { u32x2 w; w.x = pk2(o[hh][0], o[hh][1]); w.y = pk2(o[hh][2], o[hh][3]);
        *(u32x2*)(YA + (size_t)m * D + (4 * g + hh) * 64 + (lane & 15) * 4) = w; }
    asm volatile("s_waitcnt lgkmcnt(0)" ::: "memory");
}


__device__ __forceinline__ void check_compare(const Args& A, int gw, int NGW, int lane) {
    const bf16_t* Y1 = (const bf16_t*)(A.ws + WS_YA); const bf16_t* Y2 = (const bf16_t*)(A.ws + WS_CHK_YA); unsigned* ctl = (unsigned*)(A.ws + WS_CTL);
    for (int m = gw; m < MP; m += NGW) {
        float e = 0.f, n = 0.f;
#pragma unroll
        for (int j = 0; j < 2; ++j) { float a[8], b[8]; unpack8(*(const u32x4*)(Y1 + (size_t)m * D + j * 512 + lane * 8), a); unpack8(*(const u32x4*)(Y2 + (size_t)m * D + j * 512 + lane * 8), b);
#pragma unroll
            for (int i = 0; i < 8; ++i) { const float d = a[i] - b[i]; e += d * d; n += b[i] * b[i]; } }
        e = wave_sum(e); n = wave_sum(n);
        { const unsigned long long w1 = (lane < 32) ? ((const unsigned long long*)(A.ws + WS_SC))[(size_t)m * 32 + lane] : 0ull, w2 = (lane < 32) ? ((const unsigned long long*)(A.ws + WS_CHK_MASK))[(size_t)m * 32 + lane] : 0ull;
          if (__any(w1 != w2) && lane == 0) atomicAdd(ctl + CW_CHK + 3, 1u);
          const int t = m & 2047;
          if (t >= 256) {
              const float* srow = (const float*)(A.ws + WS_CHK_SC) + (size_t)m * SCW;
              int c1 = 0, c2 = 0; float mins1 = INFINITY, maxu1 = -INFINITY, mins2 = INFINITY, maxu2 = -INFINITY;
              for (int j = 0; j < 32; ++j) { const int sp = lane + 64 * j; if (64 * j > t) break;
                  const unsigned long long a1 = __shfl((unsigned long long)w1, j), a2 = __shfl((unsigned long long)w2, j);
                  if (sp <= t) { const float v = srow[sp]; const bool s1 = (a1 >> lane) & 1ull, s2 = (a2 >> lane) & 1ull;
                      if (s1) { ++c1; mins1 = fminf(mins1, v); } else maxu1 = fmaxf(maxu1, v);
                      if (s2) { ++c2; mins2 = fminf(mins2, v); } else maxu2 = fmaxf(maxu2, v); } }
              c1 = (int)wave_sum((float)c1); c2 = (int)wave_sum((float)c2);
              mins1 = -wave_max(-mins1); mins2 = -wave_max(-mins2); maxu1 = wave_max(maxu1); maxu2 = wave_max(maxu2);
              if (lane == 0) { if (c1 != 256 || mins1 < maxu1) atomicAdd(ctl + CW_CHK + 4, 1u); if (c2 != 256 || mins2 < maxu2) atomicAdd(ctl + CW_CHK + 5, 1u); }
          } }
        if (lane == 0 && !(e <= MK_CHECK_TOL * MK_CHECK_TOL * n + 1e-12f)) { const int t = m & 2047; atomicAdd(ctl + CW_CHK + (t < 64 ? 0 : t < 256 ? 1 : 2), 1u); }
    }
}
#endif
__device__ __forceinline__ void gate_norm_phase(const Args& A, int gw, int NGW, int lane) {
    const bf16_t* P = (const bf16_t*)(A.ws + WS_P); bf16_t* Y = (bf16_t*)(A.ws + WS_Y); const float* ng = A.in[I_NORMG];
    for (int it = gw; it < M * 4; it += NGW) {
        const int m = it >> 2, ch = (it & 3) * 512 + lane * 8;
        float y[8], z[8]; unpack8(*(const u32x4*)(Y + (size_t)m * DI + ch), y); unpack8(*(const u32x4*)(P + (size_t)m * NP + PZ + ch), z);
        float ss = 0.f;
#pragma unroll
        for (int i = 0; i < 8; ++i) { y[i] *= siluf_(z[i]); ss += y[i] * y[i]; }
        const float r = 1.0f / sqrtf(wave_sum(ss) * (1.f / 512.f) + LN_EPS);
        const f32x4 g0 = *(const f32x4*)(ng + ch), g1 = *(const f32x4*)(ng + ch + 4);
#pragma unroll
        for (int i = 0; i < 4; ++i) { y[i] = y[i] * r * g0[i]; y[4 + i] = y[4 + i] * r * g1[i]; }
        *(u32x4*)(Y + (size_t)m * DI + ch) = pack8(y);
    }
}

constexpr int NPHASE = 14;
__global__ void __launch_bounds__(NTHR, 2) fwd(Args args) {
    extern __shared__ __attribute__((aligned(16))) unsigned char lds_raw[];
    LAS unsigned char* lds = (LAS unsigned char*)lds_raw;
    const int tid = threadIdx.x, lane = tid & 63, wave = __builtin_amdgcn_readfirstlane(tid >> 6);
    const int G = gridDim.x, bx = blockIdx.x;
    const int vcu = (G % 8 == 0) ? (bx % 8) * (G / 8) + bx / 8 : bx;
    const int gw = vcu * NWAVES + wave, NGW = G * NWAVES;
    unsigned char* ws = args.ws;
    volatile LAS unsigned* MISC = (volatile LAS unsigned*)(lds + MISC_OFF);
    for (int u = tid; u < 64; u += NTHR) MISC[u] = 0u;
    __syncthreads();
    const int lo = args.ph_lo, hi = args.ph_hi;
    XcdBarrier bar; bar.bar = (unsigned*)(ws + WS_CTL) + CW_BAR; bar.x = 0; bar.st = nullptr;
    if (hi - lo > 1) bar = xcd_barrier_post((unsigned*)(ws + WS_CTL) + CW_BAR, MISC + 8);
#define IN(k) (lo <= (k) && (k) < hi)
#define SEAM(k) do { if (IN(k) && IN((k) + 1)) xcd_barrier(bar); } while (0)

    bf16_t* const XB = (bf16_t*)(ws + WS_XB); bf16_t* const ACT = (bf16_t*)(ws + WS_ACT); float* const T = (float*)(ws + WS_T);
    float* const HF = (float*)(ws + WS_HF); bf16_t* const HB = (bf16_t*)(ws + WS_HB); bf16_t* const P = (bf16_t*)(ws + WS_P);
    float* const SMF = (float*)(ws + WS_SMF); bf16_t* const Y = (bf16_t*)(ws + WS_Y); bf16_t* const YA = (bf16_t*)(ws + WS_YA); bf16_t* const MG = (bf16_t*)(ws + WS_MG);

    if (IN(0)) REPK(0) { p0_prologue(args, lds, gw, NGW, wave, lane); }
    SEAM(0);
    if (IN(1)) {
        { pg8::Gemm g{XB, (const bf16_t*)(ws + WS_W1A), M, 2 * DFF, D}; pg8::StaticOrder S; S.init(M, 2 * DFF, G, bx);
        EpiSwiglu E{ACT}; pg8::gemm_phase<EpiSwiglu, pg8::StaticOrder, true, true>(lds, g, S, E); }
        if constexpr (DUPK(1)) { pg8::Gemm g{XB, (const bf16_t*)(ws + WS_W1A), M, 2 * DFF, D}; pg8::StaticOrder S; S.init(M, 2 * DFF, G, bx);
        EpiSwiglu E{ACT}; pg8::gemm_phase<EpiSwiglu, pg8::StaticOrder, true, true>(lds, g, S, E); }
    }
    SEAM(1);
    if (IN(2)) {
        { pg8::Gemm g{ACT, (const bf16_t*)(ws + WS_W1B), MP, D, DFF}; pg8::StaticOrder S; S.init(MP, D, G, bx);
        EpiResid E{args.in[I_XP], args.in[I_XS], T, ALPHA, 0.5f}; pg8::gemm_phase<EpiResid, pg8::StaticOrder, true, true>(lds, g, S, E); }
        { SkResid E{args.in[I_XS], T, ALPHA, 0.5f}; skinny_gemm<DFF>(lds, ACT + (size_t)MP * DFF, (const bf16_t*)(ws + WS_W1B), E, bx, G, wave, lane); }
        if constexpr (DUPK(2)) { pg8::Gemm g{ACT, (const bf16_t*)(ws + WS_W1B), MP, D, DFF}; pg8::StaticOrder S; S.init(MP, D, G, bx);
        EpiResid E{args.in[I_XP], args.in[I_XS], T, ALPHA, 0.5f}; pg8::gemm_phase<EpiResid, pg8::StaticOrder, true, true>(lds, g, S, E); }
    }
    SEAM(2);
    if (IN(3)) REPK(3) { ln_phase(T, args.in[I_LN1G], args.in[I_LN1B], HF, HB, gw, NGW, lane); }
    SEAM(3);
    if (IN(4)) {
        { pg8::Gemm g{HB, (const bf16_t*)(ws + WS_WIN), M, NP, D}; pg8::StaticOrder S; S.init(M, NP, G, bx);
        EpiWin E{P, SMF, args.out}; pg8::gemm_phase<EpiWin, pg8::StaticOrder, true, true>(lds, g, S, E); }
        if constexpr (DUPK(4)) { pg8::Gemm g{HB, (const bf16_t*)(ws + WS_WIN), M, NP, D}; pg8::StaticOrder S; S.init(M, NP, G, bx);
        EpiWin E{P, SMF, args.out}; pg8::gemm_phase<EpiWin, pg8::StaticOrder, true, true>(lds, g, S, E); }
    }
    SEAM(4);
    if (IN(5)) REPK(5) {
        for (int rep = 0; rep < MK_REP_CONV; ++rep)
        conv_phase(args, gw, NGW, lane);
        for (int rep = 0; rep < MK_REP_SCP; ++rep)
        for (int u = bx; u < 1024; u += G) { const int i = u >> 8, c = u & 255, b = c >> 5, s = c & 31; const int qt = (i == 0) ? s : (i == 1) ? 63 - s : (i == 2) ? 64 + s : 127 - s;
            scores_select_prompt_unit(args, lds, b, qt, wave, lane); }
        for (int rep = 0; rep < MK_REP_SCS; ++rep)
        for (int u = bx; u < 256; u += G) scores_sample_unit(args, u >> 1, u & 1, wave, lane);
    }
    SEAM(5);
    if (IN(6)) {
        for (int rep = 0; rep < MK_REP_SSDP; ++rep)
        for (int it = bx; it < 256; it += G) ssd_prompt_item(args, lds, it >> 5, it & 31);
        __syncthreads();
        LAS float* biasrel = (LAS float*)(lds + BIASREL_OFF); LAS float* biasL = biasrel + 129 * 16;
        for (int i = tid; i < 129 * 16; i += NTHR) { const int rel = i >> 4, h = i & 15; const float bv = args.in[I_BIAS][t5_bucket(rel) * 16 + h]; biasrel[i] = bv; biasL[i] = bv * LOG2E; }
        __syncthreads();
        for (int rep = 0; rep < MK_REP_ATTP; ++rep)
        for (int u = bx; u < 1024; u += G) { const int i = u >> 8, c = u & 255, bg = c >> 3, s8 = c & 7; const int qt = (i == 0) ? s8 : (i == 1) ? 15 - s8 : (i == 2) ? 16 + s8 : 31 - s8;
            attn_prompt_unit(args, lds, biasL, bg >> 2, bg & 3, qt, wave, lane); }
        __syncthreads();
        LAS unsigned char* wl = lds + wave * WAREA;
        for (int rep = 0; rep < MK_REP_SSDS; ++rep)
        for (int it = gw; it < 4096; it += NGW) ssd_sample_item(args, wl, it >> 5, it & 31, lane);
        for (int rep = 0; rep < MK_REP_ATTS; ++rep)
        for (int q = gw; q < MS * 4; q += NGW) attend_sample_task(args, wl, biasrel, q >> 2, q & 3, lane);
#if MK_CHECK_ATT
        for (int q = gw; q < MP; q += NGW) attend_query<false>(args, wl, biasrel, q, lane);
#endif
        __syncthreads();
    }
    SEAM(6);
    if (IN(7)) {
        gate_norm_phase(args, gw, NGW, lane);
#if MK_CHECK_ATT
        check_compare(args, gw, NGW, lane);
#endif
        { pg8::Gemm g{YA, (const bf16_t*)(ws + WS_WBA), MP, D, D}; pg8::StaticOrder S; S.init(MP, D, G, bx);
        EpiGateA E{P, PG + D, T}; pg8::gemm_phase<EpiGateA, pg8::StaticOrder, true, true>(lds, g, S, E); }
        { SkGateA E{P, PG + D, T}; skinny_gemm<D>(lds, YA + (size_t)MP * D, (const bf16_t*)(ws + WS_WBA), E, bx, G, wave, lane); }
        if constexpr (DUPK(7)) { pg8::Gemm g{YA, (const bf16_t*)(ws + WS_WBA), MP, D, D}; pg8::StaticOrder S; S.init(MP, D, G, bx);
        EpiGateA E{P, PG + D, T}; pg8::gemm_phase<EpiGateA, pg8::StaticOrder, true, true>(lds, g, S, E); }
    }
    SEAM(7);
    if (IN(8)) {
        { pg8::Gemm g{Y, (const bf16_t*)(ws + WS_WBS), MP, D, DI}; pg8::StaticOrder S; S.init(MP, D, G, bx);
        EpiGateS E{P, PG, T, MG}; pg8::gemm_phase<EpiGateS, pg8::StaticOrder, true, true>(lds, g, S, E); }
        { SkGateS E{P, PG, T, MG}; skinny_gemm<DI>(lds, Y + (size_t)MP * DI, (const bf16_t*)(ws + WS_WBS), E, bx, G, wave, lane); }
        if constexpr (DUPK(8)) { pg8::Gemm g{Y, (const bf16_t*)(ws + WS_WBS), MP, D, DI}; pg8::StaticOrder S; S.init(MP, D, G, bx);
        EpiGateS E{P, PG, T, MG}; pg8::gemm_phase<EpiGateS, pg8::StaticOrder, true, true>(lds, g, S, E); }
    }
    SEAM(8);
    if (IN(9)) {
        { pg8::Gemm g{MG, (const bf16_t*)(ws + WS_WOUT), MP, D, D}; pg8::StaticOrder S; S.init(MP, D, G, bx);
        EpiResid E{HF, HF + (size_t)MP * D, T, ALPHA, 1.0f}; pg8::gemm_phase<EpiResid, pg8::StaticOrder, true, true>(lds, g, S, E); }
        { SkResid E{HF + (size_t)MP * D, T, ALPHA, 1.0f}; skinny_gemm<D>(lds, MG + (size_t)MP * D, (const bf16_t*)(ws + WS_WOUT), E, bx, G, wave, lane); }
        if constexpr (DUPK(9)) { pg8::Gemm g{MG, (const bf16_t*)(ws + WS_WOUT), MP, D, D}; pg8::StaticOrder S; S.init(MP, D, G, bx);
        EpiResid E{HF, HF + (size_t)MP * D, T, ALPHA, 1.0f}; pg8::gemm_phase<EpiResid, pg8::StaticOrder, true, true>(lds, g, S, E); }
    }
    SEAM(9);
    if (IN(10)) REPK(10) { ln_phase(T, args.in[I_LN2G], args.in[I_LN2B], HF, HB, gw, NGW, lane); }
    SEAM(10);
    if (IN(11)) {
        { pg8::Gemm g{HB, (const bf16_t*)(ws + WS_W2A), M, 2 * DFF, D}; pg8::StaticOrder S; S.init(M, 2 * DFF, G, bx);
        EpiSwiglu E{ACT}; pg8::gemm_phase<EpiSwiglu, pg8::StaticOrder, true, true>(lds, g, S, E); }
        if constexpr (DUPK(11)) { pg8::Gemm g{HB, (const bf16_t*)(ws + WS_W2A), M, 2 * DFF, D}; pg8::StaticOrder S; S.init(M, 2 * DFF, G, bx);
        EpiSwiglu E{ACT}; pg8::gemm_phase<EpiSwiglu, pg8::StaticOrder, true, true>(lds, g, S, E); }
    }
    SEAM(11);
    if (IN(12)) {
        { pg8::Gemm g{ACT, (const bf16_t*)(ws + WS_W2B), MP, D, DFF}; pg8::StaticOrder S; S.init(MP, D, G, bx);
        EpiResid E{HF, HF + (size_t)MP * D, T, ALPHA, 0.5f}; pg8::gemm_phase<EpiResid, pg8::StaticOrder, true, true>(lds, g, S, E); }
        { SkResid E{HF + (size_t)MP * D, T, ALPHA, 0.5f}; skinny_gemm<DFF>(lds, ACT + (size_t)MP * DFF, (const bf16_t*)(ws + WS_W2B), E, bx, G, wave, lane); }
        if constexpr (DUPK(12)) { pg8::Gemm g{ACT, (const bf16_t*)(ws + WS_W2B), MP, D, DFF}; pg8::StaticOrder S; S.init(MP, D, G, bx);
        EpiResid E{HF, HF + (size_t)MP * D, T, ALPHA, 0.5f}; pg8::gemm_phase<EpiResid, pg8::StaticOrder, true, true>(lds, g, S, E); }
    }
    SEAM(12);
    if (IN(13)) REPK(13) { ln_phase(T, args.in[I_LN3G], args.in[I_LN3B], args.out + O_Y, nullptr, gw, NGW, lane); }
#if MK_CHECK_ATT
    if (IN(13)) { __syncthreads(); unsigned* cw = (unsigned*)(ws + WS_CTL) + CW_CHK;
        const unsigned b0 = __hip_atomic_load(cw, __ATOMIC_RELAXED, __HIP_MEMORY_SCOPE_AGENT), b1 = __hip_atomic_load(cw + 1, __ATOMIC_RELAXED, __HIP_MEMORY_SCOPE_AGENT), b2 = __hip_atomic_load(cw + 2, __ATOMIC_RELAXED, __HIP_MEMORY_SCOPE_AGENT), b3 = __hip_atomic_load(cw + 3, __ATOMIC_RELAXED, __HIP_MEMORY_SCOPE_AGENT), b4 = __hip_atomic_load(cw + 4, __ATOMIC_RELAXED, __HIP_MEMORY_SCOPE_AGENT), b5 = __hip_atomic_load(cw + 5, __ATOMIC_RELAXED, __HIP_MEMORY_SCOPE_AGENT);
        const float code = MK_CHECK_CODE;
        if (code > 0.f && bx == 0 && tid == 0) args.out[O_Y] = 4096.0f * sqrtf(code); }
#endif
#undef IN
#undef SEAM
}
}

extern "C" void kernel_launch(void* const* d_in, const int* in_sizes, int n_in, void* d_out, int out_size, void* d_ws, size_t ws_size, hipStream_t stream) {
    using namespace mk;
    static int grid = 0;
    if (grid == 0) {
        if (n_in != 29 || (size_t)out_size != O_END || ws_size < WS_END) { fprintf(stderr, "kernel_launch: unexpected shapes (n_in %d, out %d, ws %zu)\n", n_in, out_size, ws_size); grid = -1; return; }
        int dev = 0, cus = 0, per_cu = 0;
        if (hipGetDevice(&dev) != hipSuccess || hipDeviceGetAttribute(&cus, hipDeviceAttributeMultiprocessorCount, dev) != hipSuccess) { grid = -1; return; }
        if (hipFuncSetAttribute((const void*)fwd, hipFuncAttributeMaxDynamicSharedMemorySize, LDS_BYTES) != hipSuccess) { fprintf(stderr, "kernel_launch: hipFuncSetAttribute failed\n"); grid = -1; return; }
        if (hipOccupancyMaxActiveBlocksPerMultiprocessor(&per_cu, (const void*)fwd, NTHR, LDS_BYTES) != hipSuccess || per_cu < 1) fprintf(stderr, "kernel_launch: occupancy query says %d\n", per_cu);
        (void)hipGetLastError();
        grid = cus;
    }
    if (grid < 0) return;
    (void)hipMemsetAsync((char*)d_ws + WS_CTL, 0, CTL_ZERO_BYTES, stream);
    Args a{};
    for (int i = 0; i < 29; ++i) a.in[i] = (const float*)d_in[i];
    a.out = (float*)d_out; a.ws = (unsigned char*)d_ws;
#if MK_SPLIT
    for (int p = 0; p < NPHASE; ++p) { a.ph_lo = p; a.ph_hi = p + 1; hipLaunchKernelGGL(fwd, dim3(grid), dim3(NTHR), LDS_BYTES, stream, a); }
#else
    a.ph_lo = 0; a.ph_hi = NPHASE; hipLaunchKernelGGL(fwd, dim3(grid), dim3(NTHR), LDS_BYTES, stream, a);
#endif
}
```

```cpp
#include <hip/hip_runtime.h>
#include <cstdio>
#include <cstdint>
#define GAS __attribute__((address_space(1)))
#define LAS __attribute__((address_space(3)))
namespace pg8 {
#define PG8_LAS __attribute__((address_space(3)))
typedef unsigned short bf16_t;
typedef short bf16x8 __attribute__((ext_vector_type(8)));
typedef float f32x4 __attribute__((ext_vector_type(4)));
typedef unsigned u32x4 __attribute__((ext_vector_type(4)));
constexpr int BM = 256, BK = 64, HALF = 128, HTB = HALF * BK * 2  , STAGE_BYTES = 8 * HTB, NXCD = 8, WGM = 8;

__host__ __device__ __forceinline__ int lds_byte(int r, int c) { const int st = (r >> 4) * 2 + (c >> 5), rr = r & 15, cc = c & 31, ob = rr * 64 + cc * 2; return st * 1024 + (ob ^ (((ob >> 9) & 1) << 5)); }
__host__ __device__ __forceinline__ void stage_rc(int b, int& R, int& C) { const int st = b / 1024, sb = b % 1024, swz = sb ^ (((sb >> 9) & 1) << 5); R = (st >> 1) * 16 + swz / 64; C = (st & 1) * 32 + (swz % 64) / 2; }
__host__ __device__ __forceinline__ int perm32(int rho) { const int n = rho >> 4, i = rho & 15; return 8 * (i >> 2) + 4 * n + (i & 3); }

struct Unit { int pm, pn; };
struct Gemm { const bf16_t* A; const bf16_t* Bt; int M, N, K; };

struct StaticOrder {
    int nM, nN, nwg, G, c;
    __host__ __device__ void init(int M, int N, int G_, int c_) { nM = M / BM; nN = N / BM; nwg = nM * nN; G = G_; c = c_; }
    __host__ __device__ bool next(int i, Unit& u) const {
        const long L = (long)i * G + c; if (L >= nwg) return false;
        int wgid = (int)L; { const int q = nwg / NXCD, r = nwg % NXCD, xcd = wgid % NXCD, off = wgid / NXCD; wgid = (xcd < r ? xcd * (q + 1) : r * (q + 1) + (xcd - r) * q) + off; }
        const int nig = WGM * nN, gid = wgid / nig, fm = gid * WGM, gsz = (nM - fm) < WGM ? (nM - fm) : WGM;
        u.pm = fm + ((wgid % nig) % gsz); u.pn = (wgid % nig) / gsz; return true;
    }
    __device__ __forceinline__ void a_ready(const Unit&) const {}
    __device__ __forceinline__ void done(const Unit&) const {}
};

__device__ __forceinline__ unsigned cvt_pk_bf16(float lo, float hi) { unsigned r; asm volatile("v_cvt_pk_bf16_f32 %0, %1, %2" : "=v"(r) : "v"(lo), "v"(hi)); return r; }

template <class Epi, class Sched, bool ALIGN_EPI = false, bool SP2 = false>
__device__ __forceinline__ void gemm_phase(PG8_LAS unsigned char* lds, const Gemm g, const Sched& S, const Epi& E) {
    const int tid = threadIdx.x, wid = __builtin_amdgcn_readfirstlane(tid >> 6), lane = tid & 63, wr = wid >> 2, wc = wid & 3, fr = lane & 15, fq = lane >> 4;
    const int K = g.K, nt = K / BK;
    unsigned voffA[2], voffB[2];
#pragma unroll
    for (int i = 0; i < 2; ++i) { int R, C; stage_rc(tid * 16 + i * 8192, R, C); const int Rb = Epi::PERM ? ((R & ~31) + perm32(R & 31)) : R;
        voffA[i] = (unsigned)(R * K + C) * 2u; voffB[i] = (unsigned)(Rb * K + C) * 2u; }
    const size_t kstep = (size_t)(BK * 2);
    const size_t hstep = (size_t)HALF * K * 2;
    const size_t tstep = 2 * hstep;
    const unsigned ldsw = (unsigned)wid * 1024u;
    const int aoff = lds_byte(wr * 64 + fr, fq * 8), boff = lds_byte(wc * 32 + fr, fq * 8);
#define PG8_SA(b, h) (((b) * 2 + (h)) * HTB)
#define PG8_SB(b, h) ((4 + (b) * 2 + (h)) * HTB)
#define PG8_STAGE(bufoff, gbase, voff) do { _Pragma("unroll") for (int _i = 0; _i < 2; ++_i) \
        __builtin_amdgcn_global_load_lds((const unsigned*)((const char*)(gbase) + (voff)[_i]), (PG8_LAS unsigned*)(lds + (bufoff) + ldsw + _i * 8192), 16, 0, 0); } while (0)
#define PG8_LDA(dst, b, h) do { _Pragma("unroll") for (int m = 0; m < 4; ++m) _Pragma("unroll") for (int k = 0; k < 2; ++k) dst[m][k] = *(const PG8_LAS bf16x8*)(lds + PG8_SA(b, h) + aoff + m * 2048 + k * 1024); } while (0)
#define PG8_LDB(dst, b, h) do { _Pragma("unroll") for (int n = 0; n < 2; ++n) _Pragma("unroll") for (int k = 0; k < 2; ++k) dst[n][k] = *(const PG8_LAS bf16x8*)(lds + PG8_SB(b, h) + boff + n * 2048 + k * 1024); } while (0)
#define PG8_MMA(ai, bj, At, Bt) do { __builtin_amdgcn_s_setprio(1); _Pragma("unroll") for (int m = 0; m < 4; ++m) _Pragma("unroll") for (int n = 0; n < 2; ++n) _Pragma("unroll") for (int k = 0; k < 2; ++k) \
        acc[ai][bj][m][n] = __builtin_amdgcn_mfma_f32_16x16x32_bf16(Bt[n][k], At[m][k], acc[ai][bj][m][n], 0, 0, 0); __builtin_amdgcn_s_setprio(0); } while (0)
#define PG8_WAIT_V(n) asm volatile("s_waitcnt vmcnt(" #n ")" ::: "memory")
#define PG8_WAIT_L(n) asm volatile("s_waitcnt lgkmcnt(" #n ")" ::: "memory")
#define PG8_BAR __builtin_amdgcn_s_barrier()
#define PG8_SCHED __builtin_amdgcn_sched_barrier(0)
    Unit cur, nxt; int ui = 0;
    if (!S.next(0, cur)) return;
    f32x4 acc[2][2][4][2];
#pragma unroll
    for (int a = 0; a < 2; ++a)
#pragma unroll
        for (int b = 0; b < 2; ++b)
#pragma unroll
            for (int m = 0; m < 4; ++m)
#pragma unroll
                for (int n = 0; n < 2; ++n) acc[a][b][m][n] = (f32x4){0.f, 0.f, 0.f, 0.f};
    bf16x8 At[4][2], B0[2][2], B1[2][2];
    const char* cA = (const char*)g.A + (size_t)cur.pm * tstep; const char* cB = (const char*)g.Bt + (size_t)cur.pn * tstep;
    S.a_ready(cur);
    if constexpr (SP2) {
        PG8_STAGE(PG8_SB(0, 0), cB, voffB); PG8_STAGE(PG8_SB(0, 1), cB + hstep, voffB); PG8_STAGE(PG8_SA(0, 0), cA, voffA); PG8_STAGE(PG8_SA(0, 1), cA + hstep, voffA);
        if (wr == 1) PG8_BAR;
        PG8_WAIT_V(2); PG8_BAR;
        PG8_STAGE(PG8_SB(1, 0), cB + kstep, voffB); PG8_STAGE(PG8_SA(1, 0), cA + kstep, voffA); PG8_STAGE(PG8_SB(1, 1), cB + hstep + kstep, voffB);
        PG8_WAIT_V(6); PG8_BAR;
    } else {
        PG8_STAGE(PG8_SB(0, 0), cB, voffB); PG8_STAGE(PG8_SA(0, 0), cA, voffA); PG8_STAGE(PG8_SB(0, 1), cB + hstep, voffB); PG8_STAGE(PG8_SA(0, 1), cA + hstep, voffA);
        if (wr == 1) PG8_BAR;
        PG8_WAIT_V(4); PG8_BAR;
        PG8_STAGE(PG8_SB(1, 0), cB + kstep, voffB); PG8_STAGE(PG8_SA(1, 0), cA + kstep, voffA); PG8_STAGE(PG8_SB(1, 1), cB + hstep + kstep, voffB);
        PG8_WAIT_V(6); PG8_BAR;
    }
    for (;;) {
        const bool has_next = S.next(ui + 1, nxt);
        const char* nA = has_next ? (const char*)g.A + (size_t)nxt.pm * tstep : cA; const char* nB = has_next ? (const char*)g.Bt + (size_t)nxt.pn * tstep : cB;
        for (int t = 0; t < nt; t += 2) {
            const bool last = (t == nt - 2);
            const char* a1 = cA + (size_t)(t + 1) * kstep;
            const char* a2 = last ? nA : cA + (size_t)(t + 2) * kstep; const char* b2 = last ? nB : cB + (size_t)(t + 2) * kstep;
            const char* a3 = a2 + kstep; const char* b3 = b2 + kstep;
            if (last && has_next) S.a_ready(nxt);
            if constexpr (SP2) {
            PG8_LDB(B0, 0, 0); PG8_LDB(B1, 0, 1); PG8_SCHED; PG8_LDA(At, 0, 0); PG8_STAGE(PG8_SA(1, 1), a1 + hstep, voffA);
            PG8_WAIT_V(8); PG8_WAIT_L(0); PG8_BAR; PG8_MMA(0, 0, At, B0); PG8_MMA(0, 1, At, B1); PG8_BAR; PG8_SCHED;
            PG8_LDA(At, 0, 1); PG8_STAGE(PG8_SB(0, 0), b2, voffB); PG8_STAGE(PG8_SB(0, 1), b2 + hstep, voffB); PG8_STAGE(PG8_SA(0, 0), a2, voffA);
            PG8_WAIT_V(8); PG8_WAIT_L(0); PG8_BAR; PG8_MMA(1, 0, At, B0); PG8_MMA(1, 1, At, B1); PG8_BAR; PG8_SCHED;
            PG8_LDB(B0, 1, 0); PG8_LDB(B1, 1, 1); PG8_SCHED; PG8_LDA(At, 1, 0); PG8_STAGE(PG8_SA(0, 1), a2 + hstep, voffA);
            PG8_WAIT_V(8); PG8_WAIT_L(0); PG8_BAR; PG8_MMA(0, 0, At, B0); PG8_MMA(0, 1, At, B1); PG8_BAR; PG8_SCHED;
            PG8_LDA(At, 1, 1); PG8_STAGE(PG8_SB(1, 0), b3, voffB); PG8_STAGE(PG8_SB(1, 1), b3 + hstep, voffB); PG8_STAGE(PG8_SA(1, 0), a3, voffA);
            PG8_WAIT_V(8); PG8_WAIT_L(0); PG8_BAR; PG8_MMA(1, 0, At, B0); PG8_MMA(1, 1, At, B1); PG8_BAR; PG8_SCHED;
            } else {
            PG8_LDB(B0, 0, 0); PG8_SCHED; PG8_LDA(At, 0, 0); PG8_STAGE(PG8_SA(1, 1), a1 + hstep, voffA);
            PG8_WAIT_L(8); PG8_BAR; PG8_WAIT_L(0); PG8_MMA(0, 0, At, B0); PG8_BAR; PG8_SCHED;
            PG8_LDB(B1, 0, 1); PG8_STAGE(PG8_SB(0, 0), b2, voffB);
            PG8_BAR; PG8_WAIT_L(0); PG8_MMA(0, 1, At, B1); PG8_BAR;
            PG8_LDA(At, 0, 1); PG8_STAGE(PG8_SA(0, 0), a2, voffA);
            PG8_BAR; PG8_WAIT_L(0); PG8_MMA(1, 0, At, B0); PG8_BAR; PG8_SCHED;
            PG8_STAGE(PG8_SB(0, 1), b2 + hstep, voffB);
            PG8_WAIT_V(6); PG8_BAR; PG8_MMA(1, 1, At, B1); PG8_BAR;
            PG8_LDB(B0, 1, 0); PG8_SCHED; PG8_LDA(At, 1, 0); PG8_STAGE(PG8_SA(0, 1), a2 + hstep, voffA);
            PG8_WAIT_L(8); PG8_BAR; PG8_WAIT_L(0); PG8_MMA(0, 0, At, B0); PG8_BAR; PG8_SCHED;
            PG8_LDB(B1, 1, 1); PG8_STAGE(PG8_SB(1, 0), b3, voffB);
            PG8_BAR; PG8_WAIT_L(0); PG8_MMA(0, 1, At, B1); PG8_BAR;
            PG8_LDA(At, 1, 1); PG8_STAGE(PG8_SA(1, 0), a3, voffA);
            PG8_BAR; PG8_WAIT_L(0); PG8_MMA(1, 0, At, B0); PG8_BAR; PG8_SCHED;
            PG8_STAGE(PG8_SB(1, 1), b3 + hstep, voffB);
            PG8_WAIT_V(6); PG8_BAR; PG8_MMA(1, 1, At, B1); PG8_BAR;
            }
        }
        if constexpr (ALIGN_EPI) { if (wr == 0) PG8_BAR; }
        if constexpr (!Epi::AFTER_DRAIN) { E(acc, cur, wr, wc, fr, fq); S.done(cur); }
        if (!has_next) break;
#pragma unroll
        for (int a = 0; a < 2; ++a)
#pragma unroll
            for (int b = 0; b < 2; ++b)
#pragma unroll
                for (int m = 0; m < 4; ++m)
#pragma unroll
                    for (int n = 0; n < 2; ++n) acc[a][b][m][n] = (f32x4){0.f, 0.f, 0.f, 0.f};
        cur = nxt; cA = nA; cB = nB; ++ui;
        if constexpr (ALIGN_EPI) { if (wr == 1) PG8_BAR; }
    }
    PG8_WAIT_V(0);
    if constexpr (!ALIGN_EPI) { if (wr == 0) PG8_BAR; }
    PG8_BAR;
    if constexpr (Epi::AFTER_DRAIN) { E.fused(acc, cur, wr, wc, fr, fq, lds, wid, lane); S.done(cur); }
#undef PG8_SA
#undef PG8_SB
#undef PG8_STAGE
#undef PG8_LDA
#undef PG8_LDB
#undef PG8_MMA
#undef PG8_WAIT_V
#undef PG8_WAIT_L
#undef PG8_BAR
#undef PG8_SCHED
}
}
#define XB_TMO      128
#define XB_XCNT(j)  (256  + 64 * (j))
#define XB_XSUB(j)  (1280 + 64 * (j))
#define XB_XGEN(j)  (2304 + 64 * (j))
#define XB_TOP      3328
#define XB_TOPGEN   3392
#define XCD_BAR_WORDS 3456
#define XB_SPIN_CAP (1u << 18)

__device__ __forceinline__ unsigned xb_ld(unsigned* p)              { return __hip_atomic_load(p, __ATOMIC_RELAXED, __HIP_MEMORY_SCOPE_AGENT); }
__device__ __forceinline__ unsigned xb_add(unsigned* p, unsigned v) { return __hip_atomic_fetch_add(p, v, __ATOMIC_RELAXED, __HIP_MEMORY_SCOPE_AGENT); }
__device__ __forceinline__ unsigned xb_xcc_id() { return (unsigned)__builtin_amdgcn_s_getreg((3 << 11) | 20) & 0xFu; }
#define XB_SPIN(cond, bar) do { unsigned _sp = 0; while (cond) { __builtin_amdgcn_s_sleep(1); \
    if ((++_sp & 255u) == 0u) { if (xb_ld(&(bar)[XB_TMO])) break; if (_sp > XB_SPIN_CAP) { atomicAdd(&(bar)[XB_TMO], 1u); break; } } } } while (0)

struct XcdBarrier {
    unsigned* bar; unsigned x;
    volatile LAS unsigned* st;
};

__device__ __forceinline__ XcdBarrier xcd_barrier_post(unsigned* bar, volatile LAS unsigned* st) {
    XcdBarrier b; b.bar = bar; b.x = xb_xcc_id(); b.st = st;
    if (threadIdx.x == 0) (void)xb_add(&bar[XB_XCNT(b.x)], 1u);
    return b;
}
__device__ __forceinline__ void xcd_barrier_complete(unsigned* bar, unsigned x, unsigned& nloc, unsigned& nx) {
    const unsigned G = gridDim.x * gridDim.y * gridDim.z;
    unsigned sum, cnt, mine, sp = 0u;
    for (;;) {
        sum = 0u; cnt = 0u; mine = 0u;
#pragma unroll
        for (unsigned j = 0; j < 16; ++j) { const unsigned c = xb_ld(&bar[XB_XCNT(j)]); sum += c; cnt += (c > 0u) ? 1u : 0u; mine = (j == x) ? c : mine; }
        if (sum == G) break;
        __builtin_amdgcn_s_sleep(1);
        if ((++sp & 255u) == 0u) { if (xb_ld(&bar[XB_TMO])) break; if (sp > XB_SPIN_CAP) { atomicAdd(&bar[XB_TMO], 1u); break; } }
    }
    nloc = mine > 0u ? mine : 1u; nx = cnt > 0u ? cnt : 1u;
}

__device__ __forceinline__ void xcd_barrier(const XcdBarrier& b) {
    asm volatile("s_waitcnt vmcnt(0)" ::: "memory");
    __syncthreads();
    if (threadIdx.x == 0) {
        unsigned* bar = b.bar;
        __builtin_amdgcn_s_waitcnt(0);
        unsigned nloc = b.st[0], nx = b.st[1];
        if (nloc == 0u) { xcd_barrier_complete(bar, b.x, nloc, nx); b.st[0] = nloc; b.st[1] = nx; }
        const unsigned old = xb_add(&bar[XB_XSUB(b.x)], 1u);
        const unsigned gen = old / nloc;
        if (old + 1u == (gen + 1u) * nloc) {
            __builtin_amdgcn_fence(__ATOMIC_RELEASE, "agent");
            asm volatile("s_waitcnt vmcnt(0)" ::: "memory");
            const unsigned og = xb_add(&bar[XB_TOP], 1u);
            const unsigned tg = og / nx;
            if (og + 1u == (tg + 1u) * nx) xb_add(&bar[XB_TOPGEN], 1u);
            else XB_SPIN(xb_ld(&bar[XB_TOPGEN]) == tg, bar);
            __builtin_amdgcn_fence(__ATOMIC_ACQUIRE, "agent");
            xb_add(&bar[XB_XGEN(b.x)], 1u);
            asm volatile("s_waitcnt vmcnt(0)" ::: "memory");
        } else {
            XB_SPIN(xb_ld(&bar[XB_XGEN(b.x)]) == gen, bar);
            __builtin_amdgcn_fence(__ATOMIC_ACQUIRE, "agent");
            asm volatile("s_waitcnt vmcnt(0)" ::: "memory");
        }
    }
    __syncthreads();
}
namespace mk {
using pg8::bf16_t; using pg8::bf16x8; using pg8::f32x4; using pg8::u32x4;
typedef unsigned u32x2 __attribute__((ext_vector_type(2)));

#ifndef MK_CHECK_ATT
#define MK_CHECK_ATT 0
#endif
#define MK_REP_SSDP 1
#define MK_REP_CONV 1
#define MK_REP_SCP 1
#define MK_REP_SCS 1
#define MK_REP_SSDS 1
#define MK_REP_ATTS 1
#define MK_REP_ATTP 1
#define MK_CHECK_TOL 0.02f
#define MK_CHECK_CODE ((b0 ? 1.f : 0.f) + (b1 ? 2.f : 0.f) + (b2 ? 4.f : 0.f) + (b3 ? 8.f : 0.f) + (b4 ? 16.f : 0.f) + (b5 ? 32.f : 0.f))
#define MK_REP_MASK 0
#define DUPK(k) (((MK_REP_MASK >> (k)) & 1) != 0)
#define REPK(k) for (int rep_ = 0; rep_ < 1 + ((MK_REP_MASK >> (k)) & 1); ++rep_)
#ifndef MK_SPLIT
#define MK_SPLIT 0
#endif

constexpr int NWAVES = 8, NTHR = 512;
constexpr int MP = 16384, MS = 512, M = MP + MS, D = 1024, DFF = 2816, DI = 2048, NP = 9472, XCW = 3072;
constexpr int PZ = 0, PXBC = 2048, PSM = 5120, PQ = 5376, PK = 6400, PV = 6656, PQI = 6912, PG = 7424;
constexpr int SCW = 2048, SCSW = 2112;
constexpr size_t O_Y = 0, O_KP = 17301504, O_VP = 21495808, O_KIP = 25690112, O_CVP = 26738688, O_SSP = 26812416,
                 O_KS = 28909568, O_VS = 29040640, O_KIS = 29171712, O_CVS = 29204480, O_SSS = 30384128, O_END = 63938560;
constexpr size_t MiB = 1u << 20;
constexpr size_t WS_CTL = 0, CTL_ZERO_BYTES = 1 * MiB;
constexpr size_t WS_W1A = 1 * MiB, WS_W1B = WS_W1A + 11 * MiB, WS_WIN = WS_W1B + 6 * MiB, WS_WBS = WS_WIN + 19 * MiB, WS_WBA = WS_WBS + 4 * MiB,
                 WS_WOUT = WS_WBA + 2 * MiB, WS_W2A = WS_WOUT + 2 * MiB, WS_W2B = WS_W2A + 11 * MiB;
constexpr size_t WS_XB = WS_W2B + 6 * MiB, WS_ACT = WS_XB + 33 * MiB, WS_T = WS_ACT + 91 * MiB, WS_HF = WS_T + 66 * MiB, WS_HB = WS_HF + 66 * MiB,
                 WS_P = WS_HB + 33 * MiB, WS_SMF = WS_P + 306 * MiB, WS_XC = WS_SMF + 9 * MiB, WS_Y = WS_XC + 99 * MiB, WS_SC = WS_Y + 66 * MiB,
                 WS_SCS = WS_SC + 128 * MiB, WS_YA = WS_SCS + 5 * MiB, WS_MG = WS_YA + 33 * MiB, WS_END = WS_MG + 33 * MiB;
constexpr int CW_BAR = 4096;
constexpr int LDS_BYTES = 163840, MISC_OFF = LDS_BYTES - 256;
constexpr int WAREA = 17920;
constexpr int BIASREL_OFF = NWAVES * WAREA;
static_assert(BIASREL_OFF + 2 * 129 * 16 * 4 <= MISC_OFF, "LDS map");

constexpr float ALPHA = 1.18920711500272f;
constexpr float LN_EPS = 1e-5f;

struct Args { const float* in[29]; float* out; unsigned char* ws; int ph_lo, ph_hi; };
enum { I_XP = 0, I_XS, I_CK, I_CV, I_CKI, I_SCONV, I_SSSM, I_PT, I_BIAS, I_WIN, I_CONVW, I_CONVB, I_DTB, I_ALOG, I_DSKIP, I_NORMG, I_WBS, I_WBA, I_WOUT,
       I_F1WI, I_F1WO, I_F2WI, I_F2WO, I_LN1G, I_LN1B, I_LN2G, I_LN2B, I_LN3G, I_LN3B };

__device__ __forceinline__ float bf2f(unsigned v) { return __uint_as_float(v << 16); }
__device__ __forceinline__ unsigned f2bf(float f) { unsigned u = __float_as_uint(f); return (u + 0x7fffu + ((u >> 16) & 1u)) >> 16; }
__device__ __forceinline__ unsigned pk2(float lo, float hi) { return pg8::cvt_pk_bf16(lo, hi); }
__device__ __forceinline__ void unpack8(const u32x4 w, float (&f)[8]) {
#pragma unroll
    for (int i = 0; i < 4; ++i) { f[2 * i] = __uint_as_float(w[i] << 16); f[2 * i + 1] = __uint_as_float(w[i] & 0xffff0000u); }
}
__device__ __forceinline__ u32x4 pack8(const float (&f)[8]) { u32x4 w; w.x = pk2(f[0], f[1]); w.y = pk2(f[2], f[3]); w.z = pk2(f[4], f[5]); w.w = pk2(f[6], f[7]); return w; }
__device__ __forceinline__ float sigmoidf_(float x) { return 1.0f / (1.0f + __expf(-x)); }
__device__ __forceinline__ float siluf_(float x) { return x / (1.0f + __expf(-x)); }
__device__ __forceinline__ float wave_sum(float v) {
#pragma unroll
    for (int o = 1; o < 64; o <<= 1) v += __shfl_xor(v, o);
    return v;
}
__device__ __forceinline__ float wave_max(float v) {
#pragma unroll
    for (int o = 1; o < 64; o <<= 1) v = fmaxf(v, __shfl_xor(v, o));
    return v;
}
__device__ __forceinline__ f32x4 mfma16(bf16x8 a, bf16x8 b, f32x4 c) { return __builtin_amdgcn_mfma_f32_16x16x32_bf16(a, b, c, 0, 0, 0); }
__device__ __forceinline__ int mbcnt64(unsigned long long m) { return (int)__builtin_amdgcn_mbcnt_hi((unsigned)(m >> 32), __builtin_amdgcn_mbcnt_lo((unsigned)m, 0u)); }

struct EpiSwiglu {
    static constexpr bool PERM = true, AFTER_DRAIN = false;
    bf16_t* O;
    __device__ __forceinline__ void operator()(const f32x4 (&acc)[2][2][4][2], const pg8::Unit& u, int wr, int wc, int fr, int fq) const {
        const int row0 = u.pm * 256 + wr * 64 + fr, col0 = u.pn * 128 + wc * 32 + 8 * fq;
#pragma unroll
        for (int ai = 0; ai < 2; ++ai)
#pragma unroll
            for (int m = 0; m < 4; ++m) {
                float o[8];
#pragma unroll
                for (int n = 0; n < 2; ++n)
#pragma unroll
                    for (int j = 0; j < 4; ++j) { const float g = acc[ai][0][m][n][j], up = acc[ai][1][m][n][j]; o[4 * n + j] = siluf_(g) * up; }
                *(u32x4*)(O + (size_t)(row0 + ai * 128 + m * 16) * DFF + col0) = pack8(o);
            }
    }
};
struct EpiResid {
    static constexpr bool PERM = false, AFTER_DRAIN = false;
    const float* base_p; const float* base_s; float* T; float alpha, s;
    __device__ __forceinline__ void operator()(const f32x4 (&acc)[2][2][4][2], const pg8::Unit& u, int wr, int wc, int fr, int fq) const {
        const int row0 = u.pm * 256 + wr * 64 + fr, col0 = u.pn * 256 + wc * 32 + 4 * fq;
#pragma unroll
        for (int ai = 0; ai < 2; ++ai)
#pragma unroll
            for (int m = 0; m < 4; ++m) {
                const int r = row0 + ai * 128 + m * 16;
                const float* b = (r < MP) ? base_p + (size_t)r * D : base_s + (size_t)(r - MP) * D;
#pragma unroll
                for (int bj = 0; bj < 2; ++bj)
#pragma unroll
                    for (int n = 0; n < 2; ++n) { const int c = col0 + bj * 128 + n * 16; const f32x4 bv = *(const f32x4*)(b + c);
                        *(f32x4*)(T + (size_t)r * D + c) = bv * alpha + acc[ai][bj][m][n] * s; }
            }
    }
};
struct EpiWin {
    static constexpr bool PERM = true, AFTER_DRAIN = false;
    bf16_t* P; float* smf; float* out;
    __device__ __forceinline__ void operator()(const f32x4 (&acc)[2][2][4][2], const pg8::Unit& u, int wr, int wc, int fr, int fq) const {
        const int row0 = u.pm * 256 + wr * 64 + fr, cl = wc * 32 + 8 * fq, col0 = u.pn * 256 + cl;
#pragma unroll
        for (int ai = 0; ai < 2; ++ai)
#pragma unroll
            for (int m = 0; m < 4; ++m) {
                const int r = row0 + ai * 128 + m * 16;
#pragma unroll
                for (int bj = 0; bj < 2; ++bj) {
                    const f32x4 v0 = acc[ai][bj][m][0], v1 = acc[ai][bj][m][1];
                    u32x4 w; w.x = pk2(v0[0], v0[1]); w.y = pk2(v0[2], v0[3]); w.z = pk2(v1[0], v1[1]); w.w = pk2(v1[2], v1[3]);
                    *(u32x4*)(P + (size_t)r * NP + col0 + bj * 128) = w;
                    if (u.pn == 20) {
                        if (bj == 0) {
                            float* d = smf + (size_t)r * 128 + cl; *(f32x4*)d = v0; *(f32x4*)(d + 4) = v1;
                            if (cl >= 64) { float* k = out + ((r < MP) ? O_KIP + (size_t)r * 64 : O_KIS + (size_t)(r - MP) * 64) + (cl - 64); *(f32x4*)k = v0; *(f32x4*)(k + 4) = v1; }
                        }
                    } else if (u.pn == 25) {
                        float* k = out + ((r < MP) ? O_KP + (size_t)r * 256 : O_KS + (size_t)(r - MP) * 256) + bj * 128 + cl; *(f32x4*)k = v0; *(f32x4*)(k + 4) = v1;
                    } else if (u.pn == 26) {
                        float* k = out + ((r < MP) ? O_VP + (size_t)r * 256 : O_VS + (size_t)(r - MP) * 256) + bj * 128 + cl; *(f32x4*)k = v0; *(f32x4*)(k + 4) = v1;
                    }
                }
            }
    }
};
struct EpiGateA {
    static constexpr bool PERM = false, AFTER_DRAIN = false;
    const bf16_t* P; int gcol; float* M1;
    __device__ __forceinline__ void operator()(const f32x4 (&acc)[2][2][4][2], const pg8::Unit& u, int wr, int wc, int fr, int fq) const {
        const int row0 = u.pm * 256 + wr * 64 + fr, col0 = u.pn * 256 + wc * 32 + 4 * fq;
#pragma unroll
        for (int ai = 0; ai < 2; ++ai)
#pragma unroll
            for (int m = 0; m < 4; ++m) {
                const int r = row0 + ai * 128 + m * 16;
#pragma unroll
                for (int bj = 0; bj < 2; ++bj)
#pragma unroll
                    for (int n = 0; n < 2; ++n) { const int c = col0 + bj * 128 + n * 16; const u32x2 gw = *(const u32x2*)(P + (size_t)r * NP + gcol + c);
                        f32x4 g; g[0] = sigmoidf_(__uint_as_float(gw.x << 16)); g[1] = sigmoidf_(__uint_as_float(gw.x & 0xffff0000u)); g[2] = sigmoidf_(__uint_as_float(gw.y << 16)); g[3] = sigmoidf_(__uint_as_float(gw.y & 0xffff0000u));
                        *(f32x4*)(M1 + (size_t)r * D + c) = g * acc[ai][bj][m][n]; }
            }
    }
};
struct EpiGateS {
    static constexpr bool PERM = true, AFTER_DRAIN = false;
    const bf16_t* P; int gcol; const float* M1; bf16_t* MG;
    __device__ __forceinline__ void operator()(const f32x4 (&acc)[2][2][4][2], const pg8::Unit& u, int wr, int wc, int fr, int fq) const {
        const int row0 = u.pm * 256 + wr * 64 + fr, col0 = u.pn * 256 + wc * 32 + 8 * fq;
#pragma unroll
        for (int ai = 0; ai < 2; ++ai)
#pragma unroll
            for (int m = 0; m < 4; ++m) {
                const int r = row0 + ai * 128 + m * 16;
#pragma unroll
                for (int bj = 0; bj < 2; ++bj) { const int c = col0 + bj * 128;
                    const u32x4 gw = *(const u32x4*)(P + (size_t)r * NP + gcol + c); float g[8]; unpack8(gw, g);
                    const f32x4 m0 = *(const f32x4*)(M1 + (size_t)r * D + c), m1 = *(const f32x4*)(M1 + (size_t)r * D + c + 4);
                    float o[8];
#pragma unroll
                    for (int j = 0; j < 4; ++j) { o[j] = m0[j] + sigmoidf_(g[j]) * acc[ai][bj][m][0][j]; o[4 + j] = m1[j] + sigmoidf_(g[4 + j]) * acc[ai][bj][m][1][j]; }
                    *(u32x4*)(MG + (size_t)r * D + c) = pack8(o); }
            }
    }
};

struct SkResid { const float* base; float* T; float alpha, s;
    __device__ __forceinline__ void operator()(int r, int c, f32x4 v) const { const f32x4 bv = *(const f32x4*)(base + (size_t)(r - MP) * D + c); *(f32x4*)(T + (size_t)r * D + c) = bv * alpha + v * s; } };
struct SkGateA { const bf16_t* P; int gcol; float* M1;
    __device__ __forceinline__ void operator()(int r, int c, f32x4 v) const { const u32x2 gw = *(const u32x2*)(P + (size_t)r * NP + gcol + c);
        f32x4 g; g[0] = sigmoidf_(__uint_as_float(gw.x << 16)); g[1] = sigmoidf_(__uint_as_float(gw.x & 0xffff0000u)); g[2] = sigmoidf_(__uint_as_float(gw.y << 16)); g[3] = sigmoidf_(__uint_as_float(gw.y & 0xffff0000u));
        *(f32x4*)(M1 + (size_t)r * D + c) = g * v; } };
struct SkGateS { const bf16_t* P; int gcol; const float* M1; bf16_t* MG;
    __device__ __forceinline__ void operator()(int r, int c, f32x4 v) const { const u32x2 gw = *(const u32x2*)(P + (size_t)r * NP + gcol + c); const f32x4 m = *(const f32x4*)(M1 + (size_t)r * D + c);
        const float o0 = m[0] + sigmoidf_(__uint_as_float(gw.x << 16)) * v[0], o1 = m[1] + sigmoidf_(__uint_as_float(gw.x & 0xffff0000u)) * v[1], o2 = m[2] + sigmoidf_(__uint_as_float(gw.y << 16)) * v[2], o3 = m[3] + sigmoidf_(__uint_as_float(gw.y & 0xffff0000u)) * v[3];
        u32x2 w; w.x = pk2(o0, o1); w.y = pk2(o2, o3); *(u32x2*)(MG + (size_t)r * D + c) = w; } };
template <int K, class Epi>
__device__ __forceinline__ void skinny_gemm(LAS unsigned char* lds, const bf16_t* A  , const bf16_t* Bt, const Epi& E, int bx, int G, int wave, int lane) {
    constexpr int KW = K / 8, NS = KW / 32;
    const int fr = lane & 15, fq = lane >> 4, tid = wave * 64 + lane;
    LAS float* part = (LAS float*)lds;
    for (int tile = bx; tile < 256; tile += G) {
        const int tm = tile >> 4, tn = tile & 15;
        const bf16_t* ap = A + (size_t)(tm * 32 + fr) * K + wave * KW + 8 * fq;
        const bf16_t* bp = Bt + (size_t)(tn * 64 + fr) * K + wave * KW + 8 * fq;
        f32x4 acc[2][4];
#pragma unroll
        for (int m = 0; m < 2; ++m)
#pragma unroll
            for (int n = 0; n < 4; ++n) acc[m][n] = (f32x4){0.f, 0.f, 0.f, 0.f};
#pragma unroll 4
        for (int ks = 0; ks < NS; ++ks) {
            bf16x8 a[2], bb[4];
#pragma unroll
            for (int m = 0; m < 2; ++m) a[m] = *(const bf16x8*)(ap + (size_t)m * 16 * K + ks * 32);
#pragma unroll
            for (int n = 0; n < 4; ++n) bb[n] = *(const bf16x8*)(bp + (size_t)n * 16 * K + ks * 32);
#pragma unroll
            for (int m = 0; m < 2; ++m)
#pragma unroll
                for (int n = 0; n < 4; ++n) acc[m][n] = mfma16(a[m], bb[n], acc[m][n]);
        }
#pragma unroll
        for (int m = 0; m < 2; ++m)
#pragma unroll
            for (int n = 0; n < 4; ++n)
#pragma unroll
                for (int j = 0; j < 4; ++j) part[(wave * 32 + m * 16 + 4 * fq + j) * 64 + n * 16 + fr] = acc[m][n][j];
        __syncthreads();
        { const int row = tid >> 4, c4 = (tid & 15) * 4; f32x4 v = {0.f, 0.f, 0.f, 0.f};
#pragma unroll
          for (int w = 0; w < 8; ++w) v += *(const LAS f32x4*)(part + (w * 32 + row) * 64 + c4);
          E(MP + tm * 32 + row, tn * 64 + c4, v); }
        __syncthreads();
    }
}

__device__ __forceinline__ int tr_src(int mode, int n) {
    if (mode == 0) return n;
    if (mode == 1) { const int j = n >> 8, i = n & 255; return (i < 128) ? j * 128 + i : DFF + j * 128 + (i - 128); }
    if (n < 5120) return n;
    if (n < 5376) { const int j = n - 5120; if (j < 32) return 5120 + j; if (j < 40) return 7264 + (j - 32); if (j >= 64 && j < 128) return 7200 + (j - 64); return -1; }
    if (n < 6400) return 5152 + (n - 5376);
    if (n < 6656) return 6176 + (n - 6400);
    if (n < 6912) return 6432 + (n - 6656);
    if (n < 7424) return 6688 + (n - 6912);
    return 7272 + (n - 7424);
}
__device__ __forceinline__ void tr_item(const float* W, int K, int Nsrc, bf16_t* WT, int k0, int n0, int mode, LAS bf16_t* scr, int lane) {
    const int kr = lane >> 4, nc = (lane & 15) * 4;
    const int sc = tr_src(mode, n0 + nc);
    f32x4 v[16];
#pragma unroll
    for (int i = 0; i < 16; ++i) v[i] = (sc >= 0) ? *(const f32x4*)(W + (size_t)(k0 + 4 * i + kr) * Nsrc + sc) : (f32x4){0.f, 0.f, 0.f, 0.f};
#pragma unroll
    for (int i = 0; i < 16; ++i) { const int k = 4 * i + kr; const unsigned p01 = pk2(v[i][0], v[i][1]), p23 = pk2(v[i][2], v[i][3]);
        scr[(nc + 0) * 72 + k] = (bf16_t)(p01 & 0xffffu); scr[(nc + 1) * 72 + k] = (bf16_t)(p01 >> 16); scr[(nc + 2) * 72 + k] = (bf16_t)(p23 & 0xffffu); scr[(nc + 3) * 72 + k] = (bf16_t)(p23 >> 16); }
    asm volatile("s_waitcnt lgkmcnt(0)" ::: "memory");
    const int nr = lane >> 3, kc = (lane & 7) * 8;
#pragma unroll
    for (int i = 0; i < 8; ++i) { const int n = 8 * i + nr; *(u32x4*)(WT + (size_t)(n0 + n) * K + k0 + kc) = *(const LAS u32x4*)(scr + n * 72 + kc); }
    asm volatile("s_waitcnt lgkmcnt(0)" ::: "memory");
}
__device__ __forceinline__ void p0_prologue(const Args& A, LAS unsigned char* lds, int gw, int NGW, int wave, int lane) {
    LAS bf16_t* scr = (LAS bf16_t*)(lds + wave * 16384);
    unsigned char* ws = A.ws;
    constexpr int NI0 = 16 * 88, NI1 = 44 * 16, NI2 = 16 * 148, NI3 = 32 * 16, NI4 = 16 * 16, NI5 = 16 * 16, NI6 = NI0, NI7 = NI1;
    constexpr int NIT = NI0 + NI1 + NI2 + NI3 + NI4 + NI5 + NI6 + NI7;
    for (int it = gw; it < NIT; it += NGW) {
        int r = it; const float* W; bf16_t* WT; int K, Nsrc, nblk, mode;
        if (r < NI0) { W = A.in[I_F1WI]; WT = (bf16_t*)(ws + WS_W1A); K = 1024; Nsrc = 2 * DFF; nblk = 88; mode = 1; }
        else if ((r -= NI0) < NI1) { W = A.in[I_F1WO]; WT = (bf16_t*)(ws + WS_W1B); K = DFF; Nsrc = 1024; nblk = 16; mode = 0; }
        else if ((r -= NI1) < NI2) { W = A.in[I_WIN]; WT = (bf16_t*)(ws + WS_WIN); K = 1024; Nsrc = 9320; nblk = 148; mode = 2; }
        else if ((r -= NI2) < NI3) { W = A.in[I_WBS]; WT = (bf16_t*)(ws + WS_WBS); K = 2048; Nsrc = 1024; nblk = 16; mode = 0; }
        else if ((r -= NI3) < NI4) { W = A.in[I_WBA]; WT = (bf16_t*)(ws + WS_WBA); K = 1024; Nsrc = 1024; nblk = 16; mode = 0; }
        else if ((r -= NI4) < NI5) { W = A.in[I_WOUT]; WT = (bf16_t*)(ws + WS_WOUT); K = 1024; Nsrc = 1024; nblk = 16; mode = 0; }
        else if ((r -= NI5) < NI6) { W = A.in[I_F2WI]; WT = (bf16_t*)(ws + WS_W2A); K = 1024; Nsrc = 2 * DFF; nblk = 88; mode = 1; }
        else { r -= NI6; W = A.in[I_F2WO]; WT = (bf16_t*)(ws + WS_W2B); K = DFF; Nsrc = 1024; nblk = 16; mode = 0; }
        const int kb = r / nblk, nb = r % nblk;
        tr_item(W, K, Nsrc, WT, kb * 64, nb * 64, mode, scr, lane);
    }
    bf16_t* XB = (bf16_t*)(ws + WS_XB);
    const int nchunk = M * D / 8;
    for (int ch0 = gw * 256 + lane; ch0 < nchunk; ch0 += NGW * 256) {
        f32x4 a[4], b[4];
#pragma unroll
        for (int u = 0; u < 4; ++u) { const int ch = ch0 + 64 * u, m = ch >> 7, c = (ch & 127) * 8;
            const float* src = (m < MP) ? A.in[I_XP] + (size_t)m * D + c : A.in[I_XS] + (size_t)(m - MP) * D + c; a[u] = *(const f32x4*)src; b[u] = *(const f32x4*)(src + 4); }
#pragma unroll
        for (int u = 0; u < 4; ++u) { const int ch = ch0 + 64 * u, m = ch >> 7, c = (ch & 127) * 8;
            u32x4 w; w.x = pk2(a[u][0], a[u][1]); w.y = pk2(a[u][2], a[u][3]); w.z = pk2(b[u][0], b[u][1]); w.w = pk2(b[u][2], b[u][3]);
            *(u32x4*)(XB + (size_t)m * D + c) = w; }
    }
}

__device__ __forceinline__ void ln_phase(const float* T, const float* g, const float* b, float* outf, bf16_t* outb, int gw, int NGW, int lane) {
    f32x4 gv[4], bv[4];
#pragma unroll
    for (int j = 0; j < 4; ++j) { gv[j] = *(const f32x4*)(g + 4 * lane + 256 * j); bv[j] = *(const f32x4*)(b + 4 * lane + 256 * j); }
    for (int m = gw; m < M; m += NGW) {
        const float* xr = T + (size_t)m * D + 4 * lane;
        f32x4 v[4]; float s = 0.f;
#pragma unroll
        for (int j = 0; j < 4; ++j) { v[j] = *(const f32x4*)(xr + 256 * j); s += (v[j][0] + v[j][1]) + (v[j][2] + v[j][3]); }
        const float mean = wave_sum(s) * (1.f / D); float s2 = 0.f;
#pragma unroll
        for (int j = 0; j < 4; ++j) { v[j] = v[j] - mean; s2 += (v[j][0] * v[j][0] + v[j][1] * v[j][1]) + (v[j][2] * v[j][2] + v[j][3] * v[j][3]); }
        const float rstd = 1.0f / sqrtf(wave_sum(s2) * (1.f / D) + LN_EPS);
#pragma unroll
        for (int j = 0; j < 4; ++j) {
            const f32x4 o = v[j] * rstd * gv[j] + bv[j];
            *(f32x4*)(outf + (size_t)m * D + 4 * lane + 256 * j) = o;
            if (outb) { u32x2 w; w.x = pk2(o[0], o[1]); w.y = pk2(o[2], o[3]); *(u32x2*)(outb + (size_t)m * D + 4 * lane + 256 * j) = w; }
        }
    }
}

template <int NT  , bool SAMP>
__device__ __forceinline__ void conv_item(const Args& A, int b, int t0, int cg, int lane) {
    const bf16_t* P = (const bf16_t*)(A.ws + WS_P); bf16_t* XC = (bf16_t*)(A.ws + WS_XC);
    const float* cw = A.in[I_CONVW]; const float* cb = A.in[I_CONVB];
    const int ch = (cg * 64 + lane) * 8;
    const size_t row0 = SAMP ? (size_t)(MP + b * 4) : (size_t)(b * 2048 + t0);
    u32x4 raw[NT + 3];
#pragma unroll
    for (int i = 0; i < NT + 3; ++i) {
        const int t = t0 - 3 + i;
        if (t >= 0) raw[i] = *(const u32x4*)(P + (row0 + (size_t)(i - 3)) * NP + PXBC + ch);
        else raw[i] = (u32x4){0u, 0u, 0u, 0u};
    }
    float w[4][8], bias[8];
#pragma unroll
    for (int j = 0; j < 4; ++j) { const f32x4 w0 = *(const f32x4*)(cw + (size_t)j * XCW + ch), w1 = *(const f32x4*)(cw + (size_t)j * XCW + ch + 4);
#pragma unroll
        for (int i = 0; i < 4; ++i) { w[j][i] = w0[i]; w[j][4 + i] = w1[i]; } }
    { const f32x4 b0 = *(const f32x4*)(cb + ch), b1 = *(const f32x4*)(cb + ch + 4);
#pragma unroll
      for (int i = 0; i < 4; ++i) { bias[i] = b0[i]; bias[4 + i] = b1[i]; } }
    float u0[8], u1[8], u2[8];
    if (SAMP) {
        const float* sc = A.in[I_SCONV] + (size_t)b * 3 * XCW + ch;
#pragma unroll
        for (int i = 0; i < 4; ++i) { const f32x4 a0 = *(const f32x4*)(sc), a1 = *(const f32x4*)(sc + 4), c0 = *(const f32x4*)(sc + XCW), c1 = *(const f32x4*)(sc + XCW + 4), e0 = *(const f32x4*)(sc + 2 * XCW), e1 = *(const f32x4*)(sc + 2 * XCW + 4);
            u0[i] = a0[i]; u0[4 + i] = a1[i]; u1[i] = c0[i]; u1[4 + i] = c1[i]; u2[i] = e0[i]; u2[4 + i] = e1[i]; }
    } else { unpack8(raw[0], u0); unpack8(raw[1], u1); unpack8(raw[2], u2); }
#pragma unroll
    for (int i = 0; i < NT; ++i) {
        float u3[8], o[8]; unpack8(raw[i + 3], u3);
#pragma unroll
        for (int e = 0; e < 8; ++e) o[e] = siluf_(bias[e] + w[0][e] * u0[e] + w[1][e] * u1[e] + w[2][e] * u2[e] + w[3][e] * u3[e]);
        *(u32x4*)(XC + (row0 + (size_t)i) * XCW + ch) = pack8(o);
        const int t = t0 + i; float* cs = nullptr;
        if (!SAMP) { if (t >= 2045) cs = A.out + O_CVP + ((size_t)b * 3 + (t - 2045)) * XCW + ch; }
        else { if (t >= 1) cs = A.out + O_CVS + ((size_t)b * 3 + (t - 1)) * XCW + ch; }
        if (cs) { *(f32x4*)cs = (f32x4){u3[0], u3[1], u3[2], u3[3]}; *(f32x4*)(cs + 4) = (f32x4){u3[4], u3[5], u3[6], u3[7]}; }
#pragma unroll
        for (int e = 0; e < 8; ++e) { u0[e] = u1[e]; u1[e] = u2[e]; u2[e] = u3[e]; }
    }
}
__device__ __forceinline__ void conv_phase(const Args& A, int gw, int NGW, int lane) {
    constexpr int NPI = 8 * 128 * 6, NSI = 128 * 6;
    for (int it = gw; it < NPI + NSI; it += NGW) {
        if (it < NPI) { const int cg = it % 6, r = it / 6; conv_item<16, false>(A, r >> 7, (r & 127) * 16, cg, lane); }
        else { const int r = it - NPI; conv_item<4, true>(A, r / 6, 0, r % 6, lane); }
    }
}

constexpr float IDX_SCALE = 0.125f * 0.35355339059327373f;
constexpr int SCL = 2052;
__device__ __forceinline__ unsigned f2key(float v) { unsigned u = (v == 0.f) ? 0u : __float_as_uint(v); return (u & 0x80000000u) ? ~u : (u | 0x80000000u); }
__device__ __forceinline__ void scores_select_prompt_unit(const Args& A, LAS unsigned char* lds, int b, int qt, int wave, int lane_in) {
    const bf16_t* P = (const bf16_t*)(A.ws + WS_P); const float* SMF = (const float*)(A.ws + WS_SMF);
    unsigned long long* MASKW = (unsigned long long*)(A.ws + WS_SC);
    LAS float* sc = (LAS float*)lds;
    int lane = lane_in; asm volatile("" : "+v"(lane));
    const int fr = lane & 15, fq = lane >> 4;
    {
        const size_t rowq = (size_t)(b * 2048 + qt * 16 + fr);
        bf16x8 Af[8][2];
#pragma unroll
        for (int h = 0; h < 8; ++h)
#pragma unroll
            for (int ks = 0; ks < 2; ++ks) Af[h][ks] = *(const bf16x8*)(P + rowq * NP + PQI + h * 64 + ks * 32 + 8 * fq);
        float wq[4][8];
#pragma unroll
        for (int j = 0; j < 4; ++j) { const float* wp = SMF + (size_t)(b * 2048 + qt * 16 + 4 * fq + j) * 128 + 32; const f32x4 w0 = *(const f32x4*)wp, w1 = *(const f32x4*)(wp + 4);
#pragma unroll
            for (int h = 0; h < 4; ++h) { wq[j][h] = w0[h] * IDX_SCALE; wq[j][4 + h] = w1[h] * IDX_SCALE; } }
        const bf16_t* kbase = P + (size_t)(b * 2048 + fr) * NP + PSM + 64 + 8 * fq;
        bf16x8 nB0 = {0, 0, 0, 0, 0, 0, 0, 0}, nB1 = nB0;
        if (wave <= qt) { const bf16_t* kp = kbase + (size_t)wave * 16 * NP; nB0 = *(const bf16x8*)kp; nB1 = *(const bf16x8*)(kp + 32); }
        for (int kt = wave; kt <= qt; kt += NWAVES) {
            const bf16x8 B0 = nB0, B1 = nB1;
            if (kt + NWAVES <= qt) { const bf16_t* kp = kbase + (size_t)(kt + NWAVES) * 16 * NP; nB0 = *(const bf16x8*)kp; nB1 = *(const bf16x8*)(kp + 32); }
            f32x4 scv = {0.f, 0.f, 0.f, 0.f};
#pragma unroll
            for (int h = 0; h < 8; ++h) { f32x4 d = {0.f, 0.f, 0.f, 0.f}; d = mfma16(Af[h][0], B0, d); d = mfma16(Af[h][1], B1, d);
#pragma unroll
                for (int j = 0; j < 4; ++j) scv[j] += wq[j][h] * fmaxf(d[j], 0.f); }
#pragma unroll
            for (int j = 0; j < 4; ++j) sc[(4 * fq + j) * SCL + kt * 16 + fr] = scv[j];
#if MK_CHECK_ATT
#pragma unroll
            for (int j = 0; j < 4; ++j) ((float*)(A.ws + WS_END))[(size_t)(b * 2048 + qt * 16 + 4 * fq + j) * SCW + kt * 16 + fr] = scv[j];
#endif
        }
    }
    __syncthreads();
#pragma unroll 1
    for (int u = 0; u < 2; ++u) {
        const int ql = 2 * wave + u, t = qt * 16 + ql, nvalid = t + 1;
        const LAS float* srow = sc + ql * SCL + lane;
        unsigned key[32];
#pragma unroll
        for (int j = 0; j < 32; ++j) key[j] = (lane < nvalid - 64 * j) ? f2key(srow[64 * j]) : 0u;
        unsigned T = 0u; int need_eq = 0;
        if (nvalid > 256) {
            bool exact = false;
            for (int bit = 31; bit >= 0; --bit) {
                const unsigned cand = T | (1u << bit); int cnt = 0;
#pragma unroll
                for (int j = 0; j < 32; ++j) cnt += __popcll(__ballot(key[j] >= cand));
                if (cnt >= 256) { T = cand; if (cnt == 256) { exact = true; break; } }
            }
            if (exact) { T -= 1u; }
            else { int cgt = 0;
#pragma unroll
                for (int j = 0; j < 32; ++j) cgt += __popcll(__ballot(key[j] > T));
                need_eq = 256 - cgt; }
        }
        int eqused = 0; unsigned long long mine = 0ull;
#pragma unroll
        for (int j = 0; j < 32; ++j) {
            unsigned long long ms;
            if (need_eq > 0) {
                const bool gt = key[j] > T, eq = key[j] == T;
                const unsigned long long meq = __ballot(eq);
                const bool sel = gt || (eq && (eqused + mbcnt64(meq) < need_eq));
                eqused += __popcll(meq);
                ms = __ballot(sel);
            } else ms = __ballot(key[j] > T);
            if (lane == j) mine = ms;
        }
        if (lane < 32) MASKW[(size_t)(b * 2048 + t) * 32 + lane] = mine;
    }
    __syncthreads();
}
__device__ __forceinline__ void scores_sample_unit(const Args& A, int b, int half, int wave, int lane) {
    const bf16_t* P = (const bf16_t*)(A.ws + WS_P); const float* SMF = (const float*)(A.ws + WS_SMF); float* SCS = (float*)(A.ws + WS_SCS);
    const int* pt = (const int*)A.in[I_PT]; const float* cki = A.in[I_CKI];
    const int fr = lane & 15, fq = lane >> 4;
    bf16x8 Af[2][2]; float wq[2][4];
#pragma unroll
    for (int mt = 0; mt < 2; ++mt) {
#pragma unroll
        for (int ks = 0; ks < 2; ++ks) Af[mt][ks] = *(const bf16x8*)(P + (size_t)(MP + b * 4 + 2 * mt + (fr >> 3)) * NP + PQI + (fr & 7) * 64 + ks * 32 + 8 * fq);
        const f32x4 w = *(const f32x4*)(SMF + (size_t)(MP + b * 4 + 2 * mt + (fq >> 1)) * 128 + 32 + 4 * (fq & 1));
#pragma unroll
        for (int j = 0; j < 4; ++j) wq[mt][j] = w[j] * IDX_SCALE;
    }
    const int kt_end = (half == 0) ? 65 : 129;
    for (int kt = half * 65 + wave; kt < kt_end; kt += NWAVES) {
        const int key = kt * 16 + fr;
        bf16x8 B0, B1;
        if (key < 2048) {
            const int page = pt[b * 16 + (key >> 7)];
            const float* src = cki + ((size_t)page * 128 + (key & 127)) * 64 + 8 * fq;
            const f32x4 a0 = *(const f32x4*)src, a1 = *(const f32x4*)(src + 4), c0 = *(const f32x4*)(src + 32), c1 = *(const f32x4*)(src + 36);
            u32x4 w0, w1; w0.x = pk2(a0[0], a0[1]); w0.y = pk2(a0[2], a0[3]); w0.z = pk2(a1[0], a1[1]); w0.w = pk2(a1[2], a1[3]);
            w1.x = pk2(c0[0], c0[1]); w1.y = pk2(c0[2], c0[3]); w1.z = pk2(c1[0], c1[1]); w1.w = pk2(c1[2], c1[3]);
            B0 = __builtin_bit_cast(bf16x8, w0); B1 = __builtin_bit_cast(bf16x8, w1);
        } else if (key < 2052) {
            const bf16_t* src = P + (size_t)(MP + b * 4 + (key - 2048)) * NP + PSM + 64 + 8 * fq;
            B0 = *(const bf16x8*)src; B1 = *(const bf16x8*)(src + 32);
        } else { B0 = (bf16x8){0, 0, 0, 0, 0, 0, 0, 0}; B1 = B0; }
#pragma unroll
        for (int mt = 0; mt < 2; ++mt) {
            f32x4 d = {0.f, 0.f, 0.f, 0.f}; d = mfma16(Af[mt][0], B0, d); d = mfma16(Af[mt][1], B1, d);
            float s = 0.f;
#pragma unroll
            for (int j = 0; j < 4; ++j) s += wq[mt][j] * fmaxf(d[j], 0.f);
            s += __shfl_xor(s, 16);
            if ((fq & 1) == 0 && key < 2052) SCS[(size_t)(b * 4 + 2 * mt + (fq >> 1)) * SCSW + key] = s;
        }
    }
}

__device__ __forceinline__ float softplusf_(float x) { return fmaxf(x, 0.f) + log1pf(expf(-fabsf(x))); }
__device__ __forceinline__ void ssd_prompt_item(const Args& A, LAS unsigned char* lds, int b, int h) {
    const int tid = threadIdx.x, lane = tid & 63, wave = __builtin_amdgcn_readfirstlane(tid >> 6), fr = lane & 15, fq = lane >> 4;
    const int g = h >> 3;
    const bf16_t* XC = (const bf16_t*)(A.ws + WS_XC); const float* SMF = (const float*)(A.ws + WS_SMF); bf16_t* Y = (bf16_t*)(A.ws + WS_Y);
    LAS bf16_t* Cm = (LAS bf16_t*)lds;
    LAS bf16_t* Bm = Cm + 64 * 136;
    LAS bf16_t* Btw = Bm + 64 * 136;
    LAS bf16_t* Xt = Btw + 128 * 72;
    LAS bf16_t* Mt = Xt + 64 * 72;
    LAS bf16_t* Hp = Mt + 64 * 72;
    LAS float* cumA = (LAS float*)(Hp + 64 * 136);
    LAS float* dtvA = cumA + 2048; LAS float* wvA = dtvA + 2048; LAS float* ecumA = wvA + 2048;
    const float Ah = -expf(A.in[I_ALOG][h]), dtb = A.in[I_DTB][h], dsk = A.in[I_DSKIP][h];
    f32x4 hst[4];
#pragma unroll
    for (int i = 0; i < 4; ++i) hst[i] = (f32x4){0.f, 0.f, 0.f, 0.f};
    for (int i = tid; i < 64 * 136 / 8; i += NTHR) *(LAS u32x4*)(Hp + i * 8) = (u32x4){0u, 0u, 0u, 0u};
#pragma unroll 1
    for (int c = wave; c < 32; c += NWAVES) {
        const int tk = c * 64 + lane;
        const float dt = softplusf_(SMF[(size_t)(b * 2048 + tk) * 128 + h] + dtb);
        float v = dt * Ah;
#pragma unroll
        for (int o = 1; o < 64; o <<= 1) { const float n = __shfl_up(v, o); if (lane >= o) v += n; }
        const float ce = __shfl(v, 63);
        cumA[tk] = v; dtvA[tk] = dt; wvA[tk] = dt * expf(ce - v); ecumA[tk] = expf(v);
    }
    const int s0 = tid >> 4, part0 = tid & 15;
    const int xs = tid >> 3, xpart = tid & 7;
    u32x4 cr[2], br[2], xr;
    {
#pragma unroll
        for (int i = 0; i < 2; ++i) { const bf16_t* rp = XC + (size_t)(b * 2048 + s0 + 32 * i) * XCW + g * 128 + part0 * 8; cr[i] = *(const u32x4*)(rp + 2560); br[i] = *(const u32x4*)(rp + 2048); }
        xr = *(const u32x4*)(XC + (size_t)(b * 2048 + xs) * XCW + h * 64 + xpart * 8);
    }
    for (int c = 0; c < 32; ++c) {
        const int row0 = b * 2048 + c * 64;
        const LAS float* cum = cumA + c * 64; const LAS float* dtv = dtvA + c * 64; const LAS float* wv = wvA + c * 64; const LAS float* ecum = ecumA + c * 64;
        __syncthreads();
#pragma unroll
        for (int i = 0; i < 2; ++i) {
            const int s = s0 + 32 * i;
            *(LAS u32x4*)(Cm + s * 136 + part0 * 8) = cr[i];
            *(LAS u32x4*)(Bm + s * 136 + part0 * 8) = br[i];
            float bf[8]; unpack8(br[i], bf); const float w = wv[s];
#pragma unroll
            for (int e = 0; e < 8; ++e) Btw[(part0 * 8 + e) * 72 + s] = (bf16_t)f2bf(bf[e] * w);
        }
        {
#pragma unroll
            for (int e = 0; e < 4; ++e) { Xt[(xpart * 8 + 2 * e) * 72 + xs] = (bf16_t)(xr[e] & 0xffffu); Xt[(xpart * 8 + 2 * e + 1) * 72 + xs] = (bf16_t)(xr[e] >> 16); }
        }
#pragma unroll
        for (int p4 = 0; p4 < 4; ++p4) { u32x2 w; w.x = pk2(hst[p4][0], hst[p4][1]); w.y = pk2(hst[p4][2], hst[p4][3]);
            *(LAS u32x2*)(Hp + (16 * p4 + fr) * 136 + 16 * wave + 4 * fq) = w; }
        if (c + 1 < 32) {
#pragma unroll
            for (int i = 0; i < 2; ++i) { const bf16_t* rp = XC + (size_t)(row0 + 64 + s0 + 32 * i) * XCW + g * 128 + part0 * 8; cr[i] = *(const u32x4*)(rp + 2560); br[i] = *(const u32x4*)(rp + 2048); }
            xr = *(const u32x4*)(XC + (size_t)(row0 + 64 + xs) * XCW + h * 64 + xpart * 8);
        }
        __syncthreads();
        {
            const int st = wave >> 1, tt0 = 2 * (wave & 1);
            bf16x8 a[4];
#pragma unroll
            for (int ks = 0; ks < 4; ++ks) a[ks] = *(const LAS bf16x8*)(Bm + (16 * st + fr) * 136 + ks * 32 + 8 * fq);
#pragma unroll
            for (int u = 0; u < 2; ++u) {
                const int tt = tt0 + u; f32x4 d = {0.f, 0.f, 0.f, 0.f};
#pragma unroll
                for (int ks = 0; ks < 4; ++ks) { const bf16x8 bb = *(const LAS bf16x8*)(Cm + (16 * tt + fr) * 136 + ks * 32 + 8 * fq); d = mfma16(a[ks], bb, d); }
                const int t = 16 * tt + fr; const float ct = cum[t]; float mv[4];
#pragma unroll
                for (int j = 0; j < 4; ++j) { const int s = 16 * st + 4 * fq + j; mv[j] = (s <= t) ? d[j] * __expf(ct - cum[s]) * dtv[s] : 0.f; }
                u32x2 w; w.x = pk2(mv[0], mv[1]); w.y = pk2(mv[2], mv[3]);
                *(LAS u32x2*)(Mt + t * 72 + 16 * st + 4 * fq) = w;
            }
        }
        __syncthreads();
        {
            const int pt = wave >> 1, tt0 = 2 * (wave & 1);
            bf16x8 a1[2], a2[4];
#pragma unroll
            for (int ks = 0; ks < 2; ++ks) a1[ks] = *(const LAS bf16x8*)(Xt + (16 * pt + fr) * 72 + ks * 32 + 8 * fq);
#pragma unroll
            for (int ks = 0; ks < 4; ++ks) a2[ks] = *(const LAS bf16x8*)(Hp + (16 * pt + fr) * 136 + ks * 32 + 8 * fq);
#pragma unroll
            for (int u = 0; u < 2; ++u) {
                const int tt = tt0 + u; f32x4 d1 = {0.f, 0.f, 0.f, 0.f}, d2 = {0.f, 0.f, 0.f, 0.f};
#pragma unroll
                for (int ks = 0; ks < 2; ++ks) { const bf16x8 bb = *(const LAS bf16x8*)(Mt + (16 * tt + fr) * 72 + ks * 32 + 8 * fq); d1 = mfma16(a1[ks], bb, d1); }
#pragma unroll
                for (int ks = 0; ks < 4; ++ks) { const bf16x8 bb = *(const LAS bf16x8*)(Cm + (16 * tt + fr) * 136 + ks * 32 + 8 * fq); d2 = mfma16(a2[ks], bb, d2); }
                const int t = 16 * tt + fr; const float et = ecum[t]; float yv[4];
#pragma unroll
                for (int j = 0; j < 4; ++j) { const int p = 16 * pt + 4 * fq + j; yv[j] = d1[j] + et * d2[j] + dsk * bf2f((unsigned)Xt[p * 72 + t]); }
                u32x2 w; w.x = pk2(yv[0], yv[1]); w.y = pk2(yv[2], yv[3]);
                *(u32x2*)(Y + (size_t)(row0 + t) * DI + h * 64 + 16 * pt + 4 * fq) = w;
            }
            bf16x8 a3[2];
#pragma unroll
            for (int ks = 0; ks < 2; ++ks) a3[ks] = *(const LAS bf16x8*)(Btw + (16 * wave + fr) * 72 + ks * 32 + 8 * fq);
            const float dec = ecum[63];
#pragma unroll
            for (int p4 = 0; p4 < 4; ++p4) { f32x4 d = {0.f, 0.f, 0.f, 0.f};
#pragma unroll
                for (int ks = 0; ks < 2; ++ks) { const bf16x8 bb = *(const LAS bf16x8*)(Xt + (16 * p4 + fr) * 72 + ks * 32 + 8 * fq); d = mfma16(a3[ks], bb, d); }
                hst[p4] = hst[p4] * dec + d; }
        }
    }
    float* so = A.out + O_SSP + ((size_t)b * 32 + h) * 64 * 128;
#pragma unroll
    for (int p4 = 0; p4 < 4; ++p4) *(f32x4*)(so + (size_t)(16 * p4 + fr) * 128 + 16 * wave + 4 * fq) = hst[p4];
    __syncthreads();
}

__device__ __forceinline__ void ssd_sample_item(const Args& A, LAS unsigned char* wl, int b, int h, int lane) {
    const bf16_t* XC = (const bf16_t*)(A.ws + WS_XC); const float* SMF = (const float*)(A.ws + WS_SMF); bf16_t* Y = (bf16_t*)(A.ws + WS_Y);
    LAS float* red = (LAS float*)wl;
    const int g = h >> 3;
    const float Ah = -expf(A.in[I_ALOG][h]), dtb = A.in[I_DTB][h], dsk = A.in[I_DSKIP][h];
#pragma unroll 1
    for (int half = 0; half < 2; ++half) {
        const float* h0 = A.in[I_SSSM] + (((size_t)b * 32 + h) * 64 + 32 * half) * 128 + 2 * lane;
        float st[32][2];
#pragma unroll
        for (int p = 0; p < 32; ++p) { const float2 v = *(const float2*)(h0 + p * 128); st[p][0] = v.x; st[p][1] = v.y; }
#pragma unroll 1
        for (int t = 0; t < 4; ++t) {
            const size_t m = (size_t)(MP + b * 4 + t);
            const float dt = softplusf_(SMF[m * 128 + h] + dtb), dec = expf(dt * Ah);
            const unsigned bw = *(const unsigned*)(XC + m * XCW + 2048 + g * 128 + 2 * lane), cw = *(const unsigned*)(XC + m * XCW + 2560 + g * 128 + 2 * lane);
            const float b0 = bf2f(bw & 0xffffu) * dt, b1 = __uint_as_float(bw & 0xffff0000u) * dt, c0 = bf2f(cw & 0xffffu), c1 = __uint_as_float(cw & 0xffff0000u);
            const float xl = bf2f((unsigned)XC[m * XCW + h * 64 + 32 * half + (lane & 31)]);
#pragma unroll
            for (int p = 0; p < 32; ++p) {
                const float xp = __shfl(xl, p);
                st[p][0] = st[p][0] * dec + xp * b0; st[p][1] = st[p][1] * dec + xp * b1;
                red[p * 65 + lane] = st[p][0] * c0 + st[p][1] * c1;
            }
            asm volatile("s_waitcnt lgkmcnt(0)" ::: "memory");
            float y = 0.f;
#pragma unroll 16
            for (int i = 0; i < 64; ++i) y += red[(lane & 31) * 65 + i];
            y += dsk * xl;
            if (lane < 32) Y[m * DI + h * 64 + 32 * half + lane] = (bf16_t)f2bf(y);
            asm volatile("s_waitcnt lgkmcnt(0)" ::: "memory");
        }
        float* so = A.out + O_SSS + (((size_t)b * 32 + h) * 64 + 32 * half) * 128 + 2 * lane;
#pragma unroll
        for (int p = 0; p < 32; ++p) *(float2*)(so + p * 128) = make_float2(st[p][0], st[p][1]);
    }
}

__device__ __forceinline__ int t5_bucket(int n) {
    if (n < 16) return n;
    const float nf = (float)n;
    int large = 16 + (int)(logf(nf / 16.0f) / 2.0794415416798357f * 16.0f);
    return large < 31 ? large : 31;
}
typedef float f32x16 __attribute__((ext_vector_type(16)));
__device__ __forceinline__ f32x16 mfma32(bf16x8 a, bf16x8 b, f32x16 c) { return __builtin_amdgcn_mfma_f32_32x32x16_bf16(a, b, c, 0, 0, 0); }
constexpr float LOG2E = 1.4426950408889634f;
constexpr int AK_STR = 72, AV_STR = 68, AT_K0 = 0, AT_V0 = 2 * 64 * AK_STR * 2, AT_WS = AT_V0 + 2 * 64 * AV_STR * 2;
__device__ __forceinline__ void attn_prompt_unit(const Args& A, LAS unsigned char* lds, const LAS float* biasL, int b, int g, int qt, int wave, int lane_in) {
    const bf16_t* P = (const bf16_t*)(A.ws + WS_P); const unsigned* MASK32 = (const unsigned*)(A.ws + WS_SC); bf16_t* YA = (bf16_t*)(A.ws + WS_YA);
    int lane = lane_in; asm volatile("" : "+v"(lane));
    const int tid = wave * 64 + lane, r32 = lane & 31, hi = lane >> 5;
    LAS float* wsc = (LAS float*)(lds + AT_WS) + wave * 64;
    const int query = qt * 64 + 8 * wave + (r32 >> 2), head = 4 * g + (r32 & 3);
    const size_t qrow = (size_t)(b * 2048 + query);
    bf16x8 qf[4];
#pragma unroll
    for (int ds = 0; ds < 4; ++ds) qf[ds] = *(const bf16x8*)(P + qrow * NP + PQ + head * 64 + 16 * ds + 8 * hi);
    const unsigned* mrow = MASK32 + qrow * 64;
    const float bfar = biasL[128 * 16 + head];
    const int skey = tid >> 3, sdch = tid & 7;
    const bf16_t* ksrc = P + (size_t)(b * 2048 + skey) * NP + PK + g * 64 + sdch * 8;
    f32x16 O0, O1;
#pragma unroll
    for (int i = 0; i < 16; ++i) { O0[i] = 0.f; O1[i] = 0.f; }
    float m_run = -1e30f, l_run = 0.f;
    u32x4 kreg = *(const u32x4*)ksrc, vreg = *(const u32x4*)(ksrc + 256);
    unsigned mw0 = mrow[0], mw1 = mrow[1];
    {
        LAS bf16_t* Kb = (LAS bf16_t*)(lds + AT_K0); LAS bf16_t* Vb = (LAS bf16_t*)(lds + AT_V0);
        *(LAS u32x4*)(Kb + skey * AK_STR + sdch * 8) = kreg;
#pragma unroll
        for (int e = 0; e < 4; ++e) { Vb[(sdch * 8 + 2 * e) * AV_STR + skey] = (bf16_t)(vreg[e] & 0xffffu); Vb[(sdch * 8 + 2 * e + 1) * AV_STR + skey] = (bf16_t)(vreg[e] >> 16); }
    }
    for (int kt = 0; kt <= qt; ++kt) {
        const int buf = kt & 1;
        __syncthreads();
        const unsigned w0 = mw0 >> (4 * hi), w1 = mw1 >> (4 * hi);
        if (kt < qt) { const bf16_t* src = ksrc + (size_t)(kt + 1) * 64 * NP; kreg = *(const u32x4*)src; vreg = *(const u32x4*)(src + 256); mw0 = mrow[2 * kt + 2]; mw1 = mrow[2 * kt + 3]; }
        const LAS bf16_t* Kb = (const LAS bf16_t*)(lds + AT_K0 + buf * (64 * AK_STR * 2)); const LAS bf16_t* Vb = (const LAS bf16_t*)(lds + AT_V0 + buf * (64 * AV_STR * 2));
        f32x16 S0, S1;
#pragma unroll
        for (int i = 0; i < 16; ++i) { S0[i] = 0.f; S1[i] = 0.f; }
#pragma unroll
        for (int ds = 0; ds < 4; ++ds) {
            const bf16x8 k0 = *(const LAS bf16x8*)(Kb + r32 * AK_STR + 16 * ds + 8 * hi), k1 = *(const LAS bf16x8*)(Kb + (32 + r32) * AK_STR + 16 * ds + 8 * hi);
            S0 = mfma32(k0, qf[ds], S0); S1 = mfma32(k1, qf[ds], S1);
        }
        const float c1 = 0.125f * LOG2E;
        if (qt - kt >= 3) {
#pragma unroll
            for (int i = 0; i < 16; ++i) { const unsigned bit = 1u << ((i & 3) + 8 * (i >> 2));
                S0[i] = (w0 & bit) ? S0[i] * c1 + bfar : -INFINITY; S1[i] = (w1 & bit) ? S1[i] * c1 + bfar : -INFINITY; }
        } else {
            const int kbase = kt * 64 + 4 * hi;
#pragma unroll
            for (int i = 0; i < 16; ++i) { const int pos = (i & 3) + 8 * (i >> 2); const unsigned bit = 1u << pos;
                int r0 = query - (kbase + pos), r1 = r0 - 32; r0 = r0 < 0 ? 0 : (r0 > 128 ? 128 : r0); r1 = r1 < 0 ? 0 : (r1 > 128 ? 128 : r1);
                S0[i] = (w0 & bit) ? S0[i] * c1 + biasL[r0 * 16 + head] : -INFINITY; S1[i] = (w1 & bit) ? S1[i] * c1 + biasL[r1 * 16 + head] : -INFINITY; }
        }
        float tm = fmaxf(S0[0], S1[0]);
#pragma unroll
        for (int i = 1; i < 16; ++i) tm = fmaxf(tm, fmaxf(S0[i], S1[i]));
        tm = fmaxf(tm, __shfl_xor(tm, 32));
        if (__any(tm > m_run + 8.0f)) {
            const float mn = fmaxf(m_run, tm), f = __builtin_amdgcn_exp2f(m_run - mn);
            m_run = mn; l_run *= f;
            if (hi == 0) wsc[r32] = f;
            asm volatile("s_waitcnt lgkmcnt(0)" ::: "memory");
#pragma unroll
            for (int i = 0; i < 16; ++i) { const float fi = wsc[(i & 3) + 8 * (i >> 2) + 4 * hi]; O0[i] *= fi; O1[i] *= fi; }
            asm volatile("s_waitcnt lgkmcnt(0)" ::: "memory");
        }
        float ls = 0.f;
#pragma unroll
        for (int i = 0; i < 16; ++i) { S0[i] = __builtin_amdgcn_exp2f(S0[i] - m_run); S1[i] = __builtin_amdgcn_exp2f(S1[i] - m_run); ls += S0[i] + S1[i]; }
        l_run += ls;
        bf16x8 pa[2][2];
#pragma unroll
        for (int sk = 0; sk < 2; ++sk) {
            u32x4 a0, a1;
            a0.x = pk2(S0[8 * sk + 0], S0[8 * sk + 1]); a0.y = pk2(S0[8 * sk + 2], S0[8 * sk + 3]); a0.z = pk2(S0[8 * sk + 4], S0[8 * sk + 5]); a0.w = pk2(S0[8 * sk + 6], S0[8 * sk + 7]);
            a1.x = pk2(S1[8 * sk + 0], S1[8 * sk + 1]); a1.y = pk2(S1[8 * sk + 2], S1[8 * sk + 3]); a1.z = pk2(S1[8 * sk + 4], S1[8 * sk + 5]); a1.w = pk2(S1[8 * sk + 6], S1[8 * sk + 7]);
            pa[0][sk] = __builtin_bit_cast(bf16x8, a0); pa[1][sk] = __builtin_bit_cast(bf16x8, a1);
        }
#pragma unroll
        for (int blk = 0; blk < 2; ++blk)
#pragma unroll
            for (int sk = 0; sk < 2; ++sk) {
                const int kb = 32 * blk + 16 * sk + 4 * hi;
                const u32x2 a = *(const LAS u32x2*)(Vb + r32 * AV_STR + kb), c = *(const LAS u32x2*)(Vb + r32 * AV_STR + kb + 8);
                const u32x2 a2 = *(const LAS u32x2*)(Vb + (32 + r32) * AV_STR + kb), c2 = *(const LAS u32x2*)(Vb + (32 + r32) * AV_STR + kb + 8);
                const u32x4 v0 = {a.x, a.y, c.x, c.y}, v1 = {a2.x, a2.y, c2.x, c2.y};
                O0 = mfma32(pa[blk][sk], __builtin_bit_cast(bf16x8, v0), O0);
                O1 = mfma32(pa[blk][sk], __builtin_bit_cast(bf16x8, v1), O1);
            }
        if (kt < qt) {
            LAS bf16_t* Kn = (LAS bf16_t*)(lds + AT_K0 + (buf ^ 1) * (64 * AK_STR * 2)); LAS bf16_t* Vn = (LAS bf16_t*)(lds + AT_V0 + (buf ^ 1) * (64 * AV_STR * 2));
            *(LAS u32x4*)(Kn + skey * AK_STR + sdch * 8) = kreg;
#pragma unroll
            for (int e = 0; e < 4; ++e) { Vn[(sdch * 8 + 2 * e) * AV_STR + skey] = (bf16_t)(vreg[e] & 0xffffu); Vn[(sdch * 8 + 2 * e + 1) * AV_STR + skey] = (bf16_t)(vreg[e] >> 16); }
        }
    }
    l_run += __shfl_xor(l_run, 32);
    if (hi == 0) wsc[r32] = 1.0f / l_run;
    asm volatile("s_waitcnt lgkmcnt(0)" ::: "memory");
#pragma unroll
    for (int i = 0; i < 16; ++i) {
        const int rq = (i & 3) + 8 * (i >> 2) + 4 * hi; const float inv = wsc[rq];
        bf16_t* dst = YA + (size_t)(b * 2048 + qt * 64 + 8 * wave + (rq >> 2)) * D + (4 * g + (rq & 3)) * 64 + r32;
        dst[0] = (bf16_t)f2bf(O0[i] * inv); dst[32] = (bf16_t)f2bf(O1[i] * inv);
    }
    __syncthreads();
}

__device__ __forceinline__ void attend_sample_task(const Args& A, LAS unsigned char* wl, const LAS float* biasrel, int ms, int g, int lane_in) {
    constexpr int NJ = 33;
    int lane = lane_in; asm volatile("" : "+v"(lane));
    const bf16_t* P = (const bf16_t*)(A.ws + WS_P);
    const int b = ms >> 2, t = ms & 3, nvalid = 2049 + t, qpos = 2048 + t, m = MP + ms;
    const float* srow = (const float*)(A.ws + WS_SCS) + (size_t)ms * SCSW;
    LAS float* pq = (LAS float*)wl;
    LAS unsigned* rowid = (LAS unsigned*)(wl + 4096);
    LAS unsigned short* posl = (LAS unsigned short*)(wl + 4096 + 1024);
    unsigned key[NJ];
#pragma unroll
    for (int j = 0; j < NJ; ++j) key[j] = (lane < nvalid - 64 * j) ? f2key(srow[lane + 64 * j]) : 0u;
    unsigned T = 0u; int need_eq = 0;
    {
        bool exact = false;
        for (int bit = 31; bit >= 0; --bit) {
            const unsigned cand = T | (1u << bit); int cnt = 0;
#pragma unroll
            for (int j = 0; j < NJ; ++j) cnt += __popcll(__ballot(key[j] >= cand));
            if (cnt >= 256) { T = cand; if (cnt == 256) { exact = true; break; } }
        }
        if (exact) { T -= 1u; }
        else { int cgt = 0;
#pragma unroll
            for (int j = 0; j < NJ; ++j) cgt += __popcll(__ballot(key[j] > T));
            need_eq = 256 - cgt; }
    }
    int base = 0, eqused = 0;
    const int* pt = (const int*)A.in[I_PT];
#pragma unroll
    for (int j = 0; j < NJ; ++j) {
        const bool gt = key[j] > T, eq = (need_eq > 0) && (key[j] == T);
        const unsigned long long meq = __ballot(eq);
        const bool sel = gt || (eq && (eqused + mbcnt64(meq) < need_eq));
        eqused += __popcll(meq);
        const unsigned long long msk = __ballot(sel);
        if (sel) { const int pos = lane + 64 * j, k = base + mbcnt64(msk);
            posl[k] = (unsigned short)pos;
            rowid[k] = (pos < 2048) ? (unsigned)(pt[b * 16 + (pos >> 7)] * 128 + (pos & 127)) : (0x80000000u | (unsigned)(b * 4 + pos - 2048)); }
        base += __popcll(msk);
    }
    { const u32x2 w = *(const u32x2*)(P + (size_t)m * NP + PQ + g * 256 + lane * 4);
      *(LAS f32x4*)(pq + lane * 4) = (f32x4){__uint_as_float(w.x << 16), __uint_as_float(w.x & 0xffff0000u), __uint_as_float(w.y << 16), __uint_as_float(w.y & 0xffff0000u)}; }
    asm volatile("s_waitcnt lgkmcnt(0)" ::: "memory");
    const float* ck = A.in[I_CK]; const float* cv = A.in[I_CV]; const float* kn = A.out + O_KS; const float* vn = A.out + O_VS;
    const float* kp[4]; int rel[4];
#pragma unroll
    for (int i = 0; i < 4; ++i) { const unsigned rid = rowid[lane + 64 * i]; rel[i] = qpos - (int)posl[lane + 64 * i];
        kp[i] = ((rid & 0x80000000u) ? kn + (size_t)(rid & 0x7fffffffu) * 256 : ck + (size_t)rid * 256) + g * 64; }
    float acc[4][4];
#pragma unroll
    for (int i = 0; i < 4; ++i)
#pragma unroll
        for (int hh = 0; hh < 4; ++hh) acc[i][hh] = 0.f;
#pragma unroll 2
    for (int dc = 0; dc < 16; ++dc) {
        f32x4 kv[4];
#pragma unroll
        for (int i = 0; i < 4; ++i) kv[i] = *(const f32x4*)(kp[i] + dc * 4);
#pragma unroll
        for (int hh = 0; hh < 4; ++hh) { const f32x4 q4 = *(const LAS f32x4*)(pq + hh * 64 + dc * 4);
#pragma unroll
            for (int i = 0; i < 4; ++i) acc[i][hh] += kv[i][0] * q4[0] + kv[i][1] * q4[1] + kv[i][2] * q4[2] + kv[i][3] * q4[3]; }
    }
    asm volatile("s_waitcnt lgkmcnt(0)" ::: "memory");
#pragma unroll
    for (int i = 0; i < 4; ++i) { const int rc = rel[i] < 128 ? (rel[i] < 0 ? 0 : rel[i]) : 128; const f32x4 bv = *(const LAS f32x4*)(biasrel + rc * 16 + 4 * g);
#pragma unroll
        for (int hh = 0; hh < 4; ++hh) acc[i][hh] = acc[i][hh] * 0.125f + bv[hh]; }
#pragma unroll
    for (int hh = 0; hh < 4; ++hh) {
        const float mx = wave_max(fmaxf(fmaxf(acc[0][hh], acc[1][hh]), fmaxf(acc[2][hh], acc[3][hh])));
        float sm = 0.f;
#pragma unroll
        for (int i = 0; i < 4; ++i) { acc[i][hh] = __expf(acc[i][hh] - mx); sm += acc[i][hh]; }
        const float inv = 1.0f / wave_sum(sm);
#pragma unroll
        for (int i = 0; i < 4; ++i) acc[i][hh] *= inv;
    }
#pragma unroll
    for (int i = 0; i < 4; ++i) *(LAS f32x4*)(pq + (lane + 64 * i) * 4) = (f32x4){acc[i][0], acc[i][1], acc[i][2], acc[i][3]};
    asm volatile("s_waitcnt lgkmcnt(0)" ::: "memory");
    float o[4] = {0.f, 0.f, 0.f, 0.f};
    for (int k0 = 0; k0 < 256; k0 += 8) {
        float vv[8]; f32x4 pp[8];
#pragma unroll
        for (int u = 0; u < 8; ++u) { const unsigned rid = rowid[k0 + u];
            const float* vp = ((rid & 0x80000000u) ? vn + (size_t)(rid & 0x7fffffffu) * 256 : cv + (size_t)rid * 256) + g * 64 + lane;
            vv[u] = *vp; pp[u] = *(const LAS f32x4*)(pq + (k0 + u) * 4); }
#pragma unroll
        for (int u = 0; u < 8; ++u)
#pragma unroll
            for (int hh = 0; hh < 4; ++hh) o[hh] += pp[u][hh] * vv[u];
    }
    bf16_t* YA = (bf16_t*)(A.ws + WS_YA);
#pragma unroll
    for (int hh = 0; hh < 4; ++hh) YA[(size_t)m * D + (4 * g + hh) * 64 + lane] = (bf16_t)f2bf(o[hh]);
    asm volatile("s_waitcnt lgkmcnt(0)" ::: "memory");
}

#if MK_CHECK_ATT
constexpr size_t WS_CHK_SC = WS_END, WS_CHK_YA = WS_CHK_SC + 128 * MiB, WS_CHK_MASK = WS_CHK_YA + 33 * MiB, WS_CHK_END = WS_CHK_MASK + 4 * MiB;
constexpr int CW_CHK = 512;
template <bool SAMPLE> struct KVRow;
template <> struct KVRow<false> {
    typedef const bf16_t* ptr;
    const bf16_t* P;
    __device__ __forceinline__ ptr krow(unsigned rid) const { return P + (size_t)rid * NP + PK; }
    __device__ __forceinline__ ptr vrow(unsigned rid) const { return P + (size_t)rid * NP + PV; }
    static __device__ __forceinline__ void k8(ptr p, float (&f)[8]) { unpack8(*(const u32x4*)p, f); }
    static __device__ __forceinline__ f32x4 v4(ptr p) { const u32x2 w = *(const u32x2*)p;
        return (f32x4){__uint_as_float(w.x << 16), __uint_as_float(w.x & 0xffff0000u), __uint_as_float(w.y << 16), __uint_as_float(w.y & 0xffff0000u)}; }
};
template <> struct KVRow<true> {
    typedef const float* ptr;
    const float* ck; const float* cv; const float* kn; const float* vn;
    __device__ __forceinline__ ptr krow(unsigned rid) const { return (rid & 0x80000000u) ? kn + (size_t)(rid & 0x7fffffffu) * 256 : ck + (size_t)rid * 256; }
    __device__ __forceinline__ ptr vrow(unsigned rid) const { return (rid & 0x80000000u) ? vn + (size_t)(rid & 0x7fffffffu) * 256 : cv + (size_t)rid * 256; }
    static __device__ __forceinline__ void k8(ptr p, float (&f)[8]) { const f32x4 a = *(const f32x4*)p, b = *(const f32x4*)(p + 4);
#pragma unroll
        for (int i = 0; i < 4; ++i) { f[i] = a[i]; f[4 + i] = b[i]; } }
    static __device__ __forceinline__ f32x4 v4(ptr p) { return *(const f32x4*)p; }
};

template <bool SAMPLE>
__device__ __forceinline__ void attend_query(const Args& A, LAS unsigned char* wl, const LAS float* biasrel, int m, int lane_in) {
    constexpr int NJ = SAMPLE ? 33 : 32;
    int lane = lane_in; asm volatile("" : "+v"(lane));
    const bf16_t* P = (const bf16_t*)(A.ws + WS_P);
    int b, nvalid, qpos; const float* srow;
    if (!SAMPLE) { b = m >> 11; const int t = m & 2047; nvalid = t + 1; qpos = t; srow = (const float*)(A.ws + WS_CHK_SC) + (size_t)m * SCW; }
    else { const int ms = m - MP; b = ms >> 2; const int t = ms & 3; nvalid = 2049 + t; qpos = 2048 + t; srow = (const float*)(A.ws + WS_SCS) + (size_t)ms * SCSW; }
    LAS float* pq = (LAS float*)wl;
    LAS unsigned* rowid = (LAS unsigned*)(wl + 16384);
    LAS unsigned short* posl = (LAS unsigned short*)(wl + 16384 + 1024);
    unsigned key[NJ];
#pragma unroll
    for (int j = 0; j < NJ; ++j) { key[j] = (lane < nvalid - 64 * j) ? f2key(srow[lane + 64 * j]) : 0u; }
    unsigned T = 0u; int need_eq = 0;
    if (nvalid > 256) {
        for (int bit = 31; bit >= 0; --bit) {
            const unsigned cand = T | (1u << bit); int cnt = 0;
#pragma unroll
            for (int j = 0; j < NJ; ++j) cnt += __popcll(__ballot(key[j] >= cand));
            if (cnt >= 256) T = cand;
        }
        int cgt = 0;
#pragma unroll
        for (int j = 0; j < NJ; ++j) cgt += __popcll(__ballot(key[j] > T));
        need_eq = 256 - cgt;
    }
    int base = 0, eqused = 0; unsigned long long mine_chk = 0ull;
    const int* pt = (const int*)A.in[I_PT];
#pragma unroll
    for (int j = 0; j < NJ; ++j) {
        const bool gt = key[j] > T, eq = (need_eq > 0) && (key[j] == T);
        const unsigned long long meq = __ballot(eq);
        const bool sel = gt || (eq && (eqused + mbcnt64(meq) < need_eq));
        eqused += __popcll(meq);
        const unsigned long long ms = __ballot(sel);
        if (sel) { const int pos = lane + 64 * j, k = base + mbcnt64(ms);
            posl[k] = (unsigned short)pos;
            unsigned rid;
            if (!SAMPLE) rid = (unsigned)(b * 2048 + pos);
            else rid = (pos < 2048) ? (unsigned)(pt[b * 16 + (pos >> 7)] * 128 + (pos & 127)) : (0x80000000u | (unsigned)(b * 4 + pos - 2048));
            rowid[k] = rid; }
        base += __popcll(ms);
        if (!SAMPLE) { if (lane == j) mine_chk = ms; }
    }
    if (!SAMPLE) { if (lane < 32) ((unsigned long long*)(A.ws + WS_CHK_MASK))[(size_t)m * 32 + lane] = mine_chk; }
    const int nsel = base;
    asm volatile("s_waitcnt lgkmcnt(0)" ::: "memory");
    { const unsigned r0 = rowid[0]; const unsigned short p0 = posl[0];
#pragma unroll
      for (int i = 0; i < 4; ++i) { const int k = lane + 64 * i; if (k >= nsel) { rowid[k] = r0; posl[k] = p0; } } }
    { const u32x4 w0 = *(const u32x4*)(P + (size_t)m * NP + PQ + lane * 16), w1 = *(const u32x4*)(P + (size_t)m * NP + PQ + lane * 16 + 8);
      float f0[8], f1[8]; unpack8(w0, f0); unpack8(w1, f1);
#pragma unroll
      for (int e = 0; e < 8; ++e) { pq[lane * 16 + e] = f0[e]; pq[lane * 16 + 8 + e] = f1[e]; } }
    asm volatile("s_waitcnt lgkmcnt(0)" ::: "memory");
    KVRow<SAMPLE> R;
    if constexpr (!SAMPLE) { R.P = P; } else { R.ck = A.in[I_CK]; R.cv = A.in[I_CV]; R.kn = A.out + O_KS; R.vn = A.out + O_VS; }
    typename KVRow<SAMPLE>::ptr kp[4]; int rel[4];
#pragma unroll
    for (int i = 0; i < 4; ++i) { kp[i] = R.krow(rowid[lane + 64 * i]); rel[i] = qpos - (int)posl[lane + 64 * i]; }
    float acc[4][16];
#pragma unroll
    for (int i = 0; i < 4; ++i)
#pragma unroll
        for (int hh = 0; hh < 16; ++hh) acc[i][hh] = 0.f;
#pragma unroll
    for (int g = 0; g < 4; ++g) {
#pragma unroll 1
        for (int dc = 0; dc < 8; ++dc) {
            float kv[4][8];
#pragma unroll
            for (int i = 0; i < 4; ++i) KVRow<SAMPLE>::k8(kp[i] + g * 64 + dc * 8, kv[i]);
#pragma unroll
            for (int hh = 0; hh < 4; ++hh) {
                const f32x4 q0 = *(const LAS f32x4*)(pq + (4 * g + hh) * 64 + dc * 8), q1 = *(const LAS f32x4*)(pq + (4 * g + hh) * 64 + dc * 8 + 4);
#pragma unroll
                for (int i = 0; i < 4; ++i) {
                    float a = acc[i][4 * g + hh];
#pragma unroll
                    for (int e = 0; e < 4; ++e) { a += kv[i][e] * q0[e]; a += kv[i][4 + e] * q1[e]; }
                    acc[i][4 * g + hh] = a; }
            }
        }
    }
    asm volatile("s_waitcnt lgkmcnt(0)" ::: "memory");
#pragma unroll
    for (int i = 0; i < 4; ++i) {
        const bool valid = (lane + 64 * i) < nsel; const int rc = rel[i] < 128 ? (rel[i] < 0 ? 0 : rel[i]) : 128;
#pragma unroll
        for (int h4 = 0; h4 < 4; ++h4) { const f32x4 bv = *(const LAS f32x4*)(biasrel + rc * 16 + 4 * h4);
#pragma unroll
            for (int e = 0; e < 4; ++e) acc[i][4 * h4 + e] = valid ? acc[i][4 * h4 + e] * 0.125f + bv[e] : -INFINITY; }
    }
#pragma unroll
    for (int hh = 0; hh < 16; ++hh) {
        const float mx = wave_max(fmaxf(fmaxf(acc[0][hh], acc[1][hh]), fmaxf(acc[2][hh], acc[3][hh])));
        float s = 0.f;
#pragma unroll
        for (int i = 0; i < 4; ++i) { acc[i][hh] = __expf(acc[i][hh] - mx); s += acc[i][hh]; }
        const float inv = 1.0f / wave_sum(s);
#pragma unroll
        for (int i = 0; i < 4; ++i) acc[i][hh] *= inv;
    }
#pragma unroll
    for (int i = 0; i < 4; ++i)
#pragma unroll
        for (int h4 = 0; h4 < 4; ++h4) *(LAS f32x4*)(pq + (lane + 64 * i) * 16 + 4 * h4) = (f32x4){acc[i][4 * h4], acc[i][4 * h4 + 1], acc[i][4 * h4 + 2], acc[i][4 * h4 + 3]};
    asm volatile("s_waitcnt lgkmcnt(0)" ::: "memory");
    const int g = lane >> 4;
    f32x4 o[4];
#pragma unroll
    for (int hh = 0; hh < 4; ++hh) o[hh] = (f32x4){0.f, 0.f, 0.f, 0.f};
    const int nloop = (nsel + 3) & ~3;
    for (int k0 = 0; k0 < nloop; k0 += 4) {
        f32x4 vv[4], pp[4];
#pragma unroll
        for (int u = 0; u < 4; ++u) { const unsigned r = rowid[k0 + u]; vv[u] = KVRow<SAMPLE>::v4(R.vrow(r) + lane * 4); pp[u] = *(const LAS f32x4*)(pq + (k0 + u) * 16 + 4 * g); }
#pragma unroll
        for (int u = 0; u < 4; ++u)
#pragma unroll
            for (int hh = 0; hh < 4; ++hh) o[hh] += vv[u] * pp[u][hh];
    }
    bf16_t* YA = (bf16_t*)(A.ws + WS_CHK_YA);
#pragma unroll
    for (int hh = 0; hh < 4; ++hh) { u32x2 w; w.x = pk2(o[hh][0], o[hh][1]); w.y = pk2(o[hh][2], o[hh][3]);
        *(u32x2*)(YA + (size_t)m * D + (4 * g + hh) * 64 + (lane & 15) * 4) = w; }
    asm volatile("s_waitcnt lgkmcnt(0)" ::: "memory");
}


__device__ __forceinline__ void check_compare(const Args& A, int gw, int NGW, int lane) {
    const bf16_t* Y1 = (const bf16_t*)(A.ws + WS_YA); const bf16_t* Y2 = (const bf16_t*)(A.ws + WS_CHK_YA); unsigned* ctl = (unsigned*)(A.ws + WS_CTL);
    for (int m = gw; m < MP; m += NGW) {
        float e = 0.f, n = 0.f;
#pragma unroll
        for (int j = 0; j < 2; ++j) { float a[8], b[8]; unpack8(*(const u32x4*)(Y1 + (size_t)m * D + j * 512 + lane * 8), a); unpack8(*(const u32x4*)(Y2 + (size_t)m * D + j * 512 + lane * 8), b);
#pragma unroll
            for (int i = 0; i < 8; ++i) { const float d = a[i] - b[i]; e += d * d; n += b[i] * b[i]; } }
        e = wave_sum(e); n = wave_sum(n);
        { const unsigned long long w1 = (lane < 32) ? ((const unsigned long long*)(A.ws + WS_SC))[(size_t)m * 32 + lane] : 0ull, w2 = (lane < 32) ? ((const unsigned long long*)(A.ws + WS_CHK_MASK))[(size_t)m * 32 + lane] : 0ull;
          if (__any(w1 != w2) && lane == 0) atomicAdd(ctl + CW_CHK + 3, 1u);
          const int t = m & 2047;
          if (t >= 256) {
              const float* srow = (const float*)(A.ws + WS_CHK_SC) + (size_t)m * SCW;
              int c1 = 0, c2 = 0; float mins1 = INFINITY, maxu1 = -INFINITY, mins2 = INFINITY, maxu2 = -INFINITY;
              for (int j = 0; j < 32; ++j) { const int sp = lane + 64 * j; if (64 * j > t) break;
                  const unsigned long long a1 = __shfl((unsigned long long)w1, j), a2 = __shfl((unsigned long long)w2, j);
                  if (sp <= t) { const float v = srow[sp]; const bool s1 = (a1 >> lane) & 1ull, s2 = (a2 >> lane) & 1ull;
                      if (s1) { ++c1; mins1 = fminf(mins1, v); } else maxu1 = fmaxf(maxu1, v);
                      if (s2) { ++c2; mins2 = fminf(mins2, v); } else maxu2 = fmaxf(maxu2, v); } }
              c1 = (int)wave_sum((float)c1); c2 = (int)wave_sum((float)c2);
              mins1 = -wave_max(-mins1); mins2 = -wave_max(-mins2); maxu1 = wave_max(maxu1); maxu2 = wave_max(maxu2);
              if (lane == 0) { if (c1 != 256 || mins1 < maxu1) atomicAdd(ctl + CW_CHK + 4, 1u); if (c2 != 256 || mins2 < maxu2) atomicAdd(ctl + CW_CHK + 5, 1u); }
          } }
        if (lane == 0 && !(e <= MK_CHECK_TOL * MK_CHECK_TOL * n + 1e-12f)) { const int t = m & 2047; atomicAdd(ctl + CW_CHK + (t < 64 ? 0 : t < 256 ? 1 : 2), 1u); }
    }
}
#endif
__device__ __forceinline__ void gate_norm_phase(const Args& A, int gw, int NGW, int lane) {
    const bf16_t* P = (const bf16_t*)(A.ws + WS_P); bf16_t* Y = (bf16_t*)(A.ws + WS_Y); const float* ng = A.in[I_NORMG];
    for (int it = gw; it < M * 4; it += NGW) {
        const int m = it >> 2, ch = (it & 3) * 512 + lane * 8;
        float y[8], z[8]; unpack8(*(const u32x4*)(Y + (size_t)m * DI + ch), y); unpack8(*(const u32x4*)(P + (size_t)m * NP + PZ + ch), z);
        float ss = 0.f;
#pragma unroll
        for (int i = 0; i < 8; ++i) { y[i] *= siluf_(z[i]); ss += y[i] * y[i]; }
        const float r = 1.0f / sqrtf(wave_sum(ss) * (1.f / 512.f) + LN_EPS);
        const f32x4 g0 = *(const f32x4*)(ng + ch), g1 = *(const f32x4*)(ng + ch + 4);
#pragma unroll
        for (int i = 0; i < 4; ++i) { y[i] = y[i] * r * g0[i]; y[4 + i] = y[4 + i] * r * g1[i]; }
        *(u32x4*)(Y + (size_t)m * DI + ch) = pack8(y);
    }
}

constexpr int NPHASE = 14;
__global__ void __launch_bounds__(NTHR, 2) fwd(Args args) {
    extern __shared__ __attribute__((aligned(16))) unsigned char lds_raw[];
    LAS unsigned char* lds = (LAS unsigned char*)lds_raw;
    const int tid = threadIdx.x, lane = tid & 63, wave = __builtin_amdgcn_readfirstlane(tid >> 6);
    const int G = gridDim.x, bx = blockIdx.x;
    const int vcu = (G % 8 == 0) ? (bx % 8) * (G / 8) + bx / 8 : bx;
    const int gw = vcu * NWAVES + wave, NGW = G * NWAVES;
    unsigned char* ws = args.ws;
    volatile LAS unsigned* MISC = (volatile LAS unsigned*)(lds + MISC_OFF);
    for (int u = tid; u < 64; u += NTHR) MISC[u] = 0u;
    __syncthreads();
    const int lo = args.ph_lo, hi = args.ph_hi;
    XcdBarrier bar; bar.bar = (unsigned*)(ws + WS_CTL) + CW_BAR; bar.x = 0; bar.st = nullptr;
    if (hi - lo > 1) bar = xcd_barrier_post((unsigned*)(ws + WS_CTL) + CW_BAR, MISC + 8);
#define IN(k) (lo <= (k) && (k) < hi)
#define SEAM(k) do { if (IN(k) && IN((k) + 1)) xcd_barrier(bar); } while (0)

    bf16_t* const XB = (bf16_t*)(ws + WS_XB); bf16_t* const ACT = (bf16_t*)(ws + WS_ACT); float* const T = (float*)(ws + WS_T);
    float* const HF = (float*)(ws + WS_HF); bf16_t* const HB = (bf16_t*)(ws + WS_HB); bf16_t* const P = (bf16_t*)(ws + WS_P);
    float* const SMF = (float*)(ws + WS_SMF); bf16_t* const Y = (bf16_t*)(ws + WS_Y); bf16_t* const YA = (bf16_t*)(ws + WS_YA); bf16_t* const MG = (bf16_t*)(ws + WS_MG);

    if (IN(0)) REPK(0) { p0_prologue(args, lds, gw, NGW, wave, lane); }
    SEAM(0);
    if (IN(1)) {
        { pg8::Gemm g{XB, (const bf16_t*)(ws + WS_W1A), M, 2 * DFF, D}; pg8::StaticOrder S; S.init(M, 2 * DFF, G, bx);
        EpiSwiglu E{ACT}; pg8::gemm_phase<EpiSwiglu, pg8::StaticOrder, true, true>(lds, g, S, E); }
        if constexpr (DUPK(1)) { pg8::Gemm g{XB, (const bf16_t*)(ws + WS_W1A), M, 2 * DFF, D}; pg8::StaticOrder S; S.init(M, 2 * DFF, G, bx);
        EpiSwiglu E{ACT}; pg8::gemm_phase<EpiSwiglu, pg8::StaticOrder, true, true>(lds, g, S, E); }
    }
    SEAM(1);
    if (IN(2)) {
        { pg8::Gemm g{ACT, (const bf16_t*)(ws + WS_W1B), MP, D, DFF}; pg8::StaticOrder S; S.init(MP, D, G, bx);
        EpiResid E{args.in[I_XP], args.in[I_XS], T, ALPHA, 0.5f}; pg8::gemm_phase<EpiResid, pg8::StaticOrder, true, true>(lds, g, S, E); }
        { SkResid E{args.in[I_XS], T, ALPHA, 0.5f}; skinny_gemm<DFF>(lds, ACT + (size_t)MP * DFF, (const bf16_t*)(ws + WS_W1B), E, bx, G, wave, lane); }
        if constexpr (DUPK(2)) { pg8::Gemm g{ACT, (const bf16_t*)(ws + WS_W1B), MP, D, DFF}; pg8::StaticOrder S; S.init(MP, D, G, bx);
        EpiResid E{args.in[I_XP], args.in[I_XS], T, ALPHA, 0.5f}; pg8::gemm_phase<EpiResid, pg8::StaticOrder, true, true>(lds, g, S, E); }
    }
    SEAM(2);
    if (IN(3)) REPK(3) { ln_phase(T, args.in[I_LN1G], args.in[I_LN1B], HF, HB, gw, NGW, lane); }
    SEAM(3);
    if (IN(4)) {
        { pg8::Gemm g{HB, (const bf16_t*)(ws + WS_WIN), M, NP, D}; pg8::StaticOrder S; S.init(M, NP, G, bx);
        EpiWin E{P, SMF, args.out}; pg8::gemm_phase<EpiWin, pg8::StaticOrder, true, true>(lds, g, S, E); }
        if constexpr (DUPK(4)) { pg8::Gemm g{HB, (const bf16_t*)(ws + WS_WIN), M, NP, D}; pg8::StaticOrder S; S.init(M, NP, G, bx);
        EpiWin E{P, SMF, args.out}; pg8::gemm_phase<EpiWin, pg8::StaticOrder, true, true>(lds, g, S, E); }
    }
    SEAM(4);
    if (IN(5)) REPK(5) {
        for (int rep = 0; rep < MK_REP_CONV; ++rep)
        conv_phase(args, gw, NGW, lane);
        for (int rep = 0; rep < MK_REP_SCP; ++rep)
        for (int u = bx; u < 1024; u += G) { const int i = u >> 8, c = u & 255, b = c >> 5, s = c & 31; const int qt = (i == 0) ? s : (i == 1) ? 63 - s : (i == 2) ? 64 + s : 127 - s;
            scores_select_prompt_unit(args, lds, b, qt, wave, lane); }
        for (int rep = 0; rep < MK_REP_SCS; ++rep)
        for (int u = bx; u < 256; u += G) scores_sample_unit(args, u >> 1, u & 1, wave, lane);
    }
    SEAM(5);
    if (IN(6)) {
        for (int rep = 0; rep < MK_REP_SSDP; ++rep)
        for (int it = bx; it < 256; it += G) ssd_prompt_item(args, lds, it >> 5, it & 31);
        __syncthreads();
        LAS float* biasrel = (LAS float*)(lds + BIASREL_OFF); LAS float* biasL = biasrel + 129 * 16;
        for (int i = tid; i < 129 * 16; i += NTHR) { const int rel = i >> 4, h = i & 15; const float bv = args.in[I_BIAS][t5_bucket(rel) * 16 + h]; biasrel[i] = bv; biasL[i] = bv * LOG2E; }
        __syncthreads();
        for (int rep = 0; rep < MK_REP_ATTP; ++rep)
        for (int u = bx; u < 1024; u += G) { const int i = u >> 8, c = u & 255, bg = c >> 3, s8 = c & 7; const int qt = (i == 0) ? s8 : (i == 1) ? 15 - s8 : (i == 2) ? 16 + s8 : 31 - s8;
            attn_prompt_unit(args, lds, biasL, bg >> 2, bg & 3, qt, wave, lane); }
        __syncthreads();
        LAS unsigned char* wl = lds + wave * WAREA;
        for (int rep = 0; rep < MK_REP_SSDS; ++rep)
        for (int it = gw; it < 4096; it += NGW) ssd_sample_item(args, wl, it >> 5, it & 31, lane);
        for (int rep = 0; rep < MK_REP_ATTS; ++rep)
        for (int q = gw; q < MS * 4; q += NGW) attend_sample_task(args, wl, biasrel, q >> 2, q & 3, lane);
#if MK_CHECK_ATT
        for (int q = gw; q < MP; q += NGW) attend_query<false>(args, wl, biasrel, q, lane);
#endif
        __syncthreads();
    }
    SEAM(6);
    if (IN(7)) {
        gate_norm_phase(args, gw, NGW, lane);
#if MK_CHECK_ATT
        check_compare(args, gw, NGW, lane);
#endif
        { pg8::Gemm g{YA, (const bf16_t*)(ws + WS_WBA), MP, D, D}; pg8::StaticOrder S; S.init(MP, D, G, bx);
        EpiGateA E{P, PG + D, T}; pg8::gemm_phase<EpiGateA, pg8::StaticOrder, true, true>(lds, g, S, E); }
        { SkGateA E{P, PG + D, T}; skinny_gemm<D>(lds, YA + (size_t)MP * D, (const bf16_t*)(ws + WS_WBA), E, bx, G, wave, lane); }
        if constexpr (DUPK(7)) { pg8::Gemm g{YA, (const bf16_t*)(ws + WS_WBA), MP, D, D}; pg8::StaticOrder S; S.init(MP, D, G, bx);
        EpiGateA E{P, PG + D, T}; pg8::gemm_phase<EpiGateA, pg8::StaticOrder, true, true>(lds, g, S, E); }
    }
    SEAM(7);
    if (IN(8)) {
        { pg8::Gemm g{Y, (const bf16_t*)(ws + WS_WBS), MP, D, DI}; pg8::StaticOrder S; S.init(MP, D, G, bx);
        EpiGateS E{P, PG, T, MG}; pg8::gemm_phase<EpiGateS, pg8::StaticOrder, true, true>(lds, g, S, E); }
        { SkGateS E{P, PG, T, MG}; skinny_gemm<DI>(lds, Y + (size_t)MP * DI, (const bf16_t*)(ws + WS_WBS), E, bx, G, wave, lane); }
        if constexpr (DUPK(8)) { pg8::Gemm g{Y, (const bf16_t*)(ws + WS_WBS), MP, D, DI}; pg8::StaticOrder S; S.init(MP, D, G, bx);
        EpiGateS E{P, PG, T, MG}; pg8::gemm_phase<EpiGateS, pg8::StaticOrder, true, true>(lds, g, S, E); }
    }
    SEAM(8);
    if (IN(9)) {
        { pg8::Gemm g{MG, (const bf16_t*)(ws + WS_WOUT), MP, D, D}; pg8::StaticOrder S; S.init(MP, D, G, bx);
        EpiResid E{HF, HF + (size_t)MP * D, T, ALPHA, 1.0f}; pg8::gemm_phase<EpiResid, pg8::StaticOrder, true, true>(lds, g, S, E); }
        { SkResid E{HF + (size_t)MP * D, T, ALPHA, 1.0f}; skinny_gemm<D>(lds, MG + (size_t)MP * D, (const bf16_t*)(ws + WS_WOUT), E, bx, G, wave, lane); }
        if constexpr (DUPK(9)) { pg8::Gemm g{MG, (const bf16_t*)(ws + WS_WOUT), MP, D, D}; pg8::StaticOrder S; S.init(MP, D, G, bx);
        EpiResid E{HF, HF + (size_t)MP * D, T, ALPHA, 1.0f}; pg8::gemm_phase<EpiResid, pg8::StaticOrder, true, true>(lds, g, S, E); }
    }
    SEAM(9);
    if (IN(10)) REPK(10) { ln_phase(T, args.in[I_LN2G], args.in[I_LN2B], HF, HB, gw, NGW, lane); }
    SEAM(10);
    if (IN(11)) {
        { pg8::Gemm g{HB, (const bf16_t*)(ws + WS_W2A), M, 2 * DFF, D}; pg8::StaticOrder S; S.init(M, 2 * DFF, G, bx);
        EpiSwiglu E{ACT}; pg8::gemm_phase<EpiSwiglu, pg8::StaticOrder, true, true>(lds, g, S, E); }
        if constexpr (DUPK(11)) { pg8::Gemm g{HB, (const bf16_t*)(ws + WS_W2A), M, 2 * DFF, D}; pg8::StaticOrder S; S.init(M, 2 * DFF, G, bx);
        EpiSwiglu E{ACT}; pg8::gemm_phase<EpiSwiglu, pg8::StaticOrder, true, true>(lds, g, S, E); }
    }
    SEAM(11);
    if (IN(12)) {
        { pg8::Gemm g{ACT, (const bf16_t*)(ws + WS_W2B), MP, D, DFF}; pg8::StaticOrder S; S.init(MP, D, G, bx);
        EpiResid E{HF, HF + (size_t)MP * D, T, ALPHA, 0.5f}; pg8::gemm_phase<EpiResid, pg8::StaticOrder, true, true>(lds, g, S, E); }
        { SkResid E{HF + (size_t)MP * D, T, ALPHA, 0.5f}; skinny_gemm<DFF>(lds, ACT + (size_t)MP * DFF, (const bf16_t*)(ws + WS_W2B), E, bx, G, wave, lane); }
        if constexpr (DUPK(12)) { pg8::Gemm g{ACT, (const bf16_t*)(ws + WS_W2B), MP, D, DFF}; pg8::StaticOrder S; S.init(MP, D, G, bx);
        EpiResid E{HF, HF + (size_t)MP * D, T, ALPHA, 0.5f}; pg8::gemm_phase<EpiResid, pg8::StaticOrder, true, true>(lds, g, S, E); }
    }
    SEAM(12);
    if (IN(13)) REPK(13) { ln_phase(T, args.in[I_LN3G], args.in[I_LN3B], args.out + O_Y, nullptr, gw, NGW, lane); }
#if MK_CHECK_ATT
    if (IN(13)) { __syncthreads(); unsigned* cw = (unsigned*)(ws + WS_CTL) + CW_CHK;
        const unsigned b0 = __hip_atomic_load(cw, __ATOMIC_RELAXED, __HIP_MEMORY_SCOPE_AGENT), b1 = __hip_atomic_load(cw + 1, __ATOMIC_RELAXED, __HIP_MEMORY_SCOPE_AGENT), b2 = __hip_atomic_load(cw + 2, __ATOMIC_RELAXED, __HIP_MEMORY_SCOPE_AGENT), b3 = __hip_atomic_load(cw + 3, __ATOMIC_RELAXED, __HIP_MEMORY_SCOPE_AGENT), b4 = __hip_atomic_load(cw + 4, __ATOMIC_RELAXED, __HIP_MEMORY_SCOPE_AGENT), b5 = __hip_atomic_load(cw + 5, __ATOMIC_RELAXED, __HIP_MEMORY_SCOPE_AGENT);
        const float code = MK_CHECK_CODE;
        if (code > 0.f && bx == 0 && tid == 0) args.out[O_Y] = 4096.0f * sqrtf(code); }
#endif
#undef IN
#undef SEAM
}
}

extern "C" void kernel_launch(void* const* d_in, const int* in_sizes, int n_in, void* d_out, int out_size, void* d_ws, size_t ws_size, hipStream_t stream) {
    using namespace mk;
    static int grid = 0;
    if (grid == 0) {
        if (n_in != 29 || (size_t)out_size != O_END || ws_size < WS_END) { fprintf(stderr, "kernel_launch: unexpected shapes (n_in %d, out %d, ws %zu)\n", n_in, out_size, ws_size); grid = -1; return; }
        int dev = 0, cus = 0, per_cu = 0;
        if (hipGetDevice(&dev) != hipSuccess || hipDeviceGetAttribute(&cus, hipDeviceAttributeMultiprocessorCount, dev) != hipSuccess) { grid = -1; return; }
        if (hipFuncSetAttribute((const void*)fwd, hipFuncAttributeMaxDynamicSharedMemorySize, LDS_BYTES) != hipSuccess) { fprintf(stderr, "kernel_launch: hipFuncSetAttribute failed\n"); grid = -1; return; }
        if (hipOccupancyMaxActiveBlocksPerMultiprocessor(&per_cu, (const void*)fwd, NTHR, LDS_BYTES) != hipSuccess || per_cu < 1) fprintf(stderr, "kernel_launch: occupancy query says %d\n", per_cu);
        (void)hipGetLastError();
        grid = cus;
    }
    if (grid < 0) return;
    (void)hipMemsetAsync((char*)d_ws + WS_CTL, 0, CTL_ZERO_BYTES, stream);
    Args a{};
    for (int i = 0; i < 29; ++i) a.in[i] = (const float*)d_in[i];
    a.out = (float*)d_out; a.ws = (unsigned char*)d_ws;
#if MK_SPLIT
    for (int p = 0; p < NPHASE; ++p) { a.ph_lo = p; a.ph_hi = p + 1; hipLaunchKernelGGL(fwd, dim3(grid), dim3(NTHR), LDS_BYTES, stream, a); }
#else
    a.ph_lo = 0; a.ph_hi = NPHASE; hipLaunchKernelGGL(fwd, dim3(grid), dim3(NTHR), LDS_BYTES, stream, a);
#endif
}
```

```cpp
#include <hip/hip_runtime.h>
#include <cstdio>
#include <cstdint>
#define GAS __attribute__((address_space(1)))
#define LAS __attribute__((address_space(3)))
namespace pg8 {
#define PG8_LAS __attribute__((address_space(3)))
typedef unsigned short bf16_t;
typedef short bf16x8 __attribute__((ext_vector_type(8)));
typedef float f32x4 __attribute__((ext_vector_type(4)));
typedef unsigned u32x4 __attribute__((ext_vector_type(4)));
constexpr int BM = 256, BK = 64, HALF = 128, HTB = HALF * BK * 2  , STAGE_BYTES = 8 * HTB, NXCD = 8, WGM = 8;

__host__ __device__ __forceinline__ int lds_byte(int r, int c) { const int st = (r >> 4) * 2 + (c >> 5), rr = r & 15, cc = c & 31, ob = rr * 64 + cc * 2; return st * 1024 + (ob ^ (((ob >> 9) & 1) << 5)); }
__host__ __device__ __forceinline__ void stage_rc(int b, int& R, int& C) { const int st = b / 1024, sb = b % 1024, swz = sb ^ (((sb >> 9) & 1) << 5); R = (st >> 1) * 16 + swz / 64; C = (st & 1) * 32 + (swz % 64) / 2; }
__host__ __device__ __forceinline__ int perm32(int rho) { const int n = rho >> 4, i = rho & 15; return 8 * (i >> 2) + 4 * n + (i & 3); }

struct Unit { int pm, pn; };
struct Gemm { const bf16_t* A; const bf16_t* Bt; int M, N, K; };

struct StaticOrder {
    int nM, nN, nwg, G, c;
    __host__ __device__ void init(int M, int N, int G_, int c_) { nM = M / BM; nN = N / BM; nwg = nM * nN; G = G_; c = c_; }
    __host__ __device__ bool next(int i, Unit& u) const {
        const long L = (long)i * G + c; if (L >= nwg) return false;
        int wgid = (int)L; { const int q = nwg / NXCD, r = nwg % NXCD, xcd = wgid % NXCD, off = wgid / NXCD; wgid = (xcd < r ? xcd * (q + 1) : r * (q + 1) + (xcd - r) * q) + off; }
        const int nig = WGM * nN, gid = wgid / nig, fm = gid * WGM, gsz = (nM - fm) < WGM ? (nM - fm) : WGM;
        u.pm = fm + ((wgid % nig) % gsz); u.pn = (wgid % nig) / gsz; return true;
    }
    __device__ __forceinline__ void a_ready(const Unit&) const {}
    __device__ __forceinline__ void done(const Unit&) const {}
};

__device__ __forceinline__ unsigned cvt_pk_bf16(float lo, float hi) { unsigned r; asm volatile("v_cvt_pk_bf16_f32 %0, %1, %2" : "=v"(r) : "v"(lo), "v"(hi)); return r; }

template <class Epi, class Sched, bool ALIGN_EPI = false, bool SP2 = false>
__device__ __forceinline__ void gemm_phase(PG8_LAS unsigned char* lds, const Gemm g, const Sched& S, const Epi& E) {
    const int tid = threadIdx.x, wid = __builtin_amdgcn_readfirstlane(tid >> 6), lane = tid & 63, wr = wid >> 2, wc = wid & 3, fr = lane & 15, fq = lane >> 4;
    const int K = g.K, nt = K / BK;
    unsigned voffA[2], voffB[2];
#pragma unroll
    for (int i = 0; i < 2; ++i) { int R, C; stage_rc(tid * 16 + i * 8192, R, C); const int Rb = Epi::PERM ? ((R & ~31) + perm32(R & 31)) : R;
        voffA[i] = (unsigned)(R * K + C) * 2u; voffB[i] = (unsigned)(Rb * K + C) * 2u; }
    const size_t kstep = (size_t)(BK * 2);
    const size_t hstep = (size_t)HALF * K * 2;
    const size_t tstep = 2 * hstep;
    const unsigned ldsw = (unsigned)wid * 1024u;
    const int aoff = lds_byte(wr * 64 + fr, fq * 8), boff = lds_byte(wc * 32 + fr, fq * 8);
#define PG8_SA(b, h) (((b) * 2 + (h)) * HTB)
#define PG8_SB(b, h) ((4 + (b) * 2 + (h)) * HTB)
#define PG8_STAGE(bufoff, gbase, voff) do { _Pragma("unroll") for (int _i = 0; _i < 2; ++_i) \
        __builtin_amdgcn_global_load_lds((const unsigned*)((const char*)(gbase) + (voff)[_i]), (PG8_LAS unsigned*)(lds + (bufoff) + ldsw + _i * 8192), 16, 0, 0); } while (0)
#define PG8_LDA(dst, b, h) do { _Pragma("unroll") for (int m = 0; m < 4; ++m) _Pragma("unroll") for (int k = 0; k < 2; ++k) dst[m][k] = *(const PG8_LAS bf16x8*)(lds + PG8_SA(b, h) + aoff + m * 2048 + k * 1024); } while (0)
#define PG8_LDB(dst, b, h) do { _Pragma("unroll") for (int n = 0; n < 2; ++n) _Pragma("unroll") for (int k = 0; k < 2; ++k) dst[n][k] = *(const PG8_LAS bf16x8*)(lds + PG8_SB(b, h) + boff + n * 2048 + k * 1024); } while (0)
#define PG8_MMA(ai, bj, At, Bt) do { __builtin_amdgcn_s_setprio(1); _Pragma("unroll") for (int m = 0; m < 4; ++m) _Pragma("unroll") for (int n = 0; n < 2; ++n) _Pragma("unroll") for (int k = 0; k < 2; ++k) \
        acc[ai][bj][m][n] = __builtin_amdgcn_mfma_f32_16x16x32_bf16(Bt[n][k], At[m][k], acc[ai][bj][m][n], 0, 0, 0); __builtin_amdgcn_s_setprio(0); } while (0)
#define PG8_WAIT_V(n) asm volatile("s_waitcnt vmcnt(" #n ")" ::: "memory")
#define PG8_WAIT_L(n) asm volatile("s_waitcnt lgkmcnt(" #n ")" ::: "memory")
#define PG8_BAR __builtin_amdgcn_s_barrier()
#define PG8_SCHED __builtin_amdgcn_sched_barrier(0)
    Unit cur, nxt; int ui = 0;
    if (!S.next(0, cur)) return;
    f32x4 acc[2][2][4][2];
#pragma unroll
    for (int a = 0; a < 2; ++a)
#pragma unroll
        for (int b = 0; b < 2; ++b)
#pragma unroll
            for (int m = 0; m < 4; ++m)
#pragma unroll
                for (int n = 0; n < 2; ++n) acc[a][b][m][n] = (f32x4){0.f, 0.f, 0.f, 0.f};
    bf16x8 At[4][2], B0[2][2], B1[2][2];
    const char* cA = (const char*)g.A + (size_t)cur.pm * tstep; const char* cB = (const char*)g.Bt + (size_t)cur.pn * tstep;
    S.a_ready(cur);
    if constexpr (SP2) {
        PG8_STAGE(PG8_SB(0, 0), cB, voffB); PG8_STAGE(PG8_SB(0, 1), cB + hstep, voffB); PG8_STAGE(PG8_SA(0, 0), cA, voffA); PG8_STAGE(PG8_SA(0, 1), cA + hstep, voffA);
        if (wr == 1) PG8_BAR;
        PG8_WAIT_V(2); PG8_BAR;
        PG8_STAGE(PG8_SB(1, 0), cB + kstep, voffB); PG8_STAGE(PG8_SA(1, 0), cA + kstep, voffA); PG8_STAGE(PG8_SB(1, 1), cB + hstep + kstep, voffB);
        PG8_WAIT_V(6); PG8_BAR;
    } else {
        PG8_STAGE(PG8_SB(0, 0), cB, voffB); PG8_STAGE(PG8_SA(0, 0), cA, voffA); PG8_STAGE(PG8_SB(0, 1), cB + hstep, voffB); PG8_STAGE(PG8_SA(0, 1), cA + hstep, voffA);
        if (wr == 1) PG8_BAR;
        PG8_WAIT_V(4); PG8_BAR;
        PG8_STAGE(PG8_SB(1, 0), cB + kstep, voffB); PG8_STAGE(PG8_SA(1, 0), cA + kstep, voffA); PG8_STAGE(PG8_SB(1, 1), cB + hstep + kstep, voffB);
        PG8_WAIT_V(6); PG8_BAR;
    }
    for (;;) {
        const bool has_next = S.next(ui + 1, nxt);
        const char* nA = has_next ? (const char*)g.A + (size_t)nxt.pm * tstep : cA; const char* nB = has_next ? (const char*)g.Bt + (size_t)nxt.pn * tstep : cB;
        for (int t = 0; t < nt; t += 2) {
            const bool last = (t == nt - 2);
            const char* a1 = cA + (size_t)(t + 1) * kstep;
            const char* a2 = last ? nA : cA + (size_t)(t + 2) * kstep; const char* b2 = last ? nB : cB + (size_t)(t + 2) * kstep;
            const char* a3 = a2 + kstep; const char* b3 = b2 + kstep;
            if (last && has_next) S.a_ready(nxt);
            if constexpr (SP2) {
            PG8_LDB(B0, 0, 0); PG8_LDB(B1, 0, 1); PG8_SCHED; PG8_LDA(At, 0, 0); PG8_STAGE(PG8_SA(1, 1), a1 + hstep, voffA);
            PG8_WAIT_V(8); PG8_WAIT_L(0); PG8_BAR; PG8_MMA(0, 0, At, B0); PG8_MMA(0, 1, At, B1); PG8_BAR; PG8_SCHED;
            PG8_LDA(At, 0, 1); PG8_STAGE(PG8_SB(0, 0), b2, voffB); PG8_STAGE(PG8_SB(0, 1), b2 + hstep, voffB); PG8_STAGE(PG8_SA(0, 0), a2, voffA);
            PG8_WAIT_V(8); PG8_WAIT_L(0); PG8_BAR; PG8_MMA(1, 0, At, B0); PG8_MMA(1, 1, At, B1); PG8_BAR; PG8_SCHED;
            PG8_LDB(B0, 1, 0); PG8_LDB(B1, 1, 1); PG8_SCHED; PG8_LDA(At, 1, 0); PG8_STAGE(PG8_SA(0, 1), a2 + hstep, voffA);
            PG8_WAIT_V(8); PG8_WAIT_L(0); PG8_BAR; PG8_MMA(0, 0, At, B0); PG8_MMA(0, 1, At, B1); PG8_BAR; PG8_SCHED;
            PG8_LDA(At, 1, 1); PG8_STAGE(PG8_SB(1, 0), b3, voffB); PG8_STAGE(PG8_SB(1, 1), b3 + hstep, voffB); PG8_STAGE(PG8_SA(1, 0), a3, voffA);
            PG8_WAIT_V(8); PG8_WAIT_L(0); PG8_BAR; PG8_MMA(1, 0, At, B0); PG8_MMA(1, 1, At, B1); PG8_BAR; PG8_SCHED;
            } else {
            PG8_LDB(B0, 0, 0); PG8_SCHED; PG8_LDA(At, 0, 0); PG8_STAGE(PG8_SA(1, 1), a1 + hstep, voffA);
            PG8_WAIT_L(8); PG8_BAR; PG8_WAIT_L(0); PG8_MMA(0, 0, At, B0); PG8_BAR; PG8_SCHED;
            PG8_LDB(B1, 0, 1); PG8_STAGE(PG8_SB(0, 0), b2, voffB);
            PG8_BAR; PG8_WAIT_L(0); PG8_MMA(0, 1, At, B1); PG8_BAR;
            PG8_LDA(At, 0, 1); PG8_STAGE(PG8_SA(0, 0), a2, voffA);
            PG8_BAR; PG8_WAIT_L(0); PG8_MMA(1, 0, At, B0); PG8_BAR; PG8_SCHED;
            PG8_STAGE(PG8_SB(0, 1), b2 + hstep, voffB);
            PG8_WAIT_V(6); PG8_BAR; PG8_MMA(1, 1, At, B1); PG8_BAR;
            PG8_LDB(B0, 1, 0); PG8_SCHED; PG8_LDA(At, 1, 0); PG8_STAGE(PG8_SA(0, 1), a2 + hstep, voffA);
            PG8_WAIT_L(8); PG8_BAR; PG8_WAIT_L(0); PG8_MMA(0, 0, At, B0); PG8_BAR; PG8_SCHED;
            PG8_LDB(B1, 1, 1); PG8_STAGE(PG8_SB(1, 0), b3, voffB);
            PG8_BAR; PG8_WAIT_L(0); PG8_MMA(0, 1, At, B1); PG8_BAR;
            PG8_LDA(At, 1, 1); PG8_STAGE(PG8_SA(1, 0), a3, voffA);
            PG8_BAR; PG8_WAIT_L(0); PG8_MMA(1, 0, At, B0); PG8_BAR; PG8_SCHED;
            PG8_STAGE(PG8_SB(1, 1), b3 + hstep, voffB);
            PG8_WAIT_V(6); PG8_BAR; PG8_MMA(1, 1, At, B1); PG8_BAR;
            }
        }
        if constexpr (ALIGN_EPI) { if (wr == 0) PG8_BAR; }
        if constexpr (!Epi::AFTER_DRAIN) { E(acc, cur, wr, wc, fr, fq); S.done(cur); }
        if (!has_next) break;
#pragma unroll
        for (int a = 0; a < 2; ++a)
#pragma unroll
            for (int b = 0; b < 2; ++b)
#pragma unroll
                for (int m = 0; m < 4; ++m)
#pragma unroll
                    for (int n = 0; n < 2; ++n) acc[a][b][m][n] = (f32x4){0.f, 0.f, 0.f, 0.f};
        cur = nxt; cA = nA; cB = nB; ++ui;
        if constexpr (ALIGN_EPI) { if (wr == 1) PG8_BAR; }
    }
    PG8_WAIT_V(0);
    if constexpr (!ALIGN_EPI) { if (wr == 0) PG8_BAR; }
    PG8_BAR;
    if constexpr (Epi::AFTER_DRAIN) { E.fused(acc, cur, wr, wc, fr, fq, lds, wid, lane); S.done(cur); }
#undef PG8_SA
#undef PG8_SB
#undef PG8_STAGE
#undef PG8_LDA
#undef PG8_LDB
#undef PG8_MMA
#undef PG8_WAIT_V
#undef PG8_WAIT_L
#undef PG8_BAR
#undef PG8_SCHED
}
}
#define XB_TMO      128
#define XB_XCNT(j)  (256  + 64 * (j))
#define XB_XSUB(j)  (1280 + 64 * (j))
#define XB_XGEN(j)  (2304 + 64 * (j))
#define XB_TOP      3328
#define XB_TOPGEN   3392
#define XCD_BAR_WORDS 3456
#define XB_SPIN_CAP (1u << 18)

__device__ __forceinline__ unsigned xb_ld(unsigned* p)              { return __hip_atomic_load(p, __ATOMIC_RELAXED, __HIP_MEMORY_SCOPE_AGENT); }
__device__ __forceinline__ unsigned xb_add(unsigned* p, unsigned v) { return __hip_atomic_fetch_add(p, v, __ATOMIC_RELAXED, __HIP_MEMORY_SCOPE_AGENT); }
__device__ __forceinline__ unsigned xb_xcc_id() { return (unsigned)__builtin_amdgcn_s_getreg((3 << 11) | 20) & 0xFu; }
#define XB_SPIN(cond, bar) do { unsigned _sp = 0; while (cond) { __builtin_amdgcn_s_sleep(1); \
    if ((++_sp & 255u) == 0u) { if (xb_ld(&(bar)[XB_TMO])) break; if (_sp > XB_SPIN_CAP) { atomicAdd(&(bar)[XB_TMO], 1u); break; } } } } while (0)

struct XcdBarrier {
    unsigned* bar; unsigned x;
    volatile LAS unsigned* st;
};

__device__ __forceinline__ XcdBarrier xcd_barrier_post(unsigned* bar, volatile LAS unsigned* st) {
    XcdBarrier b; b.bar = bar; b.x = xb_xcc_id(); b.st = st;
    if (threadIdx.x == 0) (void)xb_add(&bar[XB_XCNT(b.x)], 1u);
    return b;
}
__device__ __forceinline__ void xcd_barrier_complete(unsigned* bar, unsigned x, unsigned& nloc, unsigned& nx) {
    const unsigned G = gridDim.x * gridDim.y * gridDim.z;
    unsigned sum, cnt, mine, sp = 0u;
    for (;;) {
        sum = 0u; cnt = 0u; mine = 0u;
#pragma unroll
        for (unsigned j = 0; j < 16; ++j) { const unsigned c = xb_ld(&bar[XB_XCNT(j)]); sum += c; cnt += (c > 0u) ? 1u : 0u; mine = (j == x) ? c : mine; }
        if (sum == G) break;
        __builtin_amdgcn_s_sleep(1);
        if ((++sp & 255u) == 0u) { if (xb_ld(&bar[XB_TMO])) break; if (sp > XB_SPIN_CAP) { atomicAdd(&bar[XB_TMO], 1u); break; } }
    }
    nloc = mine > 0u ? mine : 1u; nx = cnt > 0u ? cnt : 1u;
}

__device__ __forceinline__ void xcd_barrier(const XcdBarrier& b) {
    asm volatile("s_waitcnt vmcnt(0)" ::: "memory");
    __syncthreads();
    if (threadIdx.x == 0) {
        unsigned* bar = b.bar;
        __builtin_amdgcn_s_waitcnt(0);
        unsigned nloc = b.st[0], nx = b.st[1];
        if (nloc == 0u) { xcd_barrier_complete(bar, b.x, nloc, nx); b.st[0] = nloc; b.st[1] = nx; }
        const unsigned old = xb_add(&bar[XB_XSUB(b.x)], 1u);
        const unsigned gen = old / nloc;
        if (old + 1u == (gen + 1u) * nloc) {
            __builtin_amdgcn_fence(__ATOMIC_RELEASE, "agent");
            asm volatile("s_waitcnt vmcnt(0)" ::: "memory");
            const unsigned og = xb_add(&bar[XB_TOP], 1u);
            const unsigned tg = og / nx;
            if (og + 1u == (tg + 1u) * nx) xb_add(&bar[XB_TOPGEN], 1u);
            else XB_SPIN(xb_ld(&bar[XB_TOPGEN]) == tg, bar);
            __builtin_amdgcn_fence(__ATOMIC_ACQUIRE, "agent");
            xb_add(&bar[XB_XGEN(b.x)], 1u);
            asm volatile("s_waitcnt vmcnt(0)" ::: "memory");
        } else {
            XB_SPIN(xb_ld(&bar[XB_XGEN(b.x)]) == gen, bar);
            __builtin_amdgcn_fence(__ATOMIC_ACQUIRE, "agent");
            asm volatile("s_waitcnt vmcnt(0)" ::: "memory");
        }
    }
    __syncthreads();
}
namespace mk {
using pg8::bf16_t; using pg8::bf16x8; using pg8::f32x4; using pg8::u32x4;
typedef unsigned u32x2 __attribute__((ext_vector_type(2)));

#ifndef MK_CHECK_ATT
#define MK_CHECK_ATT 0
#endif
#define MK_REP_SSDP 1
#define MK_REP_CONV 1
#define MK_REP_SCP 1
#define MK_REP_SCS 1
#define MK_REP_SSDS 1
#define MK_REP_ATTS 1
#define MK_REP_ATTP 1
#define MK_CHECK_TOL 0.02f
#define MK_CHECK_CODE ((b0 ? 1.f : 0.f) + (b1 ? 2.f : 0.f) + (b2 ? 4.f : 0.f) + (b3 ? 8.f : 0.f) + (b4 ? 16.f : 0.f) + (b5 ? 32.f : 0.f))
#define MK_REP_MASK 0
#define DUPK(k) (((MK_REP_MASK >> (k)) & 1) != 0)
#define REPK(k) for (int rep_ = 0; rep_ < 1 + ((MK_REP_MASK >> (k)) & 1); ++rep_)
#ifndef MK_SPLIT
#define MK_SPLIT 0
#endif

constexpr int NWAVES = 8, NTHR = 512;
constexpr int MP = 16384, MS = 512, M = MP + MS, D = 1024, DFF = 2816, DI = 2048, NP = 9472, XCW = 3072;
constexpr int PZ = 0, PXBC = 2048, PSM = 5120, PQ = 5376, PK = 6400, PV = 6656, PQI = 6912, PG = 7424;
constexpr int SCW = 2048, SCSW = 2112;
constexpr size_t O_Y = 0, O_KP = 17301504, O_VP = 21495808, O_KIP = 25690112, O_CVP = 26738688, O_SSP = 26812416,
                 O_KS = 28909568, O_VS = 29040640, O_KIS = 29171712, O_CVS = 29204480, O_SSS = 30384128, O_END = 63938560;
constexpr size_t MiB = 1u << 20;
constexpr size_t WS_CTL = 0, CTL_ZERO_BYTES = 1 * MiB;
constexpr size_t WS_W1A = 1 * MiB, WS_W1B = WS_W1A + 11 * MiB, WS_WIN = WS_W1B + 6 * MiB, WS_WBS = WS_WIN + 19 * MiB, WS_WBA = WS_WBS + 4 * MiB,
                 WS_WOUT = WS_WBA + 2 * MiB, WS_W2A = WS_WOUT + 2 * MiB, WS_W2B = WS_W2A + 11 * MiB;
constexpr size_t WS_XB = WS_W2B + 6 * MiB, WS_ACT = WS_XB + 33 * MiB, WS_T = WS_ACT + 91 * MiB, WS_HF = WS_T + 66 * MiB, WS_HB = WS_HF + 66 * MiB,
                 WS_P = WS_HB + 33 * MiB, WS_SMF = WS_P + 306 * MiB, WS_XC = WS_SMF + 9 * MiB, WS_Y = WS_XC + 99 * MiB, WS_SC = WS_Y + 66 * MiB,
                 WS_SCS = WS_SC + 128 * MiB, WS_YA = WS_SCS + 5 * MiB, WS_MG = WS_YA + 33 * MiB, WS_END = WS_MG + 33 * MiB;
constexpr int CW_BAR = 4096;
constexpr int LDS_BYTES = 163840, MISC_OFF = LDS_BYTES - 256;
constexpr int WAREA = 17920;
constexpr int BIASREL_OFF = NWAVES * WAREA;
static_assert(BIASREL_OFF + 2 * 129 * 16 * 4 <= MISC_OFF, "LDS map");

constexpr float ALPHA = 1.18920711500272f;
constexpr float LN_EPS = 1e-5f;

struct Args { const float* in[29]; float* out; unsigned char* ws; int ph_lo, ph_hi; };
enum { I_XP = 0, I_XS, I_CK, I_CV, I_CKI, I_SCONV, I_SSSM, I_PT, I_BIAS, I_WIN, I_CONVW, I_CONVB, I_DTB, I_ALOG, I_DSKIP, I_NORMG, I_WBS, I_WBA, I_WOUT,
       I_F1WI, I_F1WO, I_F2WI, I_F2WO, I_LN1G, I_LN1B, I_LN2G, I_LN2B, I_LN3G, I_LN3B };

__device__ __forceinline__ float bf2f(unsigned v) { return __uint_as_float(v << 16); }
__device__ __forceinline__ unsigned f2bf(float f) { unsigned u = __float_as_uint(f); return (u + 0x7fffu + ((u >> 16) & 1u)) >> 16; }
__device__ __forceinline__ unsigned pk2(float lo, float hi) { return pg8::cvt_pk_bf16(lo, hi); }
__device__ __forceinline__ void unpack8(const u32x4 w, float (&f)[8]) {
#pragma unroll
    for (int i = 0; i < 4; ++i) { f[2 * i] = __uint_as_float(w[i] << 16); f[2 * i + 1] = __uint_as_float(w[i] & 0xffff0000u); }
}
__device__ __forceinline__ u32x4 pack8(const float (&f)[8]) { u32x4 w; w.x = pk2(f[0], f[1]); w.y = pk2(f[2], f[3]); w.z = pk2(f[4], f[5]); w.w = pk2(f[6], f[7]); return w; }
__device__ __forceinline__ float sigmoidf_(float x) { return 1.0f / (1.0f + __expf(-x)); }
__device__ __forceinline__ float siluf_(float x) { return x / (1.0f + __expf(-x)); }
__device__ __forceinline__ float wave_sum(float v) {
#pragma unroll
    for (int o = 1; o < 64; o <<= 1) v += __shfl_xor(v, o);
    return v;
}
__device__ __forceinline__ float wave_max(float v) {
#pragma unroll
    for (int o = 1; o < 64; o <<= 1) v = fmaxf(v, __shfl_xor(v, o));
    return v;
}
__device__ __forceinline__ f32x4 mfma16(bf16x8 a, bf16x8 b, f32x4 c) { return __builtin_amdgcn_mfma_f32_16x16x32_bf16(a, b, c, 0, 0, 0); }
__device__ __forceinline__ int mbcnt64(unsigned long long m) { return (int)__builtin_amdgcn_mbcnt_hi((unsigned)(m >> 32), __builtin_amdgcn_mbcnt_lo((unsigned)m, 0u)); }

struct EpiSwiglu {
    static constexpr bool PERM = true, AFTER_DRAIN = false;
    bf16_t* O;
    __device__ __forceinline__ void operator()(const f32x4 (&acc)[2][2][4][2], const pg8::Unit& u, int wr, int wc, int fr, int fq) const {
        const int row0 = u.pm * 256 + wr * 64 + fr, col0 = u.pn * 128 + wc * 32 + 8 * fq;
#pragma unroll
        for (int ai = 0; ai < 2; ++ai)
#pragma unroll
            for (int m = 0; m < 4; ++m) {
                float o[8];
#pragma unroll
                for (int n = 0; n < 2; ++n)
#pragma unroll
                    for (int j = 0; j < 4; ++j) { const float g = acc[ai][0][m][n][j], up = acc[ai][1][m][n][j]; o[4 * n + j] = siluf_(g) * up; }
                *(u32x4*)(O + (size_t)(row0 + ai * 128 + m * 16) * DFF + col0) = pack8(o);
            }
    }
};
struct EpiResid {
    static constexpr bool PERM = false, AFTER_DRAIN = false;
    const float* base_p; const float* base_s; float* T; float alpha, s;
    __device__ __forceinline__ void operator()(const f32x4 (&acc)[2][2][4][2], const pg8::Unit& u, int wr, int wc, int fr, int fq) const {
        const int row0 = u.pm * 256 + wr * 64 + fr, col0 = u.pn * 256 + wc * 32 + 4 * fq;
#pragma unroll
        for (int ai = 0; ai < 2; ++ai)
#pragma unroll
            for (int m = 0; m < 4; ++m) {
                const int r = row0 + ai * 128 + m * 16;
                const float* b = (r < MP) ? base_p + (size_t)r * D : base_s + (size_t)(r - MP) * D;
#pragma unroll
                for (int bj = 0; bj < 2; ++bj)
#pragma unroll
                    for (int n = 0; n < 2; ++n) { const int c = col0 + bj * 128 + n * 16; const f32x4 bv = *(const f32x4*)(b + c);
                        *(f32x4*)(T + (size_t)r * D + c) = bv * alpha + acc[ai][bj][m][n] * s; }
            }
    }
};
struct EpiWin {
    static constexpr bool PERM = true, AFTER_DRAIN = false;
    bf16_t* P; float* smf; float* out;
    __device__ __forceinline__ void operator()(const f32x4 (&acc)[2][2][4][2], const pg8::Unit& u, int wr, int wc, int fr, int fq) const {
        const int row0 = u.pm * 256 + wr * 64 + fr, cl = wc * 32 + 8 * fq, col0 = u.pn * 256 + cl;
#pragma unroll
        for (int ai = 0; ai < 2; ++ai)
#pragma unroll
            for (int m = 0; m < 4; ++m) {
                const int r = row0 + ai * 128 + m * 16;
#pragma unroll
                for (int bj = 0; bj < 2; ++bj) {
                    const f32x4 v0 = acc[ai][bj][m][0], v1 = acc[ai][bj][m][1];
                    u32x4 w; w.x = pk2(v0[0], v0[1]); w.y = pk2(v0[2], v0[3]); w.z = pk2(v1[0], v1[1]); w.w = pk2(v1[2], v1[3]);
                    *(u32x4*)(P + (size_t)r * NP + col0 + bj * 128) = w;
                    if (u.pn == 20) {
                        if (bj == 0) {
                            float* d = smf + (size_t)r * 128 + cl; *(f32x4*)d = v0; *(f32x4*)(d + 4) = v1;
                            if (cl >= 64) { float* k = out + ((r < MP) ? O_KIP + (size_t)r * 64 : O_KIS + (size_t)(r - MP) * 64) + (cl - 64); *(f32x4*)k = v0; *(f32x4*)(k + 4) = v1; }
                        }
                    } else if (u.pn == 25) {
                        float* k = out + ((r < MP) ? O_KP + (size_t)r * 256 : O_KS + (size_t)(r - MP) * 256) + bj * 128 + cl; *(f32x4*)k = v0; *(f32x4*)(k + 4) = v1;
                    } else if (u.pn == 26) {
                        float* k = out + ((r < MP) ? O_VP + (size_t)r * 256 : O_VS + (size_t)(r - MP) * 256) + bj * 128 + cl; *(f32x4*)k = v0; *(f32x4*)(k + 4) = v1;
                    }
                }
            }
    }
};
struct EpiGateA {
    static constexpr bool PERM = false, AFTER_DRAIN = false;
    const bf16_t* P; int gcol; float* M1;
    __device__ __forceinline__ void operator()(const f32x4 (&acc)[2][2][4][2], const pg8::Unit& u, int wr, int wc, int fr, int fq) const {
        const int row0 = u.pm * 256 + wr * 64 + fr, col0 = u.pn * 256 + wc * 32 + 4 * fq;
#pragma unroll
        for (int ai = 0; ai < 2; ++ai)
#pragma unroll
            for (int m = 0; m < 4; ++m) {
                const int r = row0 + ai * 128 + m * 16;
#pragma unroll
                for (int bj = 0; bj < 2; ++bj)
#pragma unroll
                    for (int n = 0; n < 2; ++n) { const int c = col0 + bj * 128 + n * 16; const u32x2 gw = *(const u32x2*)(P + (size_t)r * NP + gcol + c);
                        f32x4 g; g[0] = sigmoidf_(__uint_as_float(gw.x << 16)); g[1] = sigmoidf_(__uint_as_float(gw.x & 0xffff0000u)); g[2] = sigmoidf_(__uint_as_float(gw.y << 16)); g[3] = sigmoidf_(__uint_as_float(gw.y & 0xffff0000u));
                        *(f32x4*)(M1 + (size_t)r * D + c) = g * acc[ai][bj][m][n]; }
            }
    }
};
struct EpiGateS {
    static constexpr bool PERM = true, AFTER_DRAIN = false;
    const bf16_t* P; int gcol; const float* M1; bf16_t* MG;
    __device__ __forceinline__ void operator()(const f32x4 (&acc)[2][2][4][2], const pg8::Unit& u, int wr, int wc, int fr, int fq) const {
        const int row0 = u.pm * 256 + wr * 64 + fr, col0 = u.pn * 256 + wc * 32 + 8 * fq;
#pragma unroll
        for (int ai = 0; ai < 2; ++ai)
#pragma unroll
            for (int m = 0; m < 4; ++m) {
                const int r = row0 + ai * 128 + m * 16;
#pragma unroll
                for (int bj = 0; bj < 2; ++bj) { const int c = col0 + bj * 128;
                    const u32x4 gw = *(const u32x4*)(P + (size_t)r * NP + gcol + c); float g[8]; unpack8(gw, g);
                    const f32x4 m0 = *(const f32x4*)(M1 + (size_t)r * D + c), m1 = *(const f32x4*)(M1 + (size_t)r * D + c + 4);
                    float o[8];
#pragma unroll
                    for (int j = 0; j < 4; ++j) { o[j] = m0[j] + sigmoidf_(g[j]) * acc[ai][bj][m][0][j]; o[4 + j] = m1[j] + sigmoidf_(g[4 + j]) * acc[ai][bj][m][1][j]; }
                    *(u32x4*)(MG + (size_t)r * D + c) = pack8(o); }
            }
    }
};

struct SkResid { const float* base; float* T; float alpha, s;
    __device__ __forceinline__ void operator()(int r, int c, f32x4 v) const { const f32x4 bv = *(const f32x4*)(base + (size_t)(r - MP) * D + c); *(f32x4*)(T + (size_t)r * D + c) = bv * alpha + v * s; } };
struct SkGateA { const bf16_t* P; int gcol; float* M1;
    __device__ __forceinline__ void operator()(int r, int c, f32x4 v) const { const u32x2 gw = *(const u32x2*)(P + (size_t)r * NP + gcol + c);
        f32x4 g; g[0] = sigmoidf_(__uint_as_float(gw.x << 16)); g[1] = sigmoidf_(__uint_as_float(gw.x & 0xffff0000u)); g[2] = sigmoidf_(__uint_as_float(gw.y << 16)); g[3] = sigmoidf_(__uint_as_float(gw.y & 0xffff0000u));
        *(f32x4*)(M1 + (size_t)r * D + c) = g * v; } };
struct SkGateS { const bf16_t* P; int gcol; const float* M1; bf16_t* MG;
    __device__ __forceinline__ void operator()(int r, int c, f32x4 v) const { const u32x2 gw = *(const u32x2*)(P + (size_t)r * NP + gcol + c); const f32x4 m = *(const f32x4*)(M1 + (size_t)r * D + c);
        const float o0 = m[0] + sigmoidf_(__uint_as_float(gw.x << 16)) * v[0], o1 = m[1] + sigmoidf_(__uint_as_float(gw.x & 0xffff0000u)) * v[1], o2 = m[2] + sigmoidf_(__uint_as_float(gw.y << 16)) * v[2], o3 = m[3] + sigmoidf_(__uint_as_float(gw.y & 0xffff0000u)) * v[3];
        u32x2 w; w.x = pk2(o0, o1); w.y = pk2(o2, o3); *(u32x2*)(MG + (size_t)r * D + c) = w; } };
template <int K, class Epi>
__device__ __forceinline__ void skinny_gemm(LAS unsigned char* lds, const bf16_t* A  , const bf16_t* Bt, const Epi& E, int bx, int G, int wave, int lane) {
    constexpr int KW = K / 8, NS = KW / 32;
    const int fr = lane & 15, fq = lane >> 4, tid = wave * 64 + lane;
    LAS float* part = (LAS float*)lds;
    for (int tile = bx; tile < 256; tile += G) {
        const int tm = tile >> 4, tn = tile & 15;
        const bf16_t* ap = A + (size_t)(tm * 32 + fr) * K + wave * KW + 8 * fq;
        const bf16_t* bp = Bt + (size_t)(tn * 64 + fr) * K + wave * KW + 8 * fq;
        f32x4 acc[2][4];
#pragma unroll
        for (int m = 0; m < 2; ++m)
#pragma unroll
            for (int n = 0; n < 4; ++n) acc[m][n] = (f32x4){0.f, 0.f, 0.f, 0.f};
#pragma unroll 4
        for (int ks = 0; ks < NS; ++ks) {
            bf16x8 a[2], bb[4];
#pragma unroll
            for (int m = 0; m < 2; ++m) a[m] = *(const bf16x8*)(ap + (size_t)m * 16 * K + ks * 32);
#pragma unroll
            for (int n = 0; n < 4; ++n) bb[n] = *(const bf16x8*)(bp + (size_t)n * 16 * K + ks * 32);
#pragma unroll
            for (int m = 0; m < 2; ++m)
#pragma unroll
                for (int n = 0; n < 4; ++n) acc[m][n] = mfma16(a[m], bb[n], acc[m][n]);
        }
#pragma unroll
        for (int m = 0; m < 2; ++m)
#pragma unroll
            for (int n = 0; n < 4; ++n)
#pragma unroll
                for (int j = 0; j < 4; ++j) part[(wave * 32 + m * 16 + 4 * fq + j) * 64 + n * 16 + fr] = acc[m][n][j];
        __syncthreads();
        { const int row = tid >> 4, c4 = (tid & 15) * 4; f32x4 v = {0.f, 0.f, 0.f, 0.f};
#pragma unroll
          for (int w = 0; w < 8; ++w) v += *(const LAS f32x4*)(part + (w * 32 + row) * 64 + c4);
          E(MP + tm * 32 + row, tn * 64 + c4, v); }
        __syncthreads();
    }
}

__device__ __forceinline__ int tr_src(int mode, int n) {
    if (mode == 0) return n;
    if (mode == 1) { const int j = n >> 8, i = n & 255; return (i < 128) ? j * 128 + i : DFF + j * 128 + (i - 128); }
    if (n < 5120) return n;
    if (n < 5376) { const int j = n - 5120; if (j < 32) return 5120 + j; if (j < 40) return 7264 + (j - 32); if (j >= 64 && j < 128) return 7200 + (j - 64); return -1; }
    if (n < 6400) return 5152 + (n - 5376);
    if (n < 6656) return 6176 + (n - 6400);
    if (n < 6912) return 6432 + (n - 6656);
    if (n < 7424) return 6688 + (n - 6912);
    return 7272 + (n - 7424);
}
__device__ __forceinline__ void tr_item(const float* W, int K, int Nsrc, bf16_t* WT, int k0, int n0, int mode, LAS bf16_t* scr, int lane) {
    const int kr = lane >> 4, nc = (lane & 15) * 4;
    const int sc = tr_src(mode, n0 + nc);
    f32x4 v[16];
#pragma unroll
    for (int i = 0; i < 16; ++i) v[i] = (sc >= 0) ? *(const f32x4*)(W + (size_t)(k0 + 4 * i + kr) * Nsrc + sc) : (f32x4){0.f, 0.f, 0.f, 0.f};
#pragma unroll
    for (int i = 0; i < 16; ++i) { const int k = 4 * i + kr; const unsigned p01 = pk2(v[i][0], v[i][1]), p23 = pk2(v[i][2], v[i][3]);
        scr[(nc + 0) * 72 + k] = (bf16_t)(p01 & 0xffffu); scr[(nc + 1) * 72 + k] = (bf16_t)(p01 >> 16); scr[(nc + 2) * 72 + k] = (bf16_t)(p23 & 0xffffu); scr[(nc + 3) * 72 + k] = (bf16_t)(p23 >> 16); }
    asm volatile("s_waitcnt lgkmcnt(0)" ::: "memory");
    const int nr = lane >> 3, kc = (lane & 7) * 8;
#pragma unroll
    for (int i = 0; i < 8; ++i) { const int n = 8 * i + nr; *(u32x4*)(WT + (size_t)(n0 + n) * K + k0 + kc) = *(const LAS u32x4*)(scr + n * 72 + kc); }
    asm volatile("s_waitcnt lgkmcnt(0)" ::: "memory");
}
__device__ __forceinline__ void p0_prologue(const Args& A, LAS unsigned char* lds, int gw, int NGW, int wave, int lane) {
    LAS bf16_t* scr = (LAS bf16_t*)(lds + wave * 16384);
    unsigned char* ws = A.ws;
    constexpr int NI0 = 16 * 88, NI1 = 44 * 16, NI2 = 16 * 148, NI3 = 32 * 16, NI4 = 16 * 16, NI5 = 16 * 16, NI6 = NI0, NI7 = NI1;
    constexpr int NIT = NI0 + NI1 + NI2 + NI3 + NI4 + NI5 + NI6 + NI7;
    for (int it = gw; it < NIT; it += NGW) {
        int r = it; const float* W; bf16_t* WT; int K, Nsrc, nblk, mode;
        if (r < NI0) { W = A.in[I_F1WI]; WT = (bf16_t*)(ws + WS_W1A); K = 1024; Nsrc = 2 * DFF; nblk = 88; mode = 1; }
        else if ((r -= NI0) < NI1) { W = A.in[I_F1WO]; WT = (bf16_t*)(ws + WS_W1B); K = DFF; Nsrc = 1024; nblk = 16; mode = 0; }
        else if ((r -= NI1) < NI2) { W = A.in[I_WIN]; WT = (bf16_t*)(ws + WS_WIN); K = 1024; Nsrc = 9320; nblk = 148; mode = 2; }
        else if ((r -= NI2) < NI3) { W = A.in[I_WBS]; WT = (bf16_t*)(ws + WS_WBS); K = 2048; Nsrc = 1024; nblk = 16; mode = 0; }
        else if ((r -= NI3) < NI4) { W = A.in[I_WBA]; WT = (bf16_t*)(ws + WS_WBA); K = 1024; Nsrc = 1024; nblk = 16; mode = 0; }
        else if ((r -= NI4) < NI5) { W = A.in[I_WOUT]; WT = (bf16_t*)(ws + WS_WOUT); K = 1024; Nsrc = 1024; nblk = 16; mode = 0; }
        else if ((r -= NI5) < NI6) { W = A.in[I_F2WI]; WT = (bf16_t*)(ws + WS_W2A); K = 1024; Nsrc = 2 * DFF; nblk = 88; mode = 1; }
        else { r -= NI6; W = A.in[I_F2WO]; WT = (bf16_t*)(ws + WS_W2B); K = DFF; Nsrc = 1024; nblk = 16; mode = 0; }
        const int kb = r / nblk, nb = r % nblk;
        tr_item(W, K, Nsrc, WT, kb * 64, nb * 64, mode, scr, lane);
    }
    bf16_t* XB = (bf16_t*)(ws + WS_XB);
    const int nchunk = M * D / 8;
    for (int ch0 = gw * 256 + lane; ch0 < nchunk; ch0 += NGW * 256) {
        f32x4 a[4], b[4];
#pragma unroll
        for (int u = 0; u < 4; ++u) { const int ch = ch0 + 64 * u, m = ch >> 7, c = (ch & 127) * 8;
            const float* src = (m < MP) ? A.in[I_XP] + (size_t)m * D + c : A.in[I_XS] + (size_t)(m - MP) * D + c; a[u] = *(const f32x4*)src; b[u] = *(const f32x4*)(src + 4); }
#pragma unroll
        for (int u = 0; u < 4; ++u) { const int ch = ch0 + 64 * u, m = ch >> 7, c = (ch & 127) * 8;
            u32x4 w; w.x = pk2(a[u][0], a[u][1]); w.y = pk2(a[u][2], a[u][3]); w.z = pk2(b[u][0], b[u][1]); w.w = pk2(b[u][2], b[u][3]);
            *(u32x4*)(XB + (size_t)m * D + c) = w; }
    }
}

__device__ __forceinline__ void ln_phase(const float* T, const float* g, const float* b, float* outf, bf16_t* outb, int gw, int NGW, int lane) {
    f32x4 gv[4], bv[4];
#pragma unroll
    for (int j = 0; j < 4; ++j) { gv[j] = *(const f32x4*)(g + 4 * lane + 256 * j); bv[j] = *(const f32x4*)(b + 4 * lane + 256 * j); }
    for (int m = gw; m < M; m += NGW) {
        const float* xr = T + (size_t)m * D + 4 * lane;
        f32x4 v[4]; float s = 0.f;
#pragma unroll
        for (int j = 0; j < 4; ++j) { v[j] = *(const f32x4*)(xr + 256 * j); s += (v[j][0] + v[j][1]) + (v[j][2] + v[j][3]); }
        const float mean = wave_sum(s) * (1.f / D); float s2 = 0.f;
#pragma unroll
        for (int j = 0; j < 4; ++j) { v[j] = v[j] - mean; s2 += (v[j][0] * v[j][0] + v[j][1] * v[j][1]) + (v[j][2] * v[j][2] + v[j][3] * v[j][3]); }
        const float rstd = 1.0f / sqrtf(wave_sum(s2) * (1.f / D) + LN_EPS);
#pragma unroll
        for (int j = 0; j < 4; ++j) {
            const f32x4 o = v[j] * rstd * gv[j] + bv[j];
            *(f32x4*)(outf + (size_t)m * D + 4 * lane + 256 * j) = o;
            if (outb) { u32x2 w; w.x = pk2(o[0], o[1]); w.y = pk2(o[2], o[3]); *(u32x2*)(outb + (size_t)m * D + 4 * lane + 256 * j) = w; }
        }
    }
}

template <int NT  , bool SAMP>
__device__ __forceinline__ void conv_item(const Args& A, int b, int t0, int cg, int lane) {
    const bf16_t* P = (const bf16_t*)(A.ws + WS_P); bf16_t* XC = (bf16_t*)(A.ws + WS_XC);
    const float* cw = A.in[I_CONVW]; const float* cb = A.in[I_CONVB];
    const int ch = (cg * 64 + lane) * 8;
    const size_t row0 = SAMP ? (size_t)(MP + b * 4) : (size_t)(b * 2048 + t0);
    u32x4 raw[NT + 3];
#pragma unroll
    for (int i = 0; i < NT + 3; ++i) {
        const int t = t0 - 3 + i;
        if (t >= 0) raw[i] = *(const u32x4*)(P + (row0 + (size_t)(i - 3)) * NP + PXBC + ch);
        else raw[i] = (u32x4){0u, 0u, 0u, 0u};
    }
    float w[4][8], bias[8];
#pragma unroll
    for (int j = 0; j < 4; ++j) { const f32x4 w0 = *(const f32x4*)(cw + (size_t)j * XCW + ch), w1 = *(const f32x4*)(cw + (size_t)j * XCW + ch + 4);
#pragma unroll
        for (int i = 0; i < 4; ++i) { w[j][i] = w0[i]; w[j][4 + i] = w1[i]; } }
    { const f32x4 b0 = *(const f32x4*)(cb + ch), b1 = *(const f32x4*)(cb + ch + 4);
#pragma unroll
      for (int i = 0; i < 4; ++i) { bias[i] = b0[i]; bias[4 + i] = b1[i]; } }
    float u0[8], u1[8], u2[8];
    if (SAMP) {
        const float* sc = A.in[I_SCONV] + (size_t)b * 3 * XCW + ch;
#pragma unroll
        for (int i = 0; i < 4; ++i) { const f32x4 a0 = *(const f32x4*)(sc), a1 = *(const f32x4*)(sc + 4), c0 = *(const f32x4*)(sc + XCW), c1 = *(const f32x4*)(sc + XCW + 4), e0 = *(const f32x4*)(sc + 2 * XCW), e1 = *(const f32x4*)(sc + 2 * XCW + 4);
            u0[i] = a0[i]; u0[4 + i] = a1[i]; u1[i] = c0[i]; u1[4 + i] = c1[i]; u2[i] = e0[i]; u2[4 + i] = e1[i]; }
    } else { unpack8(raw[0], u0); unpack8(raw[1], u1); unpack8(raw[2], u2); }
#pragma unroll
    for (int i = 0; i < NT; ++i) {
        float u3[8], o[8]; unpack8(raw[i + 3], u3);
#pragma unroll
        for (int e = 0; e < 8; ++e) o[e] = siluf_(bias[e] + w[0][e] * u0[e] + w[1][e] * u1[e] + w[2][e] * u2[e] + w[3][e] * u3[e]);
        *(u32x4*)(XC + (row0 + (size_t)i) * XCW + ch) = pack8(o);
        const int t = t0 + i; float* cs = nullptr;
        if (!SAMP) { if (t >= 2045) cs = A.out + O_CVP + ((size_t)b * 3 + (t - 2045)) * XCW + ch; }
        else { if (t >= 1) cs = A.out + O_CVS + ((size_t)b * 3 + (t - 1)) * XCW + ch; }
        if (cs) { *(f32x4*)cs = (f32x4){u3[0], u3[1], u3[2], u3[3]}; *(f32x4*)(cs + 4) = (f32x4){u3[4], u3[5], u3[6], u3[7]}; }
#pragma unroll
        for (int e = 0; e < 8; ++e) { u0[e] = u1[e]; u1[e] = u2[e]; u2[e] = u3[e]; }
    }
}
__device__ __forceinline__ void conv_phase(const Args& A, int gw, int NGW, int lane) {
    constexpr int NPI = 8 * 128 * 6, NSI = 128 * 6;
    for (int it = gw; it < NPI + NSI; it += NGW) {
        if (it < NPI) { const int cg = it % 6, r = it / 6; conv_item<16, false>(A, r >> 7, (r & 127) * 16, cg, lane); }
        else { const int r = it - NPI; conv_item<4, true>(A, r / 6, 0, r % 6, lane); }
    }
}

constexpr float IDX_SCALE = 0.125f * 0.35355339059327373f;
constexpr int SCL = 2052;
__device__ __forceinline__ unsigned f2key(float v) { unsigned u = (v == 0.f) ? 0u : __float_as_uint(v); return (u & 0x80000000u) ? ~u : (u | 0x80000000u); }
__device__ __forceinline__ void scores_select_prompt_unit(const Args& A, LAS unsigned char* lds, int b, int qt, int wave, int lane_in) {
    const bf16_t* P = (const bf16_t*)(A.ws + WS_P); const float* SMF = (const float*)(A.ws + WS_SMF);
    unsigned long long* MASKW = (unsigned long long*)(A.ws + WS_SC);
    LAS float* sc = (LAS float*)lds;
    int lane = lane_in; asm volatile("" : "+v"(lane));
    const int fr = lane & 15, fq = lane >> 4;
    {
        const size_t rowq = (size_t)(b * 2048 + qt * 16 + fr);
        bf16x8 Af[8][2];
#pragma unroll
        for (int h = 0; h < 8; ++h)
#pragma unroll
            for (int ks = 0; ks < 2; ++ks) Af[h][ks] = *(const bf16x8*)(P + rowq * NP + PQI + h * 64 + ks * 32 + 8 * fq);
        float wq[4][8];
#pragma unroll
        for (int j = 0; j < 4; ++j) { const float* wp = SMF + (size_t)(b * 2048 + qt * 16 + 4 * fq + j) * 128 + 32; const f32x4 w0 = *(const f32x4*)wp, w1 = *(const f32x4*)(wp + 4);
#pragma unroll
            for (int h = 0; h < 4; ++h) { wq[j][h] = w0[h] * IDX_SCALE; wq[j][4 + h] = w1[h] * IDX_SCALE; } }
        const bf16_t* kbase = P + (size_t)(b * 2048 + fr) * NP + PSM + 64 + 8 * fq;
        bf16x8 nB0 = {0, 0, 0, 0, 0, 0, 0, 0}, nB1 = nB0;
        if (wave <= qt) { const bf16_t* kp = kbase + (size_t)wave * 16 * NP; nB0 = *(const bf16x8*)kp; nB1 = *(const bf16x8*)(kp + 32); }
        for (int kt = wave; kt <= qt; kt += NWAVES) {
            const bf16x8 B0 = nB0, B1 = nB1;
            if (kt + NWAVES <= qt) { const bf16_t* kp = kbase + (size_t)(kt + NWAVES) * 16 * NP; nB0 = *(const bf16x8*)kp; nB1 = *(const bf16x8*)(kp + 32); }
            f32x4 scv = {0.f, 0.f, 0.f, 0.f};
#pragma unroll
            for (int h = 0; h < 8; ++h) { f32x4 d = {0.f, 0.f, 0.f, 0.f}; d = mfma16(Af[h][0], B0, d); d = mfma16(Af[h][1], B1, d);
#pragma unroll
                for (int j = 0; j < 4; ++j) scv[j] += wq[j][h] * fmaxf(d[j], 0.f); }
#pragma unroll
            for (int j = 0; j < 4; ++j) sc[(4 * fq + j) * SCL + kt * 16 + fr] = scv[j];
#if MK_CHECK_ATT
#pragma unroll
            for (int j = 0; j < 4; ++j) ((float*)(A.ws + WS_END))[(size_t)(b * 2048 + qt * 16 + 4 * fq + j) * SCW + kt * 16 + fr] = scv[j];
#endif
        }
    }
    __syncthreads();
#pragma unroll 1
    for (int u = 0; u < 2; ++u) {
        const int ql = 2 * wave + u, t = qt * 16 + ql, nvalid = t + 1;
        const LAS float* srow = sc + ql * SCL + lane;
        unsigned key[32];
#pragma unroll
        for (int j = 0; j < 32; ++j) key[j] = (lane < nvalid - 64 * j) ? f2key(srow[64 * j]) : 0u;
        unsigned T = 0u; int need_eq = 0;
        if (nvalid > 256) {
            bool exact = false;
            for (int bit = 31; bit >= 0; --bit) {
                const unsigned cand = T | (1u << bit); int cnt = 0;
#pragma unroll
                for (int j = 0; j < 32; ++j) cnt += __popcll(__ballot(key[j] >= cand));
                if (cnt >= 256) { T = cand; if (cnt == 256) { exact = true; break; } }
            }
            if (exact) { T -= 1u; }
            else { int cgt = 0;
#pragma unroll
                for (int j = 0; j < 32; ++j) cgt += __popcll(__ballot(key[j] > T));
                need_eq = 256 - cgt; }
        }
        int eqused = 0; unsigned long long mine = 0ull;
#pragma unroll
        for (int j = 0; j < 32; ++j) {
            unsigned long long ms;
            if (need_eq > 0) {
                const bool gt = key[j] > T, eq = key[j] == T;
                const unsigned long long meq = __ballot(eq);
                const bool sel = gt || (eq && (eqused + mbcnt64(meq) < need_eq));
                eqused += __popcll(meq);
                ms = __ballot(sel);
            } else ms = __ballot(key[j] > T);
            if (lane == j) mine = ms;
        }
        if (lane < 32) MASKW[(size_t)(b * 2048 + t) * 32 + lane] = mine;
    }
    __syncthreads();
}
__device__ __forceinline__ void scores_sample_unit(const Args& A, int b, int half, int wave, int lane) {
    const bf16_t* P = (const bf16_t*)(A.ws + WS_P); const float* SMF = (const float*)(A.ws + WS_SMF); float* SCS = (float*)(A.ws + WS_SCS);
    const int* pt = (const int*)A.in[I_PT]; const float* cki = A.in[I_CKI];
    const int fr = lane & 15, fq = lane >> 4;
    bf16x8 Af[2][2]; float wq[2][4];
#pragma unroll
    for (int mt = 0; mt < 2; ++mt) {
#pragma unroll
        for (int ks = 0; ks < 2; ++ks) Af[mt][ks] = *(const bf16x8*)(P + (size_t)(MP + b * 4 + 2 * mt + (fr >> 3)) * NP + PQI + (fr & 7) * 64 + ks * 32 + 8 * fq);
        const f32x4 w = *(const f32x4*)(SMF + (size_t)(MP + b * 4 + 2 * mt + (fq >> 1)) * 128 + 32 + 4 * (fq & 1));
#pragma unroll
        for (int j = 0; j < 4; ++j) wq[mt][j] = w[j] * IDX_SCALE;
    }
    const int kt_end = (half == 0) ? 65 : 129;
    for (int kt = half * 65 + wave; kt < kt_end; kt += NWAVES) {
        const int key = kt * 16 + fr;
        bf16x8 B0, B1;
        if (key < 2048) {
            const int page = pt[b * 16 + (key >> 7)];
            const float* src = cki + ((size_t)page * 128 + (key & 127)) * 64 + 8 * fq;
            const f32x4 a0 = *(const f32x4*)src, a1 = *(const f32x4*)(src + 4), c0 = *(const f32x4*)(src + 32), c1 = *(const f32x4*)(src + 36);
            u32x4 w0, w1; w0.x = pk2(a0[0], a0[1]); w0.y = pk2(a0[2], a0[3]); w0.z = pk2(a1[0], a1[1]); w0.w = pk2(a1[2], a1[3]);
            w1.x = pk2(c0[0], c0[1]); w1.y = pk2(c0[2], c0[3]); w1.z = pk2(c1[0], c1[1]); w1.w = pk2(c1[2], c1[3]);
            B0 = __builtin_bit_cast(bf16x8, w0); B1 = __builtin_bit_cast(bf16x8, w1);
        } else if (key < 2052) {
            const bf16_t* src = P + (size_t)(MP + b * 4 + (key - 2048)) * NP + PSM + 64 + 8 * fq;
            B0 = *(const bf16x8*)src; B1 = *(const bf16x8*)(src + 32);
        } else { B0 = (bf16x8){0, 0, 0, 0, 0, 0, 0, 0}; B1 = B0; }
#pragma unroll
        for (int mt = 0; mt < 2; ++mt) {
            f32x4 d = {0.f, 0.f, 0.f, 0.f}; d = mfma16(Af[mt][0], B0, d); d = mfma16(Af[mt][1], B1, d);
            float s = 0.f;
#pragma unroll
            for (int j = 0; j < 4; ++j) s += wq[mt][j] * fmaxf(d[j], 0.f);
            s += __shfl_xor(s, 16);
            if ((fq & 1) == 0 && key < 2052) SCS[(size_t)(b * 4 + 2 * mt + (fq >> 1)) * SCSW + key] = s;
        }
    }
}

__device__ __forceinline__ float softplusf_(float x) { return fmaxf(x, 0.f) + log1pf(expf(-fabsf(x))); }
__device__ __forceinline__ void ssd_prompt_item(const Args& A, LAS unsigned char* lds, int b, int h) {
    const int tid = threadIdx.x, lane = tid & 63, wave = __builtin_amdgcn_readfirstlane(tid >> 6), fr = lane & 15, fq = lane >> 4;
    const int g = h >> 3;
    const bf16_t* XC = (const bf16_t*)(A.ws + WS_XC); const float* SMF = (const float*)(A.ws + WS_SMF); bf16_t* Y = (bf16_t*)(A.ws + WS_Y);
    LAS bf16_t* Cm = (LAS bf16_t*)lds;
    LAS bf16_t* Bm = Cm + 64 * 136;
    LAS bf16_t* Btw = Bm + 64 * 136;
    LAS bf16_t* Xt = Btw + 128 * 72;
    LAS bf16_t* Mt = Xt + 64 * 72;
    LAS bf16_t* Hp = Mt + 64 * 72;
    LAS float* cumA = (LAS float*)(Hp + 64 * 136);
    LAS float* dtvA = cumA + 2048; LAS float* wvA = dtvA + 2048; LAS float* ecumA = wvA + 2048;
    const float Ah = -expf(A.in[I_ALOG][h]), dtb = A.in[I_DTB][h], dsk = A.in[I_DSKIP][h];
    f32x4 hst[4];
#pragma unroll
    for (int i = 0; i < 4; ++i) hst[i] = (f32x4){0.f, 0.f, 0.f, 0.f};
    for (int i = tid; i < 64 * 136 / 8; i += NTHR) *(LAS u32x4*)(Hp + i * 8) = (u32x4){0u, 0u, 0u, 0u};
#pragma unroll 1
    for (int c = wave; c < 32; c += NWAVES) {
        const int tk = c * 64 + lane;
        const float dt = softplusf_(SMF[(size_t)(b * 2048 + tk) * 128 + h] + dtb);
        float v = dt * Ah;
#pragma unroll
        for (int o = 1; o < 64; o <<= 1) { const float n = __shfl_up(v, o); if (lane >= o) v += n; }
        const float ce = __shfl(v, 63);
        cumA[tk] = v; dtvA[tk] = dt; wvA[tk] = dt * expf(ce - v); ecumA[tk] = expf(v);
    }
    const int s0 = tid >> 4, part0 = tid & 15;
    const int xs = tid >> 3, xpart = tid & 7;
    u32x4 cr[2], br[2], xr;
    {
#pragma unroll
        for (int i = 0; i < 2; ++i) { const bf16_t* rp = XC + (size_t)(b * 2048 + s0 + 32 * i) * XCW + g * 128 + part0 * 8; cr[i] = *(const u32x4*)(rp + 2560); br[i] = *(const u32x4*)(rp + 2048); }
        xr = *(const u32x4*)(XC + (size_t)(b * 2048 + xs) * XCW + h * 64 + xpart * 8);
    }
    for (int c = 0; c < 32; ++c) {
        const int row0 = b * 2048 + c * 64;
        const LAS float* cum = cumA + c * 64; const LAS float* dtv = dtvA + c * 64; const LAS float* wv = wvA + c * 64; const LAS float* ecum = ecumA + c * 64;
        __syncthreads();
#pragma unroll
        for (int i = 0; i < 2; ++i) {
            const int s = s0 + 32 * i;
            *(LAS u32x4*)(Cm + s * 136 + part0 * 8) = cr[i];
            *(LAS u32x4*)(Bm + s * 136 + part0 * 8) = br[i];
            float bf[8]; unpack8(br[i], bf); const float w = wv[s];
#pragma unroll
            for (int e = 0; e < 8; ++e) Btw[(part0 * 8 + e) * 72 + s] = (bf16_t)f2bf(bf[e] * w);
        }
        {
#pragma unroll
            for (int e = 0; e < 4; ++e) { Xt[(xpart * 8 + 2 * e) * 72 + xs] = (bf16_t)(xr[e] & 0xffffu); Xt[(xpart * 8 + 2 * e + 1) * 72 + xs] = (bf16_t)(xr[e] >> 16); }
        }
#pragma unroll
        for (int p4 = 0; p4 < 4; ++p4) { u32x2 w; w.x = pk2(hst[p4][0], hst[p4][1]); w.y = pk2(hst[p4][2], hst[p4][3]);
            *(LAS u32x2*)(Hp + (16 * p4 + fr) * 136 + 16 * wave + 4 * fq) = w; }
        if (c + 1 < 32) {
#pragma unroll
            for (int i = 0; i < 2; ++i) { const bf16_t* rp = XC + (size_t)(row0 + 64 + s0 + 32 * i) * XCW + g * 128 + part0 * 8; cr[i] = *(const u32x4*)(rp + 2560); br[i] = *(const u32x4*)(rp + 2048); }
            xr = *(const u32x4*)(XC + (size_t)(row0 + 64 + xs) * XCW + h * 64 + xpart * 8);
        }
        __syncthreads();
        {
            const int st = wave >> 1, tt0 = 2 * (wave & 1);
            bf16x8 a[4];
#pragma unroll
            for (int ks = 0; ks < 4; ++ks) a[ks] = *(const LAS bf16x8*)(Bm + (16 * st + fr) * 136 + ks * 32 + 8 * fq);
#pragma unroll
            for (int u = 0; u < 2; ++u) {
                const int tt = tt0 + u; f32x4 d = {0.f, 0.f, 0.f, 0.f};
#pragma unroll
                for (int ks = 0; ks < 4; ++ks) { const bf16x8 bb = *(const LAS bf16x8*)(Cm + (16 * tt + fr) * 136 + ks * 32 + 8 * fq); d = mfma16(a[ks], bb, d); }
                const int t = 16 * tt + fr; const float ct = cum[t]; float mv[4];
#pragma unroll
                for (int j = 0; j < 4; ++j) { const int s = 16 * st + 4 * fq + j; mv[j] = (s <= t) ? d[j] * __expf(ct - cum[s]) * dtv[s] : 0.f; }
                u32x2 w; w.x = pk2(mv[0], mv[1]); w.y = pk2(mv[2], mv[3]);
                *(LAS u32x2*)(Mt + t * 72 + 16 * st + 4 * fq) = w;
            }
        }
        __syncthreads();
        {
            const int pt = wave >> 1, tt0 = 2 * (wave & 1);
            bf16x8 a1[2], a2[4];
#pragma unroll
            for (int ks = 0; ks < 2; ++ks) a1[ks] = *(const LAS bf16x8*)(Xt + (16 * pt + fr) * 72 + ks * 32 + 8 * fq);
#pragma unroll
            for (int ks = 0; ks < 4; ++ks) a2[ks] = *(const LAS bf16x8*)(Hp + (16 * pt + fr) * 136 + ks * 32 + 8 * fq);
#pragma unroll
            for (int u = 0; u < 2; ++u) {
                const int tt = tt0 + u; f32x4 d1 = {0.f, 0.f, 0.f, 0.f}, d2 = {0.f, 0.f, 0.f, 0.f};
#pragma unroll
                for (int ks = 0; ks < 2; ++ks) { const bf16x8 bb = *(const LAS bf16x8*)(Mt + (16 * tt + fr) * 72 + ks * 32 + 8 * fq); d1 = mfma16(a1[ks], bb, d1); }
#pragma unroll
                for (int ks = 0; ks < 4; ++ks) { const bf16x8 bb = *(const LAS bf16x8*)(Cm + (16 * tt + fr) * 136 + ks * 32 + 8 * fq); d2 = mfma16(a2[ks], bb, d2); }
                const int t = 16 * tt + fr; const float et = ecum[t]; float yv[4];
#pragma unroll
                for (int j = 0; j < 4; ++j) { const int p = 16 * pt + 4 * fq + j; yv[j] = d1[j] + et * d2[j] + dsk * bf2f((unsigned)Xt[p * 72 + t]); }
                u32x2 w; w.x = pk2(yv[0], yv[1]); w.y = pk2(yv[2], yv[3]);
                *(u32x2*)(Y + (size_t)(row0 + t) * DI + h * 64 + 16 * pt + 4 * fq) = w;
            }
            bf16x8 a3[2];
#pragma unroll
            for (int ks = 0; ks < 2; ++ks) a3[ks] = *(const LAS bf16x8*)(Btw + (16 * wave + fr) * 72 + ks * 32 + 8 * fq);
            const float dec = ecum[63];
#pragma unroll
            for (int p4 = 0; p4 < 4; ++p4) { f32x4 d = {0.f, 0.f, 0.f, 0.f};
#pragma unroll
                for (int ks = 0; ks < 2; ++ks) { const bf16x8 bb = *(const LAS bf16x8*)(Xt + (16 * p4 + fr) * 72 + ks * 32 + 8 * fq); d = mfma16(a3[ks], bb, d); }
                hst[p4] = hst[p4] * dec + d; }
        }
    }
    float* so = A.out + O_SSP + ((size_t)b * 32 + h) * 64 * 128;
#pragma unroll
    for (int p4 = 0; p4 < 4; ++p4) *(f32x4*)(so + (size_t)(16 * p4 + fr) * 128 + 16 * wave + 4 * fq) = hst[p4];
    __syncthreads();
}

__device__ __forceinline__ void ssd_sample_item(const Args& A, LAS unsigned char* wl, int b, int h, int lane) {
    const bf16_t* XC = (const bf16_t*)(A.ws + WS_XC); const float* SMF = (const float*)(A.ws + WS_SMF); bf16_t* Y = (bf16_t*)(A.ws + WS_Y);
    LAS float* red = (LAS float*)wl;
    const int g = h >> 3;
    const float Ah = -expf(A.in[I_ALOG][h]), dtb = A.in[I_DTB][h], dsk = A.in[I_DSKIP][h];
#pragma unroll 1
    for (int half = 0; half < 2; ++half) {
        const float* h0 = A.in[I_SSSM] + (((size_t)b * 32 + h) * 64 + 32 * half) * 128 + 2 * lane;
        float st[32][2];
#pragma unroll
        for (int p = 0; p < 32; ++p) { const float2 v = *(const float2*)(h0 + p * 128); st[p][0] = v.x; st[p][1] = v.y; }
#pragma unroll 1
        for (int t = 0; t < 4; ++t) {
            const size_t m = (size_t)(MP + b * 4 + t);
            const float dt = softplusf_(SMF[m * 128 + h] + dtb), dec = expf(dt * Ah);
            const unsigned bw = *(const unsigned*)(XC + m * XCW + 2048 + g * 128 + 2 * lane), cw = *(const unsigned*)(XC + m * XCW + 2560 + g * 128 + 2 * lane);
            const float b0 = bf2f(bw & 0xffffu) * dt, b1 = __uint_as_float(bw & 0xffff0000u) * dt, c0 = bf2f(cw & 0xffffu), c1 = __uint_as_float(cw & 0xffff0000u);
            const float xl = bf2f((unsigned)XC[m * XCW + h * 64 + 32 * half + (lane & 31)]);
#pragma unroll
            for (int p = 0; p < 32; ++p) {
                const float xp = __shfl(xl, p);
                st[p][0] = st[p][0] * dec + xp * b0; st[p][1] = st[p][1] * dec + xp * b1;
                red[p * 65 + lane] = st[p][0] * c0 + st[p][1] * c1;
            }
            asm volatile("s_waitcnt lgkmcnt(0)" ::: "memory");
            float y = 0.f;
#pragma unroll 16
            for (int i = 0; i < 64; ++i) y += red[(lane & 31) * 65 + i];
            y += dsk * xl;
            if (lane < 32) Y[m * DI + h * 64 + 32 * half + lane] = (bf16_t)f2bf(y);
            asm volatile("s_waitcnt lgkmcnt(0)" ::: "memory");
        }
        float* so = A.out + O_SSS + (((size_t)b * 32 + h) * 64 + 32 * half) * 128 + 2 * lane;
#pragma unroll
        for (int p = 0; p < 32; ++p) *(float2*)(so + p * 128) = make_float2(st[p][0], st[p][1]);
    }
}

__device__ __forceinline__ int t5_bucket(int n) {
    if (n < 16) return n;
    const float nf = (float)n;
    int large = 16 + (int)(logf(nf / 16.0f) / 2.0794415416798357f * 16.0f);
    return large < 31 ? large : 31;
}
typedef float f32x16 __attribute__((ext_vector_type(16)));
__device__ __forceinline__ f32x16 mfma32(bf16x8 a, bf16x8 b, f32x16 c) { return __builtin_amdgcn_mfma_f32_32x32x16_bf16(a, b, c, 0, 0, 0); }
constexpr float LOG2E = 1.4426950408889634f;
constexpr int AK_STR = 72, AV_STR = 68, AT_K0 = 0, AT_V0 = 2 * 64 * AK_STR * 2, AT_WS = AT_V0 + 2 * 64 * AV_STR * 2;
__device__ __forceinline__ void attn_prompt_unit(const Args& A, LAS unsigned char* lds, const LAS float* biasL, int b, int g, int qt, int wave, int lane_in) {
    const bf16_t* P = (const bf16_t*)(A.ws + WS_P); const unsigned* MASK32 = (const unsigned*)(A.ws + WS_SC); bf16_t* YA = (bf16_t*)(A.ws + WS_YA);
    int lane = lane_in; asm volatile("" : "+v"(lane));
    const int tid = wave * 64 + lane, r32 = lane & 31, hi = lane >> 5;
    LAS float* wsc = (LAS float*)(lds + AT_WS) + wave * 64;
    const int query = qt * 64 + 8 * wave + (r32 >> 2), head = 4 * g + (r32 & 3);
    const size_t qrow = (size_t)(b * 2048 + query);
    bf16x8 qf[4];
#pragma unroll
    for (int ds = 0; ds < 4; ++ds) qf[ds] = *(const bf16x8*)(P + qrow * NP + PQ + head * 64 + 16 * ds + 8 * hi);
    const unsigned* mrow = MASK32 + qrow * 64;
    const float bfar = biasL[128 * 16 + head];
    const int skey = tid >> 3, sdch = tid & 7;
    const bf16_t* ksrc = P + (size_t)(b * 2048 + skey) * NP + PK + g * 64 + sdch * 8;
    f32x16 O0, O1;
#pragma unroll
    for (int i = 0; i < 16; ++i) { O0[i] = 0.f; O1[i] = 0.f; }
    float m_run = -1e30f, l_run = 0.f;
    u32x4 kreg = *(const u32x4*)ksrc, vreg = *(const u32x4*)(ksrc + 256);
    unsigned mw0 = mrow[0], mw1 = mrow[1];
    {
        LAS bf16_t* Kb = (LAS bf16_t*)(lds + AT_K0); LAS bf16_t* Vb = (LAS bf16_t*)(lds + AT_V0);
        *(LAS u32x4*)(Kb + skey * AK_STR + sdch * 8) = kreg;
#pragma unroll
        for (int e = 0; e < 4; ++e) { Vb[(sdch * 8 + 2 * e) * AV_STR + skey] = (bf16_t)(vreg[e] & 0xffffu); Vb[(sdch * 8 + 2 * e + 1) * AV_STR + skey] = (bf16_t)(vreg[e] >> 16); }
    }
    for (int kt = 0; kt <= qt; ++kt) {
        const int buf = kt & 1;
        __syncthreads();
        const unsigned w0 = mw0 >> (4 * hi), w1 = mw1 >> (4 * hi);
        if (kt < qt) { const bf16_t* src = ksrc + (size_t)(kt + 1) * 64 * NP; kreg = *(const u32x4*)src; vreg = *(const u32x4*)(src + 256); mw0 = mrow[2 * kt + 2]; mw1 = mrow[2 * kt + 3]; }
        const LAS bf16_t* Kb = (const LAS bf16_t*)(lds + AT_K0 + buf * (64 * AK_STR * 2)); const LAS bf16_t* Vb = (const LAS bf16_t*)(lds + AT_V0 + buf * (64 * AV_STR * 2));
        f32x16 S0, S1;
#pragma unroll
        for (int i = 0; i < 16; ++i) { S0[i] = 0.f; S1[i] = 0.f; }
#pragma unroll
        for (int ds = 0; ds < 4; ++ds) {
            const bf16x8 k0 = *(const LAS bf16x8*)(Kb + r32 * AK_STR + 16 * ds + 8 * hi), k1 = *(const LAS bf16x8*)(Kb + (32 + r32) * AK_STR + 16 * ds + 8 * hi);
            S0 = mfma32(k0, qf[ds], S0); S1 = mfma32(k1, qf[ds], S1);
        }
        const float c1 = 0.125f * LOG2E;
        if (qt - kt >= 3) {
#pragma unroll
            for (int i = 0; i < 16; ++i) { const unsigned bit = 1u << ((i & 3) + 8 * (i >> 2));
                S0[i] = (w0 & bit) ? S0[i] * c1 + bfar : -INFINITY; S1[i] = (w1 & bit) ? S1[i] * c1 + bfar : -INFINITY; }
        } else {
            const int rb = query - (kt * 64 + 4 * hi);
            const LAS float* bl = biasL + head;
            float bv0[16], bv1[16];
#pragma unroll
            for (int i = 0; i < 16; ++i) { const int pos = (i & 3) + 8 * (i >> 2);
                int r0 = rb - pos, r1 = r0 - 32; r0 = r0 < 0 ? 0 : (r0 > 128 ? 128 : r0); r1 = r1 < 0 ? 0 : (r1 > 128 ? 128 : r1);
                bv0[i] = bl[r0 * 16]; bv1[i] = bl[r1 * 16]; }
#pragma unroll
            for (int i = 0; i < 16; ++i) { const unsigned bit = 1u << ((i & 3) + 8 * (i >> 2));
                const float x0 = S0[i] * c1 + bv0[i], x1 = S1[i] * c1 + bv1[i];
                S0[i] = (w0 & bit) ? x0 : -INFINITY; S1[i] = (w1 & bit) ? x1 : -INFINITY; }
        }
        float tm = fmaxf(S0[0], S1[0]);
#pragma unroll
        for (int i = 1; i < 16; ++i) tm = fmaxf(tm, fmaxf(S0[i], S1[i]));
        tm = fmaxf(tm, __shfl_xor(tm, 32));
        if (__any(tm > m_run + 8.0f)) {
            const float mn = fmaxf(m_run, tm), f = __builtin_amdgcn_exp2f(m_run - mn);
            m_run = mn; l_run *= f;
            if (hi == 0) wsc[r32] = f;
            asm volatile("s_waitcnt lgkmcnt(0)" ::: "memory");
#pragma unroll
            for (int i = 0; i < 16; ++i) { const float fi = wsc[(i & 3) + 8 * (i >> 2) + 4 * hi]; O0[i] *= fi; O1[i] *= fi; }
            asm volatile("s_waitcnt lgkmcnt(0)" ::: "memory");
        }
        float ls = 0.f;
#pragma unroll
        for (int i = 0; i < 16; ++i) { S0[i] = __builtin_amdgcn_exp2f(S0[i] - m_run); S1[i] = __builtin_amdgcn_exp2f(S1[i] - m_run); ls += S0[i] + S1[i]; }
        l_run += ls;
        bf16x8 pa[2][2];
#pragma unroll
        for (int sk = 0; sk < 2; ++sk) {
            u32x4 a0, a1;
            a0.x = pk2(S0[8 * sk + 0], S0[8 * sk + 1]); a0.y = pk2(S0[8 * sk + 2], S0[8 * sk + 3]); a0.z = pk2(S0[8 * sk + 4], S0[8 * sk + 5]); a0.w = pk2(S0[8 * sk + 6], S0[8 * sk + 7]);
            a1.x = pk2(S1[8 * sk + 0], S1[8 * sk + 1]); a1.y = pk2(S1[8 * sk + 2], S1[8 * sk + 3]); a1.z = pk2(S1[8 * sk + 4], S1[8 * sk + 5]); a1.w = pk2(S1[8 * sk + 6], S1[8 * sk + 7]);
            pa[0][sk] = __builtin_bit_cast(bf16x8, a0); pa[1][sk] = __builtin_bit_cast(bf16x8, a1);
        }
#pragma unroll
        for (int blk = 0; blk < 2; ++blk)
#pragma unroll
            for (int sk = 0; sk < 2; ++sk) {
                const int kb = 32 * blk + 16 * sk + 4 * hi;
                const u32x2 a = *(const LAS u32x2*)(Vb + r32 * AV_STR + kb), c = *(const LAS u32x2*)(Vb + r32 * AV_STR + kb + 8);
                const u32x2 a2 = *(const LAS u32x2*)(Vb + (32 + r32) * AV_STR + kb), c2 = *(const LAS u32x2*)(Vb + (32 + r32) * AV_STR + kb + 8);
                const u32x4 v0 = {a.x, a.y, c.x, c.y}, v1 = {a2.x, a2.y, c2.x, c2.y};
                O0 = mfma32(pa[blk][sk], __builtin_bit_cast(bf16x8, v0), O0);
                O1 = mfma32(pa[blk][sk], __builtin_bit_cast(bf16x8, v1), O1);
            }
        if (kt < qt) {
            LAS bf16_t* Kn = (LAS bf16_t*)(lds + AT_K0 + (buf ^ 1) * (64 * AK_STR * 2)); LAS bf16_t* Vn = (LAS bf16_t*)(lds + AT_V0 + (buf ^ 1) * (64 * AV_STR * 2));
            *(LAS u32x4*)(Kn + skey * AK_STR + sdch * 8) = kreg;
#pragma unroll
            for (int e = 0; e < 4; ++e) { Vn[(sdch * 8 + 2 * e) * AV_STR + skey] = (bf16_t)(vreg[e] & 0xffffu); Vn[(sdch * 8 + 2 * e + 1) * AV_STR + skey] = (bf16_t)(vreg[e] >> 16); }
        }
    }
    l_run += __shfl_xor(l_run, 32);
    if (hi == 0) wsc[r32] = 1.0f / l_run;
    asm volatile("s_waitcnt lgkmcnt(0)" ::: "memory");
#pragma unroll
    for (int i = 0; i < 16; ++i) {
        const int rq = (i & 3) + 8 * (i >> 2) + 4 * hi; const float inv = wsc[rq];
        bf16_t* dst = YA + (size_t)(b * 2048 + qt * 64 + 8 * wave + (rq >> 2)) * D + (4 * g + (rq & 3)) * 64 + r32;
        dst[0] = (bf16_t)f2bf(O0[i] * inv); dst[32] = (bf16_t)f2bf(O1[i] * inv);
    }
    __syncthreads();
}

__device__ __forceinline__ void attend_sample_task(const Args& A, LAS unsigned char* wl, const LAS float* biasrel, int ms, int g, int lane_in) {
    constexpr int NJ = 33;
    int lane = lane_in; asm volatile("" : "+v"(lane));
    const bf16_t* P = (const bf16_t*)(A.ws + WS_P);
    const int b = ms >> 2, t = ms & 3, nvalid = 2049 + t, qpos = 2048 + t, m = MP + ms;
    const float* srow = (const float*)(A.ws + WS_SCS) + (size_t)ms * SCSW;
    LAS float* pq = (LAS float*)wl;
    LAS unsigned* rowid = (LAS unsigned*)(wl + 4096);
    LAS unsigned short* posl = (LAS unsigned short*)(wl + 4096 + 1024);
    unsigned key[NJ];
#pragma unroll
    for (int j = 0; j < NJ; ++j) key[j] = (lane < nvalid - 64 * j) ? f2key(srow[lane + 64 * j]) : 0u;
    unsigned T = 0u; int need_eq = 0;
    {
        bool exact = false;
        for (int bit = 31; bit >= 0; --bit) {
            const unsigned cand = T | (1u << bit); int cnt = 0;
#pragma unroll
            for (int j = 0; j < NJ; ++j) cnt += __popcll(__ballot(key[j] >= cand));
            if (cnt >= 256) { T = cand; if (cnt == 256) { exact = true; break; } }
        }
        if (exact) { T -= 1u; }
        else { int cgt = 0;
#pragma unroll
            for (int j = 0; j < NJ; ++j) cgt += __popcll(__ballot(key[j] > T));
            need_eq = 256 - cgt; }
    }
    int base = 0, eqused = 0;
    const int* pt = (const int*)A.in[I_PT];
#pragma unroll
    for (int j = 0; j < NJ; ++j) {
        const bool gt = key[j] > T, eq = (need_eq > 0) && (key[j] == T);
        const unsigned long long meq = __ballot(eq);
        const bool sel = gt || (eq && (eqused + mbcnt64(meq) < need_eq));
        eqused += __popcll(meq);
        const unsigned long long msk = __ballot(sel);
        if (sel) { const int pos = lane + 64 * j, k = base + mbcnt64(msk);
            posl[k] = (unsigned short)pos;
            rowid[k] = (pos < 2048) ? (unsigned)(pt[b * 16 + (pos >> 7)] * 128 + (pos & 127)) : (0x80000000u | (unsigned)(b * 4 + pos - 2048)); }
        base += __popcll(msk);
    }
    { const u32x2 w = *(const u32x2*)(P + (size_t)m * NP + PQ + g * 256 + lane * 4);
      *(LAS f32x4*)(pq + lane * 4) = (f32x4){__uint_as_float(w.x << 16), __uint_as_float(w.x & 0xffff0000u), __uint_as_float(w.y << 16), __uint_as_float(w.y & 0xffff0000u)}; }
    asm volatile("s_waitcnt lgkmcnt(0)" ::: "memory");
    const float* ck = A.in[I_CK]; const float* cv = A.in[I_CV]; const float* kn = A.out + O_KS; const float* vn = A.out + O_VS;
    const float* kp[4]; int rel[4];
#pragma unroll
    for (int i = 0; i < 4; ++i) { const unsigned rid = rowid[lane + 64 * i]; rel[i] = qpos - (int)posl[lane + 64 * i];
        kp[i] = ((rid & 0x80000000u) ? kn + (size_t)(rid & 0x7fffffffu) * 256 : ck + (size_t)rid * 256) + g * 64; }
    float acc[4][4];
#pragma unroll
    for (int i = 0; i < 4; ++i)
#pragma unroll
        for (int hh = 0; hh < 4; ++hh) acc[i][hh] = 0.f;
#pragma unroll 2
    for (int dc = 0; dc < 16; ++dc) {
        f32x4 kv[4];
#pragma unroll
        for (int i = 0; i < 4; ++i) kv[i] = *(const f32x4*)(kp[i] + dc * 4);
#pragma unroll
        for (int hh = 0; hh < 4; ++hh) { const f32x4 q4 = *(const LAS f32x4*)(pq + hh * 64 + dc * 4);
#pragma unroll
            for (int i = 0; i < 4; ++i) acc[i][hh] += kv[i][0] * q4[0] + kv[i][1] * q4[1] + kv[i][2] * q4[2] + kv[i][3] * q4[3]; }
    }
    asm volatile("s_waitcnt lgkmcnt(0)" ::: "memory");
#pragma unroll
    for (int i = 0; i < 4; ++i) { const int rc = rel[i] < 128 ? (rel[i] < 0 ? 0 : rel[i]) : 128; const f32x4 bv = *(const LAS f32x4*)(biasrel + rc * 16 + 4 * g);
#pragma unroll
        for (int hh = 0; hh < 4; ++hh) acc[i][hh] = acc[i][hh] * 0.125f + bv[hh]; }
#pragma unroll
    for (int hh = 0; hh < 4; ++hh) {
        const float mx = wave_max(fmaxf(fmaxf(acc[0][hh], acc[1][hh]), fmaxf(acc[2][hh], acc[3][hh])));
        float sm = 0.f;
#pragma unroll
        for (int i = 0; i < 4; ++i) { acc[i][hh] = __expf(acc[i][hh] - mx); sm += acc[i][hh]; }
        const float inv = 1.0f / wave_sum(sm);
#pragma unroll
        for (int i = 0; i < 4; ++i) acc[i][hh] *= inv;
    }
#pragma unroll
    for (int i = 0; i < 4; ++i) *(LAS f32x4*)(pq + (lane + 64 * i) * 4) = (f32x4){acc[i][0], acc[i][1], acc[i][2], acc[i][3]};
    asm volatile("s_waitcnt lgkmcnt(0)" ::: "memory");
    float o[4] = {0.f, 0.f, 0.f, 0.f};
    for (int k0 = 0; k0 < 256; k0 += 8) {
        float vv[8]; f32x4 pp[8];
#pragma unroll
        for (int u = 0; u < 8; ++u) { const unsigned rid = rowid[k0 + u];
            const float* vp = ((rid & 0x80000000u) ? vn + (size_t)(rid & 0x7fffffffu) * 256 : cv + (size_t)rid * 256) + g * 64 + lane;
            vv[u] = *vp; pp[u] = *(const LAS f32x4*)(pq + (k0 + u) * 4); }
#pragma unroll
        for (int u = 0; u < 8; ++u)
#pragma unroll
            for (int hh = 0; hh < 4; ++hh) o[hh] += pp[u][hh] * vv[u];
    }
    bf16_t* YA = (bf16_t*)(A.ws + WS_YA);
#pragma unroll
    for (int hh = 0; hh < 4; ++hh) YA[(size_t)m * D + (4 * g + hh) * 64 + lane] = (bf16_t)f2bf(o[hh]);
    asm volatile("s_waitcnt lgkmcnt(0)" ::: "memory");
}

#if MK_CHECK_ATT
constexpr size_t WS_CHK_SC = WS_END, WS_CHK_YA = WS_CHK_SC + 128 * MiB, WS_CHK_MASK = WS_CHK_YA + 33 * MiB, WS_CHK_END = WS_CHK_MASK + 4 * MiB;
constexpr int CW_CHK = 512;
template <bool SAMPLE> struct KVRow;
template <> struct KVRow<false> {
    typedef const bf16_t* ptr;
    const bf16_t* P;
    __device__ __forceinline__ ptr krow(unsigned rid) const { return P + (size_t)rid * NP + PK; }
    __device__ __forceinline__ ptr vrow(unsigned rid) const { return P + (size_t)rid * NP + PV; }
    static __device__ __forceinline__ void k8(ptr p, float (&f)[8]) { unpack8(*(const u32x4*)p, f); }
    static __device__ __forceinline__ f32x4 v4(ptr p) { const u32x2 w = *(const u32x2*)p;
        return (f32x4){__uint_as_float(w.x << 16), __uint_as_float(w.x & 0xffff0000u), __uint_as_float(w.y << 16), __uint_as_float(w.y & 0xffff0000u)}; }
};
template <> struct KVRow<true> {
    typedef const float* ptr;
    const float* ck; const float* cv; const float* kn; const float* vn;
    __device__ __forceinline__ ptr krow(unsigned rid) const { return (rid & 0x80000000u) ? kn + (size_t)(rid & 0x7fffffffu) * 256 : ck + (size_t)rid * 256; }
    __device__ __forceinline__ ptr vrow(unsigned rid) const { return (rid & 0x80000000u) ? vn + (size_t)(rid & 0x7fffffffu) * 256 : cv + (size_t)rid * 256; }
    static __device__ __forceinline__ void k8(ptr p, float (&f)[8]) { const f32x4 a = *(const f32x4*)p, b = *(const f32x4*)(p + 4);
#pragma unroll
        for (int i = 0; i < 4; ++i) { f[i] = a[i]; f[4 + i] = b[i]; } }
    static __device__ __forceinline__ f32x4 v4(ptr p) { return *(const f32x4*)p; }
};

template <bool SAMPLE>
__device__ __forceinline__ void attend_query(const Args& A, LAS unsigned char* wl, const LAS float* biasrel, int m, int lane_in) {
    constexpr int NJ = SAMPLE ? 33 : 32;
    int lane = lane_in; asm volatile("" : "+v"(lane));
    const bf16_t* P = (const bf16_t*)(A.ws + WS_P);
    int b, nvalid, qpos; const float* srow;
    if (!SAMPLE) { b = m >> 11; const int t = m & 2047; nvalid = t + 1; qpos = t; srow = (const float*)(A.ws + WS_CHK_SC) + (size_t)m * SCW; }
    else { const int ms = m - MP; b = ms >> 2; const int t = ms & 3; nvalid = 2049 + t; qpos = 2048 + t; srow = (const float*)(A.ws + WS_SCS) + (size_t)ms * SCSW; }
    LAS float* pq = (LAS float*)wl;
    LAS unsigned* rowid = (LAS unsigned*)(wl + 16384);
    LAS unsigned short* posl = (LAS unsigned short*)(wl + 16384 + 1024);
    unsigned key[NJ];
#pragma unroll
    for (int j = 0; j < NJ; ++j) { key[j] = (lane < nvalid - 64 * j) ? f2key(srow[lane + 64 * j]) : 0u; }
    unsigned T = 0u; int need_eq = 0;
    if (nvalid > 256) {
        for (int bit = 31; bit >= 0; --bit) {
            const unsigned cand = T | (1u << bit); int cnt = 0;
#pragma unroll
            for (int j = 0; j < NJ; ++j) cnt += __popcll(__ballot(key[j] >= cand));
            if (cnt >= 256) T = cand;
        }
        int cgt = 0;
#pragma unroll
        for (int j = 0; j < NJ; ++j) cgt += __popcll(__ballot(key[j] > T));
        need_eq = 256 - cgt;
    }
    int base = 0, eqused = 0; unsigned long long mine_chk = 0ull;
    const int* pt = (const int*)A.in[I_PT];
#pragma unroll
    for (int j = 0; j < NJ; ++j) {
        const bool gt = key[j] > T, eq = (need_eq > 0) && (key[j] == T);
        const unsigned long long meq = __ballot(eq);
        const bool sel = gt || (eq && (eqused + mbcnt64(meq) < need_eq));
        eqused += __popcll(meq);
        const unsigned long long ms = __ballot(sel);
        if (sel) { const int pos = lane + 64 * j, k = base + mbcnt64(ms);
            posl[k] = (unsigned short)pos;
            unsigned rid;
            if (!SAMPLE) rid = (unsigned)(b * 2048 + pos);
            else rid = (pos < 2048) ? (unsigned)(pt[b * 16 + (pos >> 7)] * 128 + (pos & 127)) : (0x80000000u | (unsigned)(b * 4 + pos - 2048));
            rowid[k] = rid; }
        base += __popcll(ms);
        if (!SAMPLE) { if (lane == j) mine_chk = ms; }
    }
    if (!SAMPLE) { if (lane < 32) ((unsigned long long*)(A.ws + WS_CHK_MASK))[(size_t)m * 32 + lane] = mine_chk; }
    const int nsel = base;
    asm volatile("s_waitcnt lgkmcnt(0)" ::: "memory");
    { const unsigned r0 = rowid[0]; const unsigned short p0 = posl[0];
#pragma unroll
      for (int i = 0; i < 4; ++i) { const int k = lane + 64 * i; if (k >= nsel) { rowid[k] = r0; posl[k] = p0; } } }
    { const u32x4 w0 = *(const u32x4*)(P + (size_t)m * NP + PQ + lane * 16), w1 = *(const u32x4*)(P + (size_t)m * NP + PQ + lane * 16 + 8);
      float f0[8], f1[8]; unpack8(w0, f0); unpack8(w1, f1);
#pragma unroll
      for (int e = 0; e < 8; ++e) { pq[lane * 16 + e] = f0[e]; pq[lane * 16 + 8 + e] = f1[e]; } }
    asm volatile("s_waitcnt lgkmcnt(0)" ::: "memory");
    KVRow<SAMPLE> R;
    if constexpr (!SAMPLE) { R.P = P; } else { R.ck = A.in[I_CK]; R.cv = A.in[I_CV]; R.kn = A.out + O_KS; R.vn = A.out + O_VS; }
    typename KVRow<SAMPLE>::ptr kp[4]; int rel[4];
#pragma unroll
    for (int i = 0; i < 4; ++i) { kp[i] = R.krow(rowid[lane + 64 * i]); rel[i] = qpos - (int)posl[lane + 64 * i]; }
    float acc[4][16];
#pragma unroll
    for (int i = 0; i < 4; ++i)
#pragma unroll
        for (int hh = 0; hh < 16; ++hh) acc[i][hh] = 0.f;
#pragma unroll
    for (int g = 0; g < 4; ++g) {
#pragma unroll 1
        for (int dc = 0; dc < 8; ++dc) {
            float kv[4][8];
#pragma unroll
            for (int i = 0; i < 4; ++i) KVRow<SAMPLE>::k8(kp[i] + g * 64 + dc * 8, kv[i]);
#pragma unroll
            for (int hh = 0; hh < 4; ++hh) {
                const f32x4 q0 = *(const LAS f32x4*)(pq + (4 * g + hh) * 64 + dc * 8), q1 = *(const LAS f32x4*)(pq + (4 * g + hh) * 64 + dc * 8 + 4);
#pragma unroll
                for (int i = 0; i < 4; ++i) {
                    float a = acc[i][4 * g + hh];
#pragma unroll
                    for (int e = 0; e < 4; ++e) { a += kv[i][e] * q0[e]; a += kv[i][4 + e] * q1[e]; }
                    acc[i][4 * g + hh] = a; }
            }
        }
    }
    asm volatile("s_waitcnt lgkmcnt(0)" ::: "memory");
#pragma unroll
    for (int i = 0; i < 4; ++i) {
        const bool valid = (lane + 64 * i) < nsel; const int rc = rel[i] < 128 ? (rel[i] < 0 ? 0 : rel[i]) : 128;
#pragma unroll
        for (int h4 = 0; h4 < 4; ++h4) { const f32x4 bv = *(const LAS f32x4*)(biasrel + rc * 16 + 4 * h4);
#pragma unroll
            for (int e = 0; e < 4; ++e) acc[i][4 * h4 + e] = valid ? acc[i][4 * h4 + e] * 0.125f + bv[e] : -INFINITY; }
    }
#pragma unroll
    for (int hh = 0; hh < 16; ++hh) {
        const float mx = wave_max(fmaxf(fmaxf(acc[0][hh], acc[1][hh]), fmaxf(acc[2][hh], acc[3][hh])));
        float s = 0.f;
#pragma unroll
        for (int i = 0; i < 4; ++i) { acc[i][hh] = __expf(acc[i][hh] - mx); s += acc[i][hh]; }
        const float inv = 1.0f / wave_sum(s);
#pragma unroll
        for (int i = 0; i < 4; ++i) acc[i][hh] *= inv;
    }
#pragma unroll
    for (int i = 0; i < 4; ++i)
#pragma unroll
        for (int h4 = 0; h4 < 4; ++h4) *(LAS f32x4*)(pq + (lane + 64 * i) * 16 + 4 * h4) = (f32x4){acc[i][4 * h4], acc[i][4 * h4 + 1], acc[i][4 * h4 + 2], acc[i][4 * h4 + 3]};
    asm volatile("s_waitcnt lgkmcnt(0)" ::: "memory");
    const int g = lane >> 4;
    f32x4 o[4];
#pragma unroll
    for (int hh = 0; hh < 4; ++hh) o[hh] = (f32x4){0.f, 0.f, 0.f, 0.f};
    const int nloop = (nsel + 3) & ~3;
    for (int k0 = 0; k0 < nloop; k0 += 4) {
        f32x4 vv[4], pp[4];
#pragma unroll
        for (int u = 0; u < 4; ++u) { const unsigned r = rowid[k0 + u]; vv[u] = KVRow<SAMPLE>::v4(R.vrow(r) + lane * 4); pp[u] = *(const LAS f32x4*)(pq + (k0 + u) * 16 + 4 * g); }
#pragma unroll
        for (int u = 0; u < 4; ++u)
#pragma unroll
            for (int hh = 0; hh < 4; ++hh) o[hh] += vv[u] * pp[u][hh];
    }
    bf16_t* YA = (bf16_t*)(A.ws + WS_CHK_YA);
#pragma unroll
    for (int hh = 0; hh < 4; ++hh) { u32x2 w; w.x = pk2(o[hh][0], o[hh][1]); w.y = pk2(o[hh][2], o[hh][3]);
        *(u32x2*)(YA + (size_t)m * D + (4 * g + hh) * 64 + (lane & 15) * 4) = w; }
    asm volatile("s_waitcnt lgkmcnt(0)" ::: "memory");
}


__device__ __forceinline__ void check_compare(const Args& A, int gw, int NGW, int lane) {
    const bf16_t* Y1 = (const bf16_t*)(A.ws + WS_YA); const bf16_t* Y2 = (const bf16_t*)(A.ws + WS_CHK_YA); unsigned* ctl = (unsigned*)(A.ws + WS_CTL);
    for (int m = gw; m < MP; m += NGW) {
        float e = 0.f, n = 0.f;
#pragma unroll
        for (int j = 0; j < 2; ++j) { float a[8], b[8]; unpack8(*(const u32x4*)(Y1 + (size_t)m * D + j * 512 + lane * 8), a); unpack8(*(const u32x4*)(Y2 + (size_t)m * D + j * 512 + lane * 8), b);
#pragma unroll
            for (int i = 0; i < 8; ++i) { const float d = a[i] - b[i]; e += d * d; n += b[i] * b[i]; } }
        e = wave_sum(e); n = wave_sum(n);
        { const unsigned long long w1 = (lane < 32) ? ((const unsigned long long*)(A.ws + WS_SC))[(size_t)m * 32 + lane] : 0ull, w2 = (lane < 32) ? ((const unsigned long long*)(A.ws + WS_CHK_MASK))[(size_t)m * 32 + lane] : 0ull;
          if (__any(w1 != w2) && lane == 0) atomicAdd(ctl + CW_CHK + 3, 1u);
          const int t = m & 2047;
          if (t >= 256) {
              const float* srow = (const float*)(A.ws + WS_CHK_SC) + (size_t)m * SCW;
              int c1 = 0, c2 = 0; float mins1 = INFINITY, maxu1 = -INFINITY, mins2 = INFINITY, maxu2 = -INFINITY;
              for (int j = 0; j < 32; ++j) { const int sp = lane + 64 * j; if (64 * j > t) break;
                  const unsigned long long a1 = __shfl((unsigned long long)w1, j), a2 = __shfl((unsigned long long)w2, j);
                  if (sp <= t) { const float v = srow[sp]; const bool s1 = (a1 >> lane) & 1ull, s2 = (a2 >> lane) & 1ull;
                      if (s1) { ++c1; mins1 = fminf(mins1, v); } else maxu1 = fmaxf(maxu1, v);
                      if (s2) { ++c2; mins2 = fminf(mins2, v); } else maxu2 = fmaxf(maxu2, v); } }
              c1 = (int)wave_sum((float)c1); c2 = (int)wave_sum((float)c2);
              mins1 = -wave_max(-mins1); mins2 = -wave_max(-mins2); maxu1 = wave_max(maxu1); maxu2 = wave_max(maxu2);
              if (lane == 0) { if (c1 != 256 || mins1 < maxu1) atomicAdd(ctl + CW_CHK + 4, 1u); if (c2 != 256 || mins2 < maxu2) atomicAdd(ctl + CW_CHK + 5, 1u); }
          } }
        if (lane == 0 && !(e <= MK_CHECK_TOL * MK_CHECK_TOL * n + 1e-12f)) { const int t = m & 2047; atomicAdd(ctl + CW_CHK + (t < 64 ? 0 : t < 256 ? 1 : 2), 1u); }
    }
}
#endif
__device__ __forceinline__ void gate_norm_phase(const Args& A, int gw, int NGW, int lane) {
    const bf16_t* P = (const bf16_t*)(A.ws + WS_P); bf16_t* Y = (bf16_t*)(A.ws + WS_Y); const float* ng = A.in[I_NORMG];
    for (int it = gw; it < M * 4; it += NGW) {
        const int m = it >> 2, ch = (it & 3) * 512 + lane * 8;
        float y[8], z[8]; unpack8(*(const u32x4*)(Y + (size_t)m * DI + ch), y); unpack8(*(const u32x4*)(P + (size_t)m * NP + PZ + ch), z);
        float ss = 0.f;
#pragma unroll
        for (int i = 0; i < 8; ++i) { y[i] *= siluf_(z[i]); ss += y[i] * y[i]; }
        const float r = 1.0f / sqrtf(wave_sum(ss) * (1.f / 512.f) + LN_EPS);
        const f32x4 g0 = *(const f32x4*)(ng + ch), g1 = *(const f32x4*)(ng + ch + 4);
#pragma unroll
        for (int i = 0; i < 4; ++i) { y[i] = y[i] * r * g0[i]; y[4 + i] = y[4 + i] * r * g1[i]; }
        *(u32x4*)(Y + (size_t)m * DI + ch) = pack8(y);
    }
}

constexpr int NPHASE = 14;
__global__ void __launch_bounds__(NTHR, 2) fwd(Args args) {
    extern __shared__ __attribute__((aligned(16))) unsigned char lds_raw[];
    LAS unsigned char* lds = (LAS unsigned char*)lds_raw;
    const int tid = threadIdx.x, lane = tid & 63, wave = __builtin_amdgcn_readfirstlane(tid >> 6);
    const int G = gridDim.x, bx = blockIdx.x;
    const int vcu = (G % 8 == 0) ? (bx % 8) * (G / 8) + bx / 8 : bx;
    const int gw = vcu * NWAVES + wave, NGW = G * NWAVES;
    unsigned char* ws = args.ws;
    volatile LAS unsigned* MISC = (volatile LAS unsigned*)(lds + MISC_OFF);
    for (int u = tid; u < 64; u += NTHR) MISC[u] = 0u;
    __syncthreads();
    const int lo = args.ph_lo, hi = args.ph_hi;
    XcdBarrier bar; bar.bar = (unsigned*)(ws + WS_CTL) + CW_BAR; bar.x = 0; bar.st = nullptr;
    if (hi - lo > 1) bar = xcd_barrier_post((unsigned*)(ws + WS_CTL) + CW_BAR, MISC + 8);
#define IN(k) (lo <= (k) && (k) < hi)
#define SEAM(k) do { if (IN(k) && IN((k) + 1)) xcd_barrier(bar); } while (0)

    bf16_t* const XB = (bf16_t*)(ws + WS_XB); bf16_t* const ACT = (bf16_t*)(ws + WS_ACT); float* const T = (float*)(ws + WS_T);
    float* const HF = (float*)(ws + WS_HF); bf16_t* const HB = (bf16_t*)(ws + WS_HB); bf16_t* const P = (bf16_t*)(ws + WS_P);
    float* const SMF = (float*)(ws + WS_SMF); bf16_t* const Y = (bf16_t*)(ws + WS_Y); bf16_t* const YA = (bf16_t*)(ws + WS_YA); bf16_t* const MG = (bf16_t*)(ws + WS_MG);

    if (IN(0)) REPK(0) { p0_prologue(args, lds, gw, NGW, wave, lane); }
    SEAM(0);
    if (IN(1)) {
        { pg8::Gemm g{XB, (const bf16_t*)(ws + WS_W1A), M, 2 * DFF, D}; pg8::StaticOrder S; S.init(M, 2 * DFF, G, bx);
        EpiSwiglu E{ACT}; pg8::gemm_phase<EpiSwiglu, pg8::StaticOrder, true, true>(lds, g, S, E); }
        if constexpr (DUPK(1)) { pg8::Gemm g{XB, (const bf16_t*)(ws + WS_W1A), M, 2 * DFF, D}; pg8::StaticOrder S; S.init(M, 2 * DFF, G, bx);
        EpiSwiglu E{ACT}; pg8::gemm_phase<EpiSwiglu, pg8::StaticOrder, true, true>(lds, g, S, E); }
    }
    SEAM(1);
    if (IN(2)) {
        { pg8::Gemm g{ACT, (const bf16_t*)(ws + WS_W1B), MP, D, DFF}; pg8::StaticOrder S; S.init(MP, D, G, bx);
        EpiResid E{args.in[I_XP], args.in[I_XS], T, ALPHA, 0.5f}; pg8::gemm_phase<EpiResid, pg8::StaticOrder, true, true>(lds, g, S, E); }
        { SkResid E{args.in[I_XS], T, ALPHA, 0.5f}; skinny_gemm<DFF>(lds, ACT + (size_t)MP * DFF, (const bf16_t*)(ws + WS_W1B), E, bx, G, wave, lane); }
        if constexpr (DUPK(2)) { pg8::Gemm g{ACT, (const bf16_t*)(ws + WS_W1B), MP, D, DFF}; pg8::StaticOrder S; S.init(MP, D, G, bx);
        EpiResid E{args.in[I_XP], args.in[I_XS], T, ALPHA, 0.5f}; pg8::gemm_phase<EpiResid, pg8::StaticOrder, true, true>(lds, g, S, E); }
    }
    SEAM(2);
    if (IN(3)) REPK(3) { ln_phase(T, args.in[I_LN1G], args.in[I_LN1B], HF, HB, gw, NGW, lane); }
    SEAM(3);
    if (IN(4)) {
        { pg8::Gemm g{HB, (const bf16_t*)(ws + WS_WIN), M, NP, D}; pg8::StaticOrder S; S.init(M, NP, G, bx);
        EpiWin E{P, SMF, args.out}; pg8::gemm_phase<EpiWin, pg8::StaticOrder, true, true>(lds, g, S, E); }
        if constexpr (DUPK(4)) { pg8::Gemm g{HB, (const bf16_t*)(ws + WS_WIN), M, NP, D}; pg8::StaticOrder S; S.init(M, NP, G, bx);
        EpiWin E{P, SMF, args.out}; pg8::gemm_phase<EpiWin, pg8::StaticOrder, true, true>(lds, g, S, E); }
    }
    SEAM(4);
    if (IN(5)) REPK(5) {
        for (int rep = 0; rep < MK_REP_CONV; ++rep)
        conv_phase(args, gw, NGW, lane);
        for (int rep = 0; rep < MK_REP_SCP; ++rep)
        for (int u = bx; u < 1024; u += G) { const int i = u >> 8, c = u & 255, b = c >> 5, s = c & 31; const int qt = (i == 0) ? s : (i == 1) ? 63 - s : (i == 2) ? 64 + s : 127 - s;
            scores_select_prompt_unit(args, lds, b, qt, wave, lane); }
        for (int rep = 0; rep < MK_REP_SCS; ++rep)
        for (int u = bx; u < 256; u += G) scores_sample_unit(args, u >> 1, u & 1, wave, lane);
    }
    SEAM(5);
    if (IN(6)) {
        for (int rep = 0; rep < MK_REP_SSDP; ++rep)
        for (int it = bx; it < 256; it += G) ssd_prompt_item(args, lds, it >> 5, it & 31);
        __syncthreads();
        LAS float* biasrel = (LAS float*)(lds + BIASREL_OFF); LAS float* biasL = biasrel + 129 * 16;
        for (int i = tid; i < 129 * 16; i += NTHR) { const int rel = i >> 4, h = i & 15; const float bv = args.in[I_BIAS][t5_bucket(rel) * 16 + h]; biasrel[i] = bv; biasL[i] = bv * LOG2E; }
        __syncthreads();
        for (int rep = 0; rep < MK_REP_ATTP; ++rep)
        for (int u = bx; u < 1024; u += G) { const int i = u >> 8, c = u & 255, bg = c >> 3, s8 = c & 7; const int qt = (i == 0) ? s8 : (i == 1) ? 15 - s8 : (i == 2) ? 16 + s8 : 31 - s8;
            attn_prompt_unit(args, lds, biasL, bg >> 2, bg & 3, qt, wave, lane); }
        __syncthreads();
        LAS unsigned char* wl = lds + wave * WAREA;
        for (int rep = 0; rep < MK_REP_SSDS; ++rep)
        for (int it = gw; it < 4096; it += NGW) ssd_sample_item(args, wl, it >> 5, it & 31, lane);
        for (int rep = 0; rep < MK_REP_ATTS; ++rep)
        for (int q = gw; q < MS * 4; q += NGW) attend_sample_task(args, wl, biasrel, q >> 2, q & 3, lane);
#if MK_CHECK_ATT
        for (int q = gw; q < MP; q += NGW) attend_query<false>(args, wl, biasrel, q, lane);
#endif
        __syncthreads();
    }
    SEAM(6);
    if (IN(7)) {
        gate_norm_phase(args, gw, NGW, lane);
#if MK_CHECK_ATT
        check_compare(args, gw, NGW, lane);
#endif
        { pg8::Gemm g{YA, (const bf16_t*)(ws + WS_WBA), MP, D, D}; pg8::StaticOrder S; S.init(MP, D, G, bx);
        EpiGateA E{P, PG + D, T}; pg8::gemm_phase<EpiGateA, pg8::StaticOrder, true, true>(lds, g, S, E); }
        { SkGateA E{P, PG + D, T}; skinny_gemm<D>(lds, YA + (size_t)MP * D, (const bf16_t*)(ws + WS_WBA), E, bx, G, wave, lane); }
        if constexpr (DUPK(7)) { pg8::Gemm g{YA, (const bf16_t*)(ws + WS_WBA), MP, D, D}; pg8::StaticOrder S; S.init(MP, D, G, bx);
        EpiGateA E{P, PG + D, T}; pg8::gemm_phase<EpiGateA, pg8::StaticOrder, true, true>(lds, g, S, E); }
    }
    SEAM(7);
    if (IN(8)) {
        { pg8::Gemm g{Y, (const bf16_t*)(ws + WS_WBS), MP, D, DI}; pg8::StaticOrder S; S.init(MP, D, G, bx);
        EpiGateS E{P, PG, T, MG}; pg8::gemm_phase<EpiGateS, pg8::StaticOrder, true, true>(lds, g, S, E); }
        { SkGateS E{P, PG, T, MG}; skinny_gemm<DI>(lds, Y + (size_t)MP * DI, (const bf16_t*)(ws + WS_WBS), E, bx, G, wave, lane); }
        if constexpr (DUPK(8)) { pg8::Gemm g{Y, (const bf16_t*)(ws + WS_WBS), MP, D, DI}; pg8::StaticOrder S; S.init(MP, D, G, bx);
        EpiGateS E{P, PG, T, MG}; pg8::gemm_phase<EpiGateS, pg8::StaticOrder, true, true>(lds, g, S, E); }
    }
    SEAM(8);
    if (IN(9)) {
        { pg8::Gemm g{MG, (const bf16_t*)(ws + WS_WOUT), MP, D, D}; pg8::StaticOrder S; S.init(MP, D, G, bx);
        EpiResid E{HF, HF + (size_t)MP * D, T, ALPHA, 1.0f}; pg8::gemm_phase<EpiResid, pg8::StaticOrder, true, true>(lds, g, S, E); }
        { SkResid E{HF + (size_t)MP * D, T, ALPHA, 1.0f}; skinny_gemm<D>(lds, MG + (size_t)MP * D, (const bf16_t*)(ws + WS_WOUT), E, bx, G, wave, lane); }
        if constexpr (DUPK(9)) { pg8::Gemm g{MG, (const bf16_t*)(ws + WS_WOUT), MP, D, D}; pg8::StaticOrder S; S.init(MP, D, G, bx);
        EpiResid E{HF, HF + (size_t)MP * D, T, ALPHA, 1.0f}; pg8::gemm_phase<EpiResid, pg8::StaticOrder, true, true>(lds, g, S, E); }
    }
    SEAM(9);
    if (IN(10)) REPK(10) { ln_phase(T, args.in[I_LN2G], args.in[I_LN2B], HF, HB, gw, NGW, lane); }
    SEAM(10);
    if (IN(11)) {
        { pg8::Gemm g{HB, (const bf16_t*)(ws + WS_W2A), M, 2 * DFF, D}; pg8::StaticOrder S; S.init(M, 2 * DFF, G, bx);
        EpiSwiglu E{ACT}; pg8::gemm_phase<EpiSwiglu, pg8::StaticOrder, true, true>(lds, g, S, E); }
        if constexpr (DUPK(11)) { pg8::Gemm g{HB, (const bf16_t*)(ws + WS_W2A), M, 2 * DFF, D}; pg8::StaticOrder S; S.init(M, 2 * DFF, G, bx);
        EpiSwiglu E{ACT}; pg8::gemm_phase<EpiSwiglu, pg8::StaticOrder, true, true>(lds, g, S, E); }
    }
    SEAM(11);
    if (IN(12)) {
        { pg8::Gemm g{ACT, (const bf16_t*)(ws + WS_W2B), MP, D, DFF}; pg8::StaticOrder S; S.init(MP, D, G, bx);
        EpiResid E{HF, HF + (size_t)MP * D, T, ALPHA, 0.5f}; pg8::gemm_phase<EpiResid, pg8::StaticOrder, true, true>(lds, g, S, E); }
        { SkResid E{HF + (size_t)MP * D, T, ALPHA, 0.5f}; skinny_gemm<DFF>(lds, ACT + (size_t)MP * DFF, (const bf16_t*)(ws + WS_W2B), E, bx, G, wave, lane); }
        if constexpr (DUPK(12)) { pg8::Gemm g{ACT, (const bf16_t*)(ws + WS_W2B), MP, D, DFF}; pg8::StaticOrder S; S.init(MP, D, G, bx);
        EpiResid E{HF, HF + (size_t)MP * D, T, ALPHA, 0.5f}; pg8::gemm_phase<EpiResid, pg8::StaticOrder, true, true>(lds, g, S, E); }
    }
    SEAM(12);
    if (IN(13)) REPK(13) { ln_phase(T, args.in[I_LN3G], args.in[I_LN3B], args.out + O_Y, nullptr, gw, NGW, lane); }
#if MK_CHECK_ATT
    if (IN(13)) { __syncthreads(); unsigned* cw = (unsigned*)(ws + WS_CTL) + CW_CHK;
        const unsigned b0 = __hip_atomic_load(cw, __ATOMIC_RELAXED, __HIP_MEMORY_SCOPE_AGENT), b1 = __hip_atomic_load(cw + 1, __ATOMIC_RELAXED, __HIP_MEMORY_SCOPE_AGENT), b2 = __hip_atomic_load(cw + 2, __ATOMIC_RELAXED, __HIP_MEMORY_SCOPE_AGENT), b3 = __hip_atomic_load(cw + 3, __ATOMIC_RELAXED, __HIP_MEMORY_SCOPE_AGENT), b4 = __hip_atomic_load(cw + 4, __ATOMIC_RELAXED, __HIP_MEMORY_SCOPE_AGENT), b5 = __hip_atomic_load(cw + 5, __ATOMIC_RELAXED, __HIP_MEMORY_SCOPE_AGENT);
        const float code = MK_CHECK_CODE;
        if (code > 0.f && bx == 0 && tid == 0) args.out[O_Y] = 4096.0f * sqrtf(code); }
#endif
#undef IN
#undef SEAM
}
}

extern "C" void kernel_launch(void* const* d_in, const int* in_sizes, int n_in, void* d_out, int out_size, void* d_ws, size_t ws_size, hipStream_t stream) {
    using namespace mk;
    static int grid = 0;
    if (grid == 0) {
        if (n_in != 29 || (size_t)out_size != O_END || ws_size < WS_END) { fprintf(stderr, "kernel_launch: unexpected shapes (n_in %d, out %d, ws %zu)\n", n_in, out_size, ws_size); grid = -1; return; }
        int dev = 0, cus = 0, per_cu = 0;
        if (hipGetDevice(&dev) != hipSuccess || hipDeviceGetAttribute(&cus, hipDeviceAttributeMultiprocessorCount, dev) != hipSuccess) { grid = -1; return; }
        if (hipFuncSetAttribute((const void*)fwd, hipFuncAttributeMaxDynamicSharedMemorySize, LDS_BYTES) != hipSuccess) { fprintf(stderr, "kernel_launch: hipFuncSetAttribute failed\n"); grid = -1; return; }
        if (hipOccupancyMaxActiveBlocksPerMultiprocessor(&per_cu, (const void*)fwd, NTHR, LDS_BYTES) != hipSuccess || per_cu < 1) fprintf(stderr, "kernel_launch: occupancy query says %d\n", per_cu);
        (void)hipGetLastError();
        grid = cus;
    }
    if (grid < 0) return;
    (void)hipMemsetAsync((char*)d_ws + WS_CTL, 0, CTL_ZERO_BYTES, stream);
    Args a{};
    for (int i = 0; i < 29; ++i) a.in[i] = (const float*)d_in[i];
    a.out = (float*)d_out; a.ws = (unsigned char*)d_ws;
#if MK_SPLIT
    for (int p = 0; p < NPHASE; ++p) { a.ph_lo = p; a.ph_hi = p + 1; hipLaunchKernelGGL(fwd, dim3(grid), dim3(NTHR), LDS_BYTES, stream, a); }
#else
    a.ph_lo = 0; a.ph_hi = NPHASE; hipLaunchKernelGGL(fwd, dim3(grid), dim3(NTHR), LDS_BYTES, stream, a);
#endif
}
```

```cpp
#include <hip/hip_runtime.h>
#include <cstdio>
#include <cstdint>
#define GAS __attribute__((address_space(1)))
#define LAS __attribute__((address_space(3)))
namespace pg8 {
#define PG8_LAS __attribute__((address_space(3)))
typedef unsigned short bf16_t;
typedef short bf16x8 __attribute__((ext_vector_type(8)));
typedef float f32x4 __attribute__((ext_vector_type(4)));
typedef unsigned u32x4 __attribute__((ext_vector_type(4)));
constexpr int BM = 256, BK = 64, HALF = 128, HTB = HALF * BK * 2  , STAGE_BYTES = 8 * HTB, NXCD = 8, WGM = 8;

__host__ __device__ __forceinline__ int lds_byte(int r, int c) { const int st = (r >> 4) * 2 + (c >> 5), rr = r & 15, cc = c & 31, ob = rr * 64 + cc * 2; return st * 1024 + (ob ^ (((ob >> 9) & 1) << 5)); }
__host__ __device__ __forceinline__ void stage_rc(int b, int& R, int& C) { const int st = b / 1024, sb = b % 1024, swz = sb ^ (((sb >> 9) & 1) << 5); R = (st >> 1) * 16 + swz / 64; C = (st & 1) * 32 + (swz % 64) / 2; }
__host__ __device__ __forceinline__ int perm32(int rho) { const int n = rho >> 4, i = rho & 15; return 8 * (i >> 2) + 4 * n + (i & 3); }

struct Unit { int pm, pn; };
struct Gemm { const bf16_t* A; const bf16_t* Bt; int M, N, K; };

struct StaticOrder {
    int nM, nN, nwg, G, c;
    __host__ __device__ void init(int M, int N, int G_, int c_) { nM = M / BM; nN = N / BM; nwg = nM * nN; G = G_; c = c_; }
    __host__ __device__ bool next(int i, Unit& u) const {
        const long L = (long)i * G + c; if (L >= nwg) return false;
        int wgid = (int)L; { const int q = nwg / NXCD, r = nwg % NXCD, xcd = wgid % NXCD, off = wgid / NXCD; wgid = (xcd < r ? xcd * (q + 1) : r * (q + 1) + (xcd - r) * q) + off; }
        const int nig = WGM * nN, gid = wgid / nig, fm = gid * WGM, gsz = (nM - fm) < WGM ? (nM - fm) : WGM;
        u.pm = fm + ((wgid % nig) % gsz); u.pn = (wgid % nig) / gsz; return true;
    }
    __device__ __forceinline__ void a_ready(const Unit&) const {}
    __device__ __forceinline__ void done(const Unit&) const {}
};

__device__ __forceinline__ unsigned cvt_pk_bf16(float lo, float hi) { unsigned r; asm volatile("v_cvt_pk_bf16_f32 %0, %1, %2" : "=v"(r) : "v"(lo), "v"(hi)); return r; }

template <class Epi, class Sched, bool ALIGN_EPI = false, bool SP2 = false>
__device__ __forceinline__ void gemm_phase(PG8_LAS unsigned char* lds, const Gemm g, const Sched& S, const Epi& E) {
    const int tid = threadIdx.x, wid = __builtin_amdgcn_readfirstlane(tid >> 6), lane = tid & 63, wr = wid >> 2, wc = wid & 3, fr = lane & 15, fq = lane >> 4;
    const int K = g.K, nt = K / BK;
    unsigned voffA[2], voffB[2];
#pragma unroll
    for (int i = 0; i < 2; ++i) { int R, C; stage_rc(tid * 16 + i * 8192, R, C); const int Rb = Epi::PERM ? ((R & ~31) + perm32(R & 31)) : R;
        voffA[i] = (unsigned)(R * K + C) * 2u; voffB[i] = (unsigned)(Rb * K + C) * 2u; }
    const size_t kstep = (size_t)(BK * 2);
    const size_t hstep = (size_t)HALF * K * 2;
    const size_t tstep = 2 * hstep;
    const unsigned ldsw = (unsigned)wid * 1024u;
    const int aoff = lds_byte(wr * 64 + fr, fq * 8), boff = lds_byte(wc * 32 + fr, fq * 8);
#define PG8_SA(b, h) (((b) * 2 + (h)) * HTB)
#define PG8_SB(b, h) ((4 + (b) * 2 + (h)) * HTB)
#define PG8_STAGE(bufoff, gbase, voff) do { _Pragma("unroll") for (int _i = 0; _i < 2; ++_i) \
        __builtin_amdgcn_global_load_lds((const unsigned*)((const char*)(gbase) + (voff)[_i]), (PG8_LAS unsigned*)(lds + (bufoff) + ldsw + _i * 8192), 16, 0, 0); } while (0)
#define PG8_LDA(dst, b, h) do { _Pragma("unroll") for (int m = 0; m < 4; ++m) _Pragma("unroll") for (int k = 0; k < 2; ++k) dst[m][k] = *(const PG8_LAS bf16x8*)(lds + PG8_SA(b, h) + aoff + m * 2048 + k * 1024); } while (0)
#define PG8_LDB(dst, b, h) do { _Pragma("unroll") for (int n = 0; n < 2; ++n) _Pragma("unroll") for (int k = 0; k < 2; ++k) dst[n][k] = *(const PG8_LAS bf16x8*)(lds + PG8_SB(b, h) + boff + n * 2048 + k * 1024); } while (0)
#define PG8_MMA(ai, bj, At, Bt) do { __builtin_amdgcn_s_setprio(1); _Pragma("unroll") for (int m = 0; m < 4; ++m) _Pragma("unroll") for (int n = 0; n < 2; ++n) _Pragma("unroll") for (int k = 0; k < 2; ++k) \
        acc[ai][bj][m][n] = __builtin_amdgcn_mfma_f32_16x16x32_bf16(Bt[n][k], At[m][k], acc[ai][bj][m][n], 0, 0, 0); __builtin_amdgcn_s_setprio(0); } while (0)
#define PG8_WAIT_V(n) asm volatile("s_waitcnt vmcnt(" #n ")" ::: "memory")
#define PG8_WAIT_L(n) asm volatile("s_waitcnt lgkmcnt(" #n ")" ::: "memory")
#define PG8_BAR __builtin_amdgcn_s_barrier()
#define PG8_SCHED __builtin_amdgcn_sched_barrier(0)
    Unit cur, nxt; int ui = 0;
    if (!S.next(0, cur)) return;
    f32x4 acc[2][2][4][2];
#pragma unroll
    for (int a = 0; a < 2; ++a)
#pragma unroll
        for (int b = 0; b < 2; ++b)
#pragma unroll
            for (int m = 0; m < 4; ++m)
#pragma unroll
                for (int n = 0; n < 2; ++n) acc[a][b][m][n] = (f32x4){0.f, 0.f, 0.f, 0.f};
    bf16x8 At[4][2], B0[2][2], B1[2][2];
    const char* cA = (const char*)g.A + (size_t)cur.pm * tstep; const char* cB = (const char*)g.Bt + (size_t)cur.pn * tstep;
    S.a_ready(cur);
    if constexpr (SP2) {
        PG8_STAGE(PG8_SB(0, 0), cB, voffB); PG8_STAGE(PG8_SB(0, 1), cB + hstep, voffB); PG8_STAGE(PG8_SA(0, 0), cA, voffA); PG8_STAGE(PG8_SA(0, 1), cA + hstep, voffA);
        if (wr == 1) PG8_BAR;
        PG8_WAIT_V(2); PG8_BAR;
        PG8_STAGE(PG8_SB(1, 0), cB + kstep, voffB); PG8_STAGE(PG8_SA(1, 0), cA + kstep, voffA); PG8_STAGE(PG8_SB(1, 1), cB + hstep + kstep, voffB);
        PG8_WAIT_V(6); PG8_BAR;
    } else {
        PG8_STAGE(PG8_SB(0, 0), cB, voffB); PG8_STAGE(PG8_SA(0, 0), cA, voffA); PG8_STAGE(PG8_SB(0, 1), cB + hstep, voffB); PG8_STAGE(PG8_SA(0, 1), cA + hstep, voffA);
        if (wr == 1) PG8_BAR;
        PG8_WAIT_V(4); PG8_BAR;
        PG8_STAGE(PG8_SB(1, 0), cB + kstep, voffB); PG8_STAGE(PG8_SA(1, 0), cA + kstep, voffA); PG8_STAGE(PG8_SB(1, 1), cB + hstep + kstep, voffB);
        PG8_WAIT_V(6); PG8_BAR;
    }
    for (;;) {
        const bool has_next = S.next(ui + 1, nxt);
        const char* nA = has_next ? (const char*)g.A + (size_t)nxt.pm * tstep : cA; const char* nB = has_next ? (const char*)g.Bt + (size_t)nxt.pn * tstep : cB;
        for (int t = 0; t < nt; t += 2) {
            const bool last = (t == nt - 2);
            const char* a1 = cA + (size_t)(t + 1) * kstep;
            const char* a2 = last ? nA : cA + (size_t)(t + 2) * kstep; const char* b2 = last ? nB : cB + (size_t)(t + 2) * kstep;
            const char* a3 = a2 + kstep; const char* b3 = b2 + kstep;
            if (last && has_next) S.a_ready(nxt);
            if constexpr (SP2) {
            PG8_LDB(B0, 0, 0); PG8_LDB(B1, 0, 1); PG8_SCHED; PG8_LDA(At, 0, 0); PG8_STAGE(PG8_SA(1, 1), a1 + hstep, voffA);
            PG8_WAIT_V(8); PG8_WAIT_L(0); PG8_BAR; PG8_MMA(0, 0, At, B0); PG8_MMA(0, 1, At, B1); PG8_BAR; PG8_SCHED;
            PG8_LDA(At, 0, 1); PG8_STAGE(PG8_SB(0, 0), b2, voffB); PG8_STAGE(PG8_SB(0, 1), b2 + hstep, voffB); PG8_STAGE(PG8_SA(0, 0), a2, voffA);
            PG8_WAIT_V(8); PG8_WAIT_L(0); PG8_BAR; PG8_MMA(1, 0, At, B0); PG8_MMA(1, 1, At, B1); PG8_BAR; PG8_SCHED;
            PG8_LDB(B0, 1, 0); PG8_LDB(B1, 1, 1); PG8_SCHED; PG8_LDA(At, 1, 0); PG8_STAGE(PG8_SA(0, 1), a2 + hstep, voffA);
            PG8_WAIT_V(8); PG8_WAIT_L(0); PG8_BAR; PG8_MMA(0, 0, At, B0); PG8_MMA(0, 1, At, B1); PG8_BAR; PG8_SCHED;
            PG8_LDA(At, 1, 1); PG8_STAGE(PG8_SB(1, 0), b3, voffB); PG8_STAGE(PG8_SB(1, 1), b3 + hstep, voffB); PG8_STAGE(PG8_SA(1, 0), a3, voffA);
            PG8_WAIT_V(8); PG8_WAIT_L(0); PG8_BAR; PG8_MMA(1, 0, At, B0); PG8_MMA(1, 1, At, B1); PG8_BAR; PG8_SCHED;
            } else {
            PG8_LDB(B0, 0, 0); PG8_SCHED; PG8_LDA(At, 0, 0); PG8_STAGE(PG8_SA(1, 1), a1 + hstep, voffA);
            PG8_WAIT_L(8); PG8_BAR; PG8_WAIT_L(0); PG8_MMA(0, 0, At, B0); PG8_BAR; PG8_SCHED;
            PG8_LDB(B1, 0, 1); PG8_STAGE(PG8_SB(0, 0), b2, voffB);
            PG8_BAR; PG8_WAIT_L(0); PG8_MMA(0, 1, At, B1); PG8_BAR;
            PG8_LDA(At, 0, 1); PG8_STAGE(PG8_SA(0, 0), a2, voffA);
            PG8_BAR; PG8_WAIT_L(0); PG8_MMA(1, 0, At, B0); PG8_BAR; PG8_SCHED;
            PG8_STAGE(PG8_SB(0, 1), b2 + hstep, voffB);
            PG8_WAIT_V(6); PG8_BAR; PG8_MMA(1, 1, At, B1); PG8_BAR;
            PG8_LDB(B0, 1, 0); PG8_SCHED; PG8_LDA(At, 1, 0); PG8_STAGE(PG8_SA(0, 1), a2 + hstep, voffA);
            PG8_WAIT_L(8); PG8_BAR; PG8_WAIT_L(0); PG8_MMA(0, 0, At, B0); PG8_BAR; PG8_SCHED;
            PG8_LDB(B1, 1, 1); PG8_STAGE(PG8_SB(1, 0), b3, voffB);
            PG8_BAR; PG8_WAIT_L(0); PG8_MMA(0, 1, At, B1); PG8_BAR;
            PG8_LDA(At, 1, 1); PG8_STAGE(PG8_SA(1, 0), a3, voffA);
            PG8_BAR; PG8_WAIT_L(0); PG8_MMA(1, 0, At, B0); PG8_BAR; PG8_SCHED;
            PG8_STAGE(PG8_SB(1, 1), b3 + hstep, voffB);
            PG8_WAIT_V(6); PG8_BAR; PG8_MMA(1, 1, At, B1); PG8_BAR;
            }
        }
        if constexpr (ALIGN_EPI) { if (wr == 0) PG8_BAR; }
        if constexpr (!Epi::AFTER_DRAIN) { E(acc, cur, wr, wc, fr, fq); S.done(cur); }
        if (!has_next) break;
#pragma unroll
        for (int a = 0; a < 2; ++a)
#pragma unroll
            for (int b = 0; b < 2; ++b)
#pragma unroll
                for (int m = 0; m < 4; ++m)
#pragma unroll
                    for (int n = 0; n < 2; ++n) acc[a][b][m][n] = (f32x4){0.f, 0.f, 0.f, 0.f};
        cur = nxt; cA = nA; cB = nB; ++ui;
        if constexpr (ALIGN_EPI) { if (wr == 1) PG8_BAR; }
    }
    PG8_WAIT_V(0);
    if constexpr (!ALIGN_EPI) { if (wr == 0) PG8_BAR; }
    PG8_BAR;
    if constexpr (Epi::AFTER_DRAIN) { E.fused(acc, cur, wr, wc, fr, fq, lds, wid, lane); S.done(cur); }
#undef PG8_SA
#undef PG8_SB
#undef PG8_STAGE
#undef PG8_LDA
#undef PG8_LDB
#undef PG8_MMA
#undef PG8_WAIT_V
#undef PG8_WAIT_L
#undef PG8_BAR
#undef PG8_SCHED
}
}
#define XB_TMO      128
#define XB_XCNT(j)  (256  + 64 * (j))
#define XB_XSUB(j)  (1280 + 64 * (j))
#define XB_XGEN(j)  (2304 + 64 * (j))
#define XB_TOP      3328
#define XB_TOPGEN   3392
#define XCD_BAR_WORDS 3456
#define XB_SPIN_CAP (1u << 18)

__device__ __forceinline__ unsigned xb_ld(unsigned* p)              { return __hip_atomic_load(p, __ATOMIC_RELAXED, __HIP_MEMORY_SCOPE_AGENT); }
__device__ __forceinline__ unsigned xb_add(unsigned* p, unsigned v) { return __hip_atomic_fetch_add(p, v, __ATOMIC_RELAXED, __HIP_MEMORY_SCOPE_AGENT); }
__device__ __forceinline__ unsigned xb_xcc_id() { return (unsigned)__builtin_amdgcn_s_getreg((3 << 11) | 20) & 0xFu; }
#define XB_SPIN(cond, bar) do { unsigned _sp = 0; while (cond) { __builtin_amdgcn_s_sleep(1); \
    if ((++_sp & 255u) == 0u) { if (xb_ld(&(bar)[XB_TMO])) break; if (_sp > XB_SPIN_CAP) { atomicAdd(&(bar)[XB_TMO], 1u); break; } } } } while (0)

struct XcdBarrier {
    unsigned* bar; unsigned x;
    volatile LAS unsigned* st;
};

__device__ __forceinline__ XcdBarrier xcd_barrier_post(unsigned* bar, volatile LAS unsigned* st) {
    XcdBarrier b; b.bar = bar; b.x = xb_xcc_id(); b.st = st;
    if (threadIdx.x == 0) (void)xb_add(&bar[XB_XCNT(b.x)], 1u);
    return b;
}
__device__ __forceinline__ void xcd_barrier_complete(unsigned* bar, unsigned x, unsigned& nloc, unsigned& nx) {
    const unsigned G = gridDim.x * gridDim.y * gridDim.z;
    unsigned sum, cnt, mine, sp = 0u;
    for (;;) {
        sum = 0u; cnt = 0u; mine = 0u;
#pragma unroll
        for (unsigned j = 0; j < 16; ++j) { const unsigned c = xb_ld(&bar[XB_XCNT(j)]); sum += c; cnt += (c > 0u) ? 1u : 0u; mine = (j == x) ? c : mine; }
        if (sum == G) break;
        __builtin_amdgcn_s_sleep(1);
        if ((++sp & 255u) == 0u) { if (xb_ld(&bar[XB_TMO])) break; if (sp > XB_SPIN_CAP) { atomicAdd(&bar[XB_TMO], 1u); break; } }
    }
    nloc = mine > 0u ? mine : 1u; nx = cnt > 0u ? cnt : 1u;
}

__device__ __forceinline__ void xcd_barrier(const XcdBarrier& b) {
    asm volatile("s_waitcnt vmcnt(0)" ::: "memory");
    __syncthreads();
    if (threadIdx.x == 0) {
        unsigned* bar = b.bar;
        __builtin_amdgcn_s_waitcnt(0);
        unsigned nloc = b.st[0], nx = b.st[1];
        if (nloc == 0u) { xcd_barrier_complete(bar, b.x, nloc, nx); b.st[0] = nloc; b.st[1] = nx; }
        const unsigned old = xb_add(&bar[XB_XSUB(b.x)], 1u);
        const unsigned gen = old / nloc;
        if (old + 1u == (gen + 1u) * nloc) {
            __builtin_amdgcn_fence(__ATOMIC_RELEASE, "agent");
            asm volatile("s_waitcnt vmcnt(0)" ::: "memory");
            const unsigned og = xb_add(&bar[XB_TOP], 1u);
            const unsigned tg = og / nx;
            if (og + 1u == (tg + 1u) * nx) xb_add(&bar[XB_TOPGEN], 1u);
            else XB_SPIN(xb_ld(&bar[XB_TOPGEN]) == tg, bar);
            __builtin_amdgcn_fence(__ATOMIC_ACQUIRE, "agent");
            xb_add(&bar[XB_XGEN(b.x)], 1u);
            asm volatile("s_waitcnt vmcnt(0)" ::: "memory");
        } else {
            XB_SPIN(xb_ld(&bar[XB_XGEN(b.x)]) == gen, bar);
            __builtin_amdgcn_fence(__ATOMIC_ACQUIRE, "agent");
            asm volatile("s_waitcnt vmcnt(0)" ::: "memory");
        }
    }
    __syncthreads();
}
namespace mk {
using pg8::bf16_t; using pg8::bf16x8; using pg8::f32x4; using pg8::u32x4;
typedef unsigned u32x2 __attribute__((ext_vector_type(2)));

#ifndef MK_CHECK_ATT
#define MK_CHECK_ATT 0
#endif
#define MK_REP_SSDP 1
#define MK_REP_CONV 1
#define MK_REP_SCP 1
#define MK_REP_SCS 1
#define MK_REP_SSDS 1
#define MK_REP_ATTS 1
#define MK_REP_ATTP 1
#define MK_CHECK_TOL 0.02f
#define MK_CHECK_CODE ((b0 ? 1.f : 0.f) + (b1 ? 2.f : 0.f) + (b2 ? 4.f : 0.f) + (b3 ? 8.f : 0.f) + (b4 ? 16.f : 0.f) + (b5 ? 32.f : 0.f))
#define MK_REP_MASK 0
#define DUPK(k) (((MK_REP_MASK >> (k)) & 1) != 0)
#define REPK(k) for (int rep_ = 0; rep_ < 1 + ((MK_REP_MASK >> (k)) & 1); ++rep_)
#ifndef MK_SPLIT
#define MK_SPLIT 0
#endif

constexpr int NWAVES = 8, NTHR = 512;
constexpr int MP = 16384, MS = 512, M = MP + MS, D = 1024, DFF = 2816, DI = 2048, NP = 9472, XCW = 3072;
constexpr int PZ = 0, PXBC = 2048, PSM = 5120, PQ = 5376, PK = 6400, PV = 6656, PQI = 6912, PG = 7424;
constexpr int SCW = 2048, SCSW = 2112;
constexpr size_t O_Y = 0, O_KP = 17301504, O_VP = 21495808, O_KIP = 25690112, O_CVP = 26738688, O_SSP = 26812416,
                 O_KS = 28909568, O_VS = 29040640, O_KIS = 29171712, O_CVS = 29204480, O_SSS = 30384128, O_END = 63938560;
constexpr size_t MiB = 1u << 20;
constexpr size_t WS_CTL = 0, CTL_ZERO_BYTES = 1 * MiB;
constexpr size_t WS_W1A = 1 * MiB, WS_W1B = WS_W1A + 11 * MiB, WS_WIN = WS_W1B + 6 * MiB, WS_WBS = WS_WIN + 19 * MiB, WS_WBA = WS_WBS + 4 * MiB,
                 WS_WOUT = WS_WBA + 2 * MiB, WS_W2A = WS_WOUT + 2 * MiB, WS_W2B = WS_W2A + 11 * MiB;
constexpr size_t WS_XB = WS_W2B + 6 * MiB, WS_ACT = WS_XB + 33 * MiB, WS_T = WS_ACT + 91 * MiB, WS_HF = WS_T + 66 * MiB, WS_HB = WS_HF + 66 * MiB,
                 WS_P = WS_HB + 33 * MiB, WS_SMF = WS_P + 306 * MiB, WS_XC = WS_SMF + 9 * MiB, WS_Y = WS_XC + 99 * MiB, WS_SC = WS_Y + 66 * MiB,
                 WS_SCS = WS_SC + 128 * MiB, WS_YA = WS_SCS + 5 * MiB, WS_MG = WS_YA + 33 * MiB, WS_END = WS_MG + 33 * MiB;
constexpr int CW_BAR = 4096;
constexpr int LDS_BYTES = 163840, MISC_OFF = LDS_BYTES - 256;
constexpr int WAREA = 17920;
constexpr int BIASREL_OFF = NWAVES * WAREA;
static_assert(BIASREL_OFF + 2 * 129 * 16 * 4 <= MISC_OFF, "LDS map");

constexpr float ALPHA = 1.18920711500272f;
constexpr float LN_EPS = 1e-5f;

struct Args { const float* in[29]; float* out; unsigned char* ws; int ph_lo, ph_hi; };
enum { I_XP = 0, I_XS, I_CK, I_CV, I_CKI, I_SCONV, I_SSSM, I_PT, I_BIAS, I_WIN, I_CONVW, I_CONVB, I_DTB, I_ALOG, I_DSKIP, I_NORMG, I_WBS, I_WBA, I_WOUT,
       I_F1WI, I_F1WO, I_F2WI, I_F2WO, I_LN1G, I_LN1B, I_LN2G, I_LN2B, I_LN3G, I_LN3B };

__device__ __forceinline__ float bf2f(unsigned v) { return __uint_as_float(v << 16); }
__device__ __forceinline__ unsigned f2bf(float f) { unsigned u = __float_as_uint(f); return (u + 0x7fffu + ((u >> 16) & 1u)) >> 16; }
__device__ __forceinline__ unsigned pk2(float lo, float hi) { return pg8::cvt_pk_bf16(lo, hi); }
__device__ __forceinline__ void unpack8(const u32x4 w, float (&f)[8]) {
#pragma unroll
    for (int i = 0; i < 4; ++i) { f[2 * i] = __uint_as_float(w[i] << 16); f[2 * i + 1] = __uint_as_float(w[i] & 0xffff0000u); }
}
__device__ __forceinline__ u32x4 pack8(const float (&f)[8]) { u32x4 w; w.x = pk2(f[0], f[1]); w.y = pk2(f[2], f[3]); w.z = pk2(f[4], f[5]); w.w = pk2(f[6], f[7]); return w; }
__device__ __forceinline__ float sigmoidf_(float x) { return 1.0f / (1.0f + __expf(-x)); }
__device__ __forceinline__ float siluf_(float x) { return x / (1.0f + __expf(-x)); }
__device__ __forceinline__ float wave_sum(float v) {
#pragma unroll
    for (int o = 1; o < 64; o <<= 1) v += __shfl_xor(v, o);
    return v;
}
__device__ __forceinline__ float wave_max(float v) {
#pragma unroll
    for (int o = 1; o < 64; o <<= 1) v = fmaxf(v, __shfl_xor(v, o));
    return v;
}
__device__ __forceinline__ f32x4 mfma16(bf16x8 a, bf16x8 b, f32x4 c) { return __builtin_amdgcn_mfma_f32_16x16x32_bf16(a, b, c, 0, 0, 0); }
__device__ __forceinline__ int mbcnt64(unsigned long long m) { return (int)__builtin_amdgcn_mbcnt_hi((unsigned)(m >> 32), __builtin_amdgcn_mbcnt_lo((unsigned)m, 0u)); }

struct EpiSwiglu {
    static constexpr bool PERM = true, AFTER_DRAIN = false;
    bf16_t* O;
    __device__ __forceinline__ void operator()(const f32x4 (&acc)[2][2][4][2], const pg8::Unit& u, int wr, int wc, int fr, int fq) const {
        const int row0 = u.pm * 256 + wr * 64 + fr, col0 = u.pn * 128 + wc * 32 + 8 * fq;
#pragma unroll
        for (int ai = 0; ai < 2; ++ai)
#pragma unroll
            for (int m = 0; m < 4; ++m) {
                float o[8];
#pragma unroll
                for (int n = 0; n < 2; ++n)
#pragma unroll
                    for (int j = 0; j < 4; ++j) { const float g = acc[ai][0][m][n][j], up = acc[ai][1][m][n][j]; o[4 * n + j] = siluf_(g) * up; }
                *(u32x4*)(O + (size_t)(row0 + ai * 128 + m * 16) * DFF + col0) = pack8(o);
            }
    }
};
struct EpiResid {
    static constexpr bool PERM = false, AFTER_DRAIN = false;
    const float* base_p; const float* base_s; float* T; float alpha, s;
    __device__ __forceinline__ void operator()(const f32x4 (&acc)[2][2][4][2], const pg8::Unit& u, int wr, int wc, int fr, int fq) const {
        const int row0 = u.pm * 256 + wr * 64 + fr, col0 = u.pn * 256 + wc * 32 + 4 * fq;
#pragma unroll
        for (int ai = 0; ai < 2; ++ai)
#pragma unroll
            for (int m = 0; m < 4; ++m) {
                const int r = row0 + ai * 128 + m * 16;
                const float* b = (r < MP) ? base_p + (size_t)r * D : base_s + (size_t)(r - MP) * D;
#pragma unroll
                for (int bj = 0; bj < 2; ++bj)
#pragma unroll
                    for (int n = 0; n < 2; ++n) { const int c = col0 + bj * 128 + n * 16; const f32x4 bv = *(const f32x4*)(b + c);
                        *(f32x4*)(T + (size_t)r * D + c) = bv * alpha + acc[ai][bj][m][n] * s; }
            }
    }
};
struct EpiWin {
    static constexpr bool PERM = true, AFTER_DRAIN = false;
    bf16_t* P; float* smf; float* out;
    __device__ __forceinline__ void operator()(const f32x4 (&acc)[2][2][4][2], const pg8::Unit& u, int wr, int wc, int fr, int fq) const {
        const int row0 = u.pm * 256 + wr * 64 + fr, cl = wc * 32 + 8 * fq, col0 = u.pn * 256 + cl;
#pragma unroll
        for (int ai = 0; ai < 2; ++ai)
#pragma unroll
            for (int m = 0; m < 4; ++m) {
                const int r = row0 + ai * 128 + m * 16;
#pragma unroll
                for (int bj = 0; bj < 2; ++bj) {
                    const f32x4 v0 = acc[ai][bj][m][0], v1 = acc[ai][bj][m][1];
                    u32x4 w; w.x = pk2(v0[0], v0[1]); w.y = pk2(v0[2], v0[3]); w.z = pk2(v1[0], v1[1]); w.w = pk2(v1[2], v1[3]);
                    *(u32x4*)(P + (size_t)r * NP + col0 + bj * 128) = w;
                    if (u.pn == 20) {
                        if (bj == 0) {
                            float* d = smf + (size_t)r * 128 + cl; *(f32x4*)d = v0; *(f32x4*)(d + 4) = v1;
                            if (cl >= 64) { float* k = out + ((r < MP) ? O_KIP + (size_t)r * 64 : O_KIS + (size_t)(r - MP) * 64) + (cl - 64); *(f32x4*)k = v0; *(f32x4*)(k + 4) = v1; }
                        }
                    } else if (u.pn == 25) {
                        float* k = out + ((r < MP) ? O_KP + (size_t)r * 256 : O_KS + (size_t)(r - MP) * 256) + bj * 128 + cl; *(f32x4*)k = v0; *(f32x4*)(k + 4) = v1;
                    } else if (u.pn == 26) {
                        float* k = out + ((r < MP) ? O_VP + (size_t)r * 256 : O_VS + (size_t)(r - MP) * 256) + bj * 128 + cl; *(f32x4*)k = v0; *(f32x4*)(k + 4) = v1;
                    }
                }
            }
    }
};
struct EpiGateA {
    static constexpr bool PERM = false, AFTER_DRAIN = false;
    const bf16_t* P; int gcol; float* M1;
    __device__ __forceinline__ void operator()(const f32x4 (&acc)[2][2][4][2], const pg8::Unit& u, int wr, int wc, int fr, int fq) const {
        const int row0 = u.pm * 256 + wr * 64 + fr, col0 = u.pn * 256 + wc * 32 + 4 * fq;
#pragma unroll
        for (int ai = 0; ai < 2; ++ai)
#pragma unroll
            for (int m = 0; m < 4; ++m) {
                const int r = row0 + ai * 128 + m * 16;
#pragma unroll
                for (int bj = 0; bj < 2; ++bj)
#pragma unroll
                    for (int n = 0; n < 2; ++n) { const int c = col0 + bj * 128 + n * 16; const u32x2 gw = *(const u32x2*)(P + (size_t)r * NP + gcol + c);
                        f32x4 g; g[0] = sigmoidf_(__uint_as_float(gw.x << 16)); g[1] = sigmoidf_(__uint_as_float(gw.x & 0xffff0000u)); g[2] = sigmoidf_(__uint_as_float(gw.y << 16)); g[3] = sigmoidf_(__uint_as_float(gw.y & 0xffff0000u));
                        *(f32x4*)(M1 + (size_t)r * D + c) = g * acc[ai][bj][m][n]; }
            }
    }
};
struct EpiGateS {
    static constexpr bool PERM = true, AFTER_DRAIN = false;
    const bf16_t* P; int gcol; const float* M1; bf16_t* MG;
    __device__ __forceinline__ void operator()(const f32x4 (&acc)[2][2][4][2], const pg8::Unit& u, int wr, int wc, int fr, int fq) const {
        const int row0 = u.pm * 256 + wr * 64 + fr, col0 = u.pn * 256 + wc * 32 + 8 * fq;
#pragma unroll
        for (int ai = 0; ai < 2; ++ai)
#pragma unroll
            for (int m = 0; m < 4; ++m) {
                const int r = row0 + ai * 128 + m * 16;
#pragma unroll
                for (int bj = 0; bj < 2; ++bj) { const int c = col0 + bj * 128;
                    const u32x4 gw = *(const u32x4*)(P + (size_t)r * NP + gcol + c); float g[8]; unpack8(gw, g);
                    const f32x4 m0 = *(const f32x4*)(M1 + (size_t)r * D + c), m1 = *(const f32x4*)(M1 + (size_t)r * D + c + 4);
                    float o[8];
#pragma unroll
                    for (int j = 0; j < 4; ++j) { o[j] = m0[j] + sigmoidf_(g[j]) * acc[ai][bj][m][0][j]; o[4 + j] = m1[j] + sigmoidf_(g[4 + j]) * acc[ai][bj][m][1][j]; }
                    *(u32x4*)(MG + (size_t)r * D + c) = pack8(o); }
            }
    }
};

struct SkResid { const float* base; float* T; float alpha, s;
    __device__ __forceinline__ void operator()(int r, int c, f32x4 v) const { const f32x4 bv = *(const f32x4*)(base + (size_t)(r - MP) * D + c); *(f32x4*)(T + (size_t)r * D + c) = bv * alpha + v * s; } };
struct SkGateA { const bf16_t* P; int gcol; float* M1;
    __device__ __forceinline__ void operator()(int r, int c, f32x4 v) const { const u32x2 gw = *(const u32x2*)(P + (size_t)r * NP + gcol + c);
        f32x4 g; g[0] = sigmoidf_(__uint_as_float(gw.x << 16)); g[1] = sigmoidf_(__uint_as_float(gw.x & 0xffff0000u)); g[2] = sigmoidf_(__uint_as_float(gw.y << 16)); g[3] = sigmoidf_(__uint_as_float(gw.y & 0xffff0000u));
        *(f32x4*)(M1 + (size_t)r * D + c) = g * v; } };
struct SkGateS { const bf16_t* P; int gcol; const float* M1; bf16_t* MG;
    __device__ __forceinline__ void operator()(int r, int c, f32x4 v) const { const u32x2 gw = *(const u32x2*)(P + (size_t)r * NP + gcol + c); const f32x4 m = *(const f32x4*)(M1 + (size_t)r * D + c);
        const float o0 = m[0] + sigmoidf_(__uint_as_float(gw.x << 16)) * v[0], o1 = m[1] + sigmoidf_(__uint_as_float(gw.x & 0xffff0000u)) * v[1], o2 = m[2] + sigmoidf_(__uint_as_float(gw.y << 16)) * v[2], o3 = m[3] + sigmoidf_(__uint_as_float(gw.y & 0xffff0000u)) * v[3];
        u32x2 w; w.x = pk2(o0, o1); w.y = pk2(o2, o3); *(u32x2*)(MG + (size_t)r * D + c) = w; } };
template <int K, class Epi>
__device__ __forceinline__ void skinny_gemm(LAS unsigned char* lds, const bf16_t* A  , const bf16_t* Bt, const Epi& E, int bx, int G, int wave, int lane) {
    constexpr int KW = K / 8, NS = KW / 32;
    const int fr = lane & 15, fq = lane >> 4, tid = wave * 64 + lane;
    LAS float* part = (LAS float*)lds;
    for (int tile = bx; tile < 256; tile += G) {
        const int tm = tile >> 4, tn = tile & 15;
        const bf16_t* ap = A + (size_t)(tm * 32 + fr) * K + wave * KW + 8 * fq;
        const bf16_t* bp = Bt + (size_t)(tn * 64 + fr) * K + wave * KW + 8 * fq;
        f32x4 acc[2][4];
#pragma unroll
        for (int m = 0; m < 2; ++m)
#pragma unroll
            for (int n = 0; n < 4; ++n) acc[m][n] = (f32x4){0.f, 0.f, 0.f, 0.f};
#pragma unroll 4
        for (int ks = 0; ks < NS; ++ks) {
            bf16x8 a[2], bb[4];
#pragma unroll
            for (int m = 0; m < 2; ++m) a[m] = *(const bf16x8*)(ap + (size_t)m * 16 * K + ks * 32);
#pragma unroll
            for (int n = 0; n < 4; ++n) bb[n] = *(const bf16x8*)(bp + (size_t)n * 16 * K + ks * 32);
#pragma unroll
            for (int m = 0; m < 2; ++m)
#pragma unroll
                for (int n = 0; n < 4; ++n) acc[m][n] = mfma16(a[m], bb[n], acc[m][n]);
        }
#pragma unroll
        for (int m = 0; m < 2; ++m)
#pragma unroll
            for (int n = 0; n < 4; ++n)
#pragma unroll
                for (int j = 0; j < 4; ++j) part[(wave * 32 + m * 16 + 4 * fq + j) * 64 + n * 16 + fr] = acc[m][n][j];
        __syncthreads();
        { const int row = tid >> 4, c4 = (tid & 15) * 4; f32x4 v = {0.f, 0.f, 0.f, 0.f};
#pragma unroll
          for (int w = 0; w < 8; ++w) v += *(const LAS f32x4*)(part + (w * 32 + row) * 64 + c4);
          E(MP + tm * 32 + row, tn * 64 + c4, v); }
        __syncthreads();
    }
}

__device__ __forceinline__ int tr_src(int mode, int n) {
    if (mode == 0) return n;
    if (mode == 1) { const int j = n >> 8, i = n & 255; return (i < 128) ? j * 128 + i : DFF + j * 128 + (i - 128); }
    if (n < 5120) return n;
    if (n < 5376) { const int j = n - 5120; if (j < 32) return 5120 + j; if (j < 40) return 7264 + (j - 32); if (j >= 64 && j < 128) return 7200 + (j - 64); return -1; }
    if (n < 6400) return 5152 + (n - 5376);
    if (n < 6656) return 6176 + (n - 6400);
    if (n < 6912) return 6432 + (n - 6656);
    if (n < 7424) return 6688 + (n - 6912);
    return 7272 + (n - 7424);
}
__device__ __forceinline__ void tr_item(const float* W, int K, int Nsrc, bf16_t* WT, int k0, int n0, int mode, LAS bf16_t* scr, int lane) {
    const int kr = lane >> 4, nc = (lane & 15) * 4;
    const int sc = tr_src(mode, n0 + nc);
    f32x4 v[16];
#pragma unroll
    for (int i = 0; i < 16; ++i) v[i] = (sc >= 0) ? *(const f32x4*)(W + (size_t)(k0 + 4 * i + kr) * Nsrc + sc) : (f32x4){0.f, 0.f, 0.f, 0.f};
#pragma unroll
    for (int i = 0; i < 16; ++i) { const int k = 4 * i + kr; const unsigned p01 = pk2(v[i][0], v[i][1]), p23 = pk2(v[i][2], v[i][3]);
        scr[(nc + 0) * 72 + k] = (bf16_t)(p01 & 0xffffu); scr[(nc + 1) * 72 + k] = (bf16_t)(p01 >> 16); scr[(nc + 2) * 72 + k] = (bf16_t)(p23 & 0xffffu); scr[(nc + 3) * 72 + k] = (bf16_t)(p23 >> 16); }
    asm volatile("s_waitcnt lgkmcnt(0)" ::: "memory");
    const int nr = lane >> 3, kc = (lane & 7) * 8;
#pragma unroll
    for (int i = 0; i < 8; ++i) { const int n = 8 * i + nr; *(u32x4*)(WT + (size_t)(n0 + n) * K + k0 + kc) = *(const LAS u32x4*)(scr + n * 72 + kc); }
    asm volatile("s_waitcnt lgkmcnt(0)" ::: "memory");
}
__device__ __forceinline__ void p0_prologue(const Args& A, LAS unsigned char* lds, int gw, int NGW, int wave, int lane) {
    LAS bf16_t* scr = (LAS bf16_t*)(lds + wave * 16384);
    unsigned char* ws = A.ws;
    constexpr int NI0 = 16 * 88, NI1 = 44 * 16, NI2 = 16 * 148, NI3 = 32 * 16, NI4 = 16 * 16, NI5 = 16 * 16, NI6 = NI0, NI7 = NI1;
    constexpr int NIT = NI0 + NI1 + NI2 + NI3 + NI4 + NI5 + NI6 + NI7;
    for (int it = gw; it < NIT; it += NGW) {
        int r = it; const float* W; bf16_t* WT; int K, Nsrc, nblk, mode;
        if (r < NI0) { W = A.in[I_F1WI]; WT = (bf16_t*)(ws + WS_W1A); K = 1024; Nsrc = 2 * DFF; nblk = 88; mode = 1; }
        else if ((r -= NI0) < NI1) { W = A.in[I_F1WO]; WT = (bf16_t*)(ws + WS_W1B); K = DFF; Nsrc = 1024; nblk = 16; mode = 0; }
        else if ((r -= NI1) < NI2) { W = A.in[I_WIN]; WT = (bf16_t*)(ws + WS_WIN); K = 1024; Nsrc = 9320; nblk = 148; mode = 2; }
        else if ((r -= NI2) < NI3) { W = A.in[I_WBS]; WT = (bf16_t*)(ws + WS_WBS); K = 2048; Nsrc = 1024; nblk = 16; mode = 0; }
        else if ((r -= NI3) < NI4) { W = A.in[I_WBA]; WT = (bf16_t*)(ws + WS_WBA); K = 1024; Nsrc = 1024; nblk = 16; mode = 0; }
        else if ((r -= NI4) < NI5) { W = A.in[I_WOUT]; WT = (bf16_t*)(ws + WS_WOUT); K = 1024; Nsrc = 1024; nblk = 16; mode = 0; }
        else if ((r -= NI5) < NI6) { W = A.in[I_F2WI]; WT = (bf16_t*)(ws + WS_W2A); K = 1024; Nsrc = 2 * DFF; nblk = 88; mode = 1; }
        else { r -= NI6; W = A.in[I_F2WO]; WT = (bf16_t*)(ws + WS_W2B); K = DFF; Nsrc = 1024; nblk = 16; mode = 0; }
        const int kb = r / nblk, nb = r % nblk;
        tr_item(W, K, Nsrc, WT, kb * 64, nb * 64, mode, scr, lane);
    }
    bf16_t* XB = (bf16_t*)(ws + WS_XB);
    const int nchunk = M * D / 8;
    for (int ch0 = gw * 256 + lane; ch0 < nchunk; ch0 += NGW * 256) {
        f32x4 a[4], b[4];
#pragma unroll
        for (int u = 0; u < 4; ++u) { const int ch = ch0 + 64 * u, m = ch >> 7, c = (ch & 127) * 8;
            const float* src = (m < MP) ? A.in[I_XP] + (size_t)m * D + c : A.in[I_XS] + (size_t)(m - MP) * D + c; a[u] = *(const f32x4*)src; b[u] = *(const f32x4*)(src + 4); }
#pragma unroll
        for (int u = 0; u < 4; ++u) { const int ch = ch0 + 64 * u, m = ch >> 7, c = (ch & 127) * 8;
            u32x4 w; w.x = pk2(a[u][0], a[u][1]); w.y = pk2(a[u][2], a[u][3]); w.z = pk2(b[u][0], b[u][1]); w.w = pk2(b[u][2], b[u][3]);
            *(u32x4*)(XB + (size_t)m * D + c) = w; }
    }
}

__device__ __forceinline__ void ln_phase(const float* T, const float* g, const float* b, float* outf, bf16_t* outb, int gw, int NGW, int lane) {
    f32x4 gv[4], bv[4];
#pragma unroll
    for (int j = 0; j < 4; ++j) { gv[j] = *(const f32x4*)(g + 4 * lane + 256 * j); bv[j] = *(const f32x4*)(b + 4 * lane + 256 * j); }
    for (int m = gw; m < M; m += NGW) {
        const float* xr = T + (size_t)m * D + 4 * lane;
        f32x4 v[4]; float s = 0.f;
#pragma unroll
        for (int j = 0; j < 4; ++j) { v[j] = *(const f32x4*)(xr + 256 * j); s += (v[j][0] + v[j][1]) + (v[j][2] + v[j][3]); }
        const float mean = wave_sum(s) * (1.f / D); float s2 = 0.f;
#pragma unroll
        for (int j = 0; j < 4; ++j) { v[j] = v[j] - mean; s2 += (v[j][0] * v[j][0] + v[j][1] * v[j][1]) + (v[j][2] * v[j][2] + v[j][3] * v[j][3]); }
        const float rstd = 1.0f / sqrtf(wave_sum(s2) * (1.f / D) + LN_EPS);
#pragma unroll
        for (int j = 0; j < 4; ++j) {
            const f32x4 o = v[j] * rstd * gv[j] + bv[j];
            *(f32x4*)(outf + (size_t)m * D + 4 * lane + 256 * j) = o;
            if (outb) { u32x2 w; w.x = pk2(o[0], o[1]); w.y = pk2(o[2], o[3]); *(u32x2*)(outb + (size_t)m * D + 4 * lane + 256 * j) = w; }
        }
    }
}

template <int NT  , bool SAMP>
__device__ __forceinline__ void conv_item(const Args& A, int b, int t0, int cg, int lane) {
    const bf16_t* P = (const bf16_t*)(A.ws + WS_P); bf16_t* XC = (bf16_t*)(A.ws + WS_XC);
    const float* cw = A.in[I_CONVW]; const float* cb = A.in[I_CONVB];
    const int ch = (cg * 64 + lane) * 8;
    const size_t row0 = SAMP ? (size_t)(MP + b * 4) : (size_t)(b * 2048 + t0);
    u32x4 raw[NT + 3];
#pragma unroll
    for (int i = 0; i < NT + 3; ++i) {
        const int t = t0 - 3 + i;
        if (t >= 0) raw[i] = *(const u32x4*)(P + (row0 + (size_t)(i - 3)) * NP + PXBC + ch);
        else raw[i] = (u32x4){0u, 0u, 0u, 0u};
    }
    float w[4][8], bias[8];
#pragma unroll
    for (int j = 0; j < 4; ++j) { const f32x4 w0 = *(const f32x4*)(cw + (size_t)j * XCW + ch), w1 = *(const f32x4*)(cw + (size_t)j * XCW + ch + 4);
#pragma unroll
        for (int i = 0; i < 4; ++i) { w[j][i] = w0[i]; w[j][4 + i] = w1[i]; } }
    { const f32x4 b0 = *(const f32x4*)(cb + ch), b1 = *(const f32x4*)(cb + ch + 4);
#pragma unroll
      for (int i = 0; i < 4; ++i) { bias[i] = b0[i]; bias[4 + i] = b1[i]; } }
    float u0[8], u1[8], u2[8];
    if (SAMP) {
        const float* sc = A.in[I_SCONV] + (size_t)b * 3 * XCW + ch;
#pragma unroll
        for (int i = 0; i < 4; ++i) { const f32x4 a0 = *(const f32x4*)(sc), a1 = *(const f32x4*)(sc + 4), c0 = *(const f32x4*)(sc + XCW), c1 = *(const f32x4*)(sc + XCW + 4), e0 = *(const f32x4*)(sc + 2 * XCW), e1 = *(const f32x4*)(sc + 2 * XCW + 4);
            u0[i] = a0[i]; u0[4 + i] = a1[i]; u1[i] = c0[i]; u1[4 + i] = c1[i]; u2[i] = e0[i]; u2[4 + i] = e1[i]; }
    } else { unpack8(raw[0], u0); unpack8(raw[1], u1); unpack8(raw[2], u2); }
#pragma unroll
    for (int i = 0; i < NT; ++i) {
        float u3[8], o[8]; unpack8(raw[i + 3], u3);
#pragma unroll
        for (int e = 0; e < 8; ++e) o[e] = siluf_(bias[e] + w[0][e] * u0[e] + w[1][e] * u1[e] + w[2][e] * u2[e] + w[3][e] * u3[e]);
        *(u32x4*)(XC + (row0 + (size_t)i) * XCW + ch) = pack8(o);
        const int t = t0 + i; float* cs = nullptr;
        if (!SAMP) { if (t >= 2045) cs = A.out + O_CVP + ((size_t)b * 3 + (t - 2045)) * XCW + ch; }
        else { if (t >= 1) cs = A.out + O_CVS + ((size_t)b * 3 + (t - 1)) * XCW + ch; }
        if (cs) { *(f32x4*)cs = (f32x4){u3[0], u3[1], u3[2], u3[3]}; *(f32x4*)(cs + 4) = (f32x4){u3[4], u3[5], u3[6], u3[7]}; }
#pragma unroll
        for (int e = 0; e < 8; ++e) { u0[e] = u1[e]; u1[e] = u2[e]; u2[e] = u3[e]; }
    }
}
__device__ __forceinline__ void conv_phase(const Args& A, int gw, int NGW, int lane) {
    constexpr int NPI = 8 * 128 * 6, NSI = 128 * 6;
    for (int it = gw; it < NPI + NSI; it += NGW) {
        if (it < NPI) { const int cg = it % 6, r = it / 6; conv_item<16, false>(A, r >> 7, (r & 127) * 16, cg, lane); }
        else { const int r = it - NPI; conv_item<4, true>(A, r / 6, 0, r % 6, lane); }
    }
}

constexpr float IDX_SCALE = 0.125f * 0.35355339059327373f;
constexpr int SCL = 2052;
__device__ __forceinline__ unsigned f2key(float v) { unsigned u = (v == 0.f) ? 0u : __float_as_uint(v); return (u & 0x80000000u) ? ~u : (u | 0x80000000u); }
__device__ __forceinline__ void scores_select_prompt_unit(const Args& A, LAS unsigned char* lds, int b, int qt, int wave, int lane_in) {
    const bf16_t* P = (const bf16_t*)(A.ws + WS_P); const float* SMF = (const float*)(A.ws + WS_SMF);
    unsigned long long* MASKW = (unsigned long long*)(A.ws + WS_SC);
    LAS float* sc = (LAS float*)lds;
    int lane = lane_in; asm volatile("" : "+v"(lane));
    const int fr = lane & 15, fq = lane >> 4;
    {
        const size_t rowq = (size_t)(b * 2048 + qt * 16 + fr);
        bf16x8 Af[8][2];
#pragma unroll
        for (int h = 0; h < 8; ++h)
#pragma unroll
            for (int ks = 0; ks < 2; ++ks) Af[h][ks] = *(const bf16x8*)(P + rowq * NP + PQI + h * 64 + ks * 32 + 8 * fq);
        float wq[4][8];
#pragma unroll
        for (int j = 0; j < 4; ++j) { const float* wp = SMF + (size_t)(b * 2048 + qt * 16 + 4 * fq + j) * 128 + 32; const f32x4 w0 = *(const f32x4*)wp, w1 = *(const f32x4*)(wp + 4);
#pragma unroll
            for (int h = 0; h < 4; ++h) { wq[j][h] = w0[h] * IDX_SCALE; wq[j][4 + h] = w1[h] * IDX_SCALE; } }
        const bf16_t* kbase = P + (size_t)(b * 2048 + fr) * NP + PSM + 64 + 8 * fq;
        bf16x8 nB0 = {0, 0, 0, 0, 0, 0, 0, 0}, nB1 = nB0;
        if (wave <= qt) { const bf16_t* kp = kbase + (size_t)wave * 16 * NP; nB0 = *(const bf16x8*)kp; nB1 = *(const bf16x8*)(kp + 32); }
        for (int kt = wave; kt <= qt; kt += NWAVES) {
            const bf16x8 B0 = nB0, B1 = nB1;
            if (kt + NWAVES <= qt) { const bf16_t* kp = kbase + (size_t)(kt + NWAVES) * 16 * NP; nB0 = *(const bf16x8*)kp; nB1 = *(const bf16x8*)(kp + 32); }
            f32x4 scv = {0.f, 0.f, 0.f, 0.f};
#pragma unroll
            for (int h = 0; h < 8; ++h) { f32x4 d = {0.f, 0.f, 0.f, 0.f}; d = mfma16(Af[h][0], B0, d); d = mfma16(Af[h][1], B1, d);
#pragma unroll
                for (int j = 0; j < 4; ++j) scv[j] += wq[j][h] * fmaxf(d[j], 0.f); }
#pragma unroll
            for (int j = 0; j < 4; ++j) sc[(4 * fq + j) * SCL + kt * 16 + fr] = scv[j];
#if MK_CHECK_ATT
#pragma unroll
            for (int j = 0; j < 4; ++j) ((float*)(A.ws + WS_END))[(size_t)(b * 2048 + qt * 16 + 4 * fq + j) * SCW + kt * 16 + fr] = scv[j];
#endif
        }
    }
    __syncthreads();
#pragma unroll 1
    for (int u = 0; u < 2; ++u) {
        const int ql = 2 * wave + u, t = qt * 16 + ql, nvalid = t + 1;
        const LAS float* srow = sc + ql * SCL + lane;
        unsigned key[32];
#pragma unroll
        for (int j = 0; j < 32; ++j) key[j] = (lane < nvalid - 64 * j) ? f2key(srow[64 * j]) : 0u;
        unsigned T = 0u; int need_eq = 0;
        if (nvalid > 256) {
            bool exact = false;
            for (int bit = 31; bit >= 0; --bit) {
                const unsigned cand = T | (1u << bit); int cnt = 0;
#pragma unroll
                for (int j = 0; j < 32; ++j) cnt += __popcll(__ballot(key[j] >= cand));
                if (cnt >= 256) { T = cand; if (cnt == 256) { exact = true; break; } }
            }
            if (exact) { T -= 1u; }
            else { int cgt = 0;
#pragma unroll
                for (int j = 0; j < 32; ++j) cgt += __popcll(__ballot(key[j] > T));
                need_eq = 256 - cgt; }
        }
        int eqused = 0; unsigned long long mine = 0ull;
#pragma unroll
        for (int j = 0; j < 32; ++j) {
            unsigned long long ms;
            if (need_eq > 0) {
                const bool gt = key[j] > T, eq = key[j] == T;
                const unsigned long long meq = __ballot(eq);
                const bool sel = gt || (eq && (eqused + mbcnt64(meq) < need_eq));
                eqused += __popcll(meq);
                ms = __ballot(sel);
            } else ms = __ballot(key[j] > T);
            if (lane == j) mine = ms;
        }
        if (lane < 32) MASKW[(size_t)(b * 2048 + t) * 32 + lane] = mine;
    }
    __syncthreads();
}
__device__ __forceinline__ void scores_sample_unit(const Args& A, int b, int half, int wave, int lane) {
    const bf16_t* P = (const bf16_t*)(A.ws + WS_P); const float* SMF = (const float*)(A.ws + WS_SMF); float* SCS = (float*)(A.ws + WS_SCS);
    const int* pt = (const int*)A.in[I_PT]; const float* cki = A.in[I_CKI];
    const int fr = lane & 15, fq = lane >> 4;
    bf16x8 Af[2][2]; float wq[2][4];
#pragma unroll
    for (int mt = 0; mt < 2; ++mt) {
#pragma unroll
        for (int ks = 0; ks < 2; ++ks) Af[mt][ks] = *(const bf16x8*)(P + (size_t)(MP + b * 4 + 2 * mt + (fr >> 3)) * NP + PQI + (fr & 7) * 64 + ks * 32 + 8 * fq);
        const f32x4 w = *(const f32x4*)(SMF + (size_t)(MP + b * 4 + 2 * mt + (fq >> 1)) * 128 + 32 + 4 * (fq & 1));
#pragma unroll
        for (int j = 0; j < 4; ++j) wq[mt][j] = w[j] * IDX_SCALE;
    }
    const int kt_end = (half == 0) ? 65 : 129;
    for (int kt = half * 65 + wave; kt < kt_end; kt += NWAVES) {
        const int key = kt * 16 + fr;
        bf16x8 B0, B1;
        if (key < 2048) {
            const int page = pt[b * 16 + (key >> 7)];
            const float* src = cki + ((size_t)page * 128 + (key & 127)) * 64 + 8 * fq;
            const f32x4 a0 = *(const f32x4*)src, a1 = *(const f32x4*)(src + 4), c0 = *(const f32x4*)(src + 32), c1 = *(const f32x4*)(src + 36);
            u32x4 w0, w1; w0.x = pk2(a0[0], a0[1]); w0.y = pk2(a0[2], a0[3]); w0.z = pk2(a1[0], a1[1]); w0.w = pk2(a1[2], a1[3]);
            w1.x = pk2(c0[0], c0[1]); w1.y = pk2(c0[2], c0[3]); w1.z = pk2(c1[0], c1[1]); w1.w = pk2(c1[2], c1[3]);
            B0 = __builtin_bit_cast(bf16x8, w0); B1 = __builtin_bit_cast(bf16x8, w1);
        } else if (key < 2052) {
            const bf16_t* src = P + (size_t)(MP + b * 4 + (key - 2048)) * NP + PSM + 64 + 8 * fq;
            B0 = *(const bf16x8*)src; B1 = *(const bf16x8*)(src + 32);
        } else { B0 = (bf16x8){0, 0, 0, 0, 0, 0, 0, 0}; B1 = B0; }
#pragma unroll
        for (int mt = 0; mt < 2; ++mt) {
            f32x4 d = {0.f, 0.f, 0.f, 0.f}; d = mfma16(Af[mt][0], B0, d); d = mfma16(Af[mt][1], B1, d);
            float s = 0.f;
#pragma unroll
            for (int j = 0; j < 4; ++j) s += wq[mt][j] * fmaxf(d[j], 0.f);
            s += __shfl_xor(s, 16);
            if ((fq & 1) == 0 && key < 2052) SCS[(size_t)(b * 4 + 2 * mt + (fq >> 1)) * SCSW + key] = s;
        }
    }
}

__device__ __forceinline__ float softplusf_(float x) { return fmaxf(x, 0.f) + log1pf(expf(-fabsf(x))); }
__device__ __forceinline__ void ssd_prompt_item(const Args& A, LAS unsigned char* lds, int b, int h) {
    const int tid = threadIdx.x, lane = tid & 63, wave = __builtin_amdgcn_readfirstlane(tid >> 6), fr = lane & 15, fq = lane >> 4;
    const int g = h >> 3;
    const bf16_t* XC = (const bf16_t*)(A.ws + WS_XC); const float* SMF = (const float*)(A.ws + WS_SMF); bf16_t* Y = (bf16_t*)(A.ws + WS_Y);
    LAS bf16_t* Cm = (LAS bf16_t*)lds;
    LAS bf16_t* Bm = Cm + 64 * 136;
    LAS bf16_t* Btw = Bm + 64 * 136;
    LAS bf16_t* Xt = Btw + 128 * 72;
    LAS bf16_t* Mt = Xt + 64 * 72;
    LAS bf16_t* Hp = Mt + 64 * 72;
    LAS float* cumA = (LAS float*)(Hp + 64 * 136);
    LAS float* dtvA = cumA + 2048; LAS float* wvA = dtvA + 2048; LAS float* ecumA = wvA + 2048;
    const float Ah = -expf(A.in[I_ALOG][h]), dtb = A.in[I_DTB][h], dsk = A.in[I_DSKIP][h];
    f32x4 hst[4];
#pragma unroll
    for (int i = 0; i < 4; ++i) hst[i] = (f32x4){0.f, 0.f, 0.f, 0.f};
    for (int i = tid; i < 64 * 136 / 8; i += NTHR) *(LAS u32x4*)(Hp + i * 8) = (u32x4){0u, 0u, 0u, 0u};
#pragma unroll 1
    for (int c = wave; c < 32; c += NWAVES) {
        const int tk = c * 64 + lane;
        const float dt = softplusf_(SMF[(size_t)(b * 2048 + tk) * 128 + h] + dtb);
        float v = dt * Ah;
#pragma unroll
        for (int o = 1; o < 64; o <<= 1) { const float n = __shfl_up(v, o); if (lane >= o) v += n; }
        const float ce = __shfl(v, 63);
        cumA[tk] = v; dtvA[tk] = dt; wvA[tk] = dt * expf(ce - v); ecumA[tk] = expf(v);
    }
    const int s0 = tid >> 4, part0 = tid & 15;
    const int xs = tid >> 3, xpart = tid & 7;
    u32x4 cr[2], br[2], xr;
    {
#pragma unroll
        for (int i = 0; i < 2; ++i) { const bf16_t* rp = XC + (size_t)(b * 2048 + s0 + 32 * i) * XCW + g * 128 + part0 * 8; cr[i] = *(const u32x4*)(rp + 2560); br[i] = *(const u32x4*)(rp + 2048); }
        xr = *(const u32x4*)(XC + (size_t)(b * 2048 + xs) * XCW + h * 64 + xpart * 8);
    }
    for (int c = 0; c < 32; ++c) {
        const int row0 = b * 2048 + c * 64;
        const LAS float* cum = cumA + c * 64; const LAS float* dtv = dtvA + c * 64; const LAS float* wv = wvA + c * 64; const LAS float* ecum = ecumA + c * 64;
        __syncthreads();
#pragma unroll
        for (int i = 0; i < 2; ++i) {
            const int s = s0 + 32 * i;
            *(LAS u32x4*)(Cm + s * 136 + part0 * 8) = cr[i];
            *(LAS u32x4*)(Bm + s * 136 + part0 * 8) = br[i];
            float bf[8]; unpack8(br[i], bf); const float w = wv[s];
#pragma unroll
            for (int e = 0; e < 8; ++e) Btw[(part0 * 8 + e) * 72 + s] = (bf16_t)f2bf(bf[e] * w);
        }
        {
#pragma unroll
            for (int e = 0; e < 4; ++e) { Xt[(xpart * 8 + 2 * e) * 72 + xs] = (bf16_t)(xr[e] & 0xffffu); Xt[(xpart * 8 + 2 * e + 1) * 72 + xs] = (bf16_t)(xr[e] >> 16); }
        }
#pragma unroll
        for (int p4 = 0; p4 < 4; ++p4) { u32x2 w; w.x = pk2(hst[p4][0], hst[p4][1]); w.y = pk2(hst[p4][2], hst[p4][3]);
            *(LAS u32x2*)(Hp + (16 * p4 + fr) * 136 + 16 * wave + 4 * fq) = w; }
        if (c + 1 < 32) {
#pragma unroll
            for (int i = 0; i < 2; ++i) { const bf16_t* rp = XC + (size_t)(row0 + 64 + s0 + 32 * i) * XCW + g * 128 + part0 * 8; cr[i] = *(const u32x4*)(rp + 2560); br[i] = *(const u32x4*)(rp + 2048); }
            xr = *(const u32x4*)(XC + (size_t)(row0 + 64 + xs) * XCW + h * 64 + xpart * 8);
        }
        __syncthreads();
        {
            const int st = wave >> 1, tt0 = 2 * (wave & 1);
            bf16x8 a[4];
#pragma unroll
            for (int ks = 0; ks < 4; ++ks) a[ks] = *(const LAS bf16x8*)(Bm + (16 * st + fr) * 136 + ks * 32 + 8 * fq);
#pragma unroll
            for (int u = 0; u < 2; ++u) {
                const int tt = tt0 + u; f32x4 d = {0.f, 0.f, 0.f, 0.f};
#pragma unroll
                for (int ks = 0; ks < 4; ++ks) { const bf16x8 bb = *(const LAS bf16x8*)(Cm + (16 * tt + fr) * 136 + ks * 32 + 8 * fq); d = mfma16(a[ks], bb, d); }
                const int t = 16 * tt + fr; const float ct = cum[t]; float mv[4];
#pragma unroll
                for (int j = 0; j < 4; ++j) { const int s = 16 * st + 4 * fq + j; mv[j] = (s <= t) ? d[j] * __expf(ct - cum[s]) * dtv[s] : 0.f; }
                u32x2 w; w.x = pk2(mv[0], mv[1]); w.y = pk2(mv[2], mv[3]);
                *(LAS u32x2*)(Mt + t * 72 + 16 * st + 4 * fq) = w;
            }
        }
        __syncthreads();
        {
            const int pt = wave >> 1, tt0 = 2 * (wave & 1);
            bf16x8 a1[2], a2[4];
#pragma unroll
            for (int ks = 0; ks < 2; ++ks) a1[ks] = *(const LAS bf16x8*)(Xt + (16 * pt + fr) * 72 + ks * 32 + 8 * fq);
#pragma unroll
            for (int ks = 0; ks < 4; ++ks) a2[ks] = *(const LAS bf16x8*)(Hp + (16 * pt + fr) * 136 + ks * 32 + 8 * fq);
#pragma unroll
            for (int u = 0; u < 2; ++u) {
                const int tt = tt0 + u; f32x4 d1 = {0.f, 0.f, 0.f, 0.f}, d2 = {0.f, 0.f, 0.f, 0.f};
#pragma unroll
                for (int ks = 0; ks < 2; ++ks) { const bf16x8 bb = *(const LAS bf16x8*)(Mt + (16 * tt + fr) * 72 + ks * 32 + 8 * fq); d1 = mfma16(a1[ks], bb, d1); }
#pragma unroll
                for (int ks = 0; ks < 4; ++ks) { const bf16x8 bb = *(const LAS bf16x8*)(Cm + (16 * tt + fr) * 136 + ks * 32 + 8 * fq); d2 = mfma16(a2[ks], bb, d2); }
                const int t = 16 * tt + fr; const float et = ecum[t]; float yv[4];
#pragma unroll
                for (int j = 0; j < 4; ++j) { const int p = 16 * pt + 4 * fq + j; yv[j] = d1[j] + et * d2[j] + dsk * bf2f((unsigned)Xt[p * 72 + t]); }
                u32x2 w; w.x = pk2(yv[0], yv[1]); w.y = pk2(yv[2], yv[3]);
                *(u32x2*)(Y + (size_t)(row0 + t) * DI + h * 64 + 16 * pt + 4 * fq) = w;
            }
            bf16x8 a3[2];
#pragma unroll
            for (int ks = 0; ks < 2; ++ks) a3[ks] = *(const LAS bf16x8*)(Btw + (16 * wave + fr) * 72 + ks * 32 + 8 * fq);
            const float dec = ecum[63];
#pragma unroll
            for (int p4 = 0; p4 < 4; ++p4) { f32x4 d = {0.f, 0.f, 0.f, 0.f};
#pragma unroll
                for (int ks = 0; ks < 2; ++ks) { const bf16x8 bb = *(const LAS bf16x8*)(Xt + (16 * p4 + fr) * 72 + ks * 32 + 8 * fq); d = mfma16(a3[ks], bb, d); }
                hst[p4] = hst[p4] * dec + d; }
        }
    }
    float* so = A.out + O_SSP + ((size_t)b * 32 + h) * 64 * 128;
#pragma unroll
    for (int p4 = 0; p4 < 4; ++p4) *(f32x4*)(so + (size_t)(16 * p4 + fr) * 128 + 16 * wave + 4 * fq) = hst[p4];
    __syncthreads();
}

__device__ __forceinline__ void ssd_sample_item(const Args& A, LAS unsigned char* wl, int b, int h, int lane) {
    const bf16_t* XC = (const bf16_t*)(A.ws + WS_XC); const float* SMF = (const float*)(A.ws + WS_SMF); bf16_t* Y = (bf16_t*)(A.ws + WS_Y);
    LAS float* red = (LAS float*)wl;
    const int g = h >> 3;
    const float Ah = -expf(A.in[I_ALOG][h]), dtb = A.in[I_DTB][h], dsk = A.in[I_DSKIP][h];
#pragma unroll 1
    for (int half = 0; half < 2; ++half) {
        const float* h0 = A.in[I_SSSM] + (((size_t)b * 32 + h) * 64 + 32 * half) * 128 + 2 * lane;
        float st[32][2];
#pragma unroll
        for (int p = 0; p < 32; ++p) { const float2 v = *(const float2*)(h0 + p * 128); st[p][0] = v.x; st[p][1] = v.y; }
#pragma unroll 1
        for (int t = 0; t < 4; ++t) {
            const size_t m = (size_t)(MP + b * 4 + t);
            const float dt = softplusf_(SMF[m * 128 + h] + dtb), dec = expf(dt * Ah);
            const unsigned bw = *(const unsigned*)(XC + m * XCW + 2048 + g * 128 + 2 * lane), cw = *(const unsigned*)(XC + m * XCW + 2560 + g * 128 + 2 * lane);
            const float b0 = bf2f(bw & 0xffffu) * dt, b1 = __uint_as_float(bw & 0xffff0000u) * dt, c0 = bf2f(cw & 0xffffu), c1 = __uint_as_float(cw & 0xffff0000u);
            const float xl = bf2f((unsigned)XC[m * XCW + h * 64 + 32 * half + (lane & 31)]);
#pragma unroll
            for (int p = 0; p < 32; ++p) {
                const float xp = __shfl(xl, p);
                st[p][0] = st[p][0] * dec + xp * b0; st[p][1] = st[p][1] * dec + xp * b1;
                red[p * 65 + lane] = st[p][0] * c0 + st[p][1] * c1;
            }
            asm volatile("s_waitcnt lgkmcnt(0)" ::: "memory");
            float y = 0.f;
#pragma unroll 16
            for (int i = 0; i < 64; ++i) y += red[(lane & 31) * 65 + i];
            y += dsk * xl;
            if (lane < 32) Y[m * DI + h * 64 + 32 * half + lane] = (bf16_t)f2bf(y);
            asm volatile("s_waitcnt lgkmcnt(0)" ::: "memory");
        }
        float* so = A.out + O_SSS + (((size_t)b * 32 + h) * 64 + 32 * half) * 128 + 2 * lane;
#pragma unroll
        for (int p = 0; p < 32; ++p) *(float2*)(so + p * 128) = make_float2(st[p][0], st[p][1]);
    }
}

__device__ __forceinline__ int t5_bucket(int n) {
    if (n < 16) return n;
    const float nf = (float)n;
    int large = 16 + (int)(logf(nf / 16.0f) / 2.0794415416798357f * 16.0f);
    return large < 31 ? large : 31;
}
typedef float f32x16 __attribute__((ext_vector_type(16)));
__device__ __forceinline__ f32x16 mfma32(bf16x8 a, bf16x8 b, f32x16 c) { return __builtin_amdgcn_mfma_f32_32x32x16_bf16(a, b, c, 0, 0, 0); }
constexpr float LOG2E = 1.4426950408889634f;
constexpr int AK_STR = 72, AV_STR = 68, AT_K0 = 0, AT_V0 = 2 * 64 * AK_STR * 2, AT_WS = AT_V0 + 2 * 64 * AV_STR * 2;
__device__ __forceinline__ void attn_prompt_unit(const Args& A, LAS unsigned char* lds, const LAS float* biasL, int b, int g, int qt, int wave, int lane_in) {
    const bf16_t* P = (const bf16_t*)(A.ws + WS_P); const unsigned* MASK32 = (const unsigned*)(A.ws + WS_SC); bf16_t* YA = (bf16_t*)(A.ws + WS_YA);
    int lane = lane_in; asm volatile("" : "+v"(lane));
    const int tid = wave * 64 + lane, r32 = lane & 31, hi = lane >> 5;
    LAS float* wsc = (LAS float*)(lds + AT_WS) + wave * 64;
    const int query = qt * 64 + 8 * wave + (r32 >> 2), head = 4 * g + (r32 & 3);
    const size_t qrow = (size_t)(b * 2048 + query);
    bf16x8 qf[4];
#pragma unroll
    for (int ds = 0; ds < 4; ++ds) qf[ds] = *(const bf16x8*)(P + qrow * NP + PQ + head * 64 + 16 * ds + 8 * hi);
    const unsigned* mrow = MASK32 + qrow * 64;
    const float bfar = biasL[128 * 16 + head];
    const int skey = tid >> 3, sdch = tid & 7;
    const bf16_t* ksrc = P + (size_t)(b * 2048 + skey) * NP + PK + g * 64 + sdch * 8;
    f32x16 O0, O1;
#pragma unroll
    for (int i = 0; i < 16; ++i) { O0[i] = 0.f; O1[i] = 0.f; }
    float m_run = -1e30f, l_run = 0.f;
    u32x4 kreg = *(const u32x4*)ksrc, vreg = *(const u32x4*)(ksrc + 256);
    u32x2 mwn = *(const u32x2*)mrow;
    unsigned mw0 = mwn.x, mw1 = mwn.y;
    float bfar_ = bfar;
    asm volatile("" : "+v"(qf[0]), "+v"(qf[1]), "+v"(qf[2]), "+v"(qf[3]), "+v"(kreg), "+v"(vreg), "+v"(mw0), "+v"(mw1), "+v"(bfar_));
    {
        LAS bf16_t* Kb = (LAS bf16_t*)(lds + AT_K0); LAS bf16_t* Vb = (LAS bf16_t*)(lds + AT_V0);
        *(LAS u32x4*)(Kb + skey * AK_STR + sdch * 8) = kreg;
#pragma unroll
        for (int e = 0; e < 4; ++e) { Vb[(sdch * 8 + 2 * e) * AV_STR + skey] = (bf16_t)(vreg[e] & 0xffffu); Vb[(sdch * 8 + 2 * e + 1) * AV_STR + skey] = (bf16_t)(vreg[e] >> 16); }
    }
    for (int kt = 0; kt <= qt; ++kt) {
        const int buf = kt & 1;
        __syncthreads();
        const unsigned w0 = mw0 >> (4 * hi), w1 = mw1 >> (4 * hi);
        if (kt < qt) { const bf16_t* src = ksrc + (size_t)(kt + 1) * 64 * NP; const unsigned* msrc = mrow + 2 * kt + 2;
            asm volatile("global_load_dwordx4 %0, %3, off\n\tglobal_load_dwordx4 %1, %3, off offset:512\n\tglobal_load_dwordx2 %2, %4, off" : "=&v"(kreg), "=&v"(vreg), "=&v"(mwn) : "v"(src), "v"(msrc) : "memory"); }
        const LAS bf16_t* Kb = (const LAS bf16_t*)(lds + AT_K0 + buf * (64 * AK_STR * 2)); const LAS bf16_t* Vb = (const LAS bf16_t*)(lds + AT_V0 + buf * (64 * AV_STR * 2));
        f32x16 S0, S1;
#pragma unroll
        for (int i = 0; i < 16; ++i) { S0[i] = 0.f; S1[i] = 0.f; }
#pragma unroll
        for (int ds = 0; ds < 4; ++ds) {
            const bf16x8 k0 = *(const LAS bf16x8*)(Kb + r32 * AK_STR + 16 * ds + 8 * hi), k1 = *(const LAS bf16x8*)(Kb + (32 + r32) * AK_STR + 16 * ds + 8 * hi);
            S0 = mfma32(k0, qf[ds], S0); S1 = mfma32(k1, qf[ds], S1);
        }
        const float c1 = 0.125f * LOG2E;
        if (qt - kt >= 3) {
#pragma unroll
            for (int i = 0; i < 16; ++i) { const unsigned bit = 1u << ((i & 3) + 8 * (i >> 2));
                S0[i] = (w0 & bit) ? S0[i] * c1 + bfar_ : -INFINITY; S1[i] = (w1 & bit) ? S1[i] * c1 + bfar_ : -INFINITY; }
        } else {
            const int rb = query - (kt * 64 + 4 * hi);
            const LAS float* bl = biasL + head;
            float bv0[16], bv1[16];
#pragma unroll
            for (int i = 0; i < 16; ++i) { const int pos = (i & 3) + 8 * (i >> 2);
                int r0 = rb - pos, r1 = r0 - 32; r0 = r0 < 0 ? 0 : (r0 > 128 ? 128 : r0); r1 = r1 < 0 ? 0 : (r1 > 128 ? 128 : r1);
                bv0[i] = bl[r0 * 16]; bv1[i] = bl[r1 * 16]; }
#pragma unroll
            for (int i = 0; i < 16; ++i) { const unsigned bit = 1u << ((i & 3) + 8 * (i >> 2));
                const float x0 = S0[i] * c1 + bv0[i], x1 = S1[i] * c1 + bv1[i];
                S0[i] = (w0 & bit) ? x0 : -INFINITY; S1[i] = (w1 & bit) ? x1 : -INFINITY; }
        }
        float tm = fmaxf(S0[0], S1[0]);
#pragma unroll
        for (int i = 1; i < 16; ++i) tm = fmaxf(tm, fmaxf(S0[i], S1[i]));
        tm = fmaxf(tm, __shfl_xor(tm, 32));
        if (__any(tm > m_run + 8.0f)) {
            const float mn = fmaxf(m_run, tm), f = __builtin_amdgcn_exp2f(m_run - mn);
            m_run = mn; l_run *= f;
            if (hi == 0) wsc[r32] = f;
            asm volatile("s_waitcnt lgkmcnt(0)" ::: "memory");
#pragma unroll
            for (int i = 0; i < 16; ++i) { const float fi = wsc[(i & 3) + 8 * (i >> 2) + 4 * hi]; O0[i] *= fi; O1[i] *= fi; }
            asm volatile("s_waitcnt lgkmcnt(0)" ::: "memory");
        }
        float ls = 0.f;
#pragma unroll
        for (int i = 0; i < 16; ++i) { S0[i] = __builtin_amdgcn_exp2f(S0[i] - m_run); S1[i] = __builtin_amdgcn_exp2f(S1[i] - m_run); ls += S0[i] + S1[i]; }
        l_run += ls;
        bf16x8 pa[2][2];
#pragma unroll
        for (int sk = 0; sk < 2; ++sk) {
            u32x4 a0, a1;
            a0.x = pk2(S0[8 * sk + 0], S0[8 * sk + 1]); a0.y = pk2(S0[8 * sk + 2], S0[8 * sk + 3]); a0.z = pk2(S0[8 * sk + 4], S0[8 * sk + 5]); a0.w = pk2(S0[8 * sk + 6], S0[8 * sk + 7]);
            a1.x = pk2(S1[8 * sk + 0], S1[8 * sk + 1]); a1.y = pk2(S1[8 * sk + 2], S1[8 * sk + 3]); a1.z = pk2(S1[8 * sk + 4], S1[8 * sk + 5]); a1.w = pk2(S1[8 * sk + 6], S1[8 * sk + 7]);
            pa[0][sk] = __builtin_bit_cast(bf16x8, a0); pa[1][sk] = __builtin_bit_cast(bf16x8, a1);
        }
#pragma unroll
        for (int blk = 0; blk < 2; ++blk)
#pragma unroll
            for (int sk = 0; sk < 2; ++sk) {
                const int kb = 32 * blk + 16 * sk + 4 * hi;
                const u32x2 a = *(const LAS u32x2*)(Vb + r32 * AV_STR + kb), c = *(const LAS u32x2*)(Vb + r32 * AV_STR + kb + 8);
                const u32x2 a2 = *(const LAS u32x2*)(Vb + (32 + r32) * AV_STR + kb), c2 = *(const LAS u32x2*)(Vb + (32 + r32) * AV_STR + kb + 8);
                const u32x4 v0 = {a.x, a.y, c.x, c.y}, v1 = {a2.x, a2.y, c2.x, c2.y};
                O0 = mfma32(pa[blk][sk], __builtin_bit_cast(bf16x8, v0), O0);
                O1 = mfma32(pa[blk][sk], __builtin_bit_cast(bf16x8, v1), O1);
            }
        asm volatile("s_waitcnt vmcnt(0)" : "+v"(kreg), "+v"(vreg), "+v"(mwn) :: "memory");
        mw0 = mwn.x; mw1 = mwn.y;
        if (kt < qt) {
            LAS bf16_t* Kn = (LAS bf16_t*)(lds + AT_K0 + (buf ^ 1) * (64 * AK_STR * 2)); LAS bf16_t* Vn = (LAS bf16_t*)(lds + AT_V0 + (buf ^ 1) * (64 * AV_STR * 2));
            *(LAS u32x4*)(Kn + skey * AK_STR + sdch * 8) = kreg;
#pragma unroll
            for (int e = 0; e < 4; ++e) { Vn[(sdch * 8 + 2 * e) * AV_STR + skey] = (bf16_t)(vreg[e] & 0xffffu); Vn[(sdch * 8 + 2 * e + 1) * AV_STR + skey] = (bf16_t)(vreg[e] >> 16); }
        }
    }
    l_run += __shfl_xor(l_run, 32);
    if (hi == 0) wsc[r32] = 1.0f / l_run;
    asm volatile("s_waitcnt lgkmcnt(0)" ::: "memory");
#pragma unroll
    for (int i = 0; i < 16; ++i) {
        const int rq = (i & 3) + 8 * (i >> 2) + 4 * hi; const float inv = wsc[rq];
        bf16_t* dst = YA + (size_t)(b * 2048 + qt * 64 + 8 * wave + (rq >> 2)) * D + (4 * g + (rq & 3)) * 64 + r32;
        dst[0] = (bf16_t)f2bf(O0[i] * inv); dst[32] = (bf16_t)f2bf(O1[i] * inv);
    }
    __syncthreads();
}

__device__ __forceinline__ void attend_sample_task(const Args& A, LAS unsigned char* wl, const LAS float* biasrel, int ms, int g, int lane_in) {
    constexpr int NJ = 33;
    int lane = lane_in; asm volatile("" : "+v"(lane));
    const bf16_t* P = (const bf16_t*)(A.ws + WS_P);
    const int b = ms >> 2, t = ms & 3, nvalid = 2049 + t, qpos = 2048 + t, m = MP + ms;
    const float* srow = (const float*)(A.ws + WS_SCS) + (size_t)ms * SCSW;
    LAS float* pq = (LAS float*)wl;
    LAS unsigned* rowid = (LAS unsigned*)(wl + 4096);
    LAS unsigned short* posl = (LAS unsigned short*)(wl + 4096 + 1024);
    unsigned key[NJ];
#pragma unroll
    for (int j = 0; j < NJ; ++j) key[j] = (lane < nvalid - 64 * j) ? f2key(srow[lane + 64 * j]) : 0u;
    unsigned T = 0u; int need_eq = 0;
    {
        bool exact = false;
        for (int bit = 31; bit >= 0; --bit) {
            const unsigned cand = T | (1u << bit); int cnt = 0;
#pragma unroll
            for (int j = 0; j < NJ; ++j) cnt += __popcll(__ballot(key[j] >= cand));
            if (cnt >= 256) { T = cand; if (cnt == 256) { exact = true; break; } }
        }
        if (exact) { T -= 1u; }
        else { int cgt = 0;
#pragma unroll
            for (int j = 0; j < NJ; ++j) cgt += __popcll(__ballot(key[j] > T));
            need_eq = 256 - cgt; }
    }
    int base = 0, eqused = 0;
    const int* pt = (const int*)A.in[I_PT];
#pragma unroll
    for (int j = 0; j < NJ; ++j) {
        const bool gt = key[j] > T, eq = (need_eq > 0) && (key[j] == T);
        const unsigned long long meq = __ballot(eq);
        const bool sel = gt || (eq && (eqused + mbcnt64(meq) < need_eq));
        eqused += __popcll(meq);
        const unsigned long long msk = __ballot(sel);
        if (sel) { const int pos = lane + 64 * j, k = base + mbcnt64(msk);
            posl[k] = (unsigned short)pos;
            rowid[k] = (pos < 2048) ? (unsigned)(pt[b * 16 + (pos >> 7)] * 128 + (pos & 127)) : (0x80000000u | (unsigned)(b * 4 + pos - 2048)); }
        base += __popcll(msk);
    }
    { const u32x2 w = *(const u32x2*)(P + (size_t)m * NP + PQ + g * 256 + lane * 4);
      *(LAS f32x4*)(pq + lane * 4) = (f32x4){__uint_as_float(w.x << 16), __uint_as_float(w.x & 0xffff0000u), __uint_as_float(w.y << 16), __uint_as_float(w.y & 0xffff0000u)}; }
    asm volatile("s_waitcnt lgkmcnt(0)" ::: "memory");
    const float* ck = A.in[I_CK]; const float* cv = A.in[I_CV]; const float* kn = A.out + O_KS; const float* vn = A.out + O_VS;
    const float* kp[4]; int rel[4];
#pragma unroll
    for (int i = 0; i < 4; ++i) { const unsigned rid = rowid[lane + 64 * i]; rel[i] = qpos - (int)posl[lane + 64 * i];
        kp[i] = ((rid & 0x80000000u) ? kn + (size_t)(rid & 0x7fffffffu) * 256 : ck + (size_t)rid * 256) + g * 64; }
    float acc[4][4];
#pragma unroll
    for (int i = 0; i < 4; ++i)
#pragma unroll
        for (int hh = 0; hh < 4; ++hh) acc[i][hh] = 0.f;
#pragma unroll 2
    for (int dc = 0; dc < 16; ++dc) {
        f32x4 kv[4];
#pragma unroll
        for (int i = 0; i < 4; ++i) kv[i] = *(const f32x4*)(kp[i] + dc * 4);
#pragma unroll
        for (int hh = 0; hh < 4; ++hh) { const f32x4 q4 = *(const LAS f32x4*)(pq + hh * 64 + dc * 4);
#pragma unroll
            for (int i = 0; i < 4; ++i) acc[i][hh] += kv[i][0] * q4[0] + kv[i][1] * q4[1] + kv[i][2] * q4[2] + kv[i][3] * q4[3]; }
    }
    asm volatile("s_waitcnt lgkmcnt(0)" ::: "memory");
#pragma unroll
    for (int i = 0; i < 4; ++i) { const int rc = rel[i] < 128 ? (rel[i] < 0 ? 0 : rel[i]) : 128; const f32x4 bv = *(const LAS f32x4*)(biasrel + rc * 16 + 4 * g);
#pragma unroll
        for (int hh = 0; hh < 4; ++hh) acc[i][hh] = acc[i][hh] * 0.125f + bv[hh]; }
#pragma unroll
    for (int hh = 0; hh < 4; ++hh) {
        const float mx = wave_max(fmaxf(fmaxf(acc[0][hh], acc[1][hh]), fmaxf(acc[2][hh], acc[3][hh])));
        float sm = 0.f;
#pragma unroll
        for (int i = 0; i < 4; ++i) { acc[i][hh] = __expf(acc[i][hh] - mx); sm += acc[i][hh]; }
        const float inv = 1.0f / wave_sum(sm);
#pragma unroll
        for (int i = 0; i < 4; ++i) acc[i][hh] *= inv;
    }
#pragma unroll
    for (int i = 0; i < 4; ++i) *(LAS f32x4*)(pq + (lane + 64 * i) * 4) = (f32x4){acc[i][0], acc[i][1], acc[i][2], acc[i][3]};
    asm volatile("s_waitcnt lgkmcnt(0)" ::: "memory");
    float o[4] = {0.f, 0.f, 0.f, 0.f};
    for (int k0 = 0; k0 < 256; k0 += 8) {
        float vv[8]; f32x4 pp[8];
#pragma unroll
        for (int u = 0; u < 8; ++u) { const unsigned rid = rowid[k0 + u];
            const float* vp = ((rid & 0x80000000u) ? vn + (size_t)(rid & 0x7fffffffu) * 256 : cv + (size_t)rid * 256) + g * 64 + lane;
            vv[u] = *vp; pp[u] = *(const LAS f32x4*)(pq + (k0 + u) * 4); }
#pragma unroll
        for (int u = 0; u < 8; ++u)
#pragma unroll
            for (int hh = 0; hh < 4; ++hh) o[hh] += pp[u][hh] * vv[u];
    }
    bf16_t* YA = (bf16_t*)(A.ws + WS_YA);
#pragma unroll
    for (int hh = 0; hh < 4; ++hh) YA[(size_t)m * D + (4 * g + hh) * 64 + lane] = (bf16_t)f2bf(o[hh]);
    asm volatile("s_waitcnt lgkmcnt(0)" ::: "memory");
}

#if MK_CHECK_ATT
constexpr size_t WS_CHK_SC = WS_END, WS_CHK_YA = WS_CHK_SC + 128 * MiB, WS_CHK_MASK = WS_CHK_YA + 33 * MiB, WS_CHK_END = WS_CHK_MASK + 4 * MiB;
constexpr int CW_CHK = 512;
template <bool SAMPLE> struct KVRow;
template <> struct KVRow<false> {
    typedef const bf16_t* ptr;
    const bf16_t* P;
    __device__ __forceinline__ ptr krow(unsigned rid) const { return P + (size_t)rid * NP + PK; }
    __device__ __forceinline__ ptr vrow(unsigned rid) const { return P + (size_t)rid * NP + PV; }
    static __device__ __forceinline__ void k8(ptr p, float (&f)[8]) { unpack8(*(const u32x4*)p, f); }
    static __device__ __forceinline__ f32x4 v4(ptr p) { const u32x2 w = *(const u32x2*)p;
        return (f32x4){__uint_as_float(w.x << 16), __uint_as_float(w.x & 0xffff0000u), __uint_as_float(w.y << 16), __uint_as_float(w.y & 0xffff0000u)}; }
};
template <> struct KVRow<true> {
    typedef const float* ptr;
    const float* ck; const float* cv; const float* kn; const float* vn;
    __device__ __forceinline__ ptr krow(unsigned rid) const { return (rid & 0x80000000u) ? kn + (size_t)(rid & 0x7fffffffu) * 256 : ck + (size_t)rid * 256; }
    __device__ __forceinline__ ptr vrow(unsigned rid) const { return (rid & 0x80000000u) ? vn + (size_t)(rid & 0x7fffffffu) * 256 : cv + (size_t)rid * 256; }
    static __device__ __forceinline__ void k8(ptr p, float (&f)[8]) { const f32x4 a = *(const f32x4*)p, b = *(const f32x4*)(p + 4);
#pragma unroll
        for (int i = 0; i < 4; ++i) { f[i] = a[i]; f[4 + i] = b[i]; } }
    static __device__ __forceinline__ f32x4 v4(ptr p) { return *(const f32x4*)p; }
};

template <bool SAMPLE>
__device__ __forceinline__ void attend_query(const Args& A, LAS unsigned char* wl, const LAS float* biasrel, int m, int lane_in) {
    constexpr int NJ = SAMPLE ? 33 : 32;
    int lane = lane_in; asm volatile("" : "+v"(lane));
    const bf16_t* P = (const bf16_t*)(A.ws + WS_P);
    int b, nvalid, qpos; const float* srow;
    if (!SAMPLE) { b = m >> 11; const int t = m & 2047; nvalid = t + 1; qpos = t; srow = (const float*)(A.ws + WS_CHK_SC) + (size_t)m * SCW; }
    else { const int ms = m - MP; b = ms >> 2; const int t = ms & 3; nvalid = 2049 + t; qpos = 2048 + t; srow = (const float*)(A.ws + WS_SCS) + (size_t)ms * SCSW; }
    LAS float* pq = (LAS float*)wl;
    LAS unsigned* rowid = (LAS unsigned*)(wl + 16384);
    LAS unsigned short* posl = (LAS unsigned short*)(wl + 16384 + 1024);
    unsigned key[NJ];
#pragma unroll
    for (int j = 0; j < NJ; ++j) { key[j] = (lane < nvalid - 64 * j) ? f2key(srow[lane + 64 * j]) : 0u; }
    unsigned T = 0u; int need_eq = 0;
    if (nvalid > 256) {
        for (int bit = 31; bit >= 0; --bit) {
            const unsigned cand = T | (1u << bit); int cnt = 0;
#pragma unroll
            for (int j = 0; j < NJ; ++j) cnt += __popcll(__ballot(key[j] >= cand));
            if (cnt >= 256) T = cand;
        }
        int cgt = 0;
#pragma unroll
        for (int j = 0; j < NJ; ++j) cgt += __popcll(__ballot(key[j] > T));
        need_eq = 256 - cgt;
    }
    int base = 0, eqused = 0; unsigned long long mine_chk = 0ull;
    const int* pt = (const int*)A.in[I_PT];
#pragma unroll
    for (int j = 0; j < NJ; ++j) {
        const bool gt = key[j] > T, eq = (need_eq > 0) && (key[j] == T);
        const unsigned long long meq = __ballot(eq);
        const bool sel = gt || (eq && (eqused + mbcnt64(meq) < need_eq));
        eqused += __popcll(meq);
        const unsigned long long ms = __ballot(sel);
        if (sel) { const int pos = lane + 64 * j, k = base + mbcnt64(ms);
            posl[k] = (unsigned short)pos;
            unsigned rid;
            if (!SAMPLE) rid = (unsigned)(b * 2048 + pos);
            else rid = (pos < 2048) ? (unsigned)(pt[b * 16 + (pos >> 7)] * 128 + (pos & 127)) : (0x80000000u | (unsigned)(b * 4 + pos - 2048));
            rowid[k] = rid; }
        base += __popcll(ms);
        if (!SAMPLE) { if (lane == j) mine_chk = ms; }
    }
    if (!SAMPLE) { if (lane < 32) ((unsigned long long*)(A.ws + WS_CHK_MASK))[(size_t)m * 32 + lane] = mine_chk; }
    const int nsel = base;
    asm volatile("s_waitcnt lgkmcnt(0)" ::: "memory");
    { const unsigned r0 = rowid[0]; const unsigned short p0 = posl[0];
#pragma unroll
      for (int i = 0; i < 4; ++i) { const int k = lane + 64 * i; if (k >= nsel) { rowid[k] = r0; posl[k] = p0; } } }
    { const u32x4 w0 = *(const u32x4*)(P + (size_t)m * NP + PQ + lane * 16), w1 = *(const u32x4*)(P + (size_t)m * NP + PQ + lane * 16 + 8);
      float f0[8], f1[8]; unpack8(w0, f0); unpack8(w1, f1);
#pragma unroll
      for (int e = 0; e < 8; ++e) { pq[lane * 16 + e] = f0[e]; pq[lane * 16 + 8 + e] = f1[e]; } }
    asm volatile("s_waitcnt lgkmcnt(0)" ::: "memory");
    KVRow<SAMPLE> R;
    if constexpr (!SAMPLE) { R.P = P; } else { R.ck = A.in[I_CK]; R.cv = A.in[I_CV]; R.kn = A.out + O_KS; R.vn = A.out + O_VS; }
    typename KVRow<SAMPLE>::ptr kp[4]; int rel[4];
#pragma unroll
    for (int i = 0; i < 4; ++i) { kp[i] = R.krow(rowid[lane + 64 * i]); rel[i] = qpos - (int)posl[lane + 64 * i]; }
    float acc[4][16];
#pragma unroll
    for (int i = 0; i < 4; ++i)
#pragma unroll
        for (int hh = 0; hh < 16; ++hh) acc[i][hh] = 0.f;
#pragma unroll
    for (int g = 0; g < 4; ++g) {
#pragma unroll 1
        for (int dc = 0; dc < 8; ++dc) {
            float kv[4][8];
#pragma unroll
            for (int i = 0; i < 4; ++i) KVRow<SAMPLE>::k8(kp[i] + g * 64 + dc * 8, kv[i]);
#pragma unroll
            for (int hh = 0; hh < 4; ++hh) {
                const f32x4 q0 = *(const LAS f32x4*)(pq + (4 * g + hh) * 64 + dc * 8), q1 = *(const LAS f32x4*)(pq + (4 * g + hh) * 64 + dc * 8 + 4);
#pragma unroll
                for (int i = 0; i < 4; ++i) {
                    float a = acc[i][4 * g + hh];
#pragma unroll
                    for (int e = 0; e < 4; ++e) { a += kv[i][e] * q0[e]; a += kv[i][4 + e] * q1[e]; }
                    acc[i][4 * g + hh] = a; }
            }
        }
    }
    asm volatile("s_waitcnt lgkmcnt(0)" ::: "memory");
#pragma unroll
    for (int i = 0; i < 4; ++i) {
        const bool valid = (lane + 64 * i) < nsel; const int rc = rel[i] < 128 ? (rel[i] < 0 ? 0 : rel[i]) : 128;
#pragma unroll
        for (int h4 = 0; h4 < 4; ++h4) { const f32x4 bv = *(const LAS f32x4*)(biasrel + rc * 16 + 4 * h4);
#pragma unroll
            for (int e = 0; e < 4; ++e) acc[i][4 * h4 + e] = valid ? acc[i][4 * h4 + e] * 0.125f + bv[e] : -INFINITY; }
    }
#pragma unroll
    for (int hh = 0; hh < 16; ++hh) {
        const float mx = wave_max(fmaxf(fmaxf(acc[0][hh], acc[1][hh]), fmaxf(acc[2][hh], acc[3][hh])));
        float s = 0.f;
#pragma unroll
        for (int i = 0; i < 4; ++i) { acc[i][hh] = __expf(acc[i][hh] - mx); s += acc[i][hh]; }
        const float inv = 1.0f / wave_sum(s);
#pragma unroll
        for (int i = 0; i < 4; ++i) acc[i][hh] *= inv;
    }
#pragma unroll
    for (int i = 0; i < 4; ++i)
#pragma unroll
        for (int h4 = 0; h4 < 4; ++h4) *(LAS f32x4*)(pq + (lane + 64 * i) * 16 + 4 * h4) = (f32x4){acc[i][4 * h4], acc[i][4 * h4 + 1], acc[i][4 * h4 + 2], acc[i][4 * h4 + 3]};
    asm volatile("s_waitcnt lgkmcnt(0)" ::: "memory");
    const int g = lane >> 4;
    f32x4 o[4];
#pragma unroll
    for (int hh = 0; hh < 4; ++hh) o[hh] = (f32x4){0.f, 0.f, 0.f, 0.f};
    const int nloop = (nsel + 3) & ~3;
    for (int k0 = 0; k0 < nloop; k0 += 4) {
        f32x4 vv[4], pp[4];
#pragma unroll
        for (int u = 0; u < 4; ++u) { const unsigned r = rowid[k0 + u]; vv[u] = KVRow<SAMPLE>::v4(R.vrow(r) + lane * 4); pp[u] = *(const LAS f32x4*)(pq + (k0 + u) * 16 + 4 * g); }
#pragma unroll
        for (int u = 0; u < 4; ++u)
#pragma unroll
            for (int hh = 0; hh < 4; ++hh) o[hh] += vv[u] * pp[u][hh];
    }
    bf16_t* YA = (bf16_t*)(A.ws + WS_CHK_YA);
#pragma unroll
    for (int hh = 0; hh < 4; ++hh) { u32x2 w; w.x = pk2(o[hh][0], o[hh][1]); w.y = pk2(o[hh][2], o[hh][3]);
        *(u32x2*)(YA + (size_t)m * D + (4 * g + hh) * 64 + (lane & 15) * 4) = w; }
    asm volatile("s_waitcnt lgkmcnt(0)" ::: "memory");
}


__device__ __forceinline__ void check_compare(const Args& A, int gw, int NGW, int lane) {
    const bf16_t* Y1 = (const bf16_t*)(A.ws + WS_YA); const bf16_t* Y2 = (const bf16_t*)(A.ws + WS_CHK_YA); unsigned* ctl = (unsigned*)(A.ws + WS_CTL);
    for (int m = gw; m < MP; m += NGW) {
        float e = 0.f, n = 0.f;
#pragma unroll
        for (int j = 0; j < 2; ++j) { float a[8], b[8]; unpack8(*(const u32x4*)(Y1 + (size_t)m * D + j * 512 + lane * 8), a); unpack8(*(const u32x4*)(Y2 + (size_t)m * D + j * 512 + lane * 8), b);
#pragma unroll
            for (int i = 0; i < 8; ++i) { const float d = a[i] - b[i]; e += d * d; n += b[i] * b[i]; } }
        e = wave_sum(e); n = wave_sum(n);
        { const unsigned long long w1 = (lane < 32) ? ((const unsigned long long*)(A.ws + WS_SC))[(size_t)m * 32 + lane] : 0ull, w2 = (lane < 32) ? ((const unsigned long long*)(A.ws + WS_CHK_MASK))[(size_t)m * 32 + lane] : 0ull;
          if (__any(w1 != w2) && lane == 0) atomicAdd(ctl + CW_CHK + 3, 1u);
          const int t = m & 2047;
          if (t >= 256) {
              const float* srow = (const float*)(A.ws + WS_CHK_SC) + (size_t)m * SCW;
              int c1 = 0, c2 = 0; float mins1 = INFINITY, maxu1 = -INFINITY, mins2 = INFINITY, maxu2 = -INFINITY;
              for (int j = 0; j < 32; ++j) { const int sp = lane + 64 * j; if (64 * j > t) break;
                  const unsigned long long a1 = __shfl((unsigned long long)w1, j), a2 = __shfl((unsigned long long)w2, j);
                  if (sp <= t) { const float v = srow[sp]; const bool s1 = (a1 >> lane) & 1ull, s2 = (a2 >> lane) & 1ull;
                      if (s1) { ++c1; mins1 = fminf(mins1, v); } else maxu1 = fmaxf(maxu1, v);
                      if (s2) { ++c2; mins2 = fminf(mins2, v); } else maxu2 = fmaxf(maxu2, v); } }
              c1 = (int)wave_sum((float)c1); c2 = (int)wave_sum((float)c2);
              mins1 = -wave_max(-mins1); mins2 = -wave_max(-mins2); maxu1 = wave_max(maxu1); maxu2 = wave_max(maxu2);
              if (lane == 0) { if (c1 != 256 || mins1 < maxu1) atomicAdd(ctl + CW_CHK + 4, 1u); if (c2 != 256 || mins2 < maxu2) atomicAdd(ctl + CW_CHK + 5, 1u); }
          } }
        if (lane == 0 && !(e <= MK_CHECK_TOL * MK_CHECK_TOL * n + 1e-12f)) { const int t = m & 2047; atomicAdd(ctl + CW_CHK + (t < 64 ? 0 : t < 256 ? 1 : 2), 1u); }
    }
}
#endif
__device__ __forceinline__ void gate_norm_phase(const Args& A, int gw, int NGW, int lane) {
    const bf16_t* P = (const bf16_t*)(A.ws + WS_P); bf16_t* Y = (bf16_t*)(A.ws + WS_Y); const float* ng = A.in[I_NORMG];
    for (int it = gw; it < M * 4; it += NGW) {
        const int m = it >> 2, ch = (it & 3) * 512 + lane * 8;
        float y[8], z[8]; unpack8(*(const u32x4*)(Y + (size_t)m * DI + ch), y); unpack8(*(const u32x4*)(P + (size_t)m * NP + PZ + ch), z);
        float ss = 0.f;
#pragma unroll
        for (int i = 0; i < 8; ++i) { y[i] *= siluf_(z[i]); ss += y[i] * y[i]; }
        const float r = 1.0f / sqrtf(wave_sum(ss) * (1.f / 512.f) + LN_EPS);
        const f32x4 g0 = *(const f32x4*)(ng + ch), g1 = *(const f32x4*)(ng + ch + 4);
#pragma unroll
        for (int i = 0; i < 4; ++i) { y[i] = y[i] * r * g0[i]; y[4 + i] = y[4 + i] * r * g1[i]; }
        *(u32x4*)(Y + (size_t)m * DI + ch) = pack8(y);
    }
}

constexpr int NPHASE = 14;
__global__ void __launch_bounds__(NTHR, 2) fwd(Args args) {
    extern __shared__ __attribute__((aligned(16))) unsigned char lds_raw[];
    LAS unsigned char* lds = (LAS unsigned char*)lds_raw;
    const int tid = threadIdx.x, lane = tid & 63, wave = __builtin_amdgcn_readfirstlane(tid >> 6);
    const int G = gridDim.x, bx = blockIdx.x;
    const int vcu = (G % 8 == 0) ? (bx % 8) * (G / 8) + bx / 8 : bx;
    const int gw = vcu * NWAVES + wave, NGW = G * NWAVES;
    unsigned char* ws = args.ws;
    volatile LAS unsigned* MISC = (volatile LAS unsigned*)(lds + MISC_OFF);
    for (int u = tid; u < 64; u += NTHR) MISC[u] = 0u;
    __syncthreads();
    const int lo = args.ph_lo, hi = args.ph_hi;
    XcdBarrier bar; bar.bar = (unsigned*)(ws + WS_CTL) + CW_BAR; bar.x = 0; bar.st = nullptr;
    if (hi - lo > 1) bar = xcd_barrier_post((unsigned*)(ws + WS_CTL) + CW_BAR, MISC + 8);
#define IN(k) (lo <= (k) && (k) < hi)
#define SEAM(k) do { if (IN(k) && IN((k) + 1)) xcd_barrier(bar); } while (0)

    bf16_t* const XB = (bf16_t*)(ws + WS_XB); bf16_t* const ACT = (bf16_t*)(ws + WS_ACT); float* const T = (float*)(ws + WS_T);
    float* const HF = (float*)(ws + WS_HF); bf16_t* const HB = (bf16_t*)(ws + WS_HB); bf16_t* const P = (bf16_t*)(ws + WS_P);
    float* const SMF = (float*)(ws + WS_SMF); bf16_t* const Y = (bf16_t*)(ws + WS_Y); bf16_t* const YA = (bf16_t*)(ws + WS_YA); bf16_t* const MG = (bf16_t*)(ws + WS_MG);

    if (IN(0)) REPK(0) { p0_prologue(args, lds, gw, NGW, wave, lane); }
    SEAM(0);
    if (IN(1)) {
        { pg8::Gemm g{XB, (const bf16_t*)(ws + WS_W1A), M, 2 * DFF, D}; pg8::StaticOrder S; S.init(M, 2 * DFF, G, bx);
        EpiSwiglu E{ACT}; pg8::gemm_phase<EpiSwiglu, pg8::StaticOrder, true, true>(lds, g, S, E); }
        if constexpr (DUPK(1)) { pg8::Gemm g{XB, (const bf16_t*)(ws + WS_W1A), M, 2 * DFF, D}; pg8::StaticOrder S; S.init(M, 2 * DFF, G, bx);
        EpiSwiglu E{ACT}; pg8::gemm_phase<EpiSwiglu, pg8::StaticOrder, true, true>(lds, g, S, E); }
    }
    SEAM(1);
    if (IN(2)) {
        { pg8::Gemm g{ACT, (const bf16_t*)(ws + WS_W1B), MP, D, DFF}; pg8::StaticOrder S; S.init(MP, D, G, bx);
        EpiResid E{args.in[I_XP], args.in[I_XS], T, ALPHA, 0.5f}; pg8::gemm_phase<EpiResid, pg8::StaticOrder, true, true>(lds, g, S, E); }
        { SkResid E{args.in[I_XS], T, ALPHA, 0.5f}; skinny_gemm<DFF>(lds, ACT + (size_t)MP * DFF, (const bf16_t*)(ws + WS_W1B), E, bx, G, wave, lane); }
        if constexpr (DUPK(2)) { pg8::Gemm g{ACT, (const bf16_t*)(ws + WS_W1B), MP, D, DFF}; pg8::StaticOrder S; S.init(MP, D, G, bx);
        EpiResid E{args.in[I_XP], args.in[I_XS], T, ALPHA, 0.5f}; pg8::gemm_phase<EpiResid, pg8::StaticOrder, true, true>(lds, g, S, E); }
    }
    SEAM(2);
    if (IN(3)) REPK(3) { ln_phase(T, args.in[I_LN1G], args.in[I_LN1B], HF, HB, gw, NGW, lane); }
    SEAM(3);
    if (IN(4)) {
        { pg8::Gemm g{HB, (const bf16_t*)(ws + WS_WIN), M, NP, D}; pg8::StaticOrder S; S.init(M, NP, G, bx);
        EpiWin E{P, SMF, args.out}; pg8::gemm_phase<EpiWin, pg8::StaticOrder, true, true>(lds, g, S, E); }
        if constexpr (DUPK(4)) { pg8::Gemm g{HB, (const bf16_t*)(ws + WS_WIN), M, NP, D}; pg8::StaticOrder S; S.init(M, NP, G, bx);
        EpiWin E{P, SMF, args.out}; pg8::gemm_phase<EpiWin, pg8::StaticOrder, true, true>(lds, g, S, E); }
    }
    SEAM(4);
    if (IN(5)) REPK(5) {
        for (int rep = 0; rep < MK_REP_CONV; ++rep)
        conv_phase(args, gw, NGW, lane);
        for (int rep = 0; rep < MK_REP_SCP; ++rep)
        for (int u = bx; u < 1024; u += G) { const int i = u >> 8, c = u & 255, b = c >> 5, s = c & 31; const int qt = (i == 0) ? s : (i == 1) ? 63 - s : (i == 2) ? 64 + s : 127 - s;
            scores_select_prompt_unit(args, lds, b, qt, wave, lane); }
        for (int rep = 0; rep < MK_REP_SCS; ++rep)
        for (int u = bx; u < 256; u += G) scores_sample_unit(args, u >> 1, u & 1, wave, lane);
    }
    SEAM(5);
    if (IN(6)) {
        for (int rep = 0; rep < MK_REP_SSDP; ++rep)
        for (int it = bx; it < 256; it += G) ssd_prompt_item(args, lds, it >> 5, it & 31);
        __syncthreads();
        LAS float* biasrel = (LAS float*)(lds + BIASREL_OFF); LAS float* biasL = biasrel + 129 * 16;
        for (int i = tid; i < 129 * 16; i += NTHR) { const int rel = i >> 4, h = i & 15; const float bv = args.in[I_BIAS][t5_bucket(rel) * 16 + h]; biasrel[i] = bv; biasL[i] = bv * LOG2E; }
        __syncthreads();
        for (int rep = 0; rep < MK_REP_ATTP; ++rep)
        for (int u = bx; u < 1024; u += G) { const int i = u >> 8, c = u & 255, bg = c >> 3, s8 = c & 7; const int qt = (i == 0) ? s8 : (i == 1) ? 15 - s8 : (i == 2) ? 16 + s8 : 31 - s8;
            attn_prompt_unit(args, lds, biasL, bg >> 2, bg & 3, qt, wave, lane); }
        __syncthreads();
        LAS unsigned char* wl = lds + wave * WAREA;
        for (int rep = 0; rep < MK_REP_SSDS; ++rep)
        for (int it = gw; it < 4096; it += NGW) ssd_sample_item(args, wl, it >> 5, it & 31, lane);
        for (int rep = 0; rep < MK_REP_ATTS; ++rep)
        for (int q = gw; q < MS * 4; q += NGW) attend_sample_task(args, wl, biasrel, q >> 2, q & 3, lane);
#if MK_CHECK_ATT
        for (int q = gw; q < MP; q += NGW) attend_query<false>(args, wl, biasrel, q, lane);
#endif
        __syncthreads();
    }
    SEAM(6);
    if (IN(7)) {
        gate_norm_phase(args, gw, NGW, lane);
#if MK_CHECK_ATT
        check_compare(args, gw, NGW, lane);
#endif
        { pg8::Gemm g{YA, (const bf16_t*)(ws + WS_WBA), MP, D, D}; pg8::StaticOrder S; S.init(MP, D, G, bx);
        EpiGateA E{P, PG + D, T}; pg8::gemm_phase<EpiGateA, pg8::StaticOrder, true, true>(lds, g, S, E); }
        { SkGateA E{P, PG + D, T}; skinny_gemm<D>(lds, YA + (size_t)MP * D, (const bf16_t*)(ws + WS_WBA), E, bx, G, wave, lane); }
        if constexpr (DUPK(7)) { pg8::Gemm g{YA, (const bf16_t*)(ws + WS_WBA), MP, D, D}; pg8::StaticOrder S; S.init(MP, D, G, bx);
        EpiGateA E{P, PG + D, T}; pg8::gemm_phase<EpiGateA, pg8::StaticOrder, true, true>(lds, g, S, E); }
    }
    SEAM(7);
    if (IN(8)) {
        { pg8::Gemm g{Y, (const bf16_t*)(ws + WS_WBS), MP, D, DI}; pg8::StaticOrder S; S.init(MP, D, G, bx);
        EpiGateS E{P, PG, T, MG}; pg8::gemm_phase<EpiGateS, pg8::StaticOrder, true, true>(lds, g, S, E); }
        { SkGateS E{P, PG, T, MG}; skinny_gemm<DI>(lds, Y + (size_t)MP * DI, (const bf16_t*)(ws + WS_WBS), E, bx, G, wave, lane); }
        if constexpr (DUPK(8)) { pg8::Gemm g{Y, (const bf16_t*)(ws + WS_WBS), MP, D, DI}; pg8::StaticOrder S; S.init(MP, D, G, bx);
        EpiGateS E{P, PG, T, MG}; pg8::gemm_phase<EpiGateS, pg8::StaticOrder, true, true>(lds, g, S, E); }
    }
    SEAM(8);
    if (IN(9)) {
        { pg8::Gemm g{MG, (const bf16_t*)(ws + WS_WOUT), MP, D, D}; pg8::StaticOrder S; S.init(MP, D, G, bx);
        EpiResid E{HF, HF + (size_t)MP * D, T, ALPHA, 1.0f}; pg8::gemm_phase<EpiResid, pg8::StaticOrder, true, true>(lds, g, S, E); }
        { SkResid E{HF + (size_t)MP * D, T, ALPHA, 1.0f}; skinny_gemm<D>(lds, MG + (size_t)MP * D, (const bf16_t*)(ws + WS_WOUT), E, bx, G, wave, lane); }
        if constexpr (DUPK(9)) { pg8::Gemm g{MG, (const bf16_t*)(ws + WS_WOUT), MP, D, D}; pg8::StaticOrder S; S.init(MP, D, G, bx);
        EpiResid E{HF, HF + (size_t)MP * D, T, ALPHA, 1.0f}; pg8::gemm_phase<EpiResid, pg8::StaticOrder, true, true>(lds, g, S, E); }
    }
    SEAM(9);
    if (IN(10)) REPK(10) { ln_phase(T, args.in[I_LN2G], args.in[I_LN2B], HF, HB, gw, NGW, lane); }
    SEAM(10);
    if (IN(11)) {
        { pg8::Gemm g{HB, (const bf16_t*)(ws + WS_W2A), M, 2 * DFF, D}; pg8::StaticOrder S; S.init(M, 2 * DFF, G, bx);
        EpiSwiglu E{ACT}; pg8::gemm_phase<EpiSwiglu, pg8::StaticOrder, true, true>(lds, g, S, E); }
        if constexpr (DUPK(11)) { pg8::Gemm g{HB, (const bf16_t*)(ws + WS_W2A), M, 2 * DFF, D}; pg8::StaticOrder S; S.init(M, 2 * DFF, G, bx);
        EpiSwiglu E{ACT}; pg8::gemm_phase<EpiSwiglu, pg8::StaticOrder, true, true>(lds, g, S, E); }
    }
    SEAM(11);
    if (IN(12)) {
        { pg8::Gemm g{ACT, (const bf16_t*)(ws + WS_W2B), MP, D, DFF}; pg8::StaticOrder S; S.init(MP, D, G, bx);
        EpiResid E{HF, HF + (size_t)MP * D, T, ALPHA, 0.5f}; pg8::gemm_phase<EpiResid, pg8::StaticOrder, true, true>(lds, g, S, E); }
        { SkResid E{HF + (size_t)MP * D, T, ALPHA, 0.5f}; skinny_gemm<DFF>(lds, ACT + (size_t)MP * DFF, (const bf16_t*)(ws + WS_W2B), E, bx, G, wave, lane); }
        if constexpr (DUPK(12)) { pg8::Gemm g{ACT, (const bf16_t*)(ws + WS_W2B), MP, D, DFF}; pg8::StaticOrder S; S.init(MP, D, G, bx);
        EpiResid E{HF, HF + (size_t)MP * D, T, ALPHA, 0.5f}; pg8::gemm_phase<EpiResid, pg8::StaticOrder, true, true>(lds, g, S, E); }
    }
    SEAM(12);
    if (IN(13)) REPK(13) { ln_phase(T, args.in[I_LN3G], args.in[I_LN3B], args.out + O_Y, nullptr, gw, NGW, lane); }
#if MK_CHECK_ATT
    if (IN(13)) { __syncthreads(); unsigned* cw = (unsigned*)(ws + WS_CTL) + CW_CHK;
        const unsigned b0 = __hip_atomic_load(cw, __ATOMIC_RELAXED, __HIP_MEMORY_SCOPE_AGENT), b1 = __hip_atomic_load(cw + 1, __ATOMIC_RELAXED, __HIP_MEMORY_SCOPE_AGENT), b2 = __hip_atomic_load(cw + 2, __ATOMIC_RELAXED, __HIP_MEMORY_SCOPE_AGENT), b3 = __hip_atomic_load(cw + 3, __ATOMIC_RELAXED, __HIP_MEMORY_SCOPE_AGENT), b4 = __hip_atomic_load(cw + 4, __ATOMIC_RELAXED, __HIP_MEMORY_SCOPE_AGENT), b5 = __hip_atomic_load(cw + 5, __ATOMIC_RELAXED, __HIP_MEMORY_SCOPE_AGENT);
        const float code = MK_CHECK_CODE;
        if (code > 0.f && bx == 0 && tid == 0) args.out[O_Y] = 4096.0f * sqrtf(code); }
#endif
#undef IN
#undef SEAM
}
}

extern "C" void kernel_launch(void* const* d_in, const int* in_sizes, int n_in, void* d_out, int out_size, void* d_ws, size_t ws_size, hipStream_t stream) {
    using namespace mk;
    static int grid = 0;
    if (grid == 0) {
        if (n_in != 29 || (size_t)out_size != O_END || ws_size < WS_END) { fprintf(stderr, "kernel_launch: unexpected shapes (n_in %d, out %d, ws %zu)\n", n_in, out_size, ws_size); grid = -1; return; }
        int dev = 0, cus = 0, per_cu = 0;
        if (hipGetDevice(&dev) != hipSuccess || hipDeviceGetAttribute(&cus, hipDeviceAttributeMultiprocessorCount, dev) != hipSuccess) { grid = -1; return; }
        if (hipFuncSetAttribute((const void*)fwd, hipFuncAttributeMaxDynamicSharedMemorySize, LDS_BYTES) != hipSuccess) { fprintf(stderr, "kernel_launch: hipFuncSetAttribute failed\n"); grid = -1; return; }
        if (hipOccupancyMaxActiveBlocksPerMultiprocessor(&per_cu, (const void*)fwd, NTHR, LDS_BYTES) != hipSuccess || per_cu < 1) fprintf(stderr, "kernel_launch: occupancy query says %d\n", per_cu);
        (void)hipGetLastError();
        grid = cus;
    }
    if (grid < 0) return;
    (void)hipMemsetAsync((char*)d_ws + WS_CTL, 0, CTL_ZERO_BYTES, stream);
    Args a{};
    for (int i = 0; i < 29; ++i) a.in[i] = (const float*)d_in[i];
    a.out = (float*)d_out; a.ws = (unsigned char*)d_ws;
#if MK_SPLIT
    for (int p = 0; p < NPHASE; ++p) { a.ph_lo = p; a.ph_hi = p + 1; hipLaunchKernelGGL(fwd, dim3(grid), dim3(NTHR), LDS_BYTES, stream, a); }
#else
    a.ph_lo = 0; a.ph_hi = NPHASE; hipLaunchKernelGGL(fwd, dim3(grid), dim3(NTHR), LDS_BYTES, stream, a);
#endif
}
```

```cpp
#include <hip/hip_runtime.h>
#include <cstdio>
#include <cstdint>
#define GAS __attribute__((address_space(1)))
#define LAS __attribute__((address_space(3)))
namespace pg8 {
#define PG8_LAS __attribute__((address_space(3)))
typedef unsigned short bf16_t;
typedef short bf16x8 __attribute__((ext_vector_type(8)));
typedef float f32x4 __attribute__((ext_vector_type(4)));
typedef unsigned u32x4 __attribute__((ext_vector_type(4)));
constexpr int BM = 256, BK = 64, HALF = 128, HTB = HALF * BK * 2  , STAGE_BYTES = 8 * HTB, NXCD = 8, WGM = 8;

__host__ __device__ __forceinline__ int lds_byte(int r, int c) { const int st = (r >> 4) * 2 + (c >> 5), rr = r & 15, cc = c & 31, ob = rr * 64 + cc * 2; return st * 1024 + (ob ^ (((ob >> 9) & 1) << 5)); }
__host__ __device__ __forceinline__ void stage_rc(int b, int& R, int& C) { const int st = b / 1024, sb = b % 1024, swz = sb ^ (((sb >> 9) & 1) << 5); R = (st >> 1) * 16 + swz / 64; C = (st & 1) * 32 + (swz % 64) / 2; }
__host__ __device__ __forceinline__ int perm32(int rho) { const int n = rho >> 4, i = rho & 15; return 8 * (i >> 2) + 4 * n + (i & 3); }

struct Unit { int pm, pn; };
struct Gemm { const bf16_t* A; const bf16_t* Bt; int M, N, K; };

struct StaticOrder {
    int nM, nN, nwg, G, c;
    __host__ __device__ void init(int M, int N, int G_, int c_) { nM = M / BM; nN = N / BM; nwg = nM * nN; G = G_; c = c_; }
    __host__ __device__ bool next(int i, Unit& u) const {
        const long L = (long)i * G + c; if (L >= nwg) return false;
        int wgid = (int)L; { const int q = nwg / NXCD, r = nwg % NXCD, xcd = wgid % NXCD, off = wgid / NXCD; wgid = (xcd < r ? xcd * (q + 1) : r * (q + 1) + (xcd - r) * q) + off; }
        const int nig = WGM * nN, gid = wgid / nig, fm = gid * WGM, gsz = (nM - fm) < WGM ? (nM - fm) : WGM;
        u.pm = fm + ((wgid % nig) % gsz); u.pn = (wgid % nig) / gsz; return true;
    }
    __device__ __forceinline__ void a_ready(const Unit&) const {}
    __device__ __forceinline__ void done(const Unit&) const {}
};

__device__ __forceinline__ unsigned cvt_pk_bf16(float lo, float hi) { unsigned r; asm volatile("v_cvt_pk_bf16_f32 %0, %1, %2" : "=v"(r) : "v"(lo), "v"(hi)); return r; }

template <class Epi, class Sched, bool ALIGN_EPI = false, bool SP2 = false>
__device__ __forceinline__ void gemm_phase(PG8_LAS unsigned char* lds, const Gemm g, const Sched& S, const Epi& E) {
    const int tid = threadIdx.x, wid = __builtin_amdgcn_readfirstlane(tid >> 6), lane = tid & 63, wr = wid >> 2, wc = wid & 3, fr = lane & 15, fq = lane >> 4;
    const int K = g.K, nt = K / BK;
    unsigned voffA[2], voffB[2];
#pragma unroll
    for (int i = 0; i < 2; ++i) { int R, C; stage_rc(tid * 16 + i * 8192, R, C); const int Rb = Epi::PERM ? ((R & ~31) + perm32(R & 31)) : R;
        voffA[i] = (unsigned)(R * K + C) * 2u; voffB[i] = (unsigned)(Rb * K + C) * 2u; }
    const size_t kstep = (size_t)(BK * 2);
    const size_t hstep = (size_t)HALF * K * 2;
    const size_t tstep = 2 * hstep;
    const unsigned ldsw = (unsigned)wid * 1024u;
    const int aoff = lds_byte(wr * 64 + fr, fq * 8), boff = lds_byte(wc * 32 + fr, fq * 8);
#define PG8_SA(b, h) (((b) * 2 + (h)) * HTB)
#define PG8_SB(b, h) ((4 + (b) * 2 + (h)) * HTB)
#define PG8_STAGE(bufoff, gbase, voff) do { _Pragma("unroll") for (int _i = 0; _i < 2; ++_i) \
        __builtin_amdgcn_global_load_lds((const unsigned*)((const char*)(gbase) + (voff)[_i]), (PG8_LAS unsigned*)(lds + (bufoff) + ldsw + _i * 8192), 16, 0, 0); } while (0)
#define PG8_LDA(dst, b, h) do { _Pragma("unroll") for (int m = 0; m < 4; ++m) _Pragma("unroll") for (int k = 0; k < 2; ++k) dst[m][k] = *(const PG8_LAS bf16x8*)(lds + PG8_SA(b, h) + aoff + m * 2048 + k * 1024); } while (0)
#define PG8_LDB(dst, b, h) do { _Pragma("unroll") for (int n = 0; n < 2; ++n) _Pragma("unroll") for (int k = 0; k < 2; ++k) dst[n][k] = *(const PG8_LAS bf16x8*)(lds + PG8_SB(b, h) + boff + n * 2048 + k * 1024); } while (0)
#define PG8_MMA(ai, bj, At, Bt) do { __builtin_amdgcn_s_setprio(1); _Pragma("unroll") for (int m = 0; m < 4; ++m) _Pragma("unroll") for (int n = 0; n < 2; ++n) _Pragma("unroll") for (int k = 0; k < 2; ++k) \
        acc[ai][bj][m][n] = __builtin_amdgcn_mfma_f32_16x16x32_bf16(Bt[n][k], At[m][k], acc[ai][bj][m][n], 0, 0, 0); __builtin_amdgcn_s_setprio(0); } while (0)
#define PG8_WAIT_V(n) asm volatile("s_waitcnt vmcnt(" #n ")" ::: "memory")
#define PG8_WAIT_L(n) asm volatile("s_waitcnt lgkmcnt(" #n ")" ::: "memory")
#define PG8_BAR __builtin_amdgcn_s_barrier()
#define PG8_SCHED __builtin_amdgcn_sched_barrier(0)
    Unit cur, nxt; int ui = 0;
    if (!S.next(0, cur)) return;
    f32x4 acc[2][2][4][2];
#pragma unroll
    for (int a = 0; a < 2; ++a)
#pragma unroll
        for (int b = 0; b < 2; ++b)
#pragma unroll
            for (int m = 0; m < 4; ++m)
#pragma unroll
                for (int n = 0; n < 2; ++n) acc[a][b][m][n] = (f32x4){0.f, 0.f, 0.f, 0.f};
    bf16x8 At[4][2], B0[2][2], B1[2][2];
    const char* cA = (const char*)g.A + (size_t)cur.pm * tstep; const char* cB = (const char*)g.Bt + (size_t)cur.pn * tstep;
    S.a_ready(cur);
    if constexpr (SP2) {
        PG8_STAGE(PG8_SB(0, 0), cB, voffB); PG8_STAGE(PG8_SB(0, 1), cB + hstep, voffB); PG8_STAGE(PG8_SA(0, 0), cA, voffA); PG8_STAGE(PG8_SA(0, 1), cA + hstep, voffA);
        if (wr == 1) PG8_BAR;
        PG8_WAIT_V(2); PG8_BAR;
        PG8_STAGE(PG8_SB(1, 0), cB + kstep, voffB); PG8_STAGE(PG8_SA(1, 0), cA + kstep, voffA); PG8_STAGE(PG8_SB(1, 1), cB + hstep + kstep, voffB);
        PG8_WAIT_V(6); PG8_BAR;
    } else {
        PG8_STAGE(PG8_SB(0, 0), cB, voffB); PG8_STAGE(PG8_SA(0, 0), cA, voffA); PG8_STAGE(PG8_SB(0, 1), cB + hstep, voffB); PG8_STAGE(PG8_SA(0, 1), cA + hstep, voffA);
        if (wr == 1) PG8_BAR;
        PG8_WAIT_V(4); PG8_BAR;
        PG8_STAGE(PG8_SB(1, 0), cB + kstep, voffB); PG8_STAGE(PG8_SA(1, 0), cA + kstep, voffA); PG8_STAGE(PG8_SB(1, 1), cB + hstep + kstep, voffB);
        PG8_WAIT_V(6); PG8_BAR;
    }
    for (;;) {
        const bool has_next = S.next(ui + 1, nxt);
        const char* nA = has_next ? (const char*)g.A + (size_t)nxt.pm * tstep : cA; const char* nB = has_next ? (const char*)g.Bt + (size_t)nxt.pn * tstep : cB;
        for (int t = 0; t < nt; t += 2) {
            const bool last = (t == nt - 2);
            const char* a1 = cA + (size_t)(t + 1) * kstep;
            const char* a2 = last ? nA : cA + (size_t)(t + 2) * kstep; const char* b2 = last ? nB : cB + (size_t)(t + 2) * kstep;
            const char* a3 = a2 + kstep; const char* b3 = b2 + kstep;
            if (last && has_next) S.a_ready(nxt);
            if constexpr (SP2) {
            PG8_LDB(B0, 0, 0); PG8_LDB(B1, 0, 1); PG8_SCHED; PG8_LDA(At, 0, 0); PG8_STAGE(PG8_SA(1, 1), a1 + hstep, voffA);
            PG8_WAIT_V(8); PG8_WAIT_L(0); PG8_BAR; PG8_MMA(0, 0, At, B0); PG8_MMA(0, 1, At, B1); PG8_BAR; PG8_SCHED;
            PG8_LDA(At, 0, 1); PG8_STAGE(PG8_SB(0, 0), b2, voffB); PG8_STAGE(PG8_SB(0, 1), b2 + hstep, voffB); PG8_STAGE(PG8_SA(0, 0), a2, voffA);
            PG8_WAIT_V(8); PG8_WAIT_L(0); PG8_BAR; PG8_MMA(1, 0, At, B0); PG8_MMA(1, 1, At, B1); PG8_BAR; PG8_SCHED;
            PG8_LDB(B0, 1, 0); PG8_LDB(B1, 1, 1); PG8_SCHED; PG8_LDA(At, 1, 0); PG8_STAGE(PG8_SA(0, 1), a2 + hstep, voffA);
            PG8_WAIT_V(8); PG8_WAIT_L(0); PG8_BAR; PG8_MMA(0, 0, At, B0); PG8_MMA(0, 1, At, B1); PG8_BAR; PG8_SCHED;
            PG8_LDA(At, 1, 1); PG8_STAGE(PG8_SB(1, 0), b3, voffB); PG8_STAGE(PG8_SB(1, 1), b3 + hstep, voffB); PG8_STAGE(PG8_SA(1, 0), a3, voffA);
            PG8_WAIT_V(8); PG8_WAIT_L(0); PG8_BAR; PG8_MMA(1, 0, At, B0); PG8_MMA(1, 1, At, B1); PG8_BAR; PG8_SCHED;
            } else {
            PG8_LDB(B0, 0, 0); PG8_SCHED; PG8_LDA(At, 0, 0); PG8_STAGE(PG8_SA(1, 1), a1 + hstep, voffA);
            PG8_WAIT_L(8); PG8_BAR; PG8_WAIT_L(0); PG8_MMA(0, 0, At, B0); PG8_BAR; PG8_SCHED;
            PG8_LDB(B1, 0, 1); PG8_STAGE(PG8_SB(0, 0), b2, voffB);
            PG8_BAR; PG8_WAIT_L(0); PG8_MMA(0, 1, At, B1); PG8_BAR;
            PG8_LDA(At, 0, 1); PG8_STAGE(PG8_SA(0, 0), a2, voffA);
            PG8_BAR; PG8_WAIT_L(0); PG8_MMA(1, 0, At, B0); PG8_BAR; PG8_SCHED;
            PG8_STAGE(PG8_SB(0, 1), b2 + hstep, voffB);
            PG8_WAIT_V(6); PG8_BAR; PG8_MMA(1, 1, At, B1); PG8_BAR;
            PG8_LDB(B0, 1, 0); PG8_SCHED; PG8_LDA(At, 1, 0); PG8_STAGE(PG8_SA(0, 1), a2 + hstep, voffA);
            PG8_WAIT_L(8); PG8_BAR; PG8_WAIT_L(0); PG8_MMA(0, 0, At, B0); PG8_BAR; PG8_SCHED;
            PG8_LDB(B1, 1, 1); PG8_STAGE(PG8_SB(1, 0), b3, voffB);
            PG8_BAR; PG8_WAIT_L(0); PG8_MMA(0, 1, At, B1); PG8_BAR;
            PG8_LDA(At, 1, 1); PG8_STAGE(PG8_SA(1, 0), a3, voffA);
            PG8_BAR; PG8_WAIT_L(0); PG8_MMA(1, 0, At, B0); PG8_BAR; PG8_SCHED;
            PG8_STAGE(PG8_SB(1, 1), b3 + hstep, voffB);
            PG8_WAIT_V(6); PG8_BAR; PG8_MMA(1, 1, At, B1); PG8_BAR;
            }
        }
        if constexpr (ALIGN_EPI) { if (wr == 0) PG8_BAR; }
        if constexpr (!Epi::AFTER_DRAIN) { E(acc, cur, wr, wc, fr, fq); S.done(cur); }
        if (!has_next) break;
#pragma unroll
        for (int a = 0; a < 2; ++a)
#pragma unroll
            for (int b = 0; b < 2; ++b)
#pragma unroll
                for (int m = 0; m < 4; ++m)
#pragma unroll
                    for (int n = 0; n < 2; ++n) acc[a][b][m][n] = (f32x4){0.f, 0.f, 0.f, 0.f};
        cur = nxt; cA = nA; cB = nB; ++ui;
        if constexpr (ALIGN_EPI) { if (wr == 1) PG8_BAR; }
    }
    PG8_WAIT_V(0);
    if constexpr (!ALIGN_EPI) { if (wr == 0) PG8_BAR; }
    PG8_BAR;
    if constexpr (Epi::AFTER_DRAIN) { E.fused(acc, cur, wr, wc, fr, fq, lds, wid, lane); S.done(cur); }
#undef PG8_SA
#undef PG8_SB
#undef PG8_STAGE
#undef PG8_LDA
#undef PG8_LDB
#undef PG8_MMA
#undef PG8_WAIT_V
#undef PG8_WAIT_L
#undef PG8_BAR
#undef PG8_SCHED
}
}
#define XB_TMO      128
#define XB_XCNT(j)  (256  + 64 * (j))
#define XB_XSUB(j)  (1280 + 64 * (j))
#define XB_XGEN(j)  (2304 + 64 * (j))
#define XB_TOP      3328
#define XB_TOPGEN   3392
#define XCD_BAR_WORDS 3456
#define XB_SPIN_CAP (1u << 18)

__device__ __forceinline__ unsigned xb_ld(unsigned* p)              { return __hip_atomic_load(p, __ATOMIC_RELAXED, __HIP_MEMORY_SCOPE_AGENT); }
__device__ __forceinline__ unsigned xb_add(unsigned* p, unsigned v) { return __hip_atomic_fetch_add(p, v, __ATOMIC_RELAXED, __HIP_MEMORY_SCOPE_AGENT); }
__device__ __forceinline__ unsigned xb_xcc_id() { return (unsigned)__builtin_amdgcn_s_getreg((3 << 11) | 20) & 0xFu; }
#define XB_SPIN(cond, bar) do { unsigned _sp = 0; while (cond) { __builtin_amdgcn_s_sleep(1); \
    if ((++_sp & 255u) == 0u) { if (xb_ld(&(bar)[XB_TMO])) break; if (_sp > XB_SPIN_CAP) { atomicAdd(&(bar)[XB_TMO], 1u); break; } } } } while (0)

struct XcdBarrier {
    unsigned* bar; unsigned x;
    volatile LAS unsigned* st;
};

__device__ __forceinline__ XcdBarrier xcd_barrier_post(unsigned* bar, volatile LAS unsigned* st) {
    XcdBarrier b; b.bar = bar; b.x = xb_xcc_id(); b.st = st;
    if (threadIdx.x == 0) (void)xb_add(&bar[XB_XCNT(b.x)], 1u);
    return b;
}
__device__ __forceinline__ void xcd_barrier_complete(unsigned* bar, unsigned x, unsigned& nloc, unsigned& nx) {
    const unsigned G = gridDim.x * gridDim.y * gridDim.z;
    unsigned sum, cnt, mine, sp = 0u;
    for (;;) {
        sum = 0u; cnt = 0u; mine = 0u;
#pragma unroll
        for (unsigned j = 0; j < 16; ++j) { const unsigned c = xb_ld(&bar[XB_XCNT(j)]); sum += c; cnt += (c > 0u) ? 1u : 0u; mine = (j == x) ? c : mine; }
        if (sum == G) break;
        __builtin_amdgcn_s_sleep(1);
        if ((++sp & 255u) == 0u) { if (xb_ld(&bar[XB_TMO])) break; if (sp > XB_SPIN_CAP) { atomicAdd(&bar[XB_TMO], 1u); break; } }
    }
    nloc = mine > 0u ? mine : 1u; nx = cnt > 0u ? cnt : 1u;
}

__device__ __forceinline__ void xcd_barrier(const XcdBarrier& b) {
    asm volatile("s_waitcnt vmcnt(0)" ::: "memory");
    __syncthreads();
    if (threadIdx.x == 0) {
        unsigned* bar = b.bar;
        __builtin_amdgcn_s_waitcnt(0);
        unsigned nloc = b.st[0], nx = b.st[1];
        if (nloc == 0u) { xcd_barrier_complete(bar, b.x, nloc, nx); b.st[0] = nloc; b.st[1] = nx; }
        const unsigned old = xb_add(&bar[XB_XSUB(b.x)], 1u);
        const unsigned gen = old / nloc;
        if (old + 1u == (gen + 1u) * nloc) {
            __builtin_amdgcn_fence(__ATOMIC_RELEASE, "agent");
            asm volatile("s_waitcnt vmcnt(0)" ::: "memory");
            const unsigned og = xb_add(&bar[XB_TOP], 1u);
            const unsigned tg = og / nx;
            if (og + 1u == (tg + 1u) * nx) xb_add(&bar[XB_TOPGEN], 1u);
            else XB_SPIN(xb_ld(&bar[XB_TOPGEN]) == tg, bar);
            __builtin_amdgcn_fence(__ATOMIC_ACQUIRE, "agent");
            xb_add(&bar[XB_XGEN(b.x)], 1u);
            asm volatile("s_waitcnt vmcnt(0)" ::: "memory");
        } else {
            XB_SPIN(xb_ld(&bar[XB_XGEN(b.x)]) == gen, bar);
            __builtin_amdgcn_fence(__ATOMIC_ACQUIRE, "agent");
            asm volatile("s_waitcnt vmcnt(0)" ::: "memory");
        }
    }
    __syncthreads();
}
namespace mk {
using pg8::bf16_t; using pg8::bf16x8; using pg8::f32x4; using pg8::u32x4;
typedef unsigned u32x2 __attribute__((ext_vector_type(2)));

#ifndef MK_CHECK_ATT
#define MK_CHECK_ATT 0
#endif
#define MK_REP_SSDP 1
#define MK_REP_CONV 1
#define MK_REP_SCP 1
#define MK_REP_SCS 1
#define MK_REP_SSDS 1
#define MK_REP_ATTS 1
#define MK_REP_ATTP 1
#define MK_CHECK_TOL 0.02f
#define MK_CHECK_CODE ((b0 ? 1.f : 0.f) + (b1 ? 2.f : 0.f) + (b2 ? 4.f : 0.f) + (b3 ? 8.f : 0.f) + (b4 ? 16.f : 0.f) + (b5 ? 32.f : 0.f))
#define MK_REP_MASK 0
#define DUPK(k) (((MK_REP_MASK >> (k)) & 1) != 0)
#define REPK(k) for (int rep_ = 0; rep_ < 1 + ((MK_REP_MASK >> (k)) & 1); ++rep_)
#ifndef MK_SPLIT
#define MK_SPLIT 0
#endif

constexpr int NWAVES = 8, NTHR = 512;
constexpr int MP = 16384, MS = 512, M = MP + MS, D = 1024, DFF = 2816, DI = 2048, NP = 9472, XCW = 3072;
constexpr int PZ = 0, PXBC = 2048, PSM = 5120, PQ = 5376, PK = 6400, PV = 6656, PQI = 6912, PG = 7424;
constexpr int SCW = 2048, SCSW = 2112;
constexpr size_t O_Y = 0, O_KP = 17301504, O_VP = 21495808, O_KIP = 25690112, O_CVP = 26738688, O_SSP = 26812416,
                 O_KS = 28909568, O_VS = 29040640, O_KIS = 29171712, O_CVS = 29204480, O_SSS = 30384128, O_END = 63938560;
constexpr size_t MiB = 1u << 20;
constexpr size_t WS_CTL = 0, CTL_ZERO_BYTES = 1 * MiB;
constexpr size_t WS_W1A = 1 * MiB, WS_W1B = WS_W1A + 11 * MiB, WS_WIN = WS_W1B + 6 * MiB, WS_WBS = WS_WIN + 19 * MiB, WS_WBA = WS_WBS + 4 * MiB,
                 WS_WOUT = WS_WBA + 2 * MiB, WS_W2A = WS_WOUT + 2 * MiB, WS_W2B = WS_W2A + 11 * MiB;
constexpr size_t WS_XB = WS_W2B + 6 * MiB, WS_ACT = WS_XB + 33 * MiB, WS_T = WS_ACT + 91 * MiB, WS_HF = WS_T + 66 * MiB, WS_HB = WS_HF + 66 * MiB,
                 WS_P = WS_HB + 33 * MiB, WS_SMF = WS_P + 306 * MiB, WS_XC = WS_SMF + 9 * MiB, WS_Y = WS_XC + 99 * MiB, WS_SC = WS_Y + 66 * MiB,
                 WS_SCS = WS_SC + 128 * MiB, WS_YA = WS_SCS + 5 * MiB, WS_MG = WS_YA + 33 * MiB, WS_END = WS_MG + 33 * MiB;
constexpr int CW_BAR = 4096;
constexpr int LDS_BYTES = 163840, MISC_OFF = LDS_BYTES - 256;
constexpr int WAREA = 17920;
constexpr int BIASREL_OFF = NWAVES * WAREA;
static_assert(BIASREL_OFF + 2 * 129 * 16 * 4 <= MISC_OFF, "LDS map");

constexpr float ALPHA = 1.18920711500272f;
constexpr float LN_EPS = 1e-5f;

struct Args { const float* in[29]; float* out; unsigned char* ws; int ph_lo, ph_hi; };
enum { I_XP = 0, I_XS, I_CK, I_CV, I_CKI, I_SCONV, I_SSSM, I_PT, I_BIAS, I_WIN, I_CONVW, I_CONVB, I_DTB, I_ALOG, I_DSKIP, I_NORMG, I_WBS, I_WBA, I_WOUT,
       I_F1WI, I_F1WO, I_F2WI, I_F2WO, I_LN1G, I_LN1B, I_LN2G, I_LN2B, I_LN3G, I_LN3B };

__device__ __forceinline__ float bf2f(unsigned v) { return __uint_as_float(v << 16); }
__device__ __forceinline__ unsigned f2bf(float f) { unsigned u = __float_as_uint(f); return (u + 0x7fffu + ((u >> 16) & 1u)) >> 16; }
__device__ __forceinline__ unsigned pk2(float lo, float hi) { return pg8::cvt_pk_bf16(lo, hi); }
__device__ __forceinline__ void unpack8(const u32x4 w, float (&f)[8]) {
#pragma unroll
    for (int i = 0; i < 4; ++i) { f[2 * i] = __uint_as_float(w[i] << 16); f[2 * i + 1] = __uint_as_float(w[i] & 0xffff0000u); }
}
__device__ __forceinline__ u32x4 pack8(const float (&f)[8]) { u32x4 w; w.x = pk2(f[0], f[1]); w.y = pk2(f[2], f[3]); w.z = pk2(f[4], f[5]); w.w = pk2(f[6], f[7]); return w; }
__device__ __forceinline__ float sigmoidf_(float x) { return 1.0f / (1.0f + __expf(-x)); }
__device__ __forceinline__ float siluf_(float x) { return x / (1.0f + __expf(-x)); }
__device__ __forceinline__ float wave_sum(float v) {
#pragma unroll
    for (int o = 1; o < 64; o <<= 1) v += __shfl_xor(v, o);
    return v;
}
__device__ __forceinline__ float wave_max(float v) {
#pragma unroll
    for (int o = 1; o < 64; o <<= 1) v = fmaxf(v, __shfl_xor(v, o));
    return v;
}
__device__ __forceinline__ f32x4 mfma16(bf16x8 a, bf16x8 b, f32x4 c) { return __builtin_amdgcn_mfma_f32_16x16x32_bf16(a, b, c, 0, 0, 0); }
__device__ __forceinline__ int mbcnt64(unsigned long long m) { return (int)__builtin_amdgcn_mbcnt_hi((unsigned)(m >> 32), __builtin_amdgcn_mbcnt_lo((unsigned)m, 0u)); }

struct EpiSwiglu {
    static constexpr bool PERM = true, AFTER_DRAIN = false;
    bf16_t* O;
    __device__ __forceinline__ void operator()(const f32x4 (&acc)[2][2][4][2], const pg8::Unit& u, int wr, int wc, int fr, int fq) const {
        const int row0 = u.pm * 256 + wr * 64 + fr, col0 = u.pn * 128 + wc * 32 + 8 * fq;
#pragma unroll
        for (int ai = 0; ai < 2; ++ai)
#pragma unroll
            for (int m = 0; m < 4; ++m) {
                float o[8];
#pragma unroll
                for (int n = 0; n < 2; ++n)
#pragma unroll
                    for (int j = 0; j < 4; ++j) { const float g = acc[ai][0][m][n][j], up = acc[ai][1][m][n][j]; o[4 * n + j] = siluf_(g) * up; }
                *(u32x4*)(O + (size_t)(row0 + ai * 128 + m * 16) * DFF + col0) = pack8(o);
            }
    }
};
struct EpiResid {
    static constexpr bool PERM = false, AFTER_DRAIN = false;
    const float* base_p; const float* base_s; float* T; float alpha, s;
    __device__ __forceinline__ void operator()(const f32x4 (&acc)[2][2][4][2], const pg8::Unit& u, int wr, int wc, int fr, int fq) const {
        const int row0 = u.pm * 256 + wr * 64 + fr, col0 = u.pn * 256 + wc * 32 + 4 * fq;
#pragma unroll
        for (int ai = 0; ai < 2; ++ai)
#pragma unroll
            for (int m = 0; m < 4; ++m) {
                const int r = row0 + ai * 128 + m * 16;
                const float* b = (r < MP) ? base_p + (size_t)r * D : base_s + (size_t)(r - MP) * D;
#pragma unroll
                for (int bj = 0; bj < 2; ++bj)
#pragma unroll
                    for (int n = 0; n < 2; ++n) { const int c = col0 + bj * 128 + n * 16; const f32x4 bv = *(const f32x4*)(b + c);
                        *(f32x4*)(T + (size_t)r * D + c) = bv * alpha + acc[ai][bj][m][n] * s; }
            }
    }
};
struct EpiWin {
    static constexpr bool PERM = true, AFTER_DRAIN = false;
    bf16_t* P; float* smf; float* out;
    __device__ __forceinline__ void operator()(const f32x4 (&acc)[2][2][4][2], const pg8::Unit& u, int wr, int wc, int fr, int fq) const {
        const int row0 = u.pm * 256 + wr * 64 + fr, cl = wc * 32 + 8 * fq, col0 = u.pn * 256 + cl;
#pragma unroll
        for (int ai = 0; ai < 2; ++ai)
#pragma unroll
            for (int m = 0; m < 4; ++m) {
                const int r = row0 + ai * 128 + m * 16;
#pragma unroll
                for (int bj = 0; bj < 2; ++bj) {
                    const f32x4 v0 = acc[ai][bj][m][0], v1 = acc[ai][bj][m][1];
                    u32x4 w; w.x = pk2(v0[0], v0[1]); w.y = pk2(v0[2], v0[3]); w.z = pk2(v1[0], v1[1]); w.w = pk2(v1[2], v1[3]);
                    *(u32x4*)(P + (size_t)r * NP + col0 + bj * 128) = w;
                    if (u.pn == 20) {
                        if (bj == 0) {
                            float* d = smf + (size_t)r * 128 + cl; *(f32x4*)d = v0; *(f32x4*)(d + 4) = v1;
                            if (cl >= 64) { float* k = out + ((r < MP) ? O_KIP + (size_t)r * 64 : O_KIS + (size_t)(r - MP) * 64) + (cl - 64); *(f32x4*)k = v0; *(f32x4*)(k + 4) = v1; }
                        }
                    } else if (u.pn == 25) {
                        float* k = out + ((r < MP) ? O_KP + (size_t)r * 256 : O_KS + (size_t)(r - MP) * 256) + bj * 128 + cl; *(f32x4*)k = v0; *(f32x4*)(k + 4) = v1;
                    } else if (u.pn == 26) {
                        float* k = out + ((r < MP) ? O_VP + (size_t)r * 256 : O_VS + (size_t)(r - MP) * 256) + bj * 128 + cl; *(f32x4*)k = v0; *(f32x4*)(k + 4) = v1;
                    }
                }
            }
    }
};
struct EpiGateA {
    static constexpr bool PERM = false, AFTER_DRAIN = false;
    const bf16_t* P; int gcol; float* M1;
    __device__ __forceinline__ void operator()(const f32x4 (&acc)[2][2][4][2], const pg8::Unit& u, int wr, int wc, int fr, int fq) const {
        const int row0 = u.pm * 256 + wr * 64 + fr, col0 = u.pn * 256 + wc * 32 + 4 * fq;
#pragma unroll
        for (int ai = 0; ai < 2; ++ai)
#pragma unroll
            for (int m = 0; m < 4; ++m) {
                const int r = row0 + ai * 128 + m * 16;
#pragma unroll
                for (int bj = 0; bj < 2; ++bj)
#pragma unroll
                    for (int n = 0; n < 2; ++n) { const int c = col0 + bj * 128 + n * 16; const u32x2 gw = *(const u32x2*)(P + (size_t)r * NP + gcol + c);
                        f32x4 g; g[0] = sigmoidf_(__uint_as_float(gw.x << 16)); g[1] = sigmoidf_(__uint_as_float(gw.x & 0xffff0000u)); g[2] = sigmoidf_(__uint_as_float(gw.y << 16)); g[3] = sigmoidf_(__uint_as_float(gw.y & 0xffff0000u));
                        *(f32x4*)(M1 + (size_t)r * D + c) = g * acc[ai][bj][m][n]; }
            }
    }
};
struct EpiGateS {
    static constexpr bool PERM = true, AFTER_DRAIN = false;
    const bf16_t* P; int gcol; const float* M1; bf16_t* MG;
    __device__ __forceinline__ void operator()(const f32x4 (&acc)[2][2][4][2], const pg8::Unit& u, int wr, int wc, int fr, int fq) const {
        const int row0 = u.pm * 256 + wr * 64 + fr, col0 = u.pn * 256 + wc * 32 + 8 * fq;
#pragma unroll
        for (int ai = 0; ai < 2; ++ai)
#pragma unroll
            for (int m = 0; m < 4; ++m) {
                const int r = row0 + ai * 128 + m * 16;
#pragma unroll
                for (int bj = 0; bj < 2; ++bj) { const int c = col0 + bj * 128;
                    const u32x4 gw = *(const u32x4*)(P + (size_t)r * NP + gcol + c); float g[8]; unpack8(gw, g);
                    const f32x4 m0 = *(const f32x4*)(M1 + (size_t)r * D + c), m1 = *(const f32x4*)(M1 + (size_t)r * D + c + 4);
                    float o[8];
#pragma unroll
                    for (int j = 0; j < 4; ++j) { o[j] = m0[j] + sigmoidf_(g[j]) * acc[ai][bj][m][0][j]; o[4 + j] = m1[j] + sigmoidf_(g[4 + j]) * acc[ai][bj][m][1][j]; }
                    *(u32x4*)(MG + (size_t)r * D + c) = pack8(o); }
            }
    }
};

struct SkResid { const float* base; float* T; float alpha, s;
    __device__ __forceinline__ void operator()(int r, int c, f32x4 v) const { const f32x4 bv = *(const f32x4*)(base + (size_t)(r - MP) * D + c); *(f32x4*)(T + (size_t)r * D + c) = bv * alpha + v * s; } };
struct SkGateA { const bf16_t* P; int gcol; float* M1;
    __device__ __forceinline__ void operator()(int r, int c, f32x4 v) const { const u32x2 gw = *(const u32x2*)(P + (size_t)r * NP + gcol + c);
        f32x4 g; g[0] = sigmoidf_(__uint_as_float(gw.x << 16)); g[1] = sigmoidf_(__uint_as_float(gw.x & 0xffff0000u)); g[2] = sigmoidf_(__uint_as_float(gw.y << 16)); g[3] = sigmoidf_(__uint_as_float(gw.y & 0xffff0000u));
        *(f32x4*)(M1 + (size_t)r * D + c) = g * v; } };
struct SkGateS { const bf16_t* P; int gcol; const float* M1; bf16_t* MG;
    __device__ __forceinline__ void operator()(int r, int c, f32x4 v) const { const u32x2 gw = *(const u32x2*)(P + (size_t)r * NP + gcol + c); const f32x4 m = *(const f32x4*)(M1 + (size_t)r * D + c);
        const float o0 = m[0] + sigmoidf_(__uint_as_float(gw.x << 16)) * v[0], o1 = m[1] + sigmoidf_(__uint_as_float(gw.x & 0xffff0000u)) * v[1], o2 = m[2] + sigmoidf_(__uint_as_float(gw.y << 16)) * v[2], o3 = m[3] + sigmoidf_(__uint_as_float(gw.y & 0xffff0000u)) * v[3];
        u32x2 w; w.x = pk2(o0, o1); w.y = pk2(o2, o3); *(u32x2*)(MG + (size_t)r * D + c) = w; } };
template <int K, class Epi>
__device__ __forceinline__ void skinny_gemm(LAS unsigned char* lds, const bf16_t* A  , const bf16_t* Bt, const Epi& E, int bx, int G, int wave, int lane) {
    constexpr int KW = K / 8, NS = KW / 32;
    const int fr = lane & 15, fq = lane >> 4, tid = wave * 64 + lane;
    LAS float* part = (LAS float*)lds;
    for (int tile = bx; tile < 256; tile += G) {
        const int tm = tile >> 4, tn = tile & 15;
        const bf16_t* ap = A + (size_t)(tm * 32 + fr) * K + wave * KW + 8 * fq;
        const bf16_t* bp = Bt + (size_t)(tn * 64 + fr) * K + wave * KW + 8 * fq;
        f32x4 acc[2][4];
#pragma unroll
        for (int m = 0; m < 2; ++m)
#pragma unroll
            for (int n = 0; n < 4; ++n) acc[m][n] = (f32x4){0.f, 0.f, 0.f, 0.f};
#pragma unroll 4
        for (int ks = 0; ks < NS; ++ks) {
            bf16x8 a[2], bb[4];
#pragma unroll
            for (int m = 0; m < 2; ++m) a[m] = *(const bf16x8*)(ap + (size_t)m * 16 * K + ks * 32);
#pragma unroll
            for (int n = 0; n < 4; ++n) bb[n] = *(const bf16x8*)(bp + (size_t)n * 16 * K + ks * 32);
#pragma unroll
            for (int m = 0; m < 2; ++m)
#pragma unroll
                for (int n = 0; n < 4; ++n) acc[m][n] = mfma16(a[m], bb[n], acc[m][n]);
        }
#pragma unroll
        for (int m = 0; m < 2; ++m)
#pragma unroll
            for (int n = 0; n < 4; ++n)
#pragma unroll
                for (int j = 0; j < 4; ++j) part[(wave * 32 + m * 16 + 4 * fq + j) * 64 + n * 16 + fr] = acc[m][n][j];
        __syncthreads();
        { const int row = tid >> 4, c4 = (tid & 15) * 4; f32x4 v = {0.f, 0.f, 0.f, 0.f};
#pragma unroll
          for (int w = 0; w < 8; ++w) v += *(const LAS f32x4*)(part + (w * 32 + row) * 64 + c4);
          E(MP + tm * 32 + row, tn * 64 + c4, v); }
        __syncthreads();
    }
}

__device__ __forceinline__ int tr_src(int mode, int n) {
    if (mode == 0) return n;
    if (mode == 1) { const int j = n >> 8, i = n & 255; return (i < 128) ? j * 128 + i : DFF + j * 128 + (i - 128); }
    if (n < 5120) return n;
    if (n < 5376) { const int j = n - 5120; if (j < 32) return 5120 + j; if (j < 40) return 7264 + (j - 32); if (j >= 64 && j < 128) return 7200 + (j - 64); return -1; }
    if (n < 6400) return 5152 + (n - 5376);
    if (n < 6656) return 6176 + (n - 6400);
    if (n < 6912) return 6432 + (n - 6656);
    if (n < 7424) return 6688 + (n - 6912);
    return 7272 + (n - 7424);
}
__device__ __forceinline__ void tr_item(const float* W, int K, int Nsrc, bf16_t* WT, int k0, int n0, int mode, LAS bf16_t* scr, int lane) {
    const int kr = lane >> 4, nc = (lane & 15) * 4;
    const int sc = tr_src(mode, n0 + nc);
    f32x4 v[16];
#pragma unroll
    for (int i = 0; i < 16; ++i) v[i] = (sc >= 0) ? *(const f32x4*)(W + (size_t)(k0 + 4 * i + kr) * Nsrc + sc) : (f32x4){0.f, 0.f, 0.f, 0.f};
#pragma unroll
    for (int i = 0; i < 16; ++i) { const int k = 4 * i + kr; const unsigned p01 = pk2(v[i][0], v[i][1]), p23 = pk2(v[i][2], v[i][3]);
        scr[(nc + 0) * 72 + k] = (bf16_t)(p01 & 0xffffu); scr[(nc + 1) * 72 + k] = (bf16_t)(p01 >> 16); scr[(nc + 2) * 72 + k] = (bf16_t)(p23 & 0xffffu); scr[(nc + 3) * 72 + k] = (bf16_t)(p23 >> 16); }
    asm volatile("s_waitcnt lgkmcnt(0)" ::: "memory");
    const int nr = lane >> 3, kc = (lane & 7) * 8;
#pragma unroll
    for (int i = 0; i < 8; ++i) { const int n = 8 * i + nr; *(u32x4*)(WT + (size_t)(n0 + n) * K + k0 + kc) = *(const LAS u32x4*)(scr + n * 72 + kc); }
    asm volatile("s_waitcnt lgkmcnt(0)" ::: "memory");
}
__device__ __forceinline__ void p0_prologue(const Args& A, LAS unsigned char* lds, int gw, int NGW, int wave, int lane) {
    LAS bf16_t* scr = (LAS bf16_t*)(lds + wave * 16384);
    unsigned char* ws = A.ws;
    constexpr int NI0 = 16 * 88, NI1 = 44 * 16, NI2 = 16 * 148, NI3 = 32 * 16, NI4 = 16 * 16, NI5 = 16 * 16, NI6 = NI0, NI7 = NI1;
    constexpr int NIT = NI0 + NI1 + NI2 + NI3 + NI4 + NI5 + NI6 + NI7;
    for (int it = gw; it < NIT; it += NGW) {
        int r = it; const float* W; bf16_t* WT; int K, Nsrc, nblk, mode;
        if (r < NI0) { W = A.in[I_F1WI]; WT = (bf16_t*)(ws + WS_W1A); K = 1024; Nsrc = 2 * DFF; nblk = 88; mode = 1; }
        else if ((r -= NI0) < NI1) { W = A.in[I_F1WO]; WT = (bf16_t*)(ws + WS_W1B); K = DFF; Nsrc = 1024; nblk = 16; mode = 0; }
        else if ((r -= NI1) < NI2) { W = A.in[I_WIN]; WT = (bf16_t*)(ws + WS_WIN); K = 1024; Nsrc = 9320; nblk = 148; mode = 2; }
        else if ((r -= NI2) < NI3) { W = A.in[I_WBS]; WT = (bf16_t*)(ws + WS_WBS); K = 2048; Nsrc = 1024; nblk = 16; mode = 0; }
        else if ((r -= NI3) < NI4) { W = A.in[I_WBA]; WT = (bf16_t*)(ws + WS_WBA); K = 1024; Nsrc = 1024; nblk = 16; mode = 0; }
        else if ((r -= NI4) < NI5) { W = A.in[I_WOUT]; WT = (bf16_t*)(ws + WS_WOUT); K = 1024; Nsrc = 1024; nblk = 16; mode = 0; }
        else if ((r -= NI5) < NI6) { W = A.in[I_F2WI]; WT = (bf16_t*)(ws + WS_W2A); K = 1024; Nsrc = 2 * DFF; nblk = 88; mode = 1; }
        else { r -= NI6; W = A.in[I_F2WO]; WT = (bf16_t*)(ws + WS_W2B); K = DFF; Nsrc = 1024; nblk = 16; mode = 0; }
        const int kb = r / nblk, nb = r % nblk;
        tr_item(W, K, Nsrc, WT, kb * 64, nb * 64, mode, scr, lane);
    }
    bf16_t* XB = (bf16_t*)(ws + WS_XB);
    const int nchunk = M * D / 8;
    for (int ch0 = gw * 256 + lane; ch0 < nchunk; ch0 += NGW * 256) {
        f32x4 a[4], b[4];
#pragma unroll
        for (int u = 0; u < 4; ++u) { const int ch = ch0 + 64 * u, m = ch >> 7, c = (ch & 127) * 8;
            const float* src = (m < MP) ? A.in[I_XP] + (size_t)m * D + c : A.in[I_XS] + (size_t)(m - MP) * D + c; a[u] = *(const f32x4*)src; b[u] = *(const f32x4*)(src + 4); }
#pragma unroll
        for (int u = 0; u < 4; ++u) { const int ch = ch0 + 64 * u, m = ch >> 7, c = (ch & 127) * 8;
            u32x4 w; w.x = pk2(a[u][0], a[u][1]); w.y = pk2(a[u][2], a[u][3]); w.z = pk2(b[u][0], b[u][1]); w.w = pk2(b[u][2], b[u][3]);
            *(u32x4*)(XB + (size_t)m * D + c) = w; }
    }
}

__device__ __forceinline__ void ln_phase(const float* T, const float* g, const float* b, float* outf, bf16_t* outb, int gw, int NGW, int lane) {
    f32x4 gv[4], bv[4];
#pragma unroll
    for (int j = 0; j < 4; ++j) { gv[j] = *(const f32x4*)(g + 4 * lane + 256 * j); bv[j] = *(const f32x4*)(b + 4 * lane + 256 * j); }
    for (int m = gw; m < M; m += NGW) {
        const float* xr = T + (size_t)m * D + 4 * lane;
        f32x4 v[4]; float s = 0.f;
#pragma unroll
        for (int j = 0; j < 4; ++j) { v[j] = *(const f32x4*)(xr + 256 * j); s += (v[j][0] + v[j][1]) + (v[j][2] + v[j][3]); }
        const float mean = wave_sum(s) * (1.f / D); float s2 = 0.f;
#pragma unroll
        for (int j = 0; j < 4; ++j) { v[j] = v[j] - mean; s2 += (v[j][0] * v[j][0] + v[j][1] * v[j][1]) + (v[j][2] * v[j][2] + v[j][3] * v[j][3]); }
        const float rstd = 1.0f / sqrtf(wave_sum(s2) * (1.f / D) + LN_EPS);
#pragma unroll
        for (int j = 0; j < 4; ++j) {
            const f32x4 o = v[j] * rstd * gv[j] + bv[j];
            *(f32x4*)(outf + (size_t)m * D + 4 * lane + 256 * j) = o;
            if (outb) { u32x2 w; w.x = pk2(o[0], o[1]); w.y = pk2(o[2], o[3]); *(u32x2*)(outb + (size_t)m * D + 4 * lane + 256 * j) = w; }
        }
    }
}

template <int NT  , bool SAMP>
__device__ __forceinline__ void conv_item(const Args& A, int b, int t0, int cg, int lane) {
    const bf16_t* P = (const bf16_t*)(A.ws + WS_P); bf16_t* XC = (bf16_t*)(A.ws + WS_XC);
    const float* cw = A.in[I_CONVW]; const float* cb = A.in[I_CONVB];
    const int ch = (cg * 64 + lane) * 8;
    const size_t row0 = SAMP ? (size_t)(MP + b * 4) : (size_t)(b * 2048 + t0);
    u32x4 raw[NT + 3];
#pragma unroll
    for (int i = 0; i < NT + 3; ++i) {
        const int t = t0 - 3 + i;
        if (t >= 0) raw[i] = *(const u32x4*)(P + (row0 + (size_t)(i - 3)) * NP + PXBC + ch);
        else raw[i] = (u32x4){0u, 0u, 0u, 0u};
    }
    float w[4][8], bias[8];
#pragma unroll
    for (int j = 0; j < 4; ++j) { const f32x4 w0 = *(const f32x4*)(cw + (size_t)j * XCW + ch), w1 = *(const f32x4*)(cw + (size_t)j * XCW + ch + 4);
#pragma unroll
        for (int i = 0; i < 4; ++i) { w[j][i] = w0[i]; w[j][4 + i] = w1[i]; } }
    { const f32x4 b0 = *(const f32x4*)(cb + ch), b1 = *(const f32x4*)(cb + ch + 4);
#pragma unroll
      for (int i = 0; i < 4; ++i) { bias[i] = b0[i]; bias[4 + i] = b1[i]; } }
    float u0[8], u1[8], u2[8];
    if (SAMP) {
        const float* sc = A.in[I_SCONV] + (size_t)b * 3 * XCW + ch;
#pragma unroll
        for (int i = 0; i < 4; ++i) { const f32x4 a0 = *(const f32x4*)(sc), a1 = *(const f32x4*)(sc + 4), c0 = *(const f32x4*)(sc + XCW), c1 = *(const f32x4*)(sc + XCW + 4), e0 = *(const f32x4*)(sc + 2 * XCW), e1 = *(const f32x4*)(sc + 2 * XCW + 4);
            u0[i] = a0[i]; u0[4 + i] = a1[i]; u1[i] = c0[i]; u1[4 + i] = c1[i]; u2[i] = e0[i]; u2[4 + i] = e1[i]; }
    } else { unpack8(raw[0], u0); unpack8(raw[1], u1); unpack8(raw[2], u2); }
#pragma unroll
    for (int i = 0; i < NT; ++i) {
        float u3[8], o[8]; unpack8(raw[i + 3], u3);
#pragma unroll
        for (int e = 0; e < 8; ++e) o[e] = siluf_(bias[e] + w[0][e] * u0[e] + w[1][e] * u1[e] + w[2][e] * u2[e] + w[3][e] * u3[e]);
        *(u32x4*)(XC + (row0 + (size_t)i) * XCW + ch) = pack8(o);
        const int t = t0 + i; float* cs = nullptr;
        if (!SAMP) { if (t >= 2045) cs = A.out + O_CVP + ((size_t)b * 3 + (t - 2045)) * XCW + ch; }
        else { if (t >= 1) cs = A.out + O_CVS + ((size_t)b * 3 + (t - 1)) * XCW + ch; }
        if (cs) { *(f32x4*)cs = (f32x4){u3[0], u3[1], u3[2], u3[3]}; *(f32x4*)(cs + 4) = (f32x4){u3[4], u3[5], u3[6], u3[7]}; }
#pragma unroll
        for (int e = 0; e < 8; ++e) { u0[e] = u1[e]; u1[e] = u2[e]; u2[e] = u3[e]; }
    }
}
__device__ __forceinline__ void conv_phase(const Args& A, int gw, int NGW, int lane) {
    constexpr int NPI = 8 * 128 * 6, NSI = 128 * 6;
    for (int it = gw; it < NPI + NSI; it += NGW) {
        if (it < NPI) { const int cg = it % 6, r = it / 6; conv_item<16, false>(A, r >> 7, (r & 127) * 16, cg, lane); }
        else { const int r = it - NPI; conv_item<4, true>(A, r / 6, 0, r % 6, lane); }
    }
}

constexpr float IDX_SCALE = 0.125f * 0.35355339059327373f;
constexpr int SCL = 2052;
__device__ __forceinline__ unsigned f2key(float v) { unsigned u = (v == 0.f) ? 0u : __float_as_uint(v); return (u & 0x80000000u) ? ~u : (u | 0x80000000u); }
__device__ __forceinline__ void scores_select_prompt_unit(const Args& A, LAS unsigned char* lds, int b, int qt, int wave, int lane_in) {
    const bf16_t* P = (const bf16_t*)(A.ws + WS_P); const float* SMF = (const float*)(A.ws + WS_SMF);
    unsigned long long* MASKW = (unsigned long long*)(A.ws + WS_SC);
    LAS float* sc = (LAS float*)lds;
    int lane = lane_in; asm volatile("" : "+v"(lane));
    const int fr = lane & 15, fq = lane >> 4;
    {
        const size_t rowq = (size_t)(b * 2048 + qt * 16 + fr);
        bf16x8 Af[8][2];
#pragma unroll
        for (int h = 0; h < 8; ++h)
#pragma unroll
            for (int ks = 0; ks < 2; ++ks) Af[h][ks] = *(const bf16x8*)(P + rowq * NP + PQI + h * 64 + ks * 32 + 8 * fq);
        float wq[4][8];
#pragma unroll
        for (int j = 0; j < 4; ++j) { const float* wp = SMF + (size_t)(b * 2048 + qt * 16 + 4 * fq + j) * 128 + 32; const f32x4 w0 = *(const f32x4*)wp, w1 = *(const f32x4*)(wp + 4);
#pragma unroll
            for (int h = 0; h < 4; ++h) { wq[j][h] = w0[h] * IDX_SCALE; wq[j][4 + h] = w1[h] * IDX_SCALE; } }
        const bf16_t* kbase = P + (size_t)(b * 2048 + fr) * NP + PSM + 64 + 8 * fq;
        bf16x8 nB0 = {0, 0, 0, 0, 0, 0, 0, 0}, nB1 = nB0;
        if (wave <= qt) { const bf16_t* kp = kbase + (size_t)wave * 16 * NP; nB0 = *(const bf16x8*)kp; nB1 = *(const bf16x8*)(kp + 32); }
        for (int kt = wave; kt <= qt; kt += NWAVES) {
            const bf16x8 B0 = nB0, B1 = nB1;
            if (kt + NWAVES <= qt) { const bf16_t* kp = kbase + (size_t)(kt + NWAVES) * 16 * NP; nB0 = *(const bf16x8*)kp; nB1 = *(const bf16x8*)(kp + 32); }
            f32x4 scv = {0.f, 0.f, 0.f, 0.f};
#pragma unroll
            for (int h = 0; h < 8; ++h) { f32x4 d = {0.f, 0.f, 0.f, 0.f}; d = mfma16(Af[h][0], B0, d); d = mfma16(Af[h][1], B1, d);
#pragma unroll
                for (int j = 0; j < 4; ++j) scv[j] += wq[j][h] * fmaxf(d[j], 0.f); }
#pragma unroll
            for (int j = 0; j < 4; ++j) sc[(4 * fq + j) * SCL + kt * 16 + fr] = scv[j];
#if MK_CHECK_ATT
#pragma unroll
            for (int j = 0; j < 4; ++j) ((float*)(A.ws + WS_END))[(size_t)(b * 2048 + qt * 16 + 4 * fq + j) * SCW + kt * 16 + fr] = scv[j];
#endif
        }
    }
    __syncthreads();
#pragma unroll 1
    for (int u = 0; u < 2; ++u) {
        const int ql = 2 * wave + u, t = qt * 16 + ql, nvalid = t + 1;
        const LAS float* srow = sc + ql * SCL + lane;
        unsigned key[32];
#pragma unroll
        for (int j = 0; j < 32; ++j) key[j] = (lane < nvalid - 64 * j) ? f2key(srow[64 * j]) : 0u;
        unsigned T = 0u; int need_eq = 0;
        if (nvalid > 256) {
            bool exact = false;
            for (int bit = 31; bit >= 0; --bit) {
                const unsigned cand = T | (1u << bit); int cnt = 0;
#pragma unroll
                for (int j = 0; j < 32; ++j) cnt += __popcll(__ballot(key[j] >= cand));
                if (cnt >= 256) { T = cand; if (cnt == 256) { exact = true; break; } }
            }
            if (exact) { T -= 1u; }
            else { int cgt = 0;
#pragma unroll
                for (int j = 0; j < 32; ++j) cgt += __popcll(__ballot(key[j] > T));
                need_eq = 256 - cgt; }
        }
        int eqused = 0; unsigned long long mine = 0ull;
#pragma unroll
        for (int j = 0; j < 32; ++j) {
            unsigned long long ms;
            if (need_eq > 0) {
                const bool gt = key[j] > T, eq = key[j] == T;
                const unsigned long long meq = __ballot(eq);
                const bool sel = gt || (eq && (eqused + mbcnt64(meq) < need_eq));
                eqused += __popcll(meq);
                ms = __ballot(sel);
            } else ms = __ballot(key[j] > T);
            if (lane == j) mine = ms;
        }
        if (lane < 32) MASKW[(size_t)(b * 2048 + t) * 32 + lane] = mine;
    }
    __syncthreads();
}
__device__ __forceinline__ void scores_sample_unit(const Args& A, int b, int half, int wave, int lane) {
    const bf16_t* P = (const bf16_t*)(A.ws + WS_P); const float* SMF = (const float*)(A.ws + WS_SMF); float* SCS = (float*)(A.ws + WS_SCS);
    const int* pt = (const int*)A.in[I_PT]; const float* cki = A.in[I_CKI];
    const int fr = lane & 15, fq = lane >> 4;
    bf16x8 Af[2][2]; float wq[2][4];
#pragma unroll
    for (int mt = 0; mt < 2; ++mt) {
#pragma unroll
        for (int ks = 0; ks < 2; ++ks) Af[mt][ks] = *(const bf16x8*)(P + (size_t)(MP + b * 4 + 2 * mt + (fr >> 3)) * NP + PQI + (fr & 7) * 64 + ks * 32 + 8 * fq);
        const f32x4 w = *(const f32x4*)(SMF + (size_t)(MP + b * 4 + 2 * mt + (fq >> 1)) * 128 + 32 + 4 * (fq & 1));
#pragma unroll
        for (int j = 0; j < 4; ++j) wq[mt][j] = w[j] * IDX_SCALE;
    }
    const int kt_end = (half == 0) ? 65 : 129;
    for (int kt = half * 65 + wave; kt < kt_end; kt += NWAVES) {
        const int key = kt * 16 + fr;
        bf16x8 B0, B1;
        if (key < 2048) {
            const int page = pt[b * 16 + (key >> 7)];
            const float* src = cki + ((size_t)page * 128 + (key & 127)) * 64 + 8 * fq;
            const f32x4 a0 = *(const f32x4*)src, a1 = *(const f32x4*)(src + 4), c0 = *(const f32x4*)(src + 32), c1 = *(const f32x4*)(src + 36);
            u32x4 w0, w1; w0.x = pk2(a0[0], a0[1]); w0.y = pk2(a0[2], a0[3]); w0.z = pk2(a1[0], a1[1]); w0.w = pk2(a1[2], a1[3]);
            w1.x = pk2(c0[0], c0[1]); w1.y = pk2(c0[2], c0[3]); w1.z = pk2(c1[0], c1[1]); w1.w = pk2(c1[2], c1[3]);
            B0 = __builtin_bit_cast(bf16x8, w0); B1 = __builtin_bit_cast(bf16x8, w1);
        } else if (key < 2052) {
            const bf16_t* src = P + (size_t)(MP + b * 4 + (key - 2048)) * NP + PSM + 64 + 8 * fq;
            B0 = *(const bf16x8*)src; B1 = *(const bf16x8*)(src + 32);
        } else { B0 = (bf16x8){0, 0, 0, 0, 0, 0, 0, 0}; B1 = B0; }
#pragma unroll
        for (int mt = 0; mt < 2; ++mt) {
            f32x4 d = {0.f, 0.f, 0.f, 0.f}; d = mfma16(Af[mt][0], B0, d); d = mfma16(Af[mt][1], B1, d);
            float s = 0.f;
#pragma unroll
            for (int j = 0; j < 4; ++j) s += wq[mt][j] * fmaxf(d[j], 0.f);
            s += __shfl_xor(s, 16);
            if ((fq & 1) == 0 && key < 2052) SCS[(size_t)(b * 4 + 2 * mt + (fq >> 1)) * SCSW + key] = s;
        }
    }
}

__device__ __forceinline__ float softplusf_(float x) { return fmaxf(x, 0.f) + log1pf(expf(-fabsf(x))); }
__device__ __forceinline__ void ssd_prompt_item(const Args& A, LAS unsigned char* lds, int b, int h) {
    const int tid = threadIdx.x, lane = tid & 63, wave = __builtin_amdgcn_readfirstlane(tid >> 6), fr = lane & 15, fq = lane >> 4;
    const int g = h >> 3;
    const bf16_t* XC = (const bf16_t*)(A.ws + WS_XC); const float* SMF = (const float*)(A.ws + WS_SMF); bf16_t* Y = (bf16_t*)(A.ws + WS_Y);
    LAS bf16_t* Cm = (LAS bf16_t*)lds;
    LAS bf16_t* Bm = Cm + 64 * 136;
    LAS bf16_t* Btw = Bm + 64 * 136;
    LAS bf16_t* Xt = Btw + 128 * 72;
    LAS bf16_t* Mt = Xt + 64 * 72;
    LAS bf16_t* Hp = Mt + 64 * 72;
    LAS float* cumA = (LAS float*)(Hp + 64 * 136);
    LAS float* dtvA = cumA + 2048; LAS float* wvA = dtvA + 2048; LAS float* ecumA = wvA + 2048;
    const float Ah = -expf(A.in[I_ALOG][h]), dtb = A.in[I_DTB][h], dsk = A.in[I_DSKIP][h];
    f32x4 hst[4];
#pragma unroll
    for (int i = 0; i < 4; ++i) hst[i] = (f32x4){0.f, 0.f, 0.f, 0.f};
    for (int i = tid; i < 64 * 136 / 8; i += NTHR) *(LAS u32x4*)(Hp + i * 8) = (u32x4){0u, 0u, 0u, 0u};
#pragma unroll 1
    for (int c = wave; c < 32; c += NWAVES) {
        const int tk = c * 64 + lane;
        const float dt = softplusf_(SMF[(size_t)(b * 2048 + tk) * 128 + h] + dtb);
        float v = dt * Ah;
#pragma unroll
        for (int o = 1; o < 64; o <<= 1) { const float n = __shfl_up(v, o); if (lane >= o) v += n; }
        const float ce = __shfl(v, 63);
        cumA[tk] = v; dtvA[tk] = dt; wvA[tk] = dt * expf(ce - v); ecumA[tk] = expf(v);
    }
    const int s0 = tid >> 4, part0 = tid & 15;
    const int xs = tid >> 3, xpart = tid & 7;
    u32x4 cr[2], br[2], xr;
    {
#pragma unroll
        for (int i = 0; i < 2; ++i) { const bf16_t* rp = XC + (size_t)(b * 2048 + s0 + 32 * i) * XCW + g * 128 + part0 * 8; cr[i] = *(const u32x4*)(rp + 2560); br[i] = *(const u32x4*)(rp + 2048); }
        xr = *(const u32x4*)(XC + (size_t)(b * 2048 + xs) * XCW + h * 64 + xpart * 8);
    }
    for (int c = 0; c < 32; ++c) {
        const int row0 = b * 2048 + c * 64;
        const LAS float* cum = cumA + c * 64; const LAS float* dtv = dtvA + c * 64; const LAS float* wv = wvA + c * 64; const LAS float* ecum = ecumA + c * 64;
        __syncthreads();
#pragma unroll
        for (int i = 0; i < 2; ++i) {
            const int s = s0 + 32 * i;
            *(LAS u32x4*)(Cm + s * 136 + part0 * 8) = cr[i];
            *(LAS u32x4*)(Bm + s * 136 + part0 * 8) = br[i];
            float bf[8]; unpack8(br[i], bf); const float w = wv[s];
#pragma unroll
            for (int e = 0; e < 8; ++e) Btw[(part0 * 8 + e) * 72 + s] = (bf16_t)f2bf(bf[e] * w);
        }
        {
#pragma unroll
            for (int e = 0; e < 4; ++e) { Xt[(xpart * 8 + 2 * e) * 72 + xs] = (bf16_t)(xr[e] & 0xffffu); Xt[(xpart * 8 + 2 * e + 1) * 72 + xs] = (bf16_t)(xr[e] >> 16); }
        }
#pragma unroll
        for (int p4 = 0; p4 < 4; ++p4) { u32x2 w; w.x = pk2(hst[p4][0], hst[p4][1]); w.y = pk2(hst[p4][2], hst[p4][3]);
            *(LAS u32x2*)(Hp + (16 * p4 + fr) * 136 + 16 * wave + 4 * fq) = w; }
        if (c + 1 < 32) {
#pragma unroll
            for (int i = 0; i < 2; ++i) { const bf16_t* rp = XC + (size_t)(row0 + 64 + s0 + 32 * i) * XCW + g * 128 + part0 * 8; cr[i] = *(const u32x4*)(rp + 2560); br[i] = *(const u32x4*)(rp + 2048); }
            xr = *(const u32x4*)(XC + (size_t)(row0 + 64 + xs) * XCW + h * 64 + xpart * 8);
        }
        __syncthreads();
        {
            const int st = wave >> 1, tt0 = 2 * (wave & 1);
            bf16x8 a[4];
#pragma unroll
            for (int ks = 0; ks < 4; ++ks) a[ks] = *(const LAS bf16x8*)(Bm + (16 * st + fr) * 136 + ks * 32 + 8 * fq);
#pragma unroll
            for (int u = 0; u < 2; ++u) {
                const int tt = tt0 + u; f32x4 d = {0.f, 0.f, 0.f, 0.f};
#pragma unroll
                for (int ks = 0; ks < 4; ++ks) { const bf16x8 bb = *(const LAS bf16x8*)(Cm + (16 * tt + fr) * 136 + ks * 32 + 8 * fq); d = mfma16(a[ks], bb, d); }
                const int t = 16 * tt + fr; const float ct = cum[t]; float mv[4];
#pragma unroll
                for (int j = 0; j < 4; ++j) { const int s = 16 * st + 4 * fq + j; mv[j] = (s <= t) ? d[j] * __expf(ct - cum[s]) * dtv[s] : 0.f; }
                u32x2 w; w.x = pk2(mv[0], mv[1]); w.y = pk2(mv[2], mv[3]);
                *(LAS u32x2*)(Mt + t * 72 + 16 * st + 4 * fq) = w;
            }
        }
        __syncthreads();
        {
            const int pt = wave >> 1, tt0 = 2 * (wave & 1);
            bf16x8 a1[2], a2[4];
#pragma unroll
            for (int ks = 0; ks < 2; ++ks) a1[ks] = *(const LAS bf16x8*)(Xt + (16 * pt + fr) * 72 + ks * 32 + 8 * fq);
#pragma unroll
            for (int ks = 0; ks < 4; ++ks) a2[ks] = *(const LAS bf16x8*)(Hp + (16 * pt + fr) * 136 + ks * 32 + 8 * fq);
#pragma unroll
            for (int u = 0; u < 2; ++u) {
                const int tt = tt0 + u; f32x4 d1 = {0.f, 0.f, 0.f, 0.f}, d2 = {0.f, 0.f, 0.f, 0.f};
#pragma unroll
                for (int ks = 0; ks < 2; ++ks) { const bf16x8 bb = *(const LAS bf16x8*)(Mt + (16 * tt + fr) * 72 + ks * 32 + 8 * fq); d1 = mfma16(a1[ks], bb, d1); }
#pragma unroll
                for (int ks = 0; ks < 4; ++ks) { const bf16x8 bb = *(const LAS bf16x8*)(Cm + (16 * tt + fr) * 136 + ks * 32 + 8 * fq); d2 = mfma16(a2[ks], bb, d2); }
                const int t = 16 * tt + fr; const float et = ecum[t]; float yv[4];
#pragma unroll
                for (int j = 0; j < 4; ++j) { const int p = 16 * pt + 4 * fq + j; yv[j] = d1[j] + et * d2[j] + dsk * bf2f((unsigned)Xt[p * 72 + t]); }
                u32x2 w; w.x = pk2(yv[0], yv[1]); w.y = pk2(yv[2], yv[3]);
                *(u32x2*)(Y + (size_t)(row0 + t) * DI + h * 64 + 16 * pt + 4 * fq) = w;
            }
            bf16x8 a3[2];
#pragma unroll
            for (int ks = 0; ks < 2; ++ks) a3[ks] = *(const LAS bf16x8*)(Btw + (16 * wave + fr) * 72 + ks * 32 + 8 * fq);
            const float dec = ecum[63];
#pragma unroll
            for (int p4 = 0; p4 < 4; ++p4) { f32x4 d = {0.f, 0.f, 0.f, 0.f};
#pragma unroll
                for (int ks = 0; ks < 2; ++ks) { const bf16x8 bb = *(const LAS bf16x8*)(Xt + (16 * p4 + fr) * 72 + ks * 32 + 8 * fq); d = mfma16(a3[ks], bb, d); }
                hst[p4] = hst[p4] * dec + d; }
        }
    }
    float* so = A.out + O_SSP + ((size_t)b * 32 + h) * 64 * 128;
#pragma unroll
    for (int p4 = 0; p4 < 4; ++p4) *(f32x4*)(so + (size_t)(16 * p4 + fr) * 128 + 16 * wave + 4 * fq) = hst[p4];
    __syncthreads();
}

__device__ __forceinline__ void ssd_sample_item(const Args& A, LAS unsigned char* wl, int b, int h, int lane) {
    const bf16_t* XC = (const bf16_t*)(A.ws + WS_XC); const float* SMF = (const float*)(A.ws + WS_SMF); bf16_t* Y = (bf16_t*)(A.ws + WS_Y);
    LAS float* red = (LAS float*)wl;
    const int g = h >> 3;
    const float Ah = -expf(A.in[I_ALOG][h]), dtb = A.in[I_DTB][h], dsk = A.in[I_DSKIP][h];
#pragma unroll 1
    for (int half = 0; half < 2; ++half) {
        const float* h0 = A.in[I_SSSM] + (((size_t)b * 32 + h) * 64 + 32 * half) * 128 + 2 * lane;
        float st[32][2];
#pragma unroll
        for (int p = 0; p < 32; ++p) { const float2 v = *(const float2*)(h0 + p * 128); st[p][0] = v.x; st[p][1] = v.y; }
#pragma unroll 1
        for (int t = 0; t < 4; ++t) {
            const size_t m = (size_t)(MP + b * 4 + t);
            const float dt = softplusf_(SMF[m * 128 + h] + dtb), dec = expf(dt * Ah);
            const unsigned bw = *(const unsigned*)(XC + m * XCW + 2048 + g * 128 + 2 * lane), cw = *(const unsigned*)(XC + m * XCW + 2560 + g * 128 + 2 * lane);
            const float b0 = bf2f(bw & 0xffffu) * dt, b1 = __uint_as_float(bw & 0xffff0000u) * dt, c0 = bf2f(cw & 0xffffu), c1 = __uint_as_float(cw & 0xffff0000u);
            const float xl = bf2f((unsigned)XC[m * XCW + h * 64 + 32 * half + (lane & 31)]);
#pragma unroll
            for (int p = 0; p < 32; ++p) {
                const float xp = __shfl(xl, p);
                st[p][0] = st[p][0] * dec + xp * b0; st[p][1] = st[p][1] * dec + xp * b1;
                red[p * 65 + lane] = st[p][0] * c0 + st[p][1] * c1;
            }
            asm volatile("s_waitcnt lgkmcnt(0)" ::: "memory");
            float y = 0.f;
#pragma unroll 16
            for (int i = 0; i < 64; ++i) y += red[(lane & 31) * 65 + i];
            y += dsk * xl;
            if (lane < 32) Y[m * DI + h * 64 + 32 * half + lane] = (bf16_t)f2bf(y);
            asm volatile("s_waitcnt lgkmcnt(0)" ::: "memory");
        }
        float* so = A.out + O_SSS + (((size_t)b * 32 + h) * 64 + 32 * half) * 128 + 2 * lane;
#pragma unroll
        for (int p = 0; p < 32; ++p) *(float2*)(so + p * 128) = make_float2(st[p][0], st[p][1]);
    }
}

__device__ __forceinline__ int t5_bucket(int n) {
    if (n < 16) return n;
    const float nf = (float)n;
    int large = 16 + (int)(logf(nf / 16.0f) / 2.0794415416798357f * 16.0f);
    return large < 31 ? large : 31;
}
typedef float f32x16 __attribute__((ext_vector_type(16)));
__device__ __forceinline__ f32x16 mfma32(bf16x8 a, bf16x8 b, f32x16 c) { return __builtin_amdgcn_mfma_f32_32x32x16_bf16(a, b, c, 0, 0, 0); }
constexpr float LOG2E = 1.4426950408889634f;
constexpr int AK_STR = 72, AV_STR = 68, ATK_T = 64 * AK_STR * 2, ATV_T = 64 * AV_STR * 2, AT_K0 = 0, AT_V0 = 4 * ATK_T, AT_WS = AT_V0 + 4 * ATV_T;
struct AttStage { u32x4 k0, v0, k1, v1, m; };
__device__ __forceinline__ void att_issue(AttStage& R, const bf16_t* src, const unsigned* msrc) {
    const bf16_t* src1 = src + (size_t)64 * NP;
    asm volatile("global_load_dwordx4 %0, %5, off\n\tglobal_load_dwordx4 %1, %5, off offset:512\n\tglobal_load_dwordx4 %2, %6, off\n\tglobal_load_dwordx4 %3, %6, off offset:512\n\tglobal_load_dwordx4 %4, %7, off"
                 : "=&v"(R.k0), "=&v"(R.v0), "=&v"(R.k1), "=&v"(R.v1), "=&v"(R.m) : "v"(src), "v"(src1), "v"(msrc) : "memory");
}
__device__ __forceinline__ void att_wait(AttStage& R) { asm volatile("s_waitcnt vmcnt(0)" : "+v"(R.k0), "+v"(R.v0), "+v"(R.k1), "+v"(R.v1), "+v"(R.m) :: "memory"); }
__device__ __forceinline__ void att_stage_write1(const u32x4 k, const u32x4 v, LAS bf16_t* Kb, LAS bf16_t* Vb, int skey, int sdch) {
    *(LAS u32x4*)(Kb + skey * AK_STR + sdch * 8) = k;
#pragma unroll
    for (int e = 0; e < 4; ++e) { Vb[(sdch * 8 + 2 * e) * AV_STR + skey] = (bf16_t)(v[e] & 0xffffu); Vb[(sdch * 8 + 2 * e + 1) * AV_STR + skey] = (bf16_t)(v[e] >> 16); }
}
struct AttState { f32x16 O0, O1; float m_run, l_run; };
__device__ __forceinline__ void att_tile(AttState& st, const LAS bf16_t* Kb, const LAS bf16_t* Vb, const bf16x8 (&qf)[4], unsigned mw0, unsigned mw1, bool far, float bfar, const LAS float* bl  ,
                                         int rb  , LAS float* wsc, int r32, int hi) {
    const unsigned w0 = mw0 >> (4 * hi), w1 = mw1 >> (4 * hi);
    f32x16 S0, S1;
#pragma unroll
    for (int i = 0; i < 16; ++i) { S0[i] = 0.f; S1[i] = 0.f; }
#pragma unroll
    for (int ds = 0; ds < 4; ++ds) {
        const bf16x8 k0 = *(const LAS bf16x8*)(Kb + r32 * AK_STR + 16 * ds + 8 * hi), k1 = *(const LAS bf16x8*)(Kb + (32 + r32) * AK_STR + 16 * ds + 8 * hi);
        S0 = mfma32(k0, qf[ds], S0); S1 = mfma32(k1, qf[ds], S1);
    }
    const float c1 = 0.125f * LOG2E;
    if (far) {
#pragma unroll
        for (int i = 0; i < 16; ++i) { const unsigned bit = 1u << ((i & 3) + 8 * (i >> 2));
            S0[i] = (w0 & bit) ? S0[i] * c1 + bfar : -INFINITY; S1[i] = (w1 & bit) ? S1[i] * c1 + bfar : -INFINITY; }
    } else {
        float bv0[16], bv1[16];
#pragma unroll
        for (int i = 0; i < 16; ++i) { const int pos = (i & 3) + 8 * (i >> 2);
            int r0 = rb - pos, r1 = r0 - 32; r0 = r0 < 0 ? 0 : (r0 > 128 ? 128 : r0); r1 = r1 < 0 ? 0 : (r1 > 128 ? 128 : r1);
            bv0[i] = bl[r0 * 16]; bv1[i] = bl[r1 * 16]; }
#pragma unroll
        for (int i = 0; i < 16; ++i) { const unsigned bit = 1u << ((i & 3) + 8 * (i >> 2));
            const float x0 = S0[i] * c1 + bv0[i], x1 = S1[i] * c1 + bv1[i];
            S0[i] = (w0 & bit) ? x0 : -INFINITY; S1[i] = (w1 & bit) ? x1 : -INFINITY; }
    }
    float tm = fmaxf(S0[0], S1[0]);
#pragma unroll
    for (int i = 1; i < 16; ++i) tm = fmaxf(tm, fmaxf(S0[i], S1[i]));
    tm = fmaxf(tm, __shfl_xor(tm, 32));
    if (__any(tm > st.m_run + 8.0f)) {
        const float mn = fmaxf(st.m_run, tm), f = __builtin_amdgcn_exp2f(st.m_run - mn);
        st.m_run = mn; st.l_run *= f;
        if (hi == 0) wsc[r32] = f;
        asm volatile("s_waitcnt lgkmcnt(0)" ::: "memory");
#pragma unroll
        for (int i = 0; i < 16; ++i) { const float fi = wsc[(i & 3) + 8 * (i >> 2) + 4 * hi]; st.O0[i] *= fi; st.O1[i] *= fi; }
        asm volatile("s_waitcnt lgkmcnt(0)" ::: "memory");
    }
    float ls = 0.f; const float mr = st.m_run;
#pragma unroll
    for (int i = 0; i < 16; ++i) { S0[i] = __builtin_amdgcn_exp2f(S0[i] - mr); S1[i] = __builtin_amdgcn_exp2f(S1[i] - mr); ls += S0[i] + S1[i]; }
    st.l_run += ls;
    bf16x8 pa[2][2];
#pragma unroll
    for (int sk = 0; sk < 2; ++sk) {
        u32x4 a0, a1;
        a0.x = pk2(S0[8 * sk + 0], S0[8 * sk + 1]); a0.y = pk2(S0[8 * sk + 2], S0[8 * sk + 3]); a0.z = pk2(S0[8 * sk + 4], S0[8 * sk + 5]); a0.w = pk2(S0[8 * sk + 6], S0[8 * sk + 7]);
        a1.x = pk2(S1[8 * sk + 0], S1[8 * sk + 1]); a1.y = pk2(S1[8 * sk + 2], S1[8 * sk + 3]); a1.z = pk2(S1[8 * sk + 4], S1[8 * sk + 5]); a1.w = pk2(S1[8 * sk + 6], S1[8 * sk + 7]);
        pa[0][sk] = __builtin_bit_cast(bf16x8, a0); pa[1][sk] = __builtin_bit_cast(bf16x8, a1);
    }
#pragma unroll
    for (int blk = 0; blk < 2; ++blk)
#pragma unroll
        for (int sk = 0; sk < 2; ++sk) {
            const int kb = 32 * blk + 16 * sk + 4 * hi;
            const u32x2 a = *(const LAS u32x2*)(Vb + r32 * AV_STR + kb), c = *(const LAS u32x2*)(Vb + r32 * AV_STR + kb + 8);
            const u32x2 a2 = *(const LAS u32x2*)(Vb + (32 + r32) * AV_STR + kb), c2 = *(const LAS u32x2*)(Vb + (32 + r32) * AV_STR + kb + 8);
            const u32x4 v0 = {a.x, a.y, c.x, c.y}, v1 = {a2.x, a2.y, c2.x, c2.y};
            st.O0 = mfma32(pa[blk][sk], __builtin_bit_cast(bf16x8, v0), st.O0);
            st.O1 = mfma32(pa[blk][sk], __builtin_bit_cast(bf16x8, v1), st.O1);
        }
}
__device__ __forceinline__ void attn_prompt_unit(const Args& A, LAS unsigned char* lds, const LAS float* biasL, int b, int g, int qt, int wave, int lane_in) {
    const bf16_t* P = (const bf16_t*)(A.ws + WS_P); const unsigned* MASK32 = (const unsigned*)(A.ws + WS_SC); bf16_t* YA = (bf16_t*)(A.ws + WS_YA);
    int lane = lane_in; asm volatile("" : "+v"(lane));
    const int tid = wave * 64 + lane, r32 = lane & 31, hi = lane >> 5;
    LAS float* wsc = (LAS float*)(lds + AT_WS) + wave * 64;
    const int query = qt * 64 + 8 * wave + (r32 >> 2), head = 4 * g + (r32 & 3);
    const size_t qrow = (size_t)(b * 2048 + query);
    bf16x8 qf[4];
#pragma unroll
    for (int ds = 0; ds < 4; ++ds) qf[ds] = *(const bf16x8*)(P + qrow * NP + PQ + head * 64 + 16 * ds + 8 * hi);
    const unsigned* mrow = MASK32 + qrow * 64;
    float bfar = biasL[128 * 16 + head];
    const LAS float* bl = biasL + head;
    asm volatile("" : "+v"(qf[0]), "+v"(qf[1]), "+v"(qf[2]), "+v"(qf[3]), "+v"(bfar));
    const int skey = tid >> 3, sdch = tid & 7;
    const bf16_t* ksrc = P + (size_t)(b * 2048 + skey) * NP + PK + g * 64 + sdch * 8;
    AttState st;
#pragma unroll
    for (int i = 0; i < 16; ++i) { st.O0[i] = 0.f; st.O1[i] = 0.f; }
    st.m_run = -1e30f; st.l_run = 0.f;
    const int nstep = (qt + 2) >> 1;
    AttStage R;
    att_issue(R, ksrc, mrow);
    att_wait(R);
    att_stage_write1(R.k0, R.v0, (LAS bf16_t*)(lds + AT_K0), (LAS bf16_t*)(lds + AT_V0), skey, sdch);
    att_stage_write1(R.k1, R.v1, (LAS bf16_t*)(lds + AT_K0 + ATK_T), (LAS bf16_t*)(lds + AT_V0 + ATV_T), skey, sdch);
    u32x4 mw = R.m;
    for (int j = 0; j < nstep; ++j) {
        const int buf = j & 1, kt = 2 * j;
        __syncthreads();
        { const int jn = (j + 1 < nstep) ? j + 1 : j; att_issue(R, ksrc + (size_t)jn * 128 * NP, mrow + 4 * jn); }
        const LAS bf16_t* Kb = (const LAS bf16_t*)(lds + AT_K0 + buf * (2 * ATK_T)); const LAS bf16_t* Vb = (const LAS bf16_t*)(lds + AT_V0 + buf * (2 * ATV_T));
        att_tile(st, Kb, Vb, qf, mw[0], mw[1], qt - kt >= 3, bfar, bl, query - (kt * 64 + 4 * hi), wsc, r32, hi);
        if (kt + 1 <= qt) att_tile(st, (const LAS bf16_t*)((const LAS unsigned char*)Kb + ATK_T), (const LAS bf16_t*)((const LAS unsigned char*)Vb + ATV_T), qf, mw[2], mw[3], qt - kt - 1 >= 3, bfar, bl, query - ((kt + 1) * 64 + 4 * hi), wsc, r32, hi);
        att_wait(R);
        if (j + 1 < nstep) {
            LAS bf16_t* Kn = (LAS bf16_t*)(lds + AT_K0 + (buf ^ 1) * (2 * ATK_T)); LAS bf16_t* Vn = (LAS bf16_t*)(lds + AT_V0 + (buf ^ 1) * (2 * ATV_T));
            att_stage_write1(R.k0, R.v0, Kn, Vn, skey, sdch);
            att_stage_write1(R.k1, R.v1, (LAS bf16_t*)((LAS unsigned char*)Kn + ATK_T), (LAS bf16_t*)((LAS unsigned char*)Vn + ATV_T), skey, sdch);
        }
        mw = R.m;
    }
    st.l_run += __shfl_xor(st.l_run, 32);
    if (hi == 0) wsc[r32] = 1.0f / st.l_run;
    asm volatile("s_waitcnt lgkmcnt(0)" ::: "memory");
#pragma unroll
    for (int i = 0; i < 16; ++i) {
        const int rq = (i & 3) + 8 * (i >> 2) + 4 * hi; const float inv = wsc[rq];
        bf16_t* dst = YA + (size_t)(b * 2048 + qt * 64 + 8 * wave + (rq >> 2)) * D + (4 * g + (rq & 3)) * 64 + r32;
        dst[0] = (bf16_t)f2bf(st.O0[i] * inv); dst[32] = (bf16_t)f2bf(st.O1[i] * inv);
    }
    __syncthreads();
}

__device__ __forceinline__ void attend_sample_task(const Args& A, LAS unsigned char* wl, const LAS float* biasrel, int ms, int g, int lane_in) {
    constexpr int NJ = 33;
    int lane = lane_in; asm volatile("" : "+v"(lane));
    const bf16_t* P = (const bf16_t*)(A.ws + WS_P);
    const int b = ms >> 2, t = ms & 3, nvalid = 2049 + t, qpos = 2048 + t, m = MP + ms;
    const float* srow = (const float*)(A.ws + WS_SCS) + (size_t)ms * SCSW;
    LAS float* pq = (LAS float*)wl;
    LAS unsigned* rowid = (LAS unsigned*)(wl + 4096);
    LAS unsigned short* posl = (LAS unsigned short*)(wl + 4096 + 1024);
    unsigned key[NJ];
#pragma unroll
    for (int j = 0; j < NJ; ++j) key[j] = (lane < nvalid - 64 * j) ? f2key(srow[lane + 64 * j]) : 0u;
    unsigned T = 0u; int need_eq = 0;
    {
        bool exact = false;
        for (int bit = 31; bit >= 0; --bit) {
            const unsigned cand = T | (1u << bit); int cnt = 0;
#pragma unroll
            for (int j = 0; j < NJ; ++j) cnt += __popcll(__ballot(key[j] >= cand));
            if (cnt >= 256) { T = cand; if (cnt == 256) { exact = true; break; } }
        }
        if (exact) { T -= 1u; }
        else { int cgt = 0;
#pragma unroll
            for (int j = 0; j < NJ; ++j) cgt += __popcll(__ballot(key[j] > T));
            need_eq = 256 - cgt; }
    }
    int base = 0, eqused = 0;
    const int* pt = (const int*)A.in[I_PT];
#pragma unroll
    for (int j = 0; j < NJ; ++j) {
        const bool gt = key[j] > T, eq = (need_eq > 0) && (key[j] == T);
        const unsigned long long meq = __ballot(eq);
        const bool sel = gt || (eq && (eqused + mbcnt64(meq) < need_eq));
        eqused += __popcll(meq);
        const unsigned long long msk = __ballot(sel);
        if (sel) { const int pos = lane + 64 * j, k = base + mbcnt64(msk);
            posl[k] = (unsigned short)pos;
            rowid[k] = (pos < 2048) ? (unsigned)(pt[b * 16 + (pos >> 7)] * 128 + (pos & 127)) : (0x80000000u | (unsigned)(b * 4 + pos - 2048)); }
        base += __popcll(msk);
    }
    { const u32x2 w = *(const u32x2*)(P + (size_t)m * NP + PQ + g * 256 + lane * 4);
      *(LAS f32x4*)(pq + lane * 4) = (f32x4){__uint_as_float(w.x << 16), __uint_as_float(w.x & 0xffff0000u), __uint_as_float(w.y << 16), __uint_as_float(w.y & 0xffff0000u)}; }
    asm volatile("s_waitcnt lgkmcnt(0)" ::: "memory");
    const float* ck = A.in[I_CK]; const float* cv = A.in[I_CV]; const float* kn = A.out + O_KS; const float* vn = A.out + O_VS;
    const float* kp[4]; int rel[4];
#pragma unroll
    for (int i = 0; i < 4; ++i) { const unsigned rid = rowid[lane + 64 * i]; rel[i] = qpos - (int)posl[lane + 64 * i];
        kp[i] = ((rid & 0x80000000u) ? kn + (size_t)(rid & 0x7fffffffu) * 256 : ck + (size_t)rid * 256) + g * 64; }
    float acc[4][4];
#pragma unroll
    for (int i = 0; i < 4; ++i)
#pragma unroll
        for (int hh = 0; hh < 4; ++hh) acc[i][hh] = 0.f;
#pragma unroll 2
    for (int dc = 0; dc < 16; ++dc) {
        f32x4 kv[4];
#pragma unroll
        for (int i = 0; i < 4; ++i) kv[i] = *(const f32x4*)(kp[i] + dc * 4);
#pragma unroll
        for (int hh = 0; hh < 4; ++hh) { const f32x4 q4 = *(const LAS f32x4*)(pq + hh * 64 + dc * 4);
#pragma unroll
            for (int i = 0; i < 4; ++i) acc[i][hh] += kv[i][0] * q4[0] + kv[i][1] * q4[1] + kv[i][2] * q4[2] + kv[i][3] * q4[3]; }
    }
    asm volatile("s_waitcnt lgkmcnt(0)" ::: "memory");
#pragma unroll
    for (int i = 0; i < 4; ++i) { const int rc = rel[i] < 128 ? (rel[i] < 0 ? 0 : rel[i]) : 128; const f32x4 bv = *(const LAS f32x4*)(biasrel + rc * 16 + 4 * g);
#pragma unroll
        for (int hh = 0; hh < 4; ++hh) acc[i][hh] = acc[i][hh] * 0.125f + bv[hh]; }
#pragma unroll
    for (int hh = 0; hh < 4; ++hh) {
        const float mx = wave_max(fmaxf(fmaxf(acc[0][hh], acc[1][hh]), fmaxf(acc[2][hh], acc[3][hh])));
        float sm = 0.f;
#pragma unroll
        for (int i = 0; i < 4; ++i) { acc[i][hh] = __expf(acc[i][hh] - mx); sm += acc[i][hh]; }
        const float inv = 1.0f / wave_sum(sm);
#pragma unroll
        for (int i = 0; i < 4; ++i) acc[i][hh] *= inv;
    }
#pragma unroll
    for (int i = 0; i < 4; ++i) *(LAS f32x4*)(pq + (lane + 64 * i) * 4) = (f32x4){acc[i][0], acc[i][1], acc[i][2], acc[i][3]};
    asm volatile("s_waitcnt lgkmcnt(0)" ::: "memory");
    float o[4] = {0.f, 0.f, 0.f, 0.f};
    for (int k0 = 0; k0 < 256; k0 += 8) {
        float vv[8]; f32x4 pp[8];
#pragma unroll
        for (int u = 0; u < 8; ++u) { const unsigned rid = rowid[k0 + u];
            const float* vp = ((rid & 0x80000000u) ? vn + (size_t)(rid & 0x7fffffffu) * 256 : cv + (size_t)rid * 256) + g * 64 + lane;
            vv[u] = *vp; pp[u] = *(const LAS f32x4*)(pq + (k0 + u) * 4); }
#pragma unroll
        for (int u = 0; u < 8; ++u)
#pragma unroll
            for (int hh = 0; hh < 4; ++hh) o[hh] += pp[u][hh] * vv[u];
    }
    bf16_t* YA = (bf16_t*)(A.ws + WS_YA);
#pragma unroll
    for (int hh = 0; hh < 4; ++hh) YA[(size_t)m * D + (4 * g + hh) * 64 + lane] = (bf16_t)f2bf(o[hh]);
    asm volatile("s_waitcnt lgkmcnt(0)" ::: "memory");
}

#if MK_CHECK_ATT
constexpr size_t WS_CHK_SC = WS_END, WS_CHK_YA = WS_CHK_SC + 128 * MiB, WS_CHK_MASK = WS_CHK_YA + 33 * MiB, WS_CHK_END = WS_CHK_MASK + 4 * MiB;
constexpr int CW_CHK = 512;
template <bool SAMPLE> struct KVRow;
template <> struct KVRow<false> {
    typedef const bf16_t* ptr;
    const bf16_t* P;
    __device__ __forceinline__ ptr krow(unsigned rid) const { return P + (size_t)rid * NP + PK; }
    __device__ __forceinline__ ptr vrow(unsigned rid) const { return P + (size_t)rid * NP + PV; }
    static __device__ __forceinline__ void k8(ptr p, float (&f)[8]) { unpack8(*(const u32x4*)p, f); }
    static __device__ __forceinline__ f32x4 v4(ptr p) { const u32x2 w = *(const u32x2*)p;
        return (f32x4){__uint_as_float(w.x << 16), __uint_as_float(w.x & 0xffff0000u), __uint_as_float(w.y << 16), __uint_as_float(w.y & 0xffff0000u)}; }
};
template <> struct KVRow<true> {
    typedef const float* ptr;
    const float* ck; const float* cv; const float* kn; const float* vn;
    __device__ __forceinline__ ptr krow(unsigned rid) const { return (rid & 0x80000000u) ? kn + (size_t)(rid & 0x7fffffffu) * 256 : ck + (size_t)rid * 256; }
    __device__ __forceinline__ ptr vrow(unsigned rid) const { return (rid & 0x80000000u) ? vn + (size_t)(rid & 0x7fffffffu) * 256 : cv + (size_t)rid * 256; }
    static __device__ __forceinline__ void k8(ptr p, float (&f)[8]) { const f32x4 a = *(const f32x4*)p, b = *(const f32x4*)(p + 4);
#pragma unroll
        for (int i = 0; i < 4; ++i) { f[i] = a[i]; f[4 + i] = b[i]; } }
    static __device__ __forceinline__ f32x4 v4(ptr p) { return *(const f32x4*)p; }
};

template <bool SAMPLE>
__device__ __forceinline__ void attend_query(const Args& A, LAS unsigned char* wl, const LAS float* biasrel, int m, int lane_in) {
    constexpr int NJ = SAMPLE ? 33 : 32;
    int lane = lane_in; asm volatile("" : "+v"(lane));
    const bf16_t* P = (const bf16_t*)(A.ws + WS_P);
    int b, nvalid, qpos; const float* srow;
    if (!SAMPLE) { b = m >> 11; const int t = m & 2047; nvalid = t + 1; qpos = t; srow = (const float*)(A.ws + WS_CHK_SC) + (size_t)m * SCW; }
    else { const int ms = m - MP; b = ms >> 2; const int t = ms & 3; nvalid = 2049 + t; qpos = 2048 + t; srow = (const float*)(A.ws + WS_SCS) + (size_t)ms * SCSW; }
    LAS float* pq = (LAS float*)wl;
    LAS unsigned* rowid = (LAS unsigned*)(wl + 16384);
    LAS unsigned short* posl = (LAS unsigned short*)(wl + 16384 + 1024);
    unsigned key[NJ];
#pragma unroll
    for (int j = 0; j < NJ; ++j) { key[j] = (lane < nvalid - 64 * j) ? f2key(srow[lane + 64 * j]) : 0u; }
    unsigned T = 0u; int need_eq = 0;
    if (nvalid > 256) {
        for (int bit = 31; bit >= 0; --bit) {
            const unsigned cand = T | (1u << bit); int cnt = 0;
#pragma unroll
            for (int j = 0; j < NJ; ++j) cnt += __popcll(__ballot(key[j] >= cand));
            if (cnt >= 256) T = cand;
        }
        int cgt = 0;
#pragma unroll
        for (int j = 0; j < NJ; ++j) cgt += __popcll(__ballot(key[j] > T));
        need_eq = 256 - cgt;
    }
    int base = 0, eqused = 0; unsigned long long mine_chk = 0ull;
    const int* pt = (const int*)A.in[I_PT];
#pragma unroll
    for (int j = 0; j < NJ; ++j) {
        const bool gt = key[j] > T, eq = (need_eq > 0) && (key[j] == T);
        const unsigned long long meq = __ballot(eq);
        const bool sel = gt || (eq && (eqused + mbcnt64(meq) < need_eq));
        eqused += __popcll(meq);
        const unsigned long long ms = __ballot(sel);
        if (sel) { const int pos = lane + 64 * j, k = base + mbcnt64(ms);
            posl[k] = (unsigned short)pos;
            unsigned rid;
            if (!SAMPLE) rid = (unsigned)(b * 2048 + pos);
            else rid = (pos < 2048) ? (unsigned)(pt[b * 16 + (pos >> 7)] * 128 + (pos & 127)) : (0x80000000u | (unsigned)(b * 4 + pos - 2048));
            rowid[k] = rid; }
        base += __popcll(ms);
        if (!SAMPLE) { if (lane == j) mine_chk = ms; }
    }
    if (!SAMPLE) { if (lane < 32) ((unsigned long long*)(A.ws + WS_CHK_MASK))[(size_t)m * 32 + lane] = mine_chk; }
    const int nsel = base;
    asm volatile("s_waitcnt lgkmcnt(0)" ::: "memory");
    { const unsigned r0 = rowid[0]; const unsigned short p0 = posl[0];
#pragma unroll
      for (int i = 0; i < 4; ++i) { const int k = lane + 64 * i; if (k >= nsel) { rowid[k] = r0; posl[k] = p0; } } }
    { const u32x4 w0 = *(const u32x4*)(P + (size_t)m * NP + PQ + lane * 16), w1 = *(const u32x4*)(P + (size_t)m * NP + PQ + lane * 16 + 8);
      float f0[8], f1[8]; unpack8(w0, f0); unpack8(w1, f1);
#pragma unroll
      for (int e = 0; e < 8; ++e) { pq[lane * 16 + e] = f0[e]; pq[lane * 16 + 8 + e] = f1[e]; } }
    asm volatile("s_waitcnt lgkmcnt(0)" ::: "memory");
    KVRow<SAMPLE> R;
    if constexpr (!SAMPLE) { R.P = P; } else { R.ck = A.in[I_CK]; R.cv = A.in[I_CV]; R.kn = A.out + O_KS; R.vn = A.out + O_VS; }
    typename KVRow<SAMPLE>::ptr kp[4]; int rel[4];
#pragma unroll
    for (int i = 0; i < 4; ++i) { kp[i] = R.krow(rowid[lane + 64 * i]); rel[i] = qpos - (int)posl[lane + 64 * i]; }
    float acc[4][16];
#pragma unroll
    for (int i = 0; i < 4; ++i)
#pragma unroll
        for (int hh = 0; hh < 16; ++hh) acc[i][hh] = 0.f;
#pragma unroll
    for (int g = 0; g < 4; ++g) {
#pragma unroll 1
        for (int dc = 0; dc < 8; ++dc) {
            float kv[4][8];
#pragma unroll
            for (int i = 0; i < 4; ++i) KVRow<SAMPLE>::k8(kp[i] + g * 64 + dc * 8, kv[i]);
#pragma unroll
            for (int hh = 0; hh < 4; ++hh) {
                const f32x4 q0 = *(const LAS f32x4*)(pq + (4 * g + hh) * 64 + dc * 8), q1 = *(const LAS f32x4*)(pq + (4 * g + hh) * 64 + dc * 8 + 4);
#pragma unroll
                for (int i = 0; i < 4; ++i) {
                    float a = acc[i][4 * g + hh];
#pragma unroll
                    for (int e = 0; e < 4; ++e) { a += kv[i][e] * q0[e]; a += kv[i][4 + e] * q1[e]; }
                    acc[i][4 * g + hh] = a; }
            }
        }
    }
    asm volatile("s_waitcnt lgkmcnt(0)" ::: "memory");
#pragma unroll
    for (int i = 0; i < 4; ++i) {
        const bool valid = (lane + 64 * i) < nsel; const int rc = rel[i] < 128 ? (rel[i] < 0 ? 0 : rel[i]) : 128;
#pragma unroll
        for (int h4 = 0; h4 < 4; ++h4) { const f32x4 bv = *(const LAS f32x4*)(biasrel + rc * 16 + 4 * h4);
#pragma unroll
            for (int e = 0; e < 4; ++e) acc[i][4 * h4 + e] = valid ? acc[i][4 * h4 + e] * 0.125f + bv[e] : -INFINITY; }
    }
#pragma unroll
    for (int hh = 0; hh < 16; ++hh) {
        const float mx = wave_max(fmaxf(fmaxf(acc[0][hh], acc[1][hh]), fmaxf(acc[2][hh], acc[3][hh])));
        float s = 0.f;
#pragma unroll
        for (int i = 0; i < 4; ++i) { acc[i][hh] = __expf(acc[i][hh] - mx); s += acc[i][hh]; }
        const float inv = 1.0f / wave_sum(s);
#pragma unroll
        for (int i = 0; i < 4; ++i) acc[i][hh] *= inv;
    }
#pragma unroll
    for (int i = 0; i < 4; ++i)
#pragma unroll
        for (int h4 = 0; h4 < 4; ++h4) *(LAS f32x4*)(pq + (lane + 64 * i) * 16 + 4 * h4) = (f32x4){acc[i][4 * h4], acc[i][4 * h4 + 1], acc[i][4 * h4 + 2], acc[i][4 * h4 + 3]};
    asm volatile("s_waitcnt lgkmcnt(0)" ::: "memory");
    const int g = lane >> 4;
    f32x4 o[4];
#pragma unroll
    for (int hh = 0; hh < 4; ++hh) o[hh] = (f32x4){0.f, 0.f, 0.f, 0.f};
    const int nloop = (nsel + 3) & ~3;
    for (int k0 = 0; k0 < nloop; k0 += 4) {
        f32x4 vv[4], pp[4];
#pragma unroll
        for (int u = 0; u < 4; ++u) { const unsigned r = rowid[k0 + u]; vv[u] = KVRow<SAMPLE>::v4(R.vrow(r) + lane * 4); pp[u] = *(const LAS f32x4*)(pq + (k0 + u) * 16 + 4 * g); }
#pragma unroll
        for (int u = 0; u < 4; ++u)
#pragma unroll
            for (int hh = 0; hh < 4; ++hh) o[hh] += vv[u] * pp[u][hh];
    }
    bf16_t* YA = (bf16_t*)(A.ws + WS_CHK_YA);
#pragma unroll
    for (int hh = 0; hh < 4; ++hh) { u32x2 w; w.x = pk2(o[hh][0], o[hh][1]); w.y = pk2(o[hh][2], o[hh][3]);
        *(u32x2*)(YA + (size_t)m * D + (4 * g + hh) * 64 + (lane & 15) * 4) = w; }
    asm volatile("s_waitcnt lgkmcnt(0)" ::: "memory");
}


__device__ __forceinline__ void check_compare(const Args& A, int gw, int NGW, int lane) {
    const bf16_t* Y1 = (const bf16_t*)(A.ws + WS_YA); const bf16_t* Y2 = (const bf16_t*)(A.ws + WS_CHK_YA); unsigned* ctl = (unsigned*)(A.ws + WS_CTL);
    for (int m = gw; m < MP; m += NGW) {
        float e = 0.f, n = 0.f;
#pragma unroll
        for (int j = 0; j < 2; ++j) { float a[8], b[8]; unpack8(*(const u32x4*)(Y1 + (size_t)m * D + j * 512 + lane * 8), a); unpack8(*(const u32x4*)(Y2 + (size_t)m * D + j * 512 + lane * 8), b);
#pragma unroll
            for (int i = 0; i < 8; ++i) { const float d = a[i] - b[i]; e += d * d; n += b[i] * b[i]; } }
        e = wave_sum(e); n = wave_sum(n);
        { const unsigned long long w1 = (lane < 32) ? ((const unsigned long long*)(A.ws + WS_SC))[(size_t)m * 32 + lane] : 0ull, w2 = (lane < 32) ? ((const unsigned long long*)(A.ws + WS_CHK_MASK))[(size_t)m * 32 + lane] : 0ull;
          if (__any(w1 != w2) && lane == 0) atomicAdd(ctl + CW_CHK + 3, 1u);
          const int t = m & 2047;
          if (t >= 256) {
              const float* srow = (const float*)(A.ws + WS_CHK_SC) + (size_t)m * SCW;
              int c1 = 0, c2 = 0; float mins1 = INFINITY, maxu1 = -INFINITY, mins2 = INFINITY, maxu2 = -INFINITY;
              for (int j = 0; j < 32; ++j) { const int sp = lane + 64 * j; if (64 * j > t) break;
                  const unsigned long long a1 = __shfl((unsigned long long)w1, j), a2 = __shfl((unsigned long long)w2, j);
                  if (sp <= t) { const float v = srow[sp]; const bool s1 = (a1 >> lane) & 1ull, s2 = (a2 >> lane) & 1ull;
                      if (s1) { ++c1; mins1 = fminf(mins1, v); } else maxu1 = fmaxf(maxu1, v);
                      if (s2) { ++c2; mins2 = fminf(mins2, v); } else maxu2 = fmaxf(maxu2, v); } }
              c1 = (int)wave_sum((float)c1); c2 = (int)wave_sum((float)c2);
              mins1 = -wave_max(-mins1); mins2 = -wave_max(-mins2); maxu1 = wave_max(maxu1); maxu2 = wave_max(maxu2);
              if (lane == 0) { if (c1 != 256 || mins1 < maxu1) atomicAdd(ctl + CW_CHK + 4, 1u); if (c2 != 256 || mins2 < maxu2) atomicAdd(ctl + CW_CHK + 5, 1u); }
          } }
        if (lane == 0 && !(e <= MK_CHECK_TOL * MK_CHECK_TOL * n + 1e-12f)) { const int t = m & 2047; atomicAdd(ctl + CW_CHK + (t < 64 ? 0 : t < 256 ? 1 : 2), 1u); }
    }
}
#endif
__device__ __forceinline__ void gate_norm_phase(const Args& A, int gw, int NGW, int lane) {
    const bf16_t* P = (const bf16_t*)(A.ws + WS_P); bf16_t* Y = (bf16_t*)(A.ws + WS_Y); const float* ng = A.in[I_NORMG];
    for (int it = gw; it < M * 4; it += NGW) {
        const int m = it >> 2, ch = (it & 3) * 512 + lane * 8;
        float y[8], z[8]; unpack8(*(const u32x4*)(Y + (size_t)m * DI + ch), y); unpack8(*(const u32x4*)(P + (size_t)m * NP + PZ + ch), z);
        float ss = 0.f;
#pragma unroll
        for (int i = 0; i < 8; ++i) { y[i] *= siluf_(z[i]); ss += y[i] * y[i]; }
        const float r = 1.0f / sqrtf(wave_sum(ss) * (1.f / 512.f) + LN_EPS);
        const f32x4 g0 = *(const f32x4*)(ng + ch), g1 = *(const f32x4*)(ng + ch + 4);
#pragma unroll
        for (int i = 0; i < 4; ++i) { y[i] = y[i] * r * g0[i]; y[4 + i] = y[4 + i] * r * g1[i]; }
        *(u32x4*)(Y + (size_t)m * DI + ch) = pack8(y);
    }
}

constexpr int NPHASE = 14;
__global__ void __launch_bounds__(NTHR, 2) fwd(Args args) {
    extern __shared__ __attribute__((aligned(16))) unsigned char lds_raw[];
    LAS unsigned char* lds = (LAS unsigned char*)lds_raw;
    const int tid = threadIdx.x, lane = tid & 63, wave = __builtin_amdgcn_readfirstlane(tid >> 6);
    const int G = gridDim.x, bx = blockIdx.x;
    const int vcu = (G % 8 == 0) ? (bx % 8) * (G / 8) + bx / 8 : bx;
    const int gw = vcu * NWAVES + wave, NGW = G * NWAVES;
    unsigned char* ws = args.ws;
    volatile LAS unsigned* MISC = (volatile LAS unsigned*)(lds + MISC_OFF);
    for (int u = tid; u < 64; u += NTHR) MISC[u] = 0u;
    __syncthreads();
    const int lo = args.ph_lo, hi = args.ph_hi;
    XcdBarrier bar; bar.bar = (unsigned*)(ws + WS_CTL) + CW_BAR; bar.x = 0; bar.st = nullptr;
    if (hi - lo > 1) bar = xcd_barrier_post((unsigned*)(ws + WS_CTL) + CW_BAR, MISC + 8);
#define IN(k) (lo <= (k) && (k) < hi)
#define SEAM(k) do { if (IN(k) && IN((k) + 1)) xcd_barrier(bar); } while (0)

    bf16_t* const XB = (bf16_t*)(ws + WS_XB); bf16_t* const ACT = (bf16_t*)(ws + WS_ACT); float* const T = (float*)(ws + WS_T);
    float* const HF = (float*)(ws + WS_HF); bf16_t* const HB = (bf16_t*)(ws + WS_HB); bf16_t* const P = (bf16_t*)(ws + WS_P);
    float* const SMF = (float*)(ws + WS_SMF); bf16_t* const Y = (bf16_t*)(ws + WS_Y); bf16_t* const YA = (bf16_t*)(ws + WS_YA); bf16_t* const MG = (bf16_t*)(ws + WS_MG);

    if (IN(0)) REPK(0) { p0_prologue(args, lds, gw, NGW, wave, lane); }
    SEAM(0);
    if (IN(1)) {
        { pg8::Gemm g{XB, (const bf16_t*)(ws + WS_W1A), M, 2 * DFF, D}; pg8::StaticOrder S; S.init(M, 2 * DFF, G, bx);
        EpiSwiglu E{ACT}; pg8::gemm_phase<EpiSwiglu, pg8::StaticOrder, true, true>(lds, g, S, E); }
        if constexpr (DUPK(1)) { pg8::Gemm g{XB, (const bf16_t*)(ws + WS_W1A), M, 2 * DFF, D}; pg8::StaticOrder S; S.init(M, 2 * DFF, G, bx);
        EpiSwiglu E{ACT}; pg8::gemm_phase<EpiSwiglu, pg8::StaticOrder, true, true>(lds, g, S, E); }
    }
    SEAM(1);
    if (IN(2)) {
        { pg8::Gemm g{ACT, (const bf16_t*)(ws + WS_W1B), MP, D, DFF}; pg8::StaticOrder S; S.init(MP, D, G, bx);
        EpiResid E{args.in[I_XP], args.in[I_XS], T, ALPHA, 0.5f}; pg8::gemm_phase<EpiResid, pg8::StaticOrder, true, true>(lds, g, S, E); }
        { SkResid E{args.in[I_XS], T, ALPHA, 0.5f}; skinny_gemm<DFF>(lds, ACT + (size_t)MP * DFF, (const bf16_t*)(ws + WS_W1B), E, bx, G, wave, lane); }
        if constexpr (DUPK(2)) { pg8::Gemm g{ACT, (const bf16_t*)(ws + WS_W1B), MP, D, DFF}; pg8::StaticOrder S; S.init(MP, D, G, bx);
        EpiResid E{args.in[I_XP], args.in[I_XS], T, ALPHA, 0.5f}; pg8::gemm_phase<EpiResid, pg8::StaticOrder, true, true>(lds, g, S, E); }
    }
    SEAM(2);
    if (IN(3)) REPK(3) { ln_phase(T, args.in[I_LN1G], args.in[I_LN1B], HF, HB, gw, NGW, lane); }
    SEAM(3);
    if (IN(4)) {
        { pg8::Gemm g{HB, (const bf16_t*)(ws + WS_WIN), M, NP, D}; pg8::StaticOrder S; S.init(M, NP, G, bx);
        EpiWin E{P, SMF, args.out}; pg8::gemm_phase<EpiWin, pg8::StaticOrder, true, true>(lds, g, S, E); }
        if constexpr (DUPK(4)) { pg8::Gemm g{HB, (const bf16_t*)(ws + WS_WIN), M, NP, D}; pg8::StaticOrder S; S.init(M, NP, G, bx);
        EpiWin E{P, SMF, args.out}; pg8::gemm_phase<EpiWin, pg8::StaticOrder, true, true>(lds, g, S, E); }
    }
    SEAM(4);
    if (IN(5)) REPK(5) {
        for (int rep = 0; rep < MK_REP_CONV; ++rep)
        conv_phase(args, gw, NGW, lane);
        for (int rep = 0; rep < MK_REP_SCP; ++rep)
        for (int u = bx; u < 1024; u += G) { const int i = u >> 8, c = u & 255, b = c >> 5, s = c & 31; const int qt = (i == 0) ? s : (i == 1) ? 63 - s : (i == 2) ? 64 + s : 127 - s;
            scores_select_prompt_unit(args, lds, b, qt, wave, lane); }
        for (int rep = 0; rep < MK_REP_SCS; ++rep)
        for (int u = bx; u < 256; u += G) scores_sample_unit(args, u >> 1, u & 1, wave, lane);
    }
    SEAM(5);
    if (IN(6)) {
        for (int rep = 0; rep < MK_REP_SSDP; ++rep)
        for (int it = bx; it < 256; it += G) ssd_prompt_item(args, lds, it >> 5, it & 31);
        __syncthreads();
        LAS float* biasrel = (LAS float*)(lds + BIASREL_OFF); LAS float* biasL = biasrel + 129 * 16;
        for (int i = tid; i < 129 * 16; i += NTHR) { const int rel = i >> 4, h = i & 15; const float bv = args.in[I_BIAS][t5_bucket(rel) * 16 + h]; biasrel[i] = bv; biasL[i] = bv * LOG2E; }
        __syncthreads();
        for (int rep = 0; rep < MK_REP_ATTP; ++rep)
        for (int u = bx; u < 1024; u += G) { const int i = u >> 8, c = u & 255, bg = c >> 3, s8 = c & 7; const int qt = (i == 0) ? s8 : (i == 1) ? 15 - s8 : (i == 2) ? 16 + s8 : 31 - s8;
            attn_prompt_unit(args, lds, biasL, bg >> 2, bg & 3, qt, wave, lane); }
        __syncthreads();
        LAS unsigned char* wl = lds + wave * WAREA;
        for (int rep = 0; rep < MK_REP_SSDS; ++rep)
        for (int it = gw; it < 4096; it += NGW) ssd_sample_item(args, wl, it >> 5, it & 31, lane);
        for (int rep = 0; rep < MK_REP_ATTS; ++rep)
        for (int q = gw; q < MS * 4; q += NGW) attend_sample_task(args, wl, biasrel, q >> 2, q & 3, lane);
#if MK_CHECK_ATT
        for (int q = gw; q < MP; q += NGW) attend_query<false>(args, wl, biasrel, q, lane);
#endif
        __syncthreads();
    }
    SEAM(6);
    if (IN(7)) {
        gate_norm_phase(args, gw, NGW, lane);
#if MK_CHECK_ATT
        check_compare(args, gw, NGW, lane);
#endif
        { pg8::Gemm g{YA, (const bf16_t*)(ws + WS_WBA), MP, D, D}; pg8::StaticOrder S; S.init(MP, D, G, bx);
        EpiGateA E{P, PG + D, T}; pg8::gemm_phase<EpiGateA, pg8::StaticOrder, true, true>(lds, g, S, E); }
        { SkGateA E{P, PG + D, T}; skinny_gemm<D>(lds, YA + (size_t)MP * D, (const bf16_t*)(ws + WS_WBA), E, bx, G, wave, lane); }
        if constexpr (DUPK(7)) { pg8::Gemm g{YA, (const bf16_t*)(ws + WS_WBA), MP, D, D}; pg8::StaticOrder S; S.init(MP, D, G, bx);
        EpiGateA E{P, PG + D, T}; pg8::gemm_phase<EpiGateA, pg8::StaticOrder, true, true>(lds, g, S, E); }
    }
    SEAM(7);
    if (IN(8)) {
        { pg8::Gemm g{Y, (const bf16_t*)(ws + WS_WBS), MP, D, DI}; pg8::StaticOrder S; S.init(MP, D, G, bx);
        EpiGateS E{P, PG, T, MG}; pg8::gemm_phase<EpiGateS, pg8::StaticOrder, true, true>(lds, g, S, E); }
        { SkGateS E{P, PG, T, MG}; skinny_gemm<DI>(lds, Y + (size_t)MP * DI, (const bf16_t*)(ws + WS_WBS), E, bx, G, wave, lane); }
        if constexpr (DUPK(8)) { pg8::Gemm g{Y, (const bf16_t*)(ws + WS_WBS), MP, D, DI}; pg8::StaticOrder S; S.init(MP, D, G, bx);
        EpiGateS E{P, PG, T, MG}; pg8::gemm_phase<EpiGateS, pg8::StaticOrder, true, true>(lds, g, S, E); }
    }
    SEAM(8);
    if (IN(9)) {
        { pg8::Gemm g{MG, (const bf16_t*)(ws + WS_WOUT), MP, D, D}; pg8::StaticOrder S; S.init(MP, D, G, bx);
        EpiResid E{HF, HF + (size_t)MP * D, T, ALPHA, 1.0f}; pg8::gemm_phase<EpiResid, pg8::StaticOrder, true, true>(lds, g, S, E); }
        { SkResid E{HF + (size_t)MP * D, T, ALPHA, 1.0f}; skinny_gemm<D>(lds, MG + (size_t)MP * D, (const bf16_t*)(ws + WS_WOUT), E, bx, G, wave, lane); }
        if constexpr (DUPK(9)) { pg8::Gemm g{MG, (const bf16_t*)(ws + WS_WOUT), MP, D, D}; pg8::StaticOrder S; S.init(MP, D, G, bx);
        EpiResid E{HF, HF + (size_t)MP * D, T, ALPHA, 1.0f}; pg8::gemm_phase<EpiResid, pg8::StaticOrder, true, true>(lds, g, S, E); }
    }
    SEAM(9);
    if (IN(10)) REPK(10) { ln_phase(T, args.in[I_LN2G], args.in[I_LN2B], HF, HB, gw, NGW, lane); }
    SEAM(10);
    if (IN(11)) {
        { pg8::Gemm g{HB, (const bf16_t*)(ws + WS_W2A), M, 2 * DFF, D}; pg8::StaticOrder S; S.init(M, 2 * DFF, G, bx);
        EpiSwiglu E{ACT}; pg8::gemm_phase<EpiSwiglu, pg8::StaticOrder, true, true>(lds, g, S, E); }
        if constexpr (DUPK(11)) { pg8::Gemm g{HB, (const bf16_t*)(ws + WS_W2A), M, 2 * DFF, D}; pg8::StaticOrder S; S.init(M, 2 * DFF, G, bx);
        EpiSwiglu E{ACT}; pg8::gemm_phase<EpiSwiglu, pg8::StaticOrder, true, true>(lds, g, S, E); }
    }
    SEAM(11);
    if (IN(12)) {
        { pg8::Gemm g{ACT, (const bf16_t*)(ws + WS_W2B), MP, D, DFF}; pg8::StaticOrder S; S.init(MP, D, G, bx);
        EpiResid E{HF, HF + (size_t)MP * D, T, ALPHA, 0.5f}; pg8::gemm_phase<EpiResid, pg8::StaticOrder, true, true>(lds, g, S, E); }
        { SkResid E{HF + (size_t)MP * D, T, ALPHA, 0.5f}; skinny_gemm<DFF>(lds, ACT + (size_t)MP * DFF, (const bf16_t*)(ws + WS_W2B), E, bx, G, wave, lane); }
        if constexpr (DUPK(12)) { pg8::Gemm g{ACT, (const bf16_t*)(ws + WS_W2B), MP, D, DFF}; pg8::StaticOrder S; S.init(MP, D, G, bx);
        EpiResid E{HF, HF + (size_t)MP * D, T, ALPHA, 0.5f}; pg8::gemm_phase<EpiResid, pg8::StaticOrder, true, true>(lds, g, S, E); }
    }
    SEAM(12);
    if (IN(13)) REPK(13) { ln_phase(T, args.in[I_LN3G], args.in[I_LN3B], args.out + O_Y, nullptr, gw, NGW, lane); }
#if MK_CHECK_ATT
    if (IN(13)) { __syncthreads(); unsigned* cw = (unsigned*)(ws + WS_CTL) + CW_CHK;
        const unsigned b0 = __hip_atomic_load(cw, __ATOMIC_RELAXED, __HIP_MEMORY_SCOPE_AGENT), b1 = __hip_atomic_load(cw + 1, __ATOMIC_RELAXED, __HIP_MEMORY_SCOPE_AGENT), b2 = __hip_atomic_load(cw + 2, __ATOMIC_RELAXED, __HIP_MEMORY_SCOPE_AGENT), b3 = __hip_atomic_load(cw + 3, __ATOMIC_RELAXED, __HIP_MEMORY_SCOPE_AGENT), b4 = __hip_atomic_load(cw + 4, __ATOMIC_RELAXED, __HIP_MEMORY_SCOPE_AGENT), b5 = __hip_atomic_load(cw + 5, __ATOMIC_RELAXED, __HIP_MEMORY_SCOPE_AGENT);
        const float code = MK_CHECK_CODE;
        if (code > 0.f && bx == 0 && tid == 0) args.out[O_Y] = 4096.0f * sqrtf(code); }
#endif
#undef IN
#undef SEAM
}
}

extern "C" void kernel_launch(void* const* d_in, const int* in_sizes, int n_in, void* d_out, int out_size, void* d_ws, size_t ws_size, hipStream_t stream) {
    using namespace mk;
    static int grid = 0;
    if (grid == 0) {
        if (n_in != 29 || (size_t)out_size != O_END || ws_size < WS_END) { fprintf(stderr, "kernel_launch: unexpected shapes (n_in %d, out %d, ws %zu)\n", n_in, out_size, ws_size); grid = -1; return; }
        int dev = 0, cus = 0, per_cu = 0;
        if (hipGetDevice(&dev) != hipSuccess || hipDeviceGetAttribute(&cus, hipDeviceAttributeMultiprocessorCount, dev) != hipSuccess) { grid = -1; return; }
        if (hipFuncSetAttribute((const void*)fwd, hipFuncAttributeMaxDynamicSharedMemorySize, LDS_BYTES) != hipSuccess) { fprintf(stderr, "kernel_launch: hipFuncSetAttribute failed\n"); grid = -1; return; }
        if (hipOccupancyMaxActiveBlocksPerMultiprocessor(&per_cu, (const void*)fwd, NTHR, LDS_BYTES) != hipSuccess || per_cu < 1) fprintf(stderr, "kernel_launch: occupancy query says %d\n", per_cu);
        (void)hipGetLastError();
        grid = cus;
    }
    if (grid < 0) return;
    (void)hipMemsetAsync((char*)d_ws + WS_CTL, 0, CTL_ZERO_BYTES, stream);
    Args a{};
    for (int i = 0; i < 29; ++i) a.in[i] = (const float*)d_in[i];
    a.out = (float*)d_out; a.ws = (unsigned char*)d_ws;
#if MK_SPLIT
    for (int p = 0; p < NPHASE; ++p) { a.ph_lo = p; a.ph_hi = p + 1; hipLaunchKernelGGL(fwd, dim3(grid), dim3(NTHR), LDS_BYTES, stream, a); }
#else
    a.ph_lo = 0; a.ph_hi = NPHASE; hipLaunchKernelGGL(fwd, dim3(grid), dim3(NTHR), LDS_BYTES, stream, a);
#endif
}
```

```cpp
#include <hip/hip_runtime.h>
#include <cstdio>
#include <cstdint>
#define GAS __attribute__((address_space(1)))
#define LAS __attribute__((address_space(3)))
namespace pg8 {
#define PG8_LAS __attribute__((address_space(3)))
typedef unsigned short bf16_t;
typedef short bf16x8 __attribute__((ext_vector_type(8)));
typedef float f32x4 __attribute__((ext_vector_type(4)));
typedef unsigned u32x4 __attribute__((ext_vector_type(4)));
constexpr int BM = 256, BK = 64, HALF = 128, HTB = HALF * BK * 2  , STAGE_BYTES = 8 * HTB, NXCD = 8, WGM = 8;

__host__ __device__ __forceinline__ int lds_byte(int r, int c) { const int st = (r >> 4) * 2 + (c >> 5), rr = r & 15, cc = c & 31, ob = rr * 64 + cc * 2; return st * 1024 + (ob ^ (((ob >> 9) & 1) << 5)); }
__host__ __device__ __forceinline__ void stage_rc(int b, int& R, int& C) { const int st = b / 1024, sb = b % 1024, swz = sb ^ (((sb >> 9) & 1) << 5); R = (st >> 1) * 16 + swz / 64; C = (st & 1) * 32 + (swz % 64) / 2; }
__host__ __device__ __forceinline__ int perm32(int rho) { const int n = rho >> 4, i = rho & 15; return 8 * (i >> 2) + 4 * n + (i & 3); }

struct Unit { int pm, pn; };
struct Gemm { const bf16_t* A; const bf16_t* Bt; int M, N, K; };

struct StaticOrder {
    int nM, nN, nwg, G, c;
    __host__ __device__ void init(int M, int N, int G_, int c_) { nM = M / BM; nN = N / BM; nwg = nM * nN; G = G_; c = c_; }
    __host__ __device__ bool next(int i, Unit& u) const {
        const long L = (long)i * G + c; if (L >= nwg) return false;
        int wgid = (int)L; { const int q = nwg / NXCD, r = nwg % NXCD, xcd = wgid % NXCD, off = wgid / NXCD; wgid = (xcd < r ? xcd * (q + 1) : r * (q + 1) + (xcd - r) * q) + off; }
        const int nig = WGM * nN, gid = wgid / nig, fm = gid * WGM, gsz = (nM - fm) < WGM ? (nM - fm) : WGM;
        u.pm = fm + ((wgid % nig) % gsz); u.pn = (wgid % nig) / gsz; return true;
    }
    __device__ __forceinline__ void a_ready(const Unit&) const {}
    __device__ __forceinline__ void done(const Unit&) const {}
};

__device__ __forceinline__ unsigned cvt_pk_bf16(float lo, float hi) { unsigned r; asm volatile("v_cvt_pk_bf16_f32 %0, %1, %2" : "=v"(r) : "v"(lo), "v"(hi)); return r; }

template <class Epi, class Sched, bool ALIGN_EPI = false, bool SP2 = false>
__device__ __forceinline__ void gemm_phase(PG8_LAS unsigned char* lds, const Gemm g, const Sched& S, const Epi& E) {
    const int tid = threadIdx.x, wid = __builtin_amdgcn_readfirstlane(tid >> 6), lane = tid & 63, wr = wid >> 2, wc = wid & 3, fr = lane & 15, fq = lane >> 4;
    const int K = g.K, nt = K / BK;
    unsigned voffA[2], voffB[2];
#pragma unroll
    for (int i = 0; i < 2; ++i) { int R, C; stage_rc(tid * 16 + i * 8192, R, C); const int Rb = Epi::PERM ? ((R & ~31) + perm32(R & 31)) : R;
        voffA[i] = (unsigned)(R * K + C) * 2u; voffB[i] = (unsigned)(Rb * K + C) * 2u; }
    const size_t kstep = (size_t)(BK * 2);
    const size_t hstep = (size_t)HALF * K * 2;
    const size_t tstep = 2 * hstep;
    const unsigned ldsw = (unsigned)wid * 1024u;
    const int aoff = lds_byte(wr * 64 + fr, fq * 8), boff = lds_byte(wc * 32 + fr, fq * 8);
#define PG8_SA(b, h) (((b) * 2 + (h)) * HTB)
#define PG8_SB(b, h) ((4 + (b) * 2 + (h)) * HTB)
#define PG8_STAGE(bufoff, gbase, voff) do { _Pragma("unroll") for (int _i = 0; _i < 2; ++_i) \
        __builtin_amdgcn_global_load_lds((const unsigned*)((const char*)(gbase) + (voff)[_i]), (PG8_LAS unsigned*)(lds + (bufoff) + ldsw + _i * 8192), 16, 0, 0); } while (0)
#define PG8_LDA(dst, b, h) do { _Pragma("unroll") for (int m = 0; m < 4; ++m) _Pragma("unroll") for (int k = 0; k < 2; ++k) dst[m][k] = *(const PG8_LAS bf16x8*)(lds + PG8_SA(b, h) + aoff + m * 2048 + k * 1024); } while (0)
#define PG8_LDB(dst, b, h) do { _Pragma("unroll") for (int n = 0; n < 2; ++n) _Pragma("unroll") for (int k = 0; k < 2; ++k) dst[n][k] = *(const PG8_LAS bf16x8*)(lds + PG8_SB(b, h) + boff + n * 2048 + k * 1024); } while (0)
#define PG8_MMA(ai, bj, At, Bt) do { __builtin_amdgcn_s_setprio(1); _Pragma("unroll") for (int m = 0; m < 4; ++m) _Pragma("unroll") for (int n = 0; n < 2; ++n) _Pragma("unroll") for (int k = 0; k < 2; ++k) \
        acc[ai][bj][m][n] = __builtin_amdgcn_mfma_f32_16x16x32_bf16(Bt[n][k], At[m][k], acc[ai][bj][m][n], 0, 0, 0); __builtin_amdgcn_s_setprio(0); } while (0)
#define PG8_WAIT_V(n) asm volatile("s_waitcnt vmcnt(" #n ")" ::: "memory")
#define PG8_WAIT_L(n) asm volatile("s_waitcnt lgkmcnt(" #n ")" ::: "memory")
#define PG8_BAR __builtin_amdgcn_s_barrier()
#define PG8_SCHED __builtin_amdgcn_sched_barrier(0)
    Unit cur, nxt; int ui = 0;
    if (!S.next(0, cur)) return;
    f32x4 acc[2][2][4][2];
#pragma unroll
    for (int a = 0; a < 2; ++a)
#pragma unroll
        for (int b = 0; b < 2; ++b)
#pragma unroll
            for (int m = 0; m < 4; ++m)
#pragma unroll
                for (int n = 0; n < 2; ++n) acc[a][b][m][n] = (f32x4){0.f, 0.f, 0.f, 0.f};
    bf16x8 At[4][2], B0[2][2], B1[2][2];
    const char* cA = (const char*)g.A + (size_t)cur.pm * tstep; const char* cB = (const char*)g.Bt + (size_t)cur.pn * tstep;
    S.a_ready(cur);
    if constexpr (SP2) {
        PG8_STAGE(PG8_SB(0, 0), cB, voffB); PG8_STAGE(PG8_SB(0, 1), cB + hstep, voffB); PG8_STAGE(PG8_SA(0, 0), cA, voffA); PG8_STAGE(PG8_SA(0, 1), cA + hstep, voffA);
        if (wr == 1) PG8_BAR;
        PG8_WAIT_V(2); PG8_BAR;
        PG8_STAGE(PG8_SB(1, 0), cB + kstep, voffB); PG8_STAGE(PG8_SA(1, 0), cA + kstep, voffA); PG8_STAGE(PG8_SB(1, 1), cB + hstep + kstep, voffB);
        PG8_WAIT_V(6); PG8_BAR;
    } else {
        PG8_STAGE(PG8_SB(0, 0), cB, voffB); PG8_STAGE(PG8_SA(0, 0), cA, voffA); PG8_STAGE(PG8_SB(0, 1), cB + hstep, voffB); PG8_STAGE(PG8_SA(0, 1), cA + hstep, voffA);
        if (wr == 1) PG8_BAR;
        PG8_WAIT_V(4); PG8_BAR;
        PG8_STAGE(PG8_SB(1, 0), cB + kstep, voffB); PG8_STAGE(PG8_SA(1, 0), cA + kstep, voffA); PG8_STAGE(PG8_SB(1, 1), cB + hstep + kstep, voffB);
        PG8_WAIT_V(6); PG8_BAR;
    }
    for (;;) {
        const bool has_next = S.next(ui + 1, nxt);
        const char* nA = has_next ? (const char*)g.A + (size_t)nxt.pm * tstep : cA; const char* nB = has_next ? (const char*)g.Bt + (size_t)nxt.pn * tstep : cB;
        for (int t = 0; t < nt; t += 2) {
            const bool last = (t == nt - 2);
            const char* a1 = cA + (size_t)(t + 1) * kstep;
            const char* a2 = last ? nA : cA + (size_t)(t + 2) * kstep; const char* b2 = last ? nB : cB + (size_t)(t + 2) * kstep;
            const char* a3 = a2 + kstep; const char* b3 = b2 + kstep;
            if (last && has_next) S.a_ready(nxt);
            if constexpr (SP2) {
            PG8_LDB(B0, 0, 0); PG8_LDB(B1, 0, 1); PG8_SCHED; PG8_LDA(At, 0, 0); PG8_STAGE(PG8_SA(1, 1), a1 + hstep, voffA);
            PG8_WAIT_V(8); PG8_WAIT_L(0); PG8_BAR; PG8_MMA(0, 0, At, B0); PG8_MMA(0, 1, At, B1); PG8_BAR; PG8_SCHED;
            PG8_LDA(At, 0, 1); PG8_STAGE(PG8_SB(0, 0), b2, voffB); PG8_STAGE(PG8_SB(0, 1), b2 + hstep, voffB); PG8_STAGE(PG8_SA(0, 0), a2, voffA);
            PG8_WAIT_V(8); PG8_WAIT_L(0); PG8_BAR; PG8_MMA(1, 0, At, B0); PG8_MMA(1, 1, At, B1); PG8_BAR; PG8_SCHED;
            PG8_LDB(B0, 1, 0); PG8_LDB(B1, 1, 1); PG8_SCHED; PG8_LDA(At, 1, 0); PG8_STAGE(PG8_SA(0, 1), a2 + hstep, voffA);
            PG8_WAIT_V(8); PG8_WAIT_L(0); PG8_BAR; PG8_MMA(0, 0, At, B0); PG8_MMA(0, 1, At, B1); PG8_BAR; PG8_SCHED;
            PG8_LDA(At, 1, 1); PG8_STAGE(PG8_SB(1, 0), b3, voffB); PG8_STAGE(PG8_SB(1, 1), b3 + hstep, voffB); PG8_STAGE(PG8_SA(1, 0), a3, voffA);
            PG8_WAIT_V(8); PG8_WAIT_L(0); PG8_BAR; PG8_MMA(1, 0, At, B0); PG8_MMA(1, 1, At, B1); PG8_BAR; PG8_SCHED;
            } else {
            PG8_LDB(B0, 0, 0); PG8_SCHED; PG8_LDA(At, 0, 0); PG8_STAGE(PG8_SA(1, 1), a1 + hstep, voffA);
            PG8_WAIT_L(8); PG8_BAR; PG8_WAIT_L(0); PG8_MMA(0, 0, At, B0); PG8_BAR; PG8_SCHED;
            PG8_LDB(B1, 0, 1); PG8_STAGE(PG8_SB(0, 0), b2, voffB);
            PG8_BAR; PG8_WAIT_L(0); PG8_MMA(0, 1, At, B1); PG8_BAR;
            PG8_LDA(At, 0, 1); PG8_STAGE(PG8_SA(0, 0), a2, voffA);
            PG8_BAR; PG8_WAIT_L(0); PG8_MMA(1, 0, At, B0); PG8_BAR; PG8_SCHED;
            PG8_STAGE(PG8_SB(0, 1), b2 + hstep, voffB);
            PG8_WAIT_V(6); PG8_BAR; PG8_MMA(1, 1, At, B1); PG8_BAR;
            PG8_LDB(B0, 1, 0); PG8_SCHED; PG8_LDA(At, 1, 0); PG8_STAGE(PG8_SA(0, 1), a2 + hstep, voffA);
            PG8_WAIT_L(8); PG8_BAR; PG8_WAIT_L(0); PG8_MMA(0, 0, At, B0); PG8_BAR; PG8_SCHED;
            PG8_LDB(B1, 1, 1); PG8_STAGE(PG8_SB(1, 0), b3, voffB);
            PG8_BAR; PG8_WAIT_L(0); PG8_MMA(0, 1, At, B1); PG8_BAR;
            PG8_LDA(At, 1, 1); PG8_STAGE(PG8_SA(1, 0), a3, voffA);
            PG8_BAR; PG8_WAIT_L(0); PG8_MMA(1, 0, At, B0); PG8_BAR; PG8_SCHED;
            PG8_STAGE(PG8_SB(1, 1), b3 + hstep, voffB);
            PG8_WAIT_V(6); PG8_BAR; PG8_MMA(1, 1, At, B1); PG8_BAR;
            }
        }
        if constexpr (ALIGN_EPI) { if (wr == 0) PG8_BAR; }
        if constexpr (!Epi::AFTER_DRAIN) { E(acc, cur, wr, wc, fr, fq); S.done(cur); }
        if (!has_next) break;
#pragma unroll
        for (int a = 0; a < 2; ++a)
#pragma unroll
            for (int b = 0; b < 2; ++b)
#pragma unroll
                for (int m = 0; m < 4; ++m)
#pragma unroll
                    for (int n = 0; n < 2; ++n) acc[a][b][m][n] = (f32x4){0.f, 0.f, 0.f, 0.f};
        cur = nxt; cA = nA; cB = nB; ++ui;
        if constexpr (ALIGN_EPI) { if (wr == 1) PG8_BAR; }
    }
    PG8_WAIT_V(0);
    if constexpr (!ALIGN_EPI) { if (wr == 0) PG8_BAR; }
    PG8_BAR;
    if constexpr (Epi::AFTER_DRAIN) { E.fused(acc, cur, wr, wc, fr, fq, lds, wid, lane); S.done(cur); }
#undef PG8_SA
#undef PG8_SB
#undef PG8_STAGE
#undef PG8_LDA
#undef PG8_LDB
#undef PG8_MMA
#undef PG8_WAIT_V
#undef PG8_WAIT_L
#undef PG8_BAR
#undef PG8_SCHED
}
}
#define XB_TMO      128
#define XB_XCNT(j)  (256  + 64 * (j))
#define XB_XSUB(j)  (1280 + 64 * (j))
#define XB_XGEN(j)  (2304 + 64 * (j))
#define XB_TOP      3328
#define XB_TOPGEN   3392
#define XCD_BAR_WORDS 3456
#define XB_SPIN_CAP (1u << 18)

__device__ __forceinline__ unsigned xb_ld(unsigned* p)              { return __hip_atomic_load(p, __ATOMIC_RELAXED, __HIP_MEMORY_SCOPE_AGENT); }
__device__ __forceinline__ unsigned xb_add(unsigned* p, unsigned v) { return __hip_atomic_fetch_add(p, v, __ATOMIC_RELAXED, __HIP_MEMORY_SCOPE_AGENT); }
__device__ __forceinline__ unsigned xb_xcc_id() { return (unsigned)__builtin_amdgcn_s_getreg((3 << 11) | 20) & 0xFu; }
#define XB_SPIN(cond, bar) do { unsigned _sp = 0; while (cond) { __builtin_amdgcn_s_sleep(1); \
    if ((++_sp & 255u) == 0u) { if (xb_ld(&(bar)[XB_TMO])) break; if (_sp > XB_SPIN_CAP) { atomicAdd(&(bar)[XB_TMO], 1u); break; } } } } while (0)

struct XcdBarrier {
    unsigned* bar; unsigned x;
    volatile LAS unsigned* st;
};

__device__ __forceinline__ XcdBarrier xcd_barrier_post(unsigned* bar, volatile LAS unsigned* st) {
    XcdBarrier b; b.bar = bar; b.x = xb_xcc_id(); b.st = st;
    if (threadIdx.x == 0) (void)xb_add(&bar[XB_XCNT(b.x)], 1u);
    return b;
}
__device__ __forceinline__ void xcd_barrier_complete(unsigned* bar, unsigned x, unsigned& nloc, unsigned& nx) {
    const unsigned G = gridDim.x * gridDim.y * gridDim.z;
    unsigned sum, cnt, mine, sp = 0u;
    for (;;) {
        sum = 0u; cnt = 0u; mine = 0u;
#pragma unroll
        for (unsigned j = 0; j < 16; ++j) { const unsigned c = xb_ld(&bar[XB_XCNT(j)]); sum += c; cnt += (c > 0u) ? 1u : 0u; mine = (j == x) ? c : mine; }
        if (sum == G) break;
        __builtin_amdgcn_s_sleep(1);
        if ((++sp & 255u) == 0u) { if (xb_ld(&bar[XB_TMO])) break; if (sp > XB_SPIN_CAP) { atomicAdd(&bar[XB_TMO], 1u); break; } }
    }
    nloc = mine > 0u ? mine : 1u; nx = cnt > 0u ? cnt : 1u;
}

__device__ __forceinline__ void xcd_barrier(const XcdBarrier& b) {
    asm volatile("s_waitcnt vmcnt(0)" ::: "memory");
    __syncthreads();
    if (threadIdx.x == 0) {
        unsigned* bar = b.bar;
        __builtin_amdgcn_s_waitcnt(0);
        unsigned nloc = b.st[0], nx = b.st[1];
        if (nloc == 0u) { xcd_barrier_complete(bar, b.x, nloc, nx); b.st[0] = nloc; b.st[1] = nx; }
        const unsigned old = xb_add(&bar[XB_XSUB(b.x)], 1u);
        const unsigned gen = old / nloc;
        if (old + 1u == (gen + 1u) * nloc) {
            __builtin_amdgcn_fence(__ATOMIC_RELEASE, "agent");
            asm volatile("s_waitcnt vmcnt(0)" ::: "memory");
            const unsigned og = xb_add(&bar[XB_TOP], 1u);
            const unsigned tg = og / nx;
            if (og + 1u == (tg + 1u) * nx) xb_add(&bar[XB_TOPGEN], 1u);
            else XB_SPIN(xb_ld(&bar[XB_TOPGEN]) == tg, bar);
            __builtin_amdgcn_fence(__ATOMIC_ACQUIRE, "agent");
            xb_add(&bar[XB_XGEN(b.x)], 1u);
            asm volatile("s_waitcnt vmcnt(0)" ::: "memory");
        } else {
            XB_SPIN(xb_ld(&bar[XB_XGEN(b.x)]) == gen, bar);
            __builtin_amdgcn_fence(__ATOMIC_ACQUIRE, "agent");
            asm volatile("s_waitcnt vmcnt(0)" ::: "memory");
        }
    }
    __syncthreads();
}
namespace mk {
using pg8::bf16_t; using pg8::bf16x8; using pg8::f32x4; using pg8::u32x4;
typedef unsigned u32x2 __attribute__((ext_vector_type(2)));

#ifndef MK_CHECK_ATT
#define MK_CHECK_ATT 0
#endif
#define MK_REP_SSDP 1
#define MK_REP_CONV 1
#define MK_REP_SCP 1
#define MK_REP_SCS 1
#define MK_REP_SSDS 1
#define MK_REP_ATTS 1
#define MK_REP_ATTP 1
#define MK_CHECK_TOL 0.02f
#define MK_CHECK_CODE ((b0 ? 1.f : 0.f) + (b1 ? 2.f : 0.f) + (b2 ? 4.f : 0.f) + (b3 ? 8.f : 0.f) + (b4 ? 16.f : 0.f) + (b5 ? 32.f : 0.f))
#define MK_REP_MASK 0
#define DUPK(k) (((MK_REP_MASK >> (k)) & 1) != 0)
#define REPK(k) for (int rep_ = 0; rep_ < 1 + ((MK_REP_MASK >> (k)) & 1); ++rep_)
#ifndef MK_SPLIT
#define MK_SPLIT 0
#endif

constexpr int NWAVES = 8, NTHR = 512;
constexpr int MP = 16384, MS = 512, M = MP + MS, D = 1024, DFF = 2816, DI = 2048, NP = 9472, XCW = 3072;
constexpr int PZ = 0, PXBC = 2048, PSM = 5120, PQ = 5376, PK = 6400, PV = 6656, PQI = 6912, PG = 7424;
constexpr int SCW = 2048, SCSW = 2112;
constexpr size_t O_Y = 0, O_KP = 17301504, O_VP = 21495808, O_KIP = 25690112, O_CVP = 26738688, O_SSP = 26812416,
                 O_KS = 28909568, O_VS = 29040640, O_KIS = 29171712, O_CVS = 29204480, O_SSS = 30384128, O_END = 63938560;
constexpr size_t MiB = 1u << 20;
constexpr size_t WS_CTL = 0, CTL_ZERO_BYTES = 1 * MiB;
constexpr size_t WS_W1A = 1 * MiB, WS_W1B = WS_W1A + 11 * MiB, WS_WIN = WS_W1B + 6 * MiB, WS_WBS = WS_WIN + 19 * MiB, WS_WBA = WS_WBS + 4 * MiB,
                 WS_WOUT = WS_WBA + 2 * MiB, WS_W2A = WS_WOUT + 2 * MiB, WS_W2B = WS_W2A + 11 * MiB;
constexpr size_t WS_XB = WS_W2B + 6 * MiB, WS_ACT = WS_XB + 33 * MiB, WS_T = WS_ACT + 91 * MiB, WS_HF = WS_T + 66 * MiB, WS_HB = WS_HF + 66 * MiB,
                 WS_P = WS_HB + 33 * MiB, WS_SMF = WS_P + 306 * MiB, WS_XC = WS_SMF + 9 * MiB, WS_Y = WS_XC + 99 * MiB, WS_SC = WS_Y + 66 * MiB,
                 WS_SCS = WS_SC + 128 * MiB, WS_YA = WS_SCS + 5 * MiB, WS_MG = WS_YA + 33 * MiB, WS_END = WS_MG + 33 * MiB;
constexpr int CW_BAR = 4096;
constexpr int LDS_BYTES = 163840, MISC_OFF = LDS_BYTES - 256;
constexpr int WAREA = 17920;
constexpr int BIASREL_OFF = NWAVES * WAREA;
static_assert(BIASREL_OFF + 2 * 129 * 16 * 4 <= MISC_OFF, "LDS map");

constexpr float ALPHA = 1.18920711500272f;
constexpr float LN_EPS = 1e-5f;

struct Args { const float* in[29]; float* out; unsigned char* ws; int ph_lo, ph_hi; };
enum { I_XP = 0, I_XS, I_CK, I_CV, I_CKI, I_SCONV, I_SSSM, I_PT, I_BIAS, I_WIN, I_CONVW, I_CONVB, I_DTB, I_ALOG, I_DSKIP, I_NORMG, I_WBS, I_WBA, I_WOUT,
       I_F1WI, I_F1WO, I_F2WI, I_F2WO, I_LN1G, I_LN1B, I_LN2G, I_LN2B, I_LN3G, I_LN3B };

__device__ __forceinline__ float bf2f(unsigned v) { return __uint_as_float(v << 16); }
__device__ __forceinline__ unsigned f2bf(float f) { unsigned u = __float_as_uint(f); return (u + 0x7fffu + ((u >> 16) & 1u)) >> 16; }
__device__ __forceinline__ unsigned pk2(float lo, float hi) { return pg8::cvt_pk_bf16(lo, hi); }
__device__ __forceinline__ void unpack8(const u32x4 w, float (&f)[8]) {
#pragma unroll
    for (int i = 0; i < 4; ++i) { f[2 * i] = __uint_as_float(w[i] << 16); f[2 * i + 1] = __uint_as_float(w[i] & 0xffff0000u); }
}
__device__ __forceinline__ u32x4 pack8(const float (&f)[8]) { u32x4 w; w.x = pk2(f[0], f[1]); w.y = pk2(f[2], f[3]); w.z = pk2(f[4], f[5]); w.w = pk2(f[6], f[7]); return w; }
__device__ __forceinline__ float sigmoidf_(float x) { return 1.0f / (1.0f + __expf(-x)); }
__device__ __forceinline__ float siluf_(float x) { return x / (1.0f + __expf(-x)); }
__device__ __forceinline__ float wave_sum(float v) {
#pragma unroll
    for (int o = 1; o < 64; o <<= 1) v += __shfl_xor(v, o);
    return v;
}
__device__ __forceinline__ float wave_max(float v) {
#pragma unroll
    for (int o = 1; o < 64; o <<= 1) v = fmaxf(v, __shfl_xor(v, o));
    return v;
}
__device__ __forceinline__ f32x4 mfma16(bf16x8 a, bf16x8 b, f32x4 c) { return __builtin_amdgcn_mfma_f32_16x16x32_bf16(a, b, c, 0, 0, 0); }
__device__ __forceinline__ int mbcnt64(unsigned long long m) { return (int)__builtin_amdgcn_mbcnt_hi((unsigned)(m >> 32), __builtin_amdgcn_mbcnt_lo((unsigned)m, 0u)); }

struct EpiSwiglu {
    static constexpr bool PERM = true, AFTER_DRAIN = false;
    bf16_t* O;
    __device__ __forceinline__ void operator()(const f32x4 (&acc)[2][2][4][2], const pg8::Unit& u, int wr, int wc, int fr, int fq) const {
        const int row0 = u.pm * 256 + wr * 64 + fr, col0 = u.pn * 128 + wc * 32 + 8 * fq;
#pragma unroll
        for (int ai = 0; ai < 2; ++ai)
#pragma unroll
            for (int m = 0; m < 4; ++m) {
                float o[8];
#pragma unroll
                for (int n = 0; n < 2; ++n)
#pragma unroll
                    for (int j = 0; j < 4; ++j) { const float g = acc[ai][0][m][n][j], up = acc[ai][1][m][n][j]; o[4 * n + j] = siluf_(g) * up; }
                *(u32x4*)(O + (size_t)(row0 + ai * 128 + m * 16) * DFF + col0) = pack8(o);
            }
    }
};
struct EpiResid {
    static constexpr bool PERM = false, AFTER_DRAIN = false;
    const float* base_p; const float* base_s; float* T; float alpha, s;
    __device__ __forceinline__ void operator()(const f32x4 (&acc)[2][2][4][2], const pg8::Unit& u, int wr, int wc, int fr, int fq) const {
        const int row0 = u.pm * 256 + wr * 64 + fr, col0 = u.pn * 256 + wc * 32 + 4 * fq;
#pragma unroll
        for (int ai = 0; ai < 2; ++ai)
#pragma unroll
            for (int m = 0; m < 4; ++m) {
                const int r = row0 + ai * 128 + m * 16;
                const float* b = (r < MP) ? base_p + (size_t)r * D : base_s + (size_t)(r - MP) * D;
#pragma unroll
                for (int bj = 0; bj < 2; ++bj)
#pragma unroll
                    for (int n = 0; n < 2; ++n) { const int c = col0 + bj * 128 + n * 16; const f32x4 bv = *(const f32x4*)(b + c);
                        *(f32x4*)(T + (size_t)r * D + c) = bv * alpha + acc[ai][bj][m][n] * s; }
            }
    }
};
struct EpiWin {
    static constexpr bool PERM = true, AFTER_DRAIN = false;
    bf16_t* P; float* smf; float* out;
    __device__ __forceinline__ void operator()(const f32x4 (&acc)[2][2][4][2], const pg8::Unit& u, int wr, int wc, int fr, int fq) const {
        const int row0 = u.pm * 256 + wr * 64 + fr, cl = wc * 32 + 8 * fq, col0 = u.pn * 256 + cl;
#pragma unroll
        for (int ai = 0; ai < 2; ++ai)
#pragma unroll
            for (int m = 0; m < 4; ++m) {
                const int r = row0 + ai * 128 + m * 16;
#pragma unroll
                for (int bj = 0; bj < 2; ++bj) {
                    const f32x4 v0 = acc[ai][bj][m][0], v1 = acc[ai][bj][m][1];
                    u32x4 w; w.x = pk2(v0[0], v0[1]); w.y = pk2(v0[2], v0[3]); w.z = pk2(v1[0], v1[1]); w.w = pk2(v1[2], v1[3]);
                    *(u32x4*)(P + (size_t)r * NP + col0 + bj * 128) = w;
                    if (u.pn == 20) {
                        if (bj == 0) {
                            float* d = smf + (size_t)r * 128 + cl; *(f32x4*)d = v0; *(f32x4*)(d + 4) = v1;
                            if (cl >= 64) { float* k = out + ((r < MP) ? O_KIP + (size_t)r * 64 : O_KIS + (size_t)(r - MP) * 64) + (cl - 64); *(f32x4*)k = v0; *(f32x4*)(k + 4) = v1; }
                        }
                    } else if (u.pn == 25) {
                        float* k = out + ((r < MP) ? O_KP + (size_t)r * 256 : O_KS + (size_t)(r - MP) * 256) + bj * 128 + cl; *(f32x4*)k = v0; *(f32x4*)(k + 4) = v1;
                    } else if (u.pn == 26) {
                        float* k = out + ((r < MP) ? O_VP + (size_t)r * 256 : O_VS + (size_t)(r - MP) * 256) + bj * 128 + cl; *(f32x4*)k = v0; *(f32x4*)(k + 4) = v1;
                    }
                }
            }
    }
};
struct EpiGateA {
    static constexpr bool PERM = false, AFTER_DRAIN = false;
    const bf16_t* P; int gcol; float* M1;
    __device__ __forceinline__ void operator()(const f32x4 (&acc)[2][2][4][2], const pg8::Unit& u, int wr, int wc, int fr, int fq) const {
        const int row0 = u.pm * 256 + wr * 64 + fr, col0 = u.pn * 256 + wc * 32 + 4 * fq;
#pragma unroll
        for (int ai = 0; ai < 2; ++ai)
#pragma unroll
            for (int m = 0; m < 4; ++m) {
                const int r = row0 + ai * 128 + m * 16;
#pragma unroll
                for (int bj = 0; bj < 2; ++bj)
#pragma unroll
                    for (int n = 0; n < 2; ++n) { const int c = col0 + bj * 128 + n * 16; const u32x2 gw = *(const u32x2*)(P + (size_t)r * NP + gcol + c);
                        f32x4 g; g[0] = sigmoidf_(__uint_as_float(gw.x << 16)); g[1] = sigmoidf_(__uint_as_float(gw.x & 0xffff0000u)); g[2] = sigmoidf_(__uint_as_float(gw.y << 16)); g[3] = sigmoidf_(__uint_as_float(gw.y & 0xffff0000u));
                        *(f32x4*)(M1 + (size_t)r * D + c) = g * acc[ai][bj][m][n]; }
            }
    }
};
struct EpiGateS {
    static constexpr bool PERM = true, AFTER_DRAIN = false;
    const bf16_t* P; int gcol; const float* M1; bf16_t* MG;
    __device__ __forceinline__ void operator()(const f32x4 (&acc)[2][2][4][2], const pg8::Unit& u, int wr, int wc, int fr, int fq) const {
        const int row0 = u.pm * 256 + wr * 64 + fr, col0 = u.pn * 256 + wc * 32 + 8 * fq;
#pragma unroll
        for (int ai = 0; ai < 2; ++ai)
#pragma unroll
            for (int m = 0; m < 4; ++m) {
                const int r = row0 + ai * 128 + m * 16;
#pragma unroll
                for (int bj = 0; bj < 2; ++bj) { const int c = col0 + bj * 128;
                    const u32x4 gw = *(const u32x4*)(P + (size_t)r * NP + gcol + c); float g[8]; unpack8(gw, g);
                    const f32x4 m0 = *(const f32x4*)(M1 + (size_t)r * D + c), m1 = *(const f32x4*)(M1 + (size_t)r * D + c + 4);
                    float o[8];
#pragma unroll
                    for (int j = 0; j < 4; ++j) { o[j] = m0[j] + sigmoidf_(g[j]) * acc[ai][bj][m][0][j]; o[4 + j] = m1[j] + sigmoidf_(g[4 + j]) * acc[ai][bj][m][1][j]; }
                    *(u32x4*)(MG + (size_t)r * D + c) = pack8(o); }
            }
    }
};

struct SkResid { const float* base; float* T; float alpha, s;
    __device__ __forceinline__ void operator()(int r, int c, f32x4 v) const { const f32x4 bv = *(const f32x4*)(base + (size_t)(r - MP) * D + c); *(f32x4*)(T + (size_t)r * D + c) = bv * alpha + v * s; } };
struct SkGateA { const bf16_t* P; int gcol; float* M1;
    __device__ __forceinline__ void operator()(int r, int c, f32x4 v) const { const u32x2 gw = *(const u32x2*)(P + (size_t)r * NP + gcol + c);
        f32x4 g; g[0] = sigmoidf_(__uint_as_float(gw.x << 16)); g[1] = sigmoidf_(__uint_as_float(gw.x & 0xffff0000u)); g[2] = sigmoidf_(__uint_as_float(gw.y << 16)); g[3] = sigmoidf_(__uint_as_float(gw.y & 0xffff0000u));
        *(f32x4*)(M1 + (size_t)r * D + c) = g * v; } };
struct SkGateS { const bf16_t* P; int gcol; const float* M1; bf16_t* MG;
    __device__ __forceinline__ void operator()(int r, int c, f32x4 v) const { const u32x2 gw = *(const u32x2*)(P + (size_t)r * NP + gcol + c); const f32x4 m = *(const f32x4*)(M1 + (size_t)r * D + c);
        const float o0 = m[0] + sigmoidf_(__uint_as_float(gw.x << 16)) * v[0], o1 = m[1] + sigmoidf_(__uint_as_float(gw.x & 0xffff0000u)) * v[1], o2 = m[2] + sigmoidf_(__uint_as_float(gw.y << 16)) * v[2], o3 = m[3] + sigmoidf_(__uint_as_float(gw.y & 0xffff0000u)) * v[3];
        u32x2 w; w.x = pk2(o0, o1); w.y = pk2(o2, o3); *(u32x2*)(MG + (size_t)r * D + c) = w; } };
template <int K, class Epi>
__device__ __forceinline__ void skinny_gemm(LAS unsigned char* lds, const bf16_t* A  , const bf16_t* Bt, const Epi& E, int bx, int G, int wave, int lane) {
    constexpr int KW = K / 8, NS = KW / 32;
    const int fr = lane & 15, fq = lane >> 4, tid = wave * 64 + lane;
    LAS float* part = (LAS float*)lds;
    for (int tile = bx; tile < 256; tile += G) {
        const int tm = tile >> 4, tn = tile & 15;
        const bf16_t* ap = A + (size_t)(tm * 32 + fr) * K + wave * KW + 8 * fq;
        const bf16_t* bp = Bt + (size_t)(tn * 64 + fr) * K + wave * KW + 8 * fq;
        f32x4 acc[2][4];
#pragma unroll
        for (int m = 0; m < 2; ++m)
#pragma unroll
            for (int n = 0; n < 4; ++n) acc[m][n] = (f32x4){0.f, 0.f, 0.f, 0.f};
#pragma unroll 4
        for (int ks = 0; ks < NS; ++ks) {
            bf16x8 a[2], bb[4];
#pragma unroll
            for (int m = 0; m < 2; ++m) a[m] = *(const bf16x8*)(ap + (size_t)m * 16 * K + ks * 32);
#pragma unroll
            for (int n = 0; n < 4; ++n) bb[n] = *(const bf16x8*)(bp + (size_t)n * 16 * K + ks * 32);
#pragma unroll
            for (int m = 0; m < 2; ++m)
#pragma unroll
                for (int n = 0; n < 4; ++n) acc[m][n] = mfma16(a[m], bb[n], acc[m][n]);
        }
#pragma unroll
        for (int m = 0; m < 2; ++m)
#pragma unroll
            for (int n = 0; n < 4; ++n)
#pragma unroll
                for (int j = 0; j < 4; ++j) part[(wave * 32 + m * 16 + 4 * fq + j) * 64 + n * 16 + fr] = acc[m][n][j];
        __syncthreads();
        { const int row = tid >> 4, c4 = (tid & 15) * 4; f32x4 v = {0.f, 0.f, 0.f, 0.f};
#pragma unroll
          for (int w = 0; w < 8; ++w) v += *(const LAS f32x4*)(part + (w * 32 + row) * 64 + c4);
          E(MP + tm * 32 + row, tn * 64 + c4, v); }
        __syncthreads();
    }
}

__device__ __forceinline__ int tr_src(int mode, int n) {
    if (mode == 0) return n;
    if (mode == 1) { const int j = n >> 8, i = n & 255; return (i < 128) ? j * 128 + i : DFF + j * 128 + (i - 128); }
    if (n < 5120) return n;
    if (n < 5376) { const int j = n - 5120; if (j < 32) return 5120 + j; if (j < 40) return 7264 + (j - 32); if (j >= 64 && j < 128) return 7200 + (j - 64); return -1; }
    if (n < 6400) return 5152 + (n - 5376);
    if (n < 6656) return 6176 + (n - 6400);
    if (n < 6912) return 6432 + (n - 6656);
    if (n < 7424) return 6688 + (n - 6912);
    return 7272 + (n - 7424);
}
__device__ __forceinline__ void tr_item(const float* W, int K, int Nsrc, bf16_t* WT, int k0, int n0, int mode, LAS bf16_t* scr, int lane) {
    const int kr = lane >> 4, nc = (lane & 15) * 4;
    const int sc = tr_src(mode, n0 + nc);
    f32x4 v[16];
#pragma unroll
    for (int i = 0; i < 16; ++i) v[i] = (sc >= 0) ? *(const f32x4*)(W + (size_t)(k0 + 4 * i + kr) * Nsrc + sc) : (f32x4){0.f, 0.f, 0.f, 0.f};
#pragma unroll
    for (int i = 0; i < 16; ++i) { const int k = 4 * i + kr; const unsigned p01 = pk2(v[i][0], v[i][1]), p23 = pk2(v[i][2], v[i][3]);
        scr[(nc + 0) * 72 + k] = (bf16_t)(p01 & 0xffffu); scr[(nc + 1) * 72 + k] = (bf16_t)(p01 >> 16); scr[(nc + 2) * 72 + k] = (bf16_t)(p23 & 0xffffu); scr[(nc + 3) * 72 + k] = (bf16_t)(p23 >> 16); }
    asm volatile("s_waitcnt lgkmcnt(0)" ::: "memory");
    const int nr = lane >> 3, kc = (lane & 7) * 8;
#pragma unroll
    for (int i = 0; i < 8; ++i) { const int n = 8 * i + nr; *(u32x4*)(WT + (size_t)(n0 + n) * K + k0 + kc) = *(const LAS u32x4*)(scr + n * 72 + kc); }
    asm volatile("s_waitcnt lgkmcnt(0)" ::: "memory");
}
__device__ __forceinline__ void p0_prologue(const Args& A, LAS unsigned char* lds, int gw, int NGW, int wave, int lane) {
    LAS bf16_t* scr = (LAS bf16_t*)(lds + wave * 16384);
    unsigned char* ws = A.ws;
    constexpr int NI0 = 16 * 88, NI1 = 44 * 16, NI2 = 16 * 148, NI3 = 32 * 16, NI4 = 16 * 16, NI5 = 16 * 16, NI6 = NI0, NI7 = NI1;
    constexpr int NIT = NI0 + NI1 + NI2 + NI3 + NI4 + NI5 + NI6 + NI7;
    for (int it = gw; it < NIT; it += NGW) {
        int r = it; const float* W; bf16_t* WT; int K, Nsrc, nblk, mode;
        if (r < NI0) { W = A.in[I_F1WI]; WT = (bf16_t*)(ws + WS_W1A); K = 1024; Nsrc = 2 * DFF; nblk = 88; mode = 1; }
        else if ((r -= NI0) < NI1) { W = A.in[I_F1WO]; WT = (bf16_t*)(ws + WS_W1B); K = DFF; Nsrc = 1024; nblk = 16; mode = 0; }
        else if ((r -= NI1) < NI2) { W = A.in[I_WIN]; WT = (bf16_t*)(ws + WS_WIN); K = 1024; Nsrc = 9320; nblk = 148; mode = 2; }
        else if ((r -= NI2) < NI3) { W = A.in[I_WBS]; WT = (bf16_t*)(ws + WS_WBS); K = 2048; Nsrc = 1024; nblk = 16; mode = 0; }
        else if ((r -= NI3) < NI4) { W = A.in[I_WBA]; WT = (bf16_t*)(ws + WS_WBA); K = 1024; Nsrc = 1024; nblk = 16; mode = 0; }
        else if ((r -= NI4) < NI5) { W = A.in[I_WOUT]; WT = (bf16_t*)(ws + WS_WOUT); K = 1024; Nsrc = 1024; nblk = 16; mode = 0; }
        else if ((r -= NI5) < NI6) { W = A.in[I_F2WI]; WT = (bf16_t*)(ws + WS_W2A); K = 1024; Nsrc = 2 * DFF; nblk = 88; mode = 1; }
        else { r -= NI6; W = A.in[I_F2WO]; WT = (bf16_t*)(ws + WS_W2B); K = DFF; Nsrc = 1024; nblk = 16; mode = 0; }
        const int kb = r / nblk, nb = r % nblk;
        tr_item(W, K, Nsrc, WT, kb * 64, nb * 64, mode, scr, lane);
    }
    bf16_t* XB = (bf16_t*)(ws + WS_XB);
    const int nchunk = M * D / 8;
    for (int ch0 = gw * 256 + lane; ch0 < nchunk; ch0 += NGW * 256) {
        f32x4 a[4], b[4];
#pragma unroll
        for (int u = 0; u < 4; ++u) { const int ch = ch0 + 64 * u, m = ch >> 7, c = (ch & 127) * 8;
            const float* src = (m < MP) ? A.in[I_XP] + (size_t)m * D + c : A.in[I_XS] + (size_t)(m - MP) * D + c; a[u] = *(const f32x4*)src; b[u] = *(const f32x4*)(src + 4); }
#pragma unroll
        for (int u = 0; u < 4; ++u) { const int ch = ch0 + 64 * u, m = ch >> 7, c = (ch & 127) * 8;
            u32x4 w; w.x = pk2(a[u][0], a[u][1]); w.y = pk2(a[u][2], a[u][3]); w.z = pk2(b[u][0], b[u][1]); w.w = pk2(b[u][2], b[u][3]);
            *(u32x4*)(XB + (size_t)m * D + c) = w; }
    }
}

__device__ __forceinline__ void ln_phase(const float* T, const float* g, const float* b, float* outf, bf16_t* outb, int gw, int NGW, int lane) {
    f32x4 gv[4], bv[4];
#pragma unroll
    for (int j = 0; j < 4; ++j) { gv[j] = *(const f32x4*)(g + 4 * lane + 256 * j); bv[j] = *(const f32x4*)(b + 4 * lane + 256 * j); }
    for (int m = gw; m < M; m += NGW) {
        const float* xr = T + (size_t)m * D + 4 * lane;
        f32x4 v[4]; float s = 0.f;
#pragma unroll
        for (int j = 0; j < 4; ++j) { v[j] = *(const f32x4*)(xr + 256 * j); s += (v[j][0] + v[j][1]) + (v[j][2] + v[j][3]); }
        const float mean = wave_sum(s) * (1.f / D); float s2 = 0.f;
#pragma unroll
        for (int j = 0; j < 4; ++j) { v[j] = v[j] - mean; s2 += (v[j][0] * v[j][0] + v[j][1] * v[j][1]) + (v[j][2] * v[j][2] + v[j][3] * v[j][3]); }
        const float rstd = 1.0f / sqrtf(wave_sum(s2) * (1.f / D) + LN_EPS);
#pragma unroll
        for (int j = 0; j < 4; ++j) {
            const f32x4 o = v[j] * rstd * gv[j] + bv[j];
            *(f32x4*)(outf + (size_t)m * D + 4 * lane + 256 * j) = o;
            if (outb) { u32x2 w; w.x = pk2(o[0], o[1]); w.y = pk2(o[2], o[3]); *(u32x2*)(outb + (size_t)m * D + 4 * lane + 256 * j) = w; }
        }
    }
}

template <int NT  , bool SAMP>
__device__ __forceinline__ void conv_item(const Args& A, int b, int t0, int cg, int lane) {
    const bf16_t* P = (const bf16_t*)(A.ws + WS_P); bf16_t* XC = (bf16_t*)(A.ws + WS_XC);
    const float* cw = A.in[I_CONVW]; const float* cb = A.in[I_CONVB];
    const int ch = (cg * 64 + lane) * 8;
    const size_t row0 = SAMP ? (size_t)(MP + b * 4) : (size_t)(b * 2048 + t0);
    u32x4 raw[NT + 3];
#pragma unroll
    for (int i = 0; i < NT + 3; ++i) {
        const int t = t0 - 3 + i;
        if (t >= 0) raw[i] = *(const u32x4*)(P + (row0 + (size_t)(i - 3)) * NP + PXBC + ch);
        else raw[i] = (u32x4){0u, 0u, 0u, 0u};
    }
    float w[4][8], bias[8];
#pragma unroll
    for (int j = 0; j < 4; ++j) { const f32x4 w0 = *(const f32x4*)(cw + (size_t)j * XCW + ch), w1 = *(const f32x4*)(cw + (size_t)j * XCW + ch + 4);
#pragma unroll
        for (int i = 0; i < 4; ++i) { w[j][i] = w0[i]; w[j][4 + i] = w1[i]; } }
    { const f32x4 b0 = *(const f32x4*)(cb + ch), b1 = *(const f32x4*)(cb + ch + 4);
#pragma unroll
      for (int i = 0; i < 4; ++i) { bias[i] = b0[i]; bias[4 + i] = b1[i]; } }
    float u0[8], u1[8], u2[8];
    if (SAMP) {
        const float* sc = A.in[I_SCONV] + (size_t)b * 3 * XCW + ch;
#pragma unroll
        for (int i = 0; i < 4; ++i) { const f32x4 a0 = *(const f32x4*)(sc), a1 = *(const f32x4*)(sc + 4), c0 = *(const f32x4*)(sc + XCW), c1 = *(const f32x4*)(sc + XCW + 4), e0 = *(const f32x4*)(sc + 2 * XCW), e1 = *(const f32x4*)(sc + 2 * XCW + 4);
            u0[i] = a0[i]; u0[4 + i] = a1[i]; u1[i] = c0[i]; u1[4 + i] = c1[i]; u2[i] = e0[i]; u2[4 + i] = e1[i]; }
    } else { unpack8(raw[0], u0); unpack8(raw[1], u1); unpack8(raw[2], u2); }
#pragma unroll
    for (int i = 0; i < NT; ++i) {
        float u3[8], o[8]; unpack8(raw[i + 3], u3);
#pragma unroll
        for (int e = 0; e < 8; ++e) o[e] = siluf_(bias[e] + w[0][e] * u0[e] + w[1][e] * u1[e] + w[2][e] * u2[e] + w[3][e] * u3[e]);
        *(u32x4*)(XC + (row0 + (size_t)i) * XCW + ch) = pack8(o);
        const int t = t0 + i; float* cs = nullptr;
        if (!SAMP) { if (t >= 2045) cs = A.out + O_CVP + ((size_t)b * 3 + (t - 2045)) * XCW + ch; }
        else { if (t >= 1) cs = A.out + O_CVS + ((size_t)b * 3 + (t - 1)) * XCW + ch; }
        if (cs) { *(f32x4*)cs = (f32x4){u3[0], u3[1], u3[2], u3[3]}; *(f32x4*)(cs + 4) = (f32x4){u3[4], u3[5], u3[6], u3[7]}; }
#pragma unroll
        for (int e = 0; e < 8; ++e) { u0[e] = u1[e]; u1[e] = u2[e]; u2[e] = u3[e]; }
    }
}
__device__ __forceinline__ void conv_phase(const Args& A, int gw, int NGW, int lane) {
    constexpr int NPI = 8 * 128 * 6, NSI = 128 * 6;
    for (int it = gw; it < NPI + NSI; it += NGW) {
        if (it < NPI) { const int cg = it % 6, r = it / 6; conv_item<16, false>(A, r >> 7, (r & 127) * 16, cg, lane); }
        else { const int r = it - NPI; conv_item<4, true>(A, r / 6, 0, r % 6, lane); }
    }
}

constexpr float IDX_SCALE = 0.125f * 0.35355339059327373f;
constexpr int SCL = 2052;
__device__ __forceinline__ unsigned f2key(float v) { unsigned u = (v == 0.f) ? 0u : __float_as_uint(v); return (u & 0x80000000u) ? ~u : (u | 0x80000000u); }
__device__ __forceinline__ void scores_select_prompt_unit(const Args& A, LAS unsigned char* lds, int b, int qt, int wave, int lane_in) {
    const bf16_t* P = (const bf16_t*)(A.ws + WS_P); const float* SMF = (const float*)(A.ws + WS_SMF);
    unsigned long long* MASKW = (unsigned long long*)(A.ws + WS_SC);
    LAS float* sc = (LAS float*)lds;
    int lane = lane_in; asm volatile("" : "+v"(lane));
    const int fr = lane & 15, fq = lane >> 4;
    {
        const size_t rowq = (size_t)(b * 2048 + qt * 16 + fr);
        bf16x8 Af[8][2];
#pragma unroll
        for (int h = 0; h < 8; ++h)
#pragma unroll
            for (int ks = 0; ks < 2; ++ks) Af[h][ks] = *(const bf16x8*)(P + rowq * NP + PQI + h * 64 + ks * 32 + 8 * fq);
        float wq[4][8];
#pragma unroll
        for (int j = 0; j < 4; ++j) { const float* wp = SMF + (size_t)(b * 2048 + qt * 16 + 4 * fq + j) * 128 + 32; const f32x4 w0 = *(const f32x4*)wp, w1 = *(const f32x4*)(wp + 4);
#pragma unroll
            for (int h = 0; h < 4; ++h) { wq[j][h] = w0[h] * IDX_SCALE; wq[j][4 + h] = w1[h] * IDX_SCALE; } }
        const bf16_t* kbase = P + (size_t)(b * 2048 + fr) * NP + PSM + 64 + 8 * fq;
        bf16x8 nB0 = {0, 0, 0, 0, 0, 0, 0, 0}, nB1 = nB0;
        if (wave <= qt) { const bf16_t* kp = kbase + (size_t)wave * 16 * NP; nB0 = *(const bf16x8*)kp; nB1 = *(const bf16x8*)(kp + 32); }
        for (int kt = wave; kt <= qt; kt += NWAVES) {
            const bf16x8 B0 = nB0, B1 = nB1;
            if (kt + NWAVES <= qt) { const bf16_t* kp = kbase + (size_t)(kt + NWAVES) * 16 * NP; nB0 = *(const bf16x8*)kp; nB1 = *(const bf16x8*)(kp + 32); }
            f32x4 scv = {0.f, 0.f, 0.f, 0.f};
#pragma unroll
            for (int h = 0; h < 8; ++h) { f32x4 d = {0.f, 0.f, 0.f, 0.f}; d = mfma16(Af[h][0], B0, d); d = mfma16(Af[h][1], B1, d);
#pragma unroll
                for (int j = 0; j < 4; ++j) scv[j] += wq[j][h] * fmaxf(d[j], 0.f); }
#pragma unroll
            for (int j = 0; j < 4; ++j) sc[(4 * fq + j) * SCL + kt * 16 + fr] = scv[j];
#if MK_CHECK_ATT
#pragma unroll
            for (int j = 0; j < 4; ++j) ((float*)(A.ws + WS_END))[(size_t)(b * 2048 + qt * 16 + 4 * fq + j) * SCW + kt * 16 + fr] = scv[j];
#endif
        }
    }
    __syncthreads();
#pragma unroll 1
    for (int u = 0; u < 2; ++u) {
        const int ql = 2 * wave + u, t = qt * 16 + ql, nvalid = t + 1;
        const LAS float* srow = sc + ql * SCL + lane;
        unsigned key[32];
#pragma unroll
        for (int j = 0; j < 32; ++j) key[j] = (lane < nvalid - 64 * j) ? f2key(srow[64 * j]) : 0u;
        unsigned T = 0u; int need_eq = 0;
        if (nvalid > 256) {
            bool exact = false;
            for (int bit = 31; bit >= 0; --bit) {
                const unsigned cand = T | (1u << bit); int cnt = 0;
#pragma unroll
                for (int j = 0; j < 32; ++j) cnt += __popcll(__ballot(key[j] >= cand));
                if (cnt >= 256) { T = cand; if (cnt == 256) { exact = true; break; } }
            }
            if (exact) { T -= 1u; }
            else { int cgt = 0;
#pragma unroll
                for (int j = 0; j < 32; ++j) cgt += __popcll(__ballot(key[j] > T));
                need_eq = 256 - cgt; }
        }
        int eqused = 0; unsigned long long mine = 0ull;
#pragma unroll
        for (int j = 0; j < 32; ++j) {
            unsigned long long ms;
            if (need_eq > 0) {
                const bool gt = key[j] > T, eq = key[j] == T;
                const unsigned long long meq = __ballot(eq);
                const bool sel = gt || (eq && (eqused + mbcnt64(meq) < need_eq));
                eqused += __popcll(meq);
                ms = __ballot(sel);
            } else ms = __ballot(key[j] > T);
            if (lane == j) mine = ms;
        }
        if (lane < 32) MASKW[(size_t)(b * 2048 + t) * 32 + lane] = mine;
    }
    __syncthreads();
}
__device__ __forceinline__ void scores_sample_unit(const Args& A, int b, int half, int wave, int lane) {
    const bf16_t* P = (const bf16_t*)(A.ws + WS_P); const float* SMF = (const float*)(A.ws + WS_SMF); float* SCS = (float*)(A.ws + WS_SCS);
    const int* pt = (const int*)A.in[I_PT]; const float* cki = A.in[I_CKI];
    const int fr = lane & 15, fq = lane >> 4;
    bf16x8 Af[2][2]; float wq[2][4];
#pragma unroll
    for (int mt = 0; mt < 2; ++mt) {
#pragma unroll
        for (int ks = 0; ks < 2; ++ks) Af[mt][ks] = *(const bf16x8*)(P + (size_t)(MP + b * 4 + 2 * mt + (fr >> 3)) * NP + PQI + (fr & 7) * 64 + ks * 32 + 8 * fq);
        const f32x4 w = *(const f32x4*)(SMF + (size_t)(MP + b * 4 + 2 * mt + (fq >> 1)) * 128 + 32 + 4 * (fq & 1));
#pragma unroll
        for (int j = 0; j < 4; ++j) wq[mt][j] = w[j] * IDX_SCALE;
    }
    const int kt_end = (half == 0) ? 65 : 129;
    for (int kt = half * 65 + wave; kt < kt_end; kt += NWAVES) {
        const int key = kt * 16 + fr;
        bf16x8 B0, B1;
        if (key < 2048) {
            const int page = pt[b * 16 + (key >> 7)];
            const float* src = cki + ((size_t)page * 128 + (key & 127)) * 64 + 8 * fq;
            const f32x4 a0 = *(const f32x4*)src, a1 = *(const f32x4*)(src + 4), c0 = *(const f32x4*)(src + 32), c1 = *(const f32x4*)(src + 36);
            u32x4 w0, w1; w0.x = pk2(a0[0], a0[1]); w0.y = pk2(a0[2], a0[3]); w0.z = pk2(a1[0], a1[1]); w0.w = pk2(a1[2], a1[3]);
            w1.x = pk2(c0[0], c0[1]); w1.y = pk2(c0[2], c0[3]); w1.z = pk2(c1[0], c1[1]); w1.w = pk2(c1[2], c1[3]);
            B0 = __builtin_bit_cast(bf16x8, w0); B1 = __builtin_bit_cast(bf16x8, w1);
        } else if (key < 2052) {
            const bf16_t* src = P + (size_t)(MP + b * 4 + (key - 2048)) * NP + PSM + 64 + 8 * fq;
            B0 = *(const bf16x8*)src; B1 = *(const bf16x8*)(src + 32);
        } else { B0 = (bf16x8){0, 0, 0, 0, 0, 0, 0, 0}; B1 = B0; }
#pragma unroll
        for (int mt = 0; mt < 2; ++mt) {
            f32x4 d = {0.f, 0.f, 0.f, 0.f}; d = mfma16(Af[mt][0], B0, d); d = mfma16(Af[mt][1], B1, d);
            float s = 0.f;
#pragma unroll
            for (int j = 0; j < 4; ++j) s += wq[mt][j] * fmaxf(d[j], 0.f);
            s += __shfl_xor(s, 16);
            if ((fq & 1) == 0 && key < 2052) SCS[(size_t)(b * 4 + 2 * mt + (fq >> 1)) * SCSW + key] = s;
        }
    }
}

__device__ __forceinline__ float softplusf_(float x) { return fmaxf(x, 0.f) + log1pf(expf(-fabsf(x))); }
__device__ __forceinline__ void ssd_prompt_item(const Args& A, LAS unsigned char* lds, int b, int h) {
    const int tid = threadIdx.x, lane = tid & 63, wave = __builtin_amdgcn_readfirstlane(tid >> 6), fr = lane & 15, fq = lane >> 4;
    const int g = h >> 3;
    const bf16_t* XC = (const bf16_t*)(A.ws + WS_XC); const float* SMF = (const float*)(A.ws + WS_SMF); bf16_t* Y = (bf16_t*)(A.ws + WS_Y);
    LAS bf16_t* Cm = (LAS bf16_t*)lds;
    LAS bf16_t* Bm = Cm + 64 * 136;
    LAS bf16_t* Btw = Bm + 64 * 136;
    LAS bf16_t* Xt = Btw + 128 * 72;
    LAS bf16_t* Mt = Xt + 64 * 72;
    LAS bf16_t* Hp = Mt + 64 * 72;
    LAS float* cumA = (LAS float*)(Hp + 64 * 136);
    LAS float* dtvA = cumA + 2048; LAS float* wvA = dtvA + 2048; LAS float* ecumA = wvA + 2048;
    const float Ah = -expf(A.in[I_ALOG][h]), dtb = A.in[I_DTB][h], dsk = A.in[I_DSKIP][h];
    f32x4 hst[4];
#pragma unroll
    for (int i = 0; i < 4; ++i) hst[i] = (f32x4){0.f, 0.f, 0.f, 0.f};
    for (int i = tid; i < 64 * 136 / 8; i += NTHR) *(LAS u32x4*)(Hp + i * 8) = (u32x4){0u, 0u, 0u, 0u};
#pragma unroll 1
    for (int c = wave; c < 32; c += NWAVES) {
        const int tk = c * 64 + lane;
        const float dt = softplusf_(SMF[(size_t)(b * 2048 + tk) * 128 + h] + dtb);
        float v = dt * Ah;
#pragma unroll
        for (int o = 1; o < 64; o <<= 1) { const float n = __shfl_up(v, o); if (lane >= o) v += n; }
        const float ce = __shfl(v, 63);
        cumA[tk] = v; dtvA[tk] = dt; wvA[tk] = dt * expf(ce - v); ecumA[tk] = expf(v);
    }
    const int s0 = tid >> 4, part0 = tid & 15;
    const int xs = tid >> 3, xpart = tid & 7;
    u32x4 cr[2], br[2], xr;
    {
#pragma unroll
        for (int i = 0; i < 2; ++i) { const bf16_t* rp = XC + (size_t)(b * 2048 + s0 + 32 * i) * XCW + g * 128 + part0 * 8; cr[i] = *(const u32x4*)(rp + 2560); br[i] = *(const u32x4*)(rp + 2048); }
        xr = *(const u32x4*)(XC + (size_t)(b * 2048 + xs) * XCW + h * 64 + xpart * 8);
    }
    for (int c = 0; c < 32; ++c) {
        const int row0 = b * 2048 + c * 64;
        const LAS float* cum = cumA + c * 64; const LAS float* dtv = dtvA + c * 64; const LAS float* wv = wvA + c * 64; const LAS float* ecum = ecumA + c * 64;
        __syncthreads();
#pragma unroll
        for (int i = 0; i < 2; ++i) {
            const int s = s0 + 32 * i;
            *(LAS u32x4*)(Cm + s * 136 + part0 * 8) = cr[i];
            *(LAS u32x4*)(Bm + s * 136 + part0 * 8) = br[i];
            float bf[8]; unpack8(br[i], bf); const float w = wv[s];
#pragma unroll
            for (int e = 0; e < 8; ++e) Btw[(part0 * 8 + e) * 72 + s] = (bf16_t)f2bf(bf[e] * w);
        }
        {
#pragma unroll
            for (int e = 0; e < 4; ++e) { Xt[(xpart * 8 + 2 * e) * 72 + xs] = (bf16_t)(xr[e] & 0xffffu); Xt[(xpart * 8 + 2 * e + 1) * 72 + xs] = (bf16_t)(xr[e] >> 16); }
        }
#pragma unroll
        for (int p4 = 0; p4 < 4; ++p4) { u32x2 w; w.x = pk2(hst[p4][0], hst[p4][1]); w.y = pk2(hst[p4][2], hst[p4][3]);
            *(LAS u32x2*)(Hp + (16 * p4 + fr) * 136 + 16 * wave + 4 * fq) = w; }
        if (c + 1 < 32) {
#pragma unroll
            for (int i = 0; i < 2; ++i) { const bf16_t* rp = XC + (size_t)(row0 + 64 + s0 + 32 * i) * XCW + g * 128 + part0 * 8; cr[i] = *(const u32x4*)(rp + 2560); br[i] = *(const u32x4*)(rp + 2048); }
            xr = *(const u32x4*)(XC + (size_t)(row0 + 64 + xs) * XCW + h * 64 + xpart * 8);
        }
        __syncthreads();
        {
            const int st = wave >> 1, tt0 = 2 * (wave & 1);
            bf16x8 a[4];
#pragma unroll
            for (int ks = 0; ks < 4; ++ks) a[ks] = *(const LAS bf16x8*)(Bm + (16 * st + fr) * 136 + ks * 32 + 8 * fq);
#pragma unroll
            for (int u = 0; u < 2; ++u) {
                const int tt = tt0 + u; f32x4 d = {0.f, 0.f, 0.f, 0.f};
#pragma unroll
                for (int ks = 0; ks < 4; ++ks) { const bf16x8 bb = *(const LAS bf16x8*)(Cm + (16 * tt + fr) * 136 + ks * 32 + 8 * fq); d = mfma16(a[ks], bb, d); }
                const int t = 16 * tt + fr; const float ct = cum[t]; float mv[4];
#pragma unroll
                for (int j = 0; j < 4; ++j) { const int s = 16 * st + 4 * fq + j; mv[j] = (s <= t) ? d[j] * __expf(ct - cum[s]) * dtv[s] : 0.f; }
                u32x2 w; w.x = pk2(mv[0], mv[1]); w.y = pk2(mv[2], mv[3]);
                *(LAS u32x2*)(Mt + t * 72 + 16 * st + 4 * fq) = w;
            }
        }
        __syncthreads();
        {
            const int pt = wave >> 1, tt0 = 2 * (wave & 1);
            bf16x8 a1[2], a2[4];
#pragma unroll
            for (int ks = 0; ks < 2; ++ks) a1[ks] = *(const LAS bf16x8*)(Xt + (16 * pt + fr) * 72 + ks * 32 + 8 * fq);
#pragma unroll
            for (int ks = 0; ks < 4; ++ks) a2[ks] = *(const LAS bf16x8*)(Hp + (16 * pt + fr) * 136 + ks * 32 + 8 * fq);
#pragma unroll
            for (int u = 0; u < 2; ++u) {
                const int tt = tt0 + u; f32x4 d1 = {0.f, 0.f, 0.f, 0.f}, d2 = {0.f, 0.f, 0.f, 0.f};
#pragma unroll
                for (int ks = 0; ks < 2; ++ks) { const bf16x8 bb = *(const LAS bf16x8*)(Mt + (16 * tt + fr) * 72 + ks * 32 + 8 * fq); d1 = mfma16(a1[ks], bb, d1); }
#pragma unroll
                for (int ks = 0; ks < 4; ++ks) { const bf16x8 bb = *(const LAS bf16x8*)(Cm + (16 * tt + fr) * 136 + ks * 32 + 8 * fq); d2 = mfma16(a2[ks], bb, d2); }
                const int t = 16 * tt + fr; const float et = ecum[t]; float yv[4];
#pragma unroll
                for (int j = 0; j < 4; ++j) { const int p = 16 * pt + 4 * fq + j; yv[j] = d1[j] + et * d2[j] + dsk * bf2f((unsigned)Xt[p * 72 + t]); }
                u32x2 w; w.x = pk2(yv[0], yv[1]); w.y = pk2(yv[2], yv[3]);
                *(u32x2*)(Y + (size_t)(row0 + t) * DI + h * 64 + 16 * pt + 4 * fq) = w;
            }
            bf16x8 a3[2];
#pragma unroll
            for (int ks = 0; ks < 2; ++ks) a3[ks] = *(const LAS bf16x8*)(Btw + (16 * wave + fr) * 72 + ks * 32 + 8 * fq);
            const float dec = ecum[63];
#pragma unroll
            for (int p4 = 0; p4 < 4; ++p4) { f32x4 d = {0.f, 0.f, 0.f, 0.f};
#pragma unroll
                for (int ks = 0; ks < 2; ++ks) { const bf16x8 bb = *(const LAS bf16x8*)(Xt + (16 * p4 + fr) * 72 + ks * 32 + 8 * fq); d = mfma16(a3[ks], bb, d); }
                hst[p4] = hst[p4] * dec + d; }
        }
    }
    float* so = A.out + O_SSP + ((size_t)b * 32 + h) * 64 * 128;
#pragma unroll
    for (int p4 = 0; p4 < 4; ++p4) *(f32x4*)(so + (size_t)(16 * p4 + fr) * 128 + 16 * wave + 4 * fq) = hst[p4];
    __syncthreads();
}

__device__ __forceinline__ void ssd_sample_item(const Args& A, LAS unsigned char* wl, int b, int h, int lane) {
    const bf16_t* XC = (const bf16_t*)(A.ws + WS_XC); const float* SMF = (const float*)(A.ws + WS_SMF); bf16_t* Y = (bf16_t*)(A.ws + WS_Y);
    LAS float* red = (LAS float*)wl;
    const int g = h >> 3;
    const float Ah = -expf(A.in[I_ALOG][h]), dtb = A.in[I_DTB][h], dsk = A.in[I_DSKIP][h];
#pragma unroll 1
    for (int half = 0; half < 2; ++half) {
        const float* h0 = A.in[I_SSSM] + (((size_t)b * 32 + h) * 64 + 32 * half) * 128 + 2 * lane;
        float st[32][2];
#pragma unroll
        for (int p = 0; p < 32; ++p) { const float2 v = *(const float2*)(h0 + p * 128); st[p][0] = v.x; st[p][1] = v.y; }
#pragma unroll 1
        for (int t = 0; t < 4; ++t) {
            const size_t m = (size_t)(MP + b * 4 + t);
            const float dt = softplusf_(SMF[m * 128 + h] + dtb), dec = expf(dt * Ah);
            const unsigned bw = *(const unsigned*)(XC + m * XCW + 2048 + g * 128 + 2 * lane), cw = *(const unsigned*)(XC + m * XCW + 2560 + g * 128 + 2 * lane);
            const float b0 = bf2f(bw & 0xffffu) * dt, b1 = __uint_as_float(bw & 0xffff0000u) * dt, c0 = bf2f(cw & 0xffffu), c1 = __uint_as_float(cw & 0xffff0000u);
            const float xl = bf2f((unsigned)XC[m * XCW + h * 64 + 32 * half + (lane & 31)]);
#pragma unroll
            for (int p = 0; p < 32; ++p) {
                const float xp = __shfl(xl, p);
                st[p][0] = st[p][0] * dec + xp * b0; st[p][1] = st[p][1] * dec + xp * b1;
                red[p * 65 + lane] = st[p][0] * c0 + st[p][1] * c1;
            }
            asm volatile("s_waitcnt lgkmcnt(0)" ::: "memory");
            float y = 0.f;
#pragma unroll 16
            for (int i = 0; i < 64; ++i) y += red[(lane & 31) * 65 + i];
            y += dsk * xl;
            if (lane < 32) Y[m * DI + h * 64 + 32 * half + lane] = (bf16_t)f2bf(y);
            asm volatile("s_waitcnt lgkmcnt(0)" ::: "memory");
        }
        float* so = A.out + O_SSS + (((size_t)b * 32 + h) * 64 + 32 * half) * 128 + 2 * lane;
#pragma unroll
        for (int p = 0; p < 32; ++p) *(float2*)(so + p * 128) = make_float2(st[p][0], st[p][1]);
    }
}

__device__ __forceinline__ int t5_bucket(int n) {
    if (n < 16) return n;
    const float nf = (float)n;
    int large = 16 + (int)(logf(nf / 16.0f) / 2.0794415416798357f * 16.0f);
    return large < 31 ? large : 31;
}
typedef float f32x16 __attribute__((ext_vector_type(16)));
__device__ __forceinline__ f32x16 mfma32(bf16x8 a, bf16x8 b, f32x16 c) { return __builtin_amdgcn_mfma_f32_32x32x16_bf16(a, b, c, 0, 0, 0); }
constexpr float LOG2E = 1.4426950408889634f;
constexpr int AK_STR = 72, AV_STR = 96, ATK_T = 64 * AK_STR * 2, ATV_T = 64 * AV_STR * 2, AT_K0 = 0, AT_V0 = 4 * ATK_T, AT_WS = AT_V0 + 4 * ATV_T;
struct AttStage { u32x4 k0, v0, k1, v1, m; };
__device__ __forceinline__ void att_issue(AttStage& R, const bf16_t* src, const unsigned* msrc) {
    const bf16_t* src1 = src + (size_t)64 * NP;
    asm volatile("global_load_dwordx4 %0, %5, off\n\tglobal_load_dwordx4 %1, %5, off offset:512\n\tglobal_load_dwordx4 %2, %6, off\n\tglobal_load_dwordx4 %3, %6, off offset:512\n\tglobal_load_dwordx4 %4, %7, off"
                 : "=&v"(R.k0), "=&v"(R.v0), "=&v"(R.k1), "=&v"(R.v1), "=&v"(R.m) : "v"(src), "v"(src1), "v"(msrc) : "memory");
}
__device__ __forceinline__ void att_wait(AttStage& R) { asm volatile("s_waitcnt vmcnt(0)" : "+v"(R.k0), "+v"(R.v0), "+v"(R.k1), "+v"(R.v1), "+v"(R.m) :: "memory"); }
__device__ __forceinline__ void att_stage_write1(const u32x4 k, const u32x4 v, LAS bf16_t* Kb, LAS bf16_t* Vb, int skey, int sdch) {
    *(LAS u32x4*)(Kb + skey * AK_STR + sdch * 8) = k;
    *(LAS u32x4*)(Vb + skey * AV_STR + sdch * 8) = v;
}
typedef short v4i16_t __attribute__((ext_vector_type(4)));
__device__ __forceinline__ u32x2 lds_tr16(const LAS bf16_t* p) { return __builtin_bit_cast(u32x2, __builtin_amdgcn_ds_read_tr16_b64_v4i16((LAS v4i16_t*)p)); }
struct AttState { f32x16 O0, O1; float m_run, l_run; };
__device__ __forceinline__ void att_tile(AttState& st, const LAS bf16_t* Kb, const LAS bf16_t* Vb, const bf16x8 (&qf)[4], unsigned mw0, unsigned mw1, bool far, float bfar, const LAS float* bl  ,
                                         int rb  , LAS float* wsc, int r32, int hi) {
    const int lane16 = r32 & 15, blk16 = r32 >> 4;
    const unsigned w0 = mw0 >> (4 * hi), w1 = mw1 >> (4 * hi);
    f32x16 S0, S1;
#pragma unroll
    for (int i = 0; i < 16; ++i) { S0[i] = 0.f; S1[i] = 0.f; }
#pragma unroll
    for (int ds = 0; ds < 4; ++ds) {
        const bf16x8 k0 = *(const LAS bf16x8*)(Kb + r32 * AK_STR + 16 * ds + 8 * hi), k1 = *(const LAS bf16x8*)(Kb + (32 + r32) * AK_STR + 16 * ds + 8 * hi);
        S0 = mfma32(k0, qf[ds], S0); S1 = mfma32(k1, qf[ds], S1);
    }
    const float c1 = 0.125f * LOG2E;
    if (far) {
#pragma unroll
        for (int i = 0; i < 16; ++i) { const unsigned bit = 1u << ((i & 3) + 8 * (i >> 2));
            S0[i] = (w0 & bit) ? S0[i] * c1 + bfar : -INFINITY; S1[i] = (w1 & bit) ? S1[i] * c1 + bfar : -INFINITY; }
    } else {
        float bv0[16], bv1[16];
#pragma unroll
        for (int i = 0; i < 16; ++i) { const int pos = (i & 3) + 8 * (i >> 2);
            int r0 = rb - pos, r1 = r0 - 32; r0 = r0 < 0 ? 0 : (r0 > 128 ? 128 : r0); r1 = r1 < 0 ? 0 : (r1 > 128 ? 128 : r1);
            bv0[i] = bl[r0 * 16]; bv1[i] = bl[r1 * 16]; }
#pragma unroll
        for (int i = 0; i < 16; ++i) { const unsigned bit = 1u << ((i & 3) + 8 * (i >> 2));
            const float x0 = S0[i] * c1 + bv0[i], x1 = S1[i] * c1 + bv1[i];
            S0[i] = (w0 & bit) ? x0 : -INFINITY; S1[i] = (w1 & bit) ? x1 : -INFINITY; }
    }
    float tm = fmaxf(S0[0], S1[0]);
#pragma unroll
    for (int i = 1; i < 16; ++i) tm = fmaxf(tm, fmaxf(S0[i], S1[i]));
    tm = fmaxf(tm, __shfl_xor(tm, 32));
    if (__any(tm > st.m_run + 8.0f)) {
        const float mn = fmaxf(st.m_run, tm), f = __builtin_amdgcn_exp2f(st.m_run - mn);
        st.m_run = mn; st.l_run *= f;
        if (hi == 0) wsc[r32] = f;
        asm volatile("s_waitcnt lgkmcnt(0)" ::: "memory");
#pragma unroll
        for (int i = 0; i < 16; ++i) { const float fi = wsc[(i & 3) + 8 * (i >> 2) + 4 * hi]; st.O0[i] *= fi; st.O1[i] *= fi; }
        asm volatile("s_waitcnt lgkmcnt(0)" ::: "memory");
    }
    float ls = 0.f; const float mr = st.m_run;
#pragma unroll
    for (int i = 0; i < 16; ++i) { S0[i] = __builtin_amdgcn_exp2f(S0[i] - mr); S1[i] = __builtin_amdgcn_exp2f(S1[i] - mr); ls += S0[i] + S1[i]; }
    st.l_run += ls;
    bf16x8 pa[2][2];
#pragma unroll
    for (int sk = 0; sk < 2; ++sk) {
        u32x4 a0, a1;
        a0.x = pk2(S0[8 * sk + 0], S0[8 * sk + 1]); a0.y = pk2(S0[8 * sk + 2], S0[8 * sk + 3]); a0.z = pk2(S0[8 * sk + 4], S0[8 * sk + 5]); a0.w = pk2(S0[8 * sk + 6], S0[8 * sk + 7]);
        a1.x = pk2(S1[8 * sk + 0], S1[8 * sk + 1]); a1.y = pk2(S1[8 * sk + 2], S1[8 * sk + 3]); a1.z = pk2(S1[8 * sk + 4], S1[8 * sk + 5]); a1.w = pk2(S1[8 * sk + 6], S1[8 * sk + 7]);
        pa[0][sk] = __builtin_bit_cast(bf16x8, a0); pa[1][sk] = __builtin_bit_cast(bf16x8, a1);
    }
    const LAS bf16_t* vl = Vb + (4 * hi + ((lane16 >> 2))) * AV_STR + 16 * blk16 + 4 * (lane16 & 3);
#pragma unroll
    for (int blk = 0; blk < 2; ++blk)
#pragma unroll
        for (int sk = 0; sk < 2; ++sk) {
            const LAS bf16_t* vr = vl + (32 * blk + 16 * sk) * AV_STR;
            const u32x2 a = lds_tr16(vr), c = lds_tr16(vr + 8 * AV_STR), a2 = lds_tr16(vr + 32), c2 = lds_tr16(vr + 8 * AV_STR + 32);
            const u32x4 v0 = {a.x, a.y, c.x, c.y}, v1 = {a2.x, a2.y, c2.x, c2.y};
            st.O0 = mfma32(pa[blk][sk], __builtin_bit_cast(bf16x8, v0), st.O0);
            st.O1 = mfma32(pa[blk][sk], __builtin_bit_cast(bf16x8, v1), st.O1);
        }
}
__device__ __forceinline__ void attn_prompt_unit(const Args& A, LAS unsigned char* lds, const LAS float* biasL, int b, int g, int qt, int wave, int lane_in) {
    const bf16_t* P = (const bf16_t*)(A.ws + WS_P); const unsigned* MASK32 = (const unsigned*)(A.ws + WS_SC); bf16_t* YA = (bf16_t*)(A.ws + WS_YA);
    int lane = lane_in; asm volatile("" : "+v"(lane));
    const int tid = wave * 64 + lane, r32 = lane & 31, hi = lane >> 5;
    LAS float* wsc = (LAS float*)(lds + AT_WS) + wave * 64;
    const int query = qt * 64 + 8 * wave + (r32 >> 2), head = 4 * g + (r32 & 3);
    const size_t qrow = (size_t)(b * 2048 + query);
    bf16x8 qf[4];
#pragma unroll
    for (int ds = 0; ds < 4; ++ds) qf[ds] = *(const bf16x8*)(P + qrow * NP + PQ + head * 64 + 16 * ds + 8 * hi);
    const unsigned* mrow = MASK32 + qrow * 64;
    float bfar = biasL[128 * 16 + head];
    const LAS float* bl = biasL + head;
    asm volatile("" : "+v"(qf[0]), "+v"(qf[1]), "+v"(qf[2]), "+v"(qf[3]), "+v"(bfar));
    const int skey = tid >> 3, sdch = tid & 7;
    const bf16_t* ksrc = P + (size_t)(b * 2048 + skey) * NP + PK + g * 64 + sdch * 8;
    AttState st;
#pragma unroll
    for (int i = 0; i < 16; ++i) { st.O0[i] = 0.f; st.O1[i] = 0.f; }
    st.m_run = -1e30f; st.l_run = 0.f;
    const int nstep = (qt + 2) >> 1;
    AttStage R;
    att_issue(R, ksrc, mrow);
    att_wait(R);
    att_stage_write1(R.k0, R.v0, (LAS bf16_t*)(lds + AT_K0), (LAS bf16_t*)(lds + AT_V0), skey, sdch);
    att_stage_write1(R.k1, R.v1, (LAS bf16_t*)(lds + AT_K0 + ATK_T), (LAS bf16_t*)(lds + AT_V0 + ATV_T), skey, sdch);
    u32x4 mw = R.m;
    for (int j = 0; j < nstep; ++j) {
        const int buf = j & 1, kt = 2 * j;
        __syncthreads();
        { const int jn = (j + 1 < nstep) ? j + 1 : j; att_issue(R, ksrc + (size_t)jn * 128 * NP, mrow + 4 * jn); }
        const LAS bf16_t* Kb = (const LAS bf16_t*)(lds + AT_K0 + buf * (2 * ATK_T)); const LAS bf16_t* Vb = (const LAS bf16_t*)(lds + AT_V0 + buf * (2 * ATV_T));
        att_tile(st, Kb, Vb, qf, mw[0], mw[1], qt - kt >= 3, bfar, bl, query - (kt * 64 + 4 * hi), wsc, r32, hi);
        if (kt + 1 <= qt) att_tile(st, (const LAS bf16_t*)((const LAS unsigned char*)Kb + ATK_T), (const LAS bf16_t*)((const LAS unsigned char*)Vb + ATV_T), qf, mw[2], mw[3], qt - kt - 1 >= 3, bfar, bl, query - ((kt + 1) * 64 + 4 * hi), wsc, r32, hi);
        att_wait(R);
        if (j + 1 < nstep) {
            LAS bf16_t* Kn = (LAS bf16_t*)(lds + AT_K0 + (buf ^ 1) * (2 * ATK_T)); LAS bf16_t* Vn = (LAS bf16_t*)(lds + AT_V0 + (buf ^ 1) * (2 * ATV_T));
            att_stage_write1(R.k0, R.v0, Kn, Vn, skey, sdch);
            att_stage_write1(R.k1, R.v1, (LAS bf16_t*)((LAS unsigned char*)Kn + ATK_T), (LAS bf16_t*)((LAS unsigned char*)Vn + ATV_T), skey, sdch);
        }
        mw = R.m;
    }
    st.l_run += __shfl_xor(st.l_run, 32);
    if (hi == 0) wsc[r32] = 1.0f / st.l_run;
    asm volatile("s_waitcnt lgkmcnt(0)" ::: "memory");
#pragma unroll
    for (int i = 0; i < 16; ++i) {
        const int rq = (i & 3) + 8 * (i >> 2) + 4 * hi; const float inv = wsc[rq];
        bf16_t* dst = YA + (size_t)(b * 2048 + qt * 64 + 8 * wave + (rq >> 2)) * D + (4 * g + (rq & 3)) * 64 + r32;
        dst[0] = (bf16_t)f2bf(st.O0[i] * inv); dst[32] = (bf16_t)f2bf(st.O1[i] * inv);
    }
    __syncthreads();
}

__device__ __forceinline__ void attend_sample_task(const Args& A, LAS unsigned char* wl, const LAS float* biasrel, int ms, int g, int lane_in) {
    constexpr int NJ = 33;
    int lane = lane_in; asm volatile("" : "+v"(lane));
    const bf16_t* P = (const bf16_t*)(A.ws + WS_P);
    const int b = ms >> 2, t = ms & 3, nvalid = 2049 + t, qpos = 2048 + t, m = MP + ms;
    const float* srow = (const float*)(A.ws + WS_SCS) + (size_t)ms * SCSW;
    LAS float* pq = (LAS float*)wl;
    LAS unsigned* rowid = (LAS unsigned*)(wl + 4096);
    LAS unsigned short* posl = (LAS unsigned short*)(wl + 4096 + 1024);
    unsigned key[NJ];
#pragma unroll
    for (int j = 0; j < NJ; ++j) key[j] = (lane < nvalid - 64 * j) ? f2key(srow[lane + 64 * j]) : 0u;
    unsigned T = 0u; int need_eq = 0;
    {
        bool exact = false;
        for (int bit = 31; bit >= 0; --bit) {
            const unsigned cand = T | (1u << bit); int cnt = 0;
#pragma unroll
            for (int j = 0; j < NJ; ++j) cnt += __popcll(__ballot(key[j] >= cand));
            if (cnt >= 256) { T = cand; if (cnt == 256) { exact = true; break; } }
        }
        if (exact) { T -= 1u; }
        else { int cgt = 0;
#pragma unroll
            for (int j = 0; j < NJ; ++j) cgt += __popcll(__ballot(key[j] > T));
            need_eq = 256 - cgt; }
    }
    int base = 0, eqused = 0;
    const int* pt = (const int*)A.in[I_PT];
#pragma unroll
    for (int j = 0; j < NJ; ++j) {
        const bool gt = key[j] > T, eq = (need_eq > 0) && (key[j] == T);
        const unsigned long long meq = __ballot(eq);
        const bool sel = gt || (eq && (eqused + mbcnt64(meq) < need_eq));
        eqused += __popcll(meq);
        const unsigned long long msk = __ballot(sel);
        if (sel) { const int pos = lane + 64 * j, k = base + mbcnt64(msk);
            posl[k] = (unsigned short)pos;
            rowid[k] = (pos < 2048) ? (unsigned)(pt[b * 16 + (pos >> 7)] * 128 + (pos & 127)) : (0x80000000u | (unsigned)(b * 4 + pos - 2048)); }
        base += __popcll(msk);
    }
    { const u32x2 w = *(const u32x2*)(P + (size_t)m * NP + PQ + g * 256 + lane * 4);
      *(LAS f32x4*)(pq + lane * 4) = (f32x4){__uint_as_float(w.x << 16), __uint_as_float(w.x & 0xffff0000u), __uint_as_float(w.y << 16), __uint_as_float(w.y & 0xffff0000u)}; }
    asm volatile("s_waitcnt lgkmcnt(0)" ::: "memory");
    const float* ck = A.in[I_CK]; const float* cv = A.in[I_CV]; const float* kn = A.out + O_KS; const float* vn = A.out + O_VS;
    const float* kp[4]; int rel[4];
#pragma unroll
    for (int i = 0; i < 4; ++i) { const unsigned rid = rowid[lane + 64 * i]; rel[i] = qpos - (int)posl[lane + 64 * i];
        kp[i] = ((rid & 0x80000000u) ? kn + (size_t)(rid & 0x7fffffffu) * 256 : ck + (size_t)rid * 256) + g * 64; }
    float acc[4][4];
#pragma unroll
    for (int i = 0; i < 4; ++i)
#pragma unroll
        for (int hh = 0; hh < 4; ++hh) acc[i][hh] = 0.f;
#pragma unroll 2
    for (int dc = 0; dc < 16; ++dc) {
        f32x4 kv[4];
#pragma unroll
        for (int i = 0; i < 4; ++i) kv[i] = *(const f32x4*)(kp[i] + dc * 4);
#pragma unroll
        for (int hh = 0; hh < 4; ++hh) { const f32x4 q4 = *(const LAS f32x4*)(pq + hh * 64 + dc * 4);
#pragma unroll
            for (int i = 0; i < 4; ++i) acc[i][hh] += kv[i][0] * q4[0] + kv[i][1] * q4[1] + kv[i][2] * q4[2] + kv[i][3] * q4[3]; }
    }
    asm volatile("s_waitcnt lgkmcnt(0)" ::: "memory");
#pragma unroll
    for (int i = 0; i < 4; ++i) { const int rc = rel[i] < 128 ? (rel[i] < 0 ? 0 : rel[i]) : 128; const f32x4 bv = *(const LAS f32x4*)(biasrel + rc * 16 + 4 * g);
#pragma unroll
        for (int hh = 0; hh < 4; ++hh) acc[i][hh] = acc[i][hh] * 0.125f + bv[hh]; }
#pragma unroll
    for (int hh = 0; hh < 4; ++hh) {
        const float mx = wave_max(fmaxf(fmaxf(acc[0][hh], acc[1][hh]), fmaxf(acc[2][hh], acc[3][hh])));
        float sm = 0.f;
#pragma unroll
        for (int i = 0; i < 4; ++i) { acc[i][hh] = __expf(acc[i][hh] - mx); sm += acc[i][hh]; }
        const float inv = 1.0f / wave_sum(sm);
#pragma unroll
        for (int i = 0; i < 4; ++i) acc[i][hh] *= inv;
    }
#pragma unroll
    for (int i = 0; i < 4; ++i) *(LAS f32x4*)(pq + (lane + 64 * i) * 4) = (f32x4){acc[i][0], acc[i][1], acc[i][2], acc[i][3]};
    asm volatile("s_waitcnt lgkmcnt(0)" ::: "memory");
    float o[4] = {0.f, 0.f, 0.f, 0.f};
    for (int k0 = 0; k0 < 256; k0 += 8) {
        float vv[8]; f32x4 pp[8];
#pragma unroll
        for (int u = 0; u < 8; ++u) { const unsigned rid = rowid[k0 + u];
            const float* vp = ((rid & 0x80000000u) ? vn + (size_t)(rid & 0x7fffffffu) * 256 : cv + (size_t)rid * 256) + g * 64 + lane;
            vv[u] = *vp; pp[u] = *(const LAS f32x4*)(pq + (k0 + u) * 4); }
#pragma unroll
        for (int u = 0; u < 8; ++u)
#pragma unroll
            for (int hh = 0; hh < 4; ++hh) o[hh] += pp[u][hh] * vv[u];
    }
    bf16_t* YA = (bf16_t*)(A.ws + WS_YA);
#pragma unroll
    for (int hh = 0; hh < 4; ++hh) YA[(size_t)m * D + (4 * g + hh) * 64 + lane] = (bf16_t)f2bf(o[hh]);
    asm volatile("s_waitcnt lgkmcnt(0)" ::: "memory");
}

#if MK_CHECK_ATT
constexpr size_t WS_CHK_SC = WS_END, WS_CHK_YA = WS_CHK_SC + 128 * MiB, WS_CHK_MASK = WS_CHK_YA + 33 * MiB, WS_CHK_END = WS_CHK_MASK + 4 * MiB;
constexpr int CW_CHK = 512;
template <bool SAMPLE> struct KVRow;
template <> struct KVRow<false> {
    typedef const bf16_t* ptr;
    const bf16_t* P;
    __device__ __forceinline__ ptr krow(unsigned rid) const { return P + (size_t)rid * NP + PK; }
    __device__ __forceinline__ ptr vrow(unsigned rid) const { return P + (size_t)rid * NP + PV; }
    static __device__ __forceinline__ void k8(ptr p, float (&f)[8]) { unpack8(*(const u32x4*)p, f); }
    static __device__ __forceinline__ f32x4 v4(ptr p) { const u32x2 w = *(const u32x2*)p;
        return (f32x4){__uint_as_float(w.x << 16), __uint_as_float(w.x & 0xffff0000u), __uint_as_float(w.y << 16), __uint_as_float(w.y & 0xffff0000u)}; }
};
template <> struct KVRow<true> {
    typedef const float* ptr;
    const float* ck; const float* cv; const float* kn; const float* vn;
    __device__ __forceinline__ ptr krow(unsigned rid) const { return (rid & 0x80000000u) ? kn + (size_t)(rid & 0x7fffffffu) * 256 : ck + (size_t)rid * 256; }
    __device__ __forceinline__ ptr vrow(unsigned rid) const { return (rid & 0x80000000u) ? vn + (size_t)(rid & 0x7fffffffu) * 256 : cv + (size_t)rid * 256; }
    static __device__ __forceinline__ void k8(ptr p, float (&f)[8]) { const f32x4 a = *(const f32x4*)p, b = *(const f32x4*)(p + 4);
#pragma unroll
        for (int i = 0; i < 4; ++i) { f[i] = a[i]; f[4 + i] = b[i]; } }
    static __device__ __forceinline__ f32x4 v4(ptr p) { return *(const f32x4*)p; }
};

template <bool SAMPLE>
__device__ __forceinline__ void attend_query(const Args& A, LAS unsigned char* wl, const LAS float* biasrel, int m, int lane_in) {
    constexpr int NJ = SAMPLE ? 33 : 32;
    int lane = lane_in; asm volatile("" : "+v"(lane));
    const bf16_t* P = (const bf16_t*)(A.ws + WS_P);
    int b, nvalid, qpos; const float* srow;
    if (!SAMPLE) { b = m >> 11; const int t = m & 2047; nvalid = t + 1; qpos = t; srow = (const float*)(A.ws + WS_CHK_SC) + (size_t)m * SCW; }
    else { const int ms = m - MP; b = ms >> 2; const int t = ms & 3; nvalid = 2049 + t; qpos = 2048 + t; srow = (const float*)(A.ws + WS_SCS) + (size_t)ms * SCSW; }
    LAS float* pq = (LAS float*)wl;
    LAS unsigned* rowid = (LAS unsigned*)(wl + 16384);
    LAS unsigned short* posl = (LAS unsigned short*)(wl + 16384 + 1024);
    unsigned key[NJ];
#pragma unroll
    for (int j = 0; j < NJ; ++j) { key[j] = (lane < nvalid - 64 * j) ? f2key(srow[lane + 64 * j]) : 0u; }
    unsigned T = 0u; int need_eq = 0;
    if (nvalid > 256) {
        for (int bit = 31; bit >= 0; --bit) {
            const unsigned cand = T | (1u << bit); int cnt = 0;
#pragma unroll
            for (int j = 0; j < NJ; ++j) cnt += __popcll(__ballot(key[j] >= cand));
            if (cnt >= 256) T = cand;
        }
        int cgt = 0;
#pragma unroll
        for (int j = 0; j < NJ; ++j) cgt += __popcll(__ballot(key[j] > T));
        need_eq = 256 - cgt;
    }
    int base = 0, eqused = 0; unsigned long long mine_chk = 0ull;
    const int* pt = (const int*)A.in[I_PT];
#pragma unroll
    for (int j = 0; j < NJ; ++j) {
        const bool gt = key[j] > T, eq = (need_eq > 0) && (key[j] == T);
        const unsigned long long meq = __ballot(eq);
        const bool sel = gt || (eq && (eqused + mbcnt64(meq) < need_eq));
        eqused += __popcll(meq);
        const unsigned long long ms = __ballot(sel);
        if (sel) { const int pos = lane + 64 * j, k = base + mbcnt64(ms);
            posl[k] = (unsigned short)pos;
            unsigned rid;
            if (!SAMPLE) rid = (unsigned)(b * 2048 + pos);
            else rid = (pos < 2048) ? (unsigned)(pt[b * 16 + (pos >> 7)] * 128 + (pos & 127)) : (0x80000000u | (unsigned)(b * 4 + pos - 2048));
            rowid[k] = rid; }
        base += __popcll(ms);
        if (!SAMPLE) { if (lane == j) mine_chk = ms; }
    }
    if (!SAMPLE) { if (lane < 32) ((unsigned long long*)(A.ws + WS_CHK_MASK))[(size_t)m * 32 + lane] = mine_chk; }
    const int nsel = base;
    asm volatile("s_waitcnt lgkmcnt(0)" ::: "memory");
    { const unsigned r0 = rowid[0]; const unsigned short p0 = posl[0];
#pragma unroll
      for (int i = 0; i < 4; ++i) { const int k = lane + 64 * i; if (k >= nsel) { rowid[k] = r0; posl[k] = p0; } } }
    { const u32x4 w0 = *(const u32x4*)(P + (size_t)m * NP + PQ + lane * 16), w1 = *(const u32x4*)(P + (size_t)m * NP + PQ + lane * 16 + 8);
      float f0[8], f1[8]; unpack8(w0, f0); unpack8(w1, f1);
#pragma unroll
      for (int e = 0; e < 8; ++e) { pq[lane * 16 + e] = f0[e]; pq[lane * 16 + 8 + e] = f1[e]; } }
    asm volatile("s_waitcnt lgkmcnt(0)" ::: "memory");
    KVRow<SAMPLE> R;
    if constexpr (!SAMPLE) { R.P = P; } else { R.ck = A.in[I_CK]; R.cv = A.in[I_CV]; R.kn = A.out + O_KS; R.vn = A.out + O_VS; }
    typename KVRow<SAMPLE>::ptr kp[4]; int rel[4];
#pragma unroll
    for (int i = 0; i < 4; ++i) { kp[i] = R.krow(rowid[lane + 64 * i]); rel[i] = qpos - (int)posl[lane + 64 * i]; }
    float acc[4][16];
#pragma unroll
    for (int i = 0; i < 4; ++i)
#pragma unroll
        for (int hh = 0; hh < 16; ++hh) acc[i][hh] = 0.f;
#pragma unroll
    for (int g = 0; g < 4; ++g) {
#pragma unroll 1
        for (int dc = 0; dc < 8; ++dc) {
            float kv[4][8];
#pragma unroll
            for (int i = 0; i < 4; ++i) KVRow<SAMPLE>::k8(kp[i] + g * 64 + dc * 8, kv[i]);
#pragma unroll
            for (int hh = 0; hh < 4; ++hh) {
                const f32x4 q0 = *(const LAS f32x4*)(pq + (4 * g + hh) * 64 + dc * 8), q1 = *(const LAS f32x4*)(pq + (4 * g + hh) * 64 + dc * 8 + 4);
#pragma unroll
                for (int i = 0; i < 4; ++i) {
                    float a = acc[i][4 * g + hh];
#pragma unroll
                    for (int e = 0; e < 4; ++e) { a += kv[i][e] * q0[e]; a += kv[i][4 + e] * q1[e]; }
                    acc[i][4 * g + hh] = a; }
            }
        }
    }
    asm volatile("s_waitcnt lgkmcnt(0)" ::: "memory");
#pragma unroll
    for (int i = 0; i < 4; ++i) {
        const bool valid = (lane + 64 * i) < nsel; const int rc = rel[i] < 128 ? (rel[i] < 0 ? 0 : rel[i]) : 128;
#pragma unroll
        for (int h4 = 0; h4 < 4; ++h4) { const f32x4 bv = *(const LAS f32x4*)(biasrel + rc * 16 + 4 * h4);
#pragma unroll
            for (int e = 0; e < 4; ++e) acc[i][4 * h4 + e] = valid ? acc[i][4 * h4 + e] * 0.125f + bv[e] : -INFINITY; }
    }
#pragma unroll
    for (int hh = 0; hh < 16; ++hh) {
        const float mx = wave_max(fmaxf(fmaxf(acc[0][hh], acc[1][hh]), fmaxf(acc[2][hh], acc[3][hh])));
        float s = 0.f;
#pragma unroll
        for (int i = 0; i < 4; ++i) { acc[i][hh] = __expf(acc[i][hh] - mx); s += acc[i][hh]; }
        const float inv = 1.0f / wave_sum(s);
#pragma unroll
        for (int i = 0; i < 4; ++i) acc[i][hh] *= inv;
    }
#pragma unroll
    for (int i = 0; i < 4; ++i)
#pragma unroll
        for (int h4 = 0; h4 < 4; ++h4) *(LAS f32x4*)(pq + (lane + 64 * i) * 16 + 4 * h4) = (f32x4){acc[i][4 * h4], acc[i][4 * h4 + 1], acc[i][4 * h4 + 2], acc[i][4 * h4 + 3]};
    asm volatile("s_waitcnt lgkmcnt(0)" ::: "memory");
    const int g = lane >> 4;
    f32x4 o[4];
#pragma unroll
    for (int hh = 0; hh < 4; ++hh) o[hh] = (f32x4){0.f, 0.f, 0.f, 0.f};
    const int nloop = (nsel + 3) & ~3;
    for (int k0 = 0; k0 < nloop; k0 += 4) {
        f32x4 vv[4], pp[4];
#pragma unroll
        for (int u = 0; u < 4; ++u) { const unsigned r = rowid[k0 + u]; vv[u] = KVRow<SAMPLE>::v4(R.vrow(r) + lane * 4); pp[u] = *(const LAS f32x4*)(pq + (k0 + u) * 16 + 4 * g); }
#pragma unroll
        for (int u = 0; u < 4; ++u)
#pragma unroll
            for (int hh = 0; hh < 4; ++hh) o[hh] += vv[u] * pp[u][hh];
    }
    bf16_t* YA = (bf16_t*)(A.ws + WS_CHK_YA);
#pragma unroll
    for (int hh = 0; hh < 4; ++hh) { u32x2 w; w.x = pk2(o[hh][0], o[hh][1]); w.y = pk2(o[hh][2], o[hh][3]);
        *(u32x2*)(YA + (size_t)m * D + (4 * g + hh) * 64 + (lane & 15) * 4) = w; }
    asm volatile("s_waitcnt lgkmcnt(0)" ::: "memory");
}


__device__ __forceinline__ void check_compare(const Args& A, int gw, int NGW, int lane) {
    const bf16_t* Y1 = (const bf16_t*)(A.ws + WS_YA); const bf16_t* Y2 = (const bf16_t*)(A.ws + WS_CHK_YA); unsigned* ctl = (unsigned*)(A.ws + WS_CTL);
    for (int m = gw; m < MP; m += NGW) {
        float e = 0.f, n = 0.f;
#pragma unroll
        for (int j = 0; j < 2; ++j) { float a[8], b[8]; unpack8(*(const u32x4*)(Y1 + (size_t)m * D + j * 512 + lane * 8), a); unpack8(*(const u32x4*)(Y2 + (size_t)m * D + j * 512 + lane * 8), b);
#pragma unroll
            for (int i = 0; i < 8; ++i) { const float d = a[i] - b[i]; e += d * d; n += b[i] * b[i]; } }
        e = wave_sum(e); n = wave_sum(n);
        { const unsigned long long w1 = (lane < 32) ? ((const unsigned long long*)(A.ws + WS_SC))[(size_t)m * 32 + lane] : 0ull, w2 = (lane < 32) ? ((const unsigned long long*)(A.ws + WS_CHK_MASK))[(size_t)m * 32 + lane] : 0ull;
          if (__any(w1 != w2) && lane == 0) atomicAdd(ctl + CW_CHK + 3, 1u);
          const int t = m & 2047;
          if (t >= 256) {
              const float* srow = (const float*)(A.ws + WS_CHK_SC) + (size_t)m * SCW;
              int c1 = 0, c2 = 0; float mins1 = INFINITY, maxu1 = -INFINITY, mins2 = INFINITY, maxu2 = -INFINITY;
              for (int j = 0; j < 32; ++j) { const int sp = lane + 64 * j; if (64 * j > t) break;
                  const unsigned long long a1 = __shfl((unsigned long long)w1, j), a2 = __shfl((unsigned long long)w2, j);
                  if (sp <= t) { const float v = srow[sp]; const bool s1 = (a1 >> lane) & 1ull, s2 = (a2 >> lane) & 1ull;
                      if (s1) { ++c1; mins1 = fminf(mins1, v); } else maxu1 = fmaxf(maxu1, v);
                      if (s2) { ++c2; mins2 = fminf(mins2, v); } else maxu2 = fmaxf(maxu2, v); } }
              c1 = (int)wave_sum((float)c1); c2 = (int)wave_sum((float)c2);
              mins1 = -wave_max(-mins1); mins2 = -wave_max(-mins2); maxu1 = wave_max(maxu1); maxu2 = wave_max(maxu2);
              if (lane == 0) { if (c1 != 256 || mins1 < maxu1) atomicAdd(ctl + CW_CHK + 4, 1u); if (c2 != 256 || mins2 < maxu2) atomicAdd(ctl + CW_CHK + 5, 1u); }
          } }
        if (lane == 0 && !(e <= MK_CHECK_TOL * MK_CHECK_TOL * n + 1e-12f)) { const int t = m & 2047; atomicAdd(ctl + CW_CHK + (t < 64 ? 0 : t < 256 ? 1 : 2), 1u); }
    }
}
#endif
__device__ __forceinline__ void gate_norm_phase(const Args& A, int gw, int NGW, int lane) {
    const bf16_t* P = (const bf16_t*)(A.ws + WS_P); bf16_t* Y = (bf16_t*)(A.ws + WS_Y); const float* ng = A.in[I_NORMG];
    for (int it = gw; it < M * 4; it += NGW) {
        const int m = it >> 2, ch = (it & 3) * 512 + lane * 8;
        float y[8], z[8]; unpack8(*(const u32x4*)(Y + (size_t)m * DI + ch), y); unpack8(*(const u32x4*)(P + (size_t)m * NP + PZ + ch), z);
        float ss = 0.f;
#pragma unroll
        for (int i = 0; i < 8; ++i) { y[i] *= siluf_(z[i]); ss += y[i] * y[i]; }
        const float r = 1.0f / sqrtf(wave_sum(ss) * (1.f / 512.f) + LN_EPS);
        const f32x4 g0 = *(const f32x4*)(ng + ch), g1 = *(const f32x4*)(ng + ch + 4);
#pragma unroll
        for (int i = 0; i < 4; ++i) { y[i] = y[i] * r * g0[i]; y[4 + i] = y[4 + i] * r * g1[i]; }
        *(u32x4*)(Y + (size_t)m * DI + ch) = pack8(y);
    }
}

constexpr int NPHASE = 14;
__global__ void __launch_bounds__(NTHR, 2) fwd(Args args) {
    extern __shared__ __attribute__((aligned(16))) unsigned char lds_raw[];
    LAS unsigned char* lds = (LAS unsigned char*)lds_raw;
    const int tid = threadIdx.x, lane = tid & 63, wave = __builtin_amdgcn_readfirstlane(tid >> 6);
    const int G = gridDim.x, bx = blockIdx.x;
    const int vcu = (G % 8 == 0) ? (bx % 8) * (G / 8) + bx / 8 : bx;
    const int gw = vcu * NWAVES + wave, NGW = G * NWAVES;
    unsigned char* ws = args.ws;
    volatile LAS unsigned* MISC = (volatile LAS unsigned*)(lds + MISC_OFF);
    for (int u = tid; u < 64; u += NTHR) MISC[u] = 0u;
    __syncthreads();
    const int lo = args.ph_lo, hi = args.ph_hi;
    XcdBarrier bar; bar.bar = (unsigned*)(ws + WS_CTL) + CW_BAR; bar.x = 0; bar.st = nullptr;
    if (hi - lo > 1) bar = xcd_barrier_post((unsigned*)(ws + WS_CTL) + CW_BAR, MISC + 8);
#define IN(k) (lo <= (k) && (k) < hi)
#define SEAM(k) do { if (IN(k) && IN((k) + 1)) xcd_barrier(bar); } while (0)

    bf16_t* const XB = (bf16_t*)(ws + WS_XB); bf16_t* const ACT = (bf16_t*)(ws + WS_ACT); float* const T = (float*)(ws + WS_T);
    float* const HF = (float*)(ws + WS_HF); bf16_t* const HB = (bf16_t*)(ws + WS_HB); bf16_t* const P = (bf16_t*)(ws + WS_P);
    float* const SMF = (float*)(ws + WS_SMF); bf16_t* const Y = (bf16_t*)(ws + WS_Y); bf16_t* const YA = (bf16_t*)(ws + WS_YA); bf16_t* const MG = (bf16_t*)(ws + WS_MG);

    if (IN(0)) REPK(0) { p0_prologue(args, lds, gw, NGW, wave, lane); }
    SEAM(0);
    if (IN(1)) {
        { pg8::Gemm g{XB, (const bf16_t*)(ws + WS_W1A), M, 2 * DFF, D}; pg8::StaticOrder S; S.init(M, 2 * DFF, G, bx);
        EpiSwiglu E{ACT}; pg8::gemm_phase<EpiSwiglu, pg8::StaticOrder, true, true>(lds, g, S, E); }
        if constexpr (DUPK(1)) { pg8::Gemm g{XB, (const bf16_t*)(ws + WS_W1A), M, 2 * DFF, D}; pg8::StaticOrder S; S.init(M, 2 * DFF, G, bx);
        EpiSwiglu E{ACT}; pg8::gemm_phase<EpiSwiglu, pg8::StaticOrder, true, true>(lds, g, S, E); }
    }
    SEAM(1);
    if (IN(2)) {
        { pg8::Gemm g{ACT, (const bf16_t*)(ws + WS_W1B), MP, D, DFF}; pg8::StaticOrder S; S.init(MP, D, G, bx);
        EpiResid E{args.in[I_XP], args.in[I_XS], T, ALPHA, 0.5f}; pg8::gemm_phase<EpiResid, pg8::StaticOrder, true, true>(lds, g, S, E); }
        { SkResid E{args.in[I_XS], T, ALPHA, 0.5f}; skinny_gemm<DFF>(lds, ACT + (size_t)MP * DFF, (const bf16_t*)(ws + WS_W1B), E, bx, G, wave, lane); }
        if constexpr (DUPK(2)) { pg8::Gemm g{ACT, (const bf16_t*)(ws + WS_W1B), MP, D, DFF}; pg8::StaticOrder S; S.init(MP, D, G, bx);
        EpiResid E{args.in[I_XP], args.in[I_XS], T, ALPHA, 0.5f}; pg8::gemm_phase<EpiResid, pg8::StaticOrder, true, true>(lds, g, S, E); }
    }
    SEAM(2);
    if (IN(3)) REPK(3) { ln_phase(T, args.in[I_LN1G], args.in[I_LN1B], HF, HB, gw, NGW, lane); }
    SEAM(3);
    if (IN(4)) {
        { pg8::Gemm g{HB, (const bf16_t*)(ws + WS_WIN), M, NP, D}; pg8::StaticOrder S; S.init(M, NP, G, bx);
        EpiWin E{P, SMF, args.out}; pg8::gemm_phase<EpiWin, pg8::StaticOrder, true, true>(lds, g, S, E); }
        if constexpr (DUPK(4)) { pg8::Gemm g{HB, (const bf16_t*)(ws + WS_WIN), M, NP, D}; pg8::StaticOrder S; S.init(M, NP, G, bx);
        EpiWin E{P, SMF, args.out}; pg8::gemm_phase<EpiWin, pg8::StaticOrder, true, true>(lds, g, S, E); }
    }
    SEAM(4);
    if (IN(5)) REPK(5) {
        for (int rep = 0; rep < MK_REP_CONV; ++rep)
        conv_phase(args, gw, NGW, lane);
        for (int rep = 0; rep < MK_REP_SCP; ++rep)
        for (int u = bx; u < 1024; u += G) { const int i = u >> 8, c = u & 255, b = c >> 5, s = c & 31; const int qt = (i == 0) ? s : (i == 1) ? 63 - s : (i == 2) ? 64 + s : 127 - s;
            scores_select_prompt_unit(args, lds, b, qt, wave, lane); }
        for (int rep = 0; rep < MK_REP_SCS; ++rep)
        for (int u = bx; u < 256; u += G) scores_sample_unit(args, u >> 1, u & 1, wave, lane);
    }
    SEAM(5);
    if (IN(6)) {
        for (int rep = 0; rep < MK_REP_SSDP; ++rep)
        for (int it = bx; it < 256; it += G) ssd_prompt_item(args, lds, it >> 5, it & 31);
        __syncthreads();
        LAS float* biasrel = (LAS float*)(lds + BIASREL_OFF); LAS float* biasL = biasrel + 129 * 16;
        for (int i = tid; i < 129 * 16; i += NTHR) { const int rel = i >> 4, h = i & 15; const float bv = args.in[I_BIAS][t5_bucket(rel) * 16 + h]; biasrel[i] = bv; biasL[i] = bv * LOG2E; }
        __syncthreads();
        for (int rep = 0; rep < MK_REP_ATTP; ++rep)
        for (int u = bx; u < 1024; u += G) { const int i = u >> 8, c = u & 255, bg = c >> 3, s8 = c & 7; const int qt = (i == 0) ? s8 : (i == 1) ? 15 - s8 : (i == 2) ? 16 + s8 : 31 - s8;
            attn_prompt_unit(args, lds, biasL, bg >> 2, bg & 3, qt, wave, lane); }
        __syncthreads();
        LAS unsigned char* wl = lds + wave * WAREA;
        for (int rep = 0; rep < MK_REP_SSDS; ++rep)
        for (int it = gw; it < 4096; it += NGW) ssd_sample_item(args, wl, it >> 5, it & 31, lane);
        for (int rep = 0; rep < MK_REP_ATTS; ++rep)
        for (int q = gw; q < MS * 4; q += NGW) attend_sample_task(args, wl, biasrel, q >> 2, q & 3, lane);
#if MK_CHECK_ATT
        for (int q = gw; q < MP; q += NGW) attend_query<false>(args, wl, biasrel, q, lane);
#endif
        __syncthreads();
    }
    SEAM(6);
    if (IN(7)) {
        gate_norm_phase(args, gw, NGW, lane);
#if MK_CHECK_ATT
        check_compare(args, gw, NGW, lane);
#endif
        { pg8::Gemm g{YA, (const bf16_t*)(ws + WS_WBA), MP, D, D}; pg8::StaticOrder S; S.init(MP, D, G, bx);
        EpiGateA E{P, PG + D, T}; pg8::gemm_phase<EpiGateA, pg8::StaticOrder, true, true>(lds, g, S, E); }
        { SkGateA E{P, PG + D, T}; skinny_gemm<D>(lds, YA + (size_t)MP * D, (const bf16_t*)(ws + WS_WBA), E, bx, G, wave, lane); }
        if constexpr (DUPK(7)) { pg8::Gemm g{YA, (const bf16_t*)(ws + WS_WBA), MP, D, D}; pg8::StaticOrder S; S.init(MP, D, G, bx);
        EpiGateA E{P, PG + D, T}; pg8::gemm_phase<EpiGateA, pg8::StaticOrder, true, true>(lds, g, S, E); }
    }
    SEAM(7);
    if (IN(8)) {
        { pg8::Gemm g{Y, (const bf16_t*)(ws + WS_WBS), MP, D, DI}; pg8::StaticOrder S; S.init(MP, D, G, bx);
        EpiGateS E{P, PG, T, MG}; pg8::gemm_phase<EpiGateS, pg8::StaticOrder, true, true>(lds, g, S, E); }
        { SkGateS E{P, PG, T, MG}; skinny_gemm<DI>(lds, Y + (size_t)MP * DI, (const bf16_t*)(ws + WS_WBS), E, bx, G, wave, lane); }
        if constexpr (DUPK(8)) { pg8::Gemm g{Y, (const bf16_t*)(ws + WS_WBS), MP, D, DI}; pg8::StaticOrder S; S.init(MP, D, G, bx);
        EpiGateS E{P, PG, T, MG}; pg8::gemm_phase<EpiGateS, pg8::StaticOrder, true, true>(lds, g, S, E); }
    }
    SEAM(8);
    if (IN(9)) {
        { pg8::Gemm g{MG, (const bf16_t*)(ws + WS_WOUT), MP, D, D}; pg8::StaticOrder S; S.init(MP, D, G, bx);
        EpiResid E{HF, HF + (size_t)MP * D, T, ALPHA, 1.0f}; pg8::gemm_phase<EpiResid, pg8::StaticOrder, true, true>(lds, g, S, E); }
        { SkResid E{HF + (size_t)MP * D, T, ALPHA, 1.0f}; skinny_gemm<D>(lds, MG + (size_t)MP * D, (const bf16_t*)(ws + WS_WOUT), E, bx, G, wave, lane); }
        if constexpr (DUPK(9)) { pg8::Gemm g{MG, (const bf16_t*)(ws + WS_WOUT), MP, D, D}; pg8::StaticOrder S; S.init(MP, D, G, bx);
        EpiResid E{HF, HF + (size_t)MP * D, T, ALPHA, 1.0f}; pg8::gemm_phase<EpiResid, pg8::StaticOrder, true, true>(lds, g, S, E); }
    }
    SEAM(9);
    if (IN(10)) REPK(10) { ln_phase(T, args.in[I_LN2G], args.in[I_LN2B], HF, HB, gw, NGW, lane); }
    SEAM(10);
    if (IN(11)) {
        { pg8::Gemm g{HB, (const bf16_t*)(ws + WS_W2A), M, 2 * DFF, D}; pg8::StaticOrder S; S.init(M, 2 * DFF, G, bx);
        EpiSwiglu E{ACT}; pg8::gemm_phase<EpiSwiglu, pg8::StaticOrder, true, true>(lds, g, S, E); }
        if constexpr (DUPK(11)) { pg8::Gemm g{HB, (const bf16_t*)(ws + WS_W2A), M, 2 * DFF, D}; pg8::StaticOrder S; S.init(M, 2 * DFF, G, bx);
        EpiSwiglu E{ACT}; pg8::gemm_phase<EpiSwiglu, pg8::StaticOrder, true, true>(lds, g, S, E); }
    }
    SEAM(11);
    if (IN(12)) {
        { pg8::Gemm g{ACT, (const bf16_t*)(ws + WS_W2B), MP, D, DFF}; pg8::StaticOrder S; S.init(MP, D, G, bx);
        EpiResid E{HF, HF + (size_t)MP * D, T, ALPHA, 0.5f}; pg8::gemm_phase<EpiResid, pg8::StaticOrder, true, true>(lds, g, S, E); }
        { SkResid E{HF + (size_t)MP * D, T, ALPHA, 0.5f}; skinny_gemm<DFF>(lds, ACT + (size_t)MP * DFF, (const bf16_t*)(ws + WS_W2B), E, bx, G, wave, lane); }
        if constexpr (DUPK(12)) { pg8::Gemm g{ACT, (const bf16_t*)(ws + WS_W2B), MP, D, DFF}; pg8::StaticOrder S; S.init(MP, D, G, bx);
        EpiResid E{HF, HF + (size_t)MP * D, T, ALPHA, 0.5f}; pg8::gemm_phase<EpiResid, pg8::StaticOrder, true, true>(lds, g, S, E); }
    }
    SEAM(12);
    if (IN(13)) REPK(13) { ln_phase(T, args.in[I_LN3G], args.in[I_LN3B], args.out + O_Y, nullptr, gw, NGW, lane); }
#if MK_CHECK_ATT
    if (IN(13)) { __syncthreads(); unsigned* cw = (unsigned*)(ws + WS_CTL) + CW_CHK;
        const unsigned b0 = __hip_atomic_load(cw, __ATOMIC_RELAXED, __HIP_MEMORY_SCOPE_AGENT), b1 = __hip_atomic_load(cw + 1, __ATOMIC_RELAXED, __HIP_MEMORY_SCOPE_AGENT), b2 = __hip_atomic_load(cw + 2, __ATOMIC_RELAXED, __HIP_MEMORY_SCOPE_AGENT), b3 = __hip_atomic_load(cw + 3, __ATOMIC_RELAXED, __HIP_MEMORY_SCOPE_AGENT), b4 = __hip_atomic_load(cw + 4, __ATOMIC_RELAXED, __HIP_MEMORY_SCOPE_AGENT), b5 = __hip_atomic_load(cw + 5, __ATOMIC_RELAXED, __HIP_MEMORY_SCOPE_AGENT);
        const float code = MK_CHECK_CODE;
        if (code > 0.f && bx == 0 && tid == 0) args.out[O_Y] = 4096.0f * sqrtf(code); }
#endif
#undef IN
#undef SEAM
}
}

extern "C" void kernel_launch(void* const* d_in, const int* in_sizes, int n_in, void* d_out, int out_size, void* d_ws, size_t ws_size, hipStream_t stream) {
    using namespace mk;
    static int grid = 0;
    if (grid == 0) {
        if (n_in != 29 || (size_t)out_size != O_END || ws_size < WS_END) { fprintf(stderr, "kernel_launch: unexpected shapes (n_in %d, out %d, ws %zu)\n", n_in, out_size, ws_size); grid = -1; return; }
        int dev = 0, cus = 0, per_cu = 0;
        if (hipGetDevice(&dev) != hipSuccess || hipDeviceGetAttribute(&cus, hipDeviceAttributeMultiprocessorCount, dev) != hipSuccess) { grid = -1; return; }
        if (hipFuncSetAttribute((const void*)fwd, hipFuncAttributeMaxDynamicSharedMemorySize, LDS_BYTES) != hipSuccess) { fprintf(stderr, "kernel_launch: hipFuncSetAttribute failed\n"); grid = -1; return; }
        if (hipOccupancyMaxActiveBlocksPerMultiprocessor(&per_cu, (const void*)fwd, NTHR, LDS_BYTES) != hipSuccess || per_cu < 1) fprintf(stderr, "kernel_launch: occupancy query says %d\n", per_cu);
        (void)hipGetLastError();
        grid = cus;
    }
    if (grid < 0) return;
    (void)hipMemsetAsync((char*)d_ws + WS_CTL, 0, CTL_ZERO_BYTES, stream);
    Args a{};
    for (int i = 0; i < 29; ++i) a.in[i] = (const float*)d_in[i];
    a.out = (float*)d_out; a.ws = (unsigned char*)d_ws;
#if MK_SPLIT
    for (int p = 0; p < NPHASE; ++p) { a.ph_lo = p; a.ph_hi = p + 1; hipLaunchKernelGGL(fwd, dim3(grid), dim3(NTHR), LDS_BYTES, stream, a); }
#else
    a.ph_lo = 0; a.ph_hi = NPHASE; hipLaunchKernelGGL(fwd, dim3(grid), dim3(NTHR), LDS_BYTES, stream, a);
#endif
}
```

```cpp
#include <hip/hip_runtime.h>
#include <cstdio>
#include <cstdint>
#define GAS __attribute__((address_space(1)))
#define LAS __attribute__((address_space(3)))
namespace pg8 {
#define PG8_LAS __attribute__((address_space(3)))
typedef unsigned short bf16_t;
typedef short bf16x8 __attribute__((ext_vector_type(8)));
typedef float f32x4 __attribute__((ext_vector_type(4)));
typedef unsigned u32x4 __attribute__((ext_vector_type(4)));
constexpr int BM = 256, BK = 64, HALF = 128, HTB = HALF * BK * 2  , STAGE_BYTES = 8 * HTB, NXCD = 8, WGM = 8;

__host__ __device__ __forceinline__ int lds_byte(int r, int c) { const int st = (r >> 4) * 2 + (c >> 5), rr = r & 15, cc = c & 31, ob = rr * 64 + cc * 2; return st * 1024 + (ob ^ (((ob >> 9) & 1) << 5)); }
__host__ __device__ __forceinline__ void stage_rc(int b, int& R, int& C) { const int st = b / 1024, sb = b % 1024, swz = sb ^ (((sb >> 9) & 1) << 5); R = (st >> 1) * 16 + swz / 64; C = (st & 1) * 32 + (swz % 64) / 2; }
__host__ __device__ __forceinline__ int perm32(int rho) { const int n = rho >> 4, i = rho & 15; return 8 * (i >> 2) + 4 * n + (i & 3); }

struct Unit { int pm, pn; };
struct Gemm { const bf16_t* A; const bf16_t* Bt; int M, N, K; };

struct StaticOrder {
    int nM, nN, nwg, G, c;
    __host__ __device__ void init(int M, int N, int G_, int c_) { nM = M / BM; nN = N / BM; nwg = nM * nN; G = G_; c = c_; }
    __host__ __device__ bool next(int i, Unit& u) const {
        const long L = (long)i * G + c; if (L >= nwg) return false;
        int wgid = (int)L; { const int q = nwg / NXCD, r = nwg % NXCD, xcd = wgid % NXCD, off = wgid / NXCD; wgid = (xcd < r ? xcd * (q + 1) : r * (q + 1) + (xcd - r) * q) + off; }
        const int nig = WGM * nN, gid = wgid / nig, fm = gid * WGM, gsz = (nM - fm) < WGM ? (nM - fm) : WGM;
        u.pm = fm + ((wgid % nig) % gsz); u.pn = (wgid % nig) / gsz; return true;
    }
    __device__ __forceinline__ void a_ready(const Unit&) const {}
    __device__ __forceinline__ void done(const Unit&) const {}
};

__device__ __forceinline__ unsigned cvt_pk_bf16(float lo, float hi) { unsigned r; asm volatile("v_cvt_pk_bf16_f32 %0, %1, %2" : "=v"(r) : "v"(lo), "v"(hi)); return r; }

template <class Epi, class Sched, bool ALIGN_EPI = false, bool SP2 = false>
__device__ __forceinline__ void gemm_phase(PG8_LAS unsigned char* lds, const Gemm g, const Sched& S, const Epi& E) {
    const int tid = threadIdx.x, wid = __builtin_amdgcn_readfirstlane(tid >> 6), lane = tid & 63, wr = wid >> 2, wc = wid & 3, fr = lane & 15, fq = lane >> 4;
    const int K = g.K, nt = K / BK;
    unsigned voffA[2], voffB[2];
#pragma unroll
    for (int i = 0; i < 2; ++i) { int R, C; stage_rc(tid * 16 + i * 8192, R, C); const int Rb = Epi::PERM ? ((R & ~31) + perm32(R & 31)) : R;
        voffA[i] = (unsigned)(R * K + C) * 2u; voffB[i] = (unsigned)(Rb * K + C) * 2u; }
    const size_t kstep = (size_t)(BK * 2);
    const size_t hstep = (size_t)HALF * K * 2;
    const size_t tstep = 2 * hstep;
    const unsigned ldsw = (unsigned)wid * 1024u;
    const int aoff = lds_byte(wr * 64 + fr, fq * 8), boff = lds_byte(wc * 32 + fr, fq * 8);
#define PG8_SA(b, h) (((b) * 2 + (h)) * HTB)
#define PG8_SB(b, h) ((4 + (b) * 2 + (h)) * HTB)
#define PG8_STAGE(bufoff, gbase, voff) do { _Pragma("unroll") for (int _i = 0; _i < 2; ++_i) \
        __builtin_amdgcn_global_load_lds((const unsigned*)((const char*)(gbase) + (voff)[_i]), (PG8_LAS unsigned*)(lds + (bufoff) + ldsw + _i * 8192), 16, 0, 0); } while (0)
#define PG8_LDA(dst, b, h) do { _Pragma("unroll") for (int m = 0; m < 4; ++m) _Pragma("unroll") for (int k = 0; k < 2; ++k) dst[m][k] = *(const PG8_LAS bf16x8*)(lds + PG8_SA(b, h) + aoff + m * 2048 + k * 1024); } while (0)
#define PG8_LDB(dst, b, h) do { _Pragma("unroll") for (int n = 0; n < 2; ++n) _Pragma("unroll") for (int k = 0; k < 2; ++k) dst[n][k] = *(const PG8_LAS bf16x8*)(lds + PG8_SB(b, h) + boff + n * 2048 + k * 1024); } while (0)
#define PG8_MMA(ai, bj, At, Bt) do { __builtin_amdgcn_s_setprio(1); _Pragma("unroll") for (int m = 0; m < 4; ++m) _Pragma("unroll") for (int n = 0; n < 2; ++n) _Pragma("unroll") for (int k = 0; k < 2; ++k) \
        acc[ai][bj][m][n] = __builtin_amdgcn_mfma_f32_16x16x32_bf16(Bt[n][k], At[m][k], acc[ai][bj][m][n], 0, 0, 0); __builtin_amdgcn_s_setprio(0); } while (0)
#define PG8_WAIT_V(n) asm volatile("s_waitcnt vmcnt(" #n ")" ::: "memory")
#define PG8_WAIT_L(n) asm volatile("s_waitcnt lgkmcnt(" #n ")" ::: "memory")
#define PG8_BAR __builtin_amdgcn_s_barrier()
#define PG8_SCHED __builtin_amdgcn_sched_barrier(0)
    Unit cur, nxt; int ui = 0;
    if (!S.next(0, cur)) return;
    f32x4 acc[2][2][4][2];
#pragma unroll
    for (int a = 0; a < 2; ++a)
#pragma unroll
        for (int b = 0; b < 2; ++b)
#pragma unroll
            for (int m = 0; m < 4; ++m)
#pragma unroll
                for (int n = 0; n < 2; ++n) acc[a][b][m][n] = (f32x4){0.f, 0.f, 0.f, 0.f};
    bf16x8 At[4][2], B0[2][2], B1[2][2];
    const char* cA = (const char*)g.A + (size_t)cur.pm * tstep; const char* cB = (const char*)g.Bt + (size_t)cur.pn * tstep;
    S.a_ready(cur);
    if constexpr (SP2) {
        PG8_STAGE(PG8_SB(0, 0), cB, voffB); PG8_STAGE(PG8_SB(0, 1), cB + hstep, voffB); PG8_STAGE(PG8_SA(0, 0), cA, voffA); PG8_STAGE(PG8_SA(0, 1), cA + hstep, voffA);
        if (wr == 1) PG8_BAR;
        PG8_WAIT_V(2); PG8_BAR;
        PG8_STAGE(PG8_SB(1, 0), cB + kstep, voffB); PG8_STAGE(PG8_SA(1, 0), cA + kstep, voffA); PG8_STAGE(PG8_SB(1, 1), cB + hstep + kstep, voffB);
        PG8_WAIT_V(6); PG8_BAR;
    } else {
        PG8_STAGE(PG8_SB(0, 0), cB, voffB); PG8_STAGE(PG8_SA(0, 0), cA, voffA); PG8_STAGE(PG8_SB(0, 1), cB + hstep, voffB); PG8_STAGE(PG8_SA(0, 1), cA + hstep, voffA);
        if (wr == 1) PG8_BAR;
        PG8_WAIT_V(4); PG8_BAR;
        PG8_STAGE(PG8_SB(1, 0), cB + kstep, voffB); PG8_STAGE(PG8_SA(1, 0), cA + kstep, voffA); PG8_STAGE(PG8_SB(1, 1), cB + hstep + kstep, voffB);
        PG8_WAIT_V(6); PG8_BAR;
    }
    for (;;) {
        const bool has_next = S.next(ui + 1, nxt);
        const char* nA = has_next ? (const char*)g.A + (size_t)nxt.pm * tstep : cA; const char* nB = has_next ? (const char*)g.Bt + (size_t)nxt.pn * tstep : cB;
        for (int t = 0; t < nt; t += 2) {
            const bool last = (t == nt - 2);
            const char* a1 = cA + (size_t)(t + 1) * kstep;
            const char* a2 = last ? nA : cA + (size_t)(t + 2) * kstep; const char* b2 = last ? nB : cB + (size_t)(t + 2) * kstep;
            const char* a3 = a2 + kstep; const char* b3 = b2 + kstep;
            if (last && has_next) S.a_ready(nxt);
            if constexpr (SP2) {
            PG8_LDB(B0, 0, 0); PG8_LDB(B1, 0, 1); PG8_SCHED; PG8_LDA(At, 0, 0); PG8_STAGE(PG8_SA(1, 1), a1 + hstep, voffA);
            PG8_WAIT_V(8); PG8_WAIT_L(0); PG8_BAR; PG8_MMA(0, 0, At, B0); PG8_MMA(0, 1, At, B1); PG8_BAR; PG8_SCHED;
            PG8_LDA(At, 0, 1); PG8_STAGE(PG8_SB(0, 0), b2, voffB); PG8_STAGE(PG8_SB(0, 1), b2 + hstep, voffB); PG8_STAGE(PG8_SA(0, 0), a2, voffA);
            PG8_WAIT_V(8); PG8_WAIT_L(0); PG8_BAR; PG8_MMA(1, 0, At, B0); PG8_MMA(1, 1, At, B1); PG8_BAR; PG8_SCHED;
            PG8_LDB(B0, 1, 0); PG8_LDB(B1, 1, 1); PG8_SCHED; PG8_LDA(At, 1, 0); PG8_STAGE(PG8_SA(0, 1), a2 + hstep, voffA);
            PG8_WAIT_V(8); PG8_WAIT_L(0); PG8_BAR; PG8_MMA(0, 0, At, B0); PG8_MMA(0, 1, At, B1); PG8_BAR; PG8_SCHED;
            PG8_LDA(At, 1, 1); PG8_STAGE(PG8_SB(1, 0), b3, voffB); PG8_STAGE(PG8_SB(1, 1), b3 + hstep, voffB); PG8_STAGE(PG8_SA(1, 0), a3, voffA);
            PG8_WAIT_V(8); PG8_WAIT_L(0); PG8_BAR; PG8_MMA(1, 0, At, B0); PG8_MMA(1, 1, At, B1); PG8_BAR; PG8_SCHED;
            } else {
            PG8_LDB(B0, 0, 0); PG8_SCHED; PG8_LDA(At, 0, 0); PG8_STAGE(PG8_SA(1, 1), a1 + hstep, voffA);
            PG8_WAIT_L(8); PG8_BAR; PG8_WAIT_L(0); PG8_MMA(0, 0, At, B0); PG8_BAR; PG8_SCHED;
            PG8_LDB(B1, 0, 1); PG8_STAGE(PG8_SB(0, 0), b2, voffB);
            PG8_BAR; PG8_WAIT_L(0); PG8_MMA(0, 1, At, B1); PG8_BAR;
            PG8_LDA(At, 0, 1); PG8_STAGE(PG8_SA(0, 0), a2, voffA);
            PG8_BAR; PG8_WAIT_L(0); PG8_MMA(1, 0, At, B0); PG8_BAR; PG8_SCHED;
            PG8_STAGE(PG8_SB(0, 1), b2 + hstep, voffB);
            PG8_WAIT_V(6); PG8_BAR; PG8_MMA(1, 1, At, B1); PG8_BAR;
            PG8_LDB(B0, 1, 0); PG8_SCHED; PG8_LDA(At, 1, 0); PG8_STAGE(PG8_SA(0, 1), a2 + hstep, voffA);
            PG8_WAIT_L(8); PG8_BAR; PG8_WAIT_L(0); PG8_MMA(0, 0, At, B0); PG8_BAR; PG8_SCHED;
            PG8_LDB(B1, 1, 1); PG8_STAGE(PG8_SB(1, 0), b3, voffB);
            PG8_BAR; PG8_WAIT_L(0); PG8_MMA(0, 1, At, B1); PG8_BAR;
            PG8_LDA(At, 1, 1); PG8_STAGE(PG8_SA(1, 0), a3, voffA);
            PG8_BAR; PG8_WAIT_L(0); PG8_MMA(1, 0, At, B0); PG8_BAR; PG8_SCHED;
            PG8_STAGE(PG8_SB(1, 1), b3 + hstep, voffB);
            PG8_WAIT_V(6); PG8_BAR; PG8_MMA(1, 1, At, B1); PG8_BAR;
            }
        }
        if constexpr (ALIGN_EPI) { if (wr == 0) PG8_BAR; }
        if constexpr (!Epi::AFTER_DRAIN) { E(acc, cur, wr, wc, fr, fq); S.done(cur); }
        if (!has_next) break;
#pragma unroll
        for (int a = 0; a < 2; ++a)
#pragma unroll
            for (int b = 0; b < 2; ++b)
#pragma unroll
                for (int m = 0; m < 4; ++m)
#pragma unroll
                    for (int n = 0; n < 2; ++n) acc[a][b][m][n] = (f32x4){0.f, 0.f, 0.f, 0.f};
        cur = nxt; cA = nA; cB = nB; ++ui;
        if constexpr (ALIGN_EPI) { if (wr == 1) PG8_BAR; }
    }
    PG8_WAIT_V(0);
    if constexpr (!ALIGN_EPI) { if (wr == 0) PG8_BAR; }
    PG8_BAR;
    if constexpr (Epi::AFTER_DRAIN) { E.fused(acc, cur, wr, wc, fr, fq, lds, wid, lane); S.done(cur); }
#undef PG8_SA
#undef PG8_SB
#undef PG8_STAGE
#undef PG8_LDA
#undef PG8_LDB
#undef PG8_MMA
#undef PG8_WAIT_V
#undef PG8_WAIT_L
#undef PG8_BAR
#undef PG8_SCHED
}
}
#define XB_TMO      128
#define XB_XCNT(j)  (256  + 64 * (j))
#define XB_XSUB(j)  (1280 + 64 * (j))
#define XB_XGEN(j)  (2304 + 64 * (j))
#define XB_TOP      3328
#define XB_TOPGEN   3392
#define XCD_BAR_WORDS 3456
#define XB_SPIN_CAP (1u << 18)

__device__ __forceinline__ unsigned xb_ld(unsigned* p)              { return __hip_atomic_load(p, __ATOMIC_RELAXED, __HIP_MEMORY_SCOPE_AGENT); }
__device__ __forceinline__ unsigned xb_add(unsigned* p, unsigned v) { return __hip_atomic_fetch_add(p, v, __ATOMIC_RELAXED, __HIP_MEMORY_SCOPE_AGENT); }
__device__ __forceinline__ unsigned xb_xcc_id() { return (unsigned)__builtin_amdgcn_s_getreg((3 << 11) | 20) & 0xFu; }
#define XB_SPIN(cond, bar) do { unsigned _sp = 0; while (cond) { __builtin_amdgcn_s_sleep(1); \
    if ((++_sp & 255u) == 0u) { if (xb_ld(&(bar)[XB_TMO])) break; if (_sp > XB_SPIN_CAP) { atomicAdd(&(bar)[XB_TMO], 1u); break; } } } } while (0)

struct XcdBarrier {
    unsigned* bar; unsigned x;
    volatile LAS unsigned* st;
};

__device__ __forceinline__ XcdBarrier xcd_barrier_post(unsigned* bar, volatile LAS unsigned* st) {
    XcdBarrier b; b.bar = bar; b.x = xb_xcc_id(); b.st = st;
    if (threadIdx.x == 0) (void)xb_add(&bar[XB_XCNT(b.x)], 1u);
    return b;
}
__device__ __forceinline__ void xcd_barrier_complete(unsigned* bar, unsigned x, unsigned& nloc, unsigned& nx) {
    const unsigned G = gridDim.x * gridDim.y * gridDim.z;
    unsigned sum, cnt, mine, sp = 0u;
    for (;;) {
        sum = 0u; cnt = 0u; mine = 0u;
#pragma unroll
        for (unsigned j = 0; j < 16; ++j) { const unsigned c = xb_ld(&bar[XB_XCNT(j)]); sum += c; cnt += (c > 0u) ? 1u : 0u; mine = (j == x) ? c : mine; }
        if (sum == G) break;
        __builtin_amdgcn_s_sleep(1);
        if ((++sp & 255u) == 0u) { if (xb_ld(&bar[XB_TMO])) break; if (sp > XB_SPIN_CAP) { atomicAdd(&bar[XB_TMO], 1u); break; } }
    }
    nloc = mine > 0u ? mine : 1u; nx = cnt > 0u ? cnt : 1u;
}

__device__ __forceinline__ void xcd_barrier(const XcdBarrier& b) {
    asm volatile("s_waitcnt vmcnt(0)" ::: "memory");
    __syncthreads();
    if (threadIdx.x == 0) {
        unsigned* bar = b.bar;
        __builtin_amdgcn_s_waitcnt(0);
        unsigned nloc = b.st[0], nx = b.st[1];
        if (nloc == 0u) { xcd_barrier_complete(bar, b.x, nloc, nx); b.st[0] = nloc; b.st[1] = nx; }
        const unsigned old = xb_add(&bar[XB_XSUB(b.x)], 1u);
        const unsigned gen = old / nloc;
        if (old + 1u == (gen + 1u) * nloc) {
            __builtin_amdgcn_fence(__ATOMIC_RELEASE, "agent");
            asm volatile("s_waitcnt vmcnt(0)" ::: "memory");
            const unsigned og = xb_add(&bar[XB_TOP], 1u);
            const unsigned tg = og / nx;
            if (og + 1u == (tg + 1u) * nx) xb_add(&bar[XB_TOPGEN], 1u);
            else XB_SPIN(xb_ld(&bar[XB_TOPGEN]) == tg, bar);
            __builtin_amdgcn_fence(__ATOMIC_ACQUIRE, "agent");
            xb_add(&bar[XB_XGEN(b.x)], 1u);
            asm volatile("s_waitcnt vmcnt(0)" ::: "memory");
        } else {
            XB_SPIN(xb_ld(&bar[XB_XGEN(b.x)]) == gen, bar);
            __builtin_amdgcn_fence(__ATOMIC_ACQUIRE, "agent");
            asm volatile("s_waitcnt vmcnt(0)" ::: "memory");
        }
    }
    __syncthreads();
}
namespace mk {
using pg8::bf16_t; using pg8::bf16x8; using pg8::f32x4; using pg8::u32x4;
typedef unsigned u32x2 __attribute__((ext_vector_type(2)));

#ifndef MK_CHECK_ATT
#define MK_CHECK_ATT 0
#endif
#define MK_REP_SSDP 1
#define MK_REP_CONV 1
#define MK_REP_SCP 1
#define MK_REP_SCS 1
#define MK_REP_SSDS 1
#define MK_REP_ATTS 1
#define MK_REP_ATTP 1
#define MK_CHECK_TOL 0.02f
#define MK_CHECK_CODE ((b0 ? 1.f : 0.f) + (b1 ? 2.f : 0.f) + (b2 ? 4.f : 0.f) + (b3 ? 8.f : 0.f) + (b4 ? 16.f : 0.f) + (b5 ? 32.f : 0.f))
#define MK_REP_MASK 0
#define DUPK(k) (((MK_REP_MASK >> (k)) & 1) != 0)
#define REPK(k) for (int rep_ = 0; rep_ < 1 + ((MK_REP_MASK >> (k)) & 1); ++rep_)
#ifndef MK_SPLIT
#define MK_SPLIT 0
#endif

constexpr int NWAVES = 8, NTHR = 512;
constexpr int MP = 16384, MS = 512, M = MP + MS, D = 1024, DFF = 2816, DI = 2048, NP = 9472, XCW = 3072;
constexpr int PZ = 0, PXBC = 2048, PSM = 5120, PQ = 5376, PK = 6400, PV = 6656, PQI = 6912, PG = 7424;
constexpr int SCW = 2048, SCSW = 2112;
constexpr size_t O_Y = 0, O_KP = 17301504, O_VP = 21495808, O_KIP = 25690112, O_CVP = 26738688, O_SSP = 26812416,
                 O_KS = 28909568, O_VS = 29040640, O_KIS = 29171712, O_CVS = 29204480, O_SSS = 30384128, O_END = 63938560;
constexpr size_t MiB = 1u << 20;
constexpr size_t WS_CTL = 0, CTL_ZERO_BYTES = 1 * MiB;
constexpr size_t WS_W1A = 1 * MiB, WS_W1B = WS_W1A + 11 * MiB, WS_WIN = WS_W1B + 6 * MiB, WS_WBS = WS_WIN + 19 * MiB, WS_WBA = WS_WBS + 4 * MiB,
                 WS_WOUT = WS_WBA + 2 * MiB, WS_W2A = WS_WOUT + 2 * MiB, WS_W2B = WS_W2A + 11 * MiB;
constexpr size_t WS_XB = WS_W2B + 6 * MiB, WS_ACT = WS_XB + 33 * MiB, WS_T = WS_ACT + 91 * MiB, WS_HF = WS_T + 66 * MiB, WS_HB = WS_HF + 66 * MiB,
                 WS_P = WS_HB + 33 * MiB, WS_SMF = WS_P + 306 * MiB, WS_XC = WS_SMF + 9 * MiB, WS_Y = WS_XC + 99 * MiB, WS_SC = WS_Y + 66 * MiB,
                 WS_SCS = WS_SC + 128 * MiB, WS_YA = WS_SCS + 5 * MiB, WS_MG = WS_YA + 33 * MiB, WS_END = WS_MG + 33 * MiB;
constexpr int CW_BAR = 4096;
constexpr int LDS_BYTES = 163840, MISC_OFF = LDS_BYTES - 256;
constexpr int WAREA = 17920;
constexpr int BIASREL_OFF = NWAVES * WAREA;
static_assert(BIASREL_OFF + 2 * 129 * 16 * 4 <= MISC_OFF, "LDS map");

constexpr float ALPHA = 1.18920711500272f;
constexpr float LN_EPS = 1e-5f;

struct Args { const float* in[29]; float* out; unsigned char* ws; int ph_lo, ph_hi; };
enum { I_XP = 0, I_XS, I_CK, I_CV, I_CKI, I_SCONV, I_SSSM, I_PT, I_BIAS, I_WIN, I_CONVW, I_CONVB, I_DTB, I_ALOG, I_DSKIP, I_NORMG, I_WBS, I_WBA, I_WOUT,
       I_F1WI, I_F1WO, I_F2WI, I_F2WO, I_LN1G, I_LN1B, I_LN2G, I_LN2B, I_LN3G, I_LN3B };

__device__ __forceinline__ float bf2f(unsigned v) { return __uint_as_float(v << 16); }
__device__ __forceinline__ unsigned f2bf(float f) { unsigned u = __float_as_uint(f); return (u + 0x7fffu + ((u >> 16) & 1u)) >> 16; }
__device__ __forceinline__ unsigned pk2(float lo, float hi) { return pg8::cvt_pk_bf16(lo, hi); }
__device__ __forceinline__ void unpack8(const u32x4 w, float (&f)[8]) {
#pragma unroll
    for (int i = 0; i < 4; ++i) { f[2 * i] = __uint_as_float(w[i] << 16); f[2 * i + 1] = __uint_as_float(w[i] & 0xffff0000u); }
}
__device__ __forceinline__ u32x4 pack8(const float (&f)[8]) { u32x4 w; w.x = pk2(f[0], f[1]); w.y = pk2(f[2], f[3]); w.z = pk2(f[4], f[5]); w.w = pk2(f[6], f[7]); return w; }
__device__ __forceinline__ float sigmoidf_(float x) { return 1.0f / (1.0f + __expf(-x)); }
__device__ __forceinline__ float siluf_(float x) { return x / (1.0f + __expf(-x)); }
__device__ __forceinline__ float wave_sum(float v) {
#pragma unroll
    for (int o = 1; o < 64; o <<= 1) v += __shfl_xor(v, o);
    return v;
}
__device__ __forceinline__ float wave_max(float v) {
#pragma unroll
    for (int o = 1; o < 64; o <<= 1) v = fmaxf(v, __shfl_xor(v, o));
    return v;
}
__device__ __forceinline__ f32x4 mfma16(bf16x8 a, bf16x8 b, f32x4 c) { return __builtin_amdgcn_mfma_f32_16x16x32_bf16(a, b, c, 0, 0, 0); }
__device__ __forceinline__ int mbcnt64(unsigned long long m) { return (int)__builtin_amdgcn_mbcnt_hi((unsigned)(m >> 32), __builtin_amdgcn_mbcnt_lo((unsigned)m, 0u)); }

struct EpiSwiglu {
    static constexpr bool PERM = true, AFTER_DRAIN = false;
    bf16_t* O;
    __device__ __forceinline__ void operator()(const f32x4 (&acc)[2][2][4][2], const pg8::Unit& u, int wr, int wc, int fr, int fq) const {
        const int row0 = u.pm * 256 + wr * 64 + fr, col0 = u.pn * 128 + wc * 32 + 8 * fq;
#pragma unroll
        for (int ai = 0; ai < 2; ++ai)
#pragma unroll
            for (int m = 0; m < 4; ++m) {
                float o[8];
#pragma unroll
                for (int n = 0; n < 2; ++n)
#pragma unroll
                    for (int j = 0; j < 4; ++j) { const float g = acc[ai][0][m][n][j], up = acc[ai][1][m][n][j]; o[4 * n + j] = siluf_(g) * up; }
                *(u32x4*)(O + (size_t)(row0 + ai * 128 + m * 16) * DFF + col0) = pack8(o);
            }
    }
};
struct EpiResid {
    static constexpr bool PERM = false, AFTER_DRAIN = false;
    const float* base_p; const float* base_s; float* T; float alpha, s;
    __device__ __forceinline__ void operator()(const f32x4 (&acc)[2][2][4][2], const pg8::Unit& u, int wr, int wc, int fr, int fq) const {
        const int row0 = u.pm * 256 + wr * 64 + fr, col0 = u.pn * 256 + wc * 32 + 4 * fq;
#pragma unroll
        for (int ai = 0; ai < 2; ++ai)
#pragma unroll
            for (int m = 0; m < 4; ++m) {
                const int r = row0 + ai * 128 + m * 16;
                const float* b = (r < MP) ? base_p + (size_t)r * D : base_s + (size_t)(r - MP) * D;
#pragma unroll
                for (int bj = 0; bj < 2; ++bj)
#pragma unroll
                    for (int n = 0; n < 2; ++n) { const int c = col0 + bj * 128 + n * 16; const f32x4 bv = *(const f32x4*)(b + c);
                        *(f32x4*)(T + (size_t)r * D + c) = bv * alpha + acc[ai][bj][m][n] * s; }
            }
    }
};
struct EpiWin {
    static constexpr bool PERM = true, AFTER_DRAIN = false;
    bf16_t* P; float* smf; float* out;
    __device__ __forceinline__ void operator()(const f32x4 (&acc)[2][2][4][2], const pg8::Unit& u, int wr, int wc, int fr, int fq) const {
        const int row0 = u.pm * 256 + wr * 64 + fr, cl = wc * 32 + 8 * fq, col0 = u.pn * 256 + cl;
#pragma unroll
        for (int ai = 0; ai < 2; ++ai)
#pragma unroll
            for (int m = 0; m < 4; ++m) {
                const int r = row0 + ai * 128 + m * 16;
#pragma unroll
                for (int bj = 0; bj < 2; ++bj) {
                    const f32x4 v0 = acc[ai][bj][m][0], v1 = acc[ai][bj][m][1];
                    u32x4 w; w.x = pk2(v0[0], v0[1]); w.y = pk2(v0[2], v0[3]); w.z = pk2(v1[0], v1[1]); w.w = pk2(v1[2], v1[3]);
                    *(u32x4*)(P + (size_t)r * NP + col0 + bj * 128) = w;
                    if (u.pn == 20) {
                        if (bj == 0) {
                            float* d = smf + (size_t)r * 128 + cl; *(f32x4*)d = v0; *(f32x4*)(d + 4) = v1;
                            if (cl >= 64) { float* k = out + ((r < MP) ? O_KIP + (size_t)r * 64 : O_KIS + (size_t)(r - MP) * 64) + (cl - 64); *(f32x4*)k = v0; *(f32x4*)(k + 4) = v1; }
                        }
                    } else if (u.pn == 25) {
                        float* k = out + ((r < MP) ? O_KP + (size_t)r * 256 : O_KS + (size_t)(r - MP) * 256) + bj * 128 + cl; *(f32x4*)k = v0; *(f32x4*)(k + 4) = v1;
                    } else if (u.pn == 26) {
                        float* k = out + ((r < MP) ? O_VP + (size_t)r * 256 : O_VS + (size_t)(r - MP) * 256) + bj * 128 + cl; *(f32x4*)k = v0; *(f32x4*)(k + 4) = v1;
                    }
                }
            }
    }
};
struct EpiGateA {
    static constexpr bool PERM = false, AFTER_DRAIN = false;
    const bf16_t* P; int gcol; float* M1;
    __device__ __forceinline__ void operator()(const f32x4 (&acc)[2][2][4][2], const pg8::Unit& u, int wr, int wc, int fr, int fq) const {
        const int row0 = u.pm * 256 + wr * 64 + fr, col0 = u.pn * 256 + wc * 32 + 4 * fq;
#pragma unroll
        for (int ai = 0; ai < 2; ++ai)
#pragma unroll
            for (int m = 0; m < 4; ++m) {
                const int r = row0 + ai * 128 + m * 16;
#pragma unroll
                for (int bj = 0; bj < 2; ++bj)
#pragma unroll
                    for (int n = 0; n < 2; ++n) { const int c = col0 + bj * 128 + n * 16; const u32x2 gw = *(const u32x2*)(P + (size_t)r * NP + gcol + c);
                        f32x4 g; g[0] = sigmoidf_(__uint_as_float(gw.x << 16)); g[1] = sigmoidf_(__uint_as_float(gw.x & 0xffff0000u)); g[2] = sigmoidf_(__uint_as_float(gw.y << 16)); g[3] = sigmoidf_(__uint_as_float(gw.y & 0xffff0000u));
                        *(f32x4*)(M1 + (size_t)r * D + c) = g * acc[ai][bj][m][n]; }
            }
    }
};
struct EpiGateS {
    static constexpr bool PERM = true, AFTER_DRAIN = false;
    const bf16_t* P; int gcol; const float* M1; bf16_t* MG;
    __device__ __forceinline__ void operator()(const f32x4 (&acc)[2][2][4][2], const pg8::Unit& u, int wr, int wc, int fr, int fq) const {
        const int row0 = u.pm * 256 + wr * 64 + fr, col0 = u.pn * 256 + wc * 32 + 8 * fq;
#pragma unroll
        for (int ai = 0; ai < 2; ++ai)
#pragma unroll
            for (int m = 0; m < 4; ++m) {
                const int r = row0 + ai * 128 + m * 16;
#pragma unroll
                for (int bj = 0; bj < 2; ++bj) { const int c = col0 + bj * 128;
                    const u32x4 gw = *(const u32x4*)(P + (size_t)r * NP + gcol + c); float g[8]; unpack8(gw, g);
                    const f32x4 m0 = *(const f32x4*)(M1 + (size_t)r * D + c), m1 = *(const f32x4*)(M1 + (size_t)r * D + c + 4);
                    float o[8];
#pragma unroll
                    for (int j = 0; j < 4; ++j) { o[j] = m0[j] + sigmoidf_(g[j]) * acc[ai][bj][m][0][j]; o[4 + j] = m1[j] + sigmoidf_(g[4 + j]) * acc[ai][bj][m][1][j]; }
                    *(u32x4*)(MG + (size_t)r * D + c) = pack8(o); }
            }
    }
};

struct SkResid { const float* base; float* T; float alpha, s;
    __device__ __forceinline__ void operator()(int r, int c, f32x4 v) const { const f32x4 bv = *(const f32x4*)(base + (size_t)(r - MP) * D + c); *(f32x4*)(T + (size_t)r * D + c) = bv * alpha + v * s; } };
struct SkGateA { const bf16_t* P; int gcol; float* M1;
    __device__ __forceinline__ void operator()(int r, int c, f32x4 v) const { const u32x2 gw = *(const u32x2*)(P + (size_t)r * NP + gcol + c);
        f32x4 g; g[0] = sigmoidf_(__uint_as_float(gw.x << 16)); g[1] = sigmoidf_(__uint_as_float(gw.x & 0xffff0000u)); g[2] = sigmoidf_(__uint_as_float(gw.y << 16)); g[3] = sigmoidf_(__uint_as_float(gw.y & 0xffff0000u));
        *(f32x4*)(M1 + (size_t)r * D + c) = g * v; } };
struct SkGateS { const bf16_t* P; int gcol; const float* M1; bf16_t* MG;
    __device__ __forceinline__ void operator()(int r, int c, f32x4 v) const { const u32x2 gw = *(const u32x2*)(P + (size_t)r * NP + gcol + c); const f32x4 m = *(const f32x4*)(M1 + (size_t)r * D + c);
        const float o0 = m[0] + sigmoidf_(__uint_as_float(gw.x << 16)) * v[0], o1 = m[1] + sigmoidf_(__uint_as_float(gw.x & 0xffff0000u)) * v[1], o2 = m[2] + sigmoidf_(__uint_as_float(gw.y << 16)) * v[2], o3 = m[3] + sigmoidf_(__uint_as_float(gw.y & 0xffff0000u)) * v[3];
        u32x2 w; w.x = pk2(o0, o1); w.y = pk2(o2, o3); *(u32x2*)(MG + (size_t)r * D + c) = w; } };
template <int K, class Epi>
__device__ __forceinline__ void skinny_gemm(LAS unsigned char* lds, const bf16_t* A  , const bf16_t* Bt, const Epi& E, int bx, int G, int wave, int lane) {
    constexpr int KW = K / 8, NS = KW / 32;
    const int fr = lane & 15, fq = lane >> 4, tid = wave * 64 + lane;
    LAS float* part = (LAS float*)lds;
    for (int tile = bx; tile < 256; tile += G) {
        const int tm = tile >> 4, tn = tile & 15;
        const bf16_t* ap = A + (size_t)(tm * 32 + fr) * K + wave * KW + 8 * fq;
        const bf16_t* bp = Bt + (size_t)(tn * 64 + fr) * K + wave * KW + 8 * fq;
        f32x4 acc[2][4];
#pragma unroll
        for (int m = 0; m < 2; ++m)
#pragma unroll
            for (int n = 0; n < 4; ++n) acc[m][n] = (f32x4){0.f, 0.f, 0.f, 0.f};
#pragma unroll 4
        for (int ks = 0; ks < NS; ++ks) {
            bf16x8 a[2], bb[4];
#pragma unroll
            for (int m = 0; m < 2; ++m) a[m] = *(const bf16x8*)(ap + (size_t)m * 16 * K + ks * 32);
#pragma unroll
            for (int n = 0; n < 4; ++n) bb[n] = *(const bf16x8*)(bp + (size_t)n * 16 * K + ks * 32);
#pragma unroll
            for (int m = 0; m < 2; ++m)
#pragma unroll
                for (int n = 0; n < 4; ++n) acc[m][n] = mfma16(a[m], bb[n], acc[m][n]);
        }
#pragma unroll
        for (int m = 0; m < 2; ++m)
#pragma unroll
            for (int n = 0; n < 4; ++n)
#pragma unroll
                for (int j = 0; j < 4; ++j) part[(wave * 32 + m * 16 + 4 * fq + j) * 64 + n * 16 + fr] = acc[m][n][j];
        __syncthreads();
        { const int row = tid >> 4, c4 = (tid & 15) * 4; f32x4 v = {0.f, 0.f, 0.f, 0.f};
#pragma unroll
          for (int w = 0; w < 8; ++w) v += *(const LAS f32x4*)(part + (w * 32 + row) * 64 + c4);
          E(MP + tm * 32 + row, tn * 64 + c4, v); }
        __syncthreads();
    }
}

__device__ __forceinline__ int tr_src(int mode, int n) {
    if (mode == 0) return n;
    if (mode == 1) { const int j = n >> 8, i = n & 255; return (i < 128) ? j * 128 + i : DFF + j * 128 + (i - 128); }
    if (n < 5120) return n;
    if (n < 5376) { const int j = n - 5120; if (j < 32) return 5120 + j; if (j < 40) return 7264 + (j - 32); if (j >= 64 && j < 128) return 7200 + (j - 64); return -1; }
    if (n < 6400) return 5152 + (n - 5376);
    if (n < 6656) return 6176 + (n - 6400);
    if (n < 6912) return 6432 + (n - 6656);
    if (n < 7424) return 6688 + (n - 6912);
    return 7272 + (n - 7424);
}
__device__ __forceinline__ void tr_item(const float* W, int K, int Nsrc, bf16_t* WT, int k0, int n0, int mode, LAS bf16_t* scr, int lane) {
    const int kr = lane >> 4, nc = (lane & 15) * 4;
    const int sc = tr_src(mode, n0 + nc);
    f32x4 v[16];
#pragma unroll
    for (int i = 0; i < 16; ++i) v[i] = (sc >= 0) ? *(const f32x4*)(W + (size_t)(k0 + 4 * i + kr) * Nsrc + sc) : (f32x4){0.f, 0.f, 0.f, 0.f};
#pragma unroll
    for (int i = 0; i < 16; ++i) { const int k = 4 * i + kr; const unsigned p01 = pk2(v[i][0], v[i][1]), p23 = pk2(v[i][2], v[i][3]);
        scr[(nc + 0) * 72 + k] = (bf16_t)(p01 & 0xffffu); scr[(nc + 1) * 72 + k] = (bf16_t)(p01 >> 16); scr[(nc + 2) * 72 + k] = (bf16_t)(p23 & 0xffffu); scr[(nc + 3) * 72 + k] = (bf16_t)(p23 >> 16); }
    asm volatile("s_waitcnt lgkmcnt(0)" ::: "memory");
    const int nr = lane >> 3, kc = (lane & 7) * 8;
#pragma unroll
    for (int i = 0; i < 8; ++i) { const int n = 8 * i + nr; *(u32x4*)(WT + (size_t)(n0 + n) * K + k0 + kc) = *(const LAS u32x4*)(scr + n * 72 + kc); }
    asm volatile("s_waitcnt lgkmcnt(0)" ::: "memory");
}
__device__ __forceinline__ void p0_prologue(const Args& A, LAS unsigned char* lds, int gw, int NGW, int wave, int lane) {
    LAS bf16_t* scr = (LAS bf16_t*)(lds + wave * 16384);
    unsigned char* ws = A.ws;
    constexpr int NI0 = 16 * 88, NI1 = 44 * 16, NI2 = 16 * 148, NI3 = 32 * 16, NI4 = 16 * 16, NI5 = 16 * 16, NI6 = NI0, NI7 = NI1;
    constexpr int NIT = NI0 + NI1 + NI2 + NI3 + NI4 + NI5 + NI6 + NI7;
    for (int it = gw; it < NIT; it += NGW) {
        int r = it; const float* W; bf16_t* WT; int K, Nsrc, nblk, mode;
        if (r < NI0) { W = A.in[I_F1WI]; WT = (bf16_t*)(ws + WS_W1A); K = 1024; Nsrc = 2 * DFF; nblk = 88; mode = 1; }
        else if ((r -= NI0) < NI1) { W = A.in[I_F1WO]; WT = (bf16_t*)(ws + WS_W1B); K = DFF; Nsrc = 1024; nblk = 16; mode = 0; }
        else if ((r -= NI1) < NI2) { W = A.in[I_WIN]; WT = (bf16_t*)(ws + WS_WIN); K = 1024; Nsrc = 9320; nblk = 148; mode = 2; }
        else if ((r -= NI2) < NI3) { W = A.in[I_WBS]; WT = (bf16_t*)(ws + WS_WBS); K = 2048; Nsrc = 1024; nblk = 16; mode = 0; }
        else if ((r -= NI3) < NI4) { W = A.in[I_WBA]; WT = (bf16_t*)(ws + WS_WBA); K = 1024; Nsrc = 1024; nblk = 16; mode = 0; }
        else if ((r -= NI4) < NI5) { W = A.in[I_WOUT]; WT = (bf16_t*)(ws + WS_WOUT); K = 1024; Nsrc = 1024; nblk = 16; mode = 0; }
        else if ((r -= NI5) < NI6) { W = A.in[I_F2WI]; WT = (bf16_t*)(ws + WS_W2A); K = 1024; Nsrc = 2 * DFF; nblk = 88; mode = 1; }
        else { r -= NI6; W = A.in[I_F2WO]; WT = (bf16_t*)(ws + WS_W2B); K = DFF; Nsrc = 1024; nblk = 16; mode = 0; }
        const int kb = r / nblk, nb = r % nblk;
        tr_item(W, K, Nsrc, WT, kb * 64, nb * 64, mode, scr, lane);
    }
    bf16_t* XB = (bf16_t*)(ws + WS_XB);
    const int nchunk = M * D / 8;
    for (int ch0 = gw * 256 + lane; ch0 < nchunk; ch0 += NGW * 256) {
        f32x4 a[4], b[4];
#pragma unroll
        for (int u = 0; u < 4; ++u) { const int ch = ch0 + 64 * u, m = ch >> 7, c = (ch & 127) * 8;
            const float* src = (m < MP) ? A.in[I_XP] + (size_t)m * D + c : A.in[I_XS] + (size_t)(m - MP) * D + c; a[u] = *(const f32x4*)src; b[u] = *(const f32x4*)(src + 4); }
#pragma unroll
        for (int u = 0; u < 4; ++u) { const int ch = ch0 + 64 * u, m = ch >> 7, c = (ch & 127) * 8;
            u32x4 w; w.x = pk2(a[u][0], a[u][1]); w.y = pk2(a[u][2], a[u][3]); w.z = pk2(b[u][0], b[u][1]); w.w = pk2(b[u][2], b[u][3]);
            *(u32x4*)(XB + (size_t)m * D + c) = w; }
    }
}

__device__ __forceinline__ void ln_phase(const float* T, const float* g, const float* b, float* outf, bf16_t* outb, int gw, int NGW, int lane) {
    f32x4 gv[4], bv[4];
#pragma unroll
    for (int j = 0; j < 4; ++j) { gv[j] = *(const f32x4*)(g + 4 * lane + 256 * j); bv[j] = *(const f32x4*)(b + 4 * lane + 256 * j); }
    for (int m = gw; m < M; m += NGW) {
        const float* xr = T + (size_t)m * D + 4 * lane;
        f32x4 v[4]; float s = 0.f;
#pragma unroll
        for (int j = 0; j < 4; ++j) { v[j] = *(const f32x4*)(xr + 256 * j); s += (v[j][0] + v[j][1]) + (v[j][2] + v[j][3]); }
        const float mean = wave_sum(s) * (1.f / D); float s2 = 0.f;
#pragma unroll
        for (int j = 0; j < 4; ++j) { v[j] = v[j] - mean; s2 += (v[j][0] * v[j][0] + v[j][1] * v[j][1]) + (v[j][2] * v[j][2] + v[j][3] * v[j][3]); }
        const float rstd = 1.0f / sqrtf(wave_sum(s2) * (1.f / D) + LN_EPS);
#pragma unroll
        for (int j = 0; j < 4; ++j) {
            const f32x4 o = v[j] * rstd * gv[j] + bv[j];
            *(f32x4*)(outf + (size_t)m * D + 4 * lane + 256 * j) = o;
            if (outb) { u32x2 w; w.x = pk2(o[0], o[1]); w.y = pk2(o[2], o[3]); *(u32x2*)(outb + (size_t)m * D + 4 * lane + 256 * j) = w; }
        }
    }
}

template <int NT  , bool SAMP>
__device__ __forceinline__ void conv_item(const Args& A, int b, int t0, int cg, int lane) {
    const bf16_t* P = (const bf16_t*)(A.ws + WS_P); bf16_t* XC = (bf16_t*)(A.ws + WS_XC);
    const float* cw = A.in[I_CONVW]; const float* cb = A.in[I_CONVB];
    const int ch = (cg * 64 + lane) * 8;
    const size_t row0 = SAMP ? (size_t)(MP + b * 4) : (size_t)(b * 2048 + t0);
    u32x4 raw[NT + 3];
#pragma unroll
    for (int i = 0; i < NT + 3; ++i) {
        const int t = t0 - 3 + i;
        if (t >= 0) raw[i] = *(const u32x4*)(P + (row0 + (size_t)(i - 3)) * NP + PXBC + ch);
        else raw[i] = (u32x4){0u, 0u, 0u, 0u};
    }
    float w[4][8], bias[8];
#pragma unroll
    for (int j = 0; j < 4; ++j) { const f32x4 w0 = *(const f32x4*)(cw + (size_t)j * XCW + ch), w1 = *(const f32x4*)(cw + (size_t)j * XCW + ch + 4);
#pragma unroll
        for (int i = 0; i < 4; ++i) { w[j][i] = w0[i]; w[j][4 + i] = w1[i]; } }
    { const f32x4 b0 = *(const f32x4*)(cb + ch), b1 = *(const f32x4*)(cb + ch + 4);
#pragma unroll
      for (int i = 0; i < 4; ++i) { bias[i] = b0[i]; bias[4 + i] = b1[i]; } }
    float u0[8], u1[8], u2[8];
    if (SAMP) {
        const float* sc = A.in[I_SCONV] + (size_t)b * 3 * XCW + ch;
#pragma unroll
        for (int i = 0; i < 4; ++i) { const f32x4 a0 = *(const f32x4*)(sc), a1 = *(const f32x4*)(sc + 4), c0 = *(const f32x4*)(sc + XCW), c1 = *(const f32x4*)(sc + XCW + 4), e0 = *(const f32x4*)(sc + 2 * XCW), e1 = *(const f32x4*)(sc + 2 * XCW + 4);
            u0[i] = a0[i]; u0[4 + i] = a1[i]; u1[i] = c0[i]; u1[4 + i] = c1[i]; u2[i] = e0[i]; u2[4 + i] = e1[i]; }
    } else { unpack8(raw[0], u0); unpack8(raw[1], u1); unpack8(raw[2], u2); }
#pragma unroll
    for (int i = 0; i < NT; ++i) {
        float u3[8], o[8]; unpack8(raw[i + 3], u3);
#pragma unroll
        for (int e = 0; e < 8; ++e) o[e] = siluf_(bias[e] + w[0][e] * u0[e] + w[1][e] * u1[e] + w[2][e] * u2[e] + w[3][e] * u3[e]);
        *(u32x4*)(XC + (row0 + (size_t)i) * XCW + ch) = pack8(o);
        const int t = t0 + i; float* cs = nullptr;
        if (!SAMP) { if (t >= 2045) cs = A.out + O_CVP + ((size_t)b * 3 + (t - 2045)) * XCW + ch; }
        else { if (t >= 1) cs = A.out + O_CVS + ((size_t)b * 3 + (t - 1)) * XCW + ch; }
        if (cs) { *(f32x4*)cs = (f32x4){u3[0], u3[1], u3[2], u3[3]}; *(f32x4*)(cs + 4) = (f32x4){u3[4], u3[5], u3[6], u3[7]}; }
#pragma unroll
        for (int e = 0; e < 8; ++e) { u0[e] = u1[e]; u1[e] = u2[e]; u2[e] = u3[e]; }
    }
}
__device__ __forceinline__ void conv_phase(const Args& A, int gw, int NGW, int lane) {
    constexpr int NPI = 8 * 128 * 6, NSI = 128 * 6;
    for (int it = gw; it < NPI + NSI; it += NGW) {
        if (it < NPI) { const int cg = it % 6, r = it / 6; conv_item<16, false>(A, r >> 7, (r & 127) * 16, cg, lane); }
        else { const int r = it - NPI; conv_item<4, true>(A, r / 6, 0, r % 6, lane); }
    }
}

constexpr float IDX_SCALE = 0.125f * 0.35355339059327373f;
constexpr int SCL = 2052;
__device__ __forceinline__ unsigned f2key(float v) { unsigned u = (v == 0.f) ? 0u : __float_as_uint(v); return (u & 0x80000000u) ? ~u : (u | 0x80000000u); }
__device__ __forceinline__ void scores_select_prompt_unit(const Args& A, LAS unsigned char* lds, int b, int qt, int wave, int lane_in) {
    const bf16_t* P = (const bf16_t*)(A.ws + WS_P); const float* SMF = (const float*)(A.ws + WS_SMF);
    unsigned long long* MASKW = (unsigned long long*)(A.ws + WS_SC);
    LAS float* sc = (LAS float*)lds;
    int lane = lane_in; asm volatile("" : "+v"(lane));
    const int fr = lane & 15, fq = lane >> 4;
    {
        const size_t rowq = (size_t)(b * 2048 + qt * 16 + fr);
        bf16x8 Af[8][2];
#pragma unroll
        for (int h = 0; h < 8; ++h)
#pragma unroll
            for (int ks = 0; ks < 2; ++ks) Af[h][ks] = *(const bf16x8*)(P + rowq * NP + PQI + h * 64 + ks * 32 + 8 * fq);
        float wq[4][8];
#pragma unroll
        for (int j = 0; j < 4; ++j) { const float* wp = SMF + (size_t)(b * 2048 + qt * 16 + 4 * fq + j) * 128 + 32; const f32x4 w0 = *(const f32x4*)wp, w1 = *(const f32x4*)(wp + 4);
#pragma unroll
            for (int h = 0; h < 4; ++h) { wq[j][h] = w0[h] * IDX_SCALE; wq[j][4 + h] = w1[h] * IDX_SCALE; } }
        const bf16_t* kbase = P + (size_t)(b * 2048 + fr) * NP + PSM + 64 + 8 * fq;
        bf16x8 nB0 = {0, 0, 0, 0, 0, 0, 0, 0}, nB1 = nB0;
        if (wave <= qt) { const bf16_t* kp = kbase + (size_t)wave * 16 * NP; nB0 = *(const bf16x8*)kp; nB1 = *(const bf16x8*)(kp + 32); }
        for (int kt = wave; kt <= qt; kt += NWAVES) {
            const bf16x8 B0 = nB0, B1 = nB1;
            if (kt + NWAVES <= qt) { const bf16_t* kp = kbase + (size_t)(kt + NWAVES) * 16 * NP; nB0 = *(const bf16x8*)kp; nB1 = *(const bf16x8*)(kp + 32); }
            f32x4 scv = {0.f, 0.f, 0.f, 0.f};
#pragma unroll
            for (int h = 0; h < 8; ++h) { f32x4 d = {0.f, 0.f, 0.f, 0.f}; d = mfma16(Af[h][0], B0, d); d = mfma16(Af[h][1], B1, d);
#pragma unroll
                for (int j = 0; j < 4; ++j) scv[j] += wq[j][h] * fmaxf(d[j], 0.f); }
#pragma unroll
            for (int j = 0; j < 4; ++j) sc[(4 * fq + j) * SCL + kt * 16 + fr] = scv[j];
#if MK_CHECK_ATT
#pragma unroll
            for (int j = 0; j < 4; ++j) ((float*)(A.ws + WS_END))[(size_t)(b * 2048 + qt * 16 + 4 * fq + j) * SCW + kt * 16 + fr] = scv[j];
#endif
        }
    }
    __syncthreads();
#pragma unroll 1
    for (int u = 0; u < 2; ++u) {
        const int ql = 2 * wave + u, t = qt * 16 + ql, nvalid = t + 1;
        const LAS float* srow = sc + ql * SCL + lane;
        unsigned key[32];
#pragma unroll
        for (int j = 0; j < 32; ++j) key[j] = (lane < nvalid - 64 * j) ? f2key(srow[64 * j]) : 0u;
        unsigned T = 0u; int need_eq = 0;
        if (nvalid > 256) {
            bool exact = false;
            for (int bit = 31; bit >= 0; --bit) {
                const unsigned cand = T | (1u << bit); int cnt = 0;
#pragma unroll
                for (int j = 0; j < 32; ++j) cnt += __popcll(__ballot(key[j] >= cand));
                if (cnt >= 256) { T = cand; if (cnt == 256) { exact = true; break; } }
            }
            if (exact) { T -= 1u; }
            else { int cgt = 0;
#pragma unroll
                for (int j = 0; j < 32; ++j) cgt += __popcll(__ballot(key[j] > T));
                need_eq = 256 - cgt; }
        }
        int eqused = 0; unsigned long long mine = 0ull;
#pragma unroll
        for (int j = 0; j < 32; ++j) {
            unsigned long long ms;
            if (need_eq > 0) {
                const bool gt = key[j] > T, eq = key[j] == T;
                const unsigned long long meq = __ballot(eq);
                const bool sel = gt || (eq && (eqused + mbcnt64(meq) < need_eq));
                eqused += __popcll(meq);
                ms = __ballot(sel);
            } else ms = __ballot(key[j] > T);
            if (lane == j) mine = ms;
        }
        if (lane < 32) MASKW[(size_t)(b * 2048 + t) * 32 + lane] = mine;
    }
    __syncthreads();
}
__device__ __forceinline__ void scores_sample_unit(const Args& A, int b, int half, int wave, int lane) {
    const bf16_t* P = (const bf16_t*)(A.ws + WS_P); const float* SMF = (const float*)(A.ws + WS_SMF); float* SCS = (float*)(A.ws + WS_SCS);
    const int* pt = (const int*)A.in[I_PT]; const float* cki = A.in[I_CKI];
    const int fr = lane & 15, fq = lane >> 4;
    bf16x8 Af[2][2]; float wq[2][4];
#pragma unroll
    for (int mt = 0; mt < 2; ++mt) {
#pragma unroll
        for (int ks = 0; ks < 2; ++ks) Af[mt][ks] = *(const bf16x8*)(P + (size_t)(MP + b * 4 + 2 * mt + (fr >> 3)) * NP + PQI + (fr & 7) * 64 + ks * 32 + 8 * fq);
        const f32x4 w = *(const f32x4*)(SMF + (size_t)(MP + b * 4 + 2 * mt + (fq >> 1)) * 128 + 32 + 4 * (fq & 1));
#pragma unroll
        for (int j = 0; j < 4; ++j) wq[mt][j] = w[j] * IDX_SCALE;
    }
    const int kt_end = (half == 0) ? 65 : 129;
    for (int kt = half * 65 + wave; kt < kt_end; kt += NWAVES) {
        const int key = kt * 16 + fr;
        bf16x8 B0, B1;
        if (key < 2048) {
            const int page = pt[b * 16 + (key >> 7)];
            const float* src = cki + ((size_t)page * 128 + (key & 127)) * 64 + 8 * fq;
            const f32x4 a0 = *(const f32x4*)src, a1 = *(const f32x4*)(src + 4), c0 = *(const f32x4*)(src + 32), c1 = *(const f32x4*)(src + 36);
            u32x4 w0, w1; w0.x = pk2(a0[0], a0[1]); w0.y = pk2(a0[2], a0[3]); w0.z = pk2(a1[0], a1[1]); w0.w = pk2(a1[2], a1[3]);
            w1.x = pk2(c0[0], c0[1]); w1.y = pk2(c0[2], c0[3]); w1.z = pk2(c1[0], c1[1]); w1.w = pk2(c1[2], c1[3]);
            B0 = __builtin_bit_cast(bf16x8, w0); B1 = __builtin_bit_cast(bf16x8, w1);
        } else if (key < 2052) {
            const bf16_t* src = P + (size_t)(MP + b * 4 + (key - 2048)) * NP + PSM + 64 + 8 * fq;
            B0 = *(const bf16x8*)src; B1 = *(const bf16x8*)(src + 32);
        } else { B0 = (bf16x8){0, 0, 0, 0, 0, 0, 0, 0}; B1 = B0; }
#pragma unroll
        for (int mt = 0; mt < 2; ++mt) {
            f32x4 d = {0.f, 0.f, 0.f, 0.f}; d = mfma16(Af[mt][0], B0, d); d = mfma16(Af[mt][1], B1, d);
            float s = 0.f;
#pragma unroll
            for (int j = 0; j < 4; ++j) s += wq[mt][j] * fmaxf(d[j], 0.f);
            s += __shfl_xor(s, 16);
            if ((fq & 1) == 0 && key < 2052) SCS[(size_t)(b * 4 + 2 * mt + (fq >> 1)) * SCSW + key] = s;
        }
    }
}

__device__ __forceinline__ float softplusf_(float x) { return fmaxf(x, 0.f) + log1pf(expf(-fabsf(x))); }
__device__ __forceinline__ void ssd_prompt_item(const Args& A, LAS unsigned char* lds, int b, int h) {
    const int tid = threadIdx.x, lane = tid & 63, wave = __builtin_amdgcn_readfirstlane(tid >> 6), fr = lane & 15, fq = lane >> 4;
    const int g = h >> 3;
    const bf16_t* XC = (const bf16_t*)(A.ws + WS_XC); const float* SMF = (const float*)(A.ws + WS_SMF); bf16_t* Y = (bf16_t*)(A.ws + WS_Y);
    LAS bf16_t* Cm = (LAS bf16_t*)lds;
    LAS bf16_t* Bm = Cm + 64 * 136;
    LAS bf16_t* Btw = Bm + 64 * 136;
    LAS bf16_t* Xt = Btw + 128 * 72;
    LAS bf16_t* Mt = Xt + 64 * 72;
    LAS bf16_t* Hp = Mt + 64 * 72;
    LAS float* cumA = (LAS float*)(Hp + 64 * 136);
    LAS float* dtvA = cumA + 2048; LAS float* wvA = dtvA + 2048; LAS float* ecumA = wvA + 2048;
    const float Ah = -expf(A.in[I_ALOG][h]), dtb = A.in[I_DTB][h], dsk = A.in[I_DSKIP][h];
    f32x4 hst[4];
#pragma unroll
    for (int i = 0; i < 4; ++i) hst[i] = (f32x4){0.f, 0.f, 0.f, 0.f};
    for (int i = tid; i < 64 * 136 / 8; i += NTHR) *(LAS u32x4*)(Hp + i * 8) = (u32x4){0u, 0u, 0u, 0u};
#pragma unroll 1
    for (int c = wave; c < 32; c += NWAVES) {
        const int tk = c * 64 + lane;
        const float dt = softplusf_(SMF[(size_t)(b * 2048 + tk) * 128 + h] + dtb);
        float v = dt * Ah;
#pragma unroll
        for (int o = 1; o < 64; o <<= 1) { const float n = __shfl_up(v, o); if (lane >= o) v += n; }
        const float ce = __shfl(v, 63);
        cumA[tk] = v; dtvA[tk] = dt; wvA[tk] = dt * expf(ce - v); ecumA[tk] = expf(v);
    }
    const int s0 = tid >> 4, part0 = tid & 15;
    const int xs = tid >> 3, xpart = tid & 7;
    u32x4 cr[2], br[2], xr;
    {
#pragma unroll
        for (int i = 0; i < 2; ++i) { const bf16_t* rp = XC + (size_t)(b * 2048 + s0 + 32 * i) * XCW + g * 128 + part0 * 8; cr[i] = *(const u32x4*)(rp + 2560); br[i] = *(const u32x4*)(rp + 2048); }
        xr = *(const u32x4*)(XC + (size_t)(b * 2048 + xs) * XCW + h * 64 + xpart * 8);
    }
    for (int c = 0; c < 32; ++c) {
        const int row0 = b * 2048 + c * 64;
        const LAS float* cum = cumA + c * 64; const LAS float* dtv = dtvA + c * 64; const LAS float* wv = wvA + c * 64; const LAS float* ecum = ecumA + c * 64;
        __syncthreads();
#pragma unroll
        for (int i = 0; i < 2; ++i) {
            const int s = s0 + 32 * i;
            *(LAS u32x4*)(Cm + s * 136 + part0 * 8) = cr[i];
            *(LAS u32x4*)(Bm + s * 136 + part0 * 8) = br[i];
            float bf[8]; unpack8(br[i], bf); const float w = wv[s];
#pragma unroll
            for (int e = 0; e < 8; ++e) Btw[(part0 * 8 + e) * 72 + s] = (bf16_t)f2bf(bf[e] * w);
        }
        {
#pragma unroll
            for (int e = 0; e < 4; ++e) { Xt[(xpart * 8 + 2 * e) * 72 + xs] = (bf16_t)(xr[e] & 0xffffu); Xt[(xpart * 8 + 2 * e + 1) * 72 + xs] = (bf16_t)(xr[e] >> 16); }
        }
#pragma unroll
        for (int p4 = 0; p4 < 4; ++p4) { u32x2 w; w.x = pk2(hst[p4][0], hst[p4][1]); w.y = pk2(hst[p4][2], hst[p4][3]);
            *(LAS u32x2*)(Hp + (16 * p4 + fr) * 136 + 16 * wave + 4 * fq) = w; }
        if (c + 1 < 32) {
#pragma unroll
            for (int i = 0; i < 2; ++i) { const bf16_t* rp = XC + (size_t)(row0 + 64 + s0 + 32 * i) * XCW + g * 128 + part0 * 8; cr[i] = *(const u32x4*)(rp + 2560); br[i] = *(const u32x4*)(rp + 2048); }
            xr = *(const u32x4*)(XC + (size_t)(row0 + 64 + xs) * XCW + h * 64 + xpart * 8);
        }
        __syncthreads();
        {
            const int st = wave >> 1, tt0 = 2 * (wave & 1);
            bf16x8 a[4];
#pragma unroll
            for (int ks = 0; ks < 4; ++ks) a[ks] = *(const LAS bf16x8*)(Bm + (16 * st + fr) * 136 + ks * 32 + 8 * fq);
#pragma unroll
            for (int u = 0; u < 2; ++u) {
                const int tt = tt0 + u; f32x4 d = {0.f, 0.f, 0.f, 0.f};
#pragma unroll
                for (int ks = 0; ks < 4; ++ks) { const bf16x8 bb = *(const LAS bf16x8*)(Cm + (16 * tt + fr) * 136 + ks * 32 + 8 * fq); d = mfma16(a[ks], bb, d); }
                const int t = 16 * tt + fr; const float ct = cum[t]; float mv[4];
#pragma unroll
                for (int j = 0; j < 4; ++j) { const int s = 16 * st + 4 * fq + j; mv[j] = (s <= t) ? d[j] * __expf(ct - cum[s]) * dtv[s] : 0.f; }
                u32x2 w; w.x = pk2(mv[0], mv[1]); w.y = pk2(mv[2], mv[3]);
                *(LAS u32x2*)(Mt + t * 72 + 16 * st + 4 * fq) = w;
            }
        }
        __syncthreads();
        {
            const int pt = wave >> 1, tt0 = 2 * (wave & 1);
            bf16x8 a1[2], a2[4];
#pragma unroll
            for (int ks = 0; ks < 2; ++ks) a1[ks] = *(const LAS bf16x8*)(Xt + (16 * pt + fr) * 72 + ks * 32 + 8 * fq);
#pragma unroll
            for (int ks = 0; ks < 4; ++ks) a2[ks] = *(const LAS bf16x8*)(Hp + (16 * pt + fr) * 136 + ks * 32 + 8 * fq);
#pragma unroll
            for (int u = 0; u < 2; ++u) {
                const int tt = tt0 + u; f32x4 d1 = {0.f, 0.f, 0.f, 0.f}, d2 = {0.f, 0.f, 0.f, 0.f};
#pragma unroll
                for (int ks = 0; ks < 2; ++ks) { const bf16x8 bb = *(const LAS bf16x8*)(Mt + (16 * tt + fr) * 72 + ks * 32 + 8 * fq); d1 = mfma16(a1[ks], bb, d1); }
#pragma unroll
                for (int ks = 0; ks < 4; ++ks) { const bf16x8 bb = *(const LAS bf16x8*)(Cm + (16 * tt + fr) * 136 + ks * 32 + 8 * fq); d2 = mfma16(a2[ks], bb, d2); }
                const int t = 16 * tt + fr; const float et = ecum[t]; float yv[4];
#pragma unroll
                for (int j = 0; j < 4; ++j) { const int p = 16 * pt + 4 * fq + j; yv[j] = d1[j] + et * d2[j] + dsk * bf2f((unsigned)Xt[p * 72 + t]); }
                u32x2 w; w.x = pk2(yv[0], yv[1]); w.y = pk2(yv[2], yv[3]);
                *(u32x2*)(Y + (size_t)(row0 + t) * DI + h * 64 + 16 * pt + 4 * fq) = w;
            }
            bf16x8 a3[2];
#pragma unroll
            for (int ks = 0; ks < 2; ++ks) a3[ks] = *(const LAS bf16x8*)(Btw + (16 * wave + fr) * 72 + ks * 32 + 8 * fq);
            const float dec = ecum[63];
#pragma unroll
            for (int p4 = 0; p4 < 4; ++p4) { f32x4 d = {0.f, 0.f, 0.f, 0.f};
#pragma unroll
                for (int ks = 0; ks < 2; ++ks) { const bf16x8 bb = *(const LAS bf16x8*)(Xt + (16 * p4 + fr) * 72 + ks * 32 + 8 * fq); d = mfma16(a3[ks], bb, d); }
                hst[p4] = hst[p4] * dec + d; }
        }
    }
    float* so = A.out + O_SSP + ((size_t)b * 32 + h) * 64 * 128;
#pragma unroll
    for (int p4 = 0; p4 < 4; ++p4) *(f32x4*)(so + (size_t)(16 * p4 + fr) * 128 + 16 * wave + 4 * fq) = hst[p4];
    __syncthreads();
}

__device__ __forceinline__ void ssd_sample_item(const Args& A, LAS unsigned char* wl, int b, int h, int lane) {
    const bf16_t* XC = (const bf16_t*)(A.ws + WS_XC); const float* SMF = (const float*)(A.ws + WS_SMF); bf16_t* Y = (bf16_t*)(A.ws + WS_Y);
    LAS float* red = (LAS float*)wl;
    const int g = h >> 3;
    const float Ah = -expf(A.in[I_ALOG][h]), dtb = A.in[I_DTB][h], dsk = A.in[I_DSKIP][h];
#pragma unroll 1
    for (int half = 0; half < 2; ++half) {
        const float* h0 = A.in[I_SSSM] + (((size_t)b * 32 + h) * 64 + 32 * half) * 128 + 2 * lane;
        float st[32][2];
#pragma unroll
        for (int p = 0; p < 32; ++p) { const float2 v = *(const float2*)(h0 + p * 128); st[p][0] = v.x; st[p][1] = v.y; }
#pragma unroll 1
        for (int t = 0; t < 4; ++t) {
            const size_t m = (size_t)(MP + b * 4 + t);
            const float dt = softplusf_(SMF[m * 128 + h] + dtb), dec = expf(dt * Ah);
            const unsigned bw = *(const unsigned*)(XC + m * XCW + 2048 + g * 128 + 2 * lane), cw = *(const unsigned*)(XC + m * XCW + 2560 + g * 128 + 2 * lane);
            const float b0 = bf2f(bw & 0xffffu) * dt, b1 = __uint_as_float(bw & 0xffff0000u) * dt, c0 = bf2f(cw & 0xffffu), c1 = __uint_as_float(cw & 0xffff0000u);
            const float xl = bf2f((unsigned)XC[m * XCW + h * 64 + 32 * half + (lane & 31)]);
#pragma unroll
            for (int p = 0; p < 32; ++p) {
                const float xp = __shfl(xl, p);
                st[p][0] = st[p][0] * dec + xp * b0; st[p][1] = st[p][1] * dec + xp * b1;
                red[p * 65 + lane] = st[p][0] * c0 + st[p][1] * c1;
            }
            asm volatile("s_waitcnt lgkmcnt(0)" ::: "memory");
            float y = 0.f;
#pragma unroll 16
            for (int i = 0; i < 64; ++i) y += red[(lane & 31) * 65 + i];
            y += dsk * xl;
            if (lane < 32) Y[m * DI + h * 64 + 32 * half + lane] = (bf16_t)f2bf(y);
            asm volatile("s_waitcnt lgkmcnt(0)" ::: "memory");
        }
        float* so = A.out + O_SSS + (((size_t)b * 32 + h) * 64 + 32 * half) * 128 + 2 * lane;
#pragma unroll
        for (int p = 0; p < 32; ++p) *(float2*)(so + p * 128) = make_float2(st[p][0], st[p][1]);
    }
}

__device__ __forceinline__ int t5_bucket(int n) {
    if (n < 16) return n;
    const float nf = (float)n;
    int large = 16 + (int)(logf(nf / 16.0f) / 2.0794415416798357f * 16.0f);
    return large < 31 ? large : 31;
}
typedef float f32x16 __attribute__((ext_vector_type(16)));
__device__ __forceinline__ f32x16 mfma32(bf16x8 a, bf16x8 b, f32x16 c) { return __builtin_amdgcn_mfma_f32_32x32x16_bf16(a, b, c, 0, 0, 0); }
constexpr float LOG2E = 1.4426950408889634f;
constexpr int AK_STR = 72, AV_STR = 96, ATK_T = 64 * AK_STR * 2, ATV_T = 64 * AV_STR * 2, AT_K0 = 0, AT_V0 = 4 * ATK_T, AT_WS = AT_V0 + 4 * ATV_T;
struct AttStage { u32x4 k0, v0, k1, v1, m; };
__device__ __forceinline__ void att_issue(AttStage& R, const bf16_t* src, const unsigned* msrc) {
    const bf16_t* src1 = src + (size_t)64 * NP;
    asm volatile("global_load_dwordx4 %0, %5, off\n\tglobal_load_dwordx4 %1, %5, off offset:512\n\tglobal_load_dwordx4 %2, %6, off\n\tglobal_load_dwordx4 %3, %6, off offset:512\n\tglobal_load_dwordx4 %4, %7, off"
                 : "=&v"(R.k0), "=&v"(R.v0), "=&v"(R.k1), "=&v"(R.v1), "=&v"(R.m) : "v"(src), "v"(src1), "v"(msrc) : "memory");
}
__device__ __forceinline__ void att_wait(AttStage& R) { asm volatile("s_waitcnt vmcnt(0)" : "+v"(R.k0), "+v"(R.v0), "+v"(R.k1), "+v"(R.v1), "+v"(R.m) :: "memory"); }
__device__ __forceinline__ void att_stage_write1(const u32x4 k, const u32x4 v, LAS bf16_t* Kb, LAS bf16_t* Vb, int skey, int sdch) {
    *(LAS u32x4*)(Kb + skey * AK_STR + sdch * 8) = k;
    *(LAS u32x4*)(Vb + skey * AV_STR + sdch * 8) = v;
}
typedef short v4i16_t __attribute__((ext_vector_type(4)));
__device__ __forceinline__ u32x2 lds_tr16(const LAS bf16_t* p) { return __builtin_bit_cast(u32x2, __builtin_amdgcn_ds_read_tr16_b64_v4i16((LAS v4i16_t*)p)); }
struct AttState { f32x16 O0, O1; float m_run, l_run; };
__device__ __forceinline__ void att_tile(AttState& st, const LAS bf16_t* Kb, const LAS bf16_t* Vb, const bf16x8 (&qf)[4], unsigned mw0, unsigned mw1, bool far, float bfar, const LAS float* bl  ,
                                         int rb  , LAS float* wsc, int r32, int hi) {
    const int lane16 = r32 & 15, blk16 = r32 >> 4;
    const unsigned w0 = mw0 >> (4 * hi), w1 = mw1 >> (4 * hi);
    f32x16 S0, S1;
#pragma unroll
    for (int i = 0; i < 16; ++i) { S0[i] = 0.f; S1[i] = 0.f; }
#pragma unroll
    for (int ds = 0; ds < 4; ++ds) {
        const bf16x8 k0 = *(const LAS bf16x8*)(Kb + r32 * AK_STR + 16 * ds + 8 * hi), k1 = *(const LAS bf16x8*)(Kb + (32 + r32) * AK_STR + 16 * ds + 8 * hi);
        S0 = mfma32(k0, qf[ds], S0); S1 = mfma32(k1, qf[ds], S1);
    }
    const float c1 = 0.125f * LOG2E;
    float tm;
    if (far) {
        float t0 = fmaxf(S0[0], S1[0]);
#pragma unroll
        for (int i = 1; i < 16; ++i) t0 = fmaxf(t0, fmaxf(S0[i], S1[i]));
        tm = t0 * c1 + bfar;
    } else {
#pragma unroll
        for (int i = 0; i < 16; ++i) { const int pos = (i & 3) + 8 * (i >> 2);
            int r0 = rb - pos, r1 = r0 - 32; r0 = r0 < 0 ? 0 : (r0 > 128 ? 128 : r0); r1 = r1 < 0 ? 0 : (r1 > 128 ? 128 : r1);
            S0[i] = S0[i] * c1 + bl[r0 * 16]; S1[i] = S1[i] * c1 + bl[r1 * 16]; }
        float t0 = fmaxf(S0[0], S1[0]);
#pragma unroll
        for (int i = 1; i < 16; ++i) t0 = fmaxf(t0, fmaxf(S0[i], S1[i]));
        tm = t0;
    }
    tm = fmaxf(tm, __shfl_xor(tm, 32));
    if (__any(tm > st.m_run + 8.0f)) {
        const float mn = fmaxf(st.m_run, tm), f = __builtin_amdgcn_exp2f(st.m_run - mn);
        st.m_run = mn; st.l_run *= f;
        if (hi == 0) wsc[r32] = f;
        asm volatile("s_waitcnt lgkmcnt(0)" ::: "memory");
#pragma unroll
        for (int i = 0; i < 16; ++i) { const float fi = wsc[(i & 3) + 8 * (i >> 2) + 4 * hi]; st.O0[i] *= fi; st.O1[i] *= fi; }
        asm volatile("s_waitcnt lgkmcnt(0)" ::: "memory");
    }
    float ls = 0.f;
    {
        const float sc = far ? c1 : 1.0f, off = (far ? bfar : 0.f) - st.m_run;
#pragma unroll
        for (int i = 0; i < 16; ++i) { const int pos = (i & 3) + 8 * (i >> 2);
            const float p0 = __builtin_amdgcn_exp2f(S0[i] * sc + off), p1 = __builtin_amdgcn_exp2f(S1[i] * sc + off);
            unsigned k0, k1;
            asm("v_bfe_i32 %0, %1, %2, 1" : "=v"(k0) : "v"(w0), "i"(pos)); asm("v_bfe_i32 %0, %1, %2, 1" : "=v"(k1) : "v"(w1), "i"(pos));
            S0[i] = __uint_as_float(__float_as_uint(p0) & k0); S1[i] = __uint_as_float(__float_as_uint(p1) & k1);
            ls += S0[i] + S1[i]; }
    }
    st.l_run += ls;
    bf16x8 pa[2][2];
#pragma unroll
    for (int sk = 0; sk < 2; ++sk) {
        u32x4 a0, a1;
        a0.x = pk2(S0[8 * sk + 0], S0[8 * sk + 1]); a0.y = pk2(S0[8 * sk + 2], S0[8 * sk + 3]); a0.z = pk2(S0[8 * sk + 4], S0[8 * sk + 5]); a0.w = pk2(S0[8 * sk + 6], S0[8 * sk + 7]);
        a1.x = pk2(S1[8 * sk + 0], S1[8 * sk + 1]); a1.y = pk2(S1[8 * sk + 2], S1[8 * sk + 3]); a1.z = pk2(S1[8 * sk + 4], S1[8 * sk + 5]); a1.w = pk2(S1[8 * sk + 6], S1[8 * sk + 7]);
        pa[0][sk] = __builtin_bit_cast(bf16x8, a0); pa[1][sk] = __builtin_bit_cast(bf16x8, a1);
    }
    const LAS bf16_t* vl = Vb + (4 * hi + ((lane16 >> 2))) * AV_STR + 16 * blk16 + 4 * (lane16 & 3);
#pragma unroll
    for (int blk = 0; blk < 2; ++blk)
#pragma unroll
        for (int sk = 0; sk < 2; ++sk) {
            const LAS bf16_t* vr = vl + (32 * blk + 16 * sk) * AV_STR;
            const u32x2 a = lds_tr16(vr), c = lds_tr16(vr + 8 * AV_STR), a2 = lds_tr16(vr + 32), c2 = lds_tr16(vr + 8 * AV_STR + 32);
            const u32x4 v0 = {a.x, a.y, c.x, c.y}, v1 = {a2.x, a2.y, c2.x, c2.y};
            st.O0 = mfma32(pa[blk][sk], __builtin_bit_cast(bf16x8, v0), st.O0);
            st.O1 = mfma32(pa[blk][sk], __builtin_bit_cast(bf16x8, v1), st.O1);
        }
}
__device__ __forceinline__ void attn_prompt_unit(const Args& A, LAS unsigned char* lds, const LAS float* biasL, int b, int g, int qt, int wave, int lane_in) {
    const bf16_t* P = (const bf16_t*)(A.ws + WS_P); const unsigned* MASK32 = (const unsigned*)(A.ws + WS_SC); bf16_t* YA = (bf16_t*)(A.ws + WS_YA);
    int lane = lane_in; asm volatile("" : "+v"(lane));
    const int tid = wave * 64 + lane, r32 = lane & 31, hi = lane >> 5;
    LAS float* wsc = (LAS float*)(lds + AT_WS) + wave * 64;
    const int query = qt * 64 + 8 * wave + (r32 >> 2), head = 4 * g + (r32 & 3);
    const size_t qrow = (size_t)(b * 2048 + query);
    bf16x8 qf[4];
#pragma unroll
    for (int ds = 0; ds < 4; ++ds) qf[ds] = *(const bf16x8*)(P + qrow * NP + PQ + head * 64 + 16 * ds + 8 * hi);
    const unsigned* mrow = MASK32 + qrow * 64;
    float bfar = biasL[128 * 16 + head];
    const LAS float* bl = biasL + head;
    asm volatile("" : "+v"(qf[0]), "+v"(qf[1]), "+v"(qf[2]), "+v"(qf[3]), "+v"(bfar));
    const int skey = tid >> 3, sdch = tid & 7;
    const bf16_t* ksrc = P + (size_t)(b * 2048 + skey) * NP + PK + g * 64 + sdch * 8;
    AttState st;
#pragma unroll
    for (int i = 0; i < 16; ++i) { st.O0[i] = 0.f; st.O1[i] = 0.f; }
    st.m_run = -1e30f; st.l_run = 0.f;
    const int nstep = (qt + 2) >> 1;
    AttStage R;
    att_issue(R, ksrc, mrow);
    att_wait(R);
    att_stage_write1(R.k0, R.v0, (LAS bf16_t*)(lds + AT_K0), (LAS bf16_t*)(lds + AT_V0), skey, sdch);
    att_stage_write1(R.k1, R.v1, (LAS bf16_t*)(lds + AT_K0 + ATK_T), (LAS bf16_t*)(lds + AT_V0 + ATV_T), skey, sdch);
    u32x4 mw = R.m;
    for (int j = 0; j < nstep; ++j) {
        const int buf = j & 1, kt = 2 * j;
        __syncthreads();
        { const int jn = (j + 1 < nstep) ? j + 1 : j; att_issue(R, ksrc + (size_t)jn * 128 * NP, mrow + 4 * jn); }
        const LAS bf16_t* Kb = (const LAS bf16_t*)(lds + AT_K0 + buf * (2 * ATK_T)); const LAS bf16_t* Vb = (const LAS bf16_t*)(lds + AT_V0 + buf * (2 * ATV_T));
        att_tile(st, Kb, Vb, qf, mw[0], mw[1], qt - kt >= 3, bfar, bl, query - (kt * 64 + 4 * hi), wsc, r32, hi);
        if (kt + 1 <= qt) att_tile(st, (const LAS bf16_t*)((const LAS unsigned char*)Kb + ATK_T), (const LAS bf16_t*)((const LAS unsigned char*)Vb + ATV_T), qf, mw[2], mw[3], qt - kt - 1 >= 3, bfar, bl, query - ((kt + 1) * 64 + 4 * hi), wsc, r32, hi);
        att_wait(R);
        if (j + 1 < nstep) {
            LAS bf16_t* Kn = (LAS bf16_t*)(lds + AT_K0 + (buf ^ 1) * (2 * ATK_T)); LAS bf16_t* Vn = (LAS bf16_t*)(lds + AT_V0 + (buf ^ 1) * (2 * ATV_T));
            att_stage_write1(R.k0, R.v0, Kn, Vn, skey, sdch);
            att_stage_write1(R.k1, R.v1, (LAS bf16_t*)((LAS unsigned char*)Kn + ATK_T), (LAS bf16_t*)((LAS unsigned char*)Vn + ATV_T), skey, sdch);
        }
        mw = R.m;
    }
    st.l_run += __shfl_xor(st.l_run, 32);
    if (hi == 0) wsc[r32] = 1.0f / st.l_run;
    asm volatile("s_waitcnt lgkmcnt(0)" ::: "memory");
#pragma unroll
    for (int i = 0; i < 16; ++i) {
        const int rq = (i & 3) + 8 * (i >> 2) + 4 * hi; const float inv = wsc[rq];
        bf16_t* dst = YA + (size_t)(b * 2048 + qt * 64 + 8 * wave + (rq >> 2)) * D + (4 * g + (rq & 3)) * 64 + r32;
        dst[0] = (bf16_t)f2bf(st.O0[i] * inv); dst[32] = (bf16_t)f2bf(st.O1[i] * inv);
    }
    __syncthreads();
}

__device__ __forceinline__ void attend_sample_task(const Args& A, LAS unsigned char* wl, const LAS float* biasrel, int ms, int g, int lane_in) {
    constexpr int NJ = 33;
    int lane = lane_in; asm volatile("" : "+v"(lane));
    const bf16_t* P = (const bf16_t*)(A.ws + WS_P);
    const int b = ms >> 2, t = ms & 3, nvalid = 2049 + t, qpos = 2048 + t, m = MP + ms;
    const float* srow = (const float*)(A.ws + WS_SCS) + (size_t)ms * SCSW;
    LAS float* pq = (LAS float*)wl;
    LAS unsigned* rowid = (LAS unsigned*)(wl + 4096);
    LAS unsigned short* posl = (LAS unsigned short*)(wl + 4096 + 1024);
    unsigned key[NJ];
#pragma unroll
    for (int j = 0; j < NJ; ++j) key[j] = (lane < nvalid - 64 * j) ? f2key(srow[lane + 64 * j]) : 0u;
    unsigned T = 0u; int need_eq = 0;
    {
        bool exact = false;
        for (int bit = 31; bit >= 0; --bit) {
            const unsigned cand = T | (1u << bit); int cnt = 0;
#pragma unroll
            for (int j = 0; j < NJ; ++j) cnt += __popcll(__ballot(key[j] >= cand));
            if (cnt >= 256) { T = cand; if (cnt == 256) { exact = true; break; } }
        }
        if (exact) { T -= 1u; }
        else { int cgt = 0;
#pragma unroll
            for (int j = 0; j < NJ; ++j) cgt += __popcll(__ballot(key[j] > T));
            need_eq = 256 - cgt; }
    }
    int base = 0, eqused = 0;
    const int* pt = (const int*)A.in[I_PT];
#pragma unroll
    for (int j = 0; j < NJ; ++j) {
        const bool gt = key[j] > T, eq = (need_eq > 0) && (key[j] == T);
        const unsigned long long meq = __ballot(eq);
        const bool sel = gt || (eq && (eqused + mbcnt64(meq) < need_eq));
        eqused += __popcll(meq);
        const unsigned long long msk = __ballot(sel);
        if (sel) { const int pos = lane + 64 * j, k = base + mbcnt64(msk);
            posl[k] = (unsigned short)pos;
            rowid[k] = (pos < 2048) ? (unsigned)(pt[b * 16 + (pos >> 7)] * 128 + (pos & 127)) : (0x80000000u | (unsigned)(b * 4 + pos - 2048)); }
        base += __popcll(msk);
    }
    { const u32x2 w = *(const u32x2*)(P + (size_t)m * NP + PQ + g * 256 + lane * 4);
      *(LAS f32x4*)(pq + lane * 4) = (f32x4){__uint_as_float(w.x << 16), __uint_as_float(w.x & 0xffff0000u), __uint_as_float(w.y << 16), __uint_as_float(w.y & 0xffff0000u)}; }
    asm volatile("s_waitcnt lgkmcnt(0)" ::: "memory");
    const float* ck = A.in[I_CK]; const float* cv = A.in[I_CV]; const float* kn = A.out + O_KS; const float* vn = A.out + O_VS;
    const float* kp[4]; int rel[4];
#pragma unroll
    for (int i = 0; i < 4; ++i) { const unsigned rid = rowid[lane + 64 * i]; rel[i] = qpos - (int)posl[lane + 64 * i];
        kp[i] = ((rid & 0x80000000u) ? kn + (size_t)(rid & 0x7fffffffu) * 256 : ck + (size_t)rid * 256) + g * 64; }
    float acc[4][4];
#pragma unroll
    for (int i = 0; i < 4; ++i)
#pragma unroll
        for (int hh = 0; hh < 4; ++hh) acc[i][hh] = 0.f;
#pragma unroll 2
    for (int dc = 0; dc < 16; ++dc) {
        f32x4 kv[4];
#pragma unroll
        for (int i = 0; i < 4; ++i) kv[i] = *(const f32x4*)(kp[i] + dc * 4);
#pragma unroll
        for (int hh = 0; hh < 4; ++hh) { const f32x4 q4 = *(const LAS f32x4*)(pq + hh * 64 + dc * 4);
#pragma unroll
            for (int i = 0; i < 4; ++i) acc[i][hh] += kv[i][0] * q4[0] + kv[i][1] * q4[1] + kv[i][2] * q4[2] + kv[i][3] * q4[3]; }
    }
    asm volatile("s_waitcnt lgkmcnt(0)" ::: "memory");
#pragma unroll
    for (int i = 0; i < 4; ++i) { const int rc = rel[i] < 128 ? (rel[i] < 0 ? 0 : rel[i]) : 128; const f32x4 bv = *(const LAS f32x4*)(biasrel + rc * 16 + 4 * g);
#pragma unroll
        for (int hh = 0; hh < 4; ++hh) acc[i][hh] = acc[i][hh] * 0.125f + bv[hh]; }
#pragma unroll
    for (int hh = 0; hh < 4; ++hh) {
        const float mx = wave_max(fmaxf(fmaxf(acc[0][hh], acc[1][hh]), fmaxf(acc[2][hh], acc[3][hh])));
        float sm = 0.f;
#pragma unroll
        for (int i = 0; i < 4; ++i) { acc[i][hh] = __expf(acc[i][hh] - mx); sm += acc[i][hh]; }
        const float inv = 1.0f / wave_sum(sm);
#pragma unroll
        for (int i = 0; i < 4; ++i) acc[i][hh] *= inv;
    }
#pragma unroll
    for (int i = 0; i < 4; ++i) *(LAS f32x4*)(pq + (lane + 64 * i) * 4) = (f32x4){acc[i][0], acc[i][1], acc[i][2], acc[i][3]};
    asm volatile("s_waitcnt lgkmcnt(0)" ::: "memory");
    float o[4] = {0.f, 0.f, 0.f, 0.f};
    for (int k0 = 0; k0 < 256; k0 += 8) {
        float vv[8]; f32x4 pp[8];
#pragma unroll
        for (int u = 0; u < 8; ++u) { const unsigned rid = rowid[k0 + u];
            const float* vp = ((rid & 0x80000000u) ? vn + (size_t)(rid & 0x7fffffffu) * 256 : cv + (size_t)rid * 256) + g * 64 + lane;
            vv[u] = *vp; pp[u] = *(const LAS f32x4*)(pq + (k0 + u) * 4); }
#pragma unroll
        for (int u = 0; u < 8; ++u)
#pragma unroll
            for (int hh = 0; hh < 4; ++hh) o[hh] += pp[u][hh] * vv[u];
    }
    bf16_t* YA = (bf16_t*)(A.ws + WS_YA);
#pragma unroll
    for (int hh = 0; hh < 4; ++hh) YA[(size_t)m * D + (4 * g + hh) * 64 + lane] = (bf16_t)f2bf(o[hh]);
    asm volatile("s_waitcnt lgkmcnt(0)" ::: "memory");
}

#if MK_CHECK_ATT
constexpr size_t WS_CHK_SC = WS_END, WS_CHK_YA = WS_CHK_SC + 128 * MiB, WS_CHK_MASK = WS_CHK_YA + 33 * MiB, WS_CHK_END = WS_CHK_MASK + 4 * MiB;
constexpr int CW_CHK = 512;
template <bool SAMPLE> struct KVRow;
template <> struct KVRow<false> {
    typedef const bf16_t* ptr;
    const bf16_t* P;
    __device__ __forceinline__ ptr krow(unsigned rid) const { return P + (size_t)rid * NP + PK; }
    __device__ __forceinline__ ptr vrow(unsigned rid) const { return P + (size_t)rid * NP + PV; }
    static __device__ __forceinline__ void k8(ptr p, float (&f)[8]) { unpack8(*(const u32x4*)p, f); }
    static __device__ __forceinline__ f32x4 v4(ptr p) { const u32x2 w = *(const u32x2*)p;
        return (f32x4){__uint_as_float(w.x << 16), __uint_as_float(w.x & 0xffff0000u), __uint_as_float(w.y << 16), __uint_as_float(w.y & 0xffff0000u)}; }
};
template <> struct KVRow<true> {
    typedef const float* ptr;
    const float* ck; const float* cv; const float* kn; const float* vn;
    __device__ __forceinline__ ptr krow(unsigned rid) const { return (rid & 0x80000000u) ? kn + (size_t)(rid & 0x7fffffffu) * 256 : ck + (size_t)rid * 256; }
    __device__ __forceinline__ ptr vrow(unsigned rid) const { return (rid & 0x80000000u) ? vn + (size_t)(rid & 0x7fffffffu) * 256 : cv + (size_t)rid * 256; }
    static __device__ __forceinline__ void k8(ptr p, float (&f)[8]) { const f32x4 a = *(const f32x4*)p, b = *(const f32x4*)(p + 4);
#pragma unroll
        for (int i = 0; i < 4; ++i) { f[i] = a[i]; f[4 + i] = b[i]; } }
    static __device__ __forceinline__ f32x4 v4(ptr p) { return *(const f32x4*)p; }
};

template <bool SAMPLE>
__device__ __forceinline__ void attend_query(const Args& A, LAS unsigned char* wl, const LAS float* biasrel, int m, int lane_in) {
    constexpr int NJ = SAMPLE ? 33 : 32;
    int lane = lane_in; asm volatile("" : "+v"(lane));
    const bf16_t* P = (const bf16_t*)(A.ws + WS_P);
    int b, nvalid, qpos; const float* srow;
    if (!SAMPLE) { b = m >> 11; const int t = m & 2047; nvalid = t + 1; qpos = t; srow = (const float*)(A.ws + WS_CHK_SC) + (size_t)m * SCW; }
    else { const int ms = m - MP; b = ms >> 2; const int t = ms & 3; nvalid = 2049 + t; qpos = 2048 + t; srow = (const float*)(A.ws + WS_SCS) + (size_t)ms * SCSW; }
    LAS float* pq = (LAS float*)wl;
    LAS unsigned* rowid = (LAS unsigned*)(wl + 16384);
    LAS unsigned short* posl = (LAS unsigned short*)(wl + 16384 + 1024);
    unsigned key[NJ];
#pragma unroll
    for (int j = 0; j < NJ; ++j) { key[j] = (lane < nvalid - 64 * j) ? f2key(srow[lane + 64 * j]) : 0u; }
    unsigned T = 0u; int need_eq = 0;
    if (nvalid > 256) {
        for (int bit = 31; bit >= 0; --bit) {
            const unsigned cand = T | (1u << bit); int cnt = 0;
#pragma unroll
            for (int j = 0; j < NJ; ++j) cnt += __popcll(__ballot(key[j] >= cand));
            if (cnt >= 256) T = cand;
        }
        int cgt = 0;
#pragma unroll
        for (int j = 0; j < NJ; ++j) cgt += __popcll(__ballot(key[j] > T));
        need_eq = 256 - cgt;
    }
    int base = 0, eqused = 0; unsigned long long mine_chk = 0ull;
    const int* pt = (const int*)A.in[I_PT];
#pragma unroll
    for (int j = 0; j < NJ; ++j) {
        const bool gt = key[j] > T, eq = (need_eq > 0) && (key[j] == T);
        const unsigned long long meq = __ballot(eq);
        const bool sel = gt || (eq && (eqused + mbcnt64(meq) < need_eq));
        eqused += __popcll(meq);
        const unsigned long long ms = __ballot(sel);
        if (sel) { const int pos = lane + 64 * j, k = base + mbcnt64(ms);
            posl[k] = (unsigned short)pos;
            unsigned rid;
            if (!SAMPLE) rid = (unsigned)(b * 2048 + pos);
            else rid = (pos < 2048) ? (unsigned)(pt[b * 16 + (pos >> 7)] * 128 + (pos & 127)) : (0x80000000u | (unsigned)(b * 4 + pos - 2048));
            rowid[k] = rid; }
        base += __popcll(ms);
        if (!SAMPLE) { if (lane == j) mine_chk = ms; }
    }
    if (!SAMPLE) { if (lane < 32) ((unsigned long long*)(A.ws + WS_CHK_MASK))[(size_t)m * 32 + lane] = mine_chk; }
    const int nsel = base;
    asm volatile("s_waitcnt lgkmcnt(0)" ::: "memory");
    { const unsigned r0 = rowid[0]; const unsigned short p0 = posl[0];
#pragma unroll
      for (int i = 0; i < 4; ++i) { const int k = lane + 64 * i; if (k >= nsel) { rowid[k] = r0; posl[k] = p0; } } }
    { const u32x4 w0 = *(const u32x4*)(P + (size_t)m * NP + PQ + lane * 16), w1 = *(const u32x4*)(P + (size_t)m * NP + PQ + lane * 16 + 8);
      float f0[8], f1[8]; unpack8(w0, f0); unpack8(w1, f1);
#pragma unroll
      for (int e = 0; e < 8; ++e) { pq[lane * 16 + e] = f0[e]; pq[lane * 16 + 8 + e] = f1[e]; } }
    asm volatile("s_waitcnt lgkmcnt(0)" ::: "memory");
    KVRow<SAMPLE> R;
    if constexpr (!SAMPLE) { R.P = P; } else { R.ck = A.in[I_CK]; R.cv = A.in[I_CV]; R.kn = A.out + O_KS; R.vn = A.out + O_VS; }
    typename KVRow<SAMPLE>::ptr kp[4]; int rel[4];
#pragma unroll
    for (int i = 0; i < 4; ++i) { kp[i] = R.krow(rowid[lane + 64 * i]); rel[i] = qpos - (int)posl[lane + 64 * i]; }
    float acc[4][16];
#pragma unroll
    for (int i = 0; i < 4; ++i)
#pragma unroll
        for (int hh = 0; hh < 16; ++hh) acc[i][hh] = 0.f;
#pragma unroll
    for (int g = 0; g < 4; ++g) {
#pragma unroll 1
        for (int dc = 0; dc < 8; ++dc) {
            float kv[4][8];
#pragma unroll
            for (int i = 0; i < 4; ++i) KVRow<SAMPLE>::k8(kp[i] + g * 64 + dc * 8, kv[i]);
#pragma unroll
            for (int hh = 0; hh < 4; ++hh) {
                const f32x4 q0 = *(const LAS f32x4*)(pq + (4 * g + hh) * 64 + dc * 8), q1 = *(const LAS f32x4*)(pq + (4 * g + hh) * 64 + dc * 8 + 4);
#pragma unroll
                for (int i = 0; i < 4; ++i) {
                    float a = acc[i][4 * g + hh];
#pragma unroll
                    for (int e = 0; e < 4; ++e) { a += kv[i][e] * q0[e]; a += kv[i][4 + e] * q1[e]; }
                    acc[i][4 * g + hh] = a; }
            }
        }
    }
    asm volatile("s_waitcnt lgkmcnt(0)" ::: "memory");
#pragma unroll
    for (int i = 0; i < 4; ++i) {
        const bool valid = (lane + 64 * i) < nsel; const int rc = rel[i] < 128 ? (rel[i] < 0 ? 0 : rel[i]) : 128;
#pragma unroll
        for (int h4 = 0; h4 < 4; ++h4) { const f32x4 bv = *(const LAS f32x4*)(biasrel + rc * 16 + 4 * h4);
#pragma unroll
            for (int e = 0; e < 4; ++e) acc[i][4 * h4 + e] = valid ? acc[i][4 * h4 + e] * 0.125f + bv[e] : -INFINITY; }
    }
#pragma unroll
    for (int hh = 0; hh < 16; ++hh) {
        const float mx = wave_max(fmaxf(fmaxf(acc[0][hh], acc[1][hh]), fmaxf(acc[2][hh], acc[3][hh])));
        float s = 0.f;
#pragma unroll
        for (int i = 0; i < 4; ++i) { acc[i][hh] = __expf(acc[i][hh] - mx); s += acc[i][hh]; }
        const float inv = 1.0f / wave_sum(s);
#pragma unroll
        for (int i = 0; i < 4; ++i) acc[i][hh] *= inv;
    }
#pragma unroll
    for (int i = 0; i < 4; ++i)
#pragma unroll
        for (int h4 = 0; h4 < 4; ++h4) *(LAS f32x4*)(pq + (lane + 64 * i) * 16 + 4 * h4) = (f32x4){acc[i][4 * h4], acc[i][4 * h4 + 1], acc[i][4 * h4 + 2], acc[i][4 * h4 + 3]};
    asm volatile("s_waitcnt lgkmcnt(0)" ::: "memory");
    const int g = lane >> 4;
    f32x4 o[4];
#pragma unroll
    for (int hh = 0; hh < 4; ++hh) o[hh] = (f32x4){0.f, 0.f, 0.f, 0.f};
    const int nloop = (nsel + 3) & ~3;
    for (int k0 = 0; k0 < nloop; k0 += 4) {
        f32x4 vv[4], pp[4];
#pragma unroll
        for (int u = 0; u < 4; ++u) { const unsigned r = rowid[k0 + u]; vv[u] = KVRow<SAMPLE>::v4(R.vrow(r) + lane * 4); pp[u] = *(const LAS f32x4*)(pq + (k0 + u) * 16 + 4 * g); }
#pragma unroll
        for (int u = 0; u < 4; ++u)
#pragma unroll
            for (int hh = 0; hh < 4; ++hh) o[hh] += vv[u] * pp[u][hh];
    }
    bf16_t* YA = (bf16_t*)(A.ws + WS_CHK_YA);
#pragma unroll
    for (int hh = 0; hh < 4; ++hh) { u32x2 w; w.x = pk2(o[hh][0], o[hh][1]); w.y = pk2(o[hh][2], o[hh][3]);
        *(u32x2*)(YA + (size_t)m * D + (4 * g + hh) * 64 + (lane & 15) * 4) = w; }
    asm volatile("s_waitcnt lgkmcnt(0)" ::: "memory");
}


__device__ __forceinline__ void check_compare(const Args& A, int gw, int NGW, int lane) {
    const bf16_t* Y1 = (const bf16_t*)(A.ws + WS_YA); const bf16_t* Y2 = (const bf16_t*)(A.ws + WS_CHK_YA); unsigned* ctl = (unsigned*)(A.ws + WS_CTL);
    for (int m = gw; m < MP; m += NGW) {
        float e = 0.f, n = 0.f;
#pragma unroll
        for (int j = 0; j < 2; ++j) { float a[8], b[8]; unpack8(*(const u32x4*)(Y1 + (size_t)m * D + j * 512 + lane * 8), a); unpack8(*(const u32x4*)(Y2 + (size_t)m * D + j * 512 + lane * 8), b);
#pragma unroll
            for (int i = 0; i < 8; ++i) { const float d = a[i] - b[i]; e += d * d; n += b[i] * b[i]; } }
        e = wave_sum(e); n = wave_sum(n);
        { const unsigned long long w1 = (lane < 32) ? ((const unsigned long long*)(A.ws + WS_SC))[(size_t)m * 32 + lane] : 0ull, w2 = (lane < 32) ? ((const unsigned long long*)(A.ws + WS_CHK_MASK))[(size_t)m * 32 + lane] : 0ull;
          if (__any(w1 != w2) && lane == 0) atomicAdd(ctl + CW_CHK + 3, 1u);
          const int t = m & 2047;
          if (t >= 256) {
              const float* srow = (const float*)(A.ws + WS_CHK_SC) + (size_t)m * SCW;
              int c1 = 0, c2 = 0; float mins1 = INFINITY, maxu1 = -INFINITY, mins2 = INFINITY, maxu2 = -INFINITY;
              for (int j = 0; j < 32; ++j) { const int sp = lane + 64 * j; if (64 * j > t) break;
                  const unsigned long long a1 = __shfl((unsigned long long)w1, j), a2 = __shfl((unsigned long long)w2, j);
                  if (sp <= t) { const float v = srow[sp]; const bool s1 = (a1 >> lane) & 1ull, s2 = (a2 >> lane) & 1ull;
                      if (s1) { ++c1; mins1 = fminf(mins1, v); } else maxu1 = fmaxf(maxu1, v);
                      if (s2) { ++c2; mins2 = fminf(mins2, v); } else maxu2 = fmaxf(maxu2, v); } }
              c1 = (int)wave_sum((float)c1); c2 = (int)wave_sum((float)c2);
              mins1 = -wave_max(-mins1); mins2 = -wave_max(-mins2); maxu1 = wave_max(maxu1); maxu2 = wave_max(maxu2);
              if (lane == 0) { if (c1 != 256 || mins1 < maxu1) atomicAdd(ctl + CW_CHK + 4, 1u); if (c2 != 256 || mins2 < maxu2) atomicAdd(ctl + CW_CHK + 5, 1u); }
          } }
        if (lane == 0 && !(e <= MK_CHECK_TOL * MK_CHECK_TOL * n + 1e-12f)) { const int t = m & 2047; atomicAdd(ctl + CW_CHK + (t < 64 ? 0 : t < 256 ? 1 : 2), 1u); }
    }
}
#endif
__device__ __forceinline__ void gate_norm_phase(const Args& A, int gw, int NGW, int lane) {
    const bf16_t* P = (const bf16_t*)(A.ws + WS_P); bf16_t* Y = (bf16_t*)(A.ws + WS_Y); const float* ng = A.in[I_NORMG];
    for (int it = gw; it < M * 4; it += NGW) {
        const int m = it >> 2, ch = (it & 3) * 512 + lane * 8;
        float y[8], z[8]; unpack8(*(const u32x4*)(Y + (size_t)m * DI + ch), y); unpack8(*(const u32x4*)(P + (size_t)m * NP + PZ + ch), z);
        float ss = 0.f;
#pragma unroll
        for (int i = 0; i < 8; ++i) { y[i] *= siluf_(z[i]); ss += y[i] * y[i]; }
        const float r = 1.0f / sqrtf(wave_sum(ss) * (1.f / 512.f) + LN_EPS);
        const f32x4 g0 = *(const f32x4*)(ng + ch), g1 = *(const f32x4*)(ng + ch + 4);
#pragma unroll
        for (int i = 0; i < 4; ++i) { y[i] = y[i] * r * g0[i]; y[4 + i] = y[4 + i] * r * g1[i]; }
        *(u32x4*)(Y + (size_t)m * DI + ch) = pack8(y);
    }
}

constexpr int NPHASE = 14;
__global__ void __launch_bounds__(NTHR, 2) fwd(Args args) {
    extern __shared__ __attribute__((aligned(16))) unsigned char lds_raw[];
    LAS unsigned char* lds = (LAS unsigned char*)lds_raw;
    const int tid = threadIdx.x, lane = tid & 63, wave = __builtin_amdgcn_readfirstlane(tid >> 6);
    const int G = gridDim.x, bx = blockIdx.x;
    const int vcu = (G % 8 == 0) ? (bx % 8) * (G / 8) + bx / 8 : bx;
    const int gw = vcu * NWAVES + wave, NGW = G * NWAVES;
    unsigned char* ws = args.ws;
    volatile LAS unsigned* MISC = (volatile LAS unsigned*)(lds + MISC_OFF);
    for (int u = tid; u < 64; u += NTHR) MISC[u] = 0u;
    __syncthreads();
    const int lo = args.ph_lo, hi = args.ph_hi;
    XcdBarrier bar; bar.bar = (unsigned*)(ws + WS_CTL) + CW_BAR; bar.x = 0; bar.st = nullptr;
    if (hi - lo > 1) bar = xcd_barrier_post((unsigned*)(ws + WS_CTL) + CW_BAR, MISC + 8);
#define IN(k) (lo <= (k) && (k) < hi)
#define SEAM(k) do { if (IN(k) && IN((k) + 1)) xcd_barrier(bar); } while (0)

    bf16_t* const XB = (bf16_t*)(ws + WS_XB); bf16_t* const ACT = (bf16_t*)(ws + WS_ACT); float* const T = (float*)(ws + WS_T);
    float* const HF = (float*)(ws + WS_HF); bf16_t* const HB = (bf16_t*)(ws + WS_HB); bf16_t* const P = (bf16_t*)(ws + WS_P);
    float* const SMF = (float*)(ws + WS_SMF); bf16_t* const Y = (bf16_t*)(ws + WS_Y); bf16_t* const YA = (bf16_t*)(ws + WS_YA); bf16_t* const MG = (bf16_t*)(ws + WS_MG);

    if (IN(0)) REPK(0) { p0_prologue(args, lds, gw, NGW, wave, lane); }
    SEAM(0);
    if (IN(1)) {
        { pg8::Gemm g{XB, (const bf16_t*)(ws + WS_W1A), M, 2 * DFF, D}; pg8::StaticOrder S; S.init(M, 2 * DFF, G, bx);
        EpiSwiglu E{ACT}; pg8::gemm_phase<EpiSwiglu, pg8::StaticOrder, true, true>(lds, g, S, E); }
        if constexpr (DUPK(1)) { pg8::Gemm g{XB, (const bf16_t*)(ws + WS_W1A), M, 2 * DFF, D}; pg8::StaticOrder S; S.init(M, 2 * DFF, G, bx);
        EpiSwiglu E{ACT}; pg8::gemm_phase<EpiSwiglu, pg8::StaticOrder, true, true>(lds, g, S, E); }
    }
    SEAM(1);
    if (IN(2)) {
        { pg8::Gemm g{ACT, (const bf16_t*)(ws + WS_W1B), MP, D, DFF}; pg8::StaticOrder S; S.init(MP, D, G, bx);
        EpiResid E{args.in[I_XP], args.in[I_XS], T, ALPHA, 0.5f}; pg8::gemm_phase<EpiResid, pg8::StaticOrder, true, true>(lds, g, S, E); }
        { SkResid E{args.in[I_XS], T, ALPHA, 0.5f}; skinny_gemm<DFF>(lds, ACT + (size_t)MP * DFF, (const bf16_t*)(ws + WS_W1B), E, bx, G, wave, lane); }
        if constexpr (DUPK(2)) { pg8::Gemm g{ACT, (const bf16_t*)(ws + WS_W1B), MP, D, DFF}; pg8::StaticOrder S; S.init(MP, D, G, bx);
        EpiResid E{args.in[I_XP], args.in[I_XS], T, ALPHA, 0.5f}; pg8::gemm_phase<EpiResid, pg8::StaticOrder, true, true>(lds, g, S, E); }
    }
    SEAM(2);
    if (IN(3)) REPK(3) { ln_phase(T, args.in[I_LN1G], args.in[I_LN1B], HF, HB, gw, NGW, lane); }
    SEAM(3);
    if (IN(4)) {
        { pg8::Gemm g{HB, (const bf16_t*)(ws + WS_WIN), M, NP, D}; pg8::StaticOrder S; S.init(M, NP, G, bx);
        EpiWin E{P, SMF, args.out}; pg8::gemm_phase<EpiWin, pg8::StaticOrder, true, true>(lds, g, S, E); }
        if constexpr (DUPK(4)) { pg8::Gemm g{HB, (const bf16_t*)(ws + WS_WIN), M, NP, D}; pg8::StaticOrder S; S.init(M, NP, G, bx);
        EpiWin E{P, SMF, args.out}; pg8::gemm_phase<EpiWin, pg8::StaticOrder, true, true>(lds, g, S, E); }
    }
    SEAM(4);
    if (IN(5)) REPK(5) {
        for (int rep = 0; rep < MK_REP_CONV; ++rep)
        conv_phase(args, gw, NGW, lane);
        for (int rep = 0; rep < MK_REP_SCP; ++rep)
        for (int u = bx; u < 1024; u += G) { const int i = u >> 8, c = u & 255, b = c >> 5, s = c & 31; const int qt = (i == 0) ? s : (i == 1) ? 63 - s : (i == 2) ? 64 + s : 127 - s;
            scores_select_prompt_unit(args, lds, b, qt, wave, lane); }
        for (int rep = 0; rep < MK_REP_SCS; ++rep)
        for (int u = bx; u < 256; u += G) scores_sample_unit(args, u >> 1, u & 1, wave, lane);
    }
    SEAM(5);
    if (IN(6)) {
        for (int rep = 0; rep < MK_REP_SSDP; ++rep)
        for (int it = bx; it < 256; it += G) ssd_prompt_item(args, lds, it >> 5, it & 31);
        __syncthreads();
        LAS float* biasrel = (LAS float*)(lds + BIASREL_OFF); LAS float* biasL = biasrel + 129 * 16;
        for (int i = tid; i < 129 * 16; i += NTHR) { const int rel = i >> 4, h = i & 15; const float bv = args.in[I_BIAS][t5_bucket(rel) * 16 + h]; biasrel[i] = bv; biasL[i] = bv * LOG2E; }
        __syncthreads();
        for (int rep = 0; rep < MK_REP_ATTP; ++rep)
        for (int u = bx; u < 1024; u += G) { const int i = u >> 8, c = u & 255, bg = c >> 3, s8 = c & 7; const int qt = (i == 0) ? s8 : (i == 1) ? 15 - s8 : (i == 2) ? 16 + s8 : 31 - s8;
            attn_prompt_unit(args, lds, biasL, bg >> 2, bg & 3, qt, wave, lane); }
        __syncthreads();
        LAS unsigned char* wl = lds + wave * WAREA;
        for (int rep = 0; rep < MK_REP_SSDS; ++rep)
        for (int it = gw; it < 4096; it += NGW) ssd_sample_item(args, wl, it >> 5, it & 31, lane);
        for (int rep = 0; rep < MK_REP_ATTS; ++rep)
        for (int q = gw; q < MS * 4; q += NGW) attend_sample_task(args, wl, biasrel, q >> 2, q & 3, lane);
#if MK_CHECK_ATT
        for (int q = gw; q < MP; q += NGW) attend_query<false>(args, wl, biasrel, q, lane);
#endif
        __syncthreads();
    }
    SEAM(6);
    if (IN(7)) {
        gate_norm_phase(args, gw, NGW, lane);
#if MK_CHECK_ATT
        check_compare(args, gw, NGW, lane);
#endif
        { pg8::Gemm g{YA, (const bf16_t*)(ws + WS_WBA), MP, D, D}; pg8::StaticOrder S; S.init(MP, D, G, bx);
        EpiGateA E{P, PG + D, T}; pg8::gemm_phase<EpiGateA, pg8::StaticOrder, true, true>(lds, g, S, E); }
        { SkGateA E{P, PG + D, T}; skinny_gemm<D>(lds, YA + (size_t)MP * D, (const bf16_t*)(ws + WS_WBA), E, bx, G, wave, lane); }
        if constexpr (DUPK(7)) { pg8::Gemm g{YA, (const bf16_t*)(ws + WS_WBA), MP, D, D}; pg8::StaticOrder S; S.init(MP, D, G, bx);
        EpiGateA E{P, PG + D, T}; pg8::gemm_phase<EpiGateA, pg8::StaticOrder, true, true>(lds, g, S, E); }
    }
    SEAM(7);
    if (IN(8)) {
        { pg8::Gemm g{Y, (const bf16_t*)(ws + WS_WBS), MP, D, DI}; pg8::StaticOrder S; S.init(MP, D, G, bx);
        EpiGateS E{P, PG, T, MG}; pg8::gemm_phase<EpiGateS, pg8::StaticOrder, true, true>(lds, g, S, E); }
        { SkGateS E{P, PG, T, MG}; skinny_gemm<DI>(lds, Y + (size_t)MP * DI, (const bf16_t*)(ws + WS_WBS), E, bx, G, wave, lane); }
        if constexpr (DUPK(8)) { pg8::Gemm g{Y, (const bf16_t*)(ws + WS_WBS), MP, D, DI}; pg8::StaticOrder S; S.init(MP, D, G, bx);
        EpiGateS E{P, PG, T, MG}; pg8::gemm_phase<EpiGateS, pg8::StaticOrder, true, true>(lds, g, S, E); }
    }
    SEAM(8);
    if (IN(9)) {
        { pg8::Gemm g{MG, (const bf16_t*)(ws + WS_WOUT), MP, D, D}; pg8::StaticOrder S; S.init(MP, D, G, bx);
        EpiResid E{HF, HF + (size_t)MP * D, T, ALPHA, 1.0f}; pg8::gemm_phase<EpiResid, pg8::StaticOrder, true, true>(lds, g, S, E); }
        { SkResid E{HF + (size_t)MP * D, T, ALPHA, 1.0f}; skinny_gemm<D>(lds, MG + (size_t)MP * D, (const bf16_t*)(ws + WS_WOUT), E, bx, G, wave, lane); }
        if constexpr (DUPK(9)) { pg8::Gemm g{MG, (const bf16_t*)(ws + WS_WOUT), MP, D, D}; pg8::StaticOrder S; S.init(MP, D, G, bx);
        EpiResid E{HF, HF + (size_t)MP * D, T, ALPHA, 1.0f}; pg8::gemm_phase<EpiResid, pg8::StaticOrder, true, true>(lds, g, S, E); }
    }
    SEAM(9);
    if (IN(10)) REPK(10) { ln_phase(T, args.in[I_LN2G], args.in[I_LN2B], HF, HB, gw, NGW, lane); }
    SEAM(10);
    if (IN(11)) {
        { pg8::Gemm g{HB, (const bf16_t*)(ws + WS_W2A), M, 2 * DFF, D}; pg8::StaticOrder S; S.init(M, 2 * DFF, G, bx);
        EpiSwiglu E{ACT}; pg8::gemm_phase<EpiSwiglu, pg8::StaticOrder, true, true>(lds, g, S, E); }
        if constexpr (DUPK(11)) { pg8::Gemm g{HB, (const bf16_t*)(ws + WS_W2A), M, 2 * DFF, D}; pg8::StaticOrder S; S.init(M, 2 * DFF, G, bx);
        EpiSwiglu E{ACT}; pg8::gemm_phase<EpiSwiglu, pg8::StaticOrder, true, true>(lds, g, S, E); }
    }
    SEAM(11);
    if (IN(12)) {
        { pg8::Gemm g{ACT, (const bf16_t*)(ws + WS_W2B), MP, D, DFF}; pg8::StaticOrder S; S.init(MP, D, G, bx);
        EpiResid E{HF, HF + (size_t)MP * D, T, ALPHA, 0.5f}; pg8::gemm_phase<EpiResid, pg8::StaticOrder, true, true>(lds, g, S, E); }
        { SkResid E{HF + (size_t)MP * D, T, ALPHA, 0.5f}; skinny_gemm<DFF>(lds, ACT + (size_t)MP * DFF, (const bf16_t*)(ws + WS_W2B), E, bx, G, wave, lane); }
        if constexpr (DUPK(12)) { pg8::Gemm g{ACT, (const bf16_t*)(ws + WS_W2B), MP, D, DFF}; pg8::StaticOrder S; S.init(MP, D, G, bx);
        EpiResid E{HF, HF + (size_t)MP * D, T, ALPHA, 0.5f}; pg8::gemm_phase<EpiResid, pg8::StaticOrder, true, true>(lds, g, S, E); }
    }
    SEAM(12);
    if (IN(13)) REPK(13) { ln_phase(T, args.in[I_LN3G], args.in[I_LN3B], args.out + O_Y, nullptr, gw, NGW, lane); }
#if MK_CHECK_ATT
    if (IN(13)) { __syncthreads(); unsigned* cw = (unsigned*)(ws + WS_CTL) + CW_CHK;
        const unsigned b0 = __hip_atomic_load(cw, __ATOMIC_RELAXED, __HIP_MEMORY_SCOPE_AGENT), b1 = __hip_atomic_load(cw + 1, __ATOMIC_RELAXED, __HIP_MEMORY_SCOPE_AGENT), b2 = __hip_atomic_load(cw + 2, __ATOMIC_RELAXED, __HIP_MEMORY_SCOPE_AGENT), b3 = __hip_atomic_load(cw + 3, __ATOMIC_RELAXED, __HIP_MEMORY_SCOPE_AGENT), b4 = __hip_atomic_load(cw + 4, __ATOMIC_RELAXED, __HIP_MEMORY_SCOPE_AGENT), b5 = __hip_atomic_load(cw + 5, __ATOMIC_RELAXED, __HIP_MEMORY_SCOPE_AGENT);
        const float code = MK_CHECK_CODE;
        if (code > 0.f && bx == 0 && tid == 0) args.out[O_Y] = 4096.0f * sqrtf(code); }
#endif
#undef IN
#undef SEAM
}
}

extern "C" void kernel_launch(void* const* d_in, const int* in_sizes, int n_in, void* d_out, int out_size, void* d_ws, size_t ws_size, hipStream_t stream) {
    using namespace mk;
    static int grid = 0;
    if (grid == 0) {
        if (n_in != 29 || (size_t)out_size != O_END || ws_size < WS_END) { fprintf(stderr, "kernel_launch: unexpected shapes (n_in %d, out %d, ws %zu)\n", n_in, out_size, ws_size); grid = -1; return; }
        int dev = 0, cus = 0, per_cu = 0;
        if (hipGetDevice(&dev) != hipSuccess || hipDeviceGetAttribute(&cus, hipDeviceAttributeMultiprocessorCount, dev) != hipSuccess) { grid = -1; return; }
        if (hipFuncSetAttribute((const void*)fwd, hipFuncAttributeMaxDynamicSharedMemorySize, LDS_BYTES) != hipSuccess) { fprintf(stderr, "kernel_launch: hipFuncSetAttribute failed\n"); grid = -1; return; }
        if (hipOccupancyMaxActiveBlocksPerMultiprocessor(&per_cu, (const void*)fwd, NTHR, LDS_BYTES) != hipSuccess || per_cu < 1) fprintf(stderr, "kernel_launch: occupancy query says %d\n", per_cu);
        (void)hipGetLastError();
        grid = cus;
    }
    if (grid < 0) return;
    (void)hipMemsetAsync((char*)d_ws + WS_CTL, 0, CTL_ZERO_BYTES, stream);
    Args a{};
    for (int i = 0; i < 29; ++i) a.in[i] = (const float*)d_in[i];
    a.out = (float*)d_out; a.ws = (unsigned char*)d_ws;
#if MK_SPLIT
    for (int p = 0; p < NPHASE; ++p) { a.ph_lo = p; a.ph_hi = p + 1; hipLaunchKernelGGL(fwd, dim3(grid), dim3(NTHR), LDS_BYTES, stream, a); }
#else
    a.ph_lo = 0; a.ph_hi = NPHASE; hipLaunchKernelGGL(fwd, dim3(grid), dim3(NTHR), LDS_BYTES, stream, a);
#endif
}
```

```cpp
#include <hip/hip_runtime.h>
#include <cstdio>
#include <cstdint>
#define GAS __attribute__((address_space(1)))
#define LAS __attribute__((address_space(3)))
namespace pg8 {
#define PG8_LAS __attribute__((address_space(3)))
typedef unsigned short bf16_t;
typedef short bf16x8 __attribute__((ext_vector_type(8)));
typedef float f32x4 __attribute__((ext_vector_type(4)));
typedef unsigned u32x4 __attribute__((ext_vector_type(4)));
constexpr int BM = 256, BK = 64, HALF = 128, HTB = HALF * BK * 2  , STAGE_BYTES = 8 * HTB, NXCD = 8, WGM = 8;

__host__ __device__ __forceinline__ int lds_byte(int r, int c) { const int st = (r >> 4) * 2 + (c >> 5), rr = r & 15, cc = c & 31, ob = rr * 64 + cc * 2; return st * 1024 + (ob ^ (((ob >> 9) & 1) << 5)); }
__host__ __device__ __forceinline__ void stage_rc(int b, int& R, int& C) { const int st = b / 1024, sb = b % 1024, swz = sb ^ (((sb >> 9) & 1) << 5); R = (st >> 1) * 16 + swz / 64; C = (st & 1) * 32 + (swz % 64) / 2; }
__host__ __device__ __forceinline__ int perm32(int rho) { const int n = rho >> 4, i = rho & 15; return 8 * (i >> 2) + 4 * n + (i & 3); }

struct Unit { int pm, pn; };
struct Gemm { const bf16_t* A; const bf16_t* Bt; int M, N, K; };

struct StaticOrder {
    int nM, nN, nwg, G, c;
    __host__ __device__ void init(int M, int N, int G_, int c_) { nM = M / BM; nN = N / BM; nwg = nM * nN; G = G_; c = c_; }
    __host__ __device__ bool next(int i, Unit& u) const {
        const long L = (long)i * G + c; if (L >= nwg) return false;
        int wgid = (int)L; { const int q = nwg / NXCD, r = nwg % NXCD, xcd = wgid % NXCD, off = wgid / NXCD; wgid = (xcd < r ? xcd * (q + 1) : r * (q + 1) + (xcd - r) * q) + off; }
        const int nig = WGM * nN, gid = wgid / nig, fm = gid * WGM, gsz = (nM - fm) < WGM ? (nM - fm) : WGM;
        u.pm = fm + ((wgid % nig) % gsz); u.pn = (wgid % nig) / gsz; return true;
    }
    __device__ __forceinline__ void a_ready(const Unit&) const {}
    __device__ __forceinline__ void done(const Unit&) const {}
};

__device__ __forceinline__ unsigned cvt_pk_bf16(float lo, float hi) { unsigned r; asm volatile("v_cvt_pk_bf16_f32 %0, %1, %2" : "=v"(r) : "v"(lo), "v"(hi)); return r; }

template <class Epi, class Sched, bool ALIGN_EPI = false, bool SP2 = false>
__device__ __forceinline__ void gemm_phase(PG8_LAS unsigned char* lds, const Gemm g, const Sched& S, const Epi& E) {
    const int tid = threadIdx.x, wid = __builtin_amdgcn_readfirstlane(tid >> 6), lane = tid & 63, wr = wid >> 2, wc = wid & 3, fr = lane & 15, fq = lane >> 4;
    const int K = g.K, nt = K / BK;
    unsigned voffA[2], voffB[2];
#pragma unroll
    for (int i = 0; i < 2; ++i) { int R, C; stage_rc(tid * 16 + i * 8192, R, C); const int Rb = Epi::PERM ? ((R & ~31) + perm32(R & 31)) : R;
        voffA[i] = (unsigned)(R * K + C) * 2u; voffB[i] = (unsigned)(Rb * K + C) * 2u; }
    const size_t kstep = (size_t)(BK * 2);
    const size_t hstep = (size_t)HALF * K * 2;
    const size_t tstep = 2 * hstep;
    const unsigned ldsw = (unsigned)wid * 1024u;
    const int aoff = lds_byte(wr * 64 + fr, fq * 8), boff = lds_byte(wc * 32 + fr, fq * 8);
#define PG8_SA(b, h) (((b) * 2 + (h)) * HTB)
#define PG8_SB(b, h) ((4 + (b) * 2 + (h)) * HTB)
#define PG8_STAGE(bufoff, gbase, voff) do { _Pragma("unroll") for (int _i = 0; _i < 2; ++_i) \
        __builtin_amdgcn_global_load_lds((const unsigned*)((const char*)(gbase) + (voff)[_i]), (PG8_LAS unsigned*)(lds + (bufoff) + ldsw + _i * 8192), 16, 0, 0); } while (0)
#define PG8_LDA(dst, b, h) do { _Pragma("unroll") for (int m = 0; m < 4; ++m) _Pragma("unroll") for (int k = 0; k < 2; ++k) dst[m][k] = *(const PG8_LAS bf16x8*)(lds + PG8_SA(b, h) + aoff + m * 2048 + k * 1024); } while (0)
#define PG8_LDB(dst, b, h) do { _Pragma("unroll") for (int n = 0; n < 2; ++n) _Pragma("unroll") for (int k = 0; k < 2; ++k) dst[n][k] = *(const PG8_LAS bf16x8*)(lds + PG8_SB(b, h) + boff + n * 2048 + k * 1024); } while (0)
#define PG8_MMA(ai, bj, At, Bt) do { __builtin_amdgcn_s_setprio(1); _Pragma("unroll") for (int m = 0; m < 4; ++m) _Pragma("unroll") for (int n = 0; n < 2; ++n) _Pragma("unroll") for (int k = 0; k < 2; ++k) \
        acc[ai][bj][m][n] = __builtin_amdgcn_mfma_f32_16x16x32_bf16(Bt[n][k], At[m][k], acc[ai][bj][m][n], 0, 0, 0); __builtin_amdgcn_s_setprio(0); } while (0)
#define PG8_WAIT_V(n) asm volatile("s_waitcnt vmcnt(" #n ")" ::: "memory")
#define PG8_WAIT_L(n) asm volatile("s_waitcnt lgkmcnt(" #n ")" ::: "memory")
#define PG8_BAR __builtin_amdgcn_s_barrier()
#define PG8_SCHED __builtin_amdgcn_sched_barrier(0)
    Unit cur, nxt; int ui = 0;
    if (!S.next(0, cur)) return;
    f32x4 acc[2][2][4][2];
#pragma unroll
    for (int a = 0; a < 2; ++a)
#pragma unroll
        for (int b = 0; b < 2; ++b)
#pragma unroll
            for (int m = 0; m < 4; ++m)
#pragma unroll
                for (int n = 0; n < 2; ++n) acc[a][b][m][n] = (f32x4){0.f, 0.f, 0.f, 0.f};
    bf16x8 At[4][2], B0[2][2], B1[2][2];
    const char* cA = (const char*)g.A + (size_t)cur.pm * tstep; const char* cB = (const char*)g.Bt + (size_t)cur.pn * tstep;
    S.a_ready(cur);
    if constexpr (SP2) {
        PG8_STAGE(PG8_SB(0, 0), cB, voffB); PG8_STAGE(PG8_SB(0, 1), cB + hstep, voffB); PG8_STAGE(PG8_SA(0, 0), cA, voffA); PG8_STAGE(PG8_SA(0, 1), cA + hstep, voffA);
        if (wr == 1) PG8_BAR;
        PG8_WAIT_V(2); PG8_BAR;
        PG8_STAGE(PG8_SB(1, 0), cB + kstep, voffB); PG8_STAGE(PG8_SA(1, 0), cA + kstep, voffA); PG8_STAGE(PG8_SB(1, 1), cB + hstep + kstep, voffB);
        PG8_WAIT_V(6); PG8_BAR;
    } else {
        PG8_STAGE(PG8_SB(0, 0), cB, voffB); PG8_STAGE(PG8_SA(0, 0), cA, voffA); PG8_STAGE(PG8_SB(0, 1), cB + hstep, voffB); PG8_STAGE(PG8_SA(0, 1), cA + hstep, voffA);
        if (wr == 1) PG8_BAR;
        PG8_WAIT_V(4); PG8_BAR;
        PG8_STAGE(PG8_SB(1, 0), cB + kstep, voffB); PG8_STAGE(PG8_SA(1, 0), cA + kstep, voffA); PG8_STAGE(PG8_SB(1, 1), cB + hstep + kstep, voffB);
        PG8_WAIT_V(6); PG8_BAR;
    }
    for (;;) {
        const bool has_next = S.next(ui + 1, nxt);
        const char* nA = has_next ? (const char*)g.A + (size_t)nxt.pm * tstep : cA; const char* nB = has_next ? (const char*)g.Bt + (size_t)nxt.pn * tstep : cB;
        for (int t = 0; t < nt; t += 2) {
            const bool last = (t == nt - 2);
            const char* a1 = cA + (size_t)(t + 1) * kstep;
            const char* a2 = last ? nA : cA + (size_t)(t + 2) * kstep; const char* b2 = last ? nB : cB + (size_t)(t + 2) * kstep;
            const char* a3 = a2 + kstep; const char* b3 = b2 + kstep;
            if (last && has_next) S.a_ready(nxt);
            if constexpr (SP2) {
            PG8_LDB(B0, 0, 0); PG8_LDB(B1, 0, 1); PG8_SCHED; PG8_LDA(At, 0, 0); PG8_STAGE(PG8_SA(1, 1), a1 + hstep, voffA);
            PG8_WAIT_V(8); PG8_WAIT_L(0); PG8_BAR; PG8_MMA(0, 0, At, B0); PG8_MMA(0, 1, At, B1); PG8_BAR; PG8_SCHED;
            PG8_LDA(At, 0, 1); PG8_STAGE(PG8_SB(0, 0), b2, voffB); PG8_STAGE(PG8_SB(0, 1), b2 + hstep, voffB); PG8_STAGE(PG8_SA(0, 0), a2, voffA);
            PG8_WAIT_V(8); PG8_WAIT_L(0); PG8_BAR; PG8_MMA(1, 0, At, B0); PG8_MMA(1, 1, At, B1); PG8_BAR; PG8_SCHED;
            PG8_LDB(B0, 1, 0); PG8_LDB(B1, 1, 1); PG8_SCHED; PG8_LDA(At, 1, 0); PG8_STAGE(PG8_SA(0, 1), a2 + hstep, voffA);
            PG8_WAIT_V(8); PG8_WAIT_L(0); PG8_BAR; PG8_MMA(0, 0, At, B0); PG8_MMA(0, 1, At, B1); PG8_BAR; PG8_SCHED;
            PG8_LDA(At, 1, 1); PG8_STAGE(PG8_SB(1, 0), b3, voffB); PG8_STAGE(PG8_SB(1, 1), b3 + hstep, voffB); PG8_STAGE(PG8_SA(1, 0), a3, voffA);
            PG8_WAIT_V(8); PG8_WAIT_L(0); PG8_BAR; PG8_MMA(1, 0, At, B0); PG8_MMA(1, 1, At, B1); PG8_BAR; PG8_SCHED;
            } else {
            PG8_LDB(B0, 0, 0); PG8_SCHED; PG8_LDA(At, 0, 0); PG8_STAGE(PG8_SA(1, 1), a1 + hstep, voffA);
            PG8_WAIT_L(8); PG8_BAR; PG8_WAIT_L(0); PG8_MMA(0, 0, At, B0); PG8_BAR; PG8_SCHED;
            PG8_LDB(B1, 0, 1); PG8_STAGE(PG8_SB(0, 0), b2, voffB);
            PG8_BAR; PG8_WAIT_L(0); PG8_MMA(0, 1, At, B1); PG8_BAR;
            PG8_LDA(At, 0, 1); PG8_STAGE(PG8_SA(0, 0), a2, voffA);
            PG8_BAR; PG8_WAIT_L(0); PG8_MMA(1, 0, At, B0); PG8_BAR; PG8_SCHED;
            PG8_STAGE(PG8_SB(0, 1), b2 + hstep, voffB);
            PG8_WAIT_V(6); PG8_BAR; PG8_MMA(1, 1, At, B1); PG8_BAR;
            PG8_LDB(B0, 1, 0); PG8_SCHED; PG8_LDA(At, 1, 0); PG8_STAGE(PG8_SA(0, 1), a2 + hstep, voffA);
            PG8_WAIT_L(8); PG8_BAR; PG8_WAIT_L(0); PG8_MMA(0, 0, At, B0); PG8_BAR; PG8_SCHED;
            PG8_LDB(B1, 1, 1); PG8_STAGE(PG8_SB(1, 0), b3, voffB);
            PG8_BAR; PG8_WAIT_L(0); PG8_MMA(0, 1, At, B1); PG8_BAR;
            PG8_LDA(At, 1, 1); PG8_STAGE(PG8_SA(1, 0), a3, voffA);
            PG8_BAR; PG8_WAIT_L(0); PG8_MMA(1, 0, At, B0); PG8_BAR; PG8_SCHED;
            PG8_STAGE(PG8_SB(1, 1), b3 + hstep, voffB);
            PG8_WAIT_V(6); PG8_BAR; PG8_MMA(1, 1, At, B1); PG8_BAR;
            }
        }
        if constexpr (ALIGN_EPI) { if (wr == 0) PG8_BAR; }
        if constexpr (!Epi::AFTER_DRAIN) { E(acc, cur, wr, wc, fr, fq); S.done(cur); }
        if (!has_next) break;
#pragma unroll
        for (int a = 0; a < 2; ++a)
#pragma unroll
            for (int b = 0; b < 2; ++b)
#pragma unroll
                for (int m = 0; m < 4; ++m)
#pragma unroll
                    for (int n = 0; n < 2; ++n) acc[a][b][m][n] = (f32x4){0.f, 0.f, 0.f, 0.f};
        cur = nxt; cA = nA; cB = nB; ++ui;
        if constexpr (ALIGN_EPI) { if (wr == 1) PG8_BAR; }
    }
    PG8_WAIT_V(0);
    if constexpr (!ALIGN_EPI) { if (wr == 0) PG8_BAR; }
    PG8_BAR;
    if constexpr (Epi::AFTER_DRAIN) { E.fused(acc, cur, wr, wc, fr, fq, lds, wid, lane); S.done(cur); }
#undef PG8_SA
#undef PG8_SB
#undef PG8_STAGE
#undef PG8_LDA
#undef PG8_LDB
#undef PG8_MMA
#undef PG8_WAIT_V
#undef PG8_WAIT_L
#undef PG8_BAR
#undef PG8_SCHED
}
}
#define XB_TMO      128
#define XB_XCNT(j)  (256  + 64 * (j))
#define XB_XSUB(j)  (1280 + 64 * (j))
#define XB_XGEN(j)  (2304 + 64 * (j))
#define XB_TOP      3328
#define XB_TOPGEN   3392
#define XCD_BAR_WORDS 3456
#define XB_SPIN_CAP (1u << 18)

__device__ __forceinline__ unsigned xb_ld(unsigned* p)              { return __hip_atomic_load(p, __ATOMIC_RELAXED, __HIP_MEMORY_SCOPE_AGENT); }
__device__ __forceinline__ unsigned xb_add(unsigned* p, unsigned v) { return __hip_atomic_fetch_add(p, v, __ATOMIC_RELAXED, __HIP_MEMORY_SCOPE_AGENT); }
__device__ __forceinline__ unsigned xb_xcc_id() { return (unsigned)__builtin_amdgcn_s_getreg((3 << 11) | 20) & 0xFu; }
#define XB_SPIN(cond, bar) do { unsigned _sp = 0; while (cond) { __builtin_amdgcn_s_sleep(1); \
    if ((++_sp & 255u) == 0u) { if (xb_ld(&(bar)[XB_TMO])) break; if (_sp > XB_SPIN_CAP) { atomicAdd(&(bar)[XB_TMO], 1u); break; } } } } while (0)

struct XcdBarrier {
    unsigned* bar; unsigned x;
    volatile LAS unsigned* st;
};

__device__ __forceinline__ XcdBarrier xcd_barrier_post(unsigned* bar, volatile LAS unsigned* st) {
    XcdBarrier b; b.bar = bar; b.x = xb_xcc_id(); b.st = st;
    if (threadIdx.x == 0) (void)xb_add(&bar[XB_XCNT(b.x)], 1u);
    return b;
}
__device__ __forceinline__ void xcd_barrier_complete(unsigned* bar, unsigned x, unsigned& nloc, unsigned& nx) {
    const unsigned G = gridDim.x * gridDim.y * gridDim.z;
    unsigned sum, cnt, mine, sp = 0u;
    for (;;) {
        sum = 0u; cnt = 0u; mine = 0u;
#pragma unroll
        for (unsigned j = 0; j < 16; ++j) { const unsigned c = xb_ld(&bar[XB_XCNT(j)]); sum += c; cnt += (c > 0u) ? 1u : 0u; mine = (j == x) ? c : mine; }
        if (sum == G) break;
        __builtin_amdgcn_s_sleep(1);
        if ((++sp & 255u) == 0u) { if (xb_ld(&bar[XB_TMO])) break; if (sp > XB_SPIN_CAP) { atomicAdd(&bar[XB_TMO], 1u); break; } }
    }
    nloc = mine > 0u ? mine : 1u; nx = cnt > 0u ? cnt : 1u;
}

__device__ __forceinline__ void xcd_barrier(const XcdBarrier& b) {
    asm volatile("s_waitcnt vmcnt(0)" ::: "memory");
    __syncthreads();
    if (threadIdx.x == 0) {
        unsigned* bar = b.bar;
        __builtin_amdgcn_s_waitcnt(0);
        unsigned nloc = b.st[0], nx = b.st[1];
        if (nloc == 0u) { xcd_barrier_complete(bar, b.x, nloc, nx); b.st[0] = nloc; b.st[1] = nx; }
        const unsigned old = xb_add(&bar[XB_XSUB(b.x)], 1u);
        const unsigned gen = old / nloc;
        if (old + 1u == (gen + 1u) * nloc) {
            __builtin_amdgcn_fence(__ATOMIC_RELEASE, "agent");
            asm volatile("s_waitcnt vmcnt(0)" ::: "memory");
            const unsigned og = xb_add(&bar[XB_TOP], 1u);
            const unsigned tg = og / nx;
            if (og + 1u == (tg + 1u) * nx) xb_add(&bar[XB_TOPGEN], 1u);
            else XB_SPIN(xb_ld(&bar[XB_TOPGEN]) == tg, bar);
            __builtin_amdgcn_fence(__ATOMIC_ACQUIRE, "agent");
            xb_add(&bar[XB_XGEN(b.x)], 1u);
            asm volatile("s_waitcnt vmcnt(0)" ::: "memory");
        } else {
            XB_SPIN(xb_ld(&bar[XB_XGEN(b.x)]) == gen, bar);
            __builtin_amdgcn_fence(__ATOMIC_ACQUIRE, "agent");
            asm volatile("s_waitcnt vmcnt(0)" ::: "memory");
        }
    }
    __syncthreads();
}
namespace mk {
using pg8::bf16_t; using pg8::bf16x8; using pg8::f32x4; using pg8::u32x4;
typedef unsigned u32x2 __attribute__((ext_vector_type(2)));

#ifndef MK_CHECK_ATT
#define MK_CHECK_ATT 0
#endif
#define MK_REP_SSDP 1
#define MK_REP_TILE 1
#define MK_REP_CONV 1
#define MK_REP_SCP 1
#define MK_REP_SCS 1
#define MK_REP_SSDS 1
#define MK_REP_ATTS 1
#define MK_REP_ATTP 1
#define MK_CHECK_TOL 0.02f
#define MK_CHECK_CODE ((b0 ? 1.f : 0.f) + (b1 ? 2.f : 0.f) + (b2 ? 4.f : 0.f) + (b3 ? 8.f : 0.f) + (b4 ? 16.f : 0.f) + (b5 ? 32.f : 0.f))
#define MK_REP_MASK 0
#define DUPK(k) (((MK_REP_MASK >> (k)) & 1) != 0)
#define REPK(k) for (int rep_ = 0; rep_ < 1 + ((MK_REP_MASK >> (k)) & 1); ++rep_)
#ifndef MK_SPLIT
#define MK_SPLIT 0
#endif

constexpr int NWAVES = 8, NTHR = 512;
constexpr int MP = 16384, MS = 512, M = MP + MS, D = 1024, DFF = 2816, DI = 2048, NP = 9472, XCW = 3072;
constexpr int PZ = 0, PXBC = 2048, PSM = 5120, PQ = 5376, PK = 6400, PV = 6656, PQI = 6912, PG = 7424;
constexpr int SCW = 2048, SCSW = 2112;
constexpr size_t O_Y = 0, O_KP = 17301504, O_VP = 21495808, O_KIP = 25690112, O_CVP = 26738688, O_SSP = 26812416,
                 O_KS = 28909568, O_VS = 29040640, O_KIS = 29171712, O_CVS = 29204480, O_SSS = 30384128, O_END = 63938560;
constexpr size_t MiB = 1u << 20;
constexpr size_t WS_CTL = 0, CTL_ZERO_BYTES = 1 * MiB;
constexpr size_t WS_W1A = 1 * MiB, WS_W1B = WS_W1A + 11 * MiB, WS_WIN = WS_W1B + 6 * MiB, WS_WBS = WS_WIN + 19 * MiB, WS_WBA = WS_WBS + 4 * MiB,
                 WS_WOUT = WS_WBA + 2 * MiB, WS_W2A = WS_WOUT + 2 * MiB, WS_W2B = WS_W2A + 11 * MiB;
constexpr size_t WS_XB = WS_W2B + 6 * MiB, WS_ACT = WS_XB + 33 * MiB, WS_T = WS_ACT + 91 * MiB, WS_HF = WS_T + 66 * MiB, WS_HB = WS_HF + 66 * MiB,
                 WS_P = WS_HB + 33 * MiB, WS_SMF = WS_P + 306 * MiB, WS_XC = WS_SMF + 9 * MiB, WS_Y = WS_XC + 99 * MiB, WS_SC = WS_Y + 66 * MiB,
                 WS_SCS = WS_SC + 128 * MiB, WS_YA = WS_SCS + 5 * MiB, WS_MG = WS_YA + 33 * MiB, WS_END = WS_MG + 33 * MiB;
constexpr int CW_BAR = 4096;
constexpr int LDS_BYTES = 163840, MISC_OFF = LDS_BYTES - 256;
constexpr int WAREA = 17920;
constexpr int BIASREL_OFF = NWAVES * WAREA;
static_assert(BIASREL_OFF + 2 * 129 * 16 * 4 <= MISC_OFF, "LDS map");

constexpr float ALPHA = 1.18920711500272f;
constexpr float LN_EPS = 1e-5f;

struct Args { const float* in[29]; float* out; unsigned char* ws; int ph_lo, ph_hi; };
enum { I_XP = 0, I_XS, I_CK, I_CV, I_CKI, I_SCONV, I_SSSM, I_PT, I_BIAS, I_WIN, I_CONVW, I_CONVB, I_DTB, I_ALOG, I_DSKIP, I_NORMG, I_WBS, I_WBA, I_WOUT,
       I_F1WI, I_F1WO, I_F2WI, I_F2WO, I_LN1G, I_LN1B, I_LN2G, I_LN2B, I_LN3G, I_LN3B };

__device__ __forceinline__ float bf2f(unsigned v) { return __uint_as_float(v << 16); }
__device__ __forceinline__ unsigned f2bf(float f) { unsigned u = __float_as_uint(f); return (u + 0x7fffu + ((u >> 16) & 1u)) >> 16; }
__device__ __forceinline__ unsigned pk2(float lo, float hi) { return pg8::cvt_pk_bf16(lo, hi); }
__device__ __forceinline__ void unpack8(const u32x4 w, float (&f)[8]) {
#pragma unroll
    for (int i = 0; i < 4; ++i) { f[2 * i] = __uint_as_float(w[i] << 16); f[2 * i + 1] = __uint_as_float(w[i] & 0xffff0000u); }
}
__device__ __forceinline__ u32x4 pack8(const float (&f)[8]) { u32x4 w; w.x = pk2(f[0], f[1]); w.y = pk2(f[2], f[3]); w.z = pk2(f[4], f[5]); w.w = pk2(f[6], f[7]); return w; }
__device__ __forceinline__ float sigmoidf_(float x) { return 1.0f / (1.0f + __expf(-x)); }
__device__ __forceinline__ float siluf_(float x) { return x / (1.0f + __expf(-x)); }
__device__ __forceinline__ float wave_sum(float v) {
#pragma unroll
    for (int o = 1; o < 64; o <<= 1) v += __shfl_xor(v, o);
    return v;
}
__device__ __forceinline__ float wave_max(float v) {
#pragma unroll
    for (int o = 1; o < 64; o <<= 1) v = fmaxf(v, __shfl_xor(v, o));
    return v;
}
__device__ __forceinline__ f32x4 mfma16(bf16x8 a, bf16x8 b, f32x4 c) { return __builtin_amdgcn_mfma_f32_16x16x32_bf16(a, b, c, 0, 0, 0); }
__device__ __forceinline__ int mbcnt64(unsigned long long m) { return (int)__builtin_amdgcn_mbcnt_hi((unsigned)(m >> 32), __builtin_amdgcn_mbcnt_lo((unsigned)m, 0u)); }

struct EpiSwiglu {
    static constexpr bool PERM = true, AFTER_DRAIN = false;
    bf16_t* O;
    __device__ __forceinline__ void operator()(const f32x4 (&acc)[2][2][4][2], const pg8::Unit& u, int wr, int wc, int fr, int fq) const {
        const int row0 = u.pm * 256 + wr * 64 + fr, col0 = u.pn * 128 + wc * 32 + 8 * fq;
#pragma unroll
        for (int ai = 0; ai < 2; ++ai)
#pragma unroll
            for (int m = 0; m < 4; ++m) {
                float o[8];
#pragma unroll
                for (int n = 0; n < 2; ++n)
#pragma unroll
                    for (int j = 0; j < 4; ++j) { const float g = acc[ai][0][m][n][j], up = acc[ai][1][m][n][j]; o[4 * n + j] = siluf_(g) * up; }
                *(u32x4*)(O + (size_t)(row0 + ai * 128 + m * 16) * DFF + col0) = pack8(o);
            }
    }
};
struct EpiResid {
    static constexpr bool PERM = false, AFTER_DRAIN = false;
    const float* base_p; const float* base_s; float* T; float alpha, s;
    __device__ __forceinline__ void operator()(const f32x4 (&acc)[2][2][4][2], const pg8::Unit& u, int wr, int wc, int fr, int fq) const {
        const int row0 = u.pm * 256 + wr * 64 + fr, col0 = u.pn * 256 + wc * 32 + 4 * fq;
#pragma unroll
        for (int ai = 0; ai < 2; ++ai)
#pragma unroll
            for (int m = 0; m < 4; ++m) {
                const int r = row0 + ai * 128 + m * 16;
                const float* b = (r < MP) ? base_p + (size_t)r * D : base_s + (size_t)(r - MP) * D;
#pragma unroll
                for (int bj = 0; bj < 2; ++bj)
#pragma unroll
                    for (int n = 0; n < 2; ++n) { const int c = col0 + bj * 128 + n * 16; const f32x4 bv = *(const f32x4*)(b + c);
                        *(f32x4*)(T + (size_t)r * D + c) = bv * alpha + acc[ai][bj][m][n] * s; }
            }
    }
};
struct EpiWin {
    static constexpr bool PERM = true, AFTER_DRAIN = false;
    bf16_t* P; float* smf; float* out;
    __device__ __forceinline__ void operator()(const f32x4 (&acc)[2][2][4][2], const pg8::Unit& u, int wr, int wc, int fr, int fq) const {
        const int row0 = u.pm * 256 + wr * 64 + fr, cl = wc * 32 + 8 * fq, col0 = u.pn * 256 + cl;
#pragma unroll
        for (int ai = 0; ai < 2; ++ai)
#pragma unroll
            for (int m = 0; m < 4; ++m) {
                const int r = row0 + ai * 128 + m * 16;
#pragma unroll
                for (int bj = 0; bj < 2; ++bj) {
                    const f32x4 v0 = acc[ai][bj][m][0], v1 = acc[ai][bj][m][1];
                    u32x4 w; w.x = pk2(v0[0], v0[1]); w.y = pk2(v0[2], v0[3]); w.z = pk2(v1[0], v1[1]); w.w = pk2(v1[2], v1[3]);
                    *(u32x4*)(P + (size_t)r * NP + col0 + bj * 128) = w;
                    if (u.pn == 20) {
                        if (bj == 0) {
                            float* d = smf + (size_t)r * 128 + cl; *(f32x4*)d = v0; *(f32x4*)(d + 4) = v1;
                            if (cl >= 64) { float* k = out + ((r < MP) ? O_KIP + (size_t)r * 64 : O_KIS + (size_t)(r - MP) * 64) + (cl - 64); *(f32x4*)k = v0; *(f32x4*)(k + 4) = v1; }
                        }
                    } else if (u.pn == 25) {
                        float* k = out + ((r < MP) ? O_KP + (size_t)r * 256 : O_KS + (size_t)(r - MP) * 256) + bj * 128 + cl; *(f32x4*)k = v0; *(f32x4*)(k + 4) = v1;
                    } else if (u.pn == 26) {
                        float* k = out + ((r < MP) ? O_VP + (size_t)r * 256 : O_VS + (size_t)(r - MP) * 256) + bj * 128 + cl; *(f32x4*)k = v0; *(f32x4*)(k + 4) = v1;
                    }
                }
            }
    }
};
struct EpiGateA {
    static constexpr bool PERM = false, AFTER_DRAIN = false;
    const bf16_t* P; int gcol; float* M1;
    __device__ __forceinline__ void operator()(const f32x4 (&acc)[2][2][4][2], const pg8::Unit& u, int wr, int wc, int fr, int fq) const {
        const int row0 = u.pm * 256 + wr * 64 + fr, col0 = u.pn * 256 + wc * 32 + 4 * fq;
#pragma unroll
        for (int ai = 0; ai < 2; ++ai)
#pragma unroll
            for (int m = 0; m < 4; ++m) {
                const int r = row0 + ai * 128 + m * 16;
#pragma unroll
                for (int bj = 0; bj < 2; ++bj)
#pragma unroll
                    for (int n = 0; n < 2; ++n) { const int c = col0 + bj * 128 + n * 16; const u32x2 gw = *(const u32x2*)(P + (size_t)r * NP + gcol + c);
                        f32x4 g; g[0] = sigmoidf_(__uint_as_float(gw.x << 16)); g[1] = sigmoidf_(__uint_as_float(gw.x & 0xffff0000u)); g[2] = sigmoidf_(__uint_as_float(gw.y << 16)); g[3] = sigmoidf_(__uint_as_float(gw.y & 0xffff0000u));
                        *(f32x4*)(M1 + (size_t)r * D + c) = g * acc[ai][bj][m][n]; }
            }
    }
};
struct EpiGateS {
    static constexpr bool PERM = true, AFTER_DRAIN = false;
    const bf16_t* P; int gcol; const float* M1; bf16_t* MG;
    __device__ __forceinline__ void operator()(const f32x4 (&acc)[2][2][4][2], const pg8::Unit& u, int wr, int wc, int fr, int fq) const {
        const int row0 = u.pm * 256 + wr * 64 + fr, col0 = u.pn * 256 + wc * 32 + 8 * fq;
#pragma unroll
        for (int ai = 0; ai < 2; ++ai)
#pragma unroll
            for (int m = 0; m < 4; ++m) {
                const int r = row0 + ai * 128 + m * 16;
#pragma unroll
                for (int bj = 0; bj < 2; ++bj) { const int c = col0 + bj * 128;
                    const u32x4 gw = *(const u32x4*)(P + (size_t)r * NP + gcol + c); float g[8]; unpack8(gw, g);
                    const f32x4 m0 = *(const f32x4*)(M1 + (size_t)r * D + c), m1 = *(const f32x4*)(M1 + (size_t)r * D + c + 4);
                    float o[8];
#pragma unroll
                    for (int j = 0; j < 4; ++j) { o[j] = m0[j] + sigmoidf_(g[j]) * acc[ai][bj][m][0][j]; o[4 + j] = m1[j] + sigmoidf_(g[4 + j]) * acc[ai][bj][m][1][j]; }
                    *(u32x4*)(MG + (size_t)r * D + c) = pack8(o); }
            }
    }
};

struct SkResid { const float* base; float* T; float alpha, s;
    __device__ __forceinline__ void operator()(int r, int c, f32x4 v) const { const f32x4 bv = *(const f32x4*)(base + (size_t)(r - MP) * D + c); *(f32x4*)(T + (size_t)r * D + c) = bv * alpha + v * s; } };
struct SkGateA { const bf16_t* P; int gcol; float* M1;
    __device__ __forceinline__ void operator()(int r, int c, f32x4 v) const { const u32x2 gw = *(const u32x2*)(P + (size_t)r * NP + gcol + c);
        f32x4 g; g[0] = sigmoidf_(__uint_as_float(gw.x << 16)); g[1] = sigmoidf_(__uint_as_float(gw.x & 0xffff0000u)); g[2] = sigmoidf_(__uint_as_float(gw.y << 16)); g[3] = sigmoidf_(__uint_as_float(gw.y & 0xffff0000u));
        *(f32x4*)(M1 + (size_t)r * D + c) = g * v; } };
struct SkGateS { const bf16_t* P; int gcol; const float* M1; bf16_t* MG;
    __device__ __forceinline__ void operator()(int r, int c, f32x4 v) const { const u32x2 gw = *(const u32x2*)(P + (size_t)r * NP + gcol + c); const f32x4 m = *(const f32x4*)(M1 + (size_t)r * D + c);
        const float o0 = m[0] + sigmoidf_(__uint_as_float(gw.x << 16)) * v[0], o1 = m[1] + sigmoidf_(__uint_as_float(gw.x & 0xffff0000u)) * v[1], o2 = m[2] + sigmoidf_(__uint_as_float(gw.y << 16)) * v[2], o3 = m[3] + sigmoidf_(__uint_as_float(gw.y & 0xffff0000u)) * v[3];
        u32x2 w; w.x = pk2(o0, o1); w.y = pk2(o2, o3); *(u32x2*)(MG + (size_t)r * D + c) = w; } };
template <int K, class Epi>
__device__ __forceinline__ void skinny_gemm(LAS unsigned char* lds, const bf16_t* A  , const bf16_t* Bt, const Epi& E, int bx, int G, int wave, int lane) {
    constexpr int KW = K / 8, NS = KW / 32;
    const int fr = lane & 15, fq = lane >> 4, tid = wave * 64 + lane;
    LAS float* part = (LAS float*)lds;
    for (int tile = bx; tile < 256; tile += G) {
        const int tm = tile >> 4, tn = tile & 15;
        const bf16_t* ap = A + (size_t)(tm * 32 + fr) * K + wave * KW + 8 * fq;
        const bf16_t* bp = Bt + (size_t)(tn * 64 + fr) * K + wave * KW + 8 * fq;
        f32x4 acc[2][4];
#pragma unroll
        for (int m = 0; m < 2; ++m)
#pragma unroll
            for (int n = 0; n < 4; ++n) acc[m][n] = (f32x4){0.f, 0.f, 0.f, 0.f};
#pragma unroll 4
        for (int ks = 0; ks < NS; ++ks) {
            bf16x8 a[2], bb[4];
#pragma unroll
            for (int m = 0; m < 2; ++m) a[m] = *(const bf16x8*)(ap + (size_t)m * 16 * K + ks * 32);
#pragma unroll
            for (int n = 0; n < 4; ++n) bb[n] = *(const bf16x8*)(bp + (size_t)n * 16 * K + ks * 32);
#pragma unroll
            for (int m = 0; m < 2; ++m)
#pragma unroll
                for (int n = 0; n < 4; ++n) acc[m][n] = mfma16(a[m], bb[n], acc[m][n]);
        }
#pragma unroll
        for (int m = 0; m < 2; ++m)
#pragma unroll
            for (int n = 0; n < 4; ++n)
#pragma unroll
                for (int j = 0; j < 4; ++j) part[(wave * 32 + m * 16 + 4 * fq + j) * 64 + n * 16 + fr] = acc[m][n][j];
        __syncthreads();
        { const int row = tid >> 4, c4 = (tid & 15) * 4; f32x4 v = {0.f, 0.f, 0.f, 0.f};
#pragma unroll
          for (int w = 0; w < 8; ++w) v += *(const LAS f32x4*)(part + (w * 32 + row) * 64 + c4);
          E(MP + tm * 32 + row, tn * 64 + c4, v); }
        __syncthreads();
    }
}

__device__ __forceinline__ int tr_src(int mode, int n) {
    if (mode == 0) return n;
    if (mode == 1) { const int j = n >> 8, i = n & 255; return (i < 128) ? j * 128 + i : DFF + j * 128 + (i - 128); }
    if (n < 5120) return n;
    if (n < 5376) { const int j = n - 5120; if (j < 32) return 5120 + j; if (j < 40) return 7264 + (j - 32); if (j >= 64 && j < 128) return 7200 + (j - 64); return -1; }
    if (n < 6400) return 5152 + (n - 5376);
    if (n < 6656) return 6176 + (n - 6400);
    if (n < 6912) return 6432 + (n - 6656);
    if (n < 7424) return 6688 + (n - 6912);
    return 7272 + (n - 7424);
}
__device__ __forceinline__ void tr_item(const float* W, int K, int Nsrc, bf16_t* WT, int k0, int n0, int mode, LAS bf16_t* scr, int lane) {
    const int kr = lane >> 4, nc = (lane & 15) * 4;
    const int sc = tr_src(mode, n0 + nc);
    f32x4 v[16];
#pragma unroll
    for (int i = 0; i < 16; ++i) v[i] = (sc >= 0) ? *(const f32x4*)(W + (size_t)(k0 + 4 * i + kr) * Nsrc + sc) : (f32x4){0.f, 0.f, 0.f, 0.f};
#pragma unroll
    for (int i = 0; i < 16; ++i) { const int k = 4 * i + kr; const unsigned p01 = pk2(v[i][0], v[i][1]), p23 = pk2(v[i][2], v[i][3]);
        scr[(nc + 0) * 72 + k] = (bf16_t)(p01 & 0xffffu); scr[(nc + 1) * 72 + k] = (bf16_t)(p01 >> 16); scr[(nc + 2) * 72 + k] = (bf16_t)(p23 & 0xffffu); scr[(nc + 3) * 72 + k] = (bf16_t)(p23 >> 16); }
    asm volatile("s_waitcnt lgkmcnt(0)" ::: "memory");
    const int nr = lane >> 3, kc = (lane & 7) * 8;
#pragma unroll
    for (int i = 0; i < 8; ++i) { const int n = 8 * i + nr; *(u32x4*)(WT + (size_t)(n0 + n) * K + k0 + kc) = *(const LAS u32x4*)(scr + n * 72 + kc); }
    asm volatile("s_waitcnt lgkmcnt(0)" ::: "memory");
}
__device__ __forceinline__ void p0_prologue(const Args& A, LAS unsigned char* lds, int gw, int NGW, int wave, int lane) {
    LAS bf16_t* scr = (LAS bf16_t*)(lds + wave * 16384);
    unsigned char* ws = A.ws;
    constexpr int NI0 = 16 * 88, NI1 = 44 * 16, NI2 = 16 * 148, NI3 = 32 * 16, NI4 = 16 * 16, NI5 = 16 * 16, NI6 = NI0, NI7 = NI1;
    constexpr int NIT = NI0 + NI1 + NI2 + NI3 + NI4 + NI5 + NI6 + NI7;
    for (int it = gw; it < NIT; it += NGW) {
        int r = it; const float* W; bf16_t* WT; int K, Nsrc, nblk, mode;
        if (r < NI0) { W = A.in[I_F1WI]; WT = (bf16_t*)(ws + WS_W1A); K = 1024; Nsrc = 2 * DFF; nblk = 88; mode = 1; }
        else if ((r -= NI0) < NI1) { W = A.in[I_F1WO]; WT = (bf16_t*)(ws + WS_W1B); K = DFF; Nsrc = 1024; nblk = 16; mode = 0; }
        else if ((r -= NI1) < NI2) { W = A.in[I_WIN]; WT = (bf16_t*)(ws + WS_WIN); K = 1024; Nsrc = 9320; nblk = 148; mode = 2; }
        else if ((r -= NI2) < NI3) { W = A.in[I_WBS]; WT = (bf16_t*)(ws + WS_WBS); K = 2048; Nsrc = 1024; nblk = 16; mode = 0; }
        else if ((r -= NI3) < NI4) { W = A.in[I_WBA]; WT = (bf16_t*)(ws + WS_WBA); K = 1024; Nsrc = 1024; nblk = 16; mode = 0; }
        else if ((r -= NI4) < NI5) { W = A.in[I_WOUT]; WT = (bf16_t*)(ws + WS_WOUT); K = 1024; Nsrc = 1024; nblk = 16; mode = 0; }
        else if ((r -= NI5) < NI6) { W = A.in[I_F2WI]; WT = (bf16_t*)(ws + WS_W2A); K = 1024; Nsrc = 2 * DFF; nblk = 88; mode = 1; }
        else { r -= NI6; W = A.in[I_F2WO]; WT = (bf16_t*)(ws + WS_W2B); K = DFF; Nsrc = 1024; nblk = 16; mode = 0; }
        const int kb = r / nblk, nb = r % nblk;
        tr_item(W, K, Nsrc, WT, kb * 64, nb * 64, mode, scr, lane);
    }
    bf16_t* XB = (bf16_t*)(ws + WS_XB);
    const int nchunk = M * D / 8;
    for (int ch0 = gw * 256 + lane; ch0 < nchunk; ch0 += NGW * 256) {
        f32x4 a[4], b[4];
#pragma unroll
        for (int u = 0; u < 4; ++u) { const int ch = ch0 + 64 * u, m = ch >> 7, c = (ch & 127) * 8;
            const float* src = (m < MP) ? A.in[I_XP] + (size_t)m * D + c : A.in[I_XS] + (size_t)(m - MP) * D + c; a[u] = *(const f32x4*)src; b[u] = *(const f32x4*)(src + 4); }
#pragma unroll
        for (int u = 0; u < 4; ++u) { const int ch = ch0 + 64 * u, m = ch >> 7, c = (ch & 127) * 8;
            u32x4 w; w.x = pk2(a[u][0], a[u][1]); w.y = pk2(a[u][2], a[u][3]); w.z = pk2(b[u][0], b[u][1]); w.w = pk2(b[u][2], b[u][3]);
            *(u32x4*)(XB + (size_t)m * D + c) = w; }
    }
}

__device__ __forceinline__ void ln_phase(const float* T, const float* g, const float* b, float* outf, bf16_t* outb, int gw, int NGW, int lane) {
    f32x4 gv[4], bv[4];
#pragma unroll
    for (int j = 0; j < 4; ++j) { gv[j] = *(const f32x4*)(g + 4 * lane + 256 * j); bv[j] = *(const f32x4*)(b + 4 * lane + 256 * j); }
    for (int m0 = gw; m0 < M; m0 += 2 * NGW) {
        const int m1 = m0 + NGW; const bool has1 = m1 < M;
        f32x4 v[2][4];
#pragma unroll
        for (int j = 0; j < 4; ++j) { v[0][j] = *(const f32x4*)(T + (size_t)m0 * D + 4 * lane + 256 * j); v[1][j] = has1 ? *(const f32x4*)(T + (size_t)m1 * D + 4 * lane + 256 * j) : (f32x4){0.f, 0.f, 0.f, 0.f}; }
#pragma unroll
        for (int r = 0; r < 2; ++r) {
            if (r == 1 && !has1) break;
            const int m = r ? m1 : m0; float s = 0.f;
#pragma unroll
            for (int j = 0; j < 4; ++j) s += (v[r][j][0] + v[r][j][1]) + (v[r][j][2] + v[r][j][3]);
            const float mean = wave_sum(s) * (1.f / D); float s2 = 0.f;
#pragma unroll
            for (int j = 0; j < 4; ++j) { v[r][j] = v[r][j] - mean; s2 += (v[r][j][0] * v[r][j][0] + v[r][j][1] * v[r][j][1]) + (v[r][j][2] * v[r][j][2] + v[r][j][3] * v[r][j][3]); }
            const float rstd = 1.0f / sqrtf(wave_sum(s2) * (1.f / D) + LN_EPS);
#pragma unroll
            for (int j = 0; j < 4; ++j) {
                const f32x4 o = v[r][j] * rstd * gv[j] + bv[j];
                *(f32x4*)(outf + (size_t)m * D + 4 * lane + 256 * j) = o;
                if (outb) { u32x2 w; w.x = pk2(o[0], o[1]); w.y = pk2(o[2], o[3]); *(u32x2*)(outb + (size_t)m * D + 4 * lane + 256 * j) = w; }
            }
        }
    }
}

template <int NT  , bool SAMP>
__device__ __forceinline__ void conv_item(const Args& A, int b, int t0, int cg, int lane) {
    const bf16_t* P = (const bf16_t*)(A.ws + WS_P); bf16_t* XC = (bf16_t*)(A.ws + WS_XC);
    const float* cw = A.in[I_CONVW]; const float* cb = A.in[I_CONVB];
    const int ch = (cg * 64 + lane) * 8;
    const size_t row0 = SAMP ? (size_t)(MP + b * 4) : (size_t)(b * 2048 + t0);
    u32x4 raw[NT + 3];
#pragma unroll
    for (int i = 0; i < NT + 3; ++i) {
        const int t = t0 - 3 + i;
        if (t >= 0) raw[i] = *(const u32x4*)(P + (row0 + (size_t)(i - 3)) * NP + PXBC + ch);
        else raw[i] = (u32x4){0u, 0u, 0u, 0u};
    }
    float w[4][8], bias[8];
#pragma unroll
    for (int j = 0; j < 4; ++j) { const f32x4 w0 = *(const f32x4*)(cw + (size_t)j * XCW + ch), w1 = *(const f32x4*)(cw + (size_t)j * XCW + ch + 4);
#pragma unroll
        for (int i = 0; i < 4; ++i) { w[j][i] = w0[i]; w[j][4 + i] = w1[i]; } }
    { const f32x4 b0 = *(const f32x4*)(cb + ch), b1 = *(const f32x4*)(cb + ch + 4);
#pragma unroll
      for (int i = 0; i < 4; ++i) { bias[i] = b0[i]; bias[4 + i] = b1[i]; } }
    float u0[8], u1[8], u2[8];
    if (SAMP) {
        const float* sc = A.in[I_SCONV] + (size_t)b * 3 * XCW + ch;
#pragma unroll
        for (int i = 0; i < 4; ++i) { const f32x4 a0 = *(const f32x4*)(sc), a1 = *(const f32x4*)(sc + 4), c0 = *(const f32x4*)(sc + XCW), c1 = *(const f32x4*)(sc + XCW + 4), e0 = *(const f32x4*)(sc + 2 * XCW), e1 = *(const f32x4*)(sc + 2 * XCW + 4);
            u0[i] = a0[i]; u0[4 + i] = a1[i]; u1[i] = c0[i]; u1[4 + i] = c1[i]; u2[i] = e0[i]; u2[4 + i] = e1[i]; }
    } else { unpack8(raw[0], u0); unpack8(raw[1], u1); unpack8(raw[2], u2); }
#pragma unroll
    for (int i = 0; i < NT; ++i) {
        float u3[8], o[8]; unpack8(raw[i + 3], u3);
#pragma unroll
        for (int e = 0; e < 8; ++e) o[e] = siluf_(bias[e] + w[0][e] * u0[e] + w[1][e] * u1[e] + w[2][e] * u2[e] + w[3][e] * u3[e]);
        *(u32x4*)(XC + (row0 + (size_t)i) * XCW + ch) = pack8(o);
        const int t = t0 + i; float* cs = nullptr;
        if (!SAMP) { if (t >= 2045) cs = A.out + O_CVP + ((size_t)b * 3 + (t - 2045)) * XCW + ch; }
        else { if (t >= 1) cs = A.out + O_CVS + ((size_t)b * 3 + (t - 1)) * XCW + ch; }
        if (cs) { *(f32x4*)cs = (f32x4){u3[0], u3[1], u3[2], u3[3]}; *(f32x4*)(cs + 4) = (f32x4){u3[4], u3[5], u3[6], u3[7]}; }
#pragma unroll
        for (int e = 0; e < 8; ++e) { u0[e] = u1[e]; u1[e] = u2[e]; u2[e] = u3[e]; }
    }
}
__device__ __forceinline__ void conv_phase(const Args& A, int gw, int NGW, int lane) {
    constexpr int NPI = 8 * 128 * 6, NSI = 128 * 6;
    for (int it = gw; it < NPI + NSI; it += NGW) {
        if (it < NPI) { const int cg = it % 6, r = it / 6; conv_item<16, false>(A, r >> 7, (r & 127) * 16, cg, lane); }
        else { const int r = it - NPI; conv_item<4, true>(A, r / 6, 0, r % 6, lane); }
    }
}

constexpr float IDX_SCALE = 0.125f * 0.35355339059327373f;
constexpr int SCL = 2052;
__device__ __forceinline__ unsigned f2key(float v) { unsigned u = (v == 0.f) ? 0u : __float_as_uint(v); return (u & 0x80000000u) ? ~u : (u | 0x80000000u); }
__device__ __forceinline__ void scores_select_prompt_unit(const Args& A, LAS unsigned char* lds, int b, int qt, int wave, int lane_in) {
    const bf16_t* P = (const bf16_t*)(A.ws + WS_P); const float* SMF = (const float*)(A.ws + WS_SMF);
    unsigned long long* MASKW = (unsigned long long*)(A.ws + WS_SC);
    LAS float* sc = (LAS float*)lds;
    int lane = lane_in; asm volatile("" : "+v"(lane));
    const int fr = lane & 15, fq = lane >> 4;
    {
        const size_t rowq = (size_t)(b * 2048 + qt * 16 + fr);
        bf16x8 Af[8][2];
#pragma unroll
        for (int h = 0; h < 8; ++h)
#pragma unroll
            for (int ks = 0; ks < 2; ++ks) Af[h][ks] = *(const bf16x8*)(P + rowq * NP + PQI + h * 64 + ks * 32 + 8 * fq);
        float wq[4][8];
#pragma unroll
        for (int j = 0; j < 4; ++j) { const float* wp = SMF + (size_t)(b * 2048 + qt * 16 + 4 * fq + j) * 128 + 32; const f32x4 w0 = *(const f32x4*)wp, w1 = *(const f32x4*)(wp + 4);
#pragma unroll
            for (int h = 0; h < 4; ++h) { wq[j][h] = w0[h] * IDX_SCALE; wq[j][4 + h] = w1[h] * IDX_SCALE; } }
        const bf16_t* kbase = P + (size_t)(b * 2048 + fr) * NP + PSM + 64 + 8 * fq;
        bf16x8 nB0 = {0, 0, 0, 0, 0, 0, 0, 0}, nB1 = nB0;
        if (wave <= qt) { const bf16_t* kp = kbase + (size_t)wave * 16 * NP; nB0 = *(const bf16x8*)kp; nB1 = *(const bf16x8*)(kp + 32); }
        for (int kt = wave; kt <= qt; kt += NWAVES) {
            const bf16x8 B0 = nB0, B1 = nB1;
            if (kt + NWAVES <= qt) { const bf16_t* kp = kbase + (size_t)(kt + NWAVES) * 16 * NP; nB0 = *(const bf16x8*)kp; nB1 = *(const bf16x8*)(kp + 32); }
            f32x4 scv = {0.f, 0.f, 0.f, 0.f};
#pragma unroll
            for (int h = 0; h < 8; ++h) { f32x4 d = {0.f, 0.f, 0.f, 0.f}; d = mfma16(Af[h][0], B0, d); d = mfma16(Af[h][1], B1, d);
#pragma unroll
                for (int j = 0; j < 4; ++j) scv[j] += wq[j][h] * fmaxf(d[j], 0.f); }
#pragma unroll
            for (int j = 0; j < 4; ++j) sc[(4 * fq + j) * SCL + kt * 16 + fr] = scv[j];
#if MK_CHECK_ATT
#pragma unroll
            for (int j = 0; j < 4; ++j) ((float*)(A.ws + WS_END))[(size_t)(b * 2048 + qt * 16 + 4 * fq + j) * SCW + kt * 16 + fr] = scv[j];
#endif
        }
    }
    __syncthreads();
#pragma unroll 1
    for (int u = 0; u < 2; ++u) {
        const int ql = 2 * wave + u, t = qt * 16 + ql, nvalid = t + 1;
        const LAS float* srow = sc + ql * SCL + lane;
        unsigned key[32];
#pragma unroll
        for (int j = 0; j < 32; ++j) key[j] = (lane < nvalid - 64 * j) ? f2key(srow[64 * j]) : 0u;
        unsigned T = 0u; int need_eq = 0;
        if (nvalid > 256) {
            bool exact = false;
            for (int bit = 31; bit >= 0; --bit) {
                const unsigned cand = T | (1u << bit); int cnt = 0;
#pragma unroll
                for (int j = 0; j < 32; ++j) cnt += __popcll(__ballot(key[j] >= cand));
                if (cnt >= 256) { T = cand; if (cnt == 256) { exact = true; break; } }
            }
            if (exact) { T -= 1u; }
            else { int cgt = 0;
#pragma unroll
                for (int j = 0; j < 32; ++j) cgt += __popcll(__ballot(key[j] > T));
                need_eq = 256 - cgt; }
        }
        int eqused = 0; unsigned long long mine = 0ull;
#pragma unroll
        for (int j = 0; j < 32; ++j) {
            unsigned long long ms;
            if (need_eq > 0) {
                const bool gt = key[j] > T, eq = key[j] == T;
                const unsigned long long meq = __ballot(eq);
                const bool sel = gt || (eq && (eqused + mbcnt64(meq) < need_eq));
                eqused += __popcll(meq);
                ms = __ballot(sel);
            } else ms = __ballot(key[j] > T);
            if (lane == j) mine = ms;
        }
        if (lane < 32) MASKW[(size_t)(b * 2048 + t) * 32 + lane] = mine;
    }
    __syncthreads();
}
__device__ __forceinline__ void scores_sample_unit(const Args& A, int b, int half, int wave, int lane) {
    const bf16_t* P = (const bf16_t*)(A.ws + WS_P); const float* SMF = (const float*)(A.ws + WS_SMF); float* SCS = (float*)(A.ws + WS_SCS);
    const int* pt = (const int*)A.in[I_PT]; const float* cki = A.in[I_CKI];
    const int fr = lane & 15, fq = lane >> 4;
    bf16x8 Af[2][2]; float wq[2][4];
#pragma unroll
    for (int mt = 0; mt < 2; ++mt) {
#pragma unroll
        for (int ks = 0; ks < 2; ++ks) Af[mt][ks] = *(const bf16x8*)(P + (size_t)(MP + b * 4 + 2 * mt + (fr >> 3)) * NP + PQI + (fr & 7) * 64 + ks * 32 + 8 * fq);
        const f32x4 w = *(const f32x4*)(SMF + (size_t)(MP + b * 4 + 2 * mt + (fq >> 1)) * 128 + 32 + 4 * (fq & 1));
#pragma unroll
        for (int j = 0; j < 4; ++j) wq[mt][j] = w[j] * IDX_SCALE;
    }
    const int kt_end = (half == 0) ? 65 : 129;
    for (int kt = half * 65 + wave; kt < kt_end; kt += NWAVES) {
        const int key = kt * 16 + fr;
        bf16x8 B0, B1;
        if (key < 2048) {
            const int page = pt[b * 16 + (key >> 7)];
            const float* src = cki + ((size_t)page * 128 + (key & 127)) * 64 + 8 * fq;
            const f32x4 a0 = *(const f32x4*)src, a1 = *(const f32x4*)(src + 4), c0 = *(const f32x4*)(src + 32), c1 = *(const f32x4*)(src + 36);
            u32x4 w0, w1; w0.x = pk2(a0[0], a0[1]); w0.y = pk2(a0[2], a0[3]); w0.z = pk2(a1[0], a1[1]); w0.w = pk2(a1[2], a1[3]);
            w1.x = pk2(c0[0], c0[1]); w1.y = pk2(c0[2], c0[3]); w1.z = pk2(c1[0], c1[1]); w1.w = pk2(c1[2], c1[3]);
            B0 = __builtin_bit_cast(bf16x8, w0); B1 = __builtin_bit_cast(bf16x8, w1);
        } else if (key < 2052) {
            const bf16_t* src = P + (size_t)(MP + b * 4 + (key - 2048)) * NP + PSM + 64 + 8 * fq;
            B0 = *(const bf16x8*)src; B1 = *(const bf16x8*)(src + 32);
        } else { B0 = (bf16x8){0, 0, 0, 0, 0, 0, 0, 0}; B1 = B0; }
#pragma unroll
        for (int mt = 0; mt < 2; ++mt) {
            f32x4 d = {0.f, 0.f, 0.f, 0.f}; d = mfma16(Af[mt][0], B0, d); d = mfma16(Af[mt][1], B1, d);
            float s = 0.f;
#pragma unroll
            for (int j = 0; j < 4; ++j) s += wq[mt][j] * fmaxf(d[j], 0.f);
            s += __shfl_xor(s, 16);
            if ((fq & 1) == 0 && key < 2052) SCS[(size_t)(b * 4 + 2 * mt + (fq >> 1)) * SCSW + key] = s;
        }
    }
}

__device__ __forceinline__ float softplusf_(float x) { return fmaxf(x, 0.f) + log1pf(expf(-fabsf(x))); }
__device__ __forceinline__ void ssd_prompt_item(const Args& A, LAS unsigned char* lds, int b, int h) {
    const int tid = threadIdx.x, lane = tid & 63, wave = __builtin_amdgcn_readfirstlane(tid >> 6), fr = lane & 15, fq = lane >> 4;
    const int g = h >> 3;
    const bf16_t* XC = (const bf16_t*)(A.ws + WS_XC); const float* SMF = (const float*)(A.ws + WS_SMF); bf16_t* Y = (bf16_t*)(A.ws + WS_Y);
    LAS bf16_t* Cm = (LAS bf16_t*)lds;
    LAS bf16_t* Bm = Cm + 64 * 136;
    LAS bf16_t* Btw = Bm + 64 * 136;
    LAS bf16_t* Xt = Btw + 128 * 72;
    LAS bf16_t* Mt = Xt + 64 * 72;
    LAS bf16_t* Hp = Mt + 64 * 72;
    LAS float* cumA = (LAS float*)(Hp + 64 * 136);
    LAS float* dtvA = cumA + 2048; LAS float* wvA = dtvA + 2048; LAS float* ecumA = wvA + 2048;
    const float Ah = -expf(A.in[I_ALOG][h]), dtb = A.in[I_DTB][h], dsk = A.in[I_DSKIP][h];
    f32x4 hst[4];
#pragma unroll
    for (int i = 0; i < 4; ++i) hst[i] = (f32x4){0.f, 0.f, 0.f, 0.f};
    for (int i = tid; i < 64 * 136 / 8; i += NTHR) *(LAS u32x4*)(Hp + i * 8) = (u32x4){0u, 0u, 0u, 0u};
#pragma unroll 1
    for (int c = wave; c < 32; c += NWAVES) {
        const int tk = c * 64 + lane;
        const float dt = softplusf_(SMF[(size_t)(b * 2048 + tk) * 128 + h] + dtb);
        float v = dt * Ah;
#pragma unroll
        for (int o = 1; o < 64; o <<= 1) { const float n = __shfl_up(v, o); if (lane >= o) v += n; }
        const float ce = __shfl(v, 63);
        cumA[tk] = v; dtvA[tk] = dt; wvA[tk] = dt * expf(ce - v); ecumA[tk] = expf(v);
    }
    const int s0 = tid >> 4, part0 = tid & 15;
    const int xs = tid >> 3, xpart = tid & 7;
    u32x4 cr[2], br[2], xr;
    {
#pragma unroll
        for (int i = 0; i < 2; ++i) { const bf16_t* rp = XC + (size_t)(b * 2048 + s0 + 32 * i) * XCW + g * 128 + part0 * 8; cr[i] = *(const u32x4*)(rp + 2560); br[i] = *(const u32x4*)(rp + 2048); }
        xr = *(const u32x4*)(XC + (size_t)(b * 2048 + xs) * XCW + h * 64 + xpart * 8);
    }
    for (int c = 0; c < 32; ++c) {
        const int row0 = b * 2048 + c * 64;
        const LAS float* cum = cumA + c * 64; const LAS float* dtv = dtvA + c * 64; const LAS float* wv = wvA + c * 64; const LAS float* ecum = ecumA + c * 64;
        __syncthreads();
#pragma unroll
        for (int i = 0; i < 2; ++i) {
            const int s = s0 + 32 * i;
            *(LAS u32x4*)(Cm + s * 136 + part0 * 8) = cr[i];
            *(LAS u32x4*)(Bm + s * 136 + part0 * 8) = br[i];
            float bf[8]; unpack8(br[i], bf); const float w = wv[s];
#pragma unroll
            for (int e = 0; e < 8; ++e) Btw[(part0 * 8 + e) * 72 + s] = (bf16_t)f2bf(bf[e] * w);
        }
        {
#pragma unroll
            for (int e = 0; e < 4; ++e) { Xt[(xpart * 8 + 2 * e) * 72 + xs] = (bf16_t)(xr[e] & 0xffffu); Xt[(xpart * 8 + 2 * e + 1) * 72 + xs] = (bf16_t)(xr[e] >> 16); }
        }
#pragma unroll
        for (int p4 = 0; p4 < 4; ++p4) { u32x2 w; w.x = pk2(hst[p4][0], hst[p4][1]); w.y = pk2(hst[p4][2], hst[p4][3]);
            *(LAS u32x2*)(Hp + (16 * p4 + fr) * 136 + 16 * wave + 4 * fq) = w; }
        if (c + 1 < 32) {
#pragma unroll
            for (int i = 0; i < 2; ++i) { const bf16_t* rp = XC + (size_t)(row0 + 64 + s0 + 32 * i) * XCW + g * 128 + part0 * 8; cr[i] = *(const u32x4*)(rp + 2560); br[i] = *(const u32x4*)(rp + 2048); }
            xr = *(const u32x4*)(XC + (size_t)(row0 + 64 + xs) * XCW + h * 64 + xpart * 8);
        }
        __syncthreads();
        {
            const int st = wave >> 1, tt0 = 2 * (wave & 1);
            bf16x8 a[4];
#pragma unroll
            for (int ks = 0; ks < 4; ++ks) a[ks] = *(const LAS bf16x8*)(Bm + (16 * st + fr) * 136 + ks * 32 + 8 * fq);
#pragma unroll
            for (int u = 0; u < 2; ++u) {
                const int tt = tt0 + u; f32x4 d = {0.f, 0.f, 0.f, 0.f};
#pragma unroll
                for (int ks = 0; ks < 4; ++ks) { const bf16x8 bb = *(const LAS bf16x8*)(Cm + (16 * tt + fr) * 136 + ks * 32 + 8 * fq); d = mfma16(a[ks], bb, d); }
                const int t = 16 * tt + fr; const float ct = cum[t]; float mv[4];
#pragma unroll
                for (int j = 0; j < 4; ++j) { const int s = 16 * st + 4 * fq + j; mv[j] = (s <= t) ? d[j] * __expf(ct - cum[s]) * dtv[s] : 0.f; }
                u32x2 w; w.x = pk2(mv[0], mv[1]); w.y = pk2(mv[2], mv[3]);
                *(LAS u32x2*)(Mt + t * 72 + 16 * st + 4 * fq) = w;
            }
        }
        __syncthreads();
        {
            const int pt = wave >> 1, tt0 = 2 * (wave & 1);
            bf16x8 a1[2], a2[4];
#pragma unroll
            for (int ks = 0; ks < 2; ++ks) a1[ks] = *(const LAS bf16x8*)(Xt + (16 * pt + fr) * 72 + ks * 32 + 8 * fq);
#pragma unroll
            for (int ks = 0; ks < 4; ++ks) a2[ks] = *(const LAS bf16x8*)(Hp + (16 * pt + fr) * 136 + ks * 32 + 8 * fq);
#pragma unroll
            for (int u = 0; u < 2; ++u) {
                const int tt = tt0 + u; f32x4 d1 = {0.f, 0.f, 0.f, 0.f}, d2 = {0.f, 0.f, 0.f, 0.f};
#pragma unroll
                for (int ks = 0; ks < 2; ++ks) { const bf16x8 bb = *(const LAS bf16x8*)(Mt + (16 * tt + fr) * 72 + ks * 32 + 8 * fq); d1 = mfma16(a1[ks], bb, d1); }
#pragma unroll
                for (int ks = 0; ks < 4; ++ks) { const bf16x8 bb = *(const LAS bf16x8*)(Cm + (16 * tt + fr) * 136 + ks * 32 + 8 * fq); d2 = mfma16(a2[ks], bb, d2); }
                const int t = 16 * tt + fr; const float et = ecum[t]; float yv[4];
#pragma unroll
                for (int j = 0; j < 4; ++j) { const int p = 16 * pt + 4 * fq + j; yv[j] = d1[j] + et * d2[j] + dsk * bf2f((unsigned)Xt[p * 72 + t]); }
                u32x2 w; w.x = pk2(yv[0], yv[1]); w.y = pk2(yv[2], yv[3]);
                *(u32x2*)(Y + (size_t)(row0 + t) * DI + h * 64 + 16 * pt + 4 * fq) = w;
            }
            bf16x8 a3[2];
#pragma unroll
            for (int ks = 0; ks < 2; ++ks) a3[ks] = *(const LAS bf16x8*)(Btw + (16 * wave + fr) * 72 + ks * 32 + 8 * fq);
            const float dec = ecum[63];
#pragma unroll
            for (int p4 = 0; p4 < 4; ++p4) { f32x4 d = {0.f, 0.f, 0.f, 0.f};
#pragma unroll
                for (int ks = 0; ks < 2; ++ks) { const bf16x8 bb = *(const LAS bf16x8*)(Xt + (16 * p4 + fr) * 72 + ks * 32 + 8 * fq); d = mfma16(a3[ks], bb, d); }
                hst[p4] = hst[p4] * dec + d; }
        }
    }
    float* so = A.out + O_SSP + ((size_t)b * 32 + h) * 64 * 128;
#pragma unroll
    for (int p4 = 0; p4 < 4; ++p4) *(f32x4*)(so + (size_t)(16 * p4 + fr) * 128 + 16 * wave + 4 * fq) = hst[p4];
    __syncthreads();
}

__device__ __forceinline__ void ssd_sample_item(const Args& A, LAS unsigned char* wl, int b, int h, int lane) {
    const bf16_t* XC = (const bf16_t*)(A.ws + WS_XC); const float* SMF = (const float*)(A.ws + WS_SMF); bf16_t* Y = (bf16_t*)(A.ws + WS_Y);
    LAS float* red = (LAS float*)wl;
    const int g = h >> 3;
    const float Ah = -expf(A.in[I_ALOG][h]), dtb = A.in[I_DTB][h], dsk = A.in[I_DSKIP][h];
#pragma unroll 1
    for (int half = 0; half < 2; ++half) {
        const float* h0 = A.in[I_SSSM] + (((size_t)b * 32 + h) * 64 + 32 * half) * 128 + 2 * lane;
        float st[32][2];
#pragma unroll
        for (int p = 0; p < 32; ++p) { const float2 v = *(const float2*)(h0 + p * 128); st[p][0] = v.x; st[p][1] = v.y; }
#pragma unroll 1
        for (int t = 0; t < 4; ++t) {
            const size_t m = (size_t)(MP + b * 4 + t);
            const float dt = softplusf_(SMF[m * 128 + h] + dtb), dec = expf(dt * Ah);
            const unsigned bw = *(const unsigned*)(XC + m * XCW + 2048 + g * 128 + 2 * lane), cw = *(const unsigned*)(XC + m * XCW + 2560 + g * 128 + 2 * lane);
            const float b0 = bf2f(bw & 0xffffu) * dt, b1 = __uint_as_float(bw & 0xffff0000u) * dt, c0 = bf2f(cw & 0xffffu), c1 = __uint_as_float(cw & 0xffff0000u);
            const float xl = bf2f((unsigned)XC[m * XCW + h * 64 + 32 * half + (lane & 31)]);
#pragma unroll
            for (int p = 0; p < 32; ++p) {
                const float xp = __shfl(xl, p);
                st[p][0] = st[p][0] * dec + xp * b0; st[p][1] = st[p][1] * dec + xp * b1;
                red[p * 65 + lane] = st[p][0] * c0 + st[p][1] * c1;
            }
            asm volatile("s_waitcnt lgkmcnt(0)" ::: "memory");
            float y = 0.f;
#pragma unroll 16
            for (int i = 0; i < 64; ++i) y += red[(lane & 31) * 65 + i];
            y += dsk * xl;
            if (lane < 32) Y[m * DI + h * 64 + 32 * half + lane] = (bf16_t)f2bf(y);
            asm volatile("s_waitcnt lgkmcnt(0)" ::: "memory");
        }
        float* so = A.out + O_SSS + (((size_t)b * 32 + h) * 64 + 32 * half) * 128 + 2 * lane;
#pragma unroll
        for (int p = 0; p < 32; ++p) *(float2*)(so + p * 128) = make_float2(st[p][0], st[p][1]);
    }
}

__device__ __forceinline__ int t5_bucket(int n) {
    if (n < 16) return n;
    const float nf = (float)n;
    int large = 16 + (int)(logf(nf / 16.0f) / 2.0794415416798357f * 16.0f);
    return large < 31 ? large : 31;
}
typedef float f32x16 __attribute__((ext_vector_type(16)));
__device__ __forceinline__ f32x16 mfma32(bf16x8 a, bf16x8 b, f32x16 c) { return __builtin_amdgcn_mfma_f32_32x32x16_bf16(a, b, c, 0, 0, 0); }
constexpr float LOG2E = 1.4426950408889634f;
constexpr int AK_STR = 72, AV_STR = 96, ATK_T = 64 * AK_STR * 2, ATV_T = 64 * AV_STR * 2, AT_K0 = 0, AT_V0 = 4 * ATK_T, AT_WS = AT_V0 + 4 * ATV_T;
struct AttStage { u32x4 k0, v0, k1, v1, m; };
__device__ __forceinline__ void att_issue(AttStage& R, const bf16_t* src, const unsigned* msrc) {
    const bf16_t* src1 = src + (size_t)64 * NP;
    asm volatile("global_load_dwordx4 %0, %5, off\n\tglobal_load_dwordx4 %1, %5, off offset:512\n\tglobal_load_dwordx4 %2, %6, off\n\tglobal_load_dwordx4 %3, %6, off offset:512\n\tglobal_load_dwordx4 %4, %7, off"
                 : "=&v"(R.k0), "=&v"(R.v0), "=&v"(R.k1), "=&v"(R.v1), "=&v"(R.m) : "v"(src), "v"(src1), "v"(msrc) : "memory");
}
__device__ __forceinline__ void att_wait(AttStage& R) { asm volatile("s_waitcnt vmcnt(0)" : "+v"(R.k0), "+v"(R.v0), "+v"(R.k1), "+v"(R.v1), "+v"(R.m) :: "memory"); }
__device__ __forceinline__ void att_stage_write1(const u32x4 k, const u32x4 v, LAS bf16_t* Kb, LAS bf16_t* Vb, int skey, int sdch) {
    *(LAS u32x4*)(Kb + skey * AK_STR + sdch * 8) = k;
    *(LAS u32x4*)(Vb + skey * AV_STR + sdch * 8) = v;
}
typedef short v4i16_t __attribute__((ext_vector_type(4)));
__device__ __forceinline__ u32x2 lds_tr16(const LAS bf16_t* p) { return __builtin_bit_cast(u32x2, __builtin_amdgcn_ds_read_tr16_b64_v4i16((LAS v4i16_t*)p)); }
struct AttState { f32x16 O0, O1; float m_run, l_run; };
__device__ __forceinline__ void att_tile(AttState& st, const LAS bf16_t* Kb, const LAS bf16_t* Vb, const bf16x8 (&qf)[4], unsigned mw0, unsigned mw1, bool far, float bfar, const LAS float* bl  ,
                                         int rb  , LAS float* wsc, int r32, int hi) {
    const int lane16 = r32 & 15, blk16 = r32 >> 4;
    const unsigned w0 = mw0 >> (4 * hi), w1 = mw1 >> (4 * hi);
    f32x16 S0, S1;
#pragma unroll
    for (int i = 0; i < 16; ++i) { S0[i] = 0.f; S1[i] = 0.f; }
#pragma unroll
    for (int ds = 0; ds < 4; ++ds) {
        const bf16x8 k0 = *(const LAS bf16x8*)(Kb + r32 * AK_STR + 16 * ds + 8 * hi), k1 = *(const LAS bf16x8*)(Kb + (32 + r32) * AK_STR + 16 * ds + 8 * hi);
        S0 = mfma32(k0, qf[ds], S0); S1 = mfma32(k1, qf[ds], S1);
    }
    const float c1 = 0.125f * LOG2E;
    float tm;
    if (far) {
        float t0 = fmaxf(S0[0], S1[0]);
#pragma unroll
        for (int i = 1; i < 16; ++i) t0 = fmaxf(t0, fmaxf(S0[i], S1[i]));
        tm = t0 * c1 + bfar;
    } else {
#pragma unroll
        for (int i = 0; i < 16; ++i) { const int pos = (i & 3) + 8 * (i >> 2);
            int r0 = rb - pos, r1 = r0 - 32; r0 = r0 < 0 ? 0 : (r0 > 128 ? 128 : r0); r1 = r1 < 0 ? 0 : (r1 > 128 ? 128 : r1);
            S0[i] = S0[i] * c1 + bl[r0 * 16]; S1[i] = S1[i] * c1 + bl[r1 * 16]; }
        float t0 = fmaxf(S0[0], S1[0]);
#pragma unroll
        for (int i = 1; i < 16; ++i) t0 = fmaxf(t0, fmaxf(S0[i], S1[i]));
        tm = t0;
    }
    tm = fmaxf(tm, __shfl_xor(tm, 32));
    if (__any(tm > st.m_run + 8.0f)) {
        const float mn = fmaxf(st.m_run, tm), f = __builtin_amdgcn_exp2f(st.m_run - mn);
        st.m_run = mn; st.l_run *= f;
        if (hi == 0) wsc[r32] = f;
        asm volatile("s_waitcnt lgkmcnt(0)" ::: "memory");
#pragma unroll
        for (int i = 0; i < 16; ++i) { const float fi = wsc[(i & 3) + 8 * (i >> 2) + 4 * hi]; st.O0[i] *= fi; st.O1[i] *= fi; }
        asm volatile("s_waitcnt lgkmcnt(0)" ::: "memory");
    }
    float ls = 0.f;
    {
        const float sc = far ? c1 : 1.0f, off = (far ? bfar : 0.f) - st.m_run;
#pragma unroll
        for (int i = 0; i < 16; ++i) { const int pos = (i & 3) + 8 * (i >> 2);
            const float p0 = __builtin_amdgcn_exp2f(S0[i] * sc + off), p1 = __builtin_amdgcn_exp2f(S1[i] * sc + off);
            unsigned k0, k1;
            asm("v_bfe_i32 %0, %1, %2, 1" : "=v"(k0) : "v"(w0), "i"(pos)); asm("v_bfe_i32 %0, %1, %2, 1" : "=v"(k1) : "v"(w1), "i"(pos));
            S0[i] = __uint_as_float(__float_as_uint(p0) & k0); S1[i] = __uint_as_float(__float_as_uint(p1) & k1);
            ls += S0[i] + S1[i]; }
    }
    st.l_run += ls;
    bf16x8 pa[2][2];
#pragma unroll
    for (int sk = 0; sk < 2; ++sk) {
        u32x4 a0, a1;
        a0.x = pk2(S0[8 * sk + 0], S0[8 * sk + 1]); a0.y = pk2(S0[8 * sk + 2], S0[8 * sk + 3]); a0.z = pk2(S0[8 * sk + 4], S0[8 * sk + 5]); a0.w = pk2(S0[8 * sk + 6], S0[8 * sk + 7]);
        a1.x = pk2(S1[8 * sk + 0], S1[8 * sk + 1]); a1.y = pk2(S1[8 * sk + 2], S1[8 * sk + 3]); a1.z = pk2(S1[8 * sk + 4], S1[8 * sk + 5]); a1.w = pk2(S1[8 * sk + 6], S1[8 * sk + 7]);
        pa[0][sk] = __builtin_bit_cast(bf16x8, a0); pa[1][sk] = __builtin_bit_cast(bf16x8, a1);
    }
    const LAS bf16_t* vl = Vb + (4 * hi + ((lane16 >> 2))) * AV_STR + 16 * blk16 + 4 * (lane16 & 3);
#pragma unroll
    for (int blk = 0; blk < 2; ++blk)
#pragma unroll
        for (int sk = 0; sk < 2; ++sk) {
            const LAS bf16_t* vr = vl + (32 * blk + 16 * sk) * AV_STR;
            const u32x2 a = lds_tr16(vr), c = lds_tr16(vr + 8 * AV_STR), a2 = lds_tr16(vr + 32), c2 = lds_tr16(vr + 8 * AV_STR + 32);
            const u32x4 v0 = {a.x, a.y, c.x, c.y}, v1 = {a2.x, a2.y, c2.x, c2.y};
            st.O0 = mfma32(pa[blk][sk], __builtin_bit_cast(bf16x8, v0), st.O0);
            st.O1 = mfma32(pa[blk][sk], __builtin_bit_cast(bf16x8, v1), st.O1);
        }
}
__device__ __forceinline__ void attn_prompt_unit(const Args& A, LAS unsigned char* lds, const LAS float* biasL, int b, int g, int qt, int wave, int lane_in) {
    const bf16_t* P = (const bf16_t*)(A.ws + WS_P); const unsigned* MASK32 = (const unsigned*)(A.ws + WS_SC); bf16_t* YA = (bf16_t*)(A.ws + WS_YA);
    int lane = lane_in; asm volatile("" : "+v"(lane));
    const int tid = wave * 64 + lane, r32 = lane & 31, hi = lane >> 5;
    LAS float* wsc = (LAS float*)(lds + AT_WS) + wave * 64;
    const int query = qt * 64 + 8 * wave + (r32 >> 2), head = 4 * g + (r32 & 3);
    const size_t qrow = (size_t)(b * 2048 + query);
    bf16x8 qf[4];
#pragma unroll
    for (int ds = 0; ds < 4; ++ds) qf[ds] = *(const bf16x8*)(P + qrow * NP + PQ + head * 64 + 16 * ds + 8 * hi);
    const unsigned* mrow = MASK32 + qrow * 64;
    float bfar = biasL[128 * 16 + head];
    const LAS float* bl = biasL + head;
    asm volatile("" : "+v"(qf[0]), "+v"(qf[1]), "+v"(qf[2]), "+v"(qf[3]), "+v"(bfar));
    const int skey = tid >> 3, sdch = tid & 7;
    const bf16_t* ksrc = P + (size_t)(b * 2048 + skey) * NP + PK + g * 64 + sdch * 8;
    AttState st;
#pragma unroll
    for (int i = 0; i < 16; ++i) { st.O0[i] = 0.f; st.O1[i] = 0.f; }
    st.m_run = -1e30f; st.l_run = 0.f;
    const int nstep = (qt + 2) >> 1;
    AttStage R;
    att_issue(R, ksrc, mrow);
    att_wait(R);
    att_stage_write1(R.k0, R.v0, (LAS bf16_t*)(lds + AT_K0), (LAS bf16_t*)(lds + AT_V0), skey, sdch);
    att_stage_write1(R.k1, R.v1, (LAS bf16_t*)(lds + AT_K0 + ATK_T), (LAS bf16_t*)(lds + AT_V0 + ATV_T), skey, sdch);
    u32x4 mw = R.m;
    for (int j = 0; j < nstep; ++j) {
        const int buf = j & 1, kt = 2 * j;
        __syncthreads();
        { const int jn = (j + 1 < nstep) ? j + 1 : j; att_issue(R, ksrc + (size_t)jn * 128 * NP, mrow + 4 * jn); }
        const LAS bf16_t* Kb = (const LAS bf16_t*)(lds + AT_K0 + buf * (2 * ATK_T)); const LAS bf16_t* Vb = (const LAS bf16_t*)(lds + AT_V0 + buf * (2 * ATV_T));
        for (int rep_ = 0; rep_ < MK_REP_TILE; ++rep_) {
        att_tile(st, Kb, Vb, qf, mw[0], mw[1], qt - kt >= 3, bfar, bl, query - (kt * 64 + 4 * hi), wsc, r32, hi);
        if (kt + 1 <= qt) att_tile(st, (const LAS bf16_t*)((const LAS unsigned char*)Kb + ATK_T), (const LAS bf16_t*)((const LAS unsigned char*)Vb + ATV_T), qf, mw[2], mw[3], qt - kt - 1 >= 3, bfar, bl, query - ((kt + 1) * 64 + 4 * hi), wsc, r32, hi);
        }
        att_wait(R);
        if (j + 1 < nstep) {
            LAS bf16_t* Kn = (LAS bf16_t*)(lds + AT_K0 + (buf ^ 1) * (2 * ATK_T)); LAS bf16_t* Vn = (LAS bf16_t*)(lds + AT_V0 + (buf ^ 1) * (2 * ATV_T));
            att_stage_write1(R.k0, R.v0, Kn, Vn, skey, sdch);
            att_stage_write1(R.k1, R.v1, (LAS bf16_t*)((LAS unsigned char*)Kn + ATK_T), (LAS bf16_t*)((LAS unsigned char*)Vn + ATV_T), skey, sdch);
        }
        mw = R.m;
    }
    st.l_run += __shfl_xor(st.l_run, 32);
    if (hi == 0) wsc[r32] = 1.0f / st.l_run;
    asm volatile("s_waitcnt lgkmcnt(0)" ::: "memory");
#pragma unroll
    for (int i = 0; i < 16; ++i) {
        const int rq = (i & 3) + 8 * (i >> 2) + 4 * hi; const float inv = wsc[rq];
        bf16_t* dst = YA + (size_t)(b * 2048 + qt * 64 + 8 * wave + (rq >> 2)) * D + (4 * g + (rq & 3)) * 64 + r32;
        dst[0] = (bf16_t)f2bf(st.O0[i] * inv); dst[32] = (bf16_t)f2bf(st.O1[i] * inv);
    }
    __syncthreads();
}

__device__ __forceinline__ void attend_sample_task(const Args& A, LAS unsigned char* wl, const LAS float* biasrel, int ms, int g, int lane_in) {
    constexpr int NJ = 33;
    int lane = lane_in; asm volatile("" : "+v"(lane));
    const bf16_t* P = (const bf16_t*)(A.ws + WS_P);
    const int b = ms >> 2, t = ms & 3, nvalid = 2049 + t, qpos = 2048 + t, m = MP + ms;
    const float* srow = (const float*)(A.ws + WS_SCS) + (size_t)ms * SCSW;
    LAS float* pq = (LAS float*)wl;
    LAS unsigned* rowid = (LAS unsigned*)(wl + 4096);
    LAS unsigned short* posl = (LAS unsigned short*)(wl + 4096 + 1024);
    unsigned key[NJ];
#pragma unroll
    for (int j = 0; j < NJ; ++j) key[j] = (lane < nvalid - 64 * j) ? f2key(srow[lane + 64 * j]) : 0u;
    unsigned T = 0u; int need_eq = 0;
    {
        bool exact = false;
        for (int bit = 31; bit >= 0; --bit) {
            const unsigned cand = T | (1u << bit); int cnt = 0;
#pragma unroll
            for (int j = 0; j < NJ; ++j) cnt += __popcll(__ballot(key[j] >= cand));
            if (cnt >= 256) { T = cand; if (cnt == 256) { exact = true; break; } }
        }
        if (exact) { T -= 1u; }
        else { int cgt = 0;
#pragma unroll
            for (int j = 0; j < NJ; ++j) cgt += __popcll(__ballot(key[j] > T));
            need_eq = 256 - cgt; }
    }
    int base = 0, eqused = 0;
    const int* pt = (const int*)A.in[I_PT];
#pragma unroll
    for (int j = 0; j < NJ; ++j) {
        const bool gt = key[j] > T, eq = (need_eq > 0) && (key[j] == T);
        const unsigned long long meq = __ballot(eq);
        const bool sel = gt || (eq && (eqused + mbcnt64(meq) < need_eq));
        eqused += __popcll(meq);
        const unsigned long long msk = __ballot(sel);
        if (sel) { const int pos = lane + 64 * j, k = base + mbcnt64(msk);
            posl[k] = (unsigned short)pos;
            rowid[k] = (pos < 2048) ? (unsigned)(pt[b * 16 + (pos >> 7)] * 128 + (pos & 127)) : (0x80000000u | (unsigned)(b * 4 + pos - 2048)); }
        base += __popcll(msk);
    }
    { const u32x2 w = *(const u32x2*)(P + (size_t)m * NP + PQ + g * 256 + lane * 4);
      *(LAS f32x4*)(pq + lane * 4) = (f32x4){__uint_as_float(w.x << 16), __uint_as_float(w.x & 0xffff0000u), __uint_as_float(w.y << 16), __uint_as_float(w.y & 0xffff0000u)}; }
    asm volatile("s_waitcnt lgkmcnt(0)" ::: "memory");
    const float* ck = A.in[I_CK]; const float* cv = A.in[I_CV]; const float* kn = A.out + O_KS; const float* vn = A.out + O_VS;
    const float* kp[4]; int rel[4];
#pragma unroll
    for (int i = 0; i < 4; ++i) { const unsigned rid = rowid[lane + 64 * i]; rel[i] = qpos - (int)posl[lane + 64 * i];
        kp[i] = ((rid & 0x80000000u) ? kn + (size_t)(rid & 0x7fffffffu) * 256 : ck + (size_t)rid * 256) + g * 64; }
    float acc[4][4];
#pragma unroll
    for (int i = 0; i < 4; ++i)
#pragma unroll
        for (int hh = 0; hh < 4; ++hh) acc[i][hh] = 0.f;
#pragma unroll 2
    for (int dc = 0; dc < 16; ++dc) {
        f32x4 kv[4];
#pragma unroll
        for (int i = 0; i < 4; ++i) kv[i] = *(const f32x4*)(kp[i] + dc * 4);
#pragma unroll
        for (int hh = 0; hh < 4; ++hh) { const f32x4 q4 = *(const LAS f32x4*)(pq + hh * 64 + dc * 4);
#pragma unroll
            for (int i = 0; i < 4; ++i) acc[i][hh] += kv[i][0] * q4[0] + kv[i][1] * q4[1] + kv[i][2] * q4[2] + kv[i][3] * q4[3]; }
    }
    asm volatile("s_waitcnt lgkmcnt(0)" ::: "memory");
#pragma unroll
    for (int i = 0; i < 4; ++i) { const int rc = rel[i] < 128 ? (rel[i] < 0 ? 0 : rel[i]) : 128; const f32x4 bv = *(const LAS f32x4*)(biasrel + rc * 16 + 4 * g);
#pragma unroll
        for (int hh = 0; hh < 4; ++hh) acc[i][hh] = acc[i][hh] * 0.125f + bv[hh]; }
#pragma unroll
    for (int hh = 0; hh < 4; ++hh) {
        const float mx = wave_max(fmaxf(fmaxf(acc[0][hh], acc[1][hh]), fmaxf(acc[2][hh], acc[3][hh])));
        float sm = 0.f;
#pragma unroll
        for (int i = 0; i < 4; ++i) { acc[i][hh] = __expf(acc[i][hh] - mx); sm += acc[i][hh]; }
        const float inv = 1.0f / wave_sum(sm);
#pragma unroll
        for (int i = 0; i < 4; ++i) acc[i][hh] *= inv;
    }
#pragma unroll
    for (int i = 0; i < 4; ++i) *(LAS f32x4*)(pq + (lane + 64 * i) * 4) = (f32x4){acc[i][0], acc[i][1], acc[i][2], acc[i][3]};
    asm volatile("s_waitcnt lgkmcnt(0)" ::: "memory");
    float o[4] = {0.f, 0.f, 0.f, 0.f};
    for (int k0 = 0; k0 < 256; k0 += 8) {
        float vv[8]; f32x4 pp[8];
#pragma unroll
        for (int u = 0; u < 8; ++u) { const unsigned rid = rowid[k0 + u];
            const float* vp = ((rid & 0x80000000u) ? vn + (size_t)(rid & 0x7fffffffu) * 256 : cv + (size_t)rid * 256) + g * 64 + lane;
            vv[u] = *vp; pp[u] = *(const LAS f32x4*)(pq + (k0 + u) * 4); }
#pragma unroll
        for (int u = 0; u < 8; ++u)
#pragma unroll
            for (int hh = 0; hh < 4; ++hh) o[hh] += pp[u][hh] * vv[u];
    }
    bf16_t* YA = (bf16_t*)(A.ws + WS_YA);
#pragma unroll
    for (int hh = 0; hh < 4; ++hh) YA[(size_t)m * D + (4 * g + hh) * 64 + lane] = (bf16_t)f2bf(o[hh]);
    asm volatile("s_waitcnt lgkmcnt(0)" ::: "memory");
}

#if MK_CHECK_ATT
constexpr size_t WS_CHK_SC = WS_END, WS_CHK_YA = WS_CHK_SC + 128 * MiB, WS_CHK_MASK = WS_CHK_YA + 33 * MiB, WS_CHK_END = WS_CHK_MASK + 4 * MiB;
constexpr int CW_CHK = 512;
template <bool SAMPLE> struct KVRow;
template <> struct KVRow<false> {
    typedef const bf16_t* ptr;
    const bf16_t* P;
    __device__ __forceinline__ ptr krow(unsigned rid) const { return P + (size_t)rid * NP + PK; }
    __device__ __forceinline__ ptr vrow(unsigned rid) const { return P + (size_t)rid * NP + PV; }
    static __device__ __forceinline__ void k8(ptr p, float (&f)[8]) { unpack8(*(const u32x4*)p, f); }
    static __device__ __forceinline__ f32x4 v4(ptr p) { const u32x2 w = *(const u32x2*)p;
        return (f32x4){__uint_as_float(w.x << 16), __uint_as_float(w.x & 0xffff0000u), __uint_as_float(w.y << 16), __uint_as_float(w.y & 0xffff0000u)}; }
};
template <> struct KVRow<true> {
    typedef const float* ptr;
    const float* ck; const float* cv; const float* kn; const float* vn;
    __device__ __forceinline__ ptr krow(unsigned rid) const { return (rid & 0x80000000u) ? kn + (size_t)(rid & 0x7fffffffu) * 256 : ck + (size_t)rid * 256; }
    __device__ __forceinline__ ptr vrow(unsigned rid) const { return (rid & 0x80000000u) ? vn + (size_t)(rid & 0x7fffffffu) * 256 : cv + (size_t)rid * 256; }
    static __device__ __forceinline__ void k8(ptr p, float (&f)[8]) { const f32x4 a = *(const f32x4*)p, b = *(const f32x4*)(p + 4);
#pragma unroll
        for (int i = 0; i < 4; ++i) { f[i] = a[i]; f[4 + i] = b[i]; } }
    static __device__ __forceinline__ f32x4 v4(ptr p) { return *(const f32x4*)p; }
};

template <bool SAMPLE>
__device__ __forceinline__ void attend_query(const Args& A, LAS unsigned char* wl, const LAS float* biasrel, int m, int lane_in) {
    constexpr int NJ = SAMPLE ? 33 : 32;
    int lane = lane_in; asm volatile("" : "+v"(lane));
    const bf16_t* P = (const bf16_t*)(A.ws + WS_P);
    int b, nvalid, qpos; const float* srow;
    if (!SAMPLE) { b = m >> 11; const int t = m & 2047; nvalid = t + 1; qpos = t; srow = (const float*)(A.ws + WS_CHK_SC) + (size_t)m * SCW; }
    else { const int ms = m - MP; b = ms >> 2; const int t = ms & 3; nvalid = 2049 + t; qpos = 2048 + t; srow = (const float*)(A.ws + WS_SCS) + (size_t)ms * SCSW; }
    LAS float* pq = (LAS float*)wl;
    LAS unsigned* rowid = (LAS unsigned*)(wl + 16384);
    LAS unsigned short* posl = (LAS unsigned short*)(wl + 16384 + 1024);
    unsigned key[NJ];
#pragma unroll
    for (int j = 0; j < NJ; ++j) { key[j] = (lane < nvalid - 64 * j) ? f2key(srow[lane + 64 * j]) : 0u; }
    unsigned T = 0u; int need_eq = 0;
    if (nvalid > 256) {
        for (int bit = 31; bit >= 0; --bit) {
            const unsigned cand = T | (1u << bit); int cnt = 0;
#pragma unroll
            for (int j = 0; j < NJ; ++j) cnt += __popcll(__ballot(key[j] >= cand));
            if (cnt >= 256) T = cand;
        }
        int cgt = 0;
#pragma unroll
        for (int j = 0; j < NJ; ++j) cgt += __popcll(__ballot(key[j] > T));
        need_eq = 256 - cgt;
    }
    int base = 0, eqused = 0; unsigned long long mine_chk = 0ull;
    const int* pt = (const int*)A.in[I_PT];
#pragma unroll
    for (int j = 0; j < NJ; ++j) {
        const bool gt = key[j] > T, eq = (need_eq > 0) && (key[j] == T);
        const unsigned long long meq = __ballot(eq);
        const bool sel = gt || (eq && (eqused + mbcnt64(meq) < need_eq));
        eqused += __popcll(meq);
        const unsigned long long ms = __ballot(sel);
        if (sel) { const int pos = lane + 64 * j, k = base + mbcnt64(ms);
            posl[k] = (unsigned short)pos;
            unsigned rid;
            if (!SAMPLE) rid = (unsigned)(b * 2048 + pos);
            else rid = (pos < 2048) ? (unsigned)(pt[b * 16 + (pos >> 7)] * 128 + (pos & 127)) : (0x80000000u | (unsigned)(b * 4 + pos - 2048));
            rowid[k] = rid; }
        base += __popcll(ms);
        if (!SAMPLE) { if (lane == j) mine_chk = ms; }
    }
    if (!SAMPLE) { if (lane < 32) ((unsigned long long*)(A.ws + WS_CHK_MASK))[(size_t)m * 32 + lane] = mine_chk; }
    const int nsel = base;
    asm volatile("s_waitcnt lgkmcnt(0)" ::: "memory");
    { const unsigned r0 = rowid[0]; const unsigned short p0 = posl[0];
#pragma unroll
      for (int i = 0; i < 4; ++i) { const int k = lane + 64 * i; if (k >= nsel) { rowid[k] = r0; posl[k] = p0; } } }
    { const u32x4 w0 = *(const u32x4*)(P + (size_t)m * NP + PQ + lane * 16), w1 = *(const u32x4*)(P + (size_t)m * NP + PQ + lane * 16 + 8);
      float f0[8], f1[8]; unpack8(w0, f0); unpack8(w1, f1);
#pragma unroll
      for (int e = 0; e < 8; ++e) { pq[lane * 16 + e] = f0[e]; pq[lane * 16 + 8 + e] = f1[e]; } }
    asm volatile("s_waitcnt lgkmcnt(0)" ::: "memory");
    KVRow<SAMPLE> R;
    if constexpr (!SAMPLE) { R.P = P; } else { R.ck = A.in[I_CK]; R.cv = A.in[I_CV]; R.kn = A.out + O_KS; R.vn = A.out + O_VS; }
    typename KVRow<SAMPLE>::ptr kp[4]; int rel[4];
#pragma unroll
    for (int i = 0; i < 4; ++i) { kp[i] = R.krow(rowid[lane + 64 * i]); rel[i] = qpos - (int)posl[lane + 64 * i]; }
    float acc[4][16];
#pragma unroll
    for (int i = 0; i < 4; ++i)
#pragma unroll
        for (int hh = 0; hh < 16; ++hh) acc[i][hh] = 0.f;
#pragma unroll
    for (int g = 0; g < 4; ++g) {
#pragma unroll 1
        for (int dc = 0; dc < 8; ++dc) {
            float kv[4][8];
#pragma unroll
            for (int i = 0; i < 4; ++i) KVRow<SAMPLE>::k8(kp[i] + g * 64 + dc * 8, kv[i]);
#pragma unroll
            for (int hh = 0; hh < 4; ++hh) {
                const f32x4 q0 = *(const LAS f32x4*)(pq + (4 * g + hh) * 64 + dc * 8), q1 = *(const LAS f32x4*)(pq + (4 * g + hh) * 64 + dc * 8 + 4);
#pragma unroll
                for (int i = 0; i < 4; ++i) {
                    float a = acc[i][4 * g + hh];
#pragma unroll
                    for (int e = 0; e < 4; ++e) { a += kv[i][e] * q0[e]; a += kv[i][4 + e] * q1[e]; }
                    acc[i][4 * g + hh] = a; }
            }
        }
    }
    asm volatile("s_waitcnt lgkmcnt(0)" ::: "memory");
#pragma unroll
    for (int i = 0; i < 4; ++i) {
        const bool valid = (lane + 64 * i) < nsel; const int rc = rel[i] < 128 ? (rel[i] < 0 ? 0 : rel[i]) : 128;
#pragma unroll
        for (int h4 = 0; h4 < 4; ++h4) { const f32x4 bv = *(const LAS f32x4*)(biasrel + rc * 16 + 4 * h4);
#pragma unroll
            for (int e = 0; e < 4; ++e) acc[i][4 * h4 + e] = valid ? acc[i][4 * h4 + e] * 0.125f + bv[e] : -INFINITY; }
    }
#pragma unroll
    for (int hh = 0; hh < 16; ++hh) {
        const float mx = wave_max(fmaxf(fmaxf(acc[0][hh], acc[1][hh]), fmaxf(acc[2][hh], acc[3][hh])));
        float s = 0.f;
#pragma unroll
        for (int i = 0; i < 4; ++i) { acc[i][hh] = __expf(acc[i][hh] - mx); s += acc[i][hh]; }
        const float inv = 1.0f / wave_sum(s);
#pragma unroll
        for (int i = 0; i < 4; ++i) acc[i][hh] *= inv;
    }
#pragma unroll
    for (int i = 0; i < 4; ++i)
#pragma unroll
        for (int h4 = 0; h4 < 4; ++h4) *(LAS f32x4*)(pq + (lane + 64 * i) * 16 + 4 * h4) = (f32x4){acc[i][4 * h4], acc[i][4 * h4 + 1], acc[i][4 * h4 + 2], acc[i][4 * h4 + 3]};
    asm volatile("s_waitcnt lgkmcnt(0)" ::: "memory");
    const int g = lane >> 4;
    f32x4 o[4];
#pragma unroll
    for (int hh = 0; hh < 4; ++hh) o[hh] = (f32x4){0.f, 0.f, 0.f, 0.f};
    const int nloop = (nsel + 3) & ~3;
    for (int k0 = 0; k0 < nloop; k0 += 4) {
        f32x4 vv[4], pp[4];
#pragma unroll
        for (int u = 0; u < 4; ++u) { const unsigned r = rowid[k0 + u]; vv[u] = KVRow<SAMPLE>::v4(R.vrow(r) + lane * 4); pp[u] = *(const LAS f32x4*)(pq + (k0 + u) * 16 + 4 * g); }
#pragma unroll
        for (int u = 0; u < 4; ++u)
#pragma unroll
            for (int hh = 0; hh < 4; ++hh) o[hh] += vv[u] * pp[u][hh];
    }
    bf16_t* YA = (bf16_t*)(A.ws + WS_CHK_YA);
#pragma unroll
    for (int hh = 0; hh < 4; ++hh) { u32x2 w; w.x = pk2(o[hh][0], o[hh][1]); w.y = pk2(o[hh][2], o[hh][3]);
        *(u32x2*)(YA + (size_t)m * D + (4 * g + hh) * 64 + (lane & 15) * 4) = w; }
    asm volatile("s_waitcnt lgkmcnt(0)" ::: "memory");
}


__device__ __forceinline__ void check_compare(const Args& A, int gw, int NGW, int lane) {
    const bf16_t* Y1 = (const bf16_t*)(A.ws + WS_YA); const bf16_t* Y2 = (const bf16_t*)(A.ws + WS_CHK_YA); unsigned* ctl = (unsigned*)(A.ws + WS_CTL);
    for (int m = gw; m < MP; m += NGW) {
        float e = 0.f, n = 0.f;
#pragma unroll
        for (int j = 0; j < 2; ++j) { float a[8], b[8]; unpack8(*(const u32x4*)(Y1 + (size_t)m * D + j * 512 + lane * 8), a); unpack8(*(const u32x4*)(Y2 + (size_t)m * D + j * 512 + lane * 8), b);
#pragma unroll
            for (int i = 0; i < 8; ++i) { const float d = a[i] - b[i]; e += d * d; n += b[i] * b[i]; } }
        e = wave_sum(e); n = wave_sum(n);
        { const unsigned long long w1 = (lane < 32) ? ((const unsigned long long*)(A.ws + WS_SC))[(size_t)m * 32 + lane] : 0ull, w2 = (lane < 32) ? ((const unsigned long long*)(A.ws + WS_CHK_MASK))[(size_t)m * 32 + lane] : 0ull;
          if (__any(w1 != w2) && lane == 0) atomicAdd(ctl + CW_CHK + 3, 1u);
          const int t = m & 2047;
          if (t >= 256) {
              const float* srow = (const float*)(A.ws + WS_CHK_SC) + (size_t)m * SCW;
              int c1 = 0, c2 = 0; float mins1 = INFINITY, maxu1 = -INFINITY, mins2 = INFINITY, maxu2 = -INFINITY;
              for (int j = 0; j < 32; ++j) { const int sp = lane + 64 * j; if (64 * j > t) break;
                  const unsigned long long a1 = __shfl((unsigned long long)w1, j), a2 = __shfl((unsigned long long)w2, j);
                  if (sp <= t) { const float v = srow[sp]; const bool s1 = (a1 >> lane) & 1ull, s2 = (a2 >> lane) & 1ull;
                      if (s1) { ++c1; mins1 = fminf(mins1, v); } else maxu1 = fmaxf(maxu1, v);
                      if (s2) { ++c2; mins2 = fminf(mins2, v); } else maxu2 = fmaxf(maxu2, v); } }
              c1 = (int)wave_sum((float)c1); c2 = (int)wave_sum((float)c2);
              mins1 = -wave_max(-mins1); mins2 = -wave_max(-mins2); maxu1 = wave_max(maxu1); maxu2 = wave_max(maxu2);
              if (lane == 0) { if (c1 != 256 || mins1 < maxu1) atomicAdd(ctl + CW_CHK + 4, 1u); if (c2 != 256 || mins2 < maxu2) atomicAdd(ctl + CW_CHK + 5, 1u); }
          } }
        if (lane == 0 && !(e <= MK_CHECK_TOL * MK_CHECK_TOL * n + 1e-12f)) { const int t = m & 2047; atomicAdd(ctl + CW_CHK + (t < 64 ? 0 : t < 256 ? 1 : 2), 1u); }
    }
}
#endif
__device__ __forceinline__ void gate_norm_phase(const Args& A, int gw, int NGW, int lane) {
    const bf16_t* P = (const bf16_t*)(A.ws + WS_P); bf16_t* Y = (bf16_t*)(A.ws + WS_Y); const float* ng = A.in[I_NORMG];
    constexpr int NIT = M * 4;
    for (int it0 = gw; it0 < NIT; it0 += 4 * NGW) {
        u32x4 yr[4], zr[4];
#pragma unroll
        for (int u = 0; u < 4; ++u) { const int it = it0 + u * NGW; if (it < NIT) { const int m = it >> 2, ch = (it & 3) * 512 + lane * 8;
            yr[u] = *(const u32x4*)(Y + (size_t)m * DI + ch); zr[u] = *(const u32x4*)(P + (size_t)m * NP + PZ + ch); } else { yr[u] = (u32x4){0u, 0u, 0u, 0u}; zr[u] = yr[u]; } }
#pragma unroll
        for (int u = 0; u < 4; ++u) { const int it = it0 + u * NGW; if (it >= NIT) break;
            const int m = it >> 2, ch = (it & 3) * 512 + lane * 8;
            float y[8], z[8]; unpack8(yr[u], y); unpack8(zr[u], z);
            float ss = 0.f;
#pragma unroll
            for (int i = 0; i < 8; ++i) { y[i] *= siluf_(z[i]); ss += y[i] * y[i]; }
            const float r = 1.0f / sqrtf(wave_sum(ss) * (1.f / 512.f) + LN_EPS);
            const f32x4 g0 = *(const f32x4*)(ng + ch), g1 = *(const f32x4*)(ng + ch + 4);
#pragma unroll
            for (int i = 0; i < 4; ++i) { y[i] = y[i] * r * g0[i]; y[4 + i] = y[4 + i] * r * g1[i]; }
            *(u32x4*)(Y + (size_t)m * DI + ch) = pack8(y); }
    }
}

constexpr int NPHASE = 14;
__global__ void __launch_bounds__(NTHR, 2) fwd(Args args) {
    extern __shared__ __attribute__((aligned(16))) unsigned char lds_raw[];
    LAS unsigned char* lds = (LAS unsigned char*)lds_raw;
    const int tid = threadIdx.x, lane = tid & 63, wave = __builtin_amdgcn_readfirstlane(tid >> 6);
    const int G = gridDim.x, bx = blockIdx.x;
    const int vcu = (G % 8 == 0) ? (bx % 8) * (G / 8) + bx / 8 : bx;
    const int gw = vcu * NWAVES + wave, NGW = G * NWAVES;
    unsigned char* ws = args.ws;
    volatile LAS unsigned* MISC = (volatile LAS unsigned*)(lds + MISC_OFF);
    for (int u = tid; u < 64; u += NTHR) MISC[u] = 0u;
    __syncthreads();
    const int lo = args.ph_lo, hi = args.ph_hi;
    XcdBarrier bar; bar.bar = (unsigned*)(ws + WS_CTL) + CW_BAR; bar.x = 0; bar.st = nullptr;
    if (hi - lo > 1) bar = xcd_barrier_post((unsigned*)(ws + WS_CTL) + CW_BAR, MISC + 8);
#define IN(k) (lo <= (k) && (k) < hi)
#define SEAM(k) do { if (IN(k) && IN((k) + 1)) xcd_barrier(bar); } while (0)

    bf16_t* const XB = (bf16_t*)(ws + WS_XB); bf16_t* const ACT = (bf16_t*)(ws + WS_ACT); float* const T = (float*)(ws + WS_T);
    float* const HF = (float*)(ws + WS_HF); bf16_t* const HB = (bf16_t*)(ws + WS_HB); bf16_t* const P = (bf16_t*)(ws + WS_P);
    float* const SMF = (float*)(ws + WS_SMF); bf16_t* const Y = (bf16_t*)(ws + WS_Y); bf16_t* const YA = (bf16_t*)(ws + WS_YA); bf16_t* const MG = (bf16_t*)(ws + WS_MG);

    if (IN(0)) REPK(0) { p0_prologue(args, lds, gw, NGW, wave, lane); }
    SEAM(0);
    if (IN(1)) {
        { pg8::Gemm g{XB, (const bf16_t*)(ws + WS_W1A), M, 2 * DFF, D}; pg8::StaticOrder S; S.init(M, 2 * DFF, G, bx);
        EpiSwiglu E{ACT}; pg8::gemm_phase<EpiSwiglu, pg8::StaticOrder, true, true>(lds, g, S, E); }
        if constexpr (DUPK(1)) { pg8::Gemm g{XB, (const bf16_t*)(ws + WS_W1A), M, 2 * DFF, D}; pg8::StaticOrder S; S.init(M, 2 * DFF, G, bx);
        EpiSwiglu E{ACT}; pg8::gemm_phase<EpiSwiglu, pg8::StaticOrder, true, true>(lds, g, S, E); }
    }
    SEAM(1);
    if (IN(2)) {
        { pg8::Gemm g{ACT, (const bf16_t*)(ws + WS_W1B), MP, D, DFF}; pg8::StaticOrder S; S.init(MP, D, G, bx);
        EpiResid E{args.in[I_XP], args.in[I_XS], T, ALPHA, 0.5f}; pg8::gemm_phase<EpiResid, pg8::StaticOrder, true, true>(lds, g, S, E); }
        { SkResid E{args.in[I_XS], T, ALPHA, 0.5f}; skinny_gemm<DFF>(lds, ACT + (size_t)MP * DFF, (const bf16_t*)(ws + WS_W1B), E, bx, G, wave, lane); }
        if constexpr (DUPK(2)) { pg8::Gemm g{ACT, (const bf16_t*)(ws + WS_W1B), MP, D, DFF}; pg8::StaticOrder S; S.init(MP, D, G, bx);
        EpiResid E{args.in[I_XP], args.in[I_XS], T, ALPHA, 0.5f}; pg8::gemm_phase<EpiResid, pg8::StaticOrder, true, true>(lds, g, S, E); }
    }
    SEAM(2);
    if (IN(3)) REPK(3) { ln_phase(T, args.in[I_LN1G], args.in[I_LN1B], HF, HB, gw, NGW, lane); }
    SEAM(3);
    if (IN(4)) {
        { pg8::Gemm g{HB, (const bf16_t*)(ws + WS_WIN), M, NP, D}; pg8::StaticOrder S; S.init(M, NP, G, bx);
        EpiWin E{P, SMF, args.out}; pg8::gemm_phase<EpiWin, pg8::StaticOrder, true, true>(lds, g, S, E); }
        if constexpr (DUPK(4)) { pg8::Gemm g{HB, (const bf16_t*)(ws + WS_WIN), M, NP, D}; pg8::StaticOrder S; S.init(M, NP, G, bx);
        EpiWin E{P, SMF, args.out}; pg8::gemm_phase<EpiWin, pg8::StaticOrder, true, true>(lds, g, S, E); }
    }
    SEAM(4);
    if (IN(5)) REPK(5) {
        for (int rep = 0; rep < MK_REP_CONV; ++rep)
        conv_phase(args, gw, NGW, lane);
        for (int rep = 0; rep < MK_REP_SCP; ++rep)
        for (int u = bx; u < 1024; u += G) { const int i = u >> 8, c = u & 255, b = c >> 5, s = c & 31; const int qt = (i == 0) ? s : (i == 1) ? 63 - s : (i == 2) ? 64 + s : 127 - s;
            scores_select_prompt_unit(args, lds, b, qt, wave, lane); }
        for (int rep = 0; rep < MK_REP_SCS; ++rep)
        for (int u = bx; u < 256; u += G) scores_sample_unit(args, u >> 1, u & 1, wave, lane);
    }
    SEAM(5);
    if (IN(6)) {
        for (int rep = 0; rep < MK_REP_SSDP; ++rep)
        for (int it = bx; it < 256; it += G) ssd_prompt_item(args, lds, it >> 5, it & 31);
        __syncthreads();
        LAS float* biasrel = (LAS float*)(lds + BIASREL_OFF); LAS float* biasL = biasrel + 129 * 16;
        for (int i = tid; i < 129 * 16; i += NTHR) { const int rel = i >> 4, h = i & 15; const float bv = args.in[I_BIAS][t5_bucket(rel) * 16 + h]; biasrel[i] = bv; biasL[i] = bv * LOG2E; }
        __syncthreads();
        for (int rep = 0; rep < MK_REP_ATTP; ++rep)
        for (int u = bx; u < 1024; u += G) { const int i = u >> 8, c = u & 255, bg = c >> 3, s8 = c & 7; const int qt = (i == 0) ? s8 : (i == 1) ? 15 - s8 : (i == 2) ? 16 + s8 : 31 - s8;
            attn_prompt_unit(args, lds, biasL, bg >> 2, bg & 3, qt, wave, lane); }
        __syncthreads();
        LAS unsigned char* wl = lds + wave * WAREA;
        for (int rep = 0; rep < MK_REP_SSDS; ++rep)
        for (int it = gw; it < 4096; it += NGW) ssd_sample_item(args, wl, it >> 5, it & 31, lane);
        for (int rep = 0; rep < MK_REP_ATTS; ++rep)
        for (int q = gw; q < MS * 4; q += NGW) attend_sample_task(args, wl, biasrel, q >> 2, q & 3, lane);
#if MK_CHECK_ATT
        for (int q = gw; q < MP; q += NGW) attend_query<false>(args, wl, biasrel, q, lane);
#endif
        __syncthreads();
    }
    SEAM(6);
    if (IN(7)) {
        gate_norm_phase(args, gw, NGW, lane);
#if MK_CHECK_ATT
        check_compare(args, gw, NGW, lane);
#endif
        { pg8::Gemm g{YA, (const bf16_t*)(ws + WS_WBA), MP, D, D}; pg8::StaticOrder S; S.init(MP, D, G, bx);
        EpiGateA E{P, PG + D, T}; pg8::gemm_phase<EpiGateA, pg8::StaticOrder, true, true>(lds, g, S, E); }
        { SkGateA E{P, PG + D, T}; skinny_gemm<D>(lds, YA + (size_t)MP * D, (const bf16_t*)(ws + WS_WBA), E, bx, G, wave, lane); }
        if constexpr (DUPK(7)) { pg8::Gemm g{YA, (const bf16_t*)(ws + WS_WBA), MP, D, D}; pg8::StaticOrder S; S.init(MP, D, G, bx);
        EpiGateA E{P, PG + D, T}; pg8::gemm_phase<EpiGateA, pg8::StaticOrder, true, true>(lds, g, S, E); }
    }
    SEAM(7);
    if (IN(8)) {
        { pg8::Gemm g{Y, (const bf16_t*)(ws + WS_WBS), MP, D, DI}; pg8::StaticOrder S; S.init(MP, D, G, bx);
        EpiGateS E{P, PG, T, MG}; pg8::gemm_phase<EpiGateS, pg8::StaticOrder, true, true>(lds, g, S, E); }
        { SkGateS E{P, PG, T, MG}; skinny_gemm<DI>(lds, Y + (size_t)MP * DI, (const bf16_t*)(ws + WS_WBS), E, bx, G, wave, lane); }
        if constexpr (DUPK(8)) { pg8::Gemm g{Y, (const bf16_t*)(ws + WS_WBS), MP, D, DI}; pg8::StaticOrder S; S.init(MP, D, G, bx);
        EpiGateS E{P, PG, T, MG}; pg8::gemm_phase<EpiGateS, pg8::StaticOrder, true, true>(lds, g, S, E); }
    }
    SEAM(8);
    if (IN(9)) {
        { pg8::Gemm g{MG, (const bf16_t*)(ws + WS_WOUT), MP, D, D}; pg8::StaticOrder S; S.init(MP, D, G, bx);
        EpiResid E{HF, HF + (size_t)MP * D, T, ALPHA, 1.0f}; pg8::gemm_phase<EpiResid, pg8::StaticOrder, true, true>(lds, g, S, E); }
        { SkResid E{HF + (size_t)MP * D, T, ALPHA, 1.0f}; skinny_gemm<D>(lds, MG + (size_t)MP * D, (const bf16_t*)(ws + WS_WOUT), E, bx, G, wave, lane); }
        if constexpr (DUPK(9)) { pg8::Gemm g{MG, (const bf16_t*)(ws + WS_WOUT), MP, D, D}; pg8::StaticOrder S; S.init(MP, D, G, bx);
        EpiResid E{HF, HF + (size_t)MP * D, T, ALPHA, 1.0f}; pg8::gemm_phase<EpiResid, pg8::StaticOrder, true, true>(lds, g, S, E); }
    }
    SEAM(9);
    if (IN(10)) REPK(10) { ln_phase(T, args.in[I_LN2G], args.in[I_LN2B], HF, HB, gw, NGW, lane); }
    SEAM(10);
    if (IN(11)) {
        { pg8::Gemm g{HB, (const bf16_t*)(ws + WS_W2A), M, 2 * DFF, D}; pg8::StaticOrder S; S.init(M, 2 * DFF, G, bx);
        EpiSwiglu E{ACT}; pg8::gemm_phase<EpiSwiglu, pg8::StaticOrder, true, true>(lds, g, S, E); }
        if constexpr (DUPK(11)) { pg8::Gemm g{HB, (const bf16_t*)(ws + WS_W2A), M, 2 * DFF, D}; pg8::StaticOrder S; S.init(M, 2 * DFF, G, bx);
        EpiSwiglu E{ACT}; pg8::gemm_phase<EpiSwiglu, pg8::StaticOrder, true, true>(lds, g, S, E); }
    }
    SEAM(11);
    if (IN(12)) {
        { pg8::Gemm g{ACT, (const bf16_t*)(ws + WS_W2B), MP, D, DFF}; pg8::StaticOrder S; S.init(MP, D, G, bx);
        EpiResid E{HF, HF + (size_t)MP * D, T, ALPHA, 0.5f}; pg8::gemm_phase<EpiResid, pg8::StaticOrder, true, true>(lds, g, S, E); }
        { SkResid E{HF + (size_t)MP * D, T, ALPHA, 0.5f}; skinny_gemm<DFF>(lds, ACT + (size_t)MP * DFF, (const bf16_t*)(ws + WS_W2B), E, bx, G, wave, lane); }
        if constexpr (DUPK(12)) { pg8::Gemm g{ACT, (const bf16_t*)(ws + WS_W2B), MP, D, DFF}; pg8::StaticOrder S; S.init(MP, D, G, bx);
        EpiResid E{HF, HF + (size_t)MP * D, T, ALPHA, 0.5f}; pg8::gemm_phase<EpiResid, pg8::StaticOrder, true, true>(lds, g, S, E); }
    }
    SEAM(12);
    if (IN(13)) REPK(13) { ln_phase(T, args.in[I_LN3G], args.in[I_LN3B], args.out + O_Y, nullptr, gw, NGW, lane); }
#if MK_CHECK_ATT
    if (IN(13)) { __syncthreads(); unsigned* cw = (unsigned*)(ws + WS_CTL) + CW_CHK;
        const unsigned b0 = __hip_atomic_load(cw, __ATOMIC_RELAXED, __HIP_MEMORY_SCOPE_AGENT), b1 = __hip_atomic_load(cw + 1, __ATOMIC_RELAXED, __HIP_MEMORY_SCOPE_AGENT), b2 = __hip_atomic_load(cw + 2, __ATOMIC_RELAXED, __HIP_MEMORY_SCOPE_AGENT), b3 = __hip_atomic_load(cw + 3, __ATOMIC_RELAXED, __HIP_MEMORY_SCOPE_AGENT), b4 = __hip_atomic_load(cw + 4, __ATOMIC_RELAXED, __HIP_MEMORY_SCOPE_AGENT), b5 = __hip_atomic_load(cw + 5, __ATOMIC_RELAXED, __HIP_MEMORY_SCOPE_AGENT);
        const float code = MK_CHECK_CODE;
        if (code > 0.f && bx == 0 && tid == 0) args.out[O_Y] = 4096.0f * sqrtf(code); }
#endif
#undef IN
#undef SEAM
}
}

extern "C" void kernel_launch(void* const* d_in, const int* in_sizes, int n_in, void* d_out, int out_size, void* d_ws, size_t ws_size, hipStream_t stream) {
    using namespace mk;
    static int grid = 0;
    if (grid == 0) {
        if (n_in != 29 || (size_t)out_size != O_END || ws_size < WS_END) { fprintf(stderr, "kernel_launch: unexpected shapes (n_in %d, out %d, ws %zu)\n", n_in, out_size, ws_size); grid = -1; return; }
        int dev = 0, cus = 0, per_cu = 0;
        if (hipGetDevice(&dev) != hipSuccess || hipDeviceGetAttribute(&cus, hipDeviceAttributeMultiprocessorCount, dev) != hipSuccess) { grid = -1; return; }
        if (hipFuncSetAttribute((const void*)fwd, hipFuncAttributeMaxDynamicSharedMemorySize, LDS_BYTES) != hipSuccess) { fprintf(stderr, "kernel_launch: hipFuncSetAttribute failed\n"); grid = -1; return; }
        if (hipOccupancyMaxActiveBlocksPerMultiprocessor(&per_cu, (const void*)fwd, NTHR, LDS_BYTES) != hipSuccess || per_cu < 1) fprintf(stderr, "kernel_launch: occupancy query says %d\n", per_cu);
        (void)hipGetLastError();
        grid = cus;
    }
    if (grid < 0) return;
    (void)hipMemsetAsync((char*)d_ws + WS_CTL, 0, CTL_ZERO_BYTES, stream);
    Args a{};
    for (int i = 0; i < 29; ++i) a.in[i] = (const float*)d_in[i];
    a.out = (float*)d_out; a.ws = (unsigned char*)d_ws;
#if MK_SPLIT
    for (int p = 0; p < NPHASE; ++p) { a.ph_lo = p; a.ph_hi = p + 1; hipLaunchKernelGGL(fwd, dim3(grid), dim3(NTHR), LDS_BYTES, stream, a); }
#else
    a.ph_lo = 0; a.ph_hi = NPHASE; hipLaunchKernelGGL(fwd, dim3(grid), dim3(NTHR), LDS_BYTES, stream, a);
#endif
}
```
